# Optimizing an MI355X kernel written in HIP

```python
import math
import jax, jax.numpy as jnp
from jax import lax
import numpy as np

D_MODEL = 1024
BATCH = 8
SEQ = 2048
DEPTH = 2
DEC_BATCH = 128
DEC_SEQ = 8
PAST_LEN = 16384
PAGE_SIZE = 128

D_MIX = D_MODEL
DN_HEAD_DIM = 128
DN_WIDTH = D_MIX // 2
DN_HEADS = DN_WIDTH // DN_HEAD_DIM
DN_CONV = 4
DN_CHUNK = 64
POOL_WINDOWS = (2, 4, 8, 16)
POOL_GROUPS = len(POOL_WINDOWS)
POOL_WIDTH = D_MIX // 4
POOL_GROUP_DIM = POOL_WIDTH // POOL_GROUPS
POOL_BUF = max(POOL_WINDOWS) - 1
SC_WIDTH = D_MIX - DN_WIDTH - POOL_WIDTH
SC_CONV = 3
D_FF = 2816
FFN_CONV = 3
EPS = 1e-6
SPLITS = (3 * DN_WIDTH, DN_WIDTH, DN_HEADS, DN_HEADS, POOL_WIDTH, SC_WIDTH, SC_WIDTH, SC_WIDTH)
D_IN = sum(SPLITS)

kernel_name = "hybrid_delta_pool_shortconv_decoder_step"


def rmsnorm(x, g):
    xf = x.astype(jnp.float32)
    y = xf * lax.rsqrt(jnp.mean(xf * xf, axis=-1, keepdims=True) + EPS)
    return (y * g.astype(jnp.float32)).astype(x.dtype)


def l2norm(t):
    tf = t.astype(jnp.float32)
    return tf * lax.rsqrt(jnp.sum(tf * tf, axis=-1, keepdims=True) + EPS)


def causal_dwconv(x, w, buf):
    width = w.shape[0]
    L = x.shape[1]
    xp = jnp.concatenate([buf.astype(x.dtype), x], axis=1)
    y = xp[:, 0:L] * w[0]
    for i in range(1, width):
        y = y + xp[:, i:i + L] * w[i]
    return y, xp[:, xp.shape[1] - (width - 1):]


def gated_delta_rule(q, k, v, g, beta, s0):
    f32 = jnp.float32
    bsz, L, h, dk = q.shape
    dv = v.shape[-1]
    c = min(DN_CHUNK, L)
    n = -(-L // c)
    pad = n * c - L

    def prep(t):
        t = t.astype(f32)
        t = jnp.pad(t, [(0, 0), (0, pad)] + [(0, 0)] * (t.ndim - 2))
        t = t.reshape((bsz, n, c) + t.shape[2:])
        return jnp.moveaxis(t, 3, 1)

    q, k, v, g, beta = prep(q), prep(k), prep(v), prep(g), prep(beta)
    q = q * (dk ** -0.5)
    gc = jnp.cumsum(g, axis=-1)
    idx = jnp.arange(c)
    causal = idx[:, None] >= idx[None, :]
    strict = idx[:, None] > idx[None, :]
    decay = jnp.exp(jnp.where(causal, gc[..., :, None] - gc[..., None, :], -jnp.inf))
    kb = k * beta[..., None]
    a = jnp.einsum('bhnid,bhnjd->bhnij', kb, k) * jnp.where(strict, decay, 0.0)
    eye = jnp.eye(c, dtype=f32)
    rhs = jnp.concatenate([v * beta[..., None], kb * jnp.exp(gc)[..., None]], axis=-1)
    sol = lax.linalg.triangular_solve(eye + a, rhs, left_side=True, lower=True)
    u, w = sol[..., :dv], sol[..., dv:]
    qk = jnp.einsum('bhnid,bhnjd->bhnij', q, k) * decay
    qg = q * jnp.exp(gc)[..., None]
    g_last = gc[..., -1]
    kd = k * jnp.exp(g_last[..., None] - gc)[..., None]

    def step(s, xs):
        u_i, w_i, qk_i, qg_i, kd_i, gl_i = xs
        v_new = u_i - jnp.einsum('bhck,bhkv->bhcv', w_i, s)
        o = jnp.einsum('bhck,bhkv->bhcv', qg_i, s) + jnp.einsum('bhij,bhjv->bhiv', qk_i, v_new)
        s = s * jnp.exp(gl_i)[..., None, None] + jnp.einsum('bhck,bhcv->bhkv', kd_i, v_new)
        return s, o

    xs = tuple(jnp.moveaxis(t, 2, 0) for t in (u, w, qk, qg, kd, g_last))
    s, o = lax.scan(step, s0.astype(f32), xs)
    o = jnp.moveaxis(o, 0, 2)
    o = jnp.moveaxis(o, 1, 3).reshape(bsz, n * c, h, dv)[:, :L]
    return o, s


def delta_mixer(qkv, z, a, bg, conv_w, a_log, dt_bias, out_norm, s0, buf):
    bsz, L, _ = qkv.shape
    cv, new_buf = causal_dwconv(qkv, conv_w, buf)
    cv = jax.nn.silu(cv)
    q, k, v = jnp.split(cv, 3, axis=-1)
    q = l2norm(q.reshape(bsz, L, DN_HEADS, DN_HEAD_DIM))
    k = l2norm(k.reshape(bsz, L, DN_HEADS, DN_HEAD_DIM))
    v = v.reshape(bsz, L, DN_HEADS, DN_HEAD_DIM)
    g = -jnp.exp(a_log.astype(jnp.float32)) * jax.nn.softplus(a.astype(jnp.float32) + dt_bias.astype(jnp.float32))
    beta = jax.nn.sigmoid(bg.astype(jnp.float32))
    o, s = gated_delta_rule(q, k, v, g, beta, s0)
    zf = z.reshape(bsz, L, DN_HEADS, DN_HEAD_DIM).astype(jnp.float32)
    o = o * lax.rsqrt(jnp.mean(o * o, axis=-1, keepdims=True) + EPS) * out_norm.astype(jnp.float32) * jax.nn.silu(zf)
    return o.reshape(bsz, L, DN_WIDTH).astype(qkv.dtype), s, new_buf


def pool_mixer(xin, buf, w_grp, scale, pos0):
    bsz, L, wd = xin.shape
    xf = xin.astype(jnp.float32)
    ext = jnp.concatenate([buf.astype(jnp.float32), xf], axis=1)
    cs = jnp.concatenate([jnp.zeros((bsz, 1, wd), jnp.float32), jnp.cumsum(ext, axis=1)], axis=1)
    pos = jnp.arange(L) + pos0
    hi = cs[:, POOL_BUF + 1:POOL_BUF + 1 + L]
    outs = []
    for gi, win in enumerate(POOL_WINDOWS):
        lo_c, hi_c = gi * POOL_GROUP_DIM, (gi + 1) * POOL_GROUP_DIM
        ssum = hi[..., lo_c:hi_c] - cs[:, POOL_BUF + 1 - win:POOL_BUF + 1 - win + L, lo_c:hi_c]
        cnt = jnp.minimum(pos + 1, win).astype(jnp.float32)
        outs.append(ssum / cnt[None, :, None])
    d = (jnp.concatenate(outs, axis=-1) - xf).reshape(bsz, L, POOL_GROUPS, POOL_GROUP_DIM)
    y = jnp.einsum('blgc,gcd->blgd', d, w_grp.astype(jnp.float32)).reshape(bsz, L, wd) * scale.astype(jnp.float32)
    return y.astype(xin.dtype), ext[:, ext.shape[1] - POOL_BUF:].astype(xin.dtype)


def trunk(x, states, pos0, params):
    st_delta, st_dconv, st_pool, st_sconv, st_fconv = states
    (norm_mix, w_in, dn_conv_w, dn_a_log, dn_dt_bias, dn_out_norm, pool_w, pool_scale,
     sconv_w, w_out, norm_ffn, w_ffn_gate, ffn_conv_w, w_ffn_up, w_ffn_down, final_norm) = params
    sd, sdc, sp, ssc, sfc = [], [], [], [], []
    cuts = list(np.cumsum(SPLITS)[:-1])
    for l in range(DEPTH):
        h = rmsnorm(x, norm_mix[l])
        proj = h @ w_in[l]
        qkv, z, a, bg, p_in, sc_x, sc_b, sc_c = jnp.split(proj, cuts, axis=-1)
        o_a, s_new, dbuf = delta_mixer(qkv, z, a, bg, dn_conv_w[l], dn_a_log[l], dn_dt_bias[l],
                                       dn_out_norm[l], st_delta[l], st_dconv[l])
        o_b, pbuf = pool_mixer(p_in, st_pool[l], pool_w[l], pool_scale[l], pos0)
        cconv, cbuf = causal_dwconv(sc_c * sc_x, sconv_w[l], st_sconv[l])
        o_c = sc_b * cconv
        x = x + jnp.concatenate([o_a, o_b, o_c], axis=-1) @ w_out[l]
        h = rmsnorm(x, norm_ffn[l])
        gate, fbuf = causal_dwconv(h @ w_ffn_gate[l], ffn_conv_w[l], st_fconv[l])
        x = x + (jax.nn.silu(gate) * (h @ w_ffn_up[l])) @ w_ffn_down[l]
        sd.append(s_new); sdc.append(dbuf); sp.append(pbuf); ssc.append(cbuf); sfc.append(fbuf)
    y = rmsnorm(x, final_norm)
    return y, (jnp.stack(sd), jnp.stack(sdc), jnp.stack(sp), jnp.stack(ssc), jnp.stack(sfc))


def setup_inputs(seed: int = 0) -> dict:
    key = jax.random.key(seed)
    ks = iter(jax.random.split(key, 32))

    def nrm(shape, scale=1.0):
        return jax.random.normal(next(ks), shape, jnp.float32) * scale

    dt = jnp.exp(jax.random.uniform(next(ks), (DEPTH, DN_HEADS), jnp.float32,
                                    minval=math.log(1e-3), maxval=math.log(1e-1)))
    return {
        "x_prompt": nrm((BATCH, SEQ, D_MODEL)),
        "x_sample": nrm((DEC_BATCH, DEC_SEQ, D_MODEL)),
        "state_delta": nrm((DEPTH, DEC_BATCH, DN_HEADS, DN_HEAD_DIM, DN_HEAD_DIM), 0.1),
        "state_delta_conv": nrm((DEPTH, DEC_BATCH, DN_CONV - 1, 3 * DN_WIDTH)),
        "state_pool": nrm((DEPTH, DEC_BATCH, POOL_BUF, POOL_WIDTH)),
        "state_sconv": nrm((DEPTH, DEC_BATCH, SC_CONV - 1, SC_WIDTH)),
        "state_ffn_conv": nrm((DEPTH, DEC_BATCH, FFN_CONV - 1, D_FF)),
        "norm_mix": 1.0 + nrm((DEPTH, D_MODEL), 0.05),
        "w_in": nrm((DEPTH, D_MODEL, D_IN), D_MODEL ** -0.5),
        "dn_conv_w": nrm((DEPTH, DN_CONV, 3 * DN_WIDTH), 0.5),
        "dn_a_log": jnp.log(jax.random.uniform(next(ks), (DEPTH, DN_HEADS), jnp.float32, minval=1.0, maxval=16.0)),
        "dn_dt_bias": dt + jnp.log(-jnp.expm1(-dt)),
        "dn_out_norm": 1.0 + nrm((DEPTH, DN_HEAD_DIM), 0.05),
        "pool_w": nrm((DEPTH, POOL_GROUPS, POOL_GROUP_DIM, POOL_GROUP_DIM), POOL_GROUP_DIM ** -0.5),
        "pool_scale": 0.5 + nrm((DEPTH, POOL_WIDTH), 0.1),
        "sconv_w": nrm((DEPTH, SC_CONV, SC_WIDTH), 0.5),
        "w_out": nrm((DEPTH, D_MIX, D_MODEL), D_MIX ** -0.5),
        "norm_ffn": 1.0 + nrm((DEPTH, D_MODEL), 0.05),
        "w_ffn_gate": nrm((DEPTH, D_MODEL, D_FF), D_MODEL ** -0.5),
        "ffn_conv_w": nrm((DEPTH, FFN_CONV, D_FF), 0.5),
        "w_ffn_up": nrm((DEPTH, D_MODEL, D_FF), D_MODEL ** -0.5),
        "w_ffn_down": nrm((DEPTH, D_FF, D_MODEL), D_FF ** -0.5),
        "final_norm": 1.0 + nrm((D_MODEL,), 0.05),
    }


def reference(x_prompt, x_sample, state_delta, state_delta_conv, state_pool, state_sconv, state_ffn_conv,
              norm_mix, w_in, dn_conv_w, dn_a_log, dn_dt_bias, dn_out_norm, pool_w, pool_scale,
              sconv_w, w_out, norm_ffn, w_ffn_gate, ffn_conv_w, w_ffn_up, w_ffn_down, final_norm):
    params = (norm_mix, w_in, dn_conv_w, dn_a_log, dn_dt_bias, dn_out_norm, pool_w, pool_scale,
              sconv_w, w_out, norm_ffn, w_ffn_gate, ffn_conv_w, w_ffn_up, w_ffn_down, final_norm)
    dt = x_prompt.dtype
    zero_states = (
        jnp.zeros((DEPTH, BATCH, DN_HEADS, DN_HEAD_DIM, DN_HEAD_DIM), jnp.float32),
        jnp.zeros((DEPTH, BATCH, DN_CONV - 1, 3 * DN_WIDTH), dt),
        jnp.zeros((DEPTH, BATCH, POOL_BUF, POOL_WIDTH), dt),
        jnp.zeros((DEPTH, BATCH, SC_CONV - 1, SC_WIDTH), dt),
        jnp.zeros((DEPTH, BATCH, FFN_CONV - 1, D_FF), dt),
    )
    y_prompt, p_st = trunk(x_prompt, zero_states, 0, params)
    y_sample, s_st = trunk(x_sample, (state_delta, state_delta_conv, state_pool, state_sconv, state_ffn_conv),
                           PAST_LEN, params)
    return (y_prompt, y_sample,
            p_st[0].astype(state_delta.dtype), p_st[1].astype(state_delta_conv.dtype),
            p_st[2].astype(state_pool.dtype), p_st[3].astype(state_sconv.dtype),
            p_st[4].astype(state_ffn_conv.dtype),
            s_st[0].astype(state_delta.dtype), s_st[1].astype(state_delta_conv.dtype),
            s_st[2].astype(state_pool.dtype), s_st[3].astype(state_sconv.dtype),
            s_st[4].astype(state_ffn_conv.dtype))
```

```cpp
#include <hip/hip_runtime.h>
#include <hip/hip_cooperative_groups.h>
#include <cstdio>
#include <cstdint>
namespace cg = cooperative_groups;
__device__ __forceinline__ int fresh_tid() { int t = threadIdx.x; asm volatile("" : "+v"(t)); return t; }
namespace pg8 {
#define PG8_LAS __attribute__((address_space(3)))
typedef unsigned short bf16_t;
typedef short bf16x8 __attribute__((ext_vector_type(8)));
typedef float f32x4 __attribute__((ext_vector_type(4)));
typedef unsigned u32x4 __attribute__((ext_vector_type(4)));
constexpr int BM = 256, BK = 64, HALF = 128, HTB = HALF * BK * 2  , STAGE_BYTES = 8 * HTB, NXCD = 8, WGM = 8;

__host__ __device__ __forceinline__ int lds_byte(int r, int c) { const int st = (r >> 4) * 2 + (c >> 5), rr = r & 15, cc = c & 31, ob = rr * 64 + cc * 2; return st * 1024 + (ob ^ (((ob >> 9) & 1) << 5)); }
__host__ __device__ __forceinline__ void stage_rc(int b, int& R, int& C) { const int st = b / 1024, sb = b % 1024, swz = sb ^ (((sb >> 9) & 1) << 5); R = (st >> 1) * 16 + swz / 64; C = (st & 1) * 32 + (swz % 64) / 2; }
__host__ __device__ __forceinline__ int perm32(int rho) { const int n = rho >> 4, i = rho & 15; return 8 * (i >> 2) + 4 * n + (i & 3); }

struct Unit { int pm, pn; };
struct Gemm { const bf16_t* A; const bf16_t* Bt; int M, N, K, lda; };

struct StaticOrder {
    int nM, nN, nwg, G, c;
    __host__ __device__ void init(int M, int N, int G_, int c_) { nM = M / BM; nN = N / BM; nwg = nM * nN; G = G_; c = c_; }
    __host__ __device__ bool next(int i, Unit& u) const {
        const long L = (long)i * G + c; if (L >= nwg) return false;
        int wgid = (int)L; { const int q = nwg / NXCD, r = nwg % NXCD, xcd = wgid % NXCD, off = wgid / NXCD; wgid = (xcd < r ? xcd * (q + 1) : r * (q + 1) + (xcd - r) * q) + off; }
        const int nig = WGM * nN, gid = wgid / nig, fm = gid * WGM, gsz = (nM - fm) < WGM ? (nM - fm) : WGM;
        u.pm = fm + ((wgid % nig) % gsz); u.pn = (wgid % nig) / gsz; return true;
    }
    __device__ __forceinline__ void a_ready(const Unit&) const {}
    __device__ __forceinline__ void done(const Unit&) const {}
};

template <class Epi, class Sched, bool ALIGN_EPI = false, bool SP2 = false>
__device__ __forceinline__ void gemm_phase(PG8_LAS unsigned char* lds, const Gemm g, const Sched& S, const Epi& E) {
    const int tid = fresh_tid(), wid = __builtin_amdgcn_readfirstlane(tid >> 6), lane = tid & 63, wr = wid >> 2, wc = wid & 3, fr = lane & 15, fq = lane >> 4;
    const int K = g.K, nt = K / BK;
    unsigned voffA[2], voffB[2];
#pragma unroll
    for (int i = 0; i < 2; ++i) { int R, C; stage_rc(tid * 16 + i * 8192, R, C); const int Rb = Epi::PERM ? ((R & ~31) + perm32(R & 31)) : R;
        voffA[i] = (unsigned)(R * g.lda + C) * 2u; voffB[i] = (unsigned)(Rb * K + C) * 2u; }
    const size_t kstep = (size_t)(BK * 2);
    const size_t hstepA = (size_t)HALF * g.lda * 2, hstepB = (size_t)HALF * K * 2;
    const size_t tstepA = 2 * hstepA, tstepB = 2 * hstepB;
    const unsigned ldsw = (unsigned)wid * 1024u;
    const int aoff = lds_byte(wr * 64 + fr, fq * 8), boff = lds_byte(wc * 32 + fr, fq * 8);
#define PG8_SA(b, h) (((b) * 2 + (h)) * HTB)
#define PG8_SB(b, h) ((4 + (b) * 2 + (h)) * HTB)
#define PG8_STAGE(bufoff, gbase, voff) do { _Pragma("unroll") for (int _i = 0; _i < 2; ++_i) \
        __builtin_amdgcn_global_load_lds((const unsigned*)((const char*)(gbase) + (voff)[_i]), (PG8_LAS unsigned*)(lds + (bufoff) + ldsw + _i * 8192), 16, 0, 0); } while (0)
#define PG8_LDA(dst, b, h) do { _Pragma("unroll") for (int m = 0; m < 4; ++m) _Pragma("unroll") for (int k = 0; k < 2; ++k) dst[m][k] = *(const PG8_LAS bf16x8*)(lds + PG8_SA(b, h) + aoff + m * 2048 + k * 1024); } while (0)
#define PG8_LDB(dst, b, h) do { _Pragma("unroll") for (int n = 0; n < 2; ++n) _Pragma("unroll") for (int k = 0; k < 2; ++k) dst[n][k] = *(const PG8_LAS bf16x8*)(lds + PG8_SB(b, h) + boff + n * 2048 + k * 1024); } while (0)
#define PG8_MMA(ai, bj, At, Bt) do { __builtin_amdgcn_s_setprio(1); _Pragma("unroll") for (int m = 0; m < 4; ++m) _Pragma("unroll") for (int n = 0; n < 2; ++n) _Pragma("unroll") for (int k = 0; k < 2; ++k) \
        acc[ai][bj][m][n] = __builtin_amdgcn_mfma_f32_16x16x32_bf16(Bt[n][k], At[m][k], acc[ai][bj][m][n], 0, 0, 0); __builtin_amdgcn_s_setprio(0); } while (0)
#define PG8_WAIT_V(n) asm volatile("s_waitcnt vmcnt(" #n ")" ::: "memory")
#define PG8_WAIT_L(n) asm volatile("s_waitcnt lgkmcnt(" #n ")" ::: "memory")
#define PG8_BAR __builtin_amdgcn_s_barrier()
#define PG8_SCHED __builtin_amdgcn_sched_barrier(0)
    Unit cur, nxt; int ui = 0;
    if (!S.next(0, cur)) return;
    f32x4 acc[2][2][4][2];
#pragma unroll
    for (int a = 0; a < 2; ++a)
#pragma unroll
        for (int b = 0; b < 2; ++b)
#pragma unroll
            for (int m = 0; m < 4; ++m)
#pragma unroll
                for (int n = 0; n < 2; ++n) acc[a][b][m][n] = (f32x4){0.f, 0.f, 0.f, 0.f};
    bf16x8 At[4][2], B0[2][2], B1[2][2];
    const char* cA = (const char*)g.A + (size_t)cur.pm * tstepA; const char* cB = (const char*)g.Bt + (size_t)cur.pn * tstepB;
    S.a_ready(cur);
    if constexpr (SP2) {
        PG8_STAGE(PG8_SB(0, 0), cB, voffB); PG8_STAGE(PG8_SB(0, 1), cB + hstepB, voffB); PG8_STAGE(PG8_SA(0, 0), cA, voffA); PG8_STAGE(PG8_SA(0, 1), cA + hstepA, voffA);
        if (wr == 1) PG8_BAR;
        PG8_WAIT_V(2); PG8_BAR;
        PG8_STAGE(PG8_SB(1, 0), cB + kstep, voffB); PG8_STAGE(PG8_SA(1, 0), cA + kstep, voffA); PG8_STAGE(PG8_SB(1, 1), cB + hstepB + kstep, voffB);
        PG8_WAIT_V(6); PG8_BAR;
    } else {
        PG8_STAGE(PG8_SB(0, 0), cB, voffB); PG8_STAGE(PG8_SA(0, 0), cA, voffA); PG8_STAGE(PG8_SB(0, 1), cB + hstepB, voffB); PG8_STAGE(PG8_SA(0, 1), cA + hstepA, voffA);
        if (wr == 1) PG8_BAR;
        PG8_WAIT_V(4); PG8_BAR;
        PG8_STAGE(PG8_SB(1, 0), cB + kstep, voffB); PG8_STAGE(PG8_SA(1, 0), cA + kstep, voffA); PG8_STAGE(PG8_SB(1, 1), cB + hstepB + kstep, voffB);
        PG8_WAIT_V(6); PG8_BAR;
    }
    for (;;) {
        const bool has_next = S.next(ui + 1, nxt);
        const char* nA = has_next ? (const char*)g.A + (size_t)nxt.pm * tstepA : cA; const char* nB = has_next ? (const char*)g.Bt + (size_t)nxt.pn * tstepB : cB;
        for (int t = 0; t < nt; t += 2) {
            const bool last = (t == nt - 2);
            const char* a1 = cA + (size_t)(t + 1) * kstep;
            const char* a2 = last ? nA : cA + (size_t)(t + 2) * kstep; const char* b2 = last ? nB : cB + (size_t)(t + 2) * kstep;
            const char* a3 = a2 + kstep; const char* b3 = b2 + kstep;
            if (last && has_next) S.a_ready(nxt);
            if constexpr (SP2) {
            PG8_LDB(B0, 0, 0); PG8_LDB(B1, 0, 1); PG8_SCHED; PG8_LDA(At, 0, 0); PG8_STAGE(PG8_SA(1, 1), a1 + hstepA, voffA);
            PG8_WAIT_V(8); PG8_WAIT_L(0); PG8_BAR; PG8_MMA(0, 0, At, B0); PG8_MMA(0, 1, At, B1); PG8_BAR; PG8_SCHED;
            PG8_LDA(At, 0, 1); PG8_STAGE(PG8_SB(0, 0), b2, voffB); PG8_STAGE(PG8_SB(0, 1), b2 + hstepB, voffB); PG8_STAGE(PG8_SA(0, 0), a2, voffA);
            PG8_WAIT_V(8); PG8_WAIT_L(0); PG8_BAR; PG8_MMA(1, 0, At, B0); PG8_MMA(1, 1, At, B1); PG8_BAR; PG8_SCHED;
            PG8_LDB(B0, 1, 0); PG8_LDB(B1, 1, 1); PG8_SCHED; PG8_LDA(At, 1, 0); PG8_STAGE(PG8_SA(0, 1), a2 + hstepA, voffA);
            PG8_WAIT_V(8); PG8_WAIT_L(0); PG8_BAR; PG8_MMA(0, 0, At, B0); PG8_MMA(0, 1, At, B1); PG8_BAR; PG8_SCHED;
            PG8_LDA(At, 1, 1); PG8_STAGE(PG8_SB(1, 0), b3, voffB); PG8_STAGE(PG8_SB(1, 1), b3 + hstepB, voffB); PG8_STAGE(PG8_SA(1, 0), a3, voffA);
            PG8_WAIT_V(8); PG8_WAIT_L(0); PG8_BAR; PG8_MMA(1, 0, At, B0); PG8_MMA(1, 1, At, B1); PG8_BAR; PG8_SCHED;
            } else {
            PG8_LDB(B0, 0, 0); PG8_SCHED; PG8_LDA(At, 0, 0); PG8_STAGE(PG8_SA(1, 1), a1 + hstepA, voffA);
            PG8_WAIT_L(8); PG8_BAR; PG8_WAIT_L(0); PG8_MMA(0, 0, At, B0); PG8_BAR; PG8_SCHED;
            PG8_LDB(B1, 0, 1); PG8_STAGE(PG8_SB(0, 0), b2, voffB);
            PG8_BAR; PG8_WAIT_L(0); PG8_MMA(0, 1, At, B1); PG8_BAR;
            PG8_LDA(At, 0, 1); PG8_STAGE(PG8_SA(0, 0), a2, voffA);
            PG8_BAR; PG8_WAIT_L(0); PG8_MMA(1, 0, At, B0); PG8_BAR; PG8_SCHED;
            PG8_STAGE(PG8_SB(0, 1), b2 + hstepB, voffB);
            PG8_WAIT_V(6); PG8_BAR; PG8_MMA(1, 1, At, B1); PG8_BAR;
            PG8_LDB(B0, 1, 0); PG8_SCHED; PG8_LDA(At, 1, 0); PG8_STAGE(PG8_SA(0, 1), a2 + hstepA, voffA);
            PG8_WAIT_L(8); PG8_BAR; PG8_WAIT_L(0); PG8_MMA(0, 0, At, B0); PG8_BAR; PG8_SCHED;
            PG8_LDB(B1, 1, 1); PG8_STAGE(PG8_SB(1, 0), b3, voffB);
            PG8_BAR; PG8_WAIT_L(0); PG8_MMA(0, 1, At, B1); PG8_BAR;
            PG8_LDA(At, 1, 1); PG8_STAGE(PG8_SA(1, 0), a3, voffA);
            PG8_BAR; PG8_WAIT_L(0); PG8_MMA(1, 0, At, B0); PG8_BAR; PG8_SCHED;
            PG8_STAGE(PG8_SB(1, 1), b3 + hstepB, voffB);
            PG8_WAIT_V(6); PG8_BAR; PG8_MMA(1, 1, At, B1); PG8_BAR;
            }
        }
        if constexpr (ALIGN_EPI) { if (wr == 0) PG8_BAR; }
        if constexpr (!Epi::AFTER_DRAIN) { E(acc, cur, wr, wc, fr, fq); S.done(cur); }
        if (!has_next) break;
#pragma unroll
        for (int a = 0; a < 2; ++a)
#pragma unroll
            for (int b = 0; b < 2; ++b)
#pragma unroll
                for (int m = 0; m < 4; ++m)
#pragma unroll
                    for (int n = 0; n < 2; ++n) acc[a][b][m][n] = (f32x4){0.f, 0.f, 0.f, 0.f};
        cur = nxt; cA = nA; cB = nB; ++ui;
        if constexpr (ALIGN_EPI) { if (wr == 1) PG8_BAR; }
    }
    PG8_WAIT_V(0);
    if constexpr (!ALIGN_EPI) { if (wr == 0) PG8_BAR; }
    PG8_BAR;
    if constexpr (Epi::AFTER_DRAIN) { E.fused(acc, cur, wr, wc, fr, fq, lds, wid, lane); S.done(cur); }
#undef PG8_SA
#undef PG8_SB
#undef PG8_STAGE
#undef PG8_LDA
#undef PG8_LDB
#undef PG8_MMA
#undef PG8_WAIT_V
#undef PG8_WAIT_L
#undef PG8_BAR
#undef PG8_SCHED
}
}

typedef unsigned short bf16;
typedef unsigned v4u __attribute__((ext_vector_type(4)));
typedef unsigned v2u __attribute__((ext_vector_type(2)));
typedef float f32x4 __attribute__((ext_vector_type(4)));
typedef short bf16x8 __attribute__((ext_vector_type(8)));

constexpr int D = 1024, MP = 16384, MS = 1024, M = MP + MS, SEQL = 2048, NBATCH = 8, DBATCH = 128;
constexpr int NPROJ = 3072, FF = 2816, NGU = 5632, DIN = 3080, MH = M / 2;
constexpr float EPS = 1e-6f;
constexpr int NTHREADS = 512, NWAVES = 8;
constexpr int LDS_BYTES = 155648;
constexpr size_t MiB = 1u << 20;
constexpr size_t WS_WOUT = 0, WS_WGU = 4 * MiB, WS_WDN = 26 * MiB, WS_XA = 37 * MiB, WS_PROJ = 71 * MiB, WS_GU = 105 * MiB, WS_SCR = 173 * MiB, WS_WIN = 239 * MiB;
constexpr size_t WS_GB = 245 * MiB, WS_SSQ = 245 * MiB + 576 * 1024, WS_WAB = 246 * MiB, WS_GL = 246 * MiB + 64 * 1024, WS_HALO = 246 * MiB + 128 * 1024, WS_END = 247 * MiB;
constexpr int SCR_ITEM = 73728;
constexpr size_t O_PDELTA = 17825792, O_PDCONV = 18874368, O_PPOOL = 18948096, O_PSCONV = 19009536, O_PFFN = 19017728;
constexpr size_t O_SDELTA = 19107840, O_SDCONV = 35885056, O_SPOOL = 37064704, O_SSCONV = 38047744, O_SFFN = 38178816, O_TOTAL = 39620608;

struct Params { const float* in[23]; float* out; unsigned char* ws; };
typedef const __attribute__((address_space(4))) Params* KP;
__device__ __forceinline__ KP kparams() { KP p = (KP)__builtin_amdgcn_kernarg_segment_ptr(); asm volatile("" : "+s"(p)); return p; }

#define LAUNDER(p) asm volatile("" : "+s"(p))
#define LDS_WAIT() asm volatile("s_waitcnt lgkmcnt(0)" ::: "memory")
__device__ __forceinline__ unsigned f2bf(float f) { unsigned u = __builtin_bit_cast(unsigned, f); return (u + 0x7fffu + ((u >> 16) & 1u)) >> 16; }
__device__ __forceinline__ unsigned pk2(float lo, float hi) { return f2bf(lo) | (f2bf(hi) << 16); }
__device__ __forceinline__ float bflo(unsigned u) { return __builtin_bit_cast(float, u << 16); }
__device__ __forceinline__ float bfhi(unsigned u) { return __builtin_bit_cast(float, u & 0xffff0000u); }
__device__ __forceinline__ float bf1(bf16 h) { return __builtin_bit_cast(float, ((unsigned)h) << 16); }
__device__ __forceinline__ float siluf(float x) { return x / (1.f + __expf(-x)); }
__device__ __forceinline__ float wave_sum(float v) {
#pragma unroll
    for (int o = 1; o < 64; o <<= 1) v += __shfl_xor(v, o);
    return v;
}
#define UNPACK8(W_, F_) do { (F_)[0] = bflo((W_).x); (F_)[1] = bfhi((W_).x); (F_)[2] = bflo((W_).y); (F_)[3] = bfhi((W_).y); (F_)[4] = bflo((W_).z); (F_)[5] = bfhi((W_).z); (F_)[6] = bflo((W_).w); (F_)[7] = bfhi((W_).w); } while (0)
#define PACK8(F_) ((v4u){pk2((F_)[0], (F_)[1]), pk2((F_)[2], (F_)[3]), pk2((F_)[4], (F_)[5]), pk2((F_)[6], (F_)[7])})

struct EpiScale {
    static constexpr bool PERM = true, AFTER_DRAIN = false;
    bf16* O; int ldc; const float* ssq;
    __device__ __forceinline__ void operator()(const pg8::f32x4 (&acc)[2][2][4][2], const pg8::Unit& u, int wr, int wc, int fr, int fq) const {
        const int row0 = u.pm * 256 + wr * 64 + fr, col0 = u.pn * 256 + wc * 32 + 8 * fq;
#pragma unroll
        for (int ai = 0; ai < 2; ++ai)
#pragma unroll
            for (int m = 0; m < 4; ++m) {
                const int row = row0 + ai * 128 + m * 16;
                const float rs = rsqrtf(ssq[row] * (1.f / D) + EPS);
                bf16* rowp = O + (size_t)row * ldc + col0;
#pragma unroll
                for (int bj = 0; bj < 2; ++bj) {
                    pg8::f32x4 v0 = acc[ai][bj][m][0] * rs, v1 = acc[ai][bj][m][1] * rs;
                    v4u w; w.x = pk2(v0[0], v0[1]); w.y = pk2(v0[2], v0[3]); w.z = pk2(v1[0], v1[1]); w.w = pk2(v1[2], v1[3]);
                    *(v4u*)(rowp + bj * 128) = w;
                }
            }
    }
};
struct EpiResid {
    static constexpr bool PERM = true, AFTER_DRAIN = false;
    const float* xa; const float* xb_; float* xres; bf16* xb16; float* ssq; int rowbase;
    __device__ __forceinline__ void operator()(const pg8::f32x4 (&acc)[2][2][4][2], const pg8::Unit& u, int wr, int wc, int fr, int fq) const {
        const int row0 = rowbase + u.pm * 256 + wr * 64 + fr, col0 = u.pn * 256 + wc * 32 + 8 * fq;
#pragma unroll
        for (int ai = 0; ai < 2; ++ai)
#pragma unroll
            for (int m = 0; m < 4; ++m) {
                const int row = row0 + ai * 128 + m * 16;
                const float* xo = (row < MP ? xa + (size_t)row * D : xb_ + (size_t)(row - MP) * D) + col0;
                float* xr = xres + (size_t)row * D + col0;
                bf16* xh = xb16 + (size_t)row * D + col0;
                float ss = 0.f;
#pragma unroll
                for (int bj = 0; bj < 2; ++bj) {
                    const pg8::f32x4 o0 = *(const pg8::f32x4*)(xo + bj * 128), o1 = *(const pg8::f32x4*)(xo + bj * 128 + 4);
                    pg8::f32x4 v0 = acc[ai][bj][m][0] + o0, v1 = acc[ai][bj][m][1] + o1;
                    *(pg8::f32x4*)(xr + bj * 128) = v0; *(pg8::f32x4*)(xr + bj * 128 + 4) = v1;
                    v4u w; w.x = pk2(v0[0], v0[1]); w.y = pk2(v0[2], v0[3]); w.z = pk2(v1[0], v1[1]); w.w = pk2(v1[2], v1[3]);
                    *(v4u*)(xh + bj * 128) = w;
                    ss += v0[0] * v0[0] + v0[1] * v0[1] + v0[2] * v0[2] + v0[3] * v0[3] + v1[0] * v1[0] + v1[1] * v1[1] + v1[2] * v1[2] + v1[3] * v1[3];
                }
                ss += __shfl_xor(ss, 16); ss += __shfl_xor(ss, 32);
                if (fq == 0) atomicAdd(ssq + row, ss);
            }
    }
};

__device__ __forceinline__ void transpose_item(const float* W, int K, int ldw, int src_col0, const float* g, bf16* WT, int dst_row0, float* scr, int kb, int lane) {
    const int k0 = 64 * kb;
#pragma unroll 8
    for (int i = 0; i < 32; ++i) { const int kk = 2 * i + (lane >> 5); const float gs = g ? g[k0 + kk] : 1.f;
        scr[kk * 33 + (lane & 31)] = W[(size_t)(k0 + kk) * ldw + src_col0 + (lane & 31)] * gs; }
    LDS_WAIT();
    const int c = lane & 7;
#pragma unroll
    for (int j = 0; j < 4; ++j) { const int n = (lane >> 3) + 8 * j; const float* s = scr + (8 * c) * 33 + n;
        v4u o; o.x = pk2(s[0 * 33], s[1 * 33]); o.y = pk2(s[2 * 33], s[3 * 33]); o.z = pk2(s[4 * 33], s[5 * 33]); o.w = pk2(s[6 * 33], s[7 * 33]);
        *(v4u*)(WT + (size_t)(dst_row0 + n) * K + k0 + 8 * c) = o; }
    LDS_WAIT();
}
__device__ __forceinline__ void convert_matrix(const float* W, int K, int N, int ldw, int skip_from, int skip, const float* g, bf16* WT, int dst_row0, float* scr, int gw, int ngw, int lane) {
    const int nnb = N / 32, nit = (K / 64) * nnb;
    for (int it = gw; it < nit; it += ngw) {
        const int kb = it / nnb, nb = it % nnb, n0 = nb * 32;
        transpose_item(W, K, ldw, n0 + (n0 >= skip_from ? skip : 0), g, WT, dst_row0 + n0, scr, kb, lane);
    }
}
__device__ __forceinline__ void convert_layer_rest(KP P, int l, float* scr, int gw, int ngw, int lane) {
    unsigned char* ws = P->ws;
    convert_matrix(P->in[16] + (size_t)l * D * D, D, D, D, 1 << 30, 0, nullptr, (bf16*)(ws + WS_WOUT) + (size_t)l * D * D, 0, scr, gw, ngw, lane);
    convert_matrix(P->in[18] + (size_t)l * D * FF, D, FF, FF, 1 << 30, 0, P->in[17] + l * D, (bf16*)(ws + WS_WGU) + (size_t)l * NGU * D, 0, scr, gw, ngw, lane);
    convert_matrix(P->in[20] + (size_t)l * D * FF, D, FF, FF, 1 << 30, 0, P->in[17] + l * D, (bf16*)(ws + WS_WGU) + (size_t)l * NGU * D, FF, scr, gw, ngw, lane);
    convert_matrix(P->in[21] + (size_t)l * FF * D, FF, D, D, 1 << 30, 0, nullptr, (bf16*)(ws + WS_WDN) + (size_t)l * D * FF, 0, scr, gw, ngw, lane);
}
__device__ __forceinline__ void convert_win(KP P, int l, float* scr, int gw, int ngw, int lane) {
    convert_matrix(P->in[8] + (size_t)l * D * DIN, D, NPROJ, DIN, 2048, 8, P->in[7] + l * D, (bf16*)(P->ws + WS_WIN), 0, scr, gw, ngw, lane);
}

constexpr int B_QF = 0, B_KF = 33792, B_VF = 67584, B_AT = 101376, B_GC = 118784, B_QKS = 120320, B_WST = 128512;
__device__ __forceinline__ void p2b_item(KP P, int l, int item, unsigned char* lds, int tid_unused) {
    const int tid = fresh_tid();
    const int h = item & 3, n = (item >> 2) & 31, b = item >> 7;
    const int lane = tid & 63, wv = __builtin_amdgcn_readfirstlane(tid >> 6), fr = lane & 15, fq = lane >> 4;
    float* QF = (float*)(lds + B_QF); float* KF = (float*)(lds + B_KF); float* VF = (float*)(lds + B_VF); float* AT = (float*)(lds + B_AT);
    float* Gs = (float*)(lds + B_GC); float* BETA = Gs + 64; float* GC = Gs + 128; float* EG = Gs + 192; float* EKD = Gs + 256;
    bf16* QKS = (bf16*)(lds + B_QKS); bf16* WST = (bf16*)(lds + B_WST);
    const bf16* PROJ = (const bf16*)(P->ws + WS_PROJ);
    const float* GB = (const float*)(P->ws + WS_GB);
    unsigned char* scr = P->ws + WS_SCR + (size_t)item * SCR_ITEM;
    if (tid < 384) {
        const int chunk = tid % 48, tg = tid / 48, part = chunk >> 4, cc = chunk & 15;
        const int col = part * 512 + h * 128 + cc * 8;
        const float* cw = P->in[9] + (size_t)(l * 4) * 1536 + col;
        float w0[8], w1[8], w2[8], w3[8];
#pragma unroll
        for (int e = 0; e < 8; ++e) { w0[e] = cw[e]; w1[e] = cw[1536 + e]; w2[e] = cw[2 * 1536 + e]; w3[e] = cw[3 * 1536 + e]; }
        const int t0 = n * 64 + tg * 8;
        const bf16* base = PROJ + (size_t)(b * SEQL) * NPROJ + col;
        float r0[8], r1[8], r2[8], r3[8];
#pragma unroll
        for (int e = 0; e < 8; ++e) { r0[e] = 0.f; r1[e] = 0.f; r2[e] = 0.f; }
        if (t0 - 3 >= 0) { const v4u w = *(const v4u*)(base + (size_t)(t0 - 3) * NPROJ); UNPACK8(w, r0); }
        if (t0 - 2 >= 0) { const v4u w = *(const v4u*)(base + (size_t)(t0 - 2) * NPROJ); UNPACK8(w, r1); }
        if (t0 - 1 >= 0) { const v4u w = *(const v4u*)(base + (size_t)(t0 - 1) * NPROJ); UNPACK8(w, r2); }
        float* dst = (float*)(lds + part * 33792) + cc * 8;
#pragma unroll
        for (int i = 0; i < 8; ++i) {
            const v4u w = *(const v4u*)(base + (size_t)(t0 + i) * NPROJ); UNPACK8(w, r3);
            float s[8];
#pragma unroll
            for (int e = 0; e < 8; ++e) { const float cv = w0[e] * r0[e] + w1[e] * r1[e] + w2[e] * r2[e] + w3[e] * r3[e]; s[e] = siluf(cv); }
            float* d = dst + (tg * 8 + i) * 132;
            *(f32x4*)d = (f32x4){s[0], s[1], s[2], s[3]}; *(f32x4*)(d + 4) = (f32x4){s[4], s[5], s[6], s[7]};
#pragma unroll
            for (int e = 0; e < 8; ++e) { r0[e] = r1[e]; r1[e] = r2[e]; r2[e] = r3[e]; }
        }
    }
    if (tid < 64) { const int row = b * SEQL + n * 64 + tid; Gs[tid] = GB[(size_t)row * 8 + h]; BETA[tid] = GB[(size_t)row * 8 + 4 + h]; }
    __syncthreads();
    {
        const int tok = tid >> 3, sub = tid & 7;
        float* qr = QF + tok * 132 + sub * 16; float* kr = KF + tok * 132 + sub * 16;
        float qv[16], kv[16]; float sq = 0.f, sk = 0.f;
#pragma unroll
        for (int e = 0; e < 16; ++e) { qv[e] = qr[e]; kv[e] = kr[e]; sq += qv[e] * qv[e]; sk += kv[e] * kv[e]; }
        sq += __shfl_xor(sq, 1); sq += __shfl_xor(sq, 2); sq += __shfl_xor(sq, 4);
        sk += __shfl_xor(sk, 1); sk += __shfl_xor(sk, 2); sk += __shfl_xor(sk, 4);
        const float rq = rsqrtf(sq + EPS) * 0.08838834764831845f, rk = rsqrtf(sk + EPS);
#pragma unroll
        for (int e = 0; e < 16; ++e) { qr[e] = qv[e] * rq; kr[e] = kv[e] * rk; }
    }
    if (tid < 64) {
        float acc = 0.f, mine = 0.f;
#pragma unroll 1
        for (int j = 0; j <= tid; ++j) mine += Gs[j];
#pragma unroll 1
        for (int j = 0; j < 64; ++j) acc += Gs[j];
        GC[tid] = mine; EG[tid] = __expf(mine); EKD[tid] = __expf(acc - mine);
        if (tid == 0) ((float*)(P->ws + WS_GL))[item] = __expf(acc);
    }
    __syncthreads();
    {
        const int p = wv >> 2, mt = wv & 3;
        const float* X = p ? QF : KF;
        f32x4 acc[4];
#pragma unroll
        for (int nt = 0; nt < 4; ++nt) acc[nt] = (f32x4){0.f, 0.f, 0.f, 0.f};
        const float* xa = X + (mt * 16 + fr) * 132 + fq; const float* kb_ = KF + fr * 132 + fq;
#pragma unroll 8
        for (int k = 0; k < 128; k += 4) {
            const float a = xa[k];
#pragma unroll
            for (int nt = 0; nt < 4; ++nt) acc[nt] = __builtin_amdgcn_mfma_f32_16x16x4f32(a, kb_[nt * 16 * 132 + k], acc[nt], 0, 0, 0);
        }
#pragma unroll
        for (int nt = 0; nt < 4; ++nt) {
            const int j = nt * 16 + fr; const float gj = GC[j];
            float v[4];
#pragma unroll
            for (int r = 0; r < 4; ++r) {
                const int i = mt * 16 + 4 * fq + r;
                if (p == 0) v[r] = (i > j) ? BETA[i] * acc[nt][r] * __expf(GC[i] - gj) : 0.f;
                else        v[r] = (i >= j) ? acc[nt][r] * __expf(GC[i] - gj) : 0.f;
            }
            if (p == 0) *(f32x4*)(AT + j * 68 + mt * 16 + 4 * fq) = (f32x4){v[0], v[1], v[2], v[3]};
            else {
#pragma unroll
                for (int r = 0; r < 4; ++r) QKS[(mt * 16 + 4 * fq + r) * 64 + j] = (bf16)f2bf(v[r]);
            }
        }
    }
    __syncthreads();
    if (tid < 256) {
        float x[64];
        int zo = 0; asm volatile("" : "+v"(zo));
        const float* ATz = AT + zo; const float* BETAz = BETA + zo; const float* EGz = EG + zo;
        if (tid < 128) {
#pragma unroll
            for (int i = 0; i < 64; ++i) x[i] = BETAz[i] * VF[i * 132 + tid];
        } else {
#pragma unroll
            for (int i = 0; i < 64; ++i) x[i] = BETAz[i] * EGz[i] * KF[i * 132 + tid - 128];
        }
#pragma unroll
        for (int j = 0; j < 63; ++j) {
            const float xj = x[j];
#pragma unroll
            for (int i4 = ((j + 1) / 4) * 4; i4 < 64; i4 += 4) {
                const f32x4 a = *(const f32x4*)(ATz + j * 68 + i4);
#pragma unroll
                for (int e = 0; e < 4; ++e) if (i4 + e > j) x[i4 + e] -= a[e] * xj;
            }
        }
        if (tid < 128) {
            unsigned char* up = scr + 49152 + tid * 128;
#pragma unroll
            for (int q = 0; q < 8; ++q) *(v4u*)(up + q * 16) = PACK8(x + 8 * q);
        } else {
            const int dk = tid - 128;
#pragma unroll
            for (int i = 0; i < 64; ++i) WST[i * 128 + dk] = (bf16)f2bf(-x[i]);
        }
    } else {
        const int t2 = tid - 256;
        {
            const int tok = t2 >> 2, seg = t2 & 3; const float eg = EG[tok]; const float* s = QF + tok * 132 + seg * 32;
            unsigned char* o = scr + 16384 + tok * 256 + seg * 64;
#pragma unroll
            for (int q = 0; q < 4; ++q) { float f[8];
#pragma unroll
                for (int e = 0; e < 8; ++e) f[e] = s[q * 8 + e] * eg;
                *(v4u*)(o + q * 16) = PACK8(f); }
        }
        {
            const int dk = t2 >> 1, hf = t2 & 1; unsigned char* o = scr + 32768 + dk * 128 + hf * 64;
#pragma unroll
            for (int q = 0; q < 4; ++q) { float f[8];
#pragma unroll
                for (int e = 0; e < 8; ++e) { const int tok = hf * 32 + q * 8 + e; f[e] = KF[tok * 132 + dk] * EKD[tok]; }
                *(v4u*)(o + q * 16) = PACK8(f); }
        }
#pragma unroll
        for (int q = 0; q < 2; ++q) { const int c = t2 + 256 * q; *(v4u*)(scr + 65536 + c * 16) = *(const v4u*)((const unsigned char*)QKS + c * 16); }
    }
    __syncthreads();
#pragma unroll
    for (int q = 0; q < 2; ++q) { const int c = tid + 512 * q; *(v4u*)(scr + c * 16) = *(const v4u*)((const unsigned char*)WST + c * 16); }
    __syncthreads();
}

constexpr int S_ST = 0, S_VNT = 34816, S_OPW = 53248, S_OPQG = 70656, S_OPKD = 88064, S_OPQK = 106496, S_OPU = 115712, S_RED = 134144;
__device__ __forceinline__ void scan_wg(KP P, int l, int bh, unsigned char* lds, int tid) {
    const int b = bh >> 2, h = bh & 3;
    const int lane = tid & 63, w = __builtin_amdgcn_readfirstlane(tid >> 6), fr = lane & 15, fq = lane >> 4;
    const bf16* PROJ = (const bf16*)(P->ws + WS_PROJ);
    bf16* OCAT = (bf16*)(P->ws + WS_XA);
    const float* GL = (const float*)(P->ws + WS_GL);
    float* RED = (float*)(lds + S_RED);
    f32x4 sacc[8];
#pragma unroll
    for (int mt = 0; mt < 8; ++mt) sacc[mt] = (f32x4){0.f, 0.f, 0.f, 0.f};
    for (int q = lane; q < 272; q += 64) *(v4u*)(lds + S_ST + (16 * w) * 272 + q * 16) = (v4u){0u, 0u, 0u, 0u};
    const f32x4 onv = *(const f32x4*)(P->in[12] + l * 128 + 16 * w + 4 * fq);
    v4u pre[9];
    {
        const unsigned char* src = P->ws + WS_SCR + (size_t)((b * 32 + 0) * 4 + h) * SCR_ITEM;
#pragma unroll
        for (int i = 0; i < 9; ++i) pre[i] = *(const v4u*)(src + (size_t)(tid + 512 * i) * 16);
    }
    for (int n = 0; n < 32; ++n) {
        const int item = (b * 32 + n) * 4 + h;
        __syncthreads();
#pragma unroll
        for (int i = 0; i < 9; ++i) {
            const int e = (tid + 512 * i) * 16 - (i >> 1) * 16384;
            if (i < 4) { const int row = e >> 8, cb = e & 255; *(v4u*)(lds + (i < 2 ? S_OPW : S_OPQG) + row * 272 + cb) = pre[i]; }
            else { const int row = e >> 7, cb = e & 127; *(v4u*)(lds + (i < 6 ? S_OPKD : (i < 8 ? S_OPU : S_OPQK)) + row * 144 + cb) = pre[i]; }
        }
        const float egl = GL[item];
        __syncthreads();
        if (n < 31) {
            const unsigned char* src = P->ws + WS_SCR + (size_t)(item + 4) * SCR_ITEM;
#pragma unroll
            for (int i = 0; i < 9; ++i) pre[i] = *(const v4u*)(src + (size_t)(tid + 512 * i) * 16);
        }
        const int rowt = b * SEQL + n * 64 + fr;
        bf16x8 sf[4];
#pragma unroll
        for (int ks = 0; ks < 4; ++ks) sf[ks] = *(const bf16x8*)(lds + S_ST + (16 * w + fr) * 272 + (ks * 32 + 8 * fq) * 2);
        f32x4 vt[4];
#pragma unroll
        for (int tt = 0; tt < 4; ++tt) { const v2u uu = *(const v2u*)(lds + S_OPU + (16 * w + fr) * 144 + (tt * 16 + 4 * fq) * 2);
            vt[tt] = (f32x4){bflo(uu.x), bfhi(uu.x), bflo(uu.y), bfhi(uu.y)}; }
#pragma unroll
        for (int tt = 0; tt < 4; ++tt)
#pragma unroll
            for (int ks = 0; ks < 4; ++ks) { const bf16x8 a = *(const bf16x8*)(lds + S_OPW + (tt * 16 + fr) * 272 + (ks * 32 + 8 * fq) * 2);
                vt[tt] = __builtin_amdgcn_mfma_f32_16x16x32_bf16(a, sf[ks], vt[tt], 0, 0, 0); }
#pragma unroll
        for (int tt = 0; tt < 4; ++tt) *(v2u*)(lds + S_VNT + (16 * w + fr) * 144 + (tt * 16 + 4 * fq) * 2) = (v2u){pk2(vt[tt][0], vt[tt][1]), pk2(vt[tt][2], vt[tt][3])};
        LDS_WAIT();
        bf16x8 vf[2];
#pragma unroll
        for (int js = 0; js < 2; ++js) vf[js] = *(const bf16x8*)(lds + S_VNT + (16 * w + fr) * 144 + (js * 32 + 8 * fq) * 2);
        f32x4 ot[4];
#pragma unroll
        for (int nt = 0; nt < 4; ++nt) {
            ot[nt] = (f32x4){0.f, 0.f, 0.f, 0.f};
#pragma unroll
            for (int ks = 0; ks < 4; ++ks) { const bf16x8 bq = *(const bf16x8*)(lds + S_OPQG + (nt * 16 + fr) * 272 + (ks * 32 + 8 * fq) * 2);
                ot[nt] = __builtin_amdgcn_mfma_f32_16x16x32_bf16(sf[ks], bq, ot[nt], 0, 0, 0); }
#pragma unroll
            for (int js = 0; js < 2; ++js) { const bf16x8 bk = *(const bf16x8*)(lds + S_OPQK + (nt * 16 + fr) * 144 + (js * 32 + 8 * fq) * 2);
                ot[nt] = __builtin_amdgcn_mfma_f32_16x16x32_bf16(vf[js], bk, ot[nt], 0, 0, 0); }
        }
#pragma unroll
        for (int nt = 0; nt < 4; ++nt) {
            float ps = ot[nt][0] * ot[nt][0] + ot[nt][1] * ot[nt][1] + ot[nt][2] * ot[nt][2] + ot[nt][3] * ot[nt][3];
            ps += __shfl_xor(ps, 16); ps += __shfl_xor(ps, 32);
            if (fq == 0) RED[w * 64 + nt * 16 + fr] = ps;
        }
        __syncthreads();
#pragma unroll
        for (int nt = 0; nt < 4; ++nt) {
            float tot = 0.f;
#pragma unroll
            for (int ww = 0; ww < 8; ++ww) tot += RED[ww * 64 + nt * 16 + fr];
            const float rs = rsqrtf(tot * (1.f / 128.f) + EPS);
            const v2u zz = *(const v2u*)(PROJ + (size_t)(rowt + nt * 16) * NPROJ + 1536 + h * 128 + 16 * w + 4 * fq);
            const float z0 = bflo(zz.x), z1 = bfhi(zz.x), z2 = bflo(zz.y), z3 = bfhi(zz.y);
            const float o0 = ot[nt][0] * rs * onv[0] * siluf(z0), o1 = ot[nt][1] * rs * onv[1] * siluf(z1), o2 = ot[nt][2] * rs * onv[2] * siluf(z2), o3 = ot[nt][3] * rs * onv[3] * siluf(z3);
            *(v2u*)(OCAT + (size_t)(rowt + nt * 16) * D + h * 128 + 16 * w + 4 * fq) = (v2u){pk2(o0, o1), pk2(o2, o3)};
        }
#pragma unroll
        for (int mt = 0; mt < 8; ++mt) {
            sacc[mt] = sacc[mt] * egl;
#pragma unroll
            for (int js = 0; js < 2; ++js) { const bf16x8 a = *(const bf16x8*)(lds + S_OPKD + (mt * 16 + fr) * 144 + (js * 32 + 8 * fq) * 2);
                sacc[mt] = __builtin_amdgcn_mfma_f32_16x16x32_bf16(a, vf[js], sacc[mt], 0, 0, 0); }
            *(v2u*)(lds + S_ST + (16 * w + fr) * 272 + (mt * 16 + 4 * fq) * 2) = (v2u){pk2(sacc[mt][0], sacc[mt][1]), pk2(sacc[mt][2], sacc[mt][3])};
        }
        LDS_WAIT();
    }
    float* pd = P->out + O_PDELTA + (size_t)((l * NBATCH + b) * 4 + h) * 16384;
#pragma unroll
    for (int mt = 0; mt < 8; ++mt)
#pragma unroll
        for (int r = 0; r < 4; ++r) pd[(mt * 16 + 4 * fq + r) * 128 + 16 * w + fr] = sacc[mt][r];
    __syncthreads();
}

__device__ __forceinline__ void sample_delta(KP P, int l, int it, unsigned char* lds, int tid_unused) {
    const int tid = fresh_tid();
    const int gq = tid >> 7, c = tid & 127, wv2 = (tid >> 6) & 1, lane = tid & 63;
    const int item = it * 4 + gq, sb = item >> 2, h = item & 3, rowbase = MP + sb * 8;
    float* QS = (float*)(lds + gq * 12288); float* KS = QS + 1024; float* VS = QS + 2048;
    float* RED2 = (float*)(lds + 49152);
    const bf16* PROJ = (const bf16*)(P->ws + WS_PROJ);
    const float* GB = (const float*)(P->ws + WS_GB);
    bf16* OCAT = (bf16*)(P->ws + WS_XA);
#pragma unroll
    for (int part = 0; part < 3; ++part) {
        const int col = part * 512 + h * 128 + c;
        const float* cw = P->in[9] + (size_t)(l * 4) * 1536 + col;
        const float w0 = cw[0], w1 = cw[1536], w2 = cw[2 * 1536], w3 = cw[3 * 1536];
        const float* hs = P->in[3] + (size_t)((l * DBATCH + sb) * 3) * 1536 + col;
        float r0 = hs[0], r1 = hs[1536], r2 = hs[2 * 1536];
        float* dst = QS + part * 1024 + c;
#pragma unroll
        for (int t = 0; t < 8; ++t) {
            const float x = bf1(PROJ[(size_t)(rowbase + t) * NPROJ + col]);
            dst[t * 128] = siluf(w0 * r0 + w1 * r1 + w2 * r2 + w3 * x);
            r0 = r1; r1 = r2; r2 = x;
        }
    }
#pragma unroll
    for (int t = 0; t < 8; ++t) {
        const float q = QS[t * 128 + c], k = KS[t * 128 + c];
        const float sq = wave_sum(q * q), sk = wave_sum(k * k);
        if (lane == 0) { RED2[(gq * 2 + wv2) * 16 + t] = sq; RED2[(gq * 2 + wv2) * 16 + 8 + t] = sk; }
    }
    __syncthreads();
#pragma unroll
    for (int t = 0; t < 8; ++t) {
        const float tq = RED2[(gq * 2) * 16 + t] + RED2[(gq * 2 + 1) * 16 + t], tk = RED2[(gq * 2) * 16 + 8 + t] + RED2[(gq * 2 + 1) * 16 + 8 + t];
        QS[t * 128 + c] *= rsqrtf(tq + EPS) * 0.08838834764831845f; KS[t * 128 + c] *= rsqrtf(tk + EPS);
    }
    __syncthreads();
    float s[128];
    {
        const float* S0 = P->in[2] + (size_t)((l * DBATCH + sb) * 4 + h) * 16384 + c;
#pragma unroll
        for (int d8 = 0; d8 < 16; ++d8) {
#pragma unroll
            for (int e = 0; e < 8; ++e) s[8 * d8 + e] = S0[e * 128];
            S0 += 8 * 128; asm volatile("" : "+v"(S0));
        }
    }
#pragma unroll 1
    for (int t = 0; t < 8; ++t) {
        const float g = GB[(size_t)(rowbase + t) * 8 + h], beta = GB[(size_t)(rowbase + t) * 8 + 4 + h], eg = __expf(g);
        const f32x4* kp = (const f32x4*)(KS + t * 128); const f32x4* qp = (const f32x4*)(QS + t * 128);
        float dot = 0.f;
#pragma unroll
        for (int d4 = 0; d4 < 32; ++d4) { const f32x4 kv = kp[d4]; dot += kv[0] * s[4 * d4] + kv[1] * s[4 * d4 + 1] + kv[2] * s[4 * d4 + 2] + kv[3] * s[4 * d4 + 3];
            if ((d4 & 3) == 3) asm volatile("" ::: "memory"); }
        const float cf = beta * (VS[t * 128 + c] - eg * dot);
        float o = 0.f;
#pragma unroll
        for (int d4 = 0; d4 < 32; ++d4) { const f32x4 kv = kp[d4], qv = qp[d4];
#pragma unroll
            for (int e = 0; e < 4; ++e) { s[4 * d4 + e] = eg * s[4 * d4 + e] + cf * kv[e]; o += qv[e] * s[4 * d4 + e]; }
            if ((d4 & 3) == 3) asm volatile("" ::: "memory"); }
        VS[t * 128 + c] = o;
    }
    {
        float* sd = P->out + O_SDELTA + (size_t)((l * DBATCH + sb) * 4 + h) * 16384 + c;
#pragma unroll
        for (int d8 = 0; d8 < 16; ++d8) {
#pragma unroll
            for (int e = 0; e < 8; ++e) sd[e * 128] = s[8 * d8 + e];
            sd += 8 * 128; asm volatile("" : "+v"(sd));
        }
    }
    __syncthreads();
#pragma unroll
    for (int t = 0; t < 8; ++t) { const float o = VS[t * 128 + c]; const float so = wave_sum(o * o); if (lane == 0) RED2[(gq * 2 + wv2) * 16 + t] = so; }
    __syncthreads();
    const float onv = P->in[12][l * 128 + c];
#pragma unroll
    for (int t = 0; t < 8; ++t) {
        const float tot = RED2[(gq * 2) * 16 + t] + RED2[(gq * 2 + 1) * 16 + t];
        const float z = bf1(PROJ[(size_t)(rowbase + t) * NPROJ + 1536 + h * 128 + c]);
        OCAT[(size_t)(rowbase + t) * D + h * 128 + c] = (bf16)f2bf(VS[t * 128 + c] * rsqrtf(tot * (1.f / 128.f) + EPS) * onv * siluf(z));
    }
    __syncthreads();
}

constexpr int PL_DT = 0, PL_PW = 69632;
__device__ __forceinline__ void pool_tile(KP P, int l, int tile, unsigned char* lds, int tid_unused) {
    const int tid = fresh_tid();
    float* DT = (float*)(lds + PL_DT); const float* PW = (const float*)(lds + PL_PW);
    const bf16* PROJ = (const bf16*)(P->ws + WS_PROJ);
    bf16* OCAT = (bf16*)(P->ws + WS_XA);
#pragma unroll 1
    for (int i = 0; i < 4; ++i) {
        const int idx = tid + 512 * i, tok = idx & 63, ch8 = idx >> 6, c0 = ch8 * 8, gi = ch8 >> 3, win = 2 << gi;
        int row, t, sb = 0; bool smp;
        if (tile < 256) { t = (tile & 31) * 64 + tok; row = (tile >> 5) * SEQL + t; smp = false; }
        else { sb = (tile - 256) * 8 + (tok >> 3); t = tok & 7; row = MP + sb * 8 + t; smp = true; }
        float ssum[8], cur[8];
#pragma unroll
        for (int e = 0; e < 8; ++e) { ssum[e] = 0.f; cur[e] = 0.f; }
        for (int j = 0; j < win; ++j) {
            const int tt = t - j; float f[8];
            if (tt >= 0) { const v4u w = *(const v4u*)(PROJ + (size_t)(row - j) * NPROJ + 2048 + c0); UNPACK8(w, f); }
            else if (smp) { const float* sp = P->in[4] + (size_t)((l * DBATCH + sb) * 15 + 15 + tt) * 256 + c0;
#pragma unroll
                for (int e = 0; e < 8; ++e) f[e] = sp[e]; }
            else {
#pragma unroll
                for (int e = 0; e < 8; ++e) f[e] = 0.f; }
#pragma unroll
            for (int e = 0; e < 8; ++e) { ssum[e] += f[e]; if (j == 0) cur[e] = f[e]; }
        }
        const float inv = 1.f / (float)(smp ? win : (t + 1 < win ? t + 1 : win));
#pragma unroll
        for (int e = 0; e < 8; ++e) DT[(c0 + e) * 68 + tok] = ssum[e] * inv - cur[e];
        float u0[8], u1[8], u2[8];
#pragma unroll
        for (int j = 0; j < 3; ++j) {
            const int tt = t - j; float f[8];
            if (tt >= 0) { const v4u wc = *(const v4u*)(PROJ + (size_t)(row - j) * NPROJ + 2816 + c0); const v4u wx = *(const v4u*)(PROJ + (size_t)(row - j) * NPROJ + 2304 + c0);
                float fc[8], fx[8]; UNPACK8(wc, fc); UNPACK8(wx, fx);
#pragma unroll
                for (int e = 0; e < 8; ++e) f[e] = fc[e] * fx[e]; }
            else if (smp) { const float* sp = P->in[5] + (size_t)((l * DBATCH + sb) * 2 + 2 + tt) * 256 + c0;
#pragma unroll
                for (int e = 0; e < 8; ++e) f[e] = sp[e]; }
            else {
#pragma unroll
                for (int e = 0; e < 8; ++e) f[e] = 0.f; }
#pragma unroll
            for (int e = 0; e < 8; ++e) { if (j == 0) u0[e] = f[e]; else if (j == 1) u1[e] = f[e]; else u2[e] = f[e]; }
        }
        const float* sw = P->in[15] + (size_t)(l * 3) * 256 + c0;
        const v4u wb = *(const v4u*)(PROJ + (size_t)row * NPROJ + 2560 + c0); float fb[8]; UNPACK8(wb, fb);
        float oc[8];
#pragma unroll
        for (int e = 0; e < 8; ++e) oc[e] = fb[e] * (sw[e] * u2[e] + sw[256 + e] * u1[e] + sw[512 + e] * u0[e]);
        *(v4u*)(OCAT + (size_t)row * D + 768 + c0) = PACK8(oc);
    }
    __syncthreads();
    {
        const int ep = tid & 255, g = ep >> 6, e = ep & 63, hf = tid >> 8;
        float acc[32];
#pragma unroll
        for (int q = 0; q < 32; ++q) acc[q] = 0.f;
#pragma unroll 2
        for (int c = 0; c < 64; ++c) {
            const float wgt = PW[(g * 64 + c) * 64 + e];
            const f32x4* dp = (const f32x4*)(DT + (g * 64 + c) * 68 + hf * 32);
#pragma unroll
            for (int q = 0; q < 8; ++q) { const f32x4 d = dp[q]; acc[4 * q] += d[0] * wgt; acc[4 * q + 1] += d[1] * wgt; acc[4 * q + 2] += d[2] * wgt; acc[4 * q + 3] += d[3] * wgt; }
        }
        const float sc = P->in[14][l * 256 + ep];
#pragma unroll
        for (int q = 0; q < 32; ++q) {
            const int tok = hf * 32 + q;
            const int row = tile < 256 ? (tile >> 5) * SEQL + (tile & 31) * 64 + tok : MP + (tile - 256) * 64 + tok;
            OCAT[(size_t)row * D + 512 + ep] = (bf16)f2bf(acc[q] * sc);
        }
    }
    __syncthreads();
}

__device__ __forceinline__ void state_copies(KP P, int l, int start, int stride) {
    const bf16* PROJ = (const bf16*)(P->ws + WS_PROJ);
    for (int i = start; i < 136 * 8960; i += stride) {
        const int seq = i / 8960, r = i % 8960;
        const bool smp = seq >= 8; const int sb = seq - 8;
        const int L = smp ? 8 : SEQL; const size_t row0 = smp ? (size_t)MP + sb * 8 : (size_t)seq * SEQL;
        if (r < 4608) {
            const int j = r / 1536, c = r % 1536;
            const float v = bf1(PROJ[(row0 + L - 3 + j) * NPROJ + c]);
            if (smp) P->out[O_SDCONV + (size_t)((l * DBATCH + sb) * 3 + j) * 1536 + c] = v; else P->out[O_PDCONV + (size_t)((l * NBATCH + seq) * 3 + j) * 1536 + c] = v;
        } else if (r < 4608 + 3840) {
            const int r2 = r - 4608, j = r2 / 256, c = r2 % 256;
            if (smp) { const float v = j < 7 ? P->in[4][(size_t)((l * DBATCH + sb) * 15 + 8 + j) * 256 + c] : bf1(PROJ[(row0 + j - 7) * NPROJ + 2048 + c]);
                P->out[O_SPOOL + (size_t)((l * DBATCH + sb) * 15 + j) * 256 + c] = v; }
            else P->out[O_PPOOL + (size_t)((l * NBATCH + seq) * 15 + j) * 256 + c] = bf1(PROJ[(row0 + L - 15 + j) * NPROJ + 2048 + c]);
        } else {
            const int r2 = r - 8448, j = r2 / 256, c = r2 % 256;
            const size_t row = row0 + L - 2 + j;
            const float v = bf1(PROJ[row * NPROJ + 2816 + c]) * bf1(PROJ[row * NPROJ + 2304 + c]);
            if (smp) P->out[O_SSCONV + (size_t)((l * DBATCH + sb) * 2 + j) * 256 + c] = v; else P->out[O_PSCONV + (size_t)((l * NBATCH + seq) * 2 + j) * 256 + c] = v;
        }
    }
}

__device__ __forceinline__ void p4b(KP P, int l, int hf, int start, int stride) {
    bf16* GU = (bf16*)(P->ws + WS_GU); bf16* HALO = (bf16*)(P->ws + WS_HALO);
    const float* cw = P->in[19] + (size_t)(l * 3) * FF;
    const int r0 = hf * MH;
    for (int idx = start; idx < MH * 352; idx += stride) {
        const int lr = idx / 352, c0 = (idx % 352) * 8, m = r0 + lr;
        int t, sb = 0; bool smp;
        if (m < MP) { t = m & (SEQL - 1); smp = false; } else { sb = (m - MP) >> 3; t = (m - MP) & 7; smp = true; }
        float g0[8], g1[8], g2[8];
#pragma unroll
        for (int j = 0; j < 3; ++j) {
            const int tt = t - j; float f[8];
            if (tt < 0) {
                if (smp) { const float* sp = P->in[6] + (size_t)((l * DBATCH + sb) * 2 + 2 + tt) * FF + c0;
#pragma unroll
                    for (int e = 0; e < 8; ++e) f[e] = sp[e]; }
                else {
#pragma unroll
                    for (int e = 0; e < 8; ++e) f[e] = 0.f; }
            } else {
                const v4u w = (lr - j < 0) ? *(const v4u*)(HALO + (size_t)(2 + lr - j) * FF + c0) : *(const v4u*)(GU + (size_t)(lr - j) * NGU + c0);
                UNPACK8(w, f);
            }
#pragma unroll
            for (int e = 0; e < 8; ++e) { if (j == 0) g0[e] = f[e]; else if (j == 1) g1[e] = f[e]; else g2[e] = f[e]; }
        }
        const v4u wu = *(const v4u*)(GU + (size_t)lr * NGU + FF + c0); float fu[8]; UNPACK8(wu, fu);
        float a[8];
#pragma unroll
        for (int e = 0; e < 8; ++e) a[e] = siluf(cw[c0 + e] * g2[e] + cw[FF + c0 + e] * g1[e] + cw[2 * FF + c0 + e] * g0[e]) * fu[e];
        *(v4u*)(GU + (size_t)lr * NGU + FF + c0) = PACK8(a);
        if (!smp && t >= SEQL - 2) { float* o = P->out + O_PFFN + (size_t)((l * NBATCH + (m >> 11)) * 2 + t - (SEQL - 2)) * FF + c0;
#pragma unroll
            for (int e = 0; e < 8; ++e) o[e] = g0[e]; }
        if (smp && t >= 6) { float* o = P->out + O_SFFN + (size_t)((l * DBATCH + sb) * 2 + t - 6) * FF + c0;
#pragma unroll
            for (int e = 0; e < 8; ++e) o[e] = g0[e]; }
        if (hf == 0 && lr >= MH - 2) *(v4u*)(HALO + (size_t)(lr - (MH - 2)) * FF + c0) = *(const v4u*)(GU + (size_t)lr * NGU + c0);
    }
}

__global__ void __launch_bounds__(NTHREADS, 2) fwd_megakernel(Params Parg) {
    KP P = kparams();
    extern __shared__ __attribute__((aligned(16))) unsigned char lds[];
    cg::grid_group grid = cg::this_grid();
    const int tid = threadIdx.x, lane = tid & 63, wave = __builtin_amdgcn_readfirstlane(tid >> 6);
    const int G = gridDim.x, bx = blockIdx.x;
    const int gw = bx * NWAVES + wave, ngw = G * NWAVES;
    const int gt = bx * NTHREADS + tid, ngt = G * NTHREADS;
    unsigned char* ws = P->ws;
    bf16* XA = (bf16*)(ws + WS_XA); bf16* XB2 = (bf16*)(ws + WS_PROJ); bf16* PROJ = (bf16*)(ws + WS_PROJ); bf16* GU = (bf16*)(ws + WS_GU);
    float* SSQ = (float*)(ws + WS_SSQ); float* GB = (float*)(ws + WS_GB); float* WAB = (float*)(ws + WS_WAB);
    float* XRES = P->out;
    float* wscr = (float*)(lds + wave * 16384);

    for (int i = gt; i < 4 * M; i += ngt) SSQ[M + i] = 0.f;
    for (int i = gt; i < 2 * 8 * D; i += ngt) { const int l = i >> 13, j = (i >> 10) & 7, k = i & 1023; WAB[i] = P->in[7][l * D + k] * P->in[8][(size_t)l * D * DIN + (size_t)k * DIN + 2048 + j]; }
    convert_win(P, 0, wscr, gw, ngw, lane);
    convert_layer_rest(P, 0, wscr, gw, ngw, lane);
    convert_layer_rest(P, 1, wscr, gw, ngw, lane);
    for (int m = gw; m < M; m += ngw) {
        const float* xr = m < MP ? P->in[0] + (size_t)m * D : P->in[1] + (size_t)(m - MP) * D;
        float ss = 0.f;
#pragma unroll
        for (int j = 0; j < 4; ++j) { const f32x4 v = ((const f32x4*)xr)[lane + 64 * j]; ss += v[0] * v[0] + v[1] * v[1] + v[2] * v[2] + v[3] * v[3];
            ((v2u*)(XA + (size_t)m * D))[lane + 64 * j] = (v2u){pk2(v[0], v[1]), pk2(v[2], v[3])}; }
        ss = wave_sum(ss);
        if (lane == 0) SSQ[m] = ss;
    }
    grid.sync();

#pragma unroll 1
    for (int l = 0; l < 2; ++l) {
#ifndef NO_P1
        {
            const bf16* gA = XA; const bf16* gB = (const bf16*)(ws + WS_WIN); LAUNDER(gA); LAUNDER(gB);
            pg8::Gemm g{gA, gB, M, NPROJ, D, D}; pg8::StaticOrder S; S.init(M, NPROJ, G, bx);
            EpiScale E{PROJ, NPROJ, SSQ + (size_t)(2 * l) * M};
            pg8::gemm_phase<EpiScale, pg8::StaticOrder, true, true>((PG8_LAS unsigned char*)lds, g, S, E);
        }
#endif
#ifndef NO_AB
        {
            const float* ssq = SSQ + (size_t)(2 * l) * M;
            const int tf = fresh_tid(), lane = tf & 63, gw = bx * NWAVES + __builtin_amdgcn_readfirstlane(tf >> 6);
            for (int m = gw; m < M; m += ngw) {
                const v4u* xr = (const v4u*)(XA + (size_t)m * D) + lane * 2;
                const v4u x0 = xr[0], x1 = xr[1]; float xf[16]; UNPACK8(x0, xf); UNPACK8(x1, xf + 8);
                float dot[8];
#pragma unroll
                for (int j = 0; j < 8; ++j) { const float* wp = WAB + (size_t)(l * 8 + j) * D + lane * 16; float s = 0.f;
#pragma unroll
                    for (int e = 0; e < 16; ++e) s += wp[e] * xf[e];
                    dot[j] = wave_sum(s); }
                float v = dot[0];
#pragma unroll
                for (int j = 1; j < 8; ++j) v = (lane == j) ? dot[j] : v;
                if (lane < 8) {
                    v *= rsqrtf(ssq[m] * (1.f / D) + EPS);
                    const int hh = lane & 3; float r;
                    if (lane < 4) { const float xx = v + P->in[11][l * 4 + hh]; const float sp = fmaxf(xx, 0.f) + log1pf(expf(-fabsf(xx))); r = -expf(P->in[10][l * 4 + hh]) * sp; }
                    else r = 1.f / (1.f + expf(-v));
                    GB[(size_t)m * 8 + lane] = r;
                }
            }
        }
#endif
        grid.sync();
#ifndef NO_P2B
        { const int tf = fresh_tid(); for (int item = bx; item < 1024; item += G) p2b_item(P, l, item, lds, tf); }
#endif
        grid.sync();
#ifndef NO_SCAN
        if (bx < 32) scan_wg(P, l, bx, lds, fresh_tid());
        else
#endif
        {
            const int vw = bx - 32, nm = G - 32; const int tid = fresh_tid();
#ifndef NO_SAMPLE
            for (int it = nm - 1 - vw; it < 128; it += nm) sample_delta(P, l, it, lds, tid);
#endif
            for (int i = tid; i < 4096; i += NTHREADS) ((f32x4*)(lds + PL_PW))[i] = ((const f32x4*)(P->in[13] + (size_t)l * 16384))[i];
            __syncthreads();
#ifndef NO_POOL
            for (int tile = vw; tile < 272; tile += nm) pool_tile(P, l, tile, lds, tid);
#endif
            state_copies(P, l, vw * NTHREADS + tid, nm * NTHREADS);
        }
        grid.sync();
#ifndef NO_P3
        {
            const bf16* gA = XA; const bf16* gB = (const bf16*)(ws + WS_WOUT) + (size_t)l * D * D; LAUNDER(gA); LAUNDER(gB);
            pg8::Gemm g{gA, gB, M, D, D, D}; pg8::StaticOrder S; S.init(M, D, G, bx);
            EpiResid E{l == 0 ? P->in[0] : XRES, l == 0 ? P->in[1] : XRES + (size_t)MP * D, XRES, XB2, SSQ + (size_t)(2 * l + 1) * M, 0};
            pg8::gemm_phase<EpiResid, pg8::StaticOrder, true, true>((PG8_LAS unsigned char*)lds, g, S, E);
        }
#endif
        grid.sync();
#pragma unroll 1
        for (int hf = 0; hf < 2; ++hf) {
            const int r0 = hf * MH;
#ifndef NO_P4
            {
                const bf16* gA = XB2 + (size_t)r0 * D; const bf16* gB = (const bf16*)(ws + WS_WGU) + (size_t)l * NGU * D; LAUNDER(gA); LAUNDER(gB);
                pg8::Gemm g{gA, gB, MH, NGU, D, D}; pg8::StaticOrder S; S.init(MH, NGU, G, bx);
                EpiScale E{GU, NGU, SSQ + (size_t)(2 * l + 1) * M + r0};
                pg8::gemm_phase<EpiScale, pg8::StaticOrder, true, true>((PG8_LAS unsigned char*)lds, g, S, E);
            }
#endif
            grid.sync();
#ifndef NO_P4B
            p4b(P, l, hf, bx * NTHREADS + fresh_tid(), ngt);
#endif
            if (l == 0 && hf == 0) { const int tf = fresh_tid(); const int wv = __builtin_amdgcn_readfirstlane(tf >> 6); convert_win(P, 1, (float*)(lds + wv * 16384), bx * NWAVES + wv, ngw, tf & 63); }
            grid.sync();
#ifndef NO_P5
            {
                const bf16* gA = GU + FF; const bf16* gB = (const bf16*)(ws + WS_WDN) + (size_t)l * D * FF; LAUNDER(gA); LAUNDER(gB);
                pg8::Gemm g{gA, gB, MH, D, FF, NGU}; pg8::StaticOrder S; S.init(MH, D, G, bx);
                EpiResid E{XRES, XRES + (size_t)MP * D, XRES, XA, SSQ + (size_t)(2 * l + 2) * M, r0};
                pg8::gemm_phase<EpiResid, pg8::StaticOrder, true, true>((PG8_LAS unsigned char*)lds, g, S, E);
            }
#endif
            grid.sync();
        }
    }
    {
        const float* ssq = SSQ + (size_t)4 * M; const float* fn = P->in[22];
        const int gt = bx * NTHREADS + fresh_tid();
        for (int i = gt; i < M * 256; i += ngt) {
            const int row = i >> 8, c4 = i & 255;
            const float rs = rsqrtf(ssq[row] * (1.f / D) + EPS);
            f32x4 v = ((f32x4*)XRES)[i]; const f32x4 gv = ((const f32x4*)fn)[c4];
            v[0] *= rs * gv[0]; v[1] *= rs * gv[1]; v[2] *= rs * gv[2]; v[3] *= rs * gv[3];
            ((f32x4*)XRES)[i] = v;
        }
    }
}

extern "C" void kernel_launch(void* const* d_in, const int* in_sizes, int n_in, void* d_out, int out_size, void* d_ws, size_t ws_size, hipStream_t stream) {
    static int grid = 0;
    if (grid == 0) {
        if (n_in != 23 || (size_t)out_size != O_TOTAL || ws_size < WS_END) { fprintf(stderr, "kernel_launch: unexpected shapes: n_in %d out %d ws %zu\n", n_in, out_size, ws_size); grid = -1; return; }
        int dev = 0, cus = 0, per_cu = 0;
        hipGetDevice(&dev); hipDeviceGetAttribute(&cus, hipDeviceAttributeMultiprocessorCount, dev);
        if (hipFuncSetAttribute((const void*)fwd_megakernel, hipFuncAttributeMaxDynamicSharedMemorySize, LDS_BYTES) != hipSuccess) { fprintf(stderr, "kernel_launch: hipFuncSetAttribute failed\n"); grid = -1; return; }
        hipOccupancyMaxActiveBlocksPerMultiprocessor(&per_cu, (const void*)fwd_megakernel, NTHREADS, LDS_BYTES);
        (void)hipGetLastError();
        if (per_cu < 1) fprintf(stderr, "kernel_launch: occupancy query reports %d blocks per CU\n", per_cu);
        grid = cus;
    }
    if (grid < 0) return;
    Params p{};
    for (int i = 0; i < 23; ++i) p.in[i] = (const float*)d_in[i];
    p.out = (float*)d_out; p.ws = (unsigned char*)d_ws;
    void* args[] = {&p};
    hipError_t e = hipLaunchCooperativeKernel((const void*)fwd_megakernel, dim3(grid), dim3(NTHREADS), args, LDS_BYTES, stream);
    if (e != hipSuccess) fprintf(stderr, "cooperative launch failed: %s (grid %d)\n", hipGetErrorString(e), grid);
}
```

```cpp
#include <hip/hip_runtime.h>
#include <hip/hip_cooperative_groups.h>
#include <cstdio>
#include <cstdint>
namespace cg = cooperative_groups;
__device__ __forceinline__ int fresh_tid() { int t = threadIdx.x; asm volatile("" : "+v"(t)); return t; }
namespace pg8 {
#define PG8_LAS __attribute__((address_space(3)))
typedef unsigned short bf16_t;
typedef short bf16x8 __attribute__((ext_vector_type(8)));
typedef float f32x4 __attribute__((ext_vector_type(4)));
typedef unsigned u32x4 __attribute__((ext_vector_type(4)));
constexpr int BM = 256, BK = 64, HALF = 128, HTB = HALF * BK * 2  , STAGE_BYTES = 8 * HTB, NXCD = 8, WGM = 8;

__host__ __device__ __forceinline__ int lds_byte(int r, int c) { const int st = (r >> 4) * 2 + (c >> 5), rr = r & 15, cc = c & 31, ob = rr * 64 + cc * 2; return st * 1024 + (ob ^ (((ob >> 9) & 1) << 5)); }
__host__ __device__ __forceinline__ void stage_rc(int b, int& R, int& C) { const int st = b / 1024, sb = b % 1024, swz = sb ^ (((sb >> 9) & 1) << 5); R = (st >> 1) * 16 + swz / 64; C = (st & 1) * 32 + (swz % 64) / 2; }
__host__ __device__ __forceinline__ int perm32(int rho) { const int n = rho >> 4, i = rho & 15; return 8 * (i >> 2) + 4 * n + (i & 3); }

struct Unit { int pm, pn; };
struct Gemm { const bf16_t* A; const bf16_t* Bt; int M, N, K, lda; };

struct StaticOrder {
    int nM, nN, nwg, G, c;
    __host__ __device__ void init(int M, int N, int G_, int c_) { nM = M / BM; nN = N / BM; nwg = nM * nN; G = G_; c = c_; }
    __host__ __device__ bool next(int i, Unit& u) const {
        const long L = (long)i * G + c; if (L >= nwg) return false;
        int wgid = (int)L; { const int q = nwg / NXCD, r = nwg % NXCD, xcd = wgid % NXCD, off = wgid / NXCD; wgid = (xcd < r ? xcd * (q + 1) : r * (q + 1) + (xcd - r) * q) + off; }
        const int nig = WGM * nN, gid = wgid / nig, fm = gid * WGM, gsz = (nM - fm) < WGM ? (nM - fm) : WGM;
        u.pm = fm + ((wgid % nig) % gsz); u.pn = (wgid % nig) / gsz; return true;
    }
    __device__ __forceinline__ void a_ready(const Unit&) const {}
    __device__ __forceinline__ void done(const Unit&) const {}
};

template <class Epi, class Sched, bool ALIGN_EPI = false, bool SP2 = false>
__device__ __forceinline__ void gemm_phase(PG8_LAS unsigned char* lds, const Gemm g, const Sched& S, const Epi& E) {
    const int tid = fresh_tid(), wid = __builtin_amdgcn_readfirstlane(tid >> 6), lane = tid & 63, wr = wid >> 2, wc = wid & 3, fr = lane & 15, fq = lane >> 4;
    const int K = g.K, nt = K / BK;
    unsigned voffA[2], voffB[2];
#pragma unroll
    for (int i = 0; i < 2; ++i) { int R, C; stage_rc(tid * 16 + i * 8192, R, C); const int Rb = Epi::PERM ? ((R & ~31) + perm32(R & 31)) : R;
        voffA[i] = (unsigned)(R * g.lda + C) * 2u; voffB[i] = (unsigned)(Rb * K + C) * 2u; }
    const size_t kstep = (size_t)(BK * 2);
    const size_t hstepA = (size_t)HALF * g.lda * 2, hstepB = (size_t)HALF * K * 2;
    const size_t tstepA = 2 * hstepA, tstepB = 2 * hstepB;
    const unsigned ldsw = (unsigned)wid * 1024u;
    const int aoff = lds_byte(wr * 64 + fr, fq * 8), boff = lds_byte(wc * 32 + fr, fq * 8);
#define PG8_SA(b, h) (((b) * 2 + (h)) * HTB)
#define PG8_SB(b, h) ((4 + (b) * 2 + (h)) * HTB)
#define PG8_STAGE(bufoff, gbase, voff) do { _Pragma("unroll") for (int _i = 0; _i < 2; ++_i) \
        __builtin_amdgcn_global_load_lds((const unsigned*)((const char*)(gbase) + (voff)[_i]), (PG8_LAS unsigned*)(lds + (bufoff) + ldsw + _i * 8192), 16, 0, 0); } while (0)
#define PG8_LDA(dst, b, h) do { _Pragma("unroll") for (int m = 0; m < 4; ++m) _Pragma("unroll") for (int k = 0; k < 2; ++k) dst[m][k] = *(const PG8_LAS bf16x8*)(lds + PG8_SA(b, h) + aoff + m * 2048 + k * 1024); } while (0)
#define PG8_LDB(dst, b, h) do { _Pragma("unroll") for (int n = 0; n < 2; ++n) _Pragma("unroll") for (int k = 0; k < 2; ++k) dst[n][k] = *(const PG8_LAS bf16x8*)(lds + PG8_SB(b, h) + boff + n * 2048 + k * 1024); } while (0)
#define PG8_MMA(ai, bj, At, Bt) do { __builtin_amdgcn_s_setprio(1); _Pragma("unroll") for (int m = 0; m < 4; ++m) _Pragma("unroll") for (int n = 0; n < 2; ++n) _Pragma("unroll") for (int k = 0; k < 2; ++k) \
        acc[ai][bj][m][n] = __builtin_amdgcn_mfma_f32_16x16x32_bf16(Bt[n][k], At[m][k], acc[ai][bj][m][n], 0, 0, 0); __builtin_amdgcn_s_setprio(0); } while (0)
#define PG8_WAIT_V(n) asm volatile("s_waitcnt vmcnt(" #n ")" ::: "memory")
#define PG8_WAIT_L(n) asm volatile("s_waitcnt lgkmcnt(" #n ")" ::: "memory")
#define PG8_BAR __builtin_amdgcn_s_barrier()
#define PG8_SCHED __builtin_amdgcn_sched_barrier(0)
    Unit cur, nxt; int ui = 0;
    if (!S.next(0, cur)) return;
    f32x4 acc[2][2][4][2];
#pragma unroll
    for (int a = 0; a < 2; ++a)
#pragma unroll
        for (int b = 0; b < 2; ++b)
#pragma unroll
            for (int m = 0; m < 4; ++m)
#pragma unroll
                for (int n = 0; n < 2; ++n) acc[a][b][m][n] = (f32x4){0.f, 0.f, 0.f, 0.f};
    bf16x8 At[4][2], B0[2][2], B1[2][2];
    const char* cA = (const char*)g.A + (size_t)cur.pm * tstepA; const char* cB = (const char*)g.Bt + (size_t)cur.pn * tstepB;
    S.a_ready(cur);
    if constexpr (SP2) {
        PG8_STAGE(PG8_SB(0, 0), cB, voffB); PG8_STAGE(PG8_SB(0, 1), cB + hstepB, voffB); PG8_STAGE(PG8_SA(0, 0), cA, voffA); PG8_STAGE(PG8_SA(0, 1), cA + hstepA, voffA);
        if (wr == 1) PG8_BAR;
        PG8_WAIT_V(2); PG8_BAR;
        PG8_STAGE(PG8_SB(1, 0), cB + kstep, voffB); PG8_STAGE(PG8_SA(1, 0), cA + kstep, voffA); PG8_STAGE(PG8_SB(1, 1), cB + hstepB + kstep, voffB);
        PG8_WAIT_V(6); PG8_BAR;
    } else {
        PG8_STAGE(PG8_SB(0, 0), cB, voffB); PG8_STAGE(PG8_SA(0, 0), cA, voffA); PG8_STAGE(PG8_SB(0, 1), cB + hstepB, voffB); PG8_STAGE(PG8_SA(0, 1), cA + hstepA, voffA);
        if (wr == 1) PG8_BAR;
        PG8_WAIT_V(4); PG8_BAR;
        PG8_STAGE(PG8_SB(1, 0), cB + kstep, voffB); PG8_STAGE(PG8_SA(1, 0), cA + kstep, voffA); PG8_STAGE(PG8_SB(1, 1), cB + hstepB + kstep, voffB);
        PG8_WAIT_V(6); PG8_BAR;
    }
    for (;;) {
        const bool has_next = S.next(ui + 1, nxt);
        const char* nA = has_next ? (const char*)g.A + (size_t)nxt.pm * tstepA : cA; const char* nB = has_next ? (const char*)g.Bt + (size_t)nxt.pn * tstepB : cB;
        for (int t = 0; t < nt; t += 2) {
            const bool last = (t == nt - 2);
            const char* a1 = cA + (size_t)(t + 1) * kstep;
            const char* a2 = last ? nA : cA + (size_t)(t + 2) * kstep; const char* b2 = last ? nB : cB + (size_t)(t + 2) * kstep;
            const char* a3 = a2 + kstep; const char* b3 = b2 + kstep;
            if (last && has_next) S.a_ready(nxt);
            if constexpr (SP2) {
            PG8_LDB(B0, 0, 0); PG8_LDB(B1, 0, 1); PG8_SCHED; PG8_LDA(At, 0, 0); PG8_STAGE(PG8_SA(1, 1), a1 + hstepA, voffA);
            PG8_WAIT_V(8); PG8_WAIT_L(0); PG8_BAR; PG8_MMA(0, 0, At, B0); PG8_MMA(0, 1, At, B1); PG8_BAR; PG8_SCHED;
            PG8_LDA(At, 0, 1); PG8_STAGE(PG8_SB(0, 0), b2, voffB); PG8_STAGE(PG8_SB(0, 1), b2 + hstepB, voffB); PG8_STAGE(PG8_SA(0, 0), a2, voffA);
            PG8_WAIT_V(8); PG8_WAIT_L(0); PG8_BAR; PG8_MMA(1, 0, At, B0); PG8_MMA(1, 1, At, B1); PG8_BAR; PG8_SCHED;
            PG8_LDB(B0, 1, 0); PG8_LDB(B1, 1, 1); PG8_SCHED; PG8_LDA(At, 1, 0); PG8_STAGE(PG8_SA(0, 1), a2 + hstepA, voffA);
            PG8_WAIT_V(8); PG8_WAIT_L(0); PG8_BAR; PG8_MMA(0, 0, At, B0); PG8_MMA(0, 1, At, B1); PG8_BAR; PG8_SCHED;
            PG8_LDA(At, 1, 1); PG8_STAGE(PG8_SB(1, 0), b3, voffB); PG8_STAGE(PG8_SB(1, 1), b3 + hstepB, voffB); PG8_STAGE(PG8_SA(1, 0), a3, voffA);
            PG8_WAIT_V(8); PG8_WAIT_L(0); PG8_BAR; PG8_MMA(1, 0, At, B0); PG8_MMA(1, 1, At, B1); PG8_BAR; PG8_SCHED;
            } else {
            PG8_LDB(B0, 0, 0); PG8_SCHED; PG8_LDA(At, 0, 0); PG8_STAGE(PG8_SA(1, 1), a1 + hstepA, voffA);
            PG8_WAIT_L(8); PG8_BAR; PG8_WAIT_L(0); PG8_MMA(0, 0, At, B0); PG8_BAR; PG8_SCHED;
            PG8_LDB(B1, 0, 1); PG8_STAGE(PG8_SB(0, 0), b2, voffB);
            PG8_BAR; PG8_WAIT_L(0); PG8_MMA(0, 1, At, B1); PG8_BAR;
            PG8_LDA(At, 0, 1); PG8_STAGE(PG8_SA(0, 0), a2, voffA);
            PG8_BAR; PG8_WAIT_L(0); PG8_MMA(1, 0, At, B0); PG8_BAR; PG8_SCHED;
            PG8_STAGE(PG8_SB(0, 1), b2 + hstepB, voffB);
            PG8_WAIT_V(6); PG8_BAR; PG8_MMA(1, 1, At, B1); PG8_BAR;
            PG8_LDB(B0, 1, 0); PG8_SCHED; PG8_LDA(At, 1, 0); PG8_STAGE(PG8_SA(0, 1), a2 + hstepA, voffA);
            PG8_WAIT_L(8); PG8_BAR; PG8_WAIT_L(0); PG8_MMA(0, 0, At, B0); PG8_BAR; PG8_SCHED;
            PG8_LDB(B1, 1, 1); PG8_STAGE(PG8_SB(1, 0), b3, voffB);
            PG8_BAR; PG8_WAIT_L(0); PG8_MMA(0, 1, At, B1); PG8_BAR;
            PG8_LDA(At, 1, 1); PG8_STAGE(PG8_SA(1, 0), a3, voffA);
            PG8_BAR; PG8_WAIT_L(0); PG8_MMA(1, 0, At, B0); PG8_BAR; PG8_SCHED;
            PG8_STAGE(PG8_SB(1, 1), b3 + hstepB, voffB);
            PG8_WAIT_V(6); PG8_BAR; PG8_MMA(1, 1, At, B1); PG8_BAR;
            }
        }
        if constexpr (ALIGN_EPI) { if (wr == 0) PG8_BAR; }
        if constexpr (!Epi::AFTER_DRAIN) { E(acc, cur, wr, wc, fr, fq); S.done(cur); }
        if (!has_next) break;
#pragma unroll
        for (int a = 0; a < 2; ++a)
#pragma unroll
            for (int b = 0; b < 2; ++b)
#pragma unroll
                for (int m = 0; m < 4; ++m)
#pragma unroll
                    for (int n = 0; n < 2; ++n) acc[a][b][m][n] = (f32x4){0.f, 0.f, 0.f, 0.f};
        cur = nxt; cA = nA; cB = nB; ++ui;
        if constexpr (ALIGN_EPI) { if (wr == 1) PG8_BAR; }
    }
    PG8_WAIT_V(0);
    if constexpr (!ALIGN_EPI) { if (wr == 0) PG8_BAR; }
    PG8_BAR;
    if constexpr (Epi::AFTER_DRAIN) { E.fused(acc, cur, wr, wc, fr, fq, lds, wid, lane); S.done(cur); }
#undef PG8_SA
#undef PG8_SB
#undef PG8_STAGE
#undef PG8_LDA
#undef PG8_LDB
#undef PG8_MMA
#undef PG8_WAIT_V
#undef PG8_WAIT_L
#undef PG8_BAR
#undef PG8_SCHED
}
}

typedef unsigned short bf16;
typedef unsigned v4u __attribute__((ext_vector_type(4)));
typedef unsigned v2u __attribute__((ext_vector_type(2)));
typedef float f32x4 __attribute__((ext_vector_type(4)));
typedef short bf16x8 __attribute__((ext_vector_type(8)));

constexpr int D = 1024, MP = 16384, MS = 1024, M = MP + MS, SEQL = 2048, NBATCH = 8, DBATCH = 128;
constexpr int NPROJ = 3072, FF = 2816, NGU = 5632, DIN = 3080, MH = M / 2;
constexpr float EPS = 1e-6f;
constexpr int NTHREADS = 512, NWAVES = 8;
constexpr int LDS_BYTES = 155648;
constexpr size_t MiB = 1u << 20;
constexpr size_t WS_WOUT = 0, WS_WGU = 4 * MiB, WS_WDN = 26 * MiB, WS_XA = 37 * MiB, WS_PROJ = 71 * MiB, WS_GU = 105 * MiB, WS_SCR = 173 * MiB, WS_WIN = 239 * MiB;
constexpr size_t WS_GB = 245 * MiB, WS_SSQ = 245 * MiB + 576 * 1024, WS_WAB = 246 * MiB, WS_GL = 246 * MiB + 64 * 1024, WS_HALO = 246 * MiB + 128 * 1024, WS_BAR = 246 * MiB + 192 * 1024, WS_END = 247 * MiB;
constexpr int SCR_ITEM = 73728;
constexpr size_t O_PDELTA = 17825792, O_PDCONV = 18874368, O_PPOOL = 18948096, O_PSCONV = 19009536, O_PFFN = 19017728;
constexpr size_t O_SDELTA = 19107840, O_SDCONV = 35885056, O_SPOOL = 37064704, O_SSCONV = 38047744, O_SFFN = 38178816, O_TOTAL = 39620608;

struct Params { const float* in[23]; float* out; unsigned char* ws; };
typedef const __attribute__((address_space(4))) Params* KP;
__device__ __forceinline__ KP kparams() { KP p = (KP)__builtin_amdgcn_kernarg_segment_ptr(); asm volatile("" : "+s"(p)); return p; }

#define LAUNDER(p) asm volatile("" : "+s"(p))
#define LDS_WAIT() asm volatile("s_waitcnt lgkmcnt(0)" ::: "memory")
__device__ __forceinline__ unsigned f2bf(float f) { unsigned u = __builtin_bit_cast(unsigned, f); return (u + 0x7fffu + ((u >> 16) & 1u)) >> 16; }
__device__ __forceinline__ unsigned pk2(float lo, float hi) { return f2bf(lo) | (f2bf(hi) << 16); }
__device__ __forceinline__ float bflo(unsigned u) { return __builtin_bit_cast(float, u << 16); }
__device__ __forceinline__ float bfhi(unsigned u) { return __builtin_bit_cast(float, u & 0xffff0000u); }
__device__ __forceinline__ float bf1(bf16 h) { return __builtin_bit_cast(float, ((unsigned)h) << 16); }
__device__ __forceinline__ float siluf(float x) { return x / (1.f + __expf(-x)); }
__device__ __forceinline__ float wave_sum(float v) {
#pragma unroll
    for (int o = 1; o < 64; o <<= 1) v += __shfl_xor(v, o);
    return v;
}
#define UNPACK8(W_, F_) do { (F_)[0] = bflo((W_).x); (F_)[1] = bfhi((W_).x); (F_)[2] = bflo((W_).y); (F_)[3] = bfhi((W_).y); (F_)[4] = bflo((W_).z); (F_)[5] = bfhi((W_).z); (F_)[6] = bflo((W_).w); (F_)[7] = bfhi((W_).w); } while (0)
#define PACK8(F_) ((v4u){pk2((F_)[0], (F_)[1]), pk2((F_)[2], (F_)[3]), pk2((F_)[4], (F_)[5]), pk2((F_)[6], (F_)[7])})

struct EpiScale {
    static constexpr bool PERM = true, AFTER_DRAIN = false;
    bf16* O; int ldc; const float* ssq;
    __device__ __forceinline__ void operator()(const pg8::f32x4 (&acc)[2][2][4][2], const pg8::Unit& u, int wr, int wc, int fr, int fq) const {
        const int row0 = u.pm * 256 + wr * 64 + fr, col0 = u.pn * 256 + wc * 32 + 8 * fq;
#pragma unroll
        for (int ai = 0; ai < 2; ++ai)
#pragma unroll
            for (int m = 0; m < 4; ++m) {
                const int row = row0 + ai * 128 + m * 16;
                const float rs = rsqrtf(ssq[row] * (1.f / D) + EPS);
                bf16* rowp = O + (size_t)row * ldc + col0;
#pragma unroll
                for (int bj = 0; bj < 2; ++bj) {
                    pg8::f32x4 v0 = acc[ai][bj][m][0] * rs, v1 = acc[ai][bj][m][1] * rs;
                    v4u w; w.x = pk2(v0[0], v0[1]); w.y = pk2(v0[2], v0[3]); w.z = pk2(v1[0], v1[1]); w.w = pk2(v1[2], v1[3]);
                    *(v4u*)(rowp + bj * 128) = w;
                }
            }
    }
};
struct EpiResid {
    static constexpr bool PERM = true, AFTER_DRAIN = false;
    const float* xa; const float* xb_; float* xres; bf16* xb16; float* ssq; int rowbase;
    __device__ __forceinline__ void operator()(const pg8::f32x4 (&acc)[2][2][4][2], const pg8::Unit& u, int wr, int wc, int fr, int fq) const {
        const int row0 = rowbase + u.pm * 256 + wr * 64 + fr, col0 = u.pn * 256 + wc * 32 + 8 * fq;
#pragma unroll
        for (int ai = 0; ai < 2; ++ai)
#pragma unroll
            for (int m = 0; m < 4; ++m) {
                const int row = row0 + ai * 128 + m * 16;
                const float* xo = (row < MP ? xa + (size_t)row * D : xb_ + (size_t)(row - MP) * D) + col0;
                float* xr = xres + (size_t)row * D + col0;
                bf16* xh = xb16 + (size_t)row * D + col0;
                float ss = 0.f;
#pragma unroll
                for (int bj = 0; bj < 2; ++bj) {
                    const pg8::f32x4 o0 = *(const pg8::f32x4*)(xo + bj * 128), o1 = *(const pg8::f32x4*)(xo + bj * 128 + 4);
                    pg8::f32x4 v0 = acc[ai][bj][m][0] + o0, v1 = acc[ai][bj][m][1] + o1;
                    *(pg8::f32x4*)(xr + bj * 128) = v0; *(pg8::f32x4*)(xr + bj * 128 + 4) = v1;
                    v4u w; w.x = pk2(v0[0], v0[1]); w.y = pk2(v0[2], v0[3]); w.z = pk2(v1[0], v1[1]); w.w = pk2(v1[2], v1[3]);
                    *(v4u*)(xh + bj * 128) = w;
                    ss += v0[0] * v0[0] + v0[1] * v0[1] + v0[2] * v0[2] + v0[3] * v0[3] + v1[0] * v1[0] + v1[1] * v1[1] + v1[2] * v1[2] + v1[3] * v1[3];
                }
                ss += __shfl_xor(ss, 16); ss += __shfl_xor(ss, 32);
                if (fq == 0) atomicAdd(ssq + row, ss);
            }
    }
};

__device__ __forceinline__ void transpose_item(const float* W, int K, int ldw, int src_col0, const float* g, bf16* WT, int dst_row0, float* scr, int kb, int lane) {
    const int k0 = 64 * kb;
#pragma unroll 8
    for (int i = 0; i < 32; ++i) { const int kk = 2 * i + (lane >> 5); const float gs = g ? g[k0 + kk] : 1.f;
        scr[kk * 33 + (lane & 31)] = W[(size_t)(k0 + kk) * ldw + src_col0 + (lane & 31)] * gs; }
    LDS_WAIT();
    const int c = lane & 7;
#pragma unroll
    for (int j = 0; j < 4; ++j) { const int n = (lane >> 3) + 8 * j; const float* s = scr + (8 * c) * 33 + n;
        v4u o; o.x = pk2(s[0 * 33], s[1 * 33]); o.y = pk2(s[2 * 33], s[3 * 33]); o.z = pk2(s[4 * 33], s[5 * 33]); o.w = pk2(s[6 * 33], s[7 * 33]);
        *(v4u*)(WT + (size_t)(dst_row0 + n) * K + k0 + 8 * c) = o; }
    LDS_WAIT();
}
__device__ __forceinline__ void convert_matrix(const float* W, int K, int N, int ldw, int skip_from, int skip, const float* g, bf16* WT, int dst_row0, float* scr, int gw, int ngw, int lane) {
    const int nnb = N / 32, nit = (K / 64) * nnb;
    for (int it = gw; it < nit; it += ngw) {
        const int kb = it / nnb, nb = it % nnb, n0 = nb * 32;
        transpose_item(W, K, ldw, n0 + (n0 >= skip_from ? skip : 0), g, WT, dst_row0 + n0, scr, kb, lane);
    }
}
__device__ __forceinline__ void convert_layer_rest(KP P, int l, float* scr, int gw, int ngw, int lane) {
    unsigned char* ws = P->ws;
    convert_matrix(P->in[16] + (size_t)l * D * D, D, D, D, 1 << 30, 0, nullptr, (bf16*)(ws + WS_WOUT) + (size_t)l * D * D, 0, scr, gw, ngw, lane);
    convert_matrix(P->in[18] + (size_t)l * D * FF, D, FF, FF, 1 << 30, 0, P->in[17] + l * D, (bf16*)(ws + WS_WGU) + (size_t)l * NGU * D, 0, scr, gw, ngw, lane);
    convert_matrix(P->in[20] + (size_t)l * D * FF, D, FF, FF, 1 << 30, 0, P->in[17] + l * D, (bf16*)(ws + WS_WGU) + (size_t)l * NGU * D, FF, scr, gw, ngw, lane);
    convert_matrix(P->in[21] + (size_t)l * FF * D, FF, D, D, 1 << 30, 0, nullptr, (bf16*)(ws + WS_WDN) + (size_t)l * D * FF, 0, scr, gw, ngw, lane);
}
__device__ __forceinline__ void convert_win(KP P, int l, float* scr, int gw, int ngw, int lane) {
    convert_matrix(P->in[8] + (size_t)l * D * DIN, D, NPROJ, DIN, 2048, 8, P->in[7] + l * D, (bf16*)(P->ws + WS_WIN), 0, scr, gw, ngw, lane);
}

constexpr int B_QF = 0, B_KF = 33792, B_VF = 67584, B_AT = 101376, B_GC = 118784, B_QKS = 120320, B_WST = 128512;
__device__ __forceinline__ void p2b_item(KP P, int l, int item, unsigned char* lds, int tid_unused) {
    const int tid = fresh_tid();
    const int h = item & 3, n = (item >> 2) & 31, b = item >> 7;
    const int lane = tid & 63, wv = __builtin_amdgcn_readfirstlane(tid >> 6), fr = lane & 15, fq = lane >> 4;
    float* QF = (float*)(lds + B_QF); float* KF = (float*)(lds + B_KF); float* VF = (float*)(lds + B_VF); float* AT = (float*)(lds + B_AT);
    float* Gs = (float*)(lds + B_GC); float* BETA = Gs + 64; float* GC = Gs + 128; float* EG = Gs + 192; float* EKD = Gs + 256;
    bf16* QKS = (bf16*)(lds + B_QKS); bf16* WST = (bf16*)(lds + B_WST);
    const bf16* PROJ = (const bf16*)(P->ws + WS_PROJ);
    const float* GB = (const float*)(P->ws + WS_GB);
    unsigned char* scr = P->ws + WS_SCR + (size_t)item * SCR_ITEM;
    if (tid < 384) {
        const int chunk = tid % 48, tg = tid / 48, part = chunk >> 4, cc = chunk & 15;
        const int col = part * 512 + h * 128 + cc * 8;
        const float* cw = P->in[9] + (size_t)(l * 4) * 1536 + col;
        float w0[8], w1[8], w2[8], w3[8];
#pragma unroll
        for (int e = 0; e < 8; ++e) { w0[e] = cw[e]; w1[e] = cw[1536 + e]; w2[e] = cw[2 * 1536 + e]; w3[e] = cw[3 * 1536 + e]; }
        const int t0 = n * 64 + tg * 8;
        const bf16* base = PROJ + (size_t)(b * SEQL) * NPROJ + col;
        float r0[8], r1[8], r2[8], r3[8];
#pragma unroll
        for (int e = 0; e < 8; ++e) { r0[e] = 0.f; r1[e] = 0.f; r2[e] = 0.f; }
        if (t0 - 3 >= 0) { const v4u w = *(const v4u*)(base + (size_t)(t0 - 3) * NPROJ); UNPACK8(w, r0); }
        if (t0 - 2 >= 0) { const v4u w = *(const v4u*)(base + (size_t)(t0 - 2) * NPROJ); UNPACK8(w, r1); }
        if (t0 - 1 >= 0) { const v4u w = *(const v4u*)(base + (size_t)(t0 - 1) * NPROJ); UNPACK8(w, r2); }
        float* dst = (float*)(lds + part * 33792) + cc * 8;
#pragma unroll
        for (int i = 0; i < 8; ++i) {
            const v4u w = *(const v4u*)(base + (size_t)(t0 + i) * NPROJ); UNPACK8(w, r3);
            float s[8];
#pragma unroll
            for (int e = 0; e < 8; ++e) { const float cv = w0[e] * r0[e] + w1[e] * r1[e] + w2[e] * r2[e] + w3[e] * r3[e]; s[e] = siluf(cv); }
            float* d = dst + (tg * 8 + i) * 132;
            *(f32x4*)d = (f32x4){s[0], s[1], s[2], s[3]}; *(f32x4*)(d + 4) = (f32x4){s[4], s[5], s[6], s[7]};
#pragma unroll
            for (int e = 0; e < 8; ++e) { r0[e] = r1[e]; r1[e] = r2[e]; r2[e] = r3[e]; }
        }
    }
    if (tid < 64) { const int row = b * SEQL + n * 64 + tid; Gs[tid] = GB[(size_t)row * 8 + h]; BETA[tid] = GB[(size_t)row * 8 + 4 + h]; }
    __syncthreads();
    {
        const int tok = tid >> 3, sub = tid & 7;
        float* qr = QF + tok * 132 + sub * 16; float* kr = KF + tok * 132 + sub * 16;
        float qv[16], kv[16]; float sq = 0.f, sk = 0.f;
#pragma unroll
        for (int e = 0; e < 16; ++e) { qv[e] = qr[e]; kv[e] = kr[e]; sq += qv[e] * qv[e]; sk += kv[e] * kv[e]; }
        sq += __shfl_xor(sq, 1); sq += __shfl_xor(sq, 2); sq += __shfl_xor(sq, 4);
        sk += __shfl_xor(sk, 1); sk += __shfl_xor(sk, 2); sk += __shfl_xor(sk, 4);
        const float rq = rsqrtf(sq + EPS) * 0.08838834764831845f, rk = rsqrtf(sk + EPS);
#pragma unroll
        for (int e = 0; e < 16; ++e) { qr[e] = qv[e] * rq; kr[e] = kv[e] * rk; }
    }
    if (tid < 64) {
        float acc = 0.f, mine = 0.f;
#pragma unroll 1
        for (int j = 0; j <= tid; ++j) mine += Gs[j];
#pragma unroll 1
        for (int j = 0; j < 64; ++j) acc += Gs[j];
        GC[tid] = mine; EG[tid] = __expf(mine); EKD[tid] = __expf(acc - mine);
        if (tid == 0) ((float*)(P->ws + WS_GL))[item] = __expf(acc);
    }
    __syncthreads();
    {
        const int p = wv >> 2, mt = wv & 3;
        const float* X = p ? QF : KF;
        f32x4 acc[4];
#pragma unroll
        for (int nt = 0; nt < 4; ++nt) acc[nt] = (f32x4){0.f, 0.f, 0.f, 0.f};
        const float* xa = X + (mt * 16 + fr) * 132 + fq; const float* kb_ = KF + fr * 132 + fq;
#pragma unroll 8
        for (int k = 0; k < 128; k += 4) {
            const float a = xa[k];
#pragma unroll
            for (int nt = 0; nt < 4; ++nt) acc[nt] = __builtin_amdgcn_mfma_f32_16x16x4f32(a, kb_[nt * 16 * 132 + k], acc[nt], 0, 0, 0);
        }
#pragma unroll
        for (int nt = 0; nt < 4; ++nt) {
            const int j = nt * 16 + fr; const float gj = GC[j];
            float v[4];
#pragma unroll
            for (int r = 0; r < 4; ++r) {
                const int i = mt * 16 + 4 * fq + r;
                if (p == 0) v[r] = (i > j) ? BETA[i] * acc[nt][r] * __expf(GC[i] - gj) : 0.f;
                else        v[r] = (i >= j) ? acc[nt][r] * __expf(GC[i] - gj) : 0.f;
            }
            if (p == 0) *(f32x4*)(AT + j * 68 + mt * 16 + 4 * fq) = (f32x4){v[0], v[1], v[2], v[3]};
            else {
#pragma unroll
                for (int r = 0; r < 4; ++r) QKS[(mt * 16 + 4 * fq + r) * 64 + j] = (bf16)f2bf(v[r]);
            }
        }
    }
    __syncthreads();
    if (tid < 256) {
        float x[64];
        int zo = 0; asm volatile("" : "+v"(zo));
        const float* ATz = AT + zo; const float* BETAz = BETA + zo; const float* EGz = EG + zo;
        if (tid < 128) {
#pragma unroll
            for (int i = 0; i < 64; ++i) x[i] = BETAz[i] * VF[i * 132 + tid];
        } else {
#pragma unroll
            for (int i = 0; i < 64; ++i) x[i] = BETAz[i] * EGz[i] * KF[i * 132 + tid - 128];
        }
#pragma unroll
        for (int j = 0; j < 63; ++j) {
            const float xj = x[j];
#pragma unroll
            for (int i4 = ((j + 1) / 4) * 4; i4 < 64; i4 += 4) {
                const f32x4 a = *(const f32x4*)(ATz + j * 68 + i4);
#pragma unroll
                for (int e = 0; e < 4; ++e) if (i4 + e > j) x[i4 + e] -= a[e] * xj;
            }
        }
        if (tid < 128) {
            unsigned char* up = scr + 49152 + tid * 128;
#pragma unroll
            for (int q = 0; q < 8; ++q) *(v4u*)(up + q * 16) = PACK8(x + 8 * q);
        } else {
            const int dk = tid - 128;
#pragma unroll
            for (int i = 0; i < 64; ++i) WST[i * 128 + dk] = (bf16)f2bf(-x[i]);
        }
    } else {
        const int t2 = tid - 256;
        {
            const int tok = t2 >> 2, seg = t2 & 3; const float eg = EG[tok]; const float* s = QF + tok * 132 + seg * 32;
            unsigned char* o = scr + 16384 + tok * 256 + seg * 64;
#pragma unroll
            for (int q = 0; q < 4; ++q) { float f[8];
#pragma unroll
                for (int e = 0; e < 8; ++e) f[e] = s[q * 8 + e] * eg;
                *(v4u*)(o + q * 16) = PACK8(f); }
        }
        {
            const int dk = t2 >> 1, hf = t2 & 1; unsigned char* o = scr + 32768 + dk * 128 + hf * 64;
#pragma unroll
            for (int q = 0; q < 4; ++q) { float f[8];
#pragma unroll
                for (int e = 0; e < 8; ++e) { const int tok = hf * 32 + q * 8 + e; f[e] = KF[tok * 132 + dk] * EKD[tok]; }
                *(v4u*)(o + q * 16) = PACK8(f); }
        }
#pragma unroll
        for (int q = 0; q < 2; ++q) { const int c = t2 + 256 * q; *(v4u*)(scr + 65536 + c * 16) = *(const v4u*)((const unsigned char*)QKS + c * 16); }
    }
    __syncthreads();
#pragma unroll
    for (int q = 0; q < 2; ++q) { const int c = tid + 512 * q; *(v4u*)(scr + c * 16) = *(const v4u*)((const unsigned char*)WST + c * 16); }
    __syncthreads();
}

constexpr int S_ST = 0, S_VNT = 34816, S_OPW = 53248, S_OPQG = 70656, S_OPKD = 88064, S_OPQK = 106496, S_OPU = 115712, S_RED = 134144;
__device__ __forceinline__ void scan_wg(KP P, int l, int bh, unsigned char* lds, int tid) {
    const int b = bh >> 2, h = bh & 3;
    const int lane = tid & 63, w = __builtin_amdgcn_readfirstlane(tid >> 6), fr = lane & 15, fq = lane >> 4;
    const bf16* PROJ = (const bf16*)(P->ws + WS_PROJ);
    bf16* OCAT = (bf16*)(P->ws + WS_XA);
    const float* GL = (const float*)(P->ws + WS_GL);
    float* RED = (float*)(lds + S_RED);
    f32x4 sacc[8];
#pragma unroll
    for (int mt = 0; mt < 8; ++mt) sacc[mt] = (f32x4){0.f, 0.f, 0.f, 0.f};
    for (int q = lane; q < 272; q += 64) *(v4u*)(lds + S_ST + (16 * w) * 272 + q * 16) = (v4u){0u, 0u, 0u, 0u};
    const f32x4 onv = *(const f32x4*)(P->in[12] + l * 128 + 16 * w + 4 * fq);
    v4u pre[9];
    {
        const unsigned char* src = P->ws + WS_SCR + (size_t)((b * 32 + 0) * 4 + h) * SCR_ITEM;
#pragma unroll
        for (int i = 0; i < 9; ++i) pre[i] = *(const v4u*)(src + (size_t)(tid + 512 * i) * 16);
    }
    for (int n = 0; n < 32; ++n) {
        const int item = (b * 32 + n) * 4 + h;
        __syncthreads();
#pragma unroll
        for (int i = 0; i < 9; ++i) {
            const int e = (tid + 512 * i) * 16 - (i >> 1) * 16384;
            if (i < 4) { const int row = e >> 8, cb = e & 255; *(v4u*)(lds + (i < 2 ? S_OPW : S_OPQG) + row * 272 + cb) = pre[i]; }
            else { const int row = e >> 7, cb = e & 127; *(v4u*)(lds + (i < 6 ? S_OPKD : (i < 8 ? S_OPU : S_OPQK)) + row * 144 + cb) = pre[i]; }
        }
        const float egl = GL[item];
        __syncthreads();
        if (n < 31) {
            const unsigned char* src = P->ws + WS_SCR + (size_t)(item + 4) * SCR_ITEM;
#pragma unroll
            for (int i = 0; i < 9; ++i) pre[i] = *(const v4u*)(src + (size_t)(tid + 512 * i) * 16);
        }
        const int rowt = b * SEQL + n * 64 + fr;
        bf16x8 sf[4];
#pragma unroll
        for (int ks = 0; ks < 4; ++ks) sf[ks] = *(const bf16x8*)(lds + S_ST + (16 * w + fr) * 272 + (ks * 32 + 8 * fq) * 2);
        f32x4 vt[4];
#pragma unroll
        for (int tt = 0; tt < 4; ++tt) { const v2u uu = *(const v2u*)(lds + S_OPU + (16 * w + fr) * 144 + (tt * 16 + 4 * fq) * 2);
            vt[tt] = (f32x4){bflo(uu.x), bfhi(uu.x), bflo(uu.y), bfhi(uu.y)}; }
#pragma unroll
        for (int tt = 0; tt < 4; ++tt)
#pragma unroll
            for (int ks = 0; ks < 4; ++ks) { const bf16x8 a = *(const bf16x8*)(lds + S_OPW + (tt * 16 + fr) * 272 + (ks * 32 + 8 * fq) * 2);
                vt[tt] = __builtin_amdgcn_mfma_f32_16x16x32_bf16(a, sf[ks], vt[tt], 0, 0, 0); }
#pragma unroll
        for (int tt = 0; tt < 4; ++tt) *(v2u*)(lds + S_VNT + (16 * w + fr) * 144 + (tt * 16 + 4 * fq) * 2) = (v2u){pk2(vt[tt][0], vt[tt][1]), pk2(vt[tt][2], vt[tt][3])};
        LDS_WAIT();
        bf16x8 vf[2];
#pragma unroll
        for (int js = 0; js < 2; ++js) vf[js] = *(const bf16x8*)(lds + S_VNT + (16 * w + fr) * 144 + (js * 32 + 8 * fq) * 2);
        f32x4 ot[4];
#pragma unroll
        for (int nt = 0; nt < 4; ++nt) {
            ot[nt] = (f32x4){0.f, 0.f, 0.f, 0.f};
#pragma unroll
            for (int ks = 0; ks < 4; ++ks) { const bf16x8 bq = *(const bf16x8*)(lds + S_OPQG + (nt * 16 + fr) * 272 + (ks * 32 + 8 * fq) * 2);
                ot[nt] = __builtin_amdgcn_mfma_f32_16x16x32_bf16(sf[ks], bq, ot[nt], 0, 0, 0); }
#pragma unroll
            for (int js = 0; js < 2; ++js) { const bf16x8 bk = *(const bf16x8*)(lds + S_OPQK + (nt * 16 + fr) * 144 + (js * 32 + 8 * fq) * 2);
                ot[nt] = __builtin_amdgcn_mfma_f32_16x16x32_bf16(vf[js], bk, ot[nt], 0, 0, 0); }
        }
#pragma unroll
        for (int nt = 0; nt < 4; ++nt) {
            float ps = ot[nt][0] * ot[nt][0] + ot[nt][1] * ot[nt][1] + ot[nt][2] * ot[nt][2] + ot[nt][3] * ot[nt][3];
            ps += __shfl_xor(ps, 16); ps += __shfl_xor(ps, 32);
            if (fq == 0) RED[w * 64 + nt * 16 + fr] = ps;
        }
        __syncthreads();
#pragma unroll
        for (int nt = 0; nt < 4; ++nt) {
            float tot = 0.f;
#pragma unroll
            for (int ww = 0; ww < 8; ++ww) tot += RED[ww * 64 + nt * 16 + fr];
            const float rs = rsqrtf(tot * (1.f / 128.f) + EPS);
            const v2u zz = *(const v2u*)(PROJ + (size_t)(rowt + nt * 16) * NPROJ + 1536 + h * 128 + 16 * w + 4 * fq);
            const float z0 = bflo(zz.x), z1 = bfhi(zz.x), z2 = bflo(zz.y), z3 = bfhi(zz.y);
            const float o0 = ot[nt][0] * rs * onv[0] * siluf(z0), o1 = ot[nt][1] * rs * onv[1] * siluf(z1), o2 = ot[nt][2] * rs * onv[2] * siluf(z2), o3 = ot[nt][3] * rs * onv[3] * siluf(z3);
            *(v2u*)(OCAT + (size_t)(rowt + nt * 16) * D + h * 128 + 16 * w + 4 * fq) = (v2u){pk2(o0, o1), pk2(o2, o3)};
        }
#pragma unroll
        for (int mt = 0; mt < 8; ++mt) {
            sacc[mt] = sacc[mt] * egl;
#pragma unroll
            for (int js = 0; js < 2; ++js) { const bf16x8 a = *(const bf16x8*)(lds + S_OPKD + (mt * 16 + fr) * 144 + (js * 32 + 8 * fq) * 2);
                sacc[mt] = __builtin_amdgcn_mfma_f32_16x16x32_bf16(a, vf[js], sacc[mt], 0, 0, 0); }
            *(v2u*)(lds + S_ST + (16 * w + fr) * 272 + (mt * 16 + 4 * fq) * 2) = (v2u){pk2(sacc[mt][0], sacc[mt][1]), pk2(sacc[mt][2], sacc[mt][3])};
        }
        LDS_WAIT();
    }
    float* pd = P->out + O_PDELTA + (size_t)((l * NBATCH + b) * 4 + h) * 16384;
#pragma unroll
    for (int mt = 0; mt < 8; ++mt)
#pragma unroll
        for (int r = 0; r < 4; ++r) pd[(mt * 16 + 4 * fq + r) * 128 + 16 * w + fr] = sacc[mt][r];
    __syncthreads();
}

__device__ __forceinline__ void sample_delta(KP P, int l, int it, unsigned char* lds, int tid_unused) {
    const int tid = fresh_tid();
    const int gq = tid >> 7, c = tid & 127, wv2 = (tid >> 6) & 1, lane = tid & 63;
    const int item = it * 4 + gq, sb = item >> 2, h = item & 3, rowbase = MP + sb * 8;
    float* QS = (float*)(lds + gq * 12288); float* KS = QS + 1024; float* VS = QS + 2048;
    float* RED2 = (float*)(lds + 49152);
    const bf16* PROJ = (const bf16*)(P->ws + WS_PROJ);
    const float* GB = (const float*)(P->ws + WS_GB);
    bf16* OCAT = (bf16*)(P->ws + WS_XA);
#pragma unroll
    for (int part = 0; part < 3; ++part) {
        const int col = part * 512 + h * 128 + c;
        const float* cw = P->in[9] + (size_t)(l * 4) * 1536 + col;
        const float w0 = cw[0], w1 = cw[1536], w2 = cw[2 * 1536], w3 = cw[3 * 1536];
        const float* hs = P->in[3] + (size_t)((l * DBATCH + sb) * 3) * 1536 + col;
        float r0 = hs[0], r1 = hs[1536], r2 = hs[2 * 1536];
        float* dst = QS + part * 1024 + c;
#pragma unroll
        for (int t = 0; t < 8; ++t) {
            const float x = bf1(PROJ[(size_t)(rowbase + t) * NPROJ + col]);
            dst[t * 128] = siluf(w0 * r0 + w1 * r1 + w2 * r2 + w3 * x);
            r0 = r1; r1 = r2; r2 = x;
        }
    }
#pragma unroll
    for (int t = 0; t < 8; ++t) {
        const float q = QS[t * 128 + c], k = KS[t * 128 + c];
        const float sq = wave_sum(q * q), sk = wave_sum(k * k);
        if (lane == 0) { RED2[(gq * 2 + wv2) * 16 + t] = sq; RED2[(gq * 2 + wv2) * 16 + 8 + t] = sk; }
    }
    __syncthreads();
#pragma unroll
    for (int t = 0; t < 8; ++t) {
        const float tq = RED2[(gq * 2) * 16 + t] + RED2[(gq * 2 + 1) * 16 + t], tk = RED2[(gq * 2) * 16 + 8 + t] + RED2[(gq * 2 + 1) * 16 + 8 + t];
        QS[t * 128 + c] *= rsqrtf(tq + EPS) * 0.08838834764831845f; KS[t * 128 + c] *= rsqrtf(tk + EPS);
    }
    __syncthreads();
    float s[128];
    {
        const float* S0 = P->in[2] + (size_t)((l * DBATCH + sb) * 4 + h) * 16384 + c;
#pragma unroll
        for (int d8 = 0; d8 < 16; ++d8) {
#pragma unroll
            for (int e = 0; e < 8; ++e) s[8 * d8 + e] = S0[e * 128];
            S0 += 8 * 128; asm volatile("" : "+v"(S0));
        }
    }
#pragma unroll 1
    for (int t = 0; t < 8; ++t) {
        const float g = GB[(size_t)(rowbase + t) * 8 + h], beta = GB[(size_t)(rowbase + t) * 8 + 4 + h], eg = __expf(g);
        const f32x4* kp = (const f32x4*)(KS + t * 128); const f32x4* qp = (const f32x4*)(QS + t * 128);
        float dot = 0.f;
#pragma unroll
        for (int d4 = 0; d4 < 32; ++d4) { const f32x4 kv = kp[d4]; dot += kv[0] * s[4 * d4] + kv[1] * s[4 * d4 + 1] + kv[2] * s[4 * d4 + 2] + kv[3] * s[4 * d4 + 3];
            if ((d4 & 3) == 3) asm volatile("" ::: "memory"); }
        const float cf = beta * (VS[t * 128 + c] - eg * dot);
        float o = 0.f;
#pragma unroll
        for (int d4 = 0; d4 < 32; ++d4) { const f32x4 kv = kp[d4], qv = qp[d4];
#pragma unroll
            for (int e = 0; e < 4; ++e) { s[4 * d4 + e] = eg * s[4 * d4 + e] + cf * kv[e]; o += qv[e] * s[4 * d4 + e]; }
            if ((d4 & 3) == 3) asm volatile("" ::: "memory"); }
        VS[t * 128 + c] = o;
    }
    {
        float* sd = P->out + O_SDELTA + (size_t)((l * DBATCH + sb) * 4 + h) * 16384 + c;
#pragma unroll
        for (int d8 = 0; d8 < 16; ++d8) {
#pragma unroll
            for (int e = 0; e < 8; ++e) sd[e * 128] = s[8 * d8 + e];
            sd += 8 * 128; asm volatile("" : "+v"(sd));
        }
    }
    __syncthreads();
#pragma unroll
    for (int t = 0; t < 8; ++t) { const float o = VS[t * 128 + c]; const float so = wave_sum(o * o); if (lane == 0) RED2[(gq * 2 + wv2) * 16 + t] = so; }
    __syncthreads();
    const float onv = P->in[12][l * 128 + c];
#pragma unroll
    for (int t = 0; t < 8; ++t) {
        const float tot = RED2[(gq * 2) * 16 + t] + RED2[(gq * 2 + 1) * 16 + t];
        const float z = bf1(PROJ[(size_t)(rowbase + t) * NPROJ + 1536 + h * 128 + c]);
        OCAT[(size_t)(rowbase + t) * D + h * 128 + c] = (bf16)f2bf(VS[t * 128 + c] * rsqrtf(tot * (1.f / 128.f) + EPS) * onv * siluf(z));
    }
    __syncthreads();
}

constexpr int PL_DT = 0, PL_PW = 69632;
__device__ __forceinline__ void pool_tile(KP P, int l, int tile, unsigned char* lds, int tid_unused) {
    const int tid = fresh_tid();
    float* DT = (float*)(lds + PL_DT); const float* PW = (const float*)(lds + PL_PW);
    const bf16* PROJ = (const bf16*)(P->ws + WS_PROJ);
    bf16* OCAT = (bf16*)(P->ws + WS_XA);
#pragma unroll 1
    for (int i = 0; i < 4; ++i) {
        const int idx = tid + 512 * i, tok = idx & 63, ch8 = idx >> 6, c0 = ch8 * 8, gi = ch8 >> 3, win = 2 << gi;
        int row, t, sb = 0; bool smp;
        if (tile < 256) { t = (tile & 31) * 64 + tok; row = (tile >> 5) * SEQL + t; smp = false; }
        else { sb = (tile - 256) * 8 + (tok >> 3); t = tok & 7; row = MP + sb * 8 + t; smp = true; }
        float ssum[8], cur[8];
#pragma unroll
        for (int e = 0; e < 8; ++e) { ssum[e] = 0.f; cur[e] = 0.f; }
        for (int j = 0; j < win; ++j) {
            const int tt = t - j; float f[8];
            if (tt >= 0) { const v4u w = *(const v4u*)(PROJ + (size_t)(row - j) * NPROJ + 2048 + c0); UNPACK8(w, f); }
            else if (smp) { const float* sp = P->in[4] + (size_t)((l * DBATCH + sb) * 15 + 15 + tt) * 256 + c0;
#pragma unroll
                for (int e = 0; e < 8; ++e) f[e] = sp[e]; }
            else {
#pragma unroll
                for (int e = 0; e < 8; ++e) f[e] = 0.f; }
#pragma unroll
            for (int e = 0; e < 8; ++e) { ssum[e] += f[e]; if (j == 0) cur[e] = f[e]; }
        }
        const float inv = 1.f / (float)(smp ? win : (t + 1 < win ? t + 1 : win));
#pragma unroll
        for (int e = 0; e < 8; ++e) DT[(c0 + e) * 68 + tok] = ssum[e] * inv - cur[e];
        float u0[8], u1[8], u2[8];
#pragma unroll
        for (int j = 0; j < 3; ++j) {
            const int tt = t - j; float f[8];
            if (tt >= 0) { const v4u wc = *(const v4u*)(PROJ + (size_t)(row - j) * NPROJ + 2816 + c0); const v4u wx = *(const v4u*)(PROJ + (size_t)(row - j) * NPROJ + 2304 + c0);
                float fc[8], fx[8]; UNPACK8(wc, fc); UNPACK8(wx, fx);
#pragma unroll
                for (int e = 0; e < 8; ++e) f[e] = fc[e] * fx[e]; }
            else if (smp) { const float* sp = P->in[5] + (size_t)((l * DBATCH + sb) * 2 + 2 + tt) * 256 + c0;
#pragma unroll
                for (int e = 0; e < 8; ++e) f[e] = sp[e]; }
            else {
#pragma unroll
                for (int e = 0; e < 8; ++e) f[e] = 0.f; }
#pragma unroll
            for (int e = 0; e < 8; ++e) { if (j == 0) u0[e] = f[e]; else if (j == 1) u1[e] = f[e]; else u2[e] = f[e]; }
        }
        const float* sw = P->in[15] + (size_t)(l * 3) * 256 + c0;
        const v4u wb = *(const v4u*)(PROJ + (size_t)row * NPROJ + 2560 + c0); float fb[8]; UNPACK8(wb, fb);
        float oc[8];
#pragma unroll
        for (int e = 0; e < 8; ++e) oc[e] = fb[e] * (sw[e] * u2[e] + sw[256 + e] * u1[e] + sw[512 + e] * u0[e]);
        *(v4u*)(OCAT + (size_t)row * D + 768 + c0) = PACK8(oc);
    }
    __syncthreads();
    {
        const int ep = tid & 255, g = ep >> 6, e = ep & 63, hf = tid >> 8;
        float acc[32];
#pragma unroll
        for (int q = 0; q < 32; ++q) acc[q] = 0.f;
#pragma unroll 2
        for (int c = 0; c < 64; ++c) {
            const float wgt = PW[(g * 64 + c) * 64 + e];
            const f32x4* dp = (const f32x4*)(DT + (g * 64 + c) * 68 + hf * 32);
#pragma unroll
            for (int q = 0; q < 8; ++q) { const f32x4 d = dp[q]; acc[4 * q] += d[0] * wgt; acc[4 * q + 1] += d[1] * wgt; acc[4 * q + 2] += d[2] * wgt; acc[4 * q + 3] += d[3] * wgt; }
        }
        const float sc = P->in[14][l * 256 + ep];
#pragma unroll
        for (int q = 0; q < 32; ++q) {
            const int tok = hf * 32 + q;
            const int row = tile < 256 ? (tile >> 5) * SEQL + (tile & 31) * 64 + tok : MP + (tile - 256) * 64 + tok;
            OCAT[(size_t)row * D + 512 + ep] = (bf16)f2bf(acc[q] * sc);
        }
    }
    __syncthreads();
}

__device__ __forceinline__ void state_copies(KP P, int l, int start, int stride) {
    const bf16* PROJ = (const bf16*)(P->ws + WS_PROJ);
    for (int i = start; i < 136 * 8960; i += stride) {
        const int seq = i / 8960, r = i % 8960;
        const bool smp = seq >= 8; const int sb = seq - 8;
        const int L = smp ? 8 : SEQL; const size_t row0 = smp ? (size_t)MP + sb * 8 : (size_t)seq * SEQL;
        if (r < 4608) {
            const int j = r / 1536, c = r % 1536;
            const float v = bf1(PROJ[(row0 + L - 3 + j) * NPROJ + c]);
            if (smp) P->out[O_SDCONV + (size_t)((l * DBATCH + sb) * 3 + j) * 1536 + c] = v; else P->out[O_PDCONV + (size_t)((l * NBATCH + seq) * 3 + j) * 1536 + c] = v;
        } else if (r < 4608 + 3840) {
            const int r2 = r - 4608, j = r2 / 256, c = r2 % 256;
            if (smp) { const float v = j < 7 ? P->in[4][(size_t)((l * DBATCH + sb) * 15 + 8 + j) * 256 + c] : bf1(PROJ[(row0 + j - 7) * NPROJ + 2048 + c]);
                P->out[O_SPOOL + (size_t)((l * DBATCH + sb) * 15 + j) * 256 + c] = v; }
            else P->out[O_PPOOL + (size_t)((l * NBATCH + seq) * 15 + j) * 256 + c] = bf1(PROJ[(row0 + L - 15 + j) * NPROJ + 2048 + c]);
        } else {
            const int r2 = r - 8448, j = r2 / 256, c = r2 % 256;
            const size_t row = row0 + L - 2 + j;
            const float v = bf1(PROJ[row * NPROJ + 2816 + c]) * bf1(PROJ[row * NPROJ + 2304 + c]);
            if (smp) P->out[O_SSCONV + (size_t)((l * DBATCH + sb) * 2 + j) * 256 + c] = v; else P->out[O_PSCONV + (size_t)((l * NBATCH + seq) * 2 + j) * 256 + c] = v;
        }
    }
}

__device__ __forceinline__ void p4b(KP P, int l, int hf, int start, int stride) {
    bf16* GU = (bf16*)(P->ws + WS_GU); bf16* HALO = (bf16*)(P->ws + WS_HALO);
    const float* cw = P->in[19] + (size_t)(l * 3) * FF;
    const int r0 = hf * MH;
    for (int idx = start; idx < MH * 352; idx += stride) {
        const int lr = idx / 352, c0 = (idx % 352) * 8, m = r0 + lr;
        int t, sb = 0; bool smp;
        if (m < MP) { t = m & (SEQL - 1); smp = false; } else { sb = (m - MP) >> 3; t = (m - MP) & 7; smp = true; }
        float g0[8], g1[8], g2[8];
#pragma unroll
        for (int j = 0; j < 3; ++j) {
            const int tt = t - j; float f[8];
            if (tt < 0) {
                if (smp) { const float* sp = P->in[6] + (size_t)((l * DBATCH + sb) * 2 + 2 + tt) * FF + c0;
#pragma unroll
                    for (int e = 0; e < 8; ++e) f[e] = sp[e]; }
                else {
#pragma unroll
                    for (int e = 0; e < 8; ++e) f[e] = 0.f; }
            } else {
                const v4u w = (lr - j < 0) ? *(const v4u*)(HALO + (size_t)(2 + lr - j) * FF + c0) : *(const v4u*)(GU + (size_t)(lr - j) * NGU + c0);
                UNPACK8(w, f);
            }
#pragma unroll
            for (int e = 0; e < 8; ++e) { if (j == 0) g0[e] = f[e]; else if (j == 1) g1[e] = f[e]; else g2[e] = f[e]; }
        }
        const v4u wu = *(const v4u*)(GU + (size_t)lr * NGU + FF + c0); float fu[8]; UNPACK8(wu, fu);
        float a[8];
#pragma unroll
        for (int e = 0; e < 8; ++e) a[e] = siluf(cw[c0 + e] * g2[e] + cw[FF + c0 + e] * g1[e] + cw[2 * FF + c0 + e] * g0[e]) * fu[e];
        *(v4u*)(GU + (size_t)lr * NGU + FF + c0) = PACK8(a);
        if (!smp && t >= SEQL - 2) { float* o = P->out + O_PFFN + (size_t)((l * NBATCH + (m >> 11)) * 2 + t - (SEQL - 2)) * FF + c0;
#pragma unroll
            for (int e = 0; e < 8; ++e) o[e] = g0[e]; }
        if (smp && t >= 6) { float* o = P->out + O_SFFN + (size_t)((l * DBATCH + sb) * 2 + t - 6) * FF + c0;
#pragma unroll
            for (int e = 0; e < 8; ++e) o[e] = g0[e]; }
        if (hf == 0 && lr >= MH - 2) *(v4u*)(HALO + (size_t)(lr - (MH - 2)) * FF + c0) = *(const v4u*)(GU + (size_t)lr * NGU + c0);
    }
}

#define LAS __attribute__((address_space(3)))
#define XB_TMO      128
#define XB_XCNT(j)  (256  + 64 * (j))
#define XB_XSUB(j)  (1280 + 64 * (j))
#define XB_XGEN(j)  (2304 + 64 * (j))
#define XB_TOP      3328
#define XB_TOPGEN   3392
#define XCD_BAR_WORDS 3456
#define XB_SPIN_CAP (1u << 18)

__device__ __forceinline__ unsigned xb_ld(unsigned* p)              { return __hip_atomic_load(p, __ATOMIC_RELAXED, __HIP_MEMORY_SCOPE_AGENT); }
__device__ __forceinline__ unsigned xb_add(unsigned* p, unsigned v) { return __hip_atomic_fetch_add(p, v, __ATOMIC_RELAXED, __HIP_MEMORY_SCOPE_AGENT); }
__device__ __forceinline__ unsigned xb_xcc_id() { return (unsigned)__builtin_amdgcn_s_getreg((3 << 11) | 20) & 0xFu; }
#define XB_SPIN(cond, bar) do { unsigned _sp = 0; while (cond) { __builtin_amdgcn_s_sleep(1); \
    if ((++_sp & 255u) == 0u) { if (xb_ld(&(bar)[XB_TMO])) break; if (_sp > XB_SPIN_CAP) { atomicAdd(&(bar)[XB_TMO], 1u); break; } } } } while (0)

struct XcdBarrier {
    unsigned* bar; unsigned x;
    volatile LAS unsigned* st;
};

__device__ __forceinline__ XcdBarrier xcd_barrier_post(unsigned* bar, volatile LAS unsigned* st) {
    XcdBarrier b; b.bar = bar; b.x = xb_xcc_id(); b.st = st;
    if (threadIdx.x == 0) (void)xb_add(&bar[XB_XCNT(b.x)], 1u);
    return b;
}
__device__ __forceinline__ void xcd_barrier_complete(unsigned* bar, unsigned x, unsigned& nloc, unsigned& nx) {
    const unsigned G = gridDim.x * gridDim.y * gridDim.z;
    unsigned sum, cnt, mine, sp = 0u;
    for (;;) {
        sum = 0u; cnt = 0u; mine = 0u;
#pragma unroll
        for (unsigned j = 0; j < 16; ++j) { const unsigned c = xb_ld(&bar[XB_XCNT(j)]); sum += c; cnt += (c > 0u) ? 1u : 0u; mine = (j == x) ? c : mine; }
        if (sum == G) break;
        __builtin_amdgcn_s_sleep(1);
        if ((++sp & 255u) == 0u) { if (xb_ld(&bar[XB_TMO])) break; if (sp > XB_SPIN_CAP) { atomicAdd(&bar[XB_TMO], 1u); break; } }
    }
    nloc = mine > 0u ? mine : 1u; nx = cnt > 0u ? cnt : 1u;
}

__device__ __forceinline__ void xcd_barrier(const XcdBarrier& b) {
    asm volatile("s_waitcnt vmcnt(0)" ::: "memory");
    __syncthreads();
    if (threadIdx.x == 0) {
        unsigned* bar = b.bar;
        __builtin_amdgcn_s_waitcnt(0);
        unsigned nloc = b.st[0], nx = b.st[1];
        if (nloc == 0u) { xcd_barrier_complete(bar, b.x, nloc, nx); b.st[0] = nloc; b.st[1] = nx; }
        const unsigned old = xb_add(&bar[XB_XSUB(b.x)], 1u);
        const unsigned gen = old / nloc;
        if (old + 1u == (gen + 1u) * nloc) {
            __builtin_amdgcn_fence(__ATOMIC_RELEASE, "agent");
            asm volatile("s_waitcnt vmcnt(0)" ::: "memory");
            const unsigned og = xb_add(&bar[XB_TOP], 1u);
            const unsigned tg = og / nx;
            if (og + 1u == (tg + 1u) * nx) xb_add(&bar[XB_TOPGEN], 1u);
            else XB_SPIN(xb_ld(&bar[XB_TOPGEN]) == tg, bar);
            __builtin_amdgcn_fence(__ATOMIC_ACQUIRE, "agent");
            xb_add(&bar[XB_XGEN(b.x)], 1u);
            asm volatile("s_waitcnt vmcnt(0)" ::: "memory");
        } else {
            XB_SPIN(xb_ld(&bar[XB_XGEN(b.x)]) == gen, bar);
            __builtin_amdgcn_fence(__ATOMIC_ACQUIRE, "agent");
            asm volatile("s_waitcnt vmcnt(0)" ::: "memory");
        }
    }
    __syncthreads();
}

#ifdef PROBE_SYNC2
#define GSYNC() do { xcd_barrier(xbar); xcd_barrier(xbar); } while (0)
#else
#define GSYNC() xcd_barrier(xbar)
#endif
__global__ void __launch_bounds__(NTHREADS, 2) fwd_megakernel(Params Parg) {
    KP P = kparams();
    extern __shared__ __attribute__((aligned(16))) unsigned char lds[];
    cg::grid_group grid = cg::this_grid();
    const int tid = threadIdx.x, lane = tid & 63, wave = __builtin_amdgcn_readfirstlane(tid >> 6);
    const int G = gridDim.x, bx = blockIdx.x;
    const int gw = bx * NWAVES + wave, ngw = G * NWAVES;
    const int gt = bx * NTHREADS + tid, ngt = G * NTHREADS;
    unsigned char* ws = P->ws;
    bf16* XA = (bf16*)(ws + WS_XA); bf16* XB2 = (bf16*)(ws + WS_PROJ); bf16* PROJ = (bf16*)(ws + WS_PROJ); bf16* GU = (bf16*)(ws + WS_GU);
    float* SSQ = (float*)(ws + WS_SSQ); float* GB = (float*)(ws + WS_GB); float* WAB = (float*)(ws + WS_WAB);
    float* XRES = P->out;
    float* wscr = (float*)(lds + wave * 16384);
    volatile LAS unsigned* xst = (volatile LAS unsigned*)((LAS unsigned char*)lds + (LDS_BYTES - 64));
    if (tid < 16) xst[tid] = 0u;
    __syncthreads();
    const XcdBarrier xbar = xcd_barrier_post((unsigned*)(ws + WS_BAR), xst);

    for (int i = gt; i < 4 * M; i += ngt) SSQ[M + i] = 0.f;
    for (int i = gt; i < 2 * 8 * D; i += ngt) { const int l = i >> 13, j = (i >> 10) & 7, k = i & 1023; WAB[i] = P->in[7][l * D + k] * P->in[8][(size_t)l * D * DIN + (size_t)k * DIN + 2048 + j]; }
    convert_win(P, 0, wscr, gw, ngw, lane);
    convert_layer_rest(P, 0, wscr, gw, ngw, lane);
    convert_layer_rest(P, 1, wscr, gw, ngw, lane);
    for (int m = gw; m < M; m += ngw) {
        const float* xr = m < MP ? P->in[0] + (size_t)m * D : P->in[1] + (size_t)(m - MP) * D;
        float ss = 0.f;
#pragma unroll
        for (int j = 0; j < 4; ++j) { const f32x4 v = ((const f32x4*)xr)[lane + 64 * j]; ss += v[0] * v[0] + v[1] * v[1] + v[2] * v[2] + v[3] * v[3];
            ((v2u*)(XA + (size_t)m * D))[lane + 64 * j] = (v2u){pk2(v[0], v[1]), pk2(v[2], v[3])}; }
        ss = wave_sum(ss);
        if (lane == 0) SSQ[m] = ss;
    }
    grid.sync();

#pragma unroll 1
    for (int l = 0; l < 2; ++l) {
#ifndef NO_P1
        {
            const bf16* gA = XA; const bf16* gB = (const bf16*)(ws + WS_WIN); LAUNDER(gA); LAUNDER(gB);
            pg8::Gemm g{gA, gB, M, NPROJ, D, D}; pg8::StaticOrder S; S.init(M, NPROJ, G, bx);
            EpiScale E{PROJ, NPROJ, SSQ + (size_t)(2 * l) * M};
            pg8::gemm_phase<EpiScale, pg8::StaticOrder, true, true>((PG8_LAS unsigned char*)lds, g, S, E);
        }
#endif
#ifndef NO_AB
        {
            const float* ssq = SSQ + (size_t)(2 * l) * M;
            const int tf = fresh_tid(), lane = tf & 63, gw = bx * NWAVES + __builtin_amdgcn_readfirstlane(tf >> 6);
            for (int m = gw; m < M; m += ngw) {
                const v4u* xr = (const v4u*)(XA + (size_t)m * D) + lane * 2;
                const v4u x0 = xr[0], x1 = xr[1]; float xf[16]; UNPACK8(x0, xf); UNPACK8(x1, xf + 8);
                float dot[8];
#pragma unroll
                for (int j = 0; j < 8; ++j) { const float* wp = WAB + (size_t)(l * 8 + j) * D + lane * 16; float s = 0.f;
#pragma unroll
                    for (int e = 0; e < 16; ++e) s += wp[e] * xf[e];
                    dot[j] = wave_sum(s); }
                float v = dot[0];
#pragma unroll
                for (int j = 1; j < 8; ++j) v = (lane == j) ? dot[j] : v;
                if (lane < 8) {
                    v *= rsqrtf(ssq[m] * (1.f / D) + EPS);
                    const int hh = lane & 3; float r;
                    if (lane < 4) { const float xx = v + P->in[11][l * 4 + hh]; const float sp = fmaxf(xx, 0.f) + log1pf(expf(-fabsf(xx))); r = -expf(P->in[10][l * 4 + hh]) * sp; }
                    else r = 1.f / (1.f + expf(-v));
                    GB[(size_t)m * 8 + lane] = r;
                }
            }
        }
#endif
        GSYNC();
#ifndef NO_P2B
        { const int tf = fresh_tid(); for (int item = bx; item < 1024; item += G) p2b_item(P, l, item, lds, tf); }
#ifdef PROBE_P2B2
        __syncthreads(); { const int tf = fresh_tid(); for (int item = bx; item < 1024; item += G) p2b_item(P, l, item, lds, tf); }
#endif
#endif
        GSYNC();
#ifndef NO_SCAN
        if (bx < 32) scan_wg(P, l, bx, lds, fresh_tid());
        else
#endif
        {
            const int vw = bx - 32, nm = G - 32; const int tid = fresh_tid();
#ifndef NO_SAMPLE
            for (int it = nm - 1 - vw; it < 128; it += nm) sample_delta(P, l, it, lds, tid);
#endif
            for (int i = tid; i < 4096; i += NTHREADS) ((f32x4*)(lds + PL_PW))[i] = ((const f32x4*)(P->in[13] + (size_t)l * 16384))[i];
            __syncthreads();
#ifndef NO_POOL
            for (int tile = vw; tile < 272; tile += nm) pool_tile(P, l, tile, lds, tid);
#endif
            state_copies(P, l, vw * NTHREADS + tid, nm * NTHREADS);
        }
        GSYNC();
#ifndef NO_P3
        {
            const bf16* gA = XA; const bf16* gB = (const bf16*)(ws + WS_WOUT) + (size_t)l * D * D; LAUNDER(gA); LAUNDER(gB);
            pg8::Gemm g{gA, gB, M, D, D, D}; pg8::StaticOrder S; S.init(M, D, G, bx);
            EpiResid E{l == 0 ? P->in[0] : XRES, l == 0 ? P->in[1] : XRES + (size_t)MP * D, XRES, XB2, SSQ + (size_t)(2 * l + 1) * M, 0};
            pg8::gemm_phase<EpiResid, pg8::StaticOrder, true, true>((PG8_LAS unsigned char*)lds, g, S, E);
        }
#endif
        GSYNC();
#pragma unroll 1
        for (int hf = 0; hf < 2; ++hf) {
            const int r0 = hf * MH;
#ifndef NO_P4
            {
                const bf16* gA = XB2 + (size_t)r0 * D; const bf16* gB = (const bf16*)(ws + WS_WGU) + (size_t)l * NGU * D; LAUNDER(gA); LAUNDER(gB);
                pg8::Gemm g{gA, gB, MH, NGU, D, D}; pg8::StaticOrder S; S.init(MH, NGU, G, bx);
                EpiScale E{GU, NGU, SSQ + (size_t)(2 * l + 1) * M + r0};
                pg8::gemm_phase<EpiScale, pg8::StaticOrder, true, true>((PG8_LAS unsigned char*)lds, g, S, E);
            }
#endif
            GSYNC();
#ifndef NO_P4B
            p4b(P, l, hf, bx * NTHREADS + fresh_tid(), ngt);
#endif
            if (l == 0 && hf == 0) { const int tf = fresh_tid(); const int wv = __builtin_amdgcn_readfirstlane(tf >> 6); convert_win(P, 1, (float*)(lds + wv * 16384), bx * NWAVES + wv, ngw, tf & 63); }
            GSYNC();
#ifndef NO_P5
            {
                const bf16* gA = GU + FF; const bf16* gB = (const bf16*)(ws + WS_WDN) + (size_t)l * D * FF; LAUNDER(gA); LAUNDER(gB);
                pg8::Gemm g{gA, gB, MH, D, FF, NGU}; pg8::StaticOrder S; S.init(MH, D, G, bx);
                EpiResid E{XRES, XRES + (size_t)MP * D, XRES, XA, SSQ + (size_t)(2 * l + 2) * M, r0};
                pg8::gemm_phase<EpiResid, pg8::StaticOrder, true, true>((PG8_LAS unsigned char*)lds, g, S, E);
            }
#endif
            GSYNC();
        }
    }
    {
        const float* ssq = SSQ + (size_t)4 * M; const float* fn = P->in[22];
        const int gt = bx * NTHREADS + fresh_tid();
        for (int i = gt; i < M * 256; i += ngt) {
            const int row = i >> 8, c4 = i & 255;
            const float rs = rsqrtf(ssq[row] * (1.f / D) + EPS);
            f32x4 v = ((f32x4*)XRES)[i]; const f32x4 gv = ((const f32x4*)fn)[c4];
            v[0] *= rs * gv[0]; v[1] *= rs * gv[1]; v[2] *= rs * gv[2]; v[3] *= rs * gv[3];
            ((f32x4*)XRES)[i] = v;
        }
    }
}

extern "C" void kernel_launch(void* const* d_in, const int* in_sizes, int n_in, void* d_out, int out_size, void* d_ws, size_t ws_size, hipStream_t stream) {
    static int grid = 0;
    if (grid == 0) {
        if (n_in != 23 || (size_t)out_size != O_TOTAL || ws_size < WS_END) { fprintf(stderr, "kernel_launch: unexpected shapes: n_in %d out %d ws %zu\n", n_in, out_size, ws_size); grid = -1; return; }
        int dev = 0, cus = 0, per_cu = 0;
        hipGetDevice(&dev); hipDeviceGetAttribute(&cus, hipDeviceAttributeMultiprocessorCount, dev);
        if (hipFuncSetAttribute((const void*)fwd_megakernel, hipFuncAttributeMaxDynamicSharedMemorySize, LDS_BYTES) != hipSuccess) { fprintf(stderr, "kernel_launch: hipFuncSetAttribute failed\n"); grid = -1; return; }
        hipOccupancyMaxActiveBlocksPerMultiprocessor(&per_cu, (const void*)fwd_megakernel, NTHREADS, LDS_BYTES);
        (void)hipGetLastError();
        if (per_cu < 1) fprintf(stderr, "kernel_launch: occupancy query reports %d blocks per CU\n", per_cu);
        grid = cus;
    }
    if (grid < 0) return;
    if (hipMemsetAsync((char*)d_ws + WS_BAR, 0, 16384, stream) != hipSuccess) { fprintf(stderr, "kernel_launch: memset failed\n"); return; }
    Params p{};
    for (int i = 0; i < 23; ++i) p.in[i] = (const float*)d_in[i];
    p.out = (float*)d_out; p.ws = (unsigned char*)d_ws;
    void* args[] = {&p};
    hipError_t e = hipLaunchCooperativeKernel((const void*)fwd_megakernel, dim3(grid), dim3(NTHREADS), args, LDS_BYTES, stream);
    if (e != hipSuccess) fprintf(stderr, "cooperative launch failed: %s (grid %d)\n", hipGetErrorString(e), grid);
}
```

```cpp
#include <hip/hip_runtime.h>
#include <hip/hip_cooperative_groups.h>
#include <cstdio>
#include <cstdint>
namespace cg = cooperative_groups;
__device__ __forceinline__ int lane_id() { int t; asm volatile("v_mbcnt_lo_u32_b32 %0, -1, 0\n\tv_mbcnt_hi_u32_b32 %0, -1, %0" : "=v"(t)); return t; }
__device__ __forceinline__ int fresh_tid(int wave) { return (wave << 6) | lane_id(); }
namespace pg8 {
#define PG8_LAS __attribute__((address_space(3)))
typedef unsigned short bf16_t;
typedef short bf16x8 __attribute__((ext_vector_type(8)));
typedef float f32x4 __attribute__((ext_vector_type(4)));
typedef unsigned u32x4 __attribute__((ext_vector_type(4)));
constexpr int BM = 256, BK = 64, HALF = 128, HTB = HALF * BK * 2  , STAGE_BYTES = 8 * HTB, NXCD = 8, WGM = 8;

__host__ __device__ __forceinline__ int lds_byte(int r, int c) { const int st = (r >> 4) * 2 + (c >> 5), rr = r & 15, cc = c & 31, ob = rr * 64 + cc * 2; return st * 1024 + (ob ^ (((ob >> 9) & 1) << 5)); }
__host__ __device__ __forceinline__ void stage_rc(int b, int& R, int& C) { const int st = b / 1024, sb = b % 1024, swz = sb ^ (((sb >> 9) & 1) << 5); R = (st >> 1) * 16 + swz / 64; C = (st & 1) * 32 + (swz % 64) / 2; }
__host__ __device__ __forceinline__ int perm32(int rho) { const int n = rho >> 4, i = rho & 15; return 8 * (i >> 2) + 4 * n + (i & 3); }

struct Unit { int pm, pn; };
struct Gemm { const bf16_t* A; const bf16_t* Bt; int M, N, K, lda; };

struct StaticOrder {
    int nM, nN, nwg, G, c;
    __host__ __device__ void init(int M, int N, int G_, int c_) { nM = M / BM; nN = N / BM; nwg = nM * nN; G = G_; c = c_; }
    __host__ __device__ bool next(int i, Unit& u) const {
        const long L = (long)i * G + c; if (L >= nwg) return false;
        int wgid = (int)L; { const int q = nwg / NXCD, r = nwg % NXCD, xcd = wgid % NXCD, off = wgid / NXCD; wgid = (xcd < r ? xcd * (q + 1) : r * (q + 1) + (xcd - r) * q) + off; }
        const int nig = WGM * nN, gid = wgid / nig, fm = gid * WGM, gsz = (nM - fm) < WGM ? (nM - fm) : WGM;
        u.pm = fm + ((wgid % nig) % gsz); u.pn = (wgid % nig) / gsz; return true;
    }
    __device__ __forceinline__ void a_ready(const Unit&) const {}
    __device__ __forceinline__ void done(const Unit&) const {}
};

template <class Epi, class Sched, bool ALIGN_EPI = false, bool SP2 = false>
__device__ __forceinline__ void gemm_phase(PG8_LAS unsigned char* lds, const Gemm g, const Sched& S, const Epi& E, const int wave_in) {
    const int tid = fresh_tid(wave_in), wid = __builtin_amdgcn_readfirstlane(tid >> 6), lane = tid & 63, wr = wid >> 2, wc = wid & 3, fr = lane & 15, fq = lane >> 4;
    const int K = g.K, nt = K / BK;
    unsigned voffA[2], voffB[2];
#pragma unroll
    for (int i = 0; i < 2; ++i) { int R, C; stage_rc(tid * 16 + i * 8192, R, C); const int Rb = Epi::PERM ? ((R & ~31) + perm32(R & 31)) : R;
        voffA[i] = (unsigned)(R * g.lda + C) * 2u; voffB[i] = (unsigned)(Rb * K + C) * 2u; }
    const size_t kstep = (size_t)(BK * 2);
    const size_t hstepA = (size_t)HALF * g.lda * 2, hstepB = (size_t)HALF * K * 2;
    const size_t tstepA = 2 * hstepA, tstepB = 2 * hstepB;
    const unsigned ldsw = (unsigned)wid * 1024u;
    const int aoff = lds_byte(wr * 64 + fr, fq * 8), boff = lds_byte(wc * 32 + fr, fq * 8);
#define PG8_SA(b, h) (((b) * 2 + (h)) * HTB)
#define PG8_SB(b, h) ((4 + (b) * 2 + (h)) * HTB)
#define PG8_STAGE(bufoff, gbase, voff) do { _Pragma("unroll") for (int _i = 0; _i < 2; ++_i) \
        __builtin_amdgcn_global_load_lds((const unsigned*)((const char*)(gbase) + (voff)[_i]), (PG8_LAS unsigned*)(lds + (bufoff) + ldsw + _i * 8192), 16, 0, 0); } while (0)
#define PG8_LDA(dst, b, h) do { _Pragma("unroll") for (int m = 0; m < 4; ++m) _Pragma("unroll") for (int k = 0; k < 2; ++k) dst[m][k] = *(const PG8_LAS bf16x8*)(lds + PG8_SA(b, h) + aoff + m * 2048 + k * 1024); } while (0)
#define PG8_LDB(dst, b, h) do { _Pragma("unroll") for (int n = 0; n < 2; ++n) _Pragma("unroll") for (int k = 0; k < 2; ++k) dst[n][k] = *(const PG8_LAS bf16x8*)(lds + PG8_SB(b, h) + boff + n * 2048 + k * 1024); } while (0)
#define PG8_MMA(ai, bj, At, Bt) do { __builtin_amdgcn_s_setprio(1); _Pragma("unroll") for (int m = 0; m < 4; ++m) _Pragma("unroll") for (int n = 0; n < 2; ++n) _Pragma("unroll") for (int k = 0; k < 2; ++k) \
        acc[ai][bj][m][n] = __builtin_amdgcn_mfma_f32_16x16x32_bf16(Bt[n][k], At[m][k], acc[ai][bj][m][n], 0, 0, 0); __builtin_amdgcn_s_setprio(0); } while (0)
#define PG8_WAIT_V(n) asm volatile("s_waitcnt vmcnt(" #n ")" ::: "memory")
#define PG8_WAIT_L(n) asm volatile("s_waitcnt lgkmcnt(" #n ")" ::: "memory")
#define PG8_BAR __builtin_amdgcn_s_barrier()
#define PG8_SCHED __builtin_amdgcn_sched_barrier(0)
    Unit cur, nxt; int ui = 0;
    if (!S.next(0, cur)) return;
    f32x4 acc[2][2][4][2];
#pragma unroll
    for (int a = 0; a < 2; ++a)
#pragma unroll
        for (int b = 0; b < 2; ++b)
#pragma unroll
            for (int m = 0; m < 4; ++m)
#pragma unroll
                for (int n = 0; n < 2; ++n) acc[a][b][m][n] = (f32x4){0.f, 0.f, 0.f, 0.f};
    bf16x8 At[4][2], B0[2][2], B1[2][2];
    const char* cA = (const char*)g.A + (size_t)cur.pm * tstepA; const char* cB = (const char*)g.Bt + (size_t)cur.pn * tstepB;
    S.a_ready(cur);
    if constexpr (SP2) {
        PG8_STAGE(PG8_SB(0, 0), cB, voffB); PG8_STAGE(PG8_SB(0, 1), cB + hstepB, voffB); PG8_STAGE(PG8_SA(0, 0), cA, voffA); PG8_STAGE(PG8_SA(0, 1), cA + hstepA, voffA);
        if (wr == 1) PG8_BAR;
        PG8_WAIT_V(2); PG8_BAR;
        PG8_STAGE(PG8_SB(1, 0), cB + kstep, voffB); PG8_STAGE(PG8_SA(1, 0), cA + kstep, voffA); PG8_STAGE(PG8_SB(1, 1), cB + hstepB + kstep, voffB);
        PG8_WAIT_V(6); PG8_BAR;
    } else {
        PG8_STAGE(PG8_SB(0, 0), cB, voffB); PG8_STAGE(PG8_SA(0, 0), cA, voffA); PG8_STAGE(PG8_SB(0, 1), cB + hstepB, voffB); PG8_STAGE(PG8_SA(0, 1), cA + hstepA, voffA);
        if (wr == 1) PG8_BAR;
        PG8_WAIT_V(4); PG8_BAR;
        PG8_STAGE(PG8_SB(1, 0), cB + kstep, voffB); PG8_STAGE(PG8_SA(1, 0), cA + kstep, voffA); PG8_STAGE(PG8_SB(1, 1), cB + hstepB + kstep, voffB);
        PG8_WAIT_V(6); PG8_BAR;
    }
    for (;;) {
        const bool has_next = S.next(ui + 1, nxt);
        const char* nA = has_next ? (const char*)g.A + (size_t)nxt.pm * tstepA : cA; const char* nB = has_next ? (const char*)g.Bt + (size_t)nxt.pn * tstepB : cB;
        for (int t = 0; t < nt; t += 2) {
            const bool last = (t == nt - 2);
            const char* a1 = cA + (size_t)(t + 1) * kstep;
            const char* a2 = last ? nA : cA + (size_t)(t + 2) * kstep; const char* b2 = last ? nB : cB + (size_t)(t + 2) * kstep;
            const char* a3 = a2 + kstep; const char* b3 = b2 + kstep;
            if (last && has_next) S.a_ready(nxt);
            if constexpr (SP2) {
            PG8_LDB(B0, 0, 0); PG8_LDB(B1, 0, 1); PG8_SCHED; PG8_LDA(At, 0, 0); PG8_STAGE(PG8_SA(1, 1), a1 + hstepA, voffA);
            PG8_WAIT_V(8); PG8_WAIT_L(0); PG8_BAR; PG8_MMA(0, 0, At, B0); PG8_MMA(0, 1, At, B1); PG8_BAR; PG8_SCHED;
            PG8_LDA(At, 0, 1); PG8_STAGE(PG8_SB(0, 0), b2, voffB); PG8_STAGE(PG8_SB(0, 1), b2 + hstepB, voffB); PG8_STAGE(PG8_SA(0, 0), a2, voffA);
            PG8_WAIT_V(8); PG8_WAIT_L(0); PG8_BAR; PG8_MMA(1, 0, At, B0); PG8_MMA(1, 1, At, B1); PG8_BAR; PG8_SCHED;
            PG8_LDB(B0, 1, 0); PG8_LDB(B1, 1, 1); PG8_SCHED; PG8_LDA(At, 1, 0); PG8_STAGE(PG8_SA(0, 1), a2 + hstepA, voffA);
            PG8_WAIT_V(8); PG8_WAIT_L(0); PG8_BAR; PG8_MMA(0, 0, At, B0); PG8_MMA(0, 1, At, B1); PG8_BAR; PG8_SCHED;
            PG8_LDA(At, 1, 1); PG8_STAGE(PG8_SB(1, 0), b3, voffB); PG8_STAGE(PG8_SB(1, 1), b3 + hstepB, voffB); PG8_STAGE(PG8_SA(1, 0), a3, voffA);
            PG8_WAIT_V(8); PG8_WAIT_L(0); PG8_BAR; PG8_MMA(1, 0, At, B0); PG8_MMA(1, 1, At, B1); PG8_BAR; PG8_SCHED;
            } else {
            PG8_LDB(B0, 0, 0); PG8_SCHED; PG8_LDA(At, 0, 0); PG8_STAGE(PG8_SA(1, 1), a1 + hstepA, voffA);
            PG8_WAIT_L(8); PG8_BAR; PG8_WAIT_L(0); PG8_MMA(0, 0, At, B0); PG8_BAR; PG8_SCHED;
            PG8_LDB(B1, 0, 1); PG8_STAGE(PG8_SB(0, 0), b2, voffB);
            PG8_BAR; PG8_WAIT_L(0); PG8_MMA(0, 1, At, B1); PG8_BAR;
            PG8_LDA(At, 0, 1); PG8_STAGE(PG8_SA(0, 0), a2, voffA);
            PG8_BAR; PG8_WAIT_L(0); PG8_MMA(1, 0, At, B0); PG8_BAR; PG8_SCHED;
            PG8_STAGE(PG8_SB(0, 1), b2 + hstepB, voffB);
            PG8_WAIT_V(6); PG8_BAR; PG8_MMA(1, 1, At, B1); PG8_BAR;
            PG8_LDB(B0, 1, 0); PG8_SCHED; PG8_LDA(At, 1, 0); PG8_STAGE(PG8_SA(0, 1), a2 + hstepA, voffA);
            PG8_WAIT_L(8); PG8_BAR; PG8_WAIT_L(0); PG8_MMA(0, 0, At, B0); PG8_BAR; PG8_SCHED;
            PG8_LDB(B1, 1, 1); PG8_STAGE(PG8_SB(1, 0), b3, voffB);
            PG8_BAR; PG8_WAIT_L(0); PG8_MMA(0, 1, At, B1); PG8_BAR;
            PG8_LDA(At, 1, 1); PG8_STAGE(PG8_SA(1, 0), a3, voffA);
            PG8_BAR; PG8_WAIT_L(0); PG8_MMA(1, 0, At, B0); PG8_BAR; PG8_SCHED;
            PG8_STAGE(PG8_SB(1, 1), b3 + hstepB, voffB);
            PG8_WAIT_V(6); PG8_BAR; PG8_MMA(1, 1, At, B1); PG8_BAR;
            }
        }
        if constexpr (ALIGN_EPI) { if (wr == 0) PG8_BAR; }
        if constexpr (!Epi::AFTER_DRAIN) { E(acc, cur, wr, wc, fr, fq); S.done(cur); }
        if (!has_next) break;
#pragma unroll
        for (int a = 0; a < 2; ++a)
#pragma unroll
            for (int b = 0; b < 2; ++b)
#pragma unroll
                for (int m = 0; m < 4; ++m)
#pragma unroll
                    for (int n = 0; n < 2; ++n) acc[a][b][m][n] = (f32x4){0.f, 0.f, 0.f, 0.f};
        cur = nxt; cA = nA; cB = nB; ++ui;
        if constexpr (ALIGN_EPI) { if (wr == 1) PG8_BAR; }
    }
    PG8_WAIT_V(0);
    if constexpr (!ALIGN_EPI) { if (wr == 0) PG8_BAR; }
    PG8_BAR;
    if constexpr (Epi::AFTER_DRAIN) { E.fused(acc, cur, wr, wc, fr, fq, lds, wid, lane); S.done(cur); }
#undef PG8_SA
#undef PG8_SB
#undef PG8_STAGE
#undef PG8_LDA
#undef PG8_LDB
#undef PG8_MMA
#undef PG8_WAIT_V
#undef PG8_WAIT_L
#undef PG8_BAR
#undef PG8_SCHED
}
}

typedef unsigned short bf16;
typedef unsigned v4u __attribute__((ext_vector_type(4)));
typedef unsigned v2u __attribute__((ext_vector_type(2)));
typedef float f32x4 __attribute__((ext_vector_type(4)));
typedef short bf16x8 __attribute__((ext_vector_type(8)));

constexpr int D = 1024, MP = 16384, MS = 1024, M = MP + MS, SEQL = 2048, NBATCH = 8, DBATCH = 128;
constexpr int NPROJ = 3072, FF = 2816, NGU = 5632, DIN = 3080, MH = M / 2;
constexpr float EPS = 1e-6f;
constexpr int NTHREADS = 512, NWAVES = 8;
constexpr int LDS_BYTES = 155648;
constexpr size_t MiB = 1u << 20;
constexpr size_t WS_WOUT = 0, WS_WGU = 4 * MiB, WS_WDN = 26 * MiB, WS_XA = 37 * MiB, WS_PROJ = 71 * MiB, WS_GU = 105 * MiB, WS_SCR = 173 * MiB, WS_WIN = 239 * MiB;
constexpr size_t WS_GB = 245 * MiB, WS_SSQ = 245 * MiB + 576 * 1024, WS_WAB = 246 * MiB, WS_GL = 246 * MiB + 64 * 1024, WS_HALO = 246 * MiB + 128 * 1024, WS_BAR = 246 * MiB + 192 * 1024, WS_END = 247 * MiB;
constexpr int SCR_ITEM = 73728;
constexpr size_t O_PDELTA = 17825792, O_PDCONV = 18874368, O_PPOOL = 18948096, O_PSCONV = 19009536, O_PFFN = 19017728;
constexpr size_t O_SDELTA = 19107840, O_SDCONV = 35885056, O_SPOOL = 37064704, O_SSCONV = 38047744, O_SFFN = 38178816, O_TOTAL = 39620608;

struct Params { const float* in[23]; float* out; unsigned char* ws; };
typedef const __attribute__((address_space(4))) Params* KP;
__device__ __forceinline__ KP kparams() { KP p = (KP)__builtin_amdgcn_kernarg_segment_ptr(); asm volatile("" : "+s"(p)); return p; }

#define LAUNDER(p) asm volatile("" : "+s"(p))
#define LDS_WAIT() asm volatile("s_waitcnt lgkmcnt(0)" ::: "memory")
__device__ __forceinline__ unsigned f2bf(float f) { unsigned u = __builtin_bit_cast(unsigned, f); return (u + 0x7fffu + ((u >> 16) & 1u)) >> 16; }
__device__ __forceinline__ unsigned pk2(float lo, float hi) { return f2bf(lo) | (f2bf(hi) << 16); }
__device__ __forceinline__ float bflo(unsigned u) { return __builtin_bit_cast(float, u << 16); }
__device__ __forceinline__ float bfhi(unsigned u) { return __builtin_bit_cast(float, u & 0xffff0000u); }
__device__ __forceinline__ float bf1(bf16 h) { return __builtin_bit_cast(float, ((unsigned)h) << 16); }
__device__ __forceinline__ float siluf(float x) { return x * __builtin_amdgcn_rcpf(1.f + __expf(-x)); }
__device__ __forceinline__ float wave_sum(float v) {
#pragma unroll
    for (int o = 1; o < 64; o <<= 1) v += __shfl_xor(v, o);
    return v;
}
#define UNPACK8(W_, F_) do { (F_)[0] = bflo((W_).x); (F_)[1] = bfhi((W_).x); (F_)[2] = bflo((W_).y); (F_)[3] = bfhi((W_).y); (F_)[4] = bflo((W_).z); (F_)[5] = bfhi((W_).z); (F_)[6] = bflo((W_).w); (F_)[7] = bfhi((W_).w); } while (0)
#define PACK8(F_) ((v4u){pk2((F_)[0], (F_)[1]), pk2((F_)[2], (F_)[3]), pk2((F_)[4], (F_)[5]), pk2((F_)[6], (F_)[7])})

struct EpiScale {
    static constexpr bool PERM = true, AFTER_DRAIN = false;
    bf16* O; int ldc; const float* ssq;
    __device__ __forceinline__ void operator()(const pg8::f32x4 (&acc)[2][2][4][2], const pg8::Unit& u, int wr, int wc, int fr, int fq) const {
        const int row0 = u.pm * 256 + wr * 64 + fr, col0 = u.pn * 256 + wc * 32 + 8 * fq;
#pragma unroll
        for (int ai = 0; ai < 2; ++ai)
#pragma unroll
            for (int m = 0; m < 4; ++m) {
                const int row = row0 + ai * 128 + m * 16;
                const float rs = rsqrtf(ssq[row] * (1.f / D) + EPS);
                bf16* rowp = O + (size_t)row * ldc + col0;
#pragma unroll
                for (int bj = 0; bj < 2; ++bj) {
                    pg8::f32x4 v0 = acc[ai][bj][m][0] * rs, v1 = acc[ai][bj][m][1] * rs;
                    v4u w; w.x = pk2(v0[0], v0[1]); w.y = pk2(v0[2], v0[3]); w.z = pk2(v1[0], v1[1]); w.w = pk2(v1[2], v1[3]);
                    *(v4u*)(rowp + bj * 128) = w;
                }
            }
    }
};
struct EpiResid {
    static constexpr bool PERM = true, AFTER_DRAIN = false;
    const float* xa; const float* xb_; float* xres; bf16* xb16; float* ssq; int rowbase;
    __device__ __forceinline__ void operator()(const pg8::f32x4 (&acc)[2][2][4][2], const pg8::Unit& u, int wr, int wc, int fr, int fq) const {
        const int row0 = rowbase + u.pm * 256 + wr * 64 + fr, col0 = u.pn * 256 + wc * 32 + 8 * fq;
#pragma unroll
        for (int ai = 0; ai < 2; ++ai)
#pragma unroll
            for (int m = 0; m < 4; ++m) {
                const int row = row0 + ai * 128 + m * 16;
                const float* xo = (row < MP ? xa + (size_t)row * D : xb_ + (size_t)(row - MP) * D) + col0;
                float* xr = xres + (size_t)row * D + col0;
                bf16* xh = xb16 + (size_t)row * D + col0;
                float ss = 0.f;
#pragma unroll
                for (int bj = 0; bj < 2; ++bj) {
                    const pg8::f32x4 o0 = *(const pg8::f32x4*)(xo + bj * 128), o1 = *(const pg8::f32x4*)(xo + bj * 128 + 4);
                    pg8::f32x4 v0 = acc[ai][bj][m][0] + o0, v1 = acc[ai][bj][m][1] + o1;
                    *(pg8::f32x4*)(xr + bj * 128) = v0; *(pg8::f32x4*)(xr + bj * 128 + 4) = v1;
                    v4u w; w.x = pk2(v0[0], v0[1]); w.y = pk2(v0[2], v0[3]); w.z = pk2(v1[0], v1[1]); w.w = pk2(v1[2], v1[3]);
                    *(v4u*)(xh + bj * 128) = w;
                    ss += v0[0] * v0[0] + v0[1] * v0[1] + v0[2] * v0[2] + v0[3] * v0[3] + v1[0] * v1[0] + v1[1] * v1[1] + v1[2] * v1[2] + v1[3] * v1[3];
                }
                ss += __shfl_xor(ss, 16); ss += __shfl_xor(ss, 32);
                if (fq == 0) atomicAdd(ssq + row, ss);
            }
    }
};

__device__ __forceinline__ void transpose_item(const float* W, int K, int ldw, int src_col0, const float* g, bf16* WT, int dst_row0, float* scr, int kb, int lane) {
    const int k0 = 64 * kb;
#pragma unroll 8
    for (int i = 0; i < 32; ++i) { const int kk = 2 * i + (lane >> 5); const float gs = g ? g[k0 + kk] : 1.f;
        scr[kk * 33 + (lane & 31)] = W[(size_t)(k0 + kk) * ldw + src_col0 + (lane & 31)] * gs; }
    LDS_WAIT();
    const int c = lane & 7;
#pragma unroll
    for (int j = 0; j < 4; ++j) { const int n = (lane >> 3) + 8 * j; const float* s = scr + (8 * c) * 33 + n;
        v4u o; o.x = pk2(s[0 * 33], s[1 * 33]); o.y = pk2(s[2 * 33], s[3 * 33]); o.z = pk2(s[4 * 33], s[5 * 33]); o.w = pk2(s[6 * 33], s[7 * 33]);
        *(v4u*)(WT + (size_t)(dst_row0 + n) * K + k0 + 8 * c) = o; }
    LDS_WAIT();
}
__device__ __forceinline__ void convert_matrix(const float* W, int K, int N, int ldw, int skip_from, int skip, const float* g, bf16* WT, int dst_row0, float* scr, int gw, int ngw, int lane) {
    const int nnb = N / 32, nit = (K / 64) * nnb;
    for (int it = gw; it < nit; it += ngw) {
        const int kb = it / nnb, nb = it % nnb, n0 = nb * 32;
        transpose_item(W, K, ldw, n0 + (n0 >= skip_from ? skip : 0), g, WT, dst_row0 + n0, scr, kb, lane);
    }
}
__device__ __forceinline__ void convert_layer_rest(KP P, int l, float* scr, int gw, int ngw, int lane) {
    unsigned char* ws = P->ws;
    convert_matrix(P->in[16] + (size_t)l * D * D, D, D, D, 1 << 30, 0, nullptr, (bf16*)(ws + WS_WOUT) + (size_t)l * D * D, 0, scr, gw, ngw, lane);
    convert_matrix(P->in[18] + (size_t)l * D * FF, D, FF, FF, 1 << 30, 0, P->in[17] + l * D, (bf16*)(ws + WS_WGU) + (size_t)l * NGU * D, 0, scr, gw, ngw, lane);
    convert_matrix(P->in[20] + (size_t)l * D * FF, D, FF, FF, 1 << 30, 0, P->in[17] + l * D, (bf16*)(ws + WS_WGU) + (size_t)l * NGU * D, FF, scr, gw, ngw, lane);
    convert_matrix(P->in[21] + (size_t)l * FF * D, FF, D, D, 1 << 30, 0, nullptr, (bf16*)(ws + WS_WDN) + (size_t)l * D * FF, 0, scr, gw, ngw, lane);
}
__device__ __forceinline__ void convert_win(KP P, int l, float* scr, int gw, int ngw, int lane) {
    convert_matrix(P->in[8] + (size_t)l * D * DIN, D, NPROJ, DIN, 2048, 8, P->in[7] + l * D, (bf16*)(P->ws + WS_WIN), 0, scr, gw, ngw, lane);
}

constexpr int B_QF = 0, B_KF = 33792, B_VF = 67584, B_AT = 101376, B_GC = 118784, B_QKS = 120320, B_WST = 128512;
__device__ __forceinline__ void p2b_item(KP P, int l, int item, unsigned char* lds, int wave_in) {
    const int tid = fresh_tid(wave_in);
    const int h = item & 3, n = (item >> 2) & 31, b = item >> 7;
    const int lane = tid & 63, wv = __builtin_amdgcn_readfirstlane(tid >> 6), fr = lane & 15, fq = lane >> 4;
    float* QF = (float*)(lds + B_QF); float* KF = (float*)(lds + B_KF); float* VF = (float*)(lds + B_VF); float* AT = (float*)(lds + B_AT);
    float* Gs = (float*)(lds + B_GC); float* BETA = Gs + 64; float* GC = Gs + 128; float* EG = Gs + 192; float* EKD = Gs + 256;
    bf16* QKS = (bf16*)(lds + B_QKS); bf16* WST = (bf16*)(lds + B_WST);
    const bf16* PROJ = (const bf16*)(P->ws + WS_PROJ);
    const float* GB = (const float*)(P->ws + WS_GB);
    unsigned char* scr = P->ws + WS_SCR + (size_t)item * SCR_ITEM;
    if (tid < 384) {
        const int chunk = tid % 48, tg = tid / 48, part = chunk >> 4, cc = chunk & 15;
        const int col = part * 512 + h * 128 + cc * 8;
        const float* cw = P->in[9] + (size_t)(l * 4) * 1536 + col;
        float w0[8], w1[8], w2[8], w3[8];
#pragma unroll
        for (int e = 0; e < 8; ++e) { w0[e] = cw[e]; w1[e] = cw[1536 + e]; w2[e] = cw[2 * 1536 + e]; w3[e] = cw[3 * 1536 + e]; }
        const int t0 = n * 64 + tg * 8;
        const bf16* base = PROJ + (size_t)(b * SEQL) * NPROJ + col;
        float r0[8], r1[8], r2[8], r3[8];
#pragma unroll
        for (int e = 0; e < 8; ++e) { r0[e] = 0.f; r1[e] = 0.f; r2[e] = 0.f; }
        if (t0 - 3 >= 0) { const v4u w = *(const v4u*)(base + (size_t)(t0 - 3) * NPROJ); UNPACK8(w, r0); }
        if (t0 - 2 >= 0) { const v4u w = *(const v4u*)(base + (size_t)(t0 - 2) * NPROJ); UNPACK8(w, r1); }
        if (t0 - 1 >= 0) { const v4u w = *(const v4u*)(base + (size_t)(t0 - 1) * NPROJ); UNPACK8(w, r2); }
        float* dst = (float*)(lds + part * 33792) + cc * 8;
#pragma unroll
        for (int i = 0; i < 8; ++i) {
            const v4u w = *(const v4u*)(base + (size_t)(t0 + i) * NPROJ); UNPACK8(w, r3);
            float s[8];
#pragma unroll
            for (int e = 0; e < 8; ++e) { const float cv = w0[e] * r0[e] + w1[e] * r1[e] + w2[e] * r2[e] + w3[e] * r3[e]; s[e] = siluf(cv); }
            float* d = dst + (tg * 8 + i) * 132;
            *(f32x4*)d = (f32x4){s[0], s[1], s[2], s[3]}; *(f32x4*)(d + 4) = (f32x4){s[4], s[5], s[6], s[7]};
#pragma unroll
            for (int e = 0; e < 8; ++e) { r0[e] = r1[e]; r1[e] = r2[e]; r2[e] = r3[e]; }
        }
    }
    if (tid < 64) { const int row = b * SEQL + n * 64 + tid; Gs[tid] = GB[(size_t)row * 8 + h]; BETA[tid] = GB[(size_t)row * 8 + 4 + h]; }
    __syncthreads();
    {
        const int tok = tid >> 3, sub = tid & 7;
        float* qr = QF + tok * 132 + sub * 16; float* kr = KF + tok * 132 + sub * 16;
        float qv[16], kv[16]; float sq = 0.f, sk = 0.f;
#pragma unroll
        for (int e = 0; e < 16; ++e) { qv[e] = qr[e]; kv[e] = kr[e]; sq += qv[e] * qv[e]; sk += kv[e] * kv[e]; }
        sq += __shfl_xor(sq, 1); sq += __shfl_xor(sq, 2); sq += __shfl_xor(sq, 4);
        sk += __shfl_xor(sk, 1); sk += __shfl_xor(sk, 2); sk += __shfl_xor(sk, 4);
        const float rq = rsqrtf(sq + EPS) * 0.08838834764831845f, rk = rsqrtf(sk + EPS);
#pragma unroll
        for (int e = 0; e < 16; ++e) { qr[e] = qv[e] * rq; kr[e] = kv[e] * rk; }
    }
    if (tid < 64) {
        float v = Gs[tid];
#pragma unroll
        for (int o = 1; o < 64; o <<= 1) { const float t = __shfl_up(v, o); if (tid >= o) v += t; }
        const float tot = __shfl(v, 63);
        GC[tid] = v; EG[tid] = __expf(v); EKD[tid] = __expf(tot - v);
        if (tid == 0) ((float*)(P->ws + WS_GL))[item] = __expf(tot);
    }
    __syncthreads();
    {
        const int p = wv >> 2, mt = wv & 3;
        const float* X = p ? QF : KF;
        f32x4 acc[4];
#pragma unroll
        for (int nt = 0; nt < 4; ++nt) acc[nt] = (f32x4){0.f, 0.f, 0.f, 0.f};
        const float* xa = X + (mt * 16 + fr) * 132 + fq; const float* kb_ = KF + fr * 132 + fq;
#pragma unroll 8
        for (int k = 0; k < 128; k += 4) {
            const float a = xa[k];
#pragma unroll
            for (int nt = 0; nt < 4; ++nt) acc[nt] = __builtin_amdgcn_mfma_f32_16x16x4f32(a, kb_[nt * 16 * 132 + k], acc[nt], 0, 0, 0);
        }
#pragma unroll
        for (int nt = 0; nt < 4; ++nt) {
            const int j = nt * 16 + fr; const float gj = GC[j];
            float v[4];
#pragma unroll
            for (int r = 0; r < 4; ++r) {
                const int i = mt * 16 + 4 * fq + r;
                if (p == 0) v[r] = (i > j) ? BETA[i] * acc[nt][r] * __expf(GC[i] - gj) : 0.f;
                else        v[r] = (i >= j) ? acc[nt][r] * __expf(GC[i] - gj) : 0.f;
            }
            if (p == 0) *(f32x4*)(AT + j * 68 + mt * 16 + 4 * fq) = (f32x4){v[0], v[1], v[2], v[3]};
            else {
#pragma unroll
                for (int r = 0; r < 4; ++r) QKS[(mt * 16 + 4 * fq + r) * 64 + j] = (bf16)f2bf(v[r]);
            }
        }
    }
    __syncthreads();
    if (tid < 256) {
        float x[64];
        int zo = 0; asm volatile("" : "+v"(zo));
        const float* ATz = AT + zo; const float* BETAz = BETA + zo; const float* EGz = EG + zo;
        if (tid < 128) {
#pragma unroll
            for (int i = 0; i < 64; ++i) x[i] = BETAz[i] * VF[i * 132 + tid];
        } else {
#pragma unroll
            for (int i = 0; i < 64; ++i) x[i] = BETAz[i] * EGz[i] * KF[i * 132 + tid - 128];
        }
        f32x4 ab[16];
#pragma unroll
        for (int q = 0; q < 16; ++q) ab[q] = *(const f32x4*)(ATz + q * 4);
#pragma unroll
        for (int j = 0; j < 63; ++j) {
            const float xj = x[j];
#pragma unroll
            for (int q = (j + 1) / 4; q < 16; ++q) {
#pragma unroll
                for (int e = 0; e < 4; ++e) if (4 * q + e > j) x[4 * q + e] -= ab[q][e] * xj;
                if (j + 1 < 63 && q >= (j + 2) / 4) ab[q] = *(const f32x4*)(ATz + (j + 1) * 68 + q * 4);
                __builtin_amdgcn_sched_barrier(0);
            }
        }
        if (tid < 128) {
            unsigned char* up = scr + 49152 + tid * 128;
#pragma unroll
            for (int q = 0; q < 8; ++q) *(v4u*)(up + q * 16) = PACK8(x + 8 * q);
        } else {
            const int dk = tid - 128;
#pragma unroll
            for (int i = 0; i < 64; ++i) WST[i * 128 + dk] = (bf16)f2bf(-x[i]);
        }
    } else {
        const int t2 = tid - 256;
        {
            const int tok = t2 >> 2, seg = t2 & 3; const float eg = EG[tok]; const float* s = QF + tok * 132 + seg * 32;
            unsigned char* o = scr + 16384 + tok * 256 + seg * 64;
#pragma unroll
            for (int q = 0; q < 4; ++q) { float f[8];
#pragma unroll
                for (int e = 0; e < 8; ++e) f[e] = s[q * 8 + e] * eg;
                *(v4u*)(o + q * 16) = PACK8(f); }
        }
        {
            const int dk = t2 >> 1, hf = t2 & 1; unsigned char* o = scr + 32768 + dk * 128 + hf * 64;
#pragma unroll
            for (int q = 0; q < 4; ++q) { float f[8];
#pragma unroll
                for (int e = 0; e < 8; ++e) { const int tok = hf * 32 + q * 8 + e; f[e] = KF[tok * 132 + dk] * EKD[tok]; }
                *(v4u*)(o + q * 16) = PACK8(f); }
        }
#pragma unroll
        for (int q = 0; q < 2; ++q) { const int c = t2 + 256 * q; *(v4u*)(scr + 65536 + c * 16) = *(const v4u*)((const unsigned char*)QKS + c * 16); }
    }
    __syncthreads();
#pragma unroll
    for (int q = 0; q < 2; ++q) { const int c = tid + 512 * q; *(v4u*)(scr + c * 16) = *(const v4u*)((const unsigned char*)WST + c * 16); }
    __syncthreads();
}

constexpr int S_ST = 0, S_VNT = 34816, S_OPW = 53248, S_OPQG = 70656, S_OPKD = 88064, S_OPQK = 106496, S_OPU = 115712;
__device__ __forceinline__ void scan_load(v4u (&pre)[9], const unsigned char* src, int tid) {
#pragma unroll
    for (int i = 0; i < 9; ++i) pre[i] = *(const v4u*)(src + (size_t)(tid + 512 * i) * 16);
}
__device__ __forceinline__ void scan_chunk(v4u (&pre)[9], f32x4 (&sacc)[8], unsigned char* lds, unsigned char* scrbase, int item, int n, float egl, int tid, int w, int fr, int fq) {
    __syncthreads();
#pragma unroll
    for (int i = 0; i < 9; ++i) {
        const int e = (tid + 512 * i) * 16 - (i >> 1) * 16384;
        if (i < 4) { const int row = e >> 8, cb = e & 255; *(v4u*)(lds + (i < 2 ? S_OPW : S_OPQG) + row * 272 + cb) = pre[i]; }
        else { const int row = e >> 7, cb = e & 127; *(v4u*)(lds + (i < 6 ? S_OPKD : (i < 8 ? S_OPU : S_OPQK)) + row * 144 + cb) = pre[i]; }
    }
    __syncthreads();
    if (n + 2 < 32) scan_load(pre, scrbase + (size_t)(item + 8) * SCR_ITEM, tid);
    bf16x8 sf[4];
#pragma unroll
    for (int ks = 0; ks < 4; ++ks) sf[ks] = *(const bf16x8*)(lds + S_ST + (16 * w + fr) * 272 + (ks * 32 + 8 * fq) * 2);
    f32x4 vt[4];
#pragma unroll
    for (int tt = 0; tt < 4; ++tt) { const v2u uu = *(const v2u*)(lds + S_OPU + (16 * w + fr) * 144 + (tt * 16 + 4 * fq) * 2);
        vt[tt] = (f32x4){bflo(uu.x), bfhi(uu.x), bflo(uu.y), bfhi(uu.y)}; }
#pragma unroll
    for (int ks = 0; ks < 4; ++ks)
#pragma unroll
        for (int tt = 0; tt < 4; ++tt) { const bf16x8 a = *(const bf16x8*)(lds + S_OPW + (tt * 16 + fr) * 272 + (ks * 32 + 8 * fq) * 2);
            vt[tt] = __builtin_amdgcn_mfma_f32_16x16x32_bf16(a, sf[ks], vt[tt], 0, 0, 0); }
#pragma unroll
    for (int tt = 0; tt < 4; ++tt) *(v2u*)(lds + S_VNT + (16 * w + fr) * 144 + (tt * 16 + 4 * fq) * 2) = (v2u){pk2(vt[tt][0], vt[tt][1]), pk2(vt[tt][2], vt[tt][3])};
    LDS_WAIT();
    bf16x8 vf[2];
#pragma unroll
    for (int js = 0; js < 2; ++js) vf[js] = *(const bf16x8*)(lds + S_VNT + (16 * w + fr) * 144 + (js * 32 + 8 * fq) * 2);
    f32x4 ot[4];
#pragma unroll
    for (int nt = 0; nt < 4; ++nt) ot[nt] = (f32x4){0.f, 0.f, 0.f, 0.f};
#pragma unroll
    for (int ks = 0; ks < 4; ++ks)
#pragma unroll
        for (int nt = 0; nt < 4; ++nt) { const bf16x8 bq = *(const bf16x8*)(lds + S_OPQG + (nt * 16 + fr) * 272 + (ks * 32 + 8 * fq) * 2);
            ot[nt] = __builtin_amdgcn_mfma_f32_16x16x32_bf16(sf[ks], bq, ot[nt], 0, 0, 0); }
#pragma unroll
    for (int js = 0; js < 2; ++js)
#pragma unroll
        for (int nt = 0; nt < 4; ++nt) { const bf16x8 bk = *(const bf16x8*)(lds + S_OPQK + (nt * 16 + fr) * 144 + (js * 32 + 8 * fq) * 2);
            ot[nt] = __builtin_amdgcn_mfma_f32_16x16x32_bf16(vf[js], bk, ot[nt], 0, 0, 0); }
    {
        float* oraw = (float*)(scrbase + (size_t)item * SCR_ITEM);
#pragma unroll
        for (int nt = 0; nt < 4; ++nt) *(f32x4*)(oraw + (nt * 16 + fr) * 128 + 16 * w + 4 * fq) = ot[nt];
    }
#pragma unroll
    for (int mt = 0; mt < 8; ++mt) {
        sacc[mt] = sacc[mt] * egl;
#pragma unroll
        for (int js = 0; js < 2; ++js) { const bf16x8 a = *(const bf16x8*)(lds + S_OPKD + (mt * 16 + fr) * 144 + (js * 32 + 8 * fq) * 2);
            sacc[mt] = __builtin_amdgcn_mfma_f32_16x16x32_bf16(a, vf[js], sacc[mt], 0, 0, 0); }
        *(v2u*)(lds + S_ST + (16 * w + fr) * 272 + (mt * 16 + 4 * fq) * 2) = (v2u){pk2(sacc[mt][0], sacc[mt][1]), pk2(sacc[mt][2], sacc[mt][3])};
    }
    LDS_WAIT();
}
__device__ __forceinline__ void scan_wg(KP P, int l, int bh, unsigned char* lds, int tid) {
    const int b = bh >> 2, h = bh & 3;
    const int lane = tid & 63, w = __builtin_amdgcn_readfirstlane(tid >> 6), fr = lane & 15, fq = lane >> 4;
    unsigned char* scrbase = P->ws + WS_SCR;
    f32x4 sacc[8];
#pragma unroll
    for (int mt = 0; mt < 8; ++mt) sacc[mt] = (f32x4){0.f, 0.f, 0.f, 0.f};
    { unsigned zz0 = 0u; asm volatile("" : "+v"(zz0)); for (int q = lane; q < 272; q += 64) *(v4u*)(lds + S_ST + (16 * w) * 272 + q * 16) = (v4u){zz0, zz0, zz0, zz0}; }
    const int item0 = (b * 32) * 4 + h;
    const float glv = ((const float*)(P->ws + WS_GL))[item0 + 4 * (lane & 31)];
    v4u preA[9], preB[9];
    scan_load(preA, scrbase + (size_t)item0 * SCR_ITEM, tid);
    scan_load(preB, scrbase + (size_t)(item0 + 4) * SCR_ITEM, tid);
#pragma unroll 1
    for (int n = 0; n < 32; n += 2) {
        scan_chunk(preA, sacc, lds, scrbase, item0 + 4 * n, n, __shfl(glv, n), tid, w, fr, fq);
        scan_chunk(preB, sacc, lds, scrbase, item0 + 4 * n + 4, n + 1, __shfl(glv, n + 1), tid, w, fr, fq);
    }
    float* pd = P->out + O_PDELTA + (size_t)((l * NBATCH + b) * 4 + h) * 16384;
#pragma unroll
    for (int mt = 0; mt < 8; ++mt)
#pragma unroll
        for (int r = 0; r < 4; ++r) pd[(mt * 16 + 4 * fq + r) * 128 + 16 * w + fr] = sacc[mt][r];
    __syncthreads();
}
__device__ __forceinline__ void p2d(KP P, int l, int gw, int ngw, int lane) {
    const bf16* PROJ = (const bf16*)(P->ws + WS_PROJ);
    bf16* OCAT = (bf16*)(P->ws + WS_XA);
    const float on0 = P->in[12][l * 128 + lane * 2], on1 = P->in[12][l * 128 + lane * 2 + 1];
    for (int pair = gw; pair < MP * 4; pair += ngw) {
        const int row = pair >> 2, h = pair & 3, b = row >> 11, t = row & 2047, n = t >> 6, tok = t & 63;
        const int item = (b * 32 + n) * 4 + h;
        const float* o = (const float*)(P->ws + WS_SCR + (size_t)item * SCR_ITEM) + tok * 128 + lane * 2;
        const float o0 = o[0], o1 = o[1];
        const unsigned zz = *(const unsigned*)(PROJ + (size_t)row * NPROJ + 1536 + h * 128 + lane * 2);
        const float rs = rsqrtf(wave_sum(o0 * o0 + o1 * o1) * (1.f / 128.f) + EPS);
        *(unsigned*)(OCAT + (size_t)row * D + h * 128 + lane * 2) = pk2(o0 * rs * on0 * siluf(bflo(zz)), o1 * rs * on1 * siluf(bfhi(zz)));
    }
}

__device__ __forceinline__ void sample_delta(KP P, int l, int it, unsigned char* lds, int wave_in) {
    const int tid = fresh_tid(wave_in);
    const int gq = tid >> 7, c = tid & 127, wv2 = (tid >> 6) & 1, lane = tid & 63;
    const int item = it * 4 + gq, sb = item >> 2, h = item & 3, rowbase = MP + sb * 8;
    float* QS = (float*)(lds + gq * 12288); float* KS = QS + 1024; float* VS = QS + 2048;
    float* RED2 = (float*)(lds + 49152);
    const bf16* PROJ = (const bf16*)(P->ws + WS_PROJ);
    const float* GB = (const float*)(P->ws + WS_GB);
    bf16* OCAT = (bf16*)(P->ws + WS_XA);
#pragma unroll
    for (int part = 0; part < 3; ++part) {
        const int col = part * 512 + h * 128 + c;
        const float* cw = P->in[9] + (size_t)(l * 4) * 1536 + col;
        const float w0 = cw[0], w1 = cw[1536], w2 = cw[2 * 1536], w3 = cw[3 * 1536];
        const float* hs = P->in[3] + (size_t)((l * DBATCH + sb) * 3) * 1536 + col;
        float r0 = hs[0], r1 = hs[1536], r2 = hs[2 * 1536];
        float* dst = QS + part * 1024 + c;
#pragma unroll
        for (int t = 0; t < 8; ++t) {
            const float x = bf1(PROJ[(size_t)(rowbase + t) * NPROJ + col]);
            dst[t * 128] = siluf(w0 * r0 + w1 * r1 + w2 * r2 + w3 * x);
            r0 = r1; r1 = r2; r2 = x;
        }
    }
#pragma unroll
    for (int t = 0; t < 8; ++t) {
        const float q = QS[t * 128 + c], k = KS[t * 128 + c];
        const float sq = wave_sum(q * q), sk = wave_sum(k * k);
        if (lane == 0) { RED2[(gq * 2 + wv2) * 16 + t] = sq; RED2[(gq * 2 + wv2) * 16 + 8 + t] = sk; }
    }
    __syncthreads();
#pragma unroll
    for (int t = 0; t < 8; ++t) {
        const float tq = RED2[(gq * 2) * 16 + t] + RED2[(gq * 2 + 1) * 16 + t], tk = RED2[(gq * 2) * 16 + 8 + t] + RED2[(gq * 2 + 1) * 16 + 8 + t];
        QS[t * 128 + c] *= rsqrtf(tq + EPS) * 0.08838834764831845f; KS[t * 128 + c] *= rsqrtf(tk + EPS);
    }
    __syncthreads();
    float s[128];
    {
        const float* S0 = P->in[2] + (size_t)((l * DBATCH + sb) * 4 + h) * 16384 + c;
#pragma unroll
        for (int d8 = 0; d8 < 16; ++d8) {
#pragma unroll
            for (int e = 0; e < 8; ++e) s[8 * d8 + e] = S0[e * 128];
            S0 += 8 * 128; asm volatile("" : "+v"(S0));
        }
    }
#pragma unroll 1
    for (int t = 0; t < 8; ++t) {
        const float g = GB[(size_t)(rowbase + t) * 8 + h], beta = GB[(size_t)(rowbase + t) * 8 + 4 + h], eg = __expf(g);
        const f32x4* kp = (const f32x4*)(KS + t * 128); const f32x4* qp = (const f32x4*)(QS + t * 128);
        float dot = 0.f;
#pragma unroll
        for (int d4 = 0; d4 < 32; ++d4) { const f32x4 kv = kp[d4]; dot += kv[0] * s[4 * d4] + kv[1] * s[4 * d4 + 1] + kv[2] * s[4 * d4 + 2] + kv[3] * s[4 * d4 + 3];
            if ((d4 & 3) == 3) asm volatile("" ::: "memory"); }
        const float cf = beta * (VS[t * 128 + c] - eg * dot);
        float o = 0.f;
#pragma unroll
        for (int d4 = 0; d4 < 32; ++d4) { const f32x4 kv = kp[d4], qv = qp[d4];
#pragma unroll
            for (int e = 0; e < 4; ++e) { s[4 * d4 + e] = eg * s[4 * d4 + e] + cf * kv[e]; o += qv[e] * s[4 * d4 + e]; }
            if ((d4 & 3) == 3) asm volatile("" ::: "memory"); }
        VS[t * 128 + c] = o;
    }
    {
        float* sd = P->out + O_SDELTA + (size_t)((l * DBATCH + sb) * 4 + h) * 16384 + c;
#pragma unroll
        for (int d8 = 0; d8 < 16; ++d8) {
#pragma unroll
            for (int e = 0; e < 8; ++e) sd[e * 128] = s[8 * d8 + e];
            sd += 8 * 128; asm volatile("" : "+v"(sd));
        }
    }
    __syncthreads();
#pragma unroll
    for (int t = 0; t < 8; ++t) { const float o = VS[t * 128 + c]; const float so = wave_sum(o * o); if (lane == 0) RED2[(gq * 2 + wv2) * 16 + t] = so; }
    __syncthreads();
    const float onv = P->in[12][l * 128 + c];
#pragma unroll
    for (int t = 0; t < 8; ++t) {
        const float tot = RED2[(gq * 2) * 16 + t] + RED2[(gq * 2 + 1) * 16 + t];
        const float z = bf1(PROJ[(size_t)(rowbase + t) * NPROJ + 1536 + h * 128 + c]);
        OCAT[(size_t)(rowbase + t) * D + h * 128 + c] = (bf16)f2bf(VS[t * 128 + c] * rsqrtf(tot * (1.f / 128.f) + EPS) * onv * siluf(z));
    }
    __syncthreads();
}

constexpr int PL_DT = 0, PL_PW = 69632;
__device__ __forceinline__ void pool_tile(KP P, int l, int tile, unsigned char* lds, int wave_in) {
    const int tid = fresh_tid(wave_in);
    float* DT = (float*)(lds + PL_DT); const float* PW = (const float*)(lds + PL_PW);
    const bf16* PROJ = (const bf16*)(P->ws + WS_PROJ);
    bf16* OCAT = (bf16*)(P->ws + WS_XA);
#pragma unroll 1
    for (int i = 0; i < 4; ++i) {
        const int idx = tid + 512 * i, tok = idx & 63, ch8 = idx >> 6, c0 = ch8 * 8, gi = ch8 >> 3, win = 2 << gi;
        int row, t, sb = 0; bool smp;
        if (tile < 256) { t = (tile & 31) * 64 + tok; row = (tile >> 5) * SEQL + t; smp = false; }
        else { sb = (tile - 256) * 8 + (tok >> 3); t = tok & 7; row = MP + sb * 8 + t; smp = true; }
        float ssum[8], cur[8];
#pragma unroll
        for (int e = 0; e < 8; ++e) { ssum[e] = 0.f; cur[e] = 0.f; }
        for (int j = 0; j < win; ++j) {
            const int tt = t - j; float f[8];
            if (tt >= 0) { const v4u w = *(const v4u*)(PROJ + (size_t)(row - j) * NPROJ + 2048 + c0); UNPACK8(w, f); }
            else if (smp) { const float* sp = P->in[4] + (size_t)((l * DBATCH + sb) * 15 + 15 + tt) * 256 + c0;
#pragma unroll
                for (int e = 0; e < 8; ++e) f[e] = sp[e]; }
            else {
#pragma unroll
                for (int e = 0; e < 8; ++e) f[e] = 0.f; }
#pragma unroll
            for (int e = 0; e < 8; ++e) { ssum[e] += f[e]; if (j == 0) cur[e] = f[e]; }
        }
        const float inv = 1.f / (float)(smp ? win : (t + 1 < win ? t + 1 : win));
#pragma unroll
        for (int e = 0; e < 8; ++e) DT[(c0 + e) * 68 + tok] = ssum[e] * inv - cur[e];
        float u0[8], u1[8], u2[8];
#pragma unroll
        for (int j = 0; j < 3; ++j) {
            const int tt = t - j; float f[8];
            if (tt >= 0) { const v4u wc = *(const v4u*)(PROJ + (size_t)(row - j) * NPROJ + 2816 + c0); const v4u wx = *(const v4u*)(PROJ + (size_t)(row - j) * NPROJ + 2304 + c0);
                float fc[8], fx[8]; UNPACK8(wc, fc); UNPACK8(wx, fx);
#pragma unroll
                for (int e = 0; e < 8; ++e) f[e] = fc[e] * fx[e]; }
            else if (smp) { const float* sp = P->in[5] + (size_t)((l * DBATCH + sb) * 2 + 2 + tt) * 256 + c0;
#pragma unroll
                for (int e = 0; e < 8; ++e) f[e] = sp[e]; }
            else {
#pragma unroll
                for (int e = 0; e < 8; ++e) f[e] = 0.f; }
#pragma unroll
            for (int e = 0; e < 8; ++e) { if (j == 0) u0[e] = f[e]; else if (j == 1) u1[e] = f[e]; else u2[e] = f[e]; }
        }
        const float* sw = P->in[15] + (size_t)(l * 3) * 256 + c0;
        const v4u wb = *(const v4u*)(PROJ + (size_t)row * NPROJ + 2560 + c0); float fb[8]; UNPACK8(wb, fb);
        float oc[8];
#pragma unroll
        for (int e = 0; e < 8; ++e) oc[e] = fb[e] * (sw[e] * u2[e] + sw[256 + e] * u1[e] + sw[512 + e] * u0[e]);
        *(v4u*)(OCAT + (size_t)row * D + 768 + c0) = PACK8(oc);
    }
    __syncthreads();
    {
        const int ep = tid & 255, g = ep >> 6, e = ep & 63, hf = tid >> 8;
        float acc[32];
#pragma unroll
        for (int q = 0; q < 32; ++q) acc[q] = 0.f;
#pragma unroll 2
        for (int c = 0; c < 64; ++c) {
            const float wgt = PW[(g * 64 + c) * 64 + e];
            const f32x4* dp = (const f32x4*)(DT + (g * 64 + c) * 68 + hf * 32);
#pragma unroll
            for (int q = 0; q < 8; ++q) { const f32x4 d = dp[q]; acc[4 * q] += d[0] * wgt; acc[4 * q + 1] += d[1] * wgt; acc[4 * q + 2] += d[2] * wgt; acc[4 * q + 3] += d[3] * wgt; }
        }
        const float sc = P->in[14][l * 256 + ep];
#pragma unroll
        for (int q = 0; q < 32; ++q) {
            const int tok = hf * 32 + q;
            const int row = tile < 256 ? (tile >> 5) * SEQL + (tile & 31) * 64 + tok : MP + (tile - 256) * 64 + tok;
            OCAT[(size_t)row * D + 512 + ep] = (bf16)f2bf(acc[q] * sc);
        }
    }
    __syncthreads();
}

__device__ __forceinline__ void state_copies(KP P, int l, int start, int stride) {
    const bf16* PROJ = (const bf16*)(P->ws + WS_PROJ);
    for (int i = start; i < 136 * 8960; i += stride) {
        const int seq = i / 8960, r = i % 8960;
        const bool smp = seq >= 8; const int sb = seq - 8;
        const int L = smp ? 8 : SEQL; const size_t row0 = smp ? (size_t)MP + sb * 8 : (size_t)seq * SEQL;
        if (r < 4608) {
            const int j = r / 1536, c = r % 1536;
            const float v = bf1(PROJ[(row0 + L - 3 + j) * NPROJ + c]);
            if (smp) P->out[O_SDCONV + (size_t)((l * DBATCH + sb) * 3 + j) * 1536 + c] = v; else P->out[O_PDCONV + (size_t)((l * NBATCH + seq) * 3 + j) * 1536 + c] = v;
        } else if (r < 4608 + 3840) {
            const int r2 = r - 4608, j = r2 / 256, c = r2 % 256;
            if (smp) { const float v = j < 7 ? P->in[4][(size_t)((l * DBATCH + sb) * 15 + 8 + j) * 256 + c] : bf1(PROJ[(row0 + j - 7) * NPROJ + 2048 + c]);
                P->out[O_SPOOL + (size_t)((l * DBATCH + sb) * 15 + j) * 256 + c] = v; }
            else P->out[O_PPOOL + (size_t)((l * NBATCH + seq) * 15 + j) * 256 + c] = bf1(PROJ[(row0 + L - 15 + j) * NPROJ + 2048 + c]);
        } else {
            const int r2 = r - 8448, j = r2 / 256, c = r2 % 256;
            const size_t row = row0 + L - 2 + j;
            const float v = bf1(PROJ[row * NPROJ + 2816 + c]) * bf1(PROJ[row * NPROJ + 2304 + c]);
            if (smp) P->out[O_SSCONV + (size_t)((l * DBATCH + sb) * 2 + j) * 256 + c] = v; else P->out[O_PSCONV + (size_t)((l * NBATCH + seq) * 2 + j) * 256 + c] = v;
        }
    }
}

__device__ __forceinline__ void p4b(KP P, int l, int hf, int start, int stride) {
    bf16* GU = (bf16*)(P->ws + WS_GU); bf16* HALO = (bf16*)(P->ws + WS_HALO);
    const float* cw = P->in[19] + (size_t)(l * 3) * FF;
    const int r0 = hf * MH;
    for (int idx = start; idx < MH * 352; idx += stride) {
        const int lr = idx / 352, c0 = (idx % 352) * 8, m = r0 + lr;
        int t, sb = 0; bool smp;
        if (m < MP) { t = m & (SEQL - 1); smp = false; } else { sb = (m - MP) >> 3; t = (m - MP) & 7; smp = true; }
        float g0[8], g1[8], g2[8];
#pragma unroll
        for (int j = 0; j < 3; ++j) {
            const int tt = t - j; float f[8];
            if (tt < 0) {
                if (smp) { const float* sp = P->in[6] + (size_t)((l * DBATCH + sb) * 2 + 2 + tt) * FF + c0;
#pragma unroll
                    for (int e = 0; e < 8; ++e) f[e] = sp[e]; }
                else {
#pragma unroll
                    for (int e = 0; e < 8; ++e) f[e] = 0.f; }
            } else {
                const v4u w = (lr - j < 0) ? *(const v4u*)(HALO + (size_t)(2 + lr - j) * FF + c0) : *(const v4u*)(GU + (size_t)(lr - j) * NGU + c0);
                UNPACK8(w, f);
            }
#pragma unroll
            for (int e = 0; e < 8; ++e) { if (j == 0) g0[e] = f[e]; else if (j == 1) g1[e] = f[e]; else g2[e] = f[e]; }
        }
        const v4u wu = *(const v4u*)(GU + (size_t)lr * NGU + FF + c0); float fu[8]; UNPACK8(wu, fu);
        float a[8];
#pragma unroll
        for (int e = 0; e < 8; ++e) a[e] = siluf(cw[c0 + e] * g2[e] + cw[FF + c0 + e] * g1[e] + cw[2 * FF + c0 + e] * g0[e]) * fu[e];
        *(v4u*)(GU + (size_t)lr * NGU + FF + c0) = PACK8(a);
        if (!smp && t >= SEQL - 2) { float* o = P->out + O_PFFN + (size_t)((l * NBATCH + (m >> 11)) * 2 + t - (SEQL - 2)) * FF + c0;
#pragma unroll
            for (int e = 0; e < 8; ++e) o[e] = g0[e]; }
        if (smp && t >= 6) { float* o = P->out + O_SFFN + (size_t)((l * DBATCH + sb) * 2 + t - 6) * FF + c0;
#pragma unroll
            for (int e = 0; e < 8; ++e) o[e] = g0[e]; }
        if (hf == 0 && lr >= MH - 2) *(v4u*)(HALO + (size_t)(lr - (MH - 2)) * FF + c0) = *(const v4u*)(GU + (size_t)lr * NGU + c0);
    }
}

#define LAS __attribute__((address_space(3)))
#define XB_TMO      128
#define XB_XCNT(j)  (256  + 64 * (j))
#define XB_XSUB(j)  (1280 + 64 * (j))
#define XB_XGEN(j)  (2304 + 64 * (j))
#define XB_TOP      3328
#define XB_TOPGEN   3392
#define XCD_BAR_WORDS 3456
#define XB_SPIN_CAP (1u << 18)

__device__ __forceinline__ unsigned xb_ld(unsigned* p)              { return __hip_atomic_load(p, __ATOMIC_RELAXED, __HIP_MEMORY_SCOPE_AGENT); }
__device__ __forceinline__ unsigned xb_add(unsigned* p, unsigned v) { return __hip_atomic_fetch_add(p, v, __ATOMIC_RELAXED, __HIP_MEMORY_SCOPE_AGENT); }
__device__ __forceinline__ unsigned xb_xcc_id() { return (unsigned)__builtin_amdgcn_s_getreg((3 << 11) | 20) & 0xFu; }
#define XB_SPIN(cond, bar) do { unsigned _sp = 0; while (cond) { __builtin_amdgcn_s_sleep(1); \
    if ((++_sp & 255u) == 0u) { if (xb_ld(&(bar)[XB_TMO])) break; if (_sp > XB_SPIN_CAP) { atomicAdd(&(bar)[XB_TMO], 1u); break; } } } } while (0)

struct XcdBarrier {
    unsigned* bar; unsigned x;
    volatile LAS unsigned* st;
    int wave;
};

__device__ __forceinline__ XcdBarrier xcd_barrier_post(unsigned* bar, volatile LAS unsigned* st) {
    XcdBarrier b; b.bar = bar; b.x = xb_xcc_id(); b.st = st; b.wave = 0;
    if (threadIdx.x == 0) (void)xb_add(&bar[XB_XCNT(b.x)], 1u);
    return b;
}
__device__ __forceinline__ void xcd_barrier_complete(unsigned* bar, unsigned x, unsigned& nloc, unsigned& nx) {
    const unsigned G = gridDim.x * gridDim.y * gridDim.z;
    unsigned sum, cnt, mine, sp = 0u;
    for (;;) {
        sum = 0u; cnt = 0u; mine = 0u;
#pragma unroll
        for (unsigned j = 0; j < 16; ++j) { const unsigned c = xb_ld(&bar[XB_XCNT(j)]); sum += c; cnt += (c > 0u) ? 1u : 0u; mine = (j == x) ? c : mine; }
        if (sum == G) break;
        __builtin_amdgcn_s_sleep(1);
        if ((++sp & 255u) == 0u) { if (xb_ld(&bar[XB_TMO])) break; if (sp > XB_SPIN_CAP) { atomicAdd(&bar[XB_TMO], 1u); break; } }
    }
    nloc = mine > 0u ? mine : 1u; nx = cnt > 0u ? cnt : 1u;
}

__device__ __forceinline__ void xcd_barrier(const XcdBarrier& b) {
    asm volatile("s_waitcnt vmcnt(0)" ::: "memory");
    __syncthreads();
    if (b.wave == 0 && lane_id() == 0) {
        unsigned* bar = b.bar;
        __builtin_amdgcn_s_waitcnt(0);
        unsigned nloc = b.st[0], nx = b.st[1];
        if (nloc == 0u) { xcd_barrier_complete(bar, b.x, nloc, nx); b.st[0] = nloc; b.st[1] = nx; }
        const unsigned old = xb_add(&bar[XB_XSUB(b.x)], 1u);
        const unsigned gen = old / nloc;
        if (old + 1u == (gen + 1u) * nloc) {
            __builtin_amdgcn_fence(__ATOMIC_RELEASE, "agent");
            asm volatile("s_waitcnt vmcnt(0)" ::: "memory");
            const unsigned og = xb_add(&bar[XB_TOP], 1u);
            const unsigned tg = og / nx;
            if (og + 1u == (tg + 1u) * nx) xb_add(&bar[XB_TOPGEN], 1u);
            else XB_SPIN(xb_ld(&bar[XB_TOPGEN]) == tg, bar);
            __builtin_amdgcn_fence(__ATOMIC_ACQUIRE, "agent");
            xb_add(&bar[XB_XGEN(b.x)], 1u);
            asm volatile("s_waitcnt vmcnt(0)" ::: "memory");
        } else {
            XB_SPIN(xb_ld(&bar[XB_XGEN(b.x)]) == gen, bar);
            __builtin_amdgcn_fence(__ATOMIC_ACQUIRE, "agent");
            asm volatile("s_waitcnt vmcnt(0)" ::: "memory");
        }
    }
    __syncthreads();
}

#define XSYNC1() do { XcdBarrier b_; b_.bar = (unsigned*)(kparams()->ws + WS_BAR); b_.x = xb_xcc_id(); b_.st = (volatile LAS unsigned*)((LAS unsigned char*)lds + (LDS_BYTES - 64)); b_.wave = wave; xcd_barrier(b_); } while (0)
#ifdef PROBE_SYNC2
#define GSYNC() do { XSYNC1(); XSYNC1(); } while (0)
#else
#define GSYNC() XSYNC1()
#endif
__global__ void __launch_bounds__(NTHREADS, 2) fwd_megakernel(Params Parg) {
    KP P = kparams();
    extern __shared__ __attribute__((aligned(16))) unsigned char lds[];
    cg::grid_group grid = cg::this_grid();
    const int wave = __builtin_amdgcn_readfirstlane((int)threadIdx.x >> 6);
    const int tid = fresh_tid(wave), lane = tid & 63;
    const int G = gridDim.x, bx = blockIdx.x;
    const int gw = bx * NWAVES + wave, ngw = G * NWAVES;
    const int gt = bx * NTHREADS + tid, ngt = G * NTHREADS;
    unsigned char* ws = P->ws;
    bf16* XA = (bf16*)(ws + WS_XA); bf16* XB2 = (bf16*)(ws + WS_PROJ); bf16* PROJ = (bf16*)(ws + WS_PROJ); bf16* GU = (bf16*)(ws + WS_GU);
    float* SSQ = (float*)(ws + WS_SSQ); float* GB = (float*)(ws + WS_GB); float* WAB = (float*)(ws + WS_WAB);
    float* XRES = P->out;
    float* wscr = (float*)(lds + wave * 16384);
    volatile LAS unsigned* xst = (volatile LAS unsigned*)((LAS unsigned char*)lds + (LDS_BYTES - 64));
    if (tid < 16) xst[tid] = 0u;
    __syncthreads();
    (void)xcd_barrier_post((unsigned*)(ws + WS_BAR), xst);

    for (int i = gt; i < 4 * M; i += ngt) SSQ[M + i] = 0.f;
    for (int i = gt; i < 2 * 8 * D; i += ngt) { const int l = i >> 13, j = (i >> 10) & 7, k = i & 1023; WAB[i] = P->in[7][l * D + k] * P->in[8][(size_t)l * D * DIN + (size_t)k * DIN + 2048 + j]; }
    convert_win(P, 0, wscr, gw, ngw, lane);
    convert_layer_rest(P, 0, wscr, gw, ngw, lane);
    convert_layer_rest(P, 1, wscr, gw, ngw, lane);
    for (int m = gw; m < M; m += ngw) {
        const float* xr = m < MP ? P->in[0] + (size_t)m * D : P->in[1] + (size_t)(m - MP) * D;
        float ss = 0.f;
#pragma unroll
        for (int j = 0; j < 4; ++j) { const f32x4 v = ((const f32x4*)xr)[lane + 64 * j]; ss += v[0] * v[0] + v[1] * v[1] + v[2] * v[2] + v[3] * v[3];
            ((v2u*)(XA + (size_t)m * D))[lane + 64 * j] = (v2u){pk2(v[0], v[1]), pk2(v[2], v[3])}; }
        ss = wave_sum(ss);
        if (lane == 0) SSQ[m] = ss;
    }
    grid.sync();

#pragma unroll 1
    for (int l = 0; l < 2; ++l) {
#ifndef NO_P1
        {
            const bf16* gA = XA; const bf16* gB = (const bf16*)(ws + WS_WIN); LAUNDER(gA); LAUNDER(gB);
            pg8::Gemm g{gA, gB, M, NPROJ, D, D}; pg8::StaticOrder S; S.init(M, NPROJ, G, bx);
            EpiScale E{PROJ, NPROJ, SSQ + (size_t)(2 * l) * M};
            pg8::gemm_phase<EpiScale, pg8::StaticOrder, true, true>((PG8_LAS unsigned char*)lds, g, S, E, wave);
        }
#endif
#ifndef NO_AB
        {
            const float* ssq = SSQ + (size_t)(2 * l) * M;
            const int tf = fresh_tid(wave), lane = tf & 63, gw = bx * NWAVES + __builtin_amdgcn_readfirstlane(tf >> 6);
            for (int m = gw; m < M; m += ngw) {
                const v4u* xr = (const v4u*)(XA + (size_t)m * D) + lane * 2;
                const v4u x0 = xr[0], x1 = xr[1]; float xf[16]; UNPACK8(x0, xf); UNPACK8(x1, xf + 8);
                float dot[8];
#pragma unroll
                for (int j = 0; j < 8; ++j) { const float* wp = WAB + (size_t)(l * 8 + j) * D + lane * 16; float s = 0.f;
#pragma unroll
                    for (int e = 0; e < 16; ++e) s += wp[e] * xf[e];
                    dot[j] = wave_sum(s); }
                float v = dot[0];
#pragma unroll
                for (int j = 1; j < 8; ++j) v = (lane == j) ? dot[j] : v;
                if (lane < 8) {
                    v *= rsqrtf(ssq[m] * (1.f / D) + EPS);
                    const int hh = lane & 3; float r;
                    if (lane < 4) { const float xx = v + P->in[11][l * 4 + hh]; const float sp = fmaxf(xx, 0.f) + __logf(1.f + __expf(-fabsf(xx))); r = -__expf(P->in[10][l * 4 + hh]) * sp; }
                    else r = __builtin_amdgcn_rcpf(1.f + __expf(-v));
                    GB[(size_t)m * 8 + lane] = r;
                }
            }
        }
#endif
        GSYNC();
#ifndef NO_P2B
        { const int tf = fresh_tid(wave); for (int item = bx; item < 1024; item += G) p2b_item(P, l, item, lds, wave); }
#ifdef PROBE_P2B2
        __syncthreads(); { const int tf = fresh_tid(wave); for (int item = bx; item < 1024; item += G) p2b_item(P, l, item, lds, wave); }
#endif
#endif
        GSYNC();
#ifdef PROBE_SCAN2
        if (bx < 32) { scan_wg(P, l, bx, lds, fresh_tid(wave)); }
#endif
#ifndef NO_SCAN
        if (bx < 32) scan_wg(P, l, bx, lds, fresh_tid(wave));
        else
#endif
        {
            const int vw = bx - 32, nm = G - 32; const int tid = fresh_tid(wave);
#ifndef NO_SAMPLE
            for (int it = nm - 1 - vw; it < 128; it += nm) sample_delta(P, l, it, lds, wave);
#endif
            for (int i = tid; i < 4096; i += NTHREADS) ((f32x4*)(lds + PL_PW))[i] = ((const f32x4*)(P->in[13] + (size_t)l * 16384))[i];
            __syncthreads();
#ifndef NO_POOL
            for (int tile = vw; tile < 272; tile += nm) pool_tile(P, l, tile, lds, wave);
#endif
            state_copies(P, l, vw * NTHREADS + tid, nm * NTHREADS);
        }
        GSYNC();
        { const int tf = fresh_tid(wave); p2d(P, l, bx * NWAVES + __builtin_amdgcn_readfirstlane(tf >> 6), ngw, tf & 63); }
        GSYNC();
#ifndef NO_P3
        {
            const bf16* gA = XA; const bf16* gB = (const bf16*)(ws + WS_WOUT) + (size_t)l * D * D; LAUNDER(gA); LAUNDER(gB);
            pg8::Gemm g{gA, gB, M, D, D, D}; pg8::StaticOrder S; S.init(M, D, G, bx);
            EpiResid E{l == 0 ? P->in[0] : XRES, l == 0 ? P->in[1] : XRES + (size_t)MP * D, XRES, XB2, SSQ + (size_t)(2 * l + 1) * M, 0};
            pg8::gemm_phase<EpiResid, pg8::StaticOrder, true, true>((PG8_LAS unsigned char*)lds, g, S, E, wave);
        }
#endif
        GSYNC();
#pragma unroll 1
        for (int hf = 0; hf < 2; ++hf) {
            const int r0 = hf * MH;
#ifndef NO_P4
            {
                const bf16* gA = XB2 + (size_t)r0 * D; const bf16* gB = (const bf16*)(ws + WS_WGU) + (size_t)l * NGU * D; LAUNDER(gA); LAUNDER(gB);
                pg8::Gemm g{gA, gB, MH, NGU, D, D}; pg8::StaticOrder S; S.init(MH, NGU, G, bx);
                EpiScale E{GU, NGU, SSQ + (size_t)(2 * l + 1) * M + r0};
                pg8::gemm_phase<EpiScale, pg8::StaticOrder, true, true>((PG8_LAS unsigned char*)lds, g, S, E, wave);
            }
#endif
            GSYNC();
#ifndef NO_P4B
            p4b(P, l, hf, bx * NTHREADS + fresh_tid(wave), ngt);
#endif
            if (l == 0 && hf == 0) { const int tf = fresh_tid(wave); const int wv = __builtin_amdgcn_readfirstlane(tf >> 6); convert_win(P, 1, (float*)(lds + wv * 16384), bx * NWAVES + wv, ngw, tf & 63); }
            GSYNC();
#ifndef NO_P5
            {
                const bf16* gA = GU + FF; const bf16* gB = (const bf16*)(ws + WS_WDN) + (size_t)l * D * FF; LAUNDER(gA); LAUNDER(gB);
                pg8::Gemm g{gA, gB, MH, D, FF, NGU}; pg8::StaticOrder S; S.init(MH, D, G, bx);
                EpiResid E{XRES, XRES + (size_t)MP * D, XRES, XA, SSQ + (size_t)(2 * l + 2) * M, r0};
                pg8::gemm_phase<EpiResid, pg8::StaticOrder, true, true>((PG8_LAS unsigned char*)lds, g, S, E, wave);
            }
#endif
            GSYNC();
        }
    }
    {
        const float* ssq = SSQ + (size_t)4 * M; const float* fn = P->in[22];
        const int gt = bx * NTHREADS + fresh_tid(wave);
        for (int i = gt; i < M * 256; i += ngt) {
            const int row = i >> 8, c4 = i & 255;
            const float rs = rsqrtf(ssq[row] * (1.f / D) + EPS);
            f32x4 v = ((f32x4*)XRES)[i]; const f32x4 gv = ((const f32x4*)fn)[c4];
            v[0] *= rs * gv[0]; v[1] *= rs * gv[1]; v[2] *= rs * gv[2]; v[3] *= rs * gv[3];
            ((f32x4*)XRES)[i] = v;
        }
    }
}

extern "C" void kernel_launch(void* const* d_in, const int* in_sizes, int n_in, void* d_out, int out_size, void* d_ws, size_t ws_size, hipStream_t stream) {
    static int grid = 0;
    if (grid == 0) {
        if (n_in != 23 || (size_t)out_size != O_TOTAL || ws_size < WS_END) { fprintf(stderr, "kernel_launch: unexpected shapes: n_in %d out %d ws %zu\n", n_in, out_size, ws_size); grid = -1; return; }
        int dev = 0, cus = 0, per_cu = 0;
        hipGetDevice(&dev); hipDeviceGetAttribute(&cus, hipDeviceAttributeMultiprocessorCount, dev);
        if (hipFuncSetAttribute((const void*)fwd_megakernel, hipFuncAttributeMaxDynamicSharedMemorySize, LDS_BYTES) != hipSuccess) { fprintf(stderr, "kernel_launch: hipFuncSetAttribute failed\n"); grid = -1; return; }
        hipOccupancyMaxActiveBlocksPerMultiprocessor(&per_cu, (const void*)fwd_megakernel, NTHREADS, LDS_BYTES);
        (void)hipGetLastError();
        if (per_cu < 1) fprintf(stderr, "kernel_launch: occupancy query reports %d blocks per CU\n", per_cu);
        grid = cus;
    }
    if (grid < 0) return;
    if (hipMemsetAsync((char*)d_ws + WS_BAR, 0, 16384, stream) != hipSuccess) { fprintf(stderr, "kernel_launch: memset failed\n"); return; }
    Params p{};
    for (int i = 0; i < 23; ++i) p.in[i] = (const float*)d_in[i];
    p.out = (float*)d_out; p.ws = (unsigned char*)d_ws;
    void* args[] = {&p};
    hipError_t e = hipLaunchCooperativeKernel((const void*)fwd_megakernel, dim3(grid), dim3(NTHREADS), args, LDS_BYTES, stream);
    if (e != hipSuccess) fprintf(stderr, "cooperative launch failed: %s (grid %d)\n", hipGetErrorString(e), grid);
}
```

```cpp
#include <hip/hip_runtime.h>
#include <hip/hip_cooperative_groups.h>
#include <cstdio>
#include <cstdint>
namespace cg = cooperative_groups;
__device__ __forceinline__ int lane_id() { int t; asm volatile("v_mbcnt_lo_u32_b32 %0, -1, 0\n\tv_mbcnt_hi_u32_b32 %0, -1, %0" : "=v"(t)); return t; }
__device__ __forceinline__ int fresh_tid(int wave) { return (wave << 6) | lane_id(); }
namespace pg8 {
#define PG8_LAS __attribute__((address_space(3)))
typedef unsigned short bf16_t;
typedef short bf16x8 __attribute__((ext_vector_type(8)));
typedef float f32x4 __attribute__((ext_vector_type(4)));
typedef unsigned u32x4 __attribute__((ext_vector_type(4)));
constexpr int BM = 256, BK = 64, HALF = 128, HTB = HALF * BK * 2  , STAGE_BYTES = 8 * HTB, NXCD = 8, WGM = 8;

__host__ __device__ __forceinline__ int lds_byte(int r, int c) { const int st = (r >> 4) * 2 + (c >> 5), rr = r & 15, cc = c & 31, ob = rr * 64 + cc * 2; return st * 1024 + (ob ^ (((ob >> 9) & 1) << 5)); }
__host__ __device__ __forceinline__ void stage_rc(int b, int& R, int& C) { const int st = b / 1024, sb = b % 1024, swz = sb ^ (((sb >> 9) & 1) << 5); R = (st >> 1) * 16 + swz / 64; C = (st & 1) * 32 + (swz % 64) / 2; }
__host__ __device__ __forceinline__ int perm32(int rho) { const int n = rho >> 4, i = rho & 15; return 8 * (i >> 2) + 4 * n + (i & 3); }

struct Unit { int pm, pn; };
struct Gemm { const bf16_t* A; const bf16_t* Bt; int M, N, K, lda; };

struct StaticOrder {
    int nM, nN, nwg, G, c;
    __host__ __device__ void init(int M, int N, int G_, int c_) { nM = M / BM; nN = N / BM; nwg = nM * nN; G = G_; c = c_; }
    __host__ __device__ bool next(int i, Unit& u) const {
        const long L = (long)i * G + c; if (L >= nwg) return false;
        int wgid = (int)L; { const int q = nwg / NXCD, r = nwg % NXCD, xcd = wgid % NXCD, off = wgid / NXCD; wgid = (xcd < r ? xcd * (q + 1) : r * (q + 1) + (xcd - r) * q) + off; }
        const int nig = WGM * nN, gid = wgid / nig, fm = gid * WGM, gsz = (nM - fm) < WGM ? (nM - fm) : WGM;
        u.pm = fm + ((wgid % nig) % gsz); u.pn = (wgid % nig) / gsz; return true;
    }
    __device__ __forceinline__ void a_ready(const Unit&) const {}
    __device__ __forceinline__ void done(const Unit&) const {}
};

template <class Epi, class Sched, bool ALIGN_EPI = false, bool SP2 = false>
__device__ __forceinline__ void gemm_phase(PG8_LAS unsigned char* lds, const Gemm g, const Sched& S, const Epi& E, const int wave_in) {
    const int tid = fresh_tid(wave_in), wid = __builtin_amdgcn_readfirstlane(tid >> 6), lane = tid & 63, wr = wid >> 2, wc = wid & 3, fr = lane & 15, fq = lane >> 4;
    const int K = g.K, nt = K / BK;
    unsigned voffA[2], voffB[2];
#pragma unroll
    for (int i = 0; i < 2; ++i) { int R, C; stage_rc(tid * 16 + i * 8192, R, C); const int Rb = Epi::PERM ? ((R & ~31) + perm32(R & 31)) : R;
        voffA[i] = (unsigned)(R * g.lda + C) * 2u; voffB[i] = (unsigned)(Rb * K + C) * 2u; }
    const size_t kstep = (size_t)(BK * 2);
    const size_t hstepA = (size_t)HALF * g.lda * 2, hstepB = (size_t)HALF * K * 2;
    const size_t tstepA = 2 * hstepA, tstepB = 2 * hstepB;
    const unsigned ldsw = (unsigned)wid * 1024u;
    const int aoff = lds_byte(wr * 64 + fr, fq * 8), boff = lds_byte(wc * 32 + fr, fq * 8);
#define PG8_SA(b, h) (((b) * 2 + (h)) * HTB)
#define PG8_SB(b, h) ((4 + (b) * 2 + (h)) * HTB)
#define PG8_STAGE(bufoff, gbase, voff) do { _Pragma("unroll") for (int _i = 0; _i < 2; ++_i) \
        __builtin_amdgcn_global_load_lds((const unsigned*)((const char*)(gbase) + (voff)[_i]), (PG8_LAS unsigned*)(lds + (bufoff) + ldsw + _i * 8192), 16, 0, 0); } while (0)
#define PG8_LDA(dst, b, h) do { _Pragma("unroll") for (int m = 0; m < 4; ++m) _Pragma("unroll") for (int k = 0; k < 2; ++k) dst[m][k] = *(const PG8_LAS bf16x8*)(lds + PG8_SA(b, h) + aoff + m * 2048 + k * 1024); } while (0)
#define PG8_LDB(dst, b, h) do { _Pragma("unroll") for (int n = 0; n < 2; ++n) _Pragma("unroll") for (int k = 0; k < 2; ++k) dst[n][k] = *(const PG8_LAS bf16x8*)(lds + PG8_SB(b, h) + boff + n * 2048 + k * 1024); } while (0)
#define PG8_MMA(ai, bj, At, Bt) do { __builtin_amdgcn_s_setprio(1); _Pragma("unroll") for (int m = 0; m < 4; ++m) _Pragma("unroll") for (int n = 0; n < 2; ++n) _Pragma("unroll") for (int k = 0; k < 2; ++k) \
        acc[ai][bj][m][n] = __builtin_amdgcn_mfma_f32_16x16x32_bf16(Bt[n][k], At[m][k], acc[ai][bj][m][n], 0, 0, 0); __builtin_amdgcn_s_setprio(0); } while (0)
#define PG8_WAIT_V(n) asm volatile("s_waitcnt vmcnt(" #n ")" ::: "memory")
#define PG8_WAIT_L(n) asm volatile("s_waitcnt lgkmcnt(" #n ")" ::: "memory")
#define PG8_BAR __builtin_amdgcn_s_barrier()
#define PG8_SCHED __builtin_amdgcn_sched_barrier(0)
    Unit cur, nxt; int ui = 0;
    if (!S.next(0, cur)) return;
    f32x4 acc[2][2][4][2];
#pragma unroll
    for (int a = 0; a < 2; ++a)
#pragma unroll
        for (int b = 0; b < 2; ++b)
#pragma unroll
            for (int m = 0; m < 4; ++m)
#pragma unroll
                for (int n = 0; n < 2; ++n) acc[a][b][m][n] = (f32x4){0.f, 0.f, 0.f, 0.f};
    bf16x8 At[4][2], B0[2][2], B1[2][2];
    const char* cA = (const char*)g.A + (size_t)cur.pm * tstepA; const char* cB = (const char*)g.Bt + (size_t)cur.pn * tstepB;
    S.a_ready(cur);
    if constexpr (SP2) {
        PG8_STAGE(PG8_SB(0, 0), cB, voffB); PG8_STAGE(PG8_SB(0, 1), cB + hstepB, voffB); PG8_STAGE(PG8_SA(0, 0), cA, voffA); PG8_STAGE(PG8_SA(0, 1), cA + hstepA, voffA);
        if (wr == 1) PG8_BAR;
        PG8_WAIT_V(2); PG8_BAR;
        PG8_STAGE(PG8_SB(1, 0), cB + kstep, voffB); PG8_STAGE(PG8_SA(1, 0), cA + kstep, voffA); PG8_STAGE(PG8_SB(1, 1), cB + hstepB + kstep, voffB);
        PG8_WAIT_V(6); PG8_BAR;
    } else {
        PG8_STAGE(PG8_SB(0, 0), cB, voffB); PG8_STAGE(PG8_SA(0, 0), cA, voffA); PG8_STAGE(PG8_SB(0, 1), cB + hstepB, voffB); PG8_STAGE(PG8_SA(0, 1), cA + hstepA, voffA);
        if (wr == 1) PG8_BAR;
        PG8_WAIT_V(4); PG8_BAR;
        PG8_STAGE(PG8_SB(1, 0), cB + kstep, voffB); PG8_STAGE(PG8_SA(1, 0), cA + kstep, voffA); PG8_STAGE(PG8_SB(1, 1), cB + hstepB + kstep, voffB);
        PG8_WAIT_V(6); PG8_BAR;
    }
    for (;;) {
        const bool has_next = S.next(ui + 1, nxt);
        const char* nA = has_next ? (const char*)g.A + (size_t)nxt.pm * tstepA : cA; const char* nB = has_next ? (const char*)g.Bt + (size_t)nxt.pn * tstepB : cB;
        for (int t = 0; t < nt; t += 2) {
            const bool last = (t == nt - 2);
            const char* a1 = cA + (size_t)(t + 1) * kstep;
            const char* a2 = last ? nA : cA + (size_t)(t + 2) * kstep; const char* b2 = last ? nB : cB + (size_t)(t + 2) * kstep;
            const char* a3 = a2 + kstep; const char* b3 = b2 + kstep;
            if (last && has_next) S.a_ready(nxt);
            if constexpr (SP2) {
            PG8_LDB(B0, 0, 0); PG8_LDB(B1, 0, 1); PG8_SCHED; PG8_LDA(At, 0, 0); PG8_STAGE(PG8_SA(1, 1), a1 + hstepA, voffA);
            PG8_WAIT_V(8); PG8_WAIT_L(0); PG8_BAR; PG8_MMA(0, 0, At, B0); PG8_MMA(0, 1, At, B1); PG8_BAR; PG8_SCHED;
            PG8_LDA(At, 0, 1); PG8_STAGE(PG8_SB(0, 0), b2, voffB); PG8_STAGE(PG8_SB(0, 1), b2 + hstepB, voffB); PG8_STAGE(PG8_SA(0, 0), a2, voffA);
            PG8_WAIT_V(8); PG8_WAIT_L(0); PG8_BAR; PG8_MMA(1, 0, At, B0); PG8_MMA(1, 1, At, B1); PG8_BAR; PG8_SCHED;
            PG8_LDB(B0, 1, 0); PG8_LDB(B1, 1, 1); PG8_SCHED; PG8_LDA(At, 1, 0); PG8_STAGE(PG8_SA(0, 1), a2 + hstepA, voffA);
            PG8_WAIT_V(8); PG8_WAIT_L(0); PG8_BAR; PG8_MMA(0, 0, At, B0); PG8_MMA(0, 1, At, B1); PG8_BAR; PG8_SCHED;
            PG8_LDA(At, 1, 1); PG8_STAGE(PG8_SB(1, 0), b3, voffB); PG8_STAGE(PG8_SB(1, 1), b3 + hstepB, voffB); PG8_STAGE(PG8_SA(1, 0), a3, voffA);
            PG8_WAIT_V(8); PG8_WAIT_L(0); PG8_BAR; PG8_MMA(1, 0, At, B0); PG8_MMA(1, 1, At, B1); PG8_BAR; PG8_SCHED;
            } else {
            PG8_LDB(B0, 0, 0); PG8_SCHED; PG8_LDA(At, 0, 0); PG8_STAGE(PG8_SA(1, 1), a1 + hstepA, voffA);
            PG8_WAIT_L(8); PG8_BAR; PG8_WAIT_L(0); PG8_MMA(0, 0, At, B0); PG8_BAR; PG8_SCHED;
            PG8_LDB(B1, 0, 1); PG8_STAGE(PG8_SB(0, 0), b2, voffB);
            PG8_BAR; PG8_WAIT_L(0); PG8_MMA(0, 1, At, B1); PG8_BAR;
            PG8_LDA(At, 0, 1); PG8_STAGE(PG8_SA(0, 0), a2, voffA);
            PG8_BAR; PG8_WAIT_L(0); PG8_MMA(1, 0, At, B0); PG8_BAR; PG8_SCHED;
            PG8_STAGE(PG8_SB(0, 1), b2 + hstepB, voffB);
            PG8_WAIT_V(6); PG8_BAR; PG8_MMA(1, 1, At, B1); PG8_BAR;
            PG8_LDB(B0, 1, 0); PG8_SCHED; PG8_LDA(At, 1, 0); PG8_STAGE(PG8_SA(0, 1), a2 + hstepA, voffA);
            PG8_WAIT_L(8); PG8_BAR; PG8_WAIT_L(0); PG8_MMA(0, 0, At, B0); PG8_BAR; PG8_SCHED;
            PG8_LDB(B1, 1, 1); PG8_STAGE(PG8_SB(1, 0), b3, voffB);
            PG8_BAR; PG8_WAIT_L(0); PG8_MMA(0, 1, At, B1); PG8_BAR;
            PG8_LDA(At, 1, 1); PG8_STAGE(PG8_SA(1, 0), a3, voffA);
            PG8_BAR; PG8_WAIT_L(0); PG8_MMA(1, 0, At, B0); PG8_BAR; PG8_SCHED;
            PG8_STAGE(PG8_SB(1, 1), b3 + hstepB, voffB);
            PG8_WAIT_V(6); PG8_BAR; PG8_MMA(1, 1, At, B1); PG8_BAR;
            }
        }
        if constexpr (ALIGN_EPI) { if (wr == 0) PG8_BAR; }
        if constexpr (!Epi::AFTER_DRAIN) { E(acc, cur, wr, wc, fr, fq); S.done(cur); }
        if (!has_next) break;
#pragma unroll
        for (int a = 0; a < 2; ++a)
#pragma unroll
            for (int b = 0; b < 2; ++b)
#pragma unroll
                for (int m = 0; m < 4; ++m)
#pragma unroll
                    for (int n = 0; n < 2; ++n) acc[a][b][m][n] = (f32x4){0.f, 0.f, 0.f, 0.f};
        cur = nxt; cA = nA; cB = nB; ++ui;
        if constexpr (ALIGN_EPI) { if (wr == 1) PG8_BAR; }
    }
    PG8_WAIT_V(0);
    if constexpr (!ALIGN_EPI) { if (wr == 0) PG8_BAR; }
    PG8_BAR;
    if constexpr (Epi::AFTER_DRAIN) { E.fused(acc, cur, wr, wc, fr, fq, lds, wid, lane); S.done(cur); }
#undef PG8_SA
#undef PG8_SB
#undef PG8_STAGE
#undef PG8_LDA
#undef PG8_LDB
#undef PG8_MMA
#undef PG8_WAIT_V
#undef PG8_WAIT_L
#undef PG8_BAR
#undef PG8_SCHED
}
}

typedef unsigned short bf16;
typedef unsigned v4u __attribute__((ext_vector_type(4)));
typedef unsigned v2u __attribute__((ext_vector_type(2)));
typedef float f32x4 __attribute__((ext_vector_type(4)));
typedef short bf16x8 __attribute__((ext_vector_type(8)));

constexpr int D = 1024, MP = 16384, MS = 1024, M = MP + MS, SEQL = 2048, NBATCH = 8, DBATCH = 128;
constexpr int NPROJ = 3072, FF = 2816, NGU = 5632, DIN = 3080, MH = M / 2;
constexpr float EPS = 1e-6f;
constexpr int NTHREADS = 512, NWAVES = 8;
constexpr int LDS_BYTES = 155648;
constexpr size_t MiB = 1u << 20;
constexpr size_t WS_WOUT = 0, WS_WGU = 4 * MiB, WS_WDN = 26 * MiB, WS_XA = 37 * MiB, WS_PROJ = 71 * MiB, WS_GU = 105 * MiB, WS_SCR = 173 * MiB, WS_WIN = 239 * MiB;
constexpr size_t WS_GB = 245 * MiB, WS_SSQ = 245 * MiB + 576 * 1024, WS_WAB = 246 * MiB, WS_GL = 246 * MiB + 64 * 1024, WS_HALO = 246 * MiB + 128 * 1024, WS_BAR = 246 * MiB + 192 * 1024, WS_HAL = 247 * MiB, WS_FIXG = 249 * MiB, WS_FIXU = 251 * MiB, WS_END = 253 * MiB;
constexpr int SCR_ITEM = 73728;
constexpr size_t O_PDELTA = 17825792, O_PDCONV = 18874368, O_PPOOL = 18948096, O_PSCONV = 19009536, O_PFFN = 19017728;
constexpr size_t O_SDELTA = 19107840, O_SDCONV = 35885056, O_SPOOL = 37064704, O_SSCONV = 38047744, O_SFFN = 38178816, O_TOTAL = 39620608;

struct Params { const float* in[23]; float* out; unsigned char* ws; };
typedef const __attribute__((address_space(4))) Params* KP;
__device__ __forceinline__ KP kparams() { KP p = (KP)__builtin_amdgcn_kernarg_segment_ptr(); asm volatile("" : "+s"(p)); return p; }

#define LAUNDER(p) asm volatile("" : "+s"(p))
#define LDS_WAIT() asm volatile("s_waitcnt lgkmcnt(0)" ::: "memory")
__device__ __forceinline__ unsigned f2bf(float f) { unsigned u = __builtin_bit_cast(unsigned, f); return (u + 0x7fffu + ((u >> 16) & 1u)) >> 16; }
__device__ __forceinline__ unsigned pk2(float lo, float hi) { return f2bf(lo) | (f2bf(hi) << 16); }
__device__ __forceinline__ float bflo(unsigned u) { return __builtin_bit_cast(float, u << 16); }
__device__ __forceinline__ float bfhi(unsigned u) { return __builtin_bit_cast(float, u & 0xffff0000u); }
__device__ __forceinline__ float bf1(bf16 h) { return __builtin_bit_cast(float, ((unsigned)h) << 16); }
__device__ __forceinline__ float siluf(float x) { return x * __builtin_amdgcn_rcpf(1.f + __expf(-x)); }
__device__ __forceinline__ float wave_sum(float v) {
#pragma unroll
    for (int o = 1; o < 64; o <<= 1) v += __shfl_xor(v, o);
    return v;
}
#define UNPACK8(W_, F_) do { (F_)[0] = bflo((W_).x); (F_)[1] = bfhi((W_).x); (F_)[2] = bflo((W_).y); (F_)[3] = bfhi((W_).y); (F_)[4] = bflo((W_).z); (F_)[5] = bfhi((W_).z); (F_)[6] = bflo((W_).w); (F_)[7] = bfhi((W_).w); } while (0)
#define PACK8(F_) ((v4u){pk2((F_)[0], (F_)[1]), pk2((F_)[2], (F_)[3]), pk2((F_)[4], (F_)[5]), pk2((F_)[6], (F_)[7])})

struct EpiScale {
    static constexpr bool PERM = true, AFTER_DRAIN = false;
    bf16* O; int ldc; const float* ssq;
    __device__ __forceinline__ void operator()(const pg8::f32x4 (&acc)[2][2][4][2], const pg8::Unit& u, int wr, int wc, int fr, int fq) const {
        const int row0 = u.pm * 256 + wr * 64 + fr, col0 = u.pn * 256 + wc * 32 + 8 * fq;
#pragma unroll
        for (int ai = 0; ai < 2; ++ai)
#pragma unroll
            for (int m = 0; m < 4; ++m) {
                const int row = row0 + ai * 128 + m * 16;
                const float rs = rsqrtf(ssq[row] * (1.f / D) + EPS);
                bf16* rowp = O + (size_t)row * ldc + col0;
#pragma unroll
                for (int bj = 0; bj < 2; ++bj) {
                    pg8::f32x4 v0 = acc[ai][bj][m][0] * rs, v1 = acc[ai][bj][m][1] * rs;
                    v4u w; w.x = pk2(v0[0], v0[1]); w.y = pk2(v0[2], v0[3]); w.z = pk2(v1[0], v1[1]); w.w = pk2(v1[2], v1[3]);
                    *(v4u*)(rowp + bj * 128) = w;
                }
            }
    }
};
struct EpiResid {
    static constexpr bool PERM = true, AFTER_DRAIN = false;
    const float* xa; const float* xb_; float* xres; bf16* xb16; float* ssq; int rowbase;
    __device__ __forceinline__ void operator()(const pg8::f32x4 (&acc)[2][2][4][2], const pg8::Unit& u, int wr, int wc, int fr, int fq) const {
        const int row0 = rowbase + u.pm * 256 + wr * 64 + fr, col0 = u.pn * 256 + wc * 32 + 8 * fq;
#pragma unroll
        for (int ai = 0; ai < 2; ++ai)
#pragma unroll
            for (int m = 0; m < 4; ++m) {
                const int row = row0 + ai * 128 + m * 16;
                const float* xo = (row < MP ? xa + (size_t)row * D : xb_ + (size_t)(row - MP) * D) + col0;
                float* xr = xres + (size_t)row * D + col0;
                bf16* xh = xb16 + (size_t)row * D + col0;
                float ss = 0.f;
#pragma unroll
                for (int bj = 0; bj < 2; ++bj) {
                    const pg8::f32x4 o0 = *(const pg8::f32x4*)(xo + bj * 128), o1 = *(const pg8::f32x4*)(xo + bj * 128 + 4);
                    pg8::f32x4 v0 = acc[ai][bj][m][0] + o0, v1 = acc[ai][bj][m][1] + o1;
                    *(pg8::f32x4*)(xr + bj * 128) = v0; *(pg8::f32x4*)(xr + bj * 128 + 4) = v1;
                    v4u w; w.x = pk2(v0[0], v0[1]); w.y = pk2(v0[2], v0[3]); w.z = pk2(v1[0], v1[1]); w.w = pk2(v1[2], v1[3]);
                    *(v4u*)(xh + bj * 128) = w;
                    ss += v0[0] * v0[0] + v0[1] * v0[1] + v0[2] * v0[2] + v0[3] * v0[3] + v1[0] * v1[0] + v1[1] * v1[1] + v1[2] * v1[2] + v1[3] * v1[3];
                }
                ss += __shfl_xor(ss, 16); ss += __shfl_xor(ss, 32);
                if (fq == 0) atomicAdd(ssq + row, ss);
            }
    }
};


constexpr int EPI_HALO_OFF = 131072;
__device__ __forceinline__ float dpp_f(float oldv, float src, const int ctrl_sel) {
    const int o = __builtin_bit_cast(int, oldv), v = __builtin_bit_cast(int, src); int r;
    if (ctrl_sel == 0) r = __builtin_amdgcn_update_dpp(o, v, 0x111, 0xf, 0xf, false);
    else if (ctrl_sel == 1) r = __builtin_amdgcn_update_dpp(o, v, 0x112, 0xf, 0xf, false);
    else if (ctrl_sel == 2) r = __builtin_amdgcn_update_dpp(o, v, 0x121, 0xf, 0xf, false);
    else r = __builtin_amdgcn_update_dpp(o, v, 0x122, 0xf, 0xf, false);
    return __builtin_bit_cast(float, r);
}
struct EpiGateUp {
    static constexpr bool PERM = true, AFTER_DRAIN = false;
    bf16* ACT; const float* ssq; const float* cw; const float* st; float* HAL; float* FIXG; float* FIXU; float* pffn; float* sffn; unsigned char* lds;
    __device__ __forceinline__ void operator()(const pg8::f32x4 (&acc)[2][2][4][2], const pg8::Unit& u, int wr, int wc, int fr, int fq) const {
        const int pm = u.pm, ch0 = u.pn * 128 + wc * 32 + 8 * fq, row0 = pm * 256 + wr * 64 + fr;
        const bool smp = pm >= 64;
        float* halo = (float*)(lds + EPI_HALO_OFF);
#pragma unroll
        for (int ai = 0; ai < 2; ++ai) {
            const float rs = rsqrtf(ssq[row0 + ai * 128 + 48] * (1.f / D) + EPS);
            if (fr >= 14) {
                float* hp = halo + ((ai * 2 + wr) * 2 + (fr - 14)) * 128 + wc * 32 + 8 * fq;
                *(pg8::f32x4*)hp = acc[ai][0][3][0] * rs; *(pg8::f32x4*)(hp + 4) = acc[ai][0][3][1] * rs;
            }
        }
        asm volatile("s_waitcnt lgkmcnt(0)" ::: "memory");
        __builtin_amdgcn_s_barrier();
        float w0[8], w1[8], w2[8];
#pragma unroll
        for (int e = 0; e < 8; ++e) { w0[e] = cw[ch0 + e]; w1[e] = cw[FF + ch0 + e]; w2[e] = cw[2 * FF + ch0 + e]; }
#pragma unroll
        for (int ai = 0; ai < 2; ++ai) {
            const int s = ai * 2 + wr;
            float prev[8];
#pragma unroll
            for (int e = 0; e < 8; ++e) prev[e] = 0.f;
            if (!smp && s >= 1 && fr >= 14) {
                const float* hp = halo + ((s - 1) * 2 + (fr - 14)) * 128 + wc * 32 + 8 * fq;
                const pg8::f32x4 h0 = *(const pg8::f32x4*)hp, h1 = *(const pg8::f32x4*)(hp + 4);
                prev[0] = h0[0]; prev[1] = h0[1]; prev[2] = h0[2]; prev[3] = h0[3]; prev[4] = h1[0]; prev[5] = h1[1]; prev[6] = h1[2]; prev[7] = h1[3];
            }
#pragma unroll
            for (int m = 0; m < 4; ++m) {
                const int row = row0 + ai * 128 + m * 16;
                const float rs = rsqrtf(ssq[row] * (1.f / D) + EPS);
                float cur[8], upv[8], s0v[8], s1v[8];
#pragma unroll
                for (int e = 0; e < 8; ++e) { cur[e] = acc[ai][0][m][e >> 2][e & 3] * rs; upv[e] = acc[ai][1][m][e >> 2][e & 3] * rs; s0v[e] = 0.f; s1v[e] = 0.f; }
                const int t = fr & 7, sb = (row - MP) >> 3;
                if (smp && t < 2) {
                    const float* sp = st + (size_t)(sb * 2) * FF + ch0;
#pragma unroll
                    for (int e = 0; e < 8; ++e) { s0v[e] = sp[e]; s1v[e] = sp[FF + e]; }
                }
                float a[8];
#pragma unroll
                for (int e = 0; e < 8; ++e) {
                    const float sh1 = dpp_f(cur[e], cur[e], 0), sh2 = dpp_f(cur[e], cur[e], 1), ro1 = dpp_f(prev[e], prev[e], 2), ro2 = dpp_f(prev[e], prev[e], 3);
                    float p1, p2;
                    if (smp) { p1 = t >= 1 ? sh1 : s1v[e]; p2 = t >= 2 ? sh2 : (t == 1 ? s1v[e] : s0v[e]); }
                    else { p1 = fr >= 1 ? sh1 : ro1; p2 = fr >= 2 ? sh2 : ro2; }
                    a[e] = siluf(w0[e] * p2 + w1[e] * p1 + w2[e] * cur[e]) * upv[e];
                }
                *(v4u*)(ACT + (size_t)row * FF + ch0) = PACK8(a);
                if (smp) {
                    if (t >= 6) { float* o = sffn + (size_t)(sb * 2 + t - 6) * FF + ch0;
                        *(pg8::f32x4*)o = (pg8::f32x4){cur[0], cur[1], cur[2], cur[3]}; *(pg8::f32x4*)(o + 4) = (pg8::f32x4){cur[4], cur[5], cur[6], cur[7]}; }
                } else {
                    if (s == 3 && m == 3 && fr >= 14) {
                        float* o = HAL + (size_t)(pm * 2 + fr - 14) * FF + ch0;
                        *(pg8::f32x4*)o = (pg8::f32x4){cur[0], cur[1], cur[2], cur[3]}; *(pg8::f32x4*)(o + 4) = (pg8::f32x4){cur[4], cur[5], cur[6], cur[7]};
                        if ((pm & 7) == 7) { float* o2 = pffn + (size_t)((pm >> 3) * 2 + fr - 14) * FF + ch0;
                            *(pg8::f32x4*)o2 = (pg8::f32x4){cur[0], cur[1], cur[2], cur[3]}; *(pg8::f32x4*)(o2 + 4) = (pg8::f32x4){cur[4], cur[5], cur[6], cur[7]}; }
                    }
                    if (s == 0 && m == 0 && fr < 2 && (pm & 7) != 0) {
                        float* o = FIXG + (size_t)(pm * 2 + fr) * FF + ch0; float* o2 = FIXU + (size_t)(pm * 2 + fr) * FF + ch0;
                        *(pg8::f32x4*)o = (pg8::f32x4){cur[0], cur[1], cur[2], cur[3]}; *(pg8::f32x4*)(o + 4) = (pg8::f32x4){cur[4], cur[5], cur[6], cur[7]};
                        *(pg8::f32x4*)o2 = (pg8::f32x4){upv[0], upv[1], upv[2], upv[3]}; *(pg8::f32x4*)(o2 + 4) = (pg8::f32x4){upv[4], upv[5], upv[6], upv[7]};
                    }
                }
#pragma unroll
                for (int e = 0; e < 8; ++e) prev[e] = cur[e];
            }
        }
    }
};
__device__ __forceinline__ void p4_fixup(KP P, int l, int start, int stride) {
    const float* HAL = (const float*)(P->ws + WS_HAL); const float* FIXG = (const float*)(P->ws + WS_FIXG); const float* FIXU = (const float*)(P->ws + WS_FIXU);
    bf16* ACT = (bf16*)(P->ws + WS_GU);
    const float* cw = P->in[19] + (size_t)(l * 3) * FF;
    for (int idx = start; idx < 56 * 2 * FF; idx += stride) {
        const int k = idx / (2 * FF), rem = idx % (2 * FF), rr = rem / FF, c = rem % FF;
        const int pm = (k / 7) * 8 + 1 + (k % 7);
        const float g0 = FIXG[(size_t)(pm * 2 + rr) * FF + c];
        const float g1 = rr == 0 ? HAL[(size_t)((pm - 1) * 2 + 1) * FF + c] : FIXG[(size_t)(pm * 2) * FF + c];
        const float g2 = rr == 0 ? HAL[(size_t)((pm - 1) * 2) * FF + c] : HAL[(size_t)((pm - 1) * 2 + 1) * FF + c];
        const float a = siluf(cw[c] * g2 + cw[FF + c] * g1 + cw[2 * FF + c] * g0) * FIXU[(size_t)(pm * 2 + rr) * FF + c];
        ACT[(size_t)(pm * 256 + rr) * FF + c] = (bf16)f2bf(a);
    }
}
__device__ __forceinline__ void transpose_item(const float* W, int K, int ldw, int src_col0, const float* g, bf16* WT, int dst_row0, float* scr, int kb, int lane) {
    const int k0 = 64 * kb;
#pragma unroll 8
    for (int i = 0; i < 32; ++i) { const int kk = 2 * i + (lane >> 5); const float gs = g ? g[k0 + kk] : 1.f;
        scr[kk * 33 + (lane & 31)] = W[(size_t)(k0 + kk) * ldw + src_col0 + (lane & 31)] * gs; }
    LDS_WAIT();
    const int c = lane & 7;
#pragma unroll
    for (int j = 0; j < 4; ++j) { const int n = (lane >> 3) + 8 * j; const float* s = scr + (8 * c) * 33 + n;
        v4u o; o.x = pk2(s[0 * 33], s[1 * 33]); o.y = pk2(s[2 * 33], s[3 * 33]); o.z = pk2(s[4 * 33], s[5 * 33]); o.w = pk2(s[6 * 33], s[7 * 33]);
        *(v4u*)(WT + (size_t)(dst_row0 + n) * K + k0 + 8 * c) = o; }
    LDS_WAIT();
}
__device__ __forceinline__ void convert_matrix(const float* W, int K, int N, int ldw, int skip_from, int skip, const float* g, bf16* WT, int dst_row0, float* scr, int gw, int ngw, int lane, int il = 0) {
    const int nnb = N / 32, nit = (K / 64) * nnb;
    for (int it = gw; it < nit; it += ngw) {
        const int kb = it / nnb, nb = it % nnb, n0 = nb * 32;
        const int drow = il ? ((n0 >> 7) * 256 + (n0 & 127) + (il == 2 ? 128 : 0)) : n0;
        transpose_item(W, K, ldw, n0 + (n0 >= skip_from ? skip : 0), g, WT, dst_row0 + drow, scr, kb, lane);
    }
}
__device__ __forceinline__ void convert_layer_rest(KP P, int l, float* scr, int gw, int ngw, int lane) {
    unsigned char* ws = P->ws;
    convert_matrix(P->in[16] + (size_t)l * D * D, D, D, D, 1 << 30, 0, nullptr, (bf16*)(ws + WS_WOUT) + (size_t)l * D * D, 0, scr, gw, ngw, lane);
    convert_matrix(P->in[18] + (size_t)l * D * FF, D, FF, FF, 1 << 30, 0, P->in[17] + l * D, (bf16*)(ws + WS_WGU) + (size_t)l * NGU * D, 0, scr, gw, ngw, lane, 1);
    convert_matrix(P->in[20] + (size_t)l * D * FF, D, FF, FF, 1 << 30, 0, P->in[17] + l * D, (bf16*)(ws + WS_WGU) + (size_t)l * NGU * D, 0, scr, gw, ngw, lane, 2);
    convert_matrix(P->in[21] + (size_t)l * FF * D, FF, D, D, 1 << 30, 0, nullptr, (bf16*)(ws + WS_WDN) + (size_t)l * D * FF, 0, scr, gw, ngw, lane);
}
__device__ __forceinline__ void convert_win(KP P, int l, float* scr, int gw, int ngw, int lane) {
    convert_matrix(P->in[8] + (size_t)l * D * DIN, D, NPROJ, DIN, 2048, 8, P->in[7] + l * D, (bf16*)(P->ws + WS_WIN), 0, scr, gw, ngw, lane);
}

constexpr int B_QF = 0, B_KF = 33792, B_VF = 67584, B_AT = 101376, B_GC = 118784, B_QKS = 120320, B_WST = 128512;
__device__ __forceinline__ void p2b_item(KP P, int l, int item, unsigned char* lds, int wave_in) {
    const int tid = fresh_tid(wave_in);
    const int h = item & 3, n = (item >> 2) & 31, b = item >> 7;
    const int lane = tid & 63, wv = __builtin_amdgcn_readfirstlane(tid >> 6), fr = lane & 15, fq = lane >> 4;
    float* QF = (float*)(lds + B_QF); float* KF = (float*)(lds + B_KF); float* VF = (float*)(lds + B_VF); float* AT = (float*)(lds + B_AT);
    float* Gs = (float*)(lds + B_GC); float* BETA = Gs + 64; float* GC = Gs + 128; float* EG = Gs + 192; float* EKD = Gs + 256;
    bf16* QKS = (bf16*)(lds + B_QKS); bf16* WST = (bf16*)(lds + B_WST);
    const bf16* PROJ = (const bf16*)(P->ws + WS_PROJ);
    const float* GB = (const float*)(P->ws + WS_GB);
    unsigned char* scr = P->ws + WS_SCR + (size_t)item * SCR_ITEM;
    if (tid < 384) {
        const int chunk = tid % 48, tg = tid / 48, part = chunk >> 4, cc = chunk & 15;
        const int col = part * 512 + h * 128 + cc * 8;
        const float* cw = P->in[9] + (size_t)(l * 4) * 1536 + col;
        float w0[8], w1[8], w2[8], w3[8];
#pragma unroll
        for (int e = 0; e < 8; ++e) { w0[e] = cw[e]; w1[e] = cw[1536 + e]; w2[e] = cw[2 * 1536 + e]; w3[e] = cw[3 * 1536 + e]; }
        const int t0 = n * 64 + tg * 8;
        const bf16* base = PROJ + (size_t)(b * SEQL) * NPROJ + col;
        float r0[8], r1[8], r2[8], r3[8];
#pragma unroll
        for (int e = 0; e < 8; ++e) { r0[e] = 0.f; r1[e] = 0.f; r2[e] = 0.f; }
        if (t0 - 3 >= 0) { const v4u w = *(const v4u*)(base + (size_t)(t0 - 3) * NPROJ); UNPACK8(w, r0); }
        if (t0 - 2 >= 0) { const v4u w = *(const v4u*)(base + (size_t)(t0 - 2) * NPROJ); UNPACK8(w, r1); }
        if (t0 - 1 >= 0) { const v4u w = *(const v4u*)(base + (size_t)(t0 - 1) * NPROJ); UNPACK8(w, r2); }
        float* dst = (float*)(lds + part * 33792) + cc * 8;
#pragma unroll
        for (int i = 0; i < 8; ++i) {
            const v4u w = *(const v4u*)(base + (size_t)(t0 + i) * NPROJ); UNPACK8(w, r3);
            float s[8];
#pragma unroll
            for (int e = 0; e < 8; ++e) { const float cv = w0[e] * r0[e] + w1[e] * r1[e] + w2[e] * r2[e] + w3[e] * r3[e]; s[e] = siluf(cv); }
            float* d = dst + (tg * 8 + i) * 132;
            *(f32x4*)d = (f32x4){s[0], s[1], s[2], s[3]}; *(f32x4*)(d + 4) = (f32x4){s[4], s[5], s[6], s[7]};
#pragma unroll
            for (int e = 0; e < 8; ++e) { r0[e] = r1[e]; r1[e] = r2[e]; r2[e] = r3[e]; }
        }
    }
    if (tid < 64) { const int row = b * SEQL + n * 64 + tid; Gs[tid] = GB[(size_t)row * 8 + h]; BETA[tid] = GB[(size_t)row * 8 + 4 + h]; }
    __syncthreads();
    {
        const int tok = tid >> 3, sub = tid & 7;
        float* qr = QF + tok * 132 + sub * 16; float* kr = KF + tok * 132 + sub * 16;
        float qv[16], kv[16]; float sq = 0.f, sk = 0.f;
#pragma unroll
        for (int e = 0; e < 16; ++e) { qv[e] = qr[e]; kv[e] = kr[e]; sq += qv[e] * qv[e]; sk += kv[e] * kv[e]; }
        sq += __shfl_xor(sq, 1); sq += __shfl_xor(sq, 2); sq += __shfl_xor(sq, 4);
        sk += __shfl_xor(sk, 1); sk += __shfl_xor(sk, 2); sk += __shfl_xor(sk, 4);
        const float rq = rsqrtf(sq + EPS) * 0.08838834764831845f, rk = rsqrtf(sk + EPS);
#pragma unroll
        for (int e = 0; e < 16; ++e) { qr[e] = qv[e] * rq; kr[e] = kv[e] * rk; }
    }
    if (tid < 64) {
        float v = Gs[tid];
#pragma unroll
        for (int o = 1; o < 64; o <<= 1) { const float t = __shfl_up(v, o); if (tid >= o) v += t; }
        const float tot = __shfl(v, 63);
        GC[tid] = v; EG[tid] = __expf(v); EKD[tid] = __expf(tot - v);
        if (tid == 0) ((float*)(P->ws + WS_GL))[item] = __expf(tot);
    }
    __syncthreads();
    {
        const int p = wv >> 2, mt = wv & 3;
        const float* X = p ? QF : KF;
        f32x4 acc[4];
#pragma unroll
        for (int nt = 0; nt < 4; ++nt) acc[nt] = (f32x4){0.f, 0.f, 0.f, 0.f};
        const float* xa = X + (mt * 16 + fr) * 132 + fq; const float* kb_ = KF + fr * 132 + fq;
#pragma unroll 8
        for (int k = 0; k < 128; k += 4) {
            const float a = xa[k];
#pragma unroll
            for (int nt = 0; nt < 4; ++nt) acc[nt] = __builtin_amdgcn_mfma_f32_16x16x4f32(a, kb_[nt * 16 * 132 + k], acc[nt], 0, 0, 0);
        }
#pragma unroll
        for (int nt = 0; nt < 4; ++nt) {
            const int j = nt * 16 + fr; const float gj = GC[j];
            float v[4];
#pragma unroll
            for (int r = 0; r < 4; ++r) {
                const int i = mt * 16 + 4 * fq + r;
                if (p == 0) v[r] = (i > j) ? BETA[i] * acc[nt][r] * __expf(GC[i] - gj) : 0.f;
                else        v[r] = (i >= j) ? acc[nt][r] * __expf(GC[i] - gj) : 0.f;
            }
            if (p == 0) *(f32x4*)(AT + j * 68 + mt * 16 + 4 * fq) = (f32x4){v[0], v[1], v[2], v[3]};
            else {
#pragma unroll
                for (int r = 0; r < 4; ++r) QKS[(mt * 16 + 4 * fq + r) * 64 + j] = (bf16)f2bf(v[r]);
            }
        }
    }
    __syncthreads();
    if (tid < 256) {
        float x[64];
        int zo = 0; asm volatile("" : "+v"(zo));
        const float* ATz = AT + zo; const float* BETAz = BETA + zo; const float* EGz = EG + zo;
        if (tid < 128) {
#pragma unroll
            for (int i = 0; i < 64; ++i) x[i] = BETAz[i] * VF[i * 132 + tid];
        } else {
#pragma unroll
            for (int i = 0; i < 64; ++i) x[i] = BETAz[i] * EGz[i] * KF[i * 132 + tid - 128];
        }
        f32x4 ab[16];
#pragma unroll
        for (int q = 0; q < 16; ++q) ab[q] = *(const f32x4*)(ATz + q * 4);
#pragma unroll
        for (int j = 0; j < 63; ++j) {
            const float xj = x[j];
#pragma unroll
            for (int q = (j + 1) / 4; q < 16; ++q) {
#pragma unroll
                for (int e = 0; e < 4; ++e) if (4 * q + e > j) x[4 * q + e] -= ab[q][e] * xj;
                if (j + 1 < 63 && q >= (j + 2) / 4) ab[q] = *(const f32x4*)(ATz + (j + 1) * 68 + q * 4);
                __builtin_amdgcn_sched_barrier(0);
            }
        }
        if (tid < 128) {
            unsigned char* up = scr + 49152 + tid * 128;
#pragma unroll
            for (int q = 0; q < 8; ++q) *(v4u*)(up + q * 16) = PACK8(x + 8 * q);
        } else {
            const int dk = tid - 128;
#pragma unroll
            for (int i = 0; i < 64; ++i) WST[i * 128 + dk] = (bf16)f2bf(-x[i]);
        }
    } else {
        const int t2 = tid - 256;
        {
            const int tok = t2 >> 2, seg = t2 & 3; const float eg = EG[tok]; const float* s = QF + tok * 132 + seg * 32;
            unsigned char* o = scr + 16384 + tok * 256 + seg * 64;
#pragma unroll
            for (int q = 0; q < 4; ++q) { float f[8];
#pragma unroll
                for (int e = 0; e < 8; ++e) f[e] = s[q * 8 + e] * eg;
                *(v4u*)(o + q * 16) = PACK8(f); }
        }
        {
            const int dk = t2 >> 1, hf = t2 & 1; unsigned char* o = scr + 32768 + dk * 128 + hf * 64;
#pragma unroll
            for (int q = 0; q < 4; ++q) { float f[8];
#pragma unroll
                for (int e = 0; e < 8; ++e) { const int tok = hf * 32 + q * 8 + e; f[e] = KF[tok * 132 + dk] * EKD[tok]; }
                *(v4u*)(o + q * 16) = PACK8(f); }
        }
#pragma unroll
        for (int q = 0; q < 2; ++q) { const int c = t2 + 256 * q; *(v4u*)(scr + 65536 + c * 16) = *(const v4u*)((const unsigned char*)QKS + c * 16); }
    }
    __syncthreads();
#pragma unroll
    for (int q = 0; q < 2; ++q) { const int c = tid + 512 * q; *(v4u*)(scr + c * 16) = *(const v4u*)((const unsigned char*)WST + c * 16); }
    __syncthreads();
}

constexpr int S_ST = 0, S_VNT = 34816, S_OPW = 53248, S_OPQG = 70656, S_OPKD = 88064, S_OPQK = 106496, S_OPU = 115712;
__device__ __forceinline__ void scan_load(v4u (&pre)[9], const unsigned char* src, int tid) {
#pragma unroll
    for (int i = 0; i < 9; ++i) pre[i] = *(const v4u*)(src + (size_t)(tid + 512 * i) * 16);
}
__device__ __forceinline__ void scan_chunk(v4u (&pre)[9], f32x4 (&sacc)[8], unsigned char* lds, unsigned char* scrbase, int item, int n, float egl, int tid, int w, int fr, int fq) {
    __syncthreads();
#pragma unroll
    for (int i = 0; i < 9; ++i) {
        const int e = (tid + 512 * i) * 16 - (i >> 1) * 16384;
        if (i < 4) { const int row = e >> 8, cb = e & 255; *(v4u*)(lds + (i < 2 ? S_OPW : S_OPQG) + row * 272 + cb) = pre[i]; }
        else { const int row = e >> 7, cb = e & 127; *(v4u*)(lds + (i < 6 ? S_OPKD : (i < 8 ? S_OPU : S_OPQK)) + row * 144 + cb) = pre[i]; }
    }
    __syncthreads();
    if (n + 2 < 32) scan_load(pre, scrbase + (size_t)(item + 8) * SCR_ITEM, tid);
    bf16x8 sf[4];
#pragma unroll
    for (int ks = 0; ks < 4; ++ks) sf[ks] = *(const bf16x8*)(lds + S_ST + (16 * w + fr) * 272 + (ks * 32 + 8 * fq) * 2);
    f32x4 vt[4];
#pragma unroll
    for (int tt = 0; tt < 4; ++tt) { const v2u uu = *(const v2u*)(lds + S_OPU + (16 * w + fr) * 144 + (tt * 16 + 4 * fq) * 2);
        vt[tt] = (f32x4){bflo(uu.x), bfhi(uu.x), bflo(uu.y), bfhi(uu.y)}; }
#pragma unroll
    for (int ks = 0; ks < 4; ++ks)
#pragma unroll
        for (int tt = 0; tt < 4; ++tt) { const bf16x8 a = *(const bf16x8*)(lds + S_OPW + (tt * 16 + fr) * 272 + (ks * 32 + 8 * fq) * 2);
            vt[tt] = __builtin_amdgcn_mfma_f32_16x16x32_bf16(a, sf[ks], vt[tt], 0, 0, 0); }
#pragma unroll
    for (int tt = 0; tt < 4; ++tt) *(v2u*)(lds + S_VNT + (16 * w + fr) * 144 + (tt * 16 + 4 * fq) * 2) = (v2u){pk2(vt[tt][0], vt[tt][1]), pk2(vt[tt][2], vt[tt][3])};
    LDS_WAIT();
    bf16x8 vf[2];
#pragma unroll
    for (int js = 0; js < 2; ++js) vf[js] = *(const bf16x8*)(lds + S_VNT + (16 * w + fr) * 144 + (js * 32 + 8 * fq) * 2);
    f32x4 ot[4];
#pragma unroll
    for (int nt = 0; nt < 4; ++nt) ot[nt] = (f32x4){0.f, 0.f, 0.f, 0.f};
#pragma unroll
    for (int ks = 0; ks < 4; ++ks)
#pragma unroll
        for (int nt = 0; nt < 4; ++nt) { const bf16x8 bq = *(const bf16x8*)(lds + S_OPQG + (nt * 16 + fr) * 272 + (ks * 32 + 8 * fq) * 2);
            ot[nt] = __builtin_amdgcn_mfma_f32_16x16x32_bf16(sf[ks], bq, ot[nt], 0, 0, 0); }
#pragma unroll
    for (int js = 0; js < 2; ++js)
#pragma unroll
        for (int nt = 0; nt < 4; ++nt) { const bf16x8 bk = *(const bf16x8*)(lds + S_OPQK + (nt * 16 + fr) * 144 + (js * 32 + 8 * fq) * 2);
            ot[nt] = __builtin_amdgcn_mfma_f32_16x16x32_bf16(vf[js], bk, ot[nt], 0, 0, 0); }
    {
        float* oraw = (float*)(scrbase + (size_t)item * SCR_ITEM);
#pragma unroll
        for (int nt = 0; nt < 4; ++nt) *(f32x4*)(oraw + (nt * 16 + fr) * 128 + 16 * w + 4 * fq) = ot[nt];
    }
#pragma unroll
    for (int mt = 0; mt < 8; ++mt) {
        sacc[mt] = sacc[mt] * egl;
#pragma unroll
        for (int js = 0; js < 2; ++js) { const bf16x8 a = *(const bf16x8*)(lds + S_OPKD + (mt * 16 + fr) * 144 + (js * 32 + 8 * fq) * 2);
            sacc[mt] = __builtin_amdgcn_mfma_f32_16x16x32_bf16(a, vf[js], sacc[mt], 0, 0, 0); }
        *(v2u*)(lds + S_ST + (16 * w + fr) * 272 + (mt * 16 + 4 * fq) * 2) = (v2u){pk2(sacc[mt][0], sacc[mt][1]), pk2(sacc[mt][2], sacc[mt][3])};
    }
    LDS_WAIT();
}
__device__ __forceinline__ void scan_wg(KP P, int l, int bh, unsigned char* lds, int tid) {
    const int b = bh >> 2, h = bh & 3;
    const int lane = tid & 63, w = __builtin_amdgcn_readfirstlane(tid >> 6), fr = lane & 15, fq = lane >> 4;
    unsigned char* scrbase = P->ws + WS_SCR;
    f32x4 sacc[8];
#pragma unroll
    for (int mt = 0; mt < 8; ++mt) sacc[mt] = (f32x4){0.f, 0.f, 0.f, 0.f};
    { unsigned zz0 = 0u; asm volatile("" : "+v"(zz0)); for (int q = lane; q < 272; q += 64) *(v4u*)(lds + S_ST + (16 * w) * 272 + q * 16) = (v4u){zz0, zz0, zz0, zz0}; }
    const int item0 = (b * 32) * 4 + h;
    const float glv = ((const float*)(P->ws + WS_GL))[item0 + 4 * (lane & 31)];
    v4u preA[9], preB[9];
    scan_load(preA, scrbase + (size_t)item0 * SCR_ITEM, tid);
    scan_load(preB, scrbase + (size_t)(item0 + 4) * SCR_ITEM, tid);
#pragma unroll 1
    for (int n = 0; n < 32; n += 2) {
        scan_chunk(preA, sacc, lds, scrbase, item0 + 4 * n, n, __shfl(glv, n), tid, w, fr, fq);
        scan_chunk(preB, sacc, lds, scrbase, item0 + 4 * n + 4, n + 1, __shfl(glv, n + 1), tid, w, fr, fq);
    }
    float* pd = P->out + O_PDELTA + (size_t)((l * NBATCH + b) * 4 + h) * 16384;
#pragma unroll
    for (int mt = 0; mt < 8; ++mt)
#pragma unroll
        for (int r = 0; r < 4; ++r) pd[(mt * 16 + 4 * fq + r) * 128 + 16 * w + fr] = sacc[mt][r];
    __syncthreads();
}
__device__ __forceinline__ void p2d(KP P, int l, int gw, int ngw, int lane) {
    const bf16* PROJ = (const bf16*)(P->ws + WS_PROJ);
    bf16* OCAT = (bf16*)(P->ws + WS_XA);
    const float on0 = P->in[12][l * 128 + lane * 2], on1 = P->in[12][l * 128 + lane * 2 + 1];
    for (int pair = gw; pair < MP * 4; pair += ngw) {
        const int row = pair >> 2, h = pair & 3, b = row >> 11, t = row & 2047, n = t >> 6, tok = t & 63;
        const int item = (b * 32 + n) * 4 + h;
        const float* o = (const float*)(P->ws + WS_SCR + (size_t)item * SCR_ITEM) + tok * 128 + lane * 2;
        const float o0 = o[0], o1 = o[1];
        const unsigned zz = *(const unsigned*)(PROJ + (size_t)row * NPROJ + 1536 + h * 128 + lane * 2);
        const float rs = rsqrtf(wave_sum(o0 * o0 + o1 * o1) * (1.f / 128.f) + EPS);
        *(unsigned*)(OCAT + (size_t)row * D + h * 128 + lane * 2) = pk2(o0 * rs * on0 * siluf(bflo(zz)), o1 * rs * on1 * siluf(bfhi(zz)));
    }
}

__device__ __forceinline__ void sample_delta(KP P, int l, int it, unsigned char* lds, int wave_in) {
    const int tid = fresh_tid(wave_in);
    const int gq = tid >> 7, c = tid & 127, wv2 = (tid >> 6) & 1, lane = tid & 63;
    const int item = it * 4 + gq, sb = item >> 2, h = item & 3, rowbase = MP + sb * 8;
    float* QS = (float*)(lds + gq * 12288); float* KS = QS + 1024; float* VS = QS + 2048;
    float* RED2 = (float*)(lds + 49152);
    const bf16* PROJ = (const bf16*)(P->ws + WS_PROJ);
    const float* GB = (const float*)(P->ws + WS_GB);
    bf16* OCAT = (bf16*)(P->ws + WS_XA);
#pragma unroll
    for (int part = 0; part < 3; ++part) {
        const int col = part * 512 + h * 128 + c;
        const float* cw = P->in[9] + (size_t)(l * 4) * 1536 + col;
        const float w0 = cw[0], w1 = cw[1536], w2 = cw[2 * 1536], w3 = cw[3 * 1536];
        const float* hs = P->in[3] + (size_t)((l * DBATCH + sb) * 3) * 1536 + col;
        float r0 = hs[0], r1 = hs[1536], r2 = hs[2 * 1536];
        float* dst = QS + part * 1024 + c;
#pragma unroll
        for (int t = 0; t < 8; ++t) {
            const float x = bf1(PROJ[(size_t)(rowbase + t) * NPROJ + col]);
            dst[t * 128] = siluf(w0 * r0 + w1 * r1 + w2 * r2 + w3 * x);
            r0 = r1; r1 = r2; r2 = x;
        }
    }
#pragma unroll
    for (int t = 0; t < 8; ++t) {
        const float q = QS[t * 128 + c], k = KS[t * 128 + c];
        const float sq = wave_sum(q * q), sk = wave_sum(k * k);
        if (lane == 0) { RED2[(gq * 2 + wv2) * 16 + t] = sq; RED2[(gq * 2 + wv2) * 16 + 8 + t] = sk; }
    }
    __syncthreads();
#pragma unroll
    for (int t = 0; t < 8; ++t) {
        const float tq = RED2[(gq * 2) * 16 + t] + RED2[(gq * 2 + 1) * 16 + t], tk = RED2[(gq * 2) * 16 + 8 + t] + RED2[(gq * 2 + 1) * 16 + 8 + t];
        QS[t * 128 + c] *= rsqrtf(tq + EPS) * 0.08838834764831845f; KS[t * 128 + c] *= rsqrtf(tk + EPS);
    }
    __syncthreads();
    float s[128];
    {
        const float* S0 = P->in[2] + (size_t)((l * DBATCH + sb) * 4 + h) * 16384 + c;
#pragma unroll
        for (int d8 = 0; d8 < 16; ++d8) {
#pragma unroll
            for (int e = 0; e < 8; ++e) s[8 * d8 + e] = S0[e * 128];
            S0 += 8 * 128; asm volatile("" : "+v"(S0));
        }
    }
#pragma unroll 1
    for (int t = 0; t < 8; ++t) {
        const float g = GB[(size_t)(rowbase + t) * 8 + h], beta = GB[(size_t)(rowbase + t) * 8 + 4 + h], eg = __expf(g);
        const f32x4* kp = (const f32x4*)(KS + t * 128); const f32x4* qp = (const f32x4*)(QS + t * 128);
        float dot = 0.f;
#pragma unroll
        for (int d4 = 0; d4 < 32; ++d4) { const f32x4 kv = kp[d4]; dot += kv[0] * s[4 * d4] + kv[1] * s[4 * d4 + 1] + kv[2] * s[4 * d4 + 2] + kv[3] * s[4 * d4 + 3];
            if ((d4 & 3) == 3) asm volatile("" ::: "memory"); }
        const float cf = beta * (VS[t * 128 + c] - eg * dot);
        float o = 0.f;
#pragma unroll
        for (int d4 = 0; d4 < 32; ++d4) { const f32x4 kv = kp[d4], qv = qp[d4];
#pragma unroll
            for (int e = 0; e < 4; ++e) { s[4 * d4 + e] = eg * s[4 * d4 + e] + cf * kv[e]; o += qv[e] * s[4 * d4 + e]; }
            if ((d4 & 3) == 3) asm volatile("" ::: "memory"); }
        VS[t * 128 + c] = o;
    }
    {
        float* sd = P->out + O_SDELTA + (size_t)((l * DBATCH + sb) * 4 + h) * 16384 + c;
#pragma unroll
        for (int d8 = 0; d8 < 16; ++d8) {
#pragma unroll
            for (int e = 0; e < 8; ++e) sd[e * 128] = s[8 * d8 + e];
            sd += 8 * 128; asm volatile("" : "+v"(sd));
        }
    }
    __syncthreads();
#pragma unroll
    for (int t = 0; t < 8; ++t) { const float o = VS[t * 128 + c]; const float so = wave_sum(o * o); if (lane == 0) RED2[(gq * 2 + wv2) * 16 + t] = so; }
    __syncthreads();
    const float onv = P->in[12][l * 128 + c];
#pragma unroll
    for (int t = 0; t < 8; ++t) {
        const float tot = RED2[(gq * 2) * 16 + t] + RED2[(gq * 2 + 1) * 16 + t];
        const float z = bf1(PROJ[(size_t)(rowbase + t) * NPROJ + 1536 + h * 128 + c]);
        OCAT[(size_t)(rowbase + t) * D + h * 128 + c] = (bf16)f2bf(VS[t * 128 + c] * rsqrtf(tot * (1.f / 128.f) + EPS) * onv * siluf(z));
    }
    __syncthreads();
}

constexpr int PL_DT = 0, PL_PW = 69632;
__device__ __forceinline__ void pool_tile(KP P, int l, int tile, unsigned char* lds, int wave_in) {
    const int tid = fresh_tid(wave_in);
    float* DT = (float*)(lds + PL_DT); const float* PW = (const float*)(lds + PL_PW);
    const bf16* PROJ = (const bf16*)(P->ws + WS_PROJ);
    bf16* OCAT = (bf16*)(P->ws + WS_XA);
#pragma unroll 1
    for (int i = 0; i < 4; ++i) {
        const int idx = tid + 512 * i, tok = idx & 63, ch8 = idx >> 6, c0 = ch8 * 8, gi = ch8 >> 3, win = 2 << gi;
        int row, t, sb = 0; bool smp;
        if (tile < 256) { t = (tile & 31) * 64 + tok; row = (tile >> 5) * SEQL + t; smp = false; }
        else { sb = (tile - 256) * 8 + (tok >> 3); t = tok & 7; row = MP + sb * 8 + t; smp = true; }
        float ssum[8], cur[8];
#pragma unroll
        for (int e = 0; e < 8; ++e) { ssum[e] = 0.f; cur[e] = 0.f; }
        for (int j = 0; j < win; ++j) {
            const int tt = t - j; float f[8];
            if (tt >= 0) { const v4u w = *(const v4u*)(PROJ + (size_t)(row - j) * NPROJ + 2048 + c0); UNPACK8(w, f); }
            else if (smp) { const float* sp = P->in[4] + (size_t)((l * DBATCH + sb) * 15 + 15 + tt) * 256 + c0;
#pragma unroll
                for (int e = 0; e < 8; ++e) f[e] = sp[e]; }
            else {
#pragma unroll
                for (int e = 0; e < 8; ++e) f[e] = 0.f; }
#pragma unroll
            for (int e = 0; e < 8; ++e) { ssum[e] += f[e]; if (j == 0) cur[e] = f[e]; }
        }
        const float inv = 1.f / (float)(smp ? win : (t + 1 < win ? t + 1 : win));
#pragma unroll
        for (int e = 0; e < 8; ++e) DT[(c0 + e) * 68 + tok] = ssum[e] * inv - cur[e];
        float u0[8], u1[8], u2[8];
#pragma unroll
        for (int j = 0; j < 3; ++j) {
            const int tt = t - j; float f[8];
            if (tt >= 0) { const v4u wc = *(const v4u*)(PROJ + (size_t)(row - j) * NPROJ + 2816 + c0); const v4u wx = *(const v4u*)(PROJ + (size_t)(row - j) * NPROJ + 2304 + c0);
                float fc[8], fx[8]; UNPACK8(wc, fc); UNPACK8(wx, fx);
#pragma unroll
                for (int e = 0; e < 8; ++e) f[e] = fc[e] * fx[e]; }
            else if (smp) { const float* sp = P->in[5] + (size_t)((l * DBATCH + sb) * 2 + 2 + tt) * 256 + c0;
#pragma unroll
                for (int e = 0; e < 8; ++e) f[e] = sp[e]; }
            else {
#pragma unroll
                for (int e = 0; e < 8; ++e) f[e] = 0.f; }
#pragma unroll
            for (int e = 0; e < 8; ++e) { if (j == 0) u0[e] = f[e]; else if (j == 1) u1[e] = f[e]; else u2[e] = f[e]; }
        }
        const float* sw = P->in[15] + (size_t)(l * 3) * 256 + c0;
        const v4u wb = *(const v4u*)(PROJ + (size_t)row * NPROJ + 2560 + c0); float fb[8]; UNPACK8(wb, fb);
        float oc[8];
#pragma unroll
        for (int e = 0; e < 8; ++e) oc[e] = fb[e] * (sw[e] * u2[e] + sw[256 + e] * u1[e] + sw[512 + e] * u0[e]);
        *(v4u*)(OCAT + (size_t)row * D + 768 + c0) = PACK8(oc);
    }
    __syncthreads();
    {
        const int ep = tid & 255, g = ep >> 6, e = ep & 63, hf = tid >> 8;
        float acc[32];
#pragma unroll
        for (int q = 0; q < 32; ++q) acc[q] = 0.f;
#pragma unroll 2
        for (int c = 0; c < 64; ++c) {
            const float wgt = PW[(g * 64 + c) * 64 + e];
            const f32x4* dp = (const f32x4*)(DT + (g * 64 + c) * 68 + hf * 32);
#pragma unroll
            for (int q = 0; q < 8; ++q) { const f32x4 d = dp[q]; acc[4 * q] += d[0] * wgt; acc[4 * q + 1] += d[1] * wgt; acc[4 * q + 2] += d[2] * wgt; acc[4 * q + 3] += d[3] * wgt; }
        }
        const float sc = P->in[14][l * 256 + ep];
#pragma unroll
        for (int q = 0; q < 32; ++q) {
            const int tok = hf * 32 + q;
            const int row = tile < 256 ? (tile >> 5) * SEQL + (tile & 31) * 64 + tok : MP + (tile - 256) * 64 + tok;
            OCAT[(size_t)row * D + 512 + ep] = (bf16)f2bf(acc[q] * sc);
        }
    }
    __syncthreads();
}

__device__ __forceinline__ void state_copies(KP P, int l, int start, int stride) {
    const bf16* PROJ = (const bf16*)(P->ws + WS_PROJ);
    for (int i = start; i < 136 * 8960; i += stride) {
        const int seq = i / 8960, r = i % 8960;
        const bool smp = seq >= 8; const int sb = seq - 8;
        const int L = smp ? 8 : SEQL; const size_t row0 = smp ? (size_t)MP + sb * 8 : (size_t)seq * SEQL;
        if (r < 4608) {
            const int j = r / 1536, c = r % 1536;
            const float v = bf1(PROJ[(row0 + L - 3 + j) * NPROJ + c]);
            if (smp) P->out[O_SDCONV + (size_t)((l * DBATCH + sb) * 3 + j) * 1536 + c] = v; else P->out[O_PDCONV + (size_t)((l * NBATCH + seq) * 3 + j) * 1536 + c] = v;
        } else if (r < 4608 + 3840) {
            const int r2 = r - 4608, j = r2 / 256, c = r2 % 256;
            if (smp) { const float v = j < 7 ? P->in[4][(size_t)((l * DBATCH + sb) * 15 + 8 + j) * 256 + c] : bf1(PROJ[(row0 + j - 7) * NPROJ + 2048 + c]);
                P->out[O_SPOOL + (size_t)((l * DBATCH + sb) * 15 + j) * 256 + c] = v; }
            else P->out[O_PPOOL + (size_t)((l * NBATCH + seq) * 15 + j) * 256 + c] = bf1(PROJ[(row0 + L - 15 + j) * NPROJ + 2048 + c]);
        } else {
            const int r2 = r - 8448, j = r2 / 256, c = r2 % 256;
            const size_t row = row0 + L - 2 + j;
            const float v = bf1(PROJ[row * NPROJ + 2816 + c]) * bf1(PROJ[row * NPROJ + 2304 + c]);
            if (smp) P->out[O_SSCONV + (size_t)((l * DBATCH + sb) * 2 + j) * 256 + c] = v; else P->out[O_PSCONV + (size_t)((l * NBATCH + seq) * 2 + j) * 256 + c] = v;
        }
    }
}

__device__ __forceinline__ void p4b(KP P, int l, int hf, int start, int stride) {
    bf16* GU = (bf16*)(P->ws + WS_GU); bf16* HALO = (bf16*)(P->ws + WS_HALO);
    const float* cw = P->in[19] + (size_t)(l * 3) * FF;
    const int r0 = hf * MH;
    for (int idx = start; idx < MH * 352; idx += stride) {
        const int lr = idx / 352, c0 = (idx % 352) * 8, m = r0 + lr;
        int t, sb = 0; bool smp;
        if (m < MP) { t = m & (SEQL - 1); smp = false; } else { sb = (m - MP) >> 3; t = (m - MP) & 7; smp = true; }
        float g0[8], g1[8], g2[8];
#pragma unroll
        for (int j = 0; j < 3; ++j) {
            const int tt = t - j; float f[8];
            if (tt < 0) {
                if (smp) { const float* sp = P->in[6] + (size_t)((l * DBATCH + sb) * 2 + 2 + tt) * FF + c0;
#pragma unroll
                    for (int e = 0; e < 8; ++e) f[e] = sp[e]; }
                else {
#pragma unroll
                    for (int e = 0; e < 8; ++e) f[e] = 0.f; }
            } else {
                const v4u w = (lr - j < 0) ? *(const v4u*)(HALO + (size_t)(2 + lr - j) * FF + c0) : *(const v4u*)(GU + (size_t)(lr - j) * NGU + c0);
                UNPACK8(w, f);
            }
#pragma unroll
            for (int e = 0; e < 8; ++e) { if (j == 0) g0[e] = f[e]; else if (j == 1) g1[e] = f[e]; else g2[e] = f[e]; }
        }
        const v4u wu = *(const v4u*)(GU + (size_t)lr * NGU + FF + c0); float fu[8]; UNPACK8(wu, fu);
        float a[8];
#pragma unroll
        for (int e = 0; e < 8; ++e) a[e] = siluf(cw[c0 + e] * g2[e] + cw[FF + c0 + e] * g1[e] + cw[2 * FF + c0 + e] * g0[e]) * fu[e];
        *(v4u*)(GU + (size_t)lr * NGU + FF + c0) = PACK8(a);
        if (!smp && t >= SEQL - 2) { float* o = P->out + O_PFFN + (size_t)((l * NBATCH + (m >> 11)) * 2 + t - (SEQL - 2)) * FF + c0;
#pragma unroll
            for (int e = 0; e < 8; ++e) o[e] = g0[e]; }
        if (smp && t >= 6) { float* o = P->out + O_SFFN + (size_t)((l * DBATCH + sb) * 2 + t - 6) * FF + c0;
#pragma unroll
            for (int e = 0; e < 8; ++e) o[e] = g0[e]; }
        if (hf == 0 && lr >= MH - 2) *(v4u*)(HALO + (size_t)(lr - (MH - 2)) * FF + c0) = *(const v4u*)(GU + (size_t)lr * NGU + c0);
    }
}

#define LAS __attribute__((address_space(3)))
#define XB_TMO      128
#define XB_XCNT(j)  (256  + 64 * (j))
#define XB_XSUB(j)  (1280 + 64 * (j))
#define XB_XGEN(j)  (2304 + 64 * (j))
#define XB_TOP      3328
#define XB_TOPGEN   3392
#define XCD_BAR_WORDS 3456
#define XB_SPIN_CAP (1u << 18)

__device__ __forceinline__ unsigned xb_ld(unsigned* p)              { return __hip_atomic_load(p, __ATOMIC_RELAXED, __HIP_MEMORY_SCOPE_AGENT); }
__device__ __forceinline__ unsigned xb_add(unsigned* p, unsigned v) { return __hip_atomic_fetch_add(p, v, __ATOMIC_RELAXED, __HIP_MEMORY_SCOPE_AGENT); }
__device__ __forceinline__ unsigned xb_xcc_id() { return (unsigned)__builtin_amdgcn_s_getreg((3 << 11) | 20) & 0xFu; }
#define XB_SPIN(cond, bar) do { unsigned _sp = 0; while (cond) { __builtin_amdgcn_s_sleep(1); \
    if ((++_sp & 255u) == 0u) { if (xb_ld(&(bar)[XB_TMO])) break; if (_sp > XB_SPIN_CAP) { atomicAdd(&(bar)[XB_TMO], 1u); break; } } } } while (0)

struct XcdBarrier {
    unsigned* bar; unsigned x;
    volatile LAS unsigned* st;
    int wave;
};

__device__ __forceinline__ XcdBarrier xcd_barrier_post(unsigned* bar, volatile LAS unsigned* st) {
    XcdBarrier b; b.bar = bar; b.x = xb_xcc_id(); b.st = st; b.wave = 0;
    if (threadIdx.x == 0) (void)xb_add(&bar[XB_XCNT(b.x)], 1u);
    return b;
}
__device__ __forceinline__ void xcd_barrier_complete(unsigned* bar, unsigned x, unsigned& nloc, unsigned& nx) {
    const unsigned G = gridDim.x * gridDim.y * gridDim.z;
    unsigned sum, cnt, mine, sp = 0u;
    for (;;) {
        sum = 0u; cnt = 0u; mine = 0u;
#pragma unroll
        for (unsigned j = 0; j < 16; ++j) { const unsigned c = xb_ld(&bar[XB_XCNT(j)]); sum += c; cnt += (c > 0u) ? 1u : 0u; mine = (j == x) ? c : mine; }
        if (sum == G) break;
        __builtin_amdgcn_s_sleep(1);
        if ((++sp & 255u) == 0u) { if (xb_ld(&bar[XB_TMO])) break; if (sp > XB_SPIN_CAP) { atomicAdd(&bar[XB_TMO], 1u); break; } }
    }
    nloc = mine > 0u ? mine : 1u; nx = cnt > 0u ? cnt : 1u;
}

__device__ __forceinline__ void xcd_barrier(const XcdBarrier& b) {
    asm volatile("s_waitcnt vmcnt(0)" ::: "memory");
    __syncthreads();
    if (b.wave == 0 && lane_id() == 0) {
        unsigned* bar = b.bar;
        __builtin_amdgcn_s_waitcnt(0);
        unsigned nloc = b.st[0], nx = b.st[1];
        if (nloc == 0u) { xcd_barrier_complete(bar, b.x, nloc, nx); b.st[0] = nloc; b.st[1] = nx; }
        const unsigned old = xb_add(&bar[XB_XSUB(b.x)], 1u);
        const unsigned gen = old / nloc;
        if (old + 1u == (gen + 1u) * nloc) {
            __builtin_amdgcn_fence(__ATOMIC_RELEASE, "agent");
            asm volatile("s_waitcnt vmcnt(0)" ::: "memory");
            const unsigned og = xb_add(&bar[XB_TOP], 1u);
            const unsigned tg = og / nx;
            if (og + 1u == (tg + 1u) * nx) xb_add(&bar[XB_TOPGEN], 1u);
            else XB_SPIN(xb_ld(&bar[XB_TOPGEN]) == tg, bar);
            __builtin_amdgcn_fence(__ATOMIC_ACQUIRE, "agent");
            xb_add(&bar[XB_XGEN(b.x)], 1u);
            asm volatile("s_waitcnt vmcnt(0)" ::: "memory");
        } else {
            XB_SPIN(xb_ld(&bar[XB_XGEN(b.x)]) == gen, bar);
            __builtin_amdgcn_fence(__ATOMIC_ACQUIRE, "agent");
            asm volatile("s_waitcnt vmcnt(0)" ::: "memory");
        }
    }
    __syncthreads();
}

#define XSYNC1() do { XcdBarrier b_; b_.bar = (unsigned*)(kparams()->ws + WS_BAR); b_.x = xb_xcc_id(); b_.st = (volatile LAS unsigned*)((LAS unsigned char*)lds + (LDS_BYTES - 64)); b_.wave = wave; xcd_barrier(b_); } while (0)
#ifdef PROBE_SYNC2
#define GSYNC() do { XSYNC1(); XSYNC1(); } while (0)
#else
#define GSYNC() XSYNC1()
#endif
__global__ void __launch_bounds__(NTHREADS, 2) fwd_megakernel(Params Parg) {
    KP P = kparams();
    extern __shared__ __attribute__((aligned(16))) unsigned char lds[];
    cg::grid_group grid = cg::this_grid();
    const int wave = __builtin_amdgcn_readfirstlane((int)threadIdx.x >> 6);
    const int tid = fresh_tid(wave), lane = tid & 63;
    const int G = gridDim.x, bx = blockIdx.x;
    const int gw = bx * NWAVES + wave, ngw = G * NWAVES;
    const int gt = bx * NTHREADS + tid, ngt = G * NTHREADS;
    unsigned char* ws = P->ws;
    bf16* XA = (bf16*)(ws + WS_XA); bf16* XB2 = (bf16*)(ws + WS_PROJ); bf16* PROJ = (bf16*)(ws + WS_PROJ); bf16* GU = (bf16*)(ws + WS_GU);
    float* SSQ = (float*)(ws + WS_SSQ); float* GB = (float*)(ws + WS_GB); float* WAB = (float*)(ws + WS_WAB);
    float* XRES = P->out;
    float* wscr = (float*)(lds + wave * 16384);
    volatile LAS unsigned* xst = (volatile LAS unsigned*)((LAS unsigned char*)lds + (LDS_BYTES - 64));
    if (tid < 16) xst[tid] = 0u;
    __syncthreads();
    (void)xcd_barrier_post((unsigned*)(ws + WS_BAR), xst);

    for (int i = gt; i < 4 * M; i += ngt) SSQ[M + i] = 0.f;
    for (int i = gt; i < 2 * 8 * D; i += ngt) { const int l = i >> 13, j = (i >> 10) & 7, k = i & 1023; WAB[i] = P->in[7][l * D + k] * P->in[8][(size_t)l * D * DIN + (size_t)k * DIN + 2048 + j]; }
    convert_win(P, 0, wscr, gw, ngw, lane);
    convert_layer_rest(P, 0, wscr, gw, ngw, lane);
    convert_layer_rest(P, 1, wscr, gw, ngw, lane);
    for (int m = gw; m < M; m += ngw) {
        const float* xr = m < MP ? P->in[0] + (size_t)m * D : P->in[1] + (size_t)(m - MP) * D;
        float ss = 0.f;
#pragma unroll
        for (int j = 0; j < 4; ++j) { const f32x4 v = ((const f32x4*)xr)[lane + 64 * j]; ss += v[0] * v[0] + v[1] * v[1] + v[2] * v[2] + v[3] * v[3];
            ((v2u*)(XA + (size_t)m * D))[lane + 64 * j] = (v2u){pk2(v[0], v[1]), pk2(v[2], v[3])}; }
        ss = wave_sum(ss);
        if (lane == 0) SSQ[m] = ss;
    }
    grid.sync();

#pragma unroll 1
    for (int l = 0; l < 2; ++l) {
#ifndef NO_P1
        {
            const bf16* gA = XA; const bf16* gB = (const bf16*)(ws + WS_WIN); LAUNDER(gA); LAUNDER(gB);
            pg8::Gemm g{gA, gB, M, NPROJ, D, D}; pg8::StaticOrder S; S.init(M, NPROJ, G, bx);
            EpiScale E{PROJ, NPROJ, SSQ + (size_t)(2 * l) * M};
            pg8::gemm_phase<EpiScale, pg8::StaticOrder, true, true>((PG8_LAS unsigned char*)lds, g, S, E, wave);
#ifdef PROBE_P1X2
            __syncthreads();
            pg8::gemm_phase<EpiScale, pg8::StaticOrder, true, true>((PG8_LAS unsigned char*)lds, g, S, E, wave);
#endif
        }
#endif
#ifndef NO_AB
        {
            const float* ssq = SSQ + (size_t)(2 * l) * M;
            const int tf = fresh_tid(wave), lane = tf & 63, gw = bx * NWAVES + __builtin_amdgcn_readfirstlane(tf >> 6);
            for (int m = gw; m < M; m += ngw) {
                const v4u* xr = (const v4u*)(XA + (size_t)m * D) + lane * 2;
                const v4u x0 = xr[0], x1 = xr[1]; float xf[16]; UNPACK8(x0, xf); UNPACK8(x1, xf + 8);
                float dot[8];
#pragma unroll
                for (int j = 0; j < 8; ++j) { const float* wp = WAB + (size_t)(l * 8 + j) * D + lane * 16; float s = 0.f;
#pragma unroll
                    for (int e = 0; e < 16; ++e) s += wp[e] * xf[e];
                    dot[j] = wave_sum(s); }
                float v = dot[0];
#pragma unroll
                for (int j = 1; j < 8; ++j) v = (lane == j) ? dot[j] : v;
                if (lane < 8) {
                    v *= rsqrtf(ssq[m] * (1.f / D) + EPS);
                    const int hh = lane & 3; float r;
                    if (lane < 4) { const float xx = v + P->in[11][l * 4 + hh]; const float sp = fmaxf(xx, 0.f) + __logf(1.f + __expf(-fabsf(xx))); r = -__expf(P->in[10][l * 4 + hh]) * sp; }
                    else r = __builtin_amdgcn_rcpf(1.f + __expf(-v));
                    GB[(size_t)m * 8 + lane] = r;
                }
            }
        }
#endif
        GSYNC();
#ifndef NO_P2B
        { const int tf = fresh_tid(wave); for (int item = bx; item < 1024; item += G) p2b_item(P, l, item, lds, wave); }
#ifdef PROBE_P2B2
        __syncthreads(); { const int tf = fresh_tid(wave); for (int item = bx; item < 1024; item += G) p2b_item(P, l, item, lds, wave); }
#endif
#endif
        GSYNC();
#ifdef PROBE_SCAN2
        if (bx < 32) { scan_wg(P, l, bx, lds, fresh_tid(wave)); }
#endif
#ifndef NO_SCAN
        if (bx < 32) scan_wg(P, l, bx, lds, fresh_tid(wave));
        else
#endif
        {
            const int vw = bx - 32, nm = G - 32; const int tid = fresh_tid(wave);
#ifndef NO_SAMPLE
            for (int it = nm - 1 - vw; it < 128; it += nm) sample_delta(P, l, it, lds, wave);
#endif
            for (int i = tid; i < 4096; i += NTHREADS) ((f32x4*)(lds + PL_PW))[i] = ((const f32x4*)(P->in[13] + (size_t)l * 16384))[i];
            __syncthreads();
#ifndef NO_POOL
            for (int tile = vw; tile < 272; tile += nm) pool_tile(P, l, tile, lds, wave);
#endif
            state_copies(P, l, vw * NTHREADS + tid, nm * NTHREADS);
        }
        GSYNC();
        { const int tf = fresh_tid(wave); p2d(P, l, bx * NWAVES + __builtin_amdgcn_readfirstlane(tf >> 6), ngw, tf & 63); }
        GSYNC();
#ifndef NO_P3
        {
            const bf16* gA = XA; const bf16* gB = (const bf16*)(ws + WS_WOUT) + (size_t)l * D * D; LAUNDER(gA); LAUNDER(gB);
            pg8::Gemm g{gA, gB, M, D, D, D}; pg8::StaticOrder S; S.init(M, D, G, bx);
            EpiResid E{l == 0 ? P->in[0] : XRES, l == 0 ? P->in[1] : XRES + (size_t)MP * D, XRES, XB2, SSQ + (size_t)(2 * l + 1) * M, 0};
            pg8::gemm_phase<EpiResid, pg8::StaticOrder, true, true>((PG8_LAS unsigned char*)lds, g, S, E, wave);
        }
#endif
        GSYNC();
        {
            const bf16* gA = XB2; const bf16* gB = (const bf16*)(ws + WS_WGU) + (size_t)l * NGU * D; LAUNDER(gA); LAUNDER(gB);
            pg8::Gemm g{gA, gB, M, NGU, D, D}; pg8::StaticOrder S; S.init(M, NGU, G, bx);
            EpiGateUp E{GU, SSQ + (size_t)(2 * l + 1) * M, P->in[19] + (size_t)(l * 3) * FF, P->in[6] + (size_t)l * DBATCH * 2 * FF, (float*)(ws + WS_HAL), (float*)(ws + WS_FIXG), (float*)(ws + WS_FIXU),
                        P->out + O_PFFN + (size_t)l * NBATCH * 2 * FF, P->out + O_SFFN + (size_t)l * DBATCH * 2 * FF, lds};
            pg8::gemm_phase<EpiGateUp, pg8::StaticOrder, true, true>((PG8_LAS unsigned char*)lds, g, S, E, wave);
        }
        GSYNC();
        p4_fixup(P, l, bx * NTHREADS + fresh_tid(wave), ngt);
        if (l == 0) { const int tf = fresh_tid(wave); convert_win(P, 1, (float*)(lds + wave * 16384), bx * NWAVES + wave, ngw, tf & 63); }
        GSYNC();
        {
            const bf16* gA = GU; const bf16* gB = (const bf16*)(ws + WS_WDN) + (size_t)l * D * FF; LAUNDER(gA); LAUNDER(gB);
            pg8::Gemm g{gA, gB, M, D, FF, FF}; pg8::StaticOrder S; S.init(M, D, G, bx);
            EpiResid E{XRES, XRES + (size_t)MP * D, XRES, XA, SSQ + (size_t)(2 * l + 2) * M, 0};
            pg8::gemm_phase<EpiResid, pg8::StaticOrder, true, true>((PG8_LAS unsigned char*)lds, g, S, E, wave);
        }
        GSYNC();
    }
    {
        const float* ssq = SSQ + (size_t)4 * M; const float* fn = P->in[22];
        const int gt = bx * NTHREADS + fresh_tid(wave);
        for (int i = gt; i < M * 256; i += ngt) {
            const int row = i >> 8, c4 = i & 255;
            const float rs = rsqrtf(ssq[row] * (1.f / D) + EPS);
            f32x4 v = ((f32x4*)XRES)[i]; const f32x4 gv = ((const f32x4*)fn)[c4];
            v[0] *= rs * gv[0]; v[1] *= rs * gv[1]; v[2] *= rs * gv[2]; v[3] *= rs * gv[3];
            ((f32x4*)XRES)[i] = v;
        }
    }
}

extern "C" void kernel_launch(void* const* d_in, const int* in_sizes, int n_in, void* d_out, int out_size, void* d_ws, size_t ws_size, hipStream_t stream) {
    static int grid = 0;
    if (grid == 0) {
        if (n_in != 23 || (size_t)out_size != O_TOTAL || ws_size < WS_END) { fprintf(stderr, "kernel_launch: unexpected shapes: n_in %d out %d ws %zu\n", n_in, out_size, ws_size); grid = -1; return; }
        int dev = 0, cus = 0, per_cu = 0;
        hipGetDevice(&dev); hipDeviceGetAttribute(&cus, hipDeviceAttributeMultiprocessorCount, dev);
        if (hipFuncSetAttribute((const void*)fwd_megakernel, hipFuncAttributeMaxDynamicSharedMemorySize, LDS_BYTES) != hipSuccess) { fprintf(stderr, "kernel_launch: hipFuncSetAttribute failed\n"); grid = -1; return; }
        hipOccupancyMaxActiveBlocksPerMultiprocessor(&per_cu, (const void*)fwd_megakernel, NTHREADS, LDS_BYTES);
        (void)hipGetLastError();
        if (per_cu < 1) fprintf(stderr, "kernel_launch: occupancy query reports %d blocks per CU\n", per_cu);
        grid = cus;
    }
    if (grid < 0) return;
    if (hipMemsetAsync((char*)d_ws + WS_BAR, 0, 16384, stream) != hipSuccess) { fprintf(stderr, "kernel_launch: memset failed\n"); return; }
    Params p{};
    for (int i = 0; i < 23; ++i) p.in[i] = (const float*)d_in[i];
    p.out = (float*)d_out; p.ws = (unsigned char*)d_ws;
    void* args[] = {&p};
    hipError_t e = hipLaunchCooperativeKernel((const void*)fwd_megakernel, dim3(grid), dim3(NTHREADS), args, LDS_BYTES, stream);
    if (e != hipSuccess) fprintf(stderr, "cooperative launch failed: %s (grid %d)\n", hipGetErrorString(e), grid);
}
```

```cpp
#include <hip/hip_runtime.h>
#include <hip/hip_cooperative_groups.h>
#include <cstdio>
#include <cstdint>
namespace cg = cooperative_groups;
__device__ __forceinline__ int lane_id() { int t; asm volatile("v_mbcnt_lo_u32_b32 %0, -1, 0\n\tv_mbcnt_hi_u32_b32 %0, -1, %0" : "=v"(t)); return t; }
__device__ __forceinline__ int fresh_tid(int wave) { return (wave << 6) | lane_id(); }
namespace pg8 {
#define PG8_LAS __attribute__((address_space(3)))
typedef unsigned short bf16_t;
typedef short bf16x8 __attribute__((ext_vector_type(8)));
typedef float f32x4 __attribute__((ext_vector_type(4)));
typedef unsigned u32x4 __attribute__((ext_vector_type(4)));
constexpr int BM = 256, BK = 64, HALF = 128, HTB = HALF * BK * 2  , STAGE_BYTES = 8 * HTB, NXCD = 8, WGM = 8;

__host__ __device__ __forceinline__ int lds_byte(int r, int c) { const int st = (r >> 4) * 2 + (c >> 5), rr = r & 15, cc = c & 31, ob = rr * 64 + cc * 2; return st * 1024 + (ob ^ (((ob >> 9) & 1) << 5)); }
__host__ __device__ __forceinline__ void stage_rc(int b, int& R, int& C) { const int st = b / 1024, sb = b % 1024, swz = sb ^ (((sb >> 9) & 1) << 5); R = (st >> 1) * 16 + swz / 64; C = (st & 1) * 32 + (swz % 64) / 2; }
__host__ __device__ __forceinline__ int perm32(int rho) { const int n = rho >> 4, i = rho & 15; return 8 * (i >> 2) + 4 * n + (i & 3); }

struct Unit { int pm, pn; };
struct Gemm { const bf16_t* A; const bf16_t* Bt; int M, N, K, lda, ldb; };

struct StaticOrder {
    int nM, nN, nwg, G, c;
    __host__ __device__ void init(int M, int N, int G_, int c_) { nM = M / BM; nN = N / BM; nwg = nM * nN; G = G_; c = c_; }
    __host__ __device__ bool next(int i, Unit& u) const {
        const long L = (long)i * G + c; if (L >= nwg) return false;
        int wgid = (int)L; { const int q = nwg / NXCD, r = nwg % NXCD, xcd = wgid % NXCD, off = wgid / NXCD; wgid = (xcd < r ? xcd * (q + 1) : r * (q + 1) + (xcd - r) * q) + off; }
        const int nig = WGM * nN, gid = wgid / nig, fm = gid * WGM, gsz = (nM - fm) < WGM ? (nM - fm) : WGM;
        u.pm = fm + ((wgid % nig) % gsz); u.pn = (wgid % nig) / gsz; return true;
    }
    __device__ __forceinline__ void a_ready(const Unit&) const {}
    __device__ __forceinline__ void done(const Unit&) const {}
};

template <class Epi, class Sched, bool ALIGN_EPI = false, bool SP2 = false>
__device__ __forceinline__ void gemm_phase(PG8_LAS unsigned char* lds, const Gemm g, const Sched& S, const Epi& E, const int wave_in) {
    const int tid = fresh_tid(wave_in), wid = __builtin_amdgcn_readfirstlane(tid >> 6), lane = tid & 63, wr = wid >> 2, wc = wid & 3, fr = lane & 15, fq = lane >> 4;
    const int K = g.K, nt = K / BK;
    unsigned voffA[2], voffB[2];
#pragma unroll
    for (int i = 0; i < 2; ++i) { int R, C; stage_rc(tid * 16 + i * 8192, R, C); const int Rb = Epi::PERM ? ((R & ~31) + perm32(R & 31)) : R;
        voffA[i] = (unsigned)(R * g.lda + C) * 2u; voffB[i] = (unsigned)(Rb * g.ldb + C) * 2u; }
    const size_t kstep = (size_t)(BK * 2);
    const size_t hstepA = (size_t)HALF * g.lda * 2, hstepB = (size_t)HALF * g.ldb * 2;
    const size_t tstepA = 2 * hstepA, tstepB = 2 * hstepB;
    const unsigned ldsw = (unsigned)wid * 1024u;
    const int aoff = lds_byte(wr * 64 + fr, fq * 8), boff = lds_byte(wc * 32 + fr, fq * 8);
#define PG8_SA(b, h) (((b) * 2 + (h)) * HTB)
#define PG8_SB(b, h) ((4 + (b) * 2 + (h)) * HTB)
#define PG8_STAGE(bufoff, gbase, voff) do { _Pragma("unroll") for (int _i = 0; _i < 2; ++_i) \
        __builtin_amdgcn_global_load_lds((const unsigned*)((const char*)(gbase) + (voff)[_i]), (PG8_LAS unsigned*)(lds + (bufoff) + ldsw + _i * 8192), 16, 0, 0); } while (0)
#define PG8_LDA(dst, b, h) do { _Pragma("unroll") for (int m = 0; m < 4; ++m) _Pragma("unroll") for (int k = 0; k < 2; ++k) dst[m][k] = *(const PG8_LAS bf16x8*)(lds + PG8_SA(b, h) + aoff + m * 2048 + k * 1024); } while (0)
#define PG8_LDB(dst, b, h) do { _Pragma("unroll") for (int n = 0; n < 2; ++n) _Pragma("unroll") for (int k = 0; k < 2; ++k) dst[n][k] = *(const PG8_LAS bf16x8*)(lds + PG8_SB(b, h) + boff + n * 2048 + k * 1024); } while (0)
#define PG8_MMA(ai, bj, At, Bt) do { __builtin_amdgcn_s_setprio(1); _Pragma("unroll") for (int m = 0; m < 4; ++m) _Pragma("unroll") for (int n = 0; n < 2; ++n) _Pragma("unroll") for (int k = 0; k < 2; ++k) \
        acc[ai][bj][m][n] = __builtin_amdgcn_mfma_f32_16x16x32_bf16(Bt[n][k], At[m][k], acc[ai][bj][m][n], 0, 0, 0); __builtin_amdgcn_s_setprio(0); } while (0)
#define PG8_WAIT_V(n) asm volatile("s_waitcnt vmcnt(" #n ")" ::: "memory")
#define PG8_WAIT_L(n) asm volatile("s_waitcnt lgkmcnt(" #n ")" ::: "memory")
#define PG8_BAR __builtin_amdgcn_s_barrier()
#define PG8_SCHED __builtin_amdgcn_sched_barrier(0)
    Unit cur, nxt; int ui = 0;
    if (!S.next(0, cur)) return;
    f32x4 acc[2][2][4][2];
#pragma unroll
    for (int a = 0; a < 2; ++a)
#pragma unroll
        for (int b = 0; b < 2; ++b)
#pragma unroll
            for (int m = 0; m < 4; ++m)
#pragma unroll
                for (int n = 0; n < 2; ++n) acc[a][b][m][n] = (f32x4){0.f, 0.f, 0.f, 0.f};
    bf16x8 At[4][2], B0[2][2], B1[2][2];
    const char* cA = (const char*)g.A + (size_t)cur.pm * tstepA; const char* cB = (const char*)g.Bt + (size_t)cur.pn * tstepB;
    S.a_ready(cur);
    if constexpr (SP2) {
        PG8_STAGE(PG8_SB(0, 0), cB, voffB); PG8_STAGE(PG8_SB(0, 1), cB + hstepB, voffB); PG8_STAGE(PG8_SA(0, 0), cA, voffA); PG8_STAGE(PG8_SA(0, 1), cA + hstepA, voffA);
        if (wr == 1) PG8_BAR;
        PG8_WAIT_V(2); PG8_BAR;
        PG8_STAGE(PG8_SB(1, 0), cB + kstep, voffB); PG8_STAGE(PG8_SA(1, 0), cA + kstep, voffA); PG8_STAGE(PG8_SB(1, 1), cB + hstepB + kstep, voffB);
        PG8_WAIT_V(6); PG8_BAR;
    } else {
        PG8_STAGE(PG8_SB(0, 0), cB, voffB); PG8_STAGE(PG8_SA(0, 0), cA, voffA); PG8_STAGE(PG8_SB(0, 1), cB + hstepB, voffB); PG8_STAGE(PG8_SA(0, 1), cA + hstepA, voffA);
        if (wr == 1) PG8_BAR;
        PG8_WAIT_V(4); PG8_BAR;
        PG8_STAGE(PG8_SB(1, 0), cB + kstep, voffB); PG8_STAGE(PG8_SA(1, 0), cA + kstep, voffA); PG8_STAGE(PG8_SB(1, 1), cB + hstepB + kstep, voffB);
        PG8_WAIT_V(6); PG8_BAR;
    }
    for (;;) {
        const bool has_next = S.next(ui + 1, nxt);
        const char* nA = has_next ? (const char*)g.A + (size_t)nxt.pm * tstepA : cA; const char* nB = has_next ? (const char*)g.Bt + (size_t)nxt.pn * tstepB : cB;
        for (int t = 0; t < nt; t += 2) {
            const bool last = (t == nt - 2);
            const char* a1 = cA + (size_t)(t + 1) * kstep;
            const char* a2 = last ? nA : cA + (size_t)(t + 2) * kstep; const char* b2 = last ? nB : cB + (size_t)(t + 2) * kstep;
            const char* a3 = a2 + kstep; const char* b3 = b2 + kstep;
            if (last && has_next) S.a_ready(nxt);
            if constexpr (SP2) {
            PG8_LDB(B0, 0, 0); PG8_LDB(B1, 0, 1); PG8_SCHED; PG8_LDA(At, 0, 0); PG8_STAGE(PG8_SA(1, 1), a1 + hstepA, voffA);
            PG8_WAIT_V(8); PG8_WAIT_L(0); PG8_BAR; PG8_MMA(0, 0, At, B0); PG8_MMA(0, 1, At, B1); PG8_BAR; PG8_SCHED;
            PG8_LDA(At, 0, 1); PG8_STAGE(PG8_SB(0, 0), b2, voffB); PG8_STAGE(PG8_SB(0, 1), b2 + hstepB, voffB); PG8_STAGE(PG8_SA(0, 0), a2, voffA);
            PG8_WAIT_V(8); PG8_WAIT_L(0); PG8_BAR; PG8_MMA(1, 0, At, B0); PG8_MMA(1, 1, At, B1); PG8_BAR; PG8_SCHED;
            PG8_LDB(B0, 1, 0); PG8_LDB(B1, 1, 1); PG8_SCHED; PG8_LDA(At, 1, 0); PG8_STAGE(PG8_SA(0, 1), a2 + hstepA, voffA);
            PG8_WAIT_V(8); PG8_WAIT_L(0); PG8_BAR; PG8_MMA(0, 0, At, B0); PG8_MMA(0, 1, At, B1); PG8_BAR; PG8_SCHED;
            PG8_LDA(At, 1, 1); PG8_STAGE(PG8_SB(1, 0), b3, voffB); PG8_STAGE(PG8_SB(1, 1), b3 + hstepB, voffB); PG8_STAGE(PG8_SA(1, 0), a3, voffA);
            PG8_WAIT_V(8); PG8_WAIT_L(0); PG8_BAR; PG8_MMA(1, 0, At, B0); PG8_MMA(1, 1, At, B1); PG8_BAR; PG8_SCHED;
            } else {
            PG8_LDB(B0, 0, 0); PG8_SCHED; PG8_LDA(At, 0, 0); PG8_STAGE(PG8_SA(1, 1), a1 + hstepA, voffA);
            PG8_WAIT_L(8); PG8_BAR; PG8_WAIT_L(0); PG8_MMA(0, 0, At, B0); PG8_BAR; PG8_SCHED;
            PG8_LDB(B1, 0, 1); PG8_STAGE(PG8_SB(0, 0), b2, voffB);
            PG8_BAR; PG8_WAIT_L(0); PG8_MMA(0, 1, At, B1); PG8_BAR;
            PG8_LDA(At, 0, 1); PG8_STAGE(PG8_SA(0, 0), a2, voffA);
            PG8_BAR; PG8_WAIT_L(0); PG8_MMA(1, 0, At, B0); PG8_BAR; PG8_SCHED;
            PG8_STAGE(PG8_SB(0, 1), b2 + hstepB, voffB);
            PG8_WAIT_V(6); PG8_BAR; PG8_MMA(1, 1, At, B1); PG8_BAR;
            PG8_LDB(B0, 1, 0); PG8_SCHED; PG8_LDA(At, 1, 0); PG8_STAGE(PG8_SA(0, 1), a2 + hstepA, voffA);
            PG8_WAIT_L(8); PG8_BAR; PG8_WAIT_L(0); PG8_MMA(0, 0, At, B0); PG8_BAR; PG8_SCHED;
            PG8_LDB(B1, 1, 1); PG8_STAGE(PG8_SB(1, 0), b3, voffB);
            PG8_BAR; PG8_WAIT_L(0); PG8_MMA(0, 1, At, B1); PG8_BAR;
            PG8_LDA(At, 1, 1); PG8_STAGE(PG8_SA(1, 0), a3, voffA);
            PG8_BAR; PG8_WAIT_L(0); PG8_MMA(1, 0, At, B0); PG8_BAR; PG8_SCHED;
            PG8_STAGE(PG8_SB(1, 1), b3 + hstepB, voffB);
            PG8_WAIT_V(6); PG8_BAR; PG8_MMA(1, 1, At, B1); PG8_BAR;
            }
        }
        if constexpr (ALIGN_EPI) { if (wr == 0) PG8_BAR; }
        if constexpr (!Epi::AFTER_DRAIN) { E(acc, cur, wr, wc, fr, fq); S.done(cur); }
        if (!has_next) break;
#pragma unroll
        for (int a = 0; a < 2; ++a)
#pragma unroll
            for (int b = 0; b < 2; ++b)
#pragma unroll
                for (int m = 0; m < 4; ++m)
#pragma unroll
                    for (int n = 0; n < 2; ++n) acc[a][b][m][n] = (f32x4){0.f, 0.f, 0.f, 0.f};
        cur = nxt; cA = nA; cB = nB; ++ui;
        if constexpr (ALIGN_EPI) { if (wr == 1) PG8_BAR; }
    }
    PG8_WAIT_V(0);
    if constexpr (!ALIGN_EPI) { if (wr == 0) PG8_BAR; }
    PG8_BAR;
    if constexpr (Epi::AFTER_DRAIN) { E.fused(acc, cur, wr, wc, fr, fq, lds, wid, lane); S.done(cur); }
#undef PG8_SA
#undef PG8_SB
#undef PG8_STAGE
#undef PG8_LDA
#undef PG8_LDB
#undef PG8_MMA
#undef PG8_WAIT_V
#undef PG8_WAIT_L
#undef PG8_BAR
#undef PG8_SCHED
}
}

typedef unsigned short bf16;
typedef unsigned v4u __attribute__((ext_vector_type(4)));
typedef unsigned v2u __attribute__((ext_vector_type(2)));
typedef float f32x4 __attribute__((ext_vector_type(4)));
typedef short bf16x8 __attribute__((ext_vector_type(8)));

constexpr int D = 1024, MP = 16384, MS = 1024, M = MP + MS, SEQL = 2048, NBATCH = 8, DBATCH = 128;
constexpr int NPROJ = 3072, FF = 2816, NGU = 5632, DIN = 3080, MH = M / 2;
constexpr float EPS = 1e-6f;
constexpr int NTHREADS = 512, NWAVES = 8;
constexpr int LDS_BYTES = 155648;
constexpr size_t MiB = 1u << 20;
constexpr size_t WS_WOUT = 0, WS_WGU = 4 * MiB, WS_WDN = 26 * MiB, WS_XA = 37 * MiB, WS_PROJ = 71 * MiB, WS_GU = 105 * MiB, WS_SCR = 173 * MiB, WS_WIN = 239 * MiB;
constexpr size_t WS_GB = 245 * MiB, WS_SSQ = 245 * MiB + 576 * 1024, WS_WAB = 246 * MiB, WS_GL = 246 * MiB + 64 * 1024, WS_HALO = 246 * MiB + 128 * 1024, WS_BAR = 246 * MiB + 192 * 1024, WS_PART2 = 200 * MiB, WS_HAL = 247 * MiB, WS_FIXG = 249 * MiB, WS_FIXU = 251 * MiB, WS_END = 253 * MiB;
constexpr int SCR_ITEM = 73728;
constexpr size_t O_PDELTA = 17825792, O_PDCONV = 18874368, O_PPOOL = 18948096, O_PSCONV = 19009536, O_PFFN = 19017728;
constexpr size_t O_SDELTA = 19107840, O_SDCONV = 35885056, O_SPOOL = 37064704, O_SSCONV = 38047744, O_SFFN = 38178816, O_TOTAL = 39620608;

struct Params { const float* in[23]; float* out; unsigned char* ws; };
typedef const __attribute__((address_space(4))) Params* KP;
__device__ __forceinline__ KP kparams() { KP p = (KP)__builtin_amdgcn_kernarg_segment_ptr(); asm volatile("" : "+s"(p)); return p; }

#define LAUNDER(p) asm volatile("" : "+s"(p))
#define LDS_WAIT() asm volatile("s_waitcnt lgkmcnt(0)" ::: "memory")
__device__ __forceinline__ unsigned f2bf(float f) { unsigned u = __builtin_bit_cast(unsigned, f); return (u + 0x7fffu + ((u >> 16) & 1u)) >> 16; }
__device__ __forceinline__ unsigned pk2(float lo, float hi) { return f2bf(lo) | (f2bf(hi) << 16); }
__device__ __forceinline__ float bflo(unsigned u) { return __builtin_bit_cast(float, u << 16); }
__device__ __forceinline__ float bfhi(unsigned u) { return __builtin_bit_cast(float, u & 0xffff0000u); }
__device__ __forceinline__ float bf1(bf16 h) { return __builtin_bit_cast(float, ((unsigned)h) << 16); }
__device__ __forceinline__ float siluf(float x) { return x * __builtin_amdgcn_rcpf(1.f + __expf(-x)); }
__device__ __forceinline__ float wave_sum(float v) {
#pragma unroll
    for (int o = 1; o < 64; o <<= 1) v += __shfl_xor(v, o);
    return v;
}
#define UNPACK8(W_, F_) do { (F_)[0] = bflo((W_).x); (F_)[1] = bfhi((W_).x); (F_)[2] = bflo((W_).y); (F_)[3] = bfhi((W_).y); (F_)[4] = bflo((W_).z); (F_)[5] = bfhi((W_).z); (F_)[6] = bflo((W_).w); (F_)[7] = bfhi((W_).w); } while (0)
#define PACK8(F_) ((v4u){pk2((F_)[0], (F_)[1]), pk2((F_)[2], (F_)[3]), pk2((F_)[4], (F_)[5]), pk2((F_)[6], (F_)[7])})

struct EpiScale {
    static constexpr bool PERM = true, AFTER_DRAIN = false;
    bf16* O; int ldc; const float* ssq;
    __device__ __forceinline__ void operator()(const pg8::f32x4 (&acc)[2][2][4][2], const pg8::Unit& u, int wr, int wc, int fr, int fq) const {
        const int row0 = u.pm * 256 + wr * 64 + fr, col0 = u.pn * 256 + wc * 32 + 8 * fq;
#pragma unroll
        for (int ai = 0; ai < 2; ++ai)
#pragma unroll
            for (int m = 0; m < 4; ++m) {
                const int row = row0 + ai * 128 + m * 16;
                const float rs = rsqrtf(ssq[row] * (1.f / D) + EPS);
                bf16* rowp = O + (size_t)row * ldc + col0;
#pragma unroll
                for (int bj = 0; bj < 2; ++bj) {
                    pg8::f32x4 v0 = acc[ai][bj][m][0] * rs, v1 = acc[ai][bj][m][1] * rs;
                    v4u w; w.x = pk2(v0[0], v0[1]); w.y = pk2(v0[2], v0[3]); w.z = pk2(v1[0], v1[1]); w.w = pk2(v1[2], v1[3]);
                    *(v4u*)(rowp + bj * 128) = w;
                }
            }
    }
};
struct EpiResid {
    static constexpr bool PERM = true, AFTER_DRAIN = false;
    const float* xa; const float* xb_; float* xres; bf16* xb16; float* ssq; int rowbase;
    __device__ __forceinline__ void operator()(const pg8::f32x4 (&acc)[2][2][4][2], const pg8::Unit& u, int wr, int wc, int fr, int fq) const {
        const int row0 = rowbase + u.pm * 256 + wr * 64 + fr, col0 = u.pn * 256 + wc * 32 + 8 * fq;
#pragma unroll
        for (int ai = 0; ai < 2; ++ai)
#pragma unroll
            for (int m = 0; m < 4; ++m) {
                const int row = row0 + ai * 128 + m * 16;
                const float* xo = (row < MP ? xa + (size_t)row * D : xb_ + (size_t)(row - MP) * D) + col0;
                float* xr = xres + (size_t)row * D + col0;
                bf16* xh = xb16 + (size_t)row * D + col0;
                float ss = 0.f;
#pragma unroll
                for (int bj = 0; bj < 2; ++bj) {
                    const pg8::f32x4 o0 = *(const pg8::f32x4*)(xo + bj * 128), o1 = *(const pg8::f32x4*)(xo + bj * 128 + 4);
                    pg8::f32x4 v0 = acc[ai][bj][m][0] + o0, v1 = acc[ai][bj][m][1] + o1;
                    *(pg8::f32x4*)(xr + bj * 128) = v0; *(pg8::f32x4*)(xr + bj * 128 + 4) = v1;
                    v4u w; w.x = pk2(v0[0], v0[1]); w.y = pk2(v0[2], v0[3]); w.z = pk2(v1[0], v1[1]); w.w = pk2(v1[2], v1[3]);
                    *(v4u*)(xh + bj * 128) = w;
                    ss += v0[0] * v0[0] + v0[1] * v0[1] + v0[2] * v0[2] + v0[3] * v0[3] + v1[0] * v1[0] + v1[1] * v1[1] + v1[2] * v1[2] + v1[3] * v1[3];
                }
                ss += __shfl_xor(ss, 16); ss += __shfl_xor(ss, 32);
                if (fq == 0) atomicAdd(ssq + row, ss);
            }
    }
};


struct SplitOrder {
    int unit;
    __device__ __forceinline__ bool next(int i, pg8::Unit& u) const { if (i != 0 || unit < 0) return false; u.pm = unit >> 2; u.pn = unit & 3; return true; }
    __device__ __forceinline__ void a_ready(const pg8::Unit&) const {}
    __device__ __forceinline__ void done(const pg8::Unit&) const {}
};
struct EpiAtomic {
    static constexpr bool PERM = true, AFTER_DRAIN = false;
    float* X;
    __device__ __forceinline__ void operator()(const pg8::f32x4 (&acc)[2][2][4][2], const pg8::Unit& u, int wr, int wc, int fr, int fq) const {
        const int row0 = u.pm * 256 + wr * 64 + fr, col0 = u.pn * 256 + wc * 32 + 8 * fq;
#pragma unroll
        for (int ai = 0; ai < 2; ++ai)
#pragma unroll
            for (int m = 0; m < 4; ++m) {
                float* xr = X + (size_t)(row0 + ai * 128 + m * 16) * D + col0;
#pragma unroll
                for (int bj = 0; bj < 2; ++bj) { *(pg8::f32x4*)(xr + bj * 128) = acc[ai][bj][m][0]; *(pg8::f32x4*)(xr + bj * 128 + 4) = acc[ai][bj][m][1]; }
            }
    }
};
__device__ __forceinline__ void fin_sample(float* X, bf16* XB, float* ssq, const float* partA, int nA, const float* partB, int nB, int gw, int ngw, int lane) {
    for (int r = gw; r < MS; r += ngw) {
        f32x4 v[4];
#pragma unroll
        for (int j = 0; j < 4; ++j) v[j] = ((const f32x4*)(X + (size_t)r * D))[lane + 64 * j];
        for (int k = 0; k < nA; ++k) {
#pragma unroll
            for (int j = 0; j < 4; ++j) v[j] += ((const f32x4*)(partA + ((size_t)k * MS + r) * D))[lane + 64 * j];
        }
        for (int k = 0; k < nB; ++k) {
#pragma unroll
            for (int j = 0; j < 4; ++j) v[j] += ((const f32x4*)(partB + ((size_t)k * MS + r) * D))[lane + 64 * j];
        }
        float ss = 0.f;
#pragma unroll
        for (int j = 0; j < 4; ++j) { ss += v[j][0] * v[j][0] + v[j][1] * v[j][1] + v[j][2] * v[j][2] + v[j][3] * v[j][3];
            ((f32x4*)(X + (size_t)r * D))[lane + 64 * j] = v[j];
            ((v2u*)(XB + (size_t)r * D))[lane + 64 * j] = (v2u){pk2(v[j][0], v[j][1]), pk2(v[j][2], v[j][3])}; }
        ss = wave_sum(ss);
        if (lane == 0) ssq[r] = ss;
    }
}

constexpr int EPI_HALO_OFF = 131072;
__device__ __forceinline__ float dpp_f(float oldv, float src, const int ctrl_sel) {
    const int o = __builtin_bit_cast(int, oldv), v = __builtin_bit_cast(int, src); int r;
    if (ctrl_sel == 0) r = __builtin_amdgcn_update_dpp(o, v, 0x111, 0xf, 0xf, false);
    else if (ctrl_sel == 1) r = __builtin_amdgcn_update_dpp(o, v, 0x112, 0xf, 0xf, false);
    else if (ctrl_sel == 2) r = __builtin_amdgcn_update_dpp(o, v, 0x121, 0xf, 0xf, false);
    else r = __builtin_amdgcn_update_dpp(o, v, 0x122, 0xf, 0xf, false);
    return __builtin_bit_cast(float, r);
}
struct EpiGateUp {
    static constexpr bool PERM = true, AFTER_DRAIN = false;
    bf16* ACT; const float* ssq; const float* cw; const float* st; float* HAL; float* FIXG; float* FIXU; float* pffn; float* sffn; unsigned char* lds;
    __device__ __forceinline__ void operator()(const pg8::f32x4 (&acc)[2][2][4][2], const pg8::Unit& u, int wr, int wc, int fr, int fq) const {
        const int pm = u.pm, ch0 = u.pn * 128 + wc * 32 + 8 * fq, row0 = pm * 256 + wr * 64 + fr;
        const bool smp = pm >= 64;
        float* halo = (float*)(lds + EPI_HALO_OFF);
#pragma unroll
        for (int ai = 0; ai < 2; ++ai) {
            const float rs = rsqrtf(ssq[row0 + ai * 128 + 48] * (1.f / D) + EPS);
            if (fr >= 14) {
                float* hp = halo + ((ai * 2 + wr) * 2 + (fr - 14)) * 128 + wc * 32 + 8 * fq;
                *(pg8::f32x4*)hp = acc[ai][0][3][0] * rs; *(pg8::f32x4*)(hp + 4) = acc[ai][0][3][1] * rs;
            }
        }
        asm volatile("s_waitcnt lgkmcnt(0)" ::: "memory");
        __builtin_amdgcn_s_barrier();
        float w0[8], w1[8], w2[8];
#pragma unroll
        for (int e = 0; e < 8; ++e) { w0[e] = cw[ch0 + e]; w1[e] = cw[FF + ch0 + e]; w2[e] = cw[2 * FF + ch0 + e]; }
#pragma unroll
        for (int ai = 0; ai < 2; ++ai) {
            const int s = ai * 2 + wr;
            float prev[8];
#pragma unroll
            for (int e = 0; e < 8; ++e) prev[e] = 0.f;
            if (!smp && s >= 1 && fr >= 14) {
                const float* hp = halo + ((s - 1) * 2 + (fr - 14)) * 128 + wc * 32 + 8 * fq;
                const pg8::f32x4 h0 = *(const pg8::f32x4*)hp, h1 = *(const pg8::f32x4*)(hp + 4);
                prev[0] = h0[0]; prev[1] = h0[1]; prev[2] = h0[2]; prev[3] = h0[3]; prev[4] = h1[0]; prev[5] = h1[1]; prev[6] = h1[2]; prev[7] = h1[3];
            }
#pragma unroll
            for (int m = 0; m < 4; ++m) {
                const int row = row0 + ai * 128 + m * 16;
                const float rs = rsqrtf(ssq[row] * (1.f / D) + EPS);
                float cur[8], upv[8], s0v[8], s1v[8];
#pragma unroll
                for (int e = 0; e < 8; ++e) { cur[e] = acc[ai][0][m][e >> 2][e & 3] * rs; upv[e] = acc[ai][1][m][e >> 2][e & 3] * rs; s0v[e] = 0.f; s1v[e] = 0.f; }
                const int t = fr & 7, sb = (row - MP) >> 3;
                if (smp && t < 2) {
                    const float* sp = st + (size_t)(sb * 2) * FF + ch0;
#pragma unroll
                    for (int e = 0; e < 8; ++e) { s0v[e] = sp[e]; s1v[e] = sp[FF + e]; }
                }
                float a[8];
#pragma unroll
                for (int e = 0; e < 8; ++e) {
                    const float sh1 = dpp_f(cur[e], cur[e], 0), sh2 = dpp_f(cur[e], cur[e], 1), ro1 = dpp_f(prev[e], prev[e], 2), ro2 = dpp_f(prev[e], prev[e], 3);
                    float p1, p2;
                    if (smp) { p1 = t >= 1 ? sh1 : s1v[e]; p2 = t >= 2 ? sh2 : (t == 1 ? s1v[e] : s0v[e]); }
                    else { p1 = fr >= 1 ? sh1 : ro1; p2 = fr >= 2 ? sh2 : ro2; }
                    a[e] = siluf(w0[e] * p2 + w1[e] * p1 + w2[e] * cur[e]) * upv[e];
                }
                *(v4u*)(ACT + (size_t)row * FF + ch0) = PACK8(a);
                if (smp) {
                    if (t >= 6) { float* o = sffn + (size_t)(sb * 2 + t - 6) * FF + ch0;
                        *(pg8::f32x4*)o = (pg8::f32x4){cur[0], cur[1], cur[2], cur[3]}; *(pg8::f32x4*)(o + 4) = (pg8::f32x4){cur[4], cur[5], cur[6], cur[7]}; }
                } else {
                    if (s == 3 && m == 3 && fr >= 14) {
                        float* o = HAL + (size_t)(pm * 2 + fr - 14) * FF + ch0;
                        *(pg8::f32x4*)o = (pg8::f32x4){cur[0], cur[1], cur[2], cur[3]}; *(pg8::f32x4*)(o + 4) = (pg8::f32x4){cur[4], cur[5], cur[6], cur[7]};
                        if ((pm & 7) == 7) { float* o2 = pffn + (size_t)((pm >> 3) * 2 + fr - 14) * FF + ch0;
                            *(pg8::f32x4*)o2 = (pg8::f32x4){cur[0], cur[1], cur[2], cur[3]}; *(pg8::f32x4*)(o2 + 4) = (pg8::f32x4){cur[4], cur[5], cur[6], cur[7]}; }
                    }
                    if (s == 0 && m == 0 && fr < 2 && (pm & 7) != 0) {
                        float* o = FIXG + (size_t)(pm * 2 + fr) * FF + ch0; float* o2 = FIXU + (size_t)(pm * 2 + fr) * FF + ch0;
                        *(pg8::f32x4*)o = (pg8::f32x4){cur[0], cur[1], cur[2], cur[3]}; *(pg8::f32x4*)(o + 4) = (pg8::f32x4){cur[4], cur[5], cur[6], cur[7]};
                        *(pg8::f32x4*)o2 = (pg8::f32x4){upv[0], upv[1], upv[2], upv[3]}; *(pg8::f32x4*)(o2 + 4) = (pg8::f32x4){upv[4], upv[5], upv[6], upv[7]};
                    }
                }
#pragma unroll
                for (int e = 0; e < 8; ++e) prev[e] = cur[e];
            }
        }
    }
};
__device__ __forceinline__ void p4_fixup(KP P, int l, int start, int stride) {
    const float* HAL = (const float*)(P->ws + WS_HAL); const float* FIXG = (const float*)(P->ws + WS_FIXG); const float* FIXU = (const float*)(P->ws + WS_FIXU);
    bf16* ACT = (bf16*)(P->ws + WS_GU);
    const float* cw = P->in[19] + (size_t)(l * 3) * FF;
    for (int idx = start; idx < 56 * 2 * FF; idx += stride) {
        const int k = idx / (2 * FF), rem = idx % (2 * FF), rr = rem / FF, c = rem % FF;
        const int pm = (k / 7) * 8 + 1 + (k % 7);
        const float g0 = FIXG[(size_t)(pm * 2 + rr) * FF + c];
        const float g1 = rr == 0 ? HAL[(size_t)((pm - 1) * 2 + 1) * FF + c] : FIXG[(size_t)(pm * 2) * FF + c];
        const float g2 = rr == 0 ? HAL[(size_t)((pm - 1) * 2) * FF + c] : HAL[(size_t)((pm - 1) * 2 + 1) * FF + c];
        const float a = siluf(cw[c] * g2 + cw[FF + c] * g1 + cw[2 * FF + c] * g0) * FIXU[(size_t)(pm * 2 + rr) * FF + c];
        ACT[(size_t)(pm * 256 + rr) * FF + c] = (bf16)f2bf(a);
    }
}
__device__ __forceinline__ void transpose_item(const float* W, int K, int ldw, int src_col0, const float* g, bf16* WT, int dst_row0, float* scr, int kb, int lane) {
    const int k0 = 64 * kb;
#pragma unroll 8
    for (int i = 0; i < 32; ++i) { const int kk = 2 * i + (lane >> 5); const float gs = g ? g[k0 + kk] : 1.f;
        scr[kk * 33 + (lane & 31)] = W[(size_t)(k0 + kk) * ldw + src_col0 + (lane & 31)] * gs; }
    LDS_WAIT();
    const int c = lane & 7;
#pragma unroll
    for (int j = 0; j < 4; ++j) { const int n = (lane >> 3) + 8 * j; const float* s = scr + (8 * c) * 33 + n;
        v4u o; o.x = pk2(s[0 * 33], s[1 * 33]); o.y = pk2(s[2 * 33], s[3 * 33]); o.z = pk2(s[4 * 33], s[5 * 33]); o.w = pk2(s[6 * 33], s[7 * 33]);
        *(v4u*)(WT + (size_t)(dst_row0 + n) * K + k0 + 8 * c) = o; }
    LDS_WAIT();
}
__device__ __forceinline__ void convert_matrix(const float* W, int K, int N, int ldw, int skip_from, int skip, const float* g, bf16* WT, int dst_row0, float* scr, int gw, int ngw, int lane, int il = 0) {
    const int nnb = N / 32, nit = (K / 64) * nnb;
    for (int it = gw; it < nit; it += ngw) {
        const int kb = it / nnb, nb = it % nnb, n0 = nb * 32;
        const int drow = il ? ((n0 >> 7) * 256 + (n0 & 127) + (il == 2 ? 128 : 0)) : n0;
        transpose_item(W, K, ldw, n0 + (n0 >= skip_from ? skip : 0), g, WT, dst_row0 + drow, scr, kb, lane);
    }
}
__device__ __forceinline__ void convert_layer_rest(KP P, int l, float* scr, int gw, int ngw, int lane) {
    unsigned char* ws = P->ws;
    convert_matrix(P->in[16] + (size_t)l * D * D, D, D, D, 1 << 30, 0, nullptr, (bf16*)(ws + WS_WOUT) + (size_t)l * D * D, 0, scr, gw, ngw, lane);
    convert_matrix(P->in[18] + (size_t)l * D * FF, D, FF, FF, 1 << 30, 0, P->in[17] + l * D, (bf16*)(ws + WS_WGU) + (size_t)l * NGU * D, 0, scr, gw, ngw, lane, 1);
    convert_matrix(P->in[20] + (size_t)l * D * FF, D, FF, FF, 1 << 30, 0, P->in[17] + l * D, (bf16*)(ws + WS_WGU) + (size_t)l * NGU * D, 0, scr, gw, ngw, lane, 2);
    convert_matrix(P->in[21] + (size_t)l * FF * D, FF, D, D, 1 << 30, 0, nullptr, (bf16*)(ws + WS_WDN) + (size_t)l * D * FF, 0, scr, gw, ngw, lane);
}
__device__ __forceinline__ void convert_win(KP P, int l, float* scr, int gw, int ngw, int lane) {
    convert_matrix(P->in[8] + (size_t)l * D * DIN, D, NPROJ, DIN, 2048, 8, P->in[7] + l * D, (bf16*)(P->ws + WS_WIN), 0, scr, gw, ngw, lane);
}

constexpr int B_QF = 0, B_KF = 33792, B_VF = 67584, B_AT = 101376, B_GC = 118784, B_QKS = 120320, B_WST = 128512;
__device__ __forceinline__ void p2b_item(KP P, int l, int item, unsigned char* lds, int wave_in) {
    const int tid = fresh_tid(wave_in);
    const int h = item & 3, n = (item >> 2) & 31, b = item >> 7;
    const int lane = tid & 63, wv = __builtin_amdgcn_readfirstlane(tid >> 6), fr = lane & 15, fq = lane >> 4;
    float* QF = (float*)(lds + B_QF); float* KF = (float*)(lds + B_KF); float* VF = (float*)(lds + B_VF); float* AT = (float*)(lds + B_AT);
    float* Gs = (float*)(lds + B_GC); float* BETA = Gs + 64; float* GC = Gs + 128; float* EG = Gs + 192; float* EKD = Gs + 256;
    bf16* QKS = (bf16*)(lds + B_QKS); bf16* WST = (bf16*)(lds + B_WST);
    const bf16* PROJ = (const bf16*)(P->ws + WS_PROJ);
    const float* GB = (const float*)(P->ws + WS_GB);
    unsigned char* scr = P->ws + WS_SCR + (size_t)item * SCR_ITEM;
    if (tid < 384) {
        const int chunk = tid % 48, tg = tid / 48, part = chunk >> 4, cc = chunk & 15;
        const int col = part * 512 + h * 128 + cc * 8;
        const float* cw = P->in[9] + (size_t)(l * 4) * 1536 + col;
        float w0[8], w1[8], w2[8], w3[8];
#pragma unroll
        for (int e = 0; e < 8; ++e) { w0[e] = cw[e]; w1[e] = cw[1536 + e]; w2[e] = cw[2 * 1536 + e]; w3[e] = cw[3 * 1536 + e]; }
        const int t0 = n * 64 + tg * 8;
        const bf16* base = PROJ + (size_t)(b * SEQL) * NPROJ + col;
        float r0[8], r1[8], r2[8], r3[8];
#pragma unroll
        for (int e = 0; e < 8; ++e) { r0[e] = 0.f; r1[e] = 0.f; r2[e] = 0.f; }
        if (t0 - 3 >= 0) { const v4u w = *(const v4u*)(base + (size_t)(t0 - 3) * NPROJ); UNPACK8(w, r0); }
        if (t0 - 2 >= 0) { const v4u w = *(const v4u*)(base + (size_t)(t0 - 2) * NPROJ); UNPACK8(w, r1); }
        if (t0 - 1 >= 0) { const v4u w = *(const v4u*)(base + (size_t)(t0 - 1) * NPROJ); UNPACK8(w, r2); }
        float* dst = (float*)(lds + part * 33792) + cc * 8;
#pragma unroll
        for (int i = 0; i < 8; ++i) {
            const v4u w = *(const v4u*)(base + (size_t)(t0 + i) * NPROJ); UNPACK8(w, r3);
            float s[8];
#pragma unroll
            for (int e = 0; e < 8; ++e) { const float cv = w0[e] * r0[e] + w1[e] * r1[e] + w2[e] * r2[e] + w3[e] * r3[e]; s[e] = siluf(cv); }
            float* d = dst + (tg * 8 + i) * 132;
            *(f32x4*)d = (f32x4){s[0], s[1], s[2], s[3]}; *(f32x4*)(d + 4) = (f32x4){s[4], s[5], s[6], s[7]};
#pragma unroll
            for (int e = 0; e < 8; ++e) { r0[e] = r1[e]; r1[e] = r2[e]; r2[e] = r3[e]; }
        }
    }
    if (tid < 64) { const int row = b * SEQL + n * 64 + tid; Gs[tid] = GB[(size_t)row * 8 + h]; BETA[tid] = GB[(size_t)row * 8 + 4 + h]; }
    __syncthreads();
    {
        const int tok = tid >> 3, sub = tid & 7;
        float* qr = QF + tok * 132 + sub * 16; float* kr = KF + tok * 132 + sub * 16;
        float qv[16], kv[16]; float sq = 0.f, sk = 0.f;
#pragma unroll
        for (int e = 0; e < 16; ++e) { qv[e] = qr[e]; kv[e] = kr[e]; sq += qv[e] * qv[e]; sk += kv[e] * kv[e]; }
        sq += __shfl_xor(sq, 1); sq += __shfl_xor(sq, 2); sq += __shfl_xor(sq, 4);
        sk += __shfl_xor(sk, 1); sk += __shfl_xor(sk, 2); sk += __shfl_xor(sk, 4);
        const float rq = rsqrtf(sq + EPS) * 0.08838834764831845f, rk = rsqrtf(sk + EPS);
#pragma unroll
        for (int e = 0; e < 16; ++e) { qr[e] = qv[e] * rq; kr[e] = kv[e] * rk; }
    }
    if (tid < 64) {
        float v = Gs[tid];
#pragma unroll
        for (int o = 1; o < 64; o <<= 1) { const float t = __shfl_up(v, o); if (tid >= o) v += t; }
        const float tot = __shfl(v, 63);
        GC[tid] = v; EG[tid] = __expf(v); EKD[tid] = __expf(tot - v);
        if (tid == 0) ((float*)(P->ws + WS_GL))[item] = __expf(tot);
    }
    __syncthreads();
    {
        const int p = wv >> 2, mt = wv & 3;
        const float* X = p ? QF : KF;
        f32x4 acc[4];
#pragma unroll
        for (int nt = 0; nt < 4; ++nt) acc[nt] = (f32x4){0.f, 0.f, 0.f, 0.f};
        const float* xa = X + (mt * 16 + fr) * 132 + fq; const float* kb_ = KF + fr * 132 + fq;
#pragma unroll 8
        for (int k = 0; k < 128; k += 4) {
            const float a = xa[k];
#pragma unroll
            for (int nt = 0; nt < 4; ++nt) acc[nt] = __builtin_amdgcn_mfma_f32_16x16x4f32(a, kb_[nt * 16 * 132 + k], acc[nt], 0, 0, 0);
        }
#pragma unroll
        for (int nt = 0; nt < 4; ++nt) {
            const int j = nt * 16 + fr; const float gj = GC[j];
            float v[4];
#pragma unroll
            for (int r = 0; r < 4; ++r) {
                const int i = mt * 16 + 4 * fq + r;
                if (p == 0) v[r] = (i > j) ? BETA[i] * acc[nt][r] * __expf(GC[i] - gj) : 0.f;
                else        v[r] = (i >= j) ? acc[nt][r] * __expf(GC[i] - gj) : 0.f;
            }
            if (p == 0) *(f32x4*)(AT + j * 68 + mt * 16 + 4 * fq) = (f32x4){v[0], v[1], v[2], v[3]};
            else {
#pragma unroll
                for (int r = 0; r < 4; ++r) QKS[(mt * 16 + 4 * fq + r) * 64 + j] = (bf16)f2bf(v[r]);
            }
        }
    }
    __syncthreads();
    if (tid < 256) {
        float x[64];
        int zo = 0; asm volatile("" : "+v"(zo));
        const float* ATz = AT + zo; const float* BETAz = BETA + zo; const float* EGz = EG + zo;
        if (tid < 128) {
#pragma unroll
            for (int i = 0; i < 64; ++i) x[i] = BETAz[i] * VF[i * 132 + tid];
        } else {
#pragma unroll
            for (int i = 0; i < 64; ++i) x[i] = BETAz[i] * EGz[i] * KF[i * 132 + tid - 128];
        }
        f32x4 ab[16];
#pragma unroll
        for (int q = 0; q < 16; ++q) ab[q] = *(const f32x4*)(ATz + q * 4);
#pragma unroll
        for (int j = 0; j < 63; ++j) {
            const float xj = x[j];
#pragma unroll
            for (int q = (j + 1) / 4; q < 16; ++q) {
#pragma unroll
                for (int e = 0; e < 4; ++e) if (4 * q + e > j) x[4 * q + e] -= ab[q][e] * xj;
                if (j + 1 < 63 && q >= (j + 2) / 4) ab[q] = *(const f32x4*)(ATz + (j + 1) * 68 + q * 4);
                __builtin_amdgcn_sched_barrier(0);
            }
        }
        if (tid < 128) {
            unsigned char* up = scr + 49152 + tid * 128;
#pragma unroll
            for (int q = 0; q < 8; ++q) *(v4u*)(up + q * 16) = PACK8(x + 8 * q);
        } else {
            const int dk = tid - 128;
#pragma unroll
            for (int i = 0; i < 64; ++i) WST[i * 128 + dk] = (bf16)f2bf(-x[i]);
        }
    } else {
        const int t2 = tid - 256;
        {
            const int tok = t2 >> 2, seg = t2 & 3; const float eg = EG[tok]; const float* s = QF + tok * 132 + seg * 32;
            unsigned char* o = scr + 16384 + tok * 256 + seg * 64;
#pragma unroll
            for (int q = 0; q < 4; ++q) { float f[8];
#pragma unroll
                for (int e = 0; e < 8; ++e) f[e] = s[q * 8 + e] * eg;
                *(v4u*)(o + q * 16) = PACK8(f); }
        }
        {
            const int dk = t2 >> 1, hf = t2 & 1; unsigned char* o = scr + 32768 + dk * 128 + hf * 64;
#pragma unroll
            for (int q = 0; q < 4; ++q) { float f[8];
#pragma unroll
                for (int e = 0; e < 8; ++e) { const int tok = hf * 32 + q * 8 + e; f[e] = KF[tok * 132 + dk] * EKD[tok]; }
                *(v4u*)(o + q * 16) = PACK8(f); }
        }
#pragma unroll
        for (int q = 0; q < 2; ++q) { const int c = t2 + 256 * q; *(v4u*)(scr + 65536 + c * 16) = *(const v4u*)((const unsigned char*)QKS + c * 16); }
    }
    __syncthreads();
#pragma unroll
    for (int q = 0; q < 2; ++q) { const int c = tid + 512 * q; *(v4u*)(scr + c * 16) = *(const v4u*)((const unsigned char*)WST + c * 16); }
    __syncthreads();
}

constexpr int S_ST = 0, S_VNT = 34816, S_OPW = 53248, S_OPQG = 70656, S_OPKD = 88064, S_OPQK = 106496, S_OPU = 115712;
__device__ __forceinline__ void scan_load(v4u (&pre)[9], const unsigned char* src, int tid) {
#pragma unroll
    for (int i = 0; i < 9; ++i) pre[i] = *(const v4u*)(src + (size_t)(tid + 512 * i) * 16);
}
__device__ __forceinline__ void scan_chunk(v4u (&pre)[9], f32x4 (&sacc)[8], unsigned char* lds, unsigned char* scrbase, int item, int n, float egl, int tid, int w, int fr, int fq) {
    __syncthreads();
#pragma unroll
    for (int i = 0; i < 9; ++i) {
        const int e = (tid + 512 * i) * 16 - (i >> 1) * 16384;
        if (i < 4) { const int row = e >> 8, cb = e & 255; *(v4u*)(lds + (i < 2 ? S_OPW : S_OPQG) + row * 272 + cb) = pre[i]; }
        else { const int row = e >> 7, cb = e & 127; *(v4u*)(lds + (i < 6 ? S_OPKD : (i < 8 ? S_OPU : S_OPQK)) + row * 144 + cb) = pre[i]; }
    }
    __syncthreads();
    if (n + 2 < 32) scan_load(pre, scrbase + (size_t)(item + 8) * SCR_ITEM, tid);
#define SB() __builtin_amdgcn_sched_barrier(0)
    bf16x8 sf[4];
#pragma unroll
    for (int ks = 0; ks < 4; ++ks) sf[ks] = *(const bf16x8*)(lds + S_ST + (16 * w + fr) * 272 + (ks * 32 + 8 * fq) * 2);
    f32x4 vt[4];
    v2u uu[4];
#pragma unroll
    for (int tt = 0; tt < 4; ++tt) uu[tt] = *(const v2u*)(lds + S_OPU + (16 * w + fr) * 144 + (tt * 16 + 4 * fq) * 2);
    {
        bf16x8 af[4][4];
#pragma unroll
        for (int ks = 0; ks < 4; ++ks)
#pragma unroll
            for (int tt = 0; tt < 4; ++tt) af[ks][tt] = *(const bf16x8*)(lds + S_OPW + (tt * 16 + fr) * 272 + (ks * 32 + 8 * fq) * 2);
        SB();
#pragma unroll
        for (int tt = 0; tt < 4; ++tt) vt[tt] = (f32x4){bflo(uu[tt].x), bfhi(uu[tt].x), bflo(uu[tt].y), bfhi(uu[tt].y)};
#pragma unroll
        for (int ks = 0; ks < 4; ++ks)
#pragma unroll
            for (int tt = 0; tt < 4; ++tt) vt[tt] = __builtin_amdgcn_mfma_f32_16x16x32_bf16(af[ks][tt], sf[ks], vt[tt], 0, 0, 0);
        SB();
    }
#pragma unroll
    for (int tt = 0; tt < 4; ++tt) *(v2u*)(lds + S_VNT + (16 * w + fr) * 144 + (tt * 16 + 4 * fq) * 2) = (v2u){pk2(vt[tt][0], vt[tt][1]), pk2(vt[tt][2], vt[tt][3])};
    f32x4 ot[4];
#pragma unroll
    for (int nt = 0; nt < 4; ++nt) ot[nt] = (f32x4){0.f, 0.f, 0.f, 0.f};
    {
        bf16x8 bq[4][4];
#pragma unroll
        for (int ks = 0; ks < 4; ++ks)
#pragma unroll
            for (int nt = 0; nt < 4; ++nt) bq[ks][nt] = *(const bf16x8*)(lds + S_OPQG + (nt * 16 + fr) * 272 + (ks * 32 + 8 * fq) * 2);
        SB();
#pragma unroll
        for (int ks = 0; ks < 4; ++ks)
#pragma unroll
            for (int nt = 0; nt < 4; ++nt) ot[nt] = __builtin_amdgcn_mfma_f32_16x16x32_bf16(sf[ks], bq[ks][nt], ot[nt], 0, 0, 0);
        SB();
    }
    LDS_WAIT();
    bf16x8 vf[2];
#pragma unroll
    for (int js = 0; js < 2; ++js) vf[js] = *(const bf16x8*)(lds + S_VNT + (16 * w + fr) * 144 + (js * 32 + 8 * fq) * 2);
    {
        bf16x8 bk[2][4];
#pragma unroll
        for (int js = 0; js < 2; ++js)
#pragma unroll
            for (int nt = 0; nt < 4; ++nt) bk[js][nt] = *(const bf16x8*)(lds + S_OPQK + (nt * 16 + fr) * 144 + (js * 32 + 8 * fq) * 2);
        SB();
#pragma unroll
        for (int js = 0; js < 2; ++js)
#pragma unroll
            for (int nt = 0; nt < 4; ++nt) ot[nt] = __builtin_amdgcn_mfma_f32_16x16x32_bf16(vf[js], bk[js][nt], ot[nt], 0, 0, 0);
        SB();
    }
    {
        float* oraw = (float*)(scrbase + (size_t)item * SCR_ITEM);
#pragma unroll
        for (int nt = 0; nt < 4; ++nt) *(f32x4*)(oraw + (nt * 16 + fr) * 128 + 16 * w + 4 * fq) = ot[nt];
    }
    {
        bf16x8 ak[2][8];
#pragma unroll
        for (int js = 0; js < 2; ++js)
#pragma unroll
            for (int mt = 0; mt < 8; ++mt) ak[js][mt] = *(const bf16x8*)(lds + S_OPKD + (mt * 16 + fr) * 144 + (js * 32 + 8 * fq) * 2);
        SB();
#pragma unroll
        for (int mt = 0; mt < 8; ++mt) sacc[mt] = sacc[mt] * egl;
#pragma unroll
        for (int js = 0; js < 2; ++js)
#pragma unroll
            for (int mt = 0; mt < 8; ++mt) sacc[mt] = __builtin_amdgcn_mfma_f32_16x16x32_bf16(ak[js][mt], vf[js], sacc[mt], 0, 0, 0);
        SB();
    }
#pragma unroll
    for (int mt = 0; mt < 8; ++mt) *(v2u*)(lds + S_ST + (16 * w + fr) * 272 + (mt * 16 + 4 * fq) * 2) = (v2u){pk2(sacc[mt][0], sacc[mt][1]), pk2(sacc[mt][2], sacc[mt][3])};
#undef SB
    LDS_WAIT();
}
__device__ __forceinline__ void scan_wg(KP P, int l, int bh, unsigned char* lds, int tid) {
    const int b = bh >> 2, h = bh & 3;
    const int lane = tid & 63, w = __builtin_amdgcn_readfirstlane(tid >> 6), fr = lane & 15, fq = lane >> 4;
    unsigned char* scrbase = P->ws + WS_SCR;
    f32x4 sacc[8];
#pragma unroll
    for (int mt = 0; mt < 8; ++mt) sacc[mt] = (f32x4){0.f, 0.f, 0.f, 0.f};
    { unsigned zz0 = 0u; asm volatile("" : "+v"(zz0)); for (int q = lane; q < 272; q += 64) *(v4u*)(lds + S_ST + (16 * w) * 272 + q * 16) = (v4u){zz0, zz0, zz0, zz0}; }
    const int item0 = (b * 32) * 4 + h;
    const float glv = ((const float*)(P->ws + WS_GL))[item0 + 4 * (lane & 31)];
    v4u preA[9], preB[9];
    scan_load(preA, scrbase + (size_t)item0 * SCR_ITEM, tid);
    scan_load(preB, scrbase + (size_t)(item0 + 4) * SCR_ITEM, tid);
#pragma unroll 1
    for (int n = 0; n < 32; n += 2) {
        scan_chunk(preA, sacc, lds, scrbase, item0 + 4 * n, n, __shfl(glv, n), tid, w, fr, fq);
        scan_chunk(preB, sacc, lds, scrbase, item0 + 4 * n + 4, n + 1, __shfl(glv, n + 1), tid, w, fr, fq);
    }
    {
        const int lane2 = lane_id(), fr2 = lane2 & 15, fq2 = lane2 >> 4;
        float* pd = P->out + O_PDELTA + (size_t)((l * NBATCH + b) * 4 + h) * 16384;
#pragma unroll
        for (int mt = 0; mt < 8; ++mt)
#pragma unroll
            for (int r = 0; r < 4; ++r) pd[(mt * 16 + 4 * fq2 + r) * 128 + 16 * w + fr2] = sacc[mt][r];
    }
    __syncthreads();
}
__device__ __forceinline__ void p2d(KP P, int l, int gw, int ngw, int lane) {
    const bf16* PROJ = (const bf16*)(P->ws + WS_PROJ);
    bf16* OCAT = (bf16*)(P->ws + WS_XA);
    const float on0 = P->in[12][l * 128 + lane * 2], on1 = P->in[12][l * 128 + lane * 2 + 1];
    for (int pair0 = gw; pair0 < MP * 4; pair0 += 4 * ngw) {
        float o0[4], o1[4]; unsigned zz[4];
#pragma unroll
        for (int q = 0; q < 4; ++q) {
            const int pair = pair0 + q * ngw;
            o0[q] = 0.f; o1[q] = 0.f; zz[q] = 0u;
            if (pair < MP * 4) {
                const int row = pair >> 2, h = pair & 3, b = row >> 11, t = row & 2047, n = t >> 6, tok = t & 63;
                const int item = (b * 32 + n) * 4 + h;
                const float* o = (const float*)(P->ws + WS_SCR + (size_t)item * SCR_ITEM) + tok * 128 + lane * 2;
                o0[q] = o[0]; o1[q] = o[1];
                zz[q] = *(const unsigned*)(PROJ + (size_t)row * NPROJ + 1536 + h * 128 + lane * 2);
            }
        }
#pragma unroll
        for (int q = 0; q < 4; ++q) {
            const int pair = pair0 + q * ngw;
            const float rs = rsqrtf(wave_sum(o0[q] * o0[q] + o1[q] * o1[q]) * (1.f / 128.f) + EPS);
            if (pair < MP * 4) {
                const int row = pair >> 2, h = pair & 3;
                *(unsigned*)(OCAT + (size_t)row * D + h * 128 + lane * 2) = pk2(o0[q] * rs * on0 * siluf(bflo(zz[q])), o1[q] * rs * on1 * siluf(bfhi(zz[q])));
            }
        }
    }
}

__device__ __forceinline__ void sample_delta(KP P, int l, int it, unsigned char* lds, int wave_in) {
    const int tid = fresh_tid(wave_in);
    const int gq = tid >> 7, c = tid & 127, wv2 = (tid >> 6) & 1, lane = tid & 63;
    const int item = it * 4 + gq, sb = item >> 2, h = item & 3, rowbase = MP + sb * 8;
    float* QS = (float*)(lds + gq * 12288); float* KS = QS + 1024; float* VS = QS + 2048;
    float* RED2 = (float*)(lds + 49152);
    const bf16* PROJ = (const bf16*)(P->ws + WS_PROJ);
    const float* GB = (const float*)(P->ws + WS_GB);
    bf16* OCAT = (bf16*)(P->ws + WS_XA);
#pragma unroll
    for (int part = 0; part < 3; ++part) {
        const int col = part * 512 + h * 128 + c;
        const float* cw = P->in[9] + (size_t)(l * 4) * 1536 + col;
        const float w0 = cw[0], w1 = cw[1536], w2 = cw[2 * 1536], w3 = cw[3 * 1536];
        const float* hs = P->in[3] + (size_t)((l * DBATCH + sb) * 3) * 1536 + col;
        float r0 = hs[0], r1 = hs[1536], r2 = hs[2 * 1536];
        float* dst = QS + part * 1024 + c;
#pragma unroll
        for (int t = 0; t < 8; ++t) {
            const float x = bf1(PROJ[(size_t)(rowbase + t) * NPROJ + col]);
            dst[t * 128] = siluf(w0 * r0 + w1 * r1 + w2 * r2 + w3 * x);
            r0 = r1; r1 = r2; r2 = x;
        }
    }
#pragma unroll
    for (int t = 0; t < 8; ++t) {
        const float q = QS[t * 128 + c], k = KS[t * 128 + c];
        const float sq = wave_sum(q * q), sk = wave_sum(k * k);
        if (lane == 0) { RED2[(gq * 2 + wv2) * 16 + t] = sq; RED2[(gq * 2 + wv2) * 16 + 8 + t] = sk; }
    }
    __syncthreads();
#pragma unroll
    for (int t = 0; t < 8; ++t) {
        const float tq = RED2[(gq * 2) * 16 + t] + RED2[(gq * 2 + 1) * 16 + t], tk = RED2[(gq * 2) * 16 + 8 + t] + RED2[(gq * 2 + 1) * 16 + 8 + t];
        QS[t * 128 + c] *= rsqrtf(tq + EPS) * 0.08838834764831845f; KS[t * 128 + c] *= rsqrtf(tk + EPS);
    }
    __syncthreads();
    float s[128];
    {
        const float* S0 = P->in[2] + (size_t)((l * DBATCH + sb) * 4 + h) * 16384 + c;
#pragma unroll
        for (int d8 = 0; d8 < 16; ++d8) {
#pragma unroll
            for (int e = 0; e < 8; ++e) s[8 * d8 + e] = S0[e * 128];
            S0 += 8 * 128; asm volatile("" : "+v"(S0));
        }
    }
#pragma unroll 1
    for (int t = 0; t < 8; ++t) {
        const float g = GB[(size_t)(rowbase + t) * 8 + h], beta = GB[(size_t)(rowbase + t) * 8 + 4 + h], eg = __expf(g);
        const f32x4* kp = (const f32x4*)(KS + t * 128); const f32x4* qp = (const f32x4*)(QS + t * 128);
        float dot = 0.f;
#pragma unroll
        for (int d4 = 0; d4 < 32; ++d4) { const f32x4 kv = kp[d4]; dot += kv[0] * s[4 * d4] + kv[1] * s[4 * d4 + 1] + kv[2] * s[4 * d4 + 2] + kv[3] * s[4 * d4 + 3];
            if ((d4 & 3) == 3) asm volatile("" ::: "memory"); }
        const float cf = beta * (VS[t * 128 + c] - eg * dot);
        float o = 0.f;
#pragma unroll
        for (int d4 = 0; d4 < 32; ++d4) { const f32x4 kv = kp[d4], qv = qp[d4];
#pragma unroll
            for (int e = 0; e < 4; ++e) { s[4 * d4 + e] = eg * s[4 * d4 + e] + cf * kv[e]; o += qv[e] * s[4 * d4 + e]; }
            if ((d4 & 3) == 3) asm volatile("" ::: "memory"); }
        VS[t * 128 + c] = o;
    }
    {
        float* sd = P->out + O_SDELTA + (size_t)((l * DBATCH + sb) * 4 + h) * 16384 + c;
#pragma unroll
        for (int d8 = 0; d8 < 16; ++d8) {
#pragma unroll
            for (int e = 0; e < 8; ++e) sd[e * 128] = s[8 * d8 + e];
            sd += 8 * 128; asm volatile("" : "+v"(sd));
        }
    }
    __syncthreads();
#pragma unroll
    for (int t = 0; t < 8; ++t) { const float o = VS[t * 128 + c]; const float so = wave_sum(o * o); if (lane == 0) RED2[(gq * 2 + wv2) * 16 + t] = so; }
    __syncthreads();
    const float onv = P->in[12][l * 128 + c];
#pragma unroll
    for (int t = 0; t < 8; ++t) {
        const float tot = RED2[(gq * 2) * 16 + t] + RED2[(gq * 2 + 1) * 16 + t];
        const float z = bf1(PROJ[(size_t)(rowbase + t) * NPROJ + 1536 + h * 128 + c]);
        OCAT[(size_t)(rowbase + t) * D + h * 128 + c] = (bf16)f2bf(VS[t * 128 + c] * rsqrtf(tot * (1.f / 128.f) + EPS) * onv * siluf(z));
    }
    __syncthreads();
}

constexpr int PL_DT = 0, PL_PW = 69632;
__device__ __forceinline__ void pool_tile(KP P, int l, int tile, unsigned char* lds, int wave_in) {
    const int tid = fresh_tid(wave_in);
    float* DT = (float*)(lds + PL_DT); const float* PW = (const float*)(lds + PL_PW);
    const bf16* PROJ = (const bf16*)(P->ws + WS_PROJ);
    bf16* OCAT = (bf16*)(P->ws + WS_XA);
#pragma unroll 1
    for (int i = 0; i < 4; ++i) {
        const int idx = tid + 512 * i, tok = idx & 63, ch8 = idx >> 6, c0 = ch8 * 8, gi = ch8 >> 3, win = 2 << gi;
        int row, t, sb = 0; bool smp;
        if (tile < 256) { t = (tile & 31) * 64 + tok; row = (tile >> 5) * SEQL + t; smp = false; }
        else { sb = (tile - 256) * 8 + (tok >> 3); t = tok & 7; row = MP + sb * 8 + t; smp = true; }
        float ssum[8], cur[8];
#pragma unroll
        for (int e = 0; e < 8; ++e) { ssum[e] = 0.f; cur[e] = 0.f; }
        {
            v4u wv[16];
#pragma unroll
            for (int j = 0; j < 16; ++j) {
                wv[j] = (v4u){0u, 0u, 0u, 0u};
                if (j < win && t - j >= 0) wv[j] = *(const v4u*)(PROJ + (size_t)(row - j) * NPROJ + 2048 + c0);
            }
#pragma unroll
            for (int j = 0; j < 16; ++j) {
                float f[8]; UNPACK8(wv[j], f);
#pragma unroll
                for (int e = 0; e < 8; ++e) { ssum[e] += f[e]; if (j == 0) cur[e] = f[e]; }
            }
            if (smp) {
                for (int j = t + 1; j < win; ++j) { const float* sp = P->in[4] + (size_t)((l * DBATCH + sb) * 15 + 15 + t - j) * 256 + c0;
#pragma unroll
                    for (int e = 0; e < 8; ++e) ssum[e] += sp[e]; }
            }
        }
        const float inv = 1.f / (float)(smp ? win : (t + 1 < win ? t + 1 : win));
#pragma unroll
        for (int e = 0; e < 8; ++e) DT[(c0 + e) * 68 + tok] = ssum[e] * inv - cur[e];
        float u0[8], u1[8], u2[8];
#pragma unroll
        for (int j = 0; j < 3; ++j) {
            const int tt = t - j; float f[8];
            if (tt >= 0) { const v4u wc = *(const v4u*)(PROJ + (size_t)(row - j) * NPROJ + 2816 + c0); const v4u wx = *(const v4u*)(PROJ + (size_t)(row - j) * NPROJ + 2304 + c0);
                float fc[8], fx[8]; UNPACK8(wc, fc); UNPACK8(wx, fx);
#pragma unroll
                for (int e = 0; e < 8; ++e) f[e] = fc[e] * fx[e]; }
            else if (smp) { const float* sp = P->in[5] + (size_t)((l * DBATCH + sb) * 2 + 2 + tt) * 256 + c0;
#pragma unroll
                for (int e = 0; e < 8; ++e) f[e] = sp[e]; }
            else {
#pragma unroll
                for (int e = 0; e < 8; ++e) f[e] = 0.f; }
#pragma unroll
            for (int e = 0; e < 8; ++e) { if (j == 0) u0[e] = f[e]; else if (j == 1) u1[e] = f[e]; else u2[e] = f[e]; }
        }
        const float* sw = P->in[15] + (size_t)(l * 3) * 256 + c0;
        const v4u wb = *(const v4u*)(PROJ + (size_t)row * NPROJ + 2560 + c0); float fb[8]; UNPACK8(wb, fb);
        float oc[8];
#pragma unroll
        for (int e = 0; e < 8; ++e) oc[e] = fb[e] * (sw[e] * u2[e] + sw[256 + e] * u1[e] + sw[512 + e] * u0[e]);
        *(v4u*)(OCAT + (size_t)row * D + 768 + c0) = PACK8(oc);
    }
    __syncthreads();
    {
        const int ep = tid & 255, g = ep >> 6, e = ep & 63, hf = tid >> 8;
        float acc[32];
#pragma unroll
        for (int q = 0; q < 32; ++q) acc[q] = 0.f;
#pragma unroll 2
        for (int c = 0; c < 64; ++c) {
            const float wgt = PW[(g * 64 + c) * 64 + e];
            const f32x4* dp = (const f32x4*)(DT + (g * 64 + c) * 68 + hf * 32);
#pragma unroll
            for (int q = 0; q < 8; ++q) { const f32x4 d = dp[q]; acc[4 * q] += d[0] * wgt; acc[4 * q + 1] += d[1] * wgt; acc[4 * q + 2] += d[2] * wgt; acc[4 * q + 3] += d[3] * wgt; }
        }
        const float sc = P->in[14][l * 256 + ep];
#pragma unroll
        for (int q = 0; q < 32; ++q) {
            const int tok = hf * 32 + q;
            const int row = tile < 256 ? (tile >> 5) * SEQL + (tile & 31) * 64 + tok : MP + (tile - 256) * 64 + tok;
            OCAT[(size_t)row * D + 512 + ep] = (bf16)f2bf(acc[q] * sc);
        }
    }
    __syncthreads();
}

__device__ __forceinline__ void state_copies(KP P, int l, int start, int stride) {
    const bf16* PROJ = (const bf16*)(P->ws + WS_PROJ);
    for (int i = start; i < 136 * 8960; i += stride) {
        const int seq = i / 8960, r = i % 8960;
        const bool smp = seq >= 8; const int sb = seq - 8;
        const int L = smp ? 8 : SEQL; const size_t row0 = smp ? (size_t)MP + sb * 8 : (size_t)seq * SEQL;
        if (r < 4608) {
            const int j = r / 1536, c = r % 1536;
            const float v = bf1(PROJ[(row0 + L - 3 + j) * NPROJ + c]);
            if (smp) P->out[O_SDCONV + (size_t)((l * DBATCH + sb) * 3 + j) * 1536 + c] = v; else P->out[O_PDCONV + (size_t)((l * NBATCH + seq) * 3 + j) * 1536 + c] = v;
        } else if (r < 4608 + 3840) {
            const int r2 = r - 4608, j = r2 / 256, c = r2 % 256;
            if (smp) { const float v = j < 7 ? P->in[4][(size_t)((l * DBATCH + sb) * 15 + 8 + j) * 256 + c] : bf1(PROJ[(row0 + j - 7) * NPROJ + 2048 + c]);
                P->out[O_SPOOL + (size_t)((l * DBATCH + sb) * 15 + j) * 256 + c] = v; }
            else P->out[O_PPOOL + (size_t)((l * NBATCH + seq) * 15 + j) * 256 + c] = bf1(PROJ[(row0 + L - 15 + j) * NPROJ + 2048 + c]);
        } else {
            const int r2 = r - 8448, j = r2 / 256, c = r2 % 256;
            const size_t row = row0 + L - 2 + j;
            const float v = bf1(PROJ[row * NPROJ + 2816 + c]) * bf1(PROJ[row * NPROJ + 2304 + c]);
            if (smp) P->out[O_SSCONV + (size_t)((l * DBATCH + sb) * 2 + j) * 256 + c] = v; else P->out[O_PSCONV + (size_t)((l * NBATCH + seq) * 2 + j) * 256 + c] = v;
        }
    }
}

__device__ __forceinline__ void p4b(KP P, int l, int hf, int start, int stride) {
    bf16* GU = (bf16*)(P->ws + WS_GU); bf16* HALO = (bf16*)(P->ws + WS_HALO);
    const float* cw = P->in[19] + (size_t)(l * 3) * FF;
    const int r0 = hf * MH;
    for (int idx = start; idx < MH * 352; idx += stride) {
        const int lr = idx / 352, c0 = (idx % 352) * 8, m = r0 + lr;
        int t, sb = 0; bool smp;
        if (m < MP) { t = m & (SEQL - 1); smp = false; } else { sb = (m - MP) >> 3; t = (m - MP) & 7; smp = true; }
        float g0[8], g1[8], g2[8];
#pragma unroll
        for (int j = 0; j < 3; ++j) {
            const int tt = t - j; float f[8];
            if (tt < 0) {
                if (smp) { const float* sp = P->in[6] + (size_t)((l * DBATCH + sb) * 2 + 2 + tt) * FF + c0;
#pragma unroll
                    for (int e = 0; e < 8; ++e) f[e] = sp[e]; }
                else {
#pragma unroll
                    for (int e = 0; e < 8; ++e) f[e] = 0.f; }
            } else {
                const v4u w = (lr - j < 0) ? *(const v4u*)(HALO + (size_t)(2 + lr - j) * FF + c0) : *(const v4u*)(GU + (size_t)(lr - j) * NGU + c0);
                UNPACK8(w, f);
            }
#pragma unroll
            for (int e = 0; e < 8; ++e) { if (j == 0) g0[e] = f[e]; else if (j == 1) g1[e] = f[e]; else g2[e] = f[e]; }
        }
        const v4u wu = *(const v4u*)(GU + (size_t)lr * NGU + FF + c0); float fu[8]; UNPACK8(wu, fu);
        float a[8];
#pragma unroll
        for (int e = 0; e < 8; ++e) a[e] = siluf(cw[c0 + e] * g2[e] + cw[FF + c0 + e] * g1[e] + cw[2 * FF + c0 + e] * g0[e]) * fu[e];
        *(v4u*)(GU + (size_t)lr * NGU + FF + c0) = PACK8(a);
        if (!smp && t >= SEQL - 2) { float* o = P->out + O_PFFN + (size_t)((l * NBATCH + (m >> 11)) * 2 + t - (SEQL - 2)) * FF + c0;
#pragma unroll
            for (int e = 0; e < 8; ++e) o[e] = g0[e]; }
        if (smp && t >= 6) { float* o = P->out + O_SFFN + (size_t)((l * DBATCH + sb) * 2 + t - 6) * FF + c0;
#pragma unroll
            for (int e = 0; e < 8; ++e) o[e] = g0[e]; }
        if (hf == 0 && lr >= MH - 2) *(v4u*)(HALO + (size_t)(lr - (MH - 2)) * FF + c0) = *(const v4u*)(GU + (size_t)lr * NGU + c0);
    }
}

#define LAS __attribute__((address_space(3)))
#define XB_TMO      128
#define XB_XCNT(j)  (256  + 64 * (j))
#define XB_XSUB(j)  (1280 + 64 * (j))
#define XB_XGEN(j)  (2304 + 64 * (j))
#define XB_TOP      3328
#define XB_TOPGEN   3392
#define XCD_BAR_WORDS 3456
#define XB_SPIN_CAP (1u << 18)

__device__ __forceinline__ unsigned xb_ld(unsigned* p)              { return __hip_atomic_load(p, __ATOMIC_RELAXED, __HIP_MEMORY_SCOPE_AGENT); }
__device__ __forceinline__ unsigned xb_add(unsigned* p, unsigned v) { return __hip_atomic_fetch_add(p, v, __ATOMIC_RELAXED, __HIP_MEMORY_SCOPE_AGENT); }
__device__ __forceinline__ unsigned xb_xcc_id() { return (unsigned)__builtin_amdgcn_s_getreg((3 << 11) | 20) & 0xFu; }
#define XB_SPIN(cond, bar) do { unsigned _sp = 0; while (cond) { __builtin_amdgcn_s_sleep(1); \
    if ((++_sp & 255u) == 0u) { if (xb_ld(&(bar)[XB_TMO])) break; if (_sp > XB_SPIN_CAP) { atomicAdd(&(bar)[XB_TMO], 1u); break; } } } } while (0)

struct XcdBarrier {
    unsigned* bar; unsigned x;
    volatile LAS unsigned* st;
    int wave;
};

__device__ __forceinline__ XcdBarrier xcd_barrier_post(unsigned* bar, volatile LAS unsigned* st) {
    XcdBarrier b; b.bar = bar; b.x = xb_xcc_id(); b.st = st; b.wave = 0;
    if (threadIdx.x == 0) (void)xb_add(&bar[XB_XCNT(b.x)], 1u);
    return b;
}
__device__ __forceinline__ void xcd_barrier_complete(unsigned* bar, unsigned x, unsigned& nloc, unsigned& nx) {
    const unsigned G = gridDim.x * gridDim.y * gridDim.z;
    unsigned sum, cnt, mine, sp = 0u;
    for (;;) {
        sum = 0u; cnt = 0u; mine = 0u;
#pragma unroll
        for (unsigned j = 0; j < 16; ++j) { const unsigned c = xb_ld(&bar[XB_XCNT(j)]); sum += c; cnt += (c > 0u) ? 1u : 0u; mine = (j == x) ? c : mine; }
        if (sum == G) break;
        __builtin_amdgcn_s_sleep(1);
        if ((++sp & 255u) == 0u) { if (xb_ld(&bar[XB_TMO])) break; if (sp > XB_SPIN_CAP) { atomicAdd(&bar[XB_TMO], 1u); break; } }
    }
    nloc = mine > 0u ? mine : 1u; nx = cnt > 0u ? cnt : 1u;
}

__device__ __forceinline__ void xcd_barrier(const XcdBarrier& b) {
    asm volatile("s_waitcnt vmcnt(0)" ::: "memory");
    __syncthreads();
    if (b.wave == 0 && lane_id() == 0) {
        unsigned* bar = b.bar;
        __builtin_amdgcn_s_waitcnt(0);
        unsigned nloc = b.st[0], nx = b.st[1];
        if (nloc == 0u) { xcd_barrier_complete(bar, b.x, nloc, nx); b.st[0] = nloc; b.st[1] = nx; }
        const unsigned old = xb_add(&bar[XB_XSUB(b.x)], 1u);
        const unsigned gen = old / nloc;
        if (old + 1u == (gen + 1u) * nloc) {
            __builtin_amdgcn_fence(__ATOMIC_RELEASE, "agent");
            asm volatile("s_waitcnt vmcnt(0)" ::: "memory");
            const unsigned og = xb_add(&bar[XB_TOP], 1u);
            const unsigned tg = og / nx;
            if (og + 1u == (tg + 1u) * nx) xb_add(&bar[XB_TOPGEN], 1u);
            else XB_SPIN(xb_ld(&bar[XB_TOPGEN]) == tg, bar);
            __builtin_amdgcn_fence(__ATOMIC_ACQUIRE, "agent");
            xb_add(&bar[XB_XGEN(b.x)], 1u);
            asm volatile("s_waitcnt vmcnt(0)" ::: "memory");
        } else {
            XB_SPIN(xb_ld(&bar[XB_XGEN(b.x)]) == gen, bar);
            __builtin_amdgcn_fence(__ATOMIC_ACQUIRE, "agent");
            asm volatile("s_waitcnt vmcnt(0)" ::: "memory");
        }
    }
    __syncthreads();
}

#define XSYNC1() do { XcdBarrier b_; b_.bar = (unsigned*)(kparams()->ws + WS_BAR); b_.x = xb_xcc_id(); b_.st = (volatile LAS unsigned*)((LAS unsigned char*)lds + (LDS_BYTES - 64)); b_.wave = wave; xcd_barrier(b_); } while (0)
#ifdef PROBE_SYNC2
#define GSYNC() do { XSYNC1(); XSYNC1(); } while (0)
#else
#define GSYNC() XSYNC1()
#endif
__global__ void __launch_bounds__(NTHREADS, 2) fwd_megakernel(Params Parg) {
    KP P = kparams();
    extern __shared__ __attribute__((aligned(16))) unsigned char lds[];
    cg::grid_group grid = cg::this_grid();
    const int wave = __builtin_amdgcn_readfirstlane((int)threadIdx.x >> 6);
    const int tid = fresh_tid(wave), lane = tid & 63;
    const int G = gridDim.x, bx = blockIdx.x;
    const int gw = bx * NWAVES + wave, ngw = G * NWAVES;
    const int gt = bx * NTHREADS + tid, ngt = G * NTHREADS;
    unsigned char* ws = P->ws;
    bf16* XA = (bf16*)(ws + WS_XA); bf16* XB2 = (bf16*)(ws + WS_PROJ); bf16* PROJ = (bf16*)(ws + WS_PROJ); bf16* GU = (bf16*)(ws + WS_GU);
    float* SSQ = (float*)(ws + WS_SSQ); float* GB = (float*)(ws + WS_GB); float* WAB = (float*)(ws + WS_WAB);
    float* XRES = P->out;
    float* wscr = (float*)(lds + wave * 16384);
    volatile LAS unsigned* xst = (volatile LAS unsigned*)((LAS unsigned char*)lds + (LDS_BYTES - 64));
    if (tid < 16) xst[tid] = 0u;
    __syncthreads();
    (void)xcd_barrier_post((unsigned*)(ws + WS_BAR), xst);

    for (int i = gt; i < 4 * M; i += ngt) SSQ[M + i] = 0.f;
    for (int i = gt; i < MS * D / 4; i += ngt) ((f32x4*)(XRES + (size_t)MP * D))[i] = ((const f32x4*)P->in[1])[i];
    for (int i = gt; i < 2 * 8 * D; i += ngt) { const int l = i >> 13, j = (i >> 10) & 7, k = i & 1023; WAB[i] = P->in[7][l * D + k] * P->in[8][(size_t)l * D * DIN + (size_t)k * DIN + 2048 + j]; }
    convert_win(P, 0, wscr, gw, ngw, lane);
    convert_layer_rest(P, 0, wscr, gw, ngw, lane);
    convert_layer_rest(P, 1, wscr, gw, ngw, lane);
    for (int m = gw; m < M; m += ngw) {
        const float* xr = m < MP ? P->in[0] + (size_t)m * D : P->in[1] + (size_t)(m - MP) * D;
        float ss = 0.f;
#pragma unroll
        for (int j = 0; j < 4; ++j) { const f32x4 v = ((const f32x4*)xr)[lane + 64 * j]; ss += v[0] * v[0] + v[1] * v[1] + v[2] * v[2] + v[3] * v[3];
            ((v2u*)(XA + (size_t)m * D))[lane + 64 * j] = (v2u){pk2(v[0], v[1]), pk2(v[2], v[3])}; }
        ss = wave_sum(ss);
        if (lane == 0) SSQ[m] = ss;
    }
    grid.sync();

#pragma unroll 1
    for (int l = 0; l < 2; ++l) {
#ifndef NO_P1
        {
            const bf16* gA = XA; const bf16* gB = (const bf16*)(ws + WS_WIN); LAUNDER(gA); LAUNDER(gB);
            pg8::Gemm g{gA, gB, M, NPROJ, D, D, D}; pg8::StaticOrder S; S.init(M, NPROJ, G, bx);
            EpiScale E{PROJ, NPROJ, SSQ + (size_t)(2 * l) * M};
            pg8::gemm_phase<EpiScale, pg8::StaticOrder, true, true>((PG8_LAS unsigned char*)lds, g, S, E, wave);
#ifdef PROBE_P1X2
            __syncthreads();
            pg8::gemm_phase<EpiScale, pg8::StaticOrder, true, true>((PG8_LAS unsigned char*)lds, g, S, E, wave);
#endif
        }
#endif
#ifndef NO_AB
        {
            const float* ssq = SSQ + (size_t)(2 * l) * M;
            const int tf = fresh_tid(wave), lane = tf & 63, gw = bx * NWAVES + __builtin_amdgcn_readfirstlane(tf >> 6);
            for (int m = gw; m < M; m += ngw) {
                const v4u* xr = (const v4u*)(XA + (size_t)m * D) + lane * 2;
                const v4u x0 = xr[0], x1 = xr[1]; float xf[16]; UNPACK8(x0, xf); UNPACK8(x1, xf + 8);
                float dot[8];
#pragma unroll
                for (int j = 0; j < 8; ++j) { const float* wp = WAB + (size_t)(l * 8 + j) * D + lane * 16; float s = 0.f;
#pragma unroll
                    for (int e = 0; e < 16; ++e) s += wp[e] * xf[e];
                    dot[j] = wave_sum(s); }
                float v = dot[0];
#pragma unroll
                for (int j = 1; j < 8; ++j) v = (lane == j) ? dot[j] : v;
                if (lane < 8) {
                    v *= rsqrtf(ssq[m] * (1.f / D) + EPS);
                    const int hh = lane & 3; float r;
                    if (lane < 4) { const float xx = v + P->in[11][l * 4 + hh]; const float sp = fmaxf(xx, 0.f) + __logf(1.f + __expf(-fabsf(xx))); r = -__expf(P->in[10][l * 4 + hh]) * sp; }
                    else r = __builtin_amdgcn_rcpf(1.f + __expf(-v));
                    GB[(size_t)m * 8 + lane] = r;
                }
            }
        }
#endif
        GSYNC();
#ifndef NO_P2B
        { const int tf = fresh_tid(wave); for (int item = bx; item < 1024; item += G) p2b_item(P, l, item, lds, wave); }
#ifdef PROBE_P2B2
        __syncthreads(); { const int tf = fresh_tid(wave); for (int item = bx; item < 1024; item += G) p2b_item(P, l, item, lds, wave); }
#endif
#endif
        GSYNC();
#ifdef PROBE_SCAN2
        if (bx < 32) { scan_wg(P, l, bx, lds, fresh_tid(wave)); }
#endif
#ifndef NO_SCAN
        if (bx < 32) scan_wg(P, l, bx, lds, fresh_tid(wave));
        else
#endif
        {
            const int vw = bx - 32, nm = G - 32; const int tid = fresh_tid(wave);
#ifndef NO_SAMPLE
            for (int it = nm - 1 - vw; it < 128; it += nm) sample_delta(P, l, it, lds, wave);
#endif
            for (int i = tid; i < 4096; i += NTHREADS) ((f32x4*)(lds + PL_PW))[i] = ((const f32x4*)(P->in[13] + (size_t)l * 16384))[i];
            __syncthreads();
#ifndef NO_POOL
            for (int tile = vw; tile < 272; tile += nm) pool_tile(P, l, tile, lds, wave);
#endif
            state_copies(P, l, vw * NTHREADS + tid, nm * NTHREADS);
#ifdef PROBE_MISC2
            __syncthreads();
#ifndef NO_SAMPLE
            for (int it = nm - 1 - vw; it < 128; it += nm) sample_delta(P, l, it, lds, wave);
#endif
            for (int i = tid; i < 4096; i += NTHREADS) ((f32x4*)(lds + PL_PW))[i] = ((const f32x4*)(P->in[13] + (size_t)l * 16384))[i];
            __syncthreads();
#ifndef NO_POOL
            for (int tile = vw; tile < 272; tile += nm) pool_tile(P, l, tile, lds, wave);
#endif
            state_copies(P, l, vw * NTHREADS + tid, nm * NTHREADS);
#endif
        }
        GSYNC();
        { const int tf = fresh_tid(wave); p2d(P, l, bx * NWAVES + __builtin_amdgcn_readfirstlane(tf >> 6), ngw, tf & 63); }
        GSYNC();
#ifdef PROBE_P2D2
        { const int tf = fresh_tid(wave); p2d(P, l, bx * NWAVES + __builtin_amdgcn_readfirstlane(tf >> 6), ngw, tf & 63); }
        GSYNC();
        { const int tf = fresh_tid(wave); p2d(P, l, bx * NWAVES + __builtin_amdgcn_readfirstlane(tf >> 6), ngw, tf & 63); }
        GSYNC();
        { const int tf = fresh_tid(wave); p2d(P, l, bx * NWAVES + __builtin_amdgcn_readfirstlane(tf >> 6), ngw, tf & 63); }
        GSYNC();
#endif
        {
            const bf16* gA = XA; const bf16* gB = (const bf16*)(ws + WS_WOUT) + (size_t)l * D * D; LAUNDER(gA); LAUNDER(gB);
            pg8::Gemm g{gA, gB, MP, D, D, D, D}; pg8::StaticOrder S; S.init(MP, D, G, bx);
            EpiResid E{l == 0 ? P->in[0] : XRES, l == 0 ? P->in[1] : XRES + (size_t)MP * D, XRES, XB2, SSQ + (size_t)(2 * l + 1) * M, 0};
            pg8::gemm_phase<EpiResid, pg8::StaticOrder, true, true>((PG8_LAS unsigned char*)lds, g, S, E, wave);
            const int ks = bx >> 4; const bf16* gA2 = XA + (size_t)MP * D + ks * 256; const bf16* gB2 = gB + ks * 256; LAUNDER(gA2); LAUNDER(gB2);
            pg8::Gemm g2{gA2, gB2, MS, D, 256, D, D}; SplitOrder S2{bx < 64 ? (bx & 15) : -1};
            EpiAtomic E2{(float*)(ws + WS_GU) + (size_t)ks * MS * D};
            pg8::gemm_phase<EpiAtomic, SplitOrder, true, true>((PG8_LAS unsigned char*)lds, g2, S2, E2, wave);
        }
        GSYNC();
        fin_sample(XRES + (size_t)MP * D, XB2 + (size_t)MP * D, SSQ + (size_t)(2 * l + 1) * M + MP, (const float*)(ws + WS_GU), 4, nullptr, 0, bx * NWAVES + wave, ngw, lane_id());
        GSYNC();
        {
            const bf16* gA = XB2; const bf16* gB = (const bf16*)(ws + WS_WGU) + (size_t)l * NGU * D; LAUNDER(gA); LAUNDER(gB);
            pg8::Gemm g{gA, gB, M, NGU, D, D, D}; pg8::StaticOrder S; S.init(M, NGU, G, bx);
            EpiGateUp E{GU, SSQ + (size_t)(2 * l + 1) * M, P->in[19] + (size_t)(l * 3) * FF, P->in[6] + (size_t)l * DBATCH * 2 * FF, (float*)(ws + WS_HAL), (float*)(ws + WS_FIXG), (float*)(ws + WS_FIXU),
                        P->out + O_PFFN + (size_t)l * NBATCH * 2 * FF, P->out + O_SFFN + (size_t)l * DBATCH * 2 * FF, lds};
            pg8::gemm_phase<EpiGateUp, pg8::StaticOrder, true, true>((PG8_LAS unsigned char*)lds, g, S, E, wave);
        }
        GSYNC();
        p4_fixup(P, l, bx * NTHREADS + fresh_tid(wave), ngt);
        if (l == 0) { const int tf = fresh_tid(wave); convert_win(P, 1, (float*)(lds + wave * 16384), bx * NWAVES + wave, ngw, tf & 63); }
        GSYNC();
        {
            const bf16* gA = GU; const bf16* gB = (const bf16*)(ws + WS_WDN) + (size_t)l * D * FF; LAUNDER(gA); LAUNDER(gB);
            pg8::Gemm g{gA, gB, MP, D, FF, FF, FF}; pg8::StaticOrder S; S.init(MP, D, G, bx);
            EpiResid E{XRES, XRES + (size_t)MP * D, XRES, XA, SSQ + (size_t)(2 * l + 2) * M, 0};
            pg8::gemm_phase<EpiResid, pg8::StaticOrder, true, true>((PG8_LAS unsigned char*)lds, g, S, E, wave);
            const int ks = bx >> 4; const bf16* gA2 = GU + (size_t)MP * FF + ks * 256; const bf16* gB2 = gB + ks * 256; LAUNDER(gA2); LAUNDER(gB2);
            pg8::Gemm g2{gA2, gB2, MS, D, 256, FF, FF}; SplitOrder S2{bx < 176 ? (bx & 15) : -1};
            EpiAtomic E2{ks < 8 ? (float*)(ws + WS_PROJ) + (size_t)ks * MS * D : (float*)(ws + WS_PART2) + (size_t)(ks - 8) * MS * D};
            pg8::gemm_phase<EpiAtomic, SplitOrder, true, true>((PG8_LAS unsigned char*)lds, g2, S2, E2, wave);
        }
        GSYNC();
        fin_sample(XRES + (size_t)MP * D, XA + (size_t)MP * D, SSQ + (size_t)(2 * l + 2) * M + MP, (const float*)(ws + WS_PROJ), 8, (const float*)(ws + WS_PART2), 3, bx * NWAVES + wave, ngw, lane_id());
        GSYNC();
    }
    {
        const float* ssq = SSQ + (size_t)4 * M; const float* fn = P->in[22];
        const int gt = bx * NTHREADS + fresh_tid(wave);
        for (int i0 = gt; i0 < M * 256; i0 += 4 * ngt) {
            f32x4 v[4]; float sq[4];
#pragma unroll
            for (int q = 0; q < 4; ++q) { const int i = i0 + q * ngt; v[q] = (f32x4){0.f, 0.f, 0.f, 0.f}; sq[q] = 1.f;
                if (i < M * 256) { v[q] = ((const f32x4*)XRES)[i]; sq[q] = ssq[i >> 8]; } }
#pragma unroll
            for (int q = 0; q < 4; ++q) { const int i = i0 + q * ngt;
                if (i < M * 256) { const float rs = rsqrtf(sq[q] * (1.f / D) + EPS); const f32x4 gv = ((const f32x4*)fn)[i & 255];
                    f32x4 o = v[q]; o[0] *= rs * gv[0]; o[1] *= rs * gv[1]; o[2] *= rs * gv[2]; o[3] *= rs * gv[3];
                    ((f32x4*)XRES)[i] = o; } }
        }
    }
}

extern "C" void kernel_launch(void* const* d_in, const int* in_sizes, int n_in, void* d_out, int out_size, void* d_ws, size_t ws_size, hipStream_t stream) {
    static int grid = 0;
    if (grid == 0) {
        if (n_in != 23 || (size_t)out_size != O_TOTAL || ws_size < WS_END) { fprintf(stderr, "kernel_launch: unexpected shapes: n_in %d out %d ws %zu\n", n_in, out_size, ws_size); grid = -1; return; }
        int dev = 0, cus = 0, per_cu = 0;
        hipGetDevice(&dev); hipDeviceGetAttribute(&cus, hipDeviceAttributeMultiprocessorCount, dev);
        if (hipFuncSetAttribute((const void*)fwd_megakernel, hipFuncAttributeMaxDynamicSharedMemorySize, LDS_BYTES) != hipSuccess) { fprintf(stderr, "kernel_launch: hipFuncSetAttribute failed\n"); grid = -1; return; }
        hipOccupancyMaxActiveBlocksPerMultiprocessor(&per_cu, (const void*)fwd_megakernel, NTHREADS, LDS_BYTES);
        (void)hipGetLastError();
        if (per_cu < 1) fprintf(stderr, "kernel_launch: occupancy query reports %d blocks per CU\n", per_cu);
        grid = cus;
    }
    if (grid < 0) return;
    if (hipMemsetAsync((char*)d_ws + WS_BAR, 0, 16384, stream) != hipSuccess) { fprintf(stderr, "kernel_launch: memset failed\n"); return; }
    Params p{};
    for (int i = 0; i < 23; ++i) p.in[i] = (const float*)d_in[i];
    p.out = (float*)d_out; p.ws = (unsigned char*)d_ws;
    void* args[] = {&p};
    hipError_t e = hipLaunchCooperativeKernel((const void*)fwd_megakernel, dim3(grid), dim3(NTHREADS), args, LDS_BYTES, stream);
    if (e != hipSuccess) fprintf(stderr, "cooperative launch failed: %s (grid %d)\n", hipGetErrorString(e), grid);
}
```

```cpp
#include <hip/hip_runtime.h>
#include <hip/hip_cooperative_groups.h>
#include <cstdio>
#include <cstdint>
namespace cg = cooperative_groups;
__device__ __forceinline__ int lane_id() { int t; asm volatile("v_mbcnt_lo_u32_b32 %0, -1, 0\n\tv_mbcnt_hi_u32_b32 %0, -1, %0" : "=v"(t)); return t; }
__device__ __forceinline__ int fresh_tid(int wave) { return (wave << 6) | lane_id(); }
namespace pg8 {
#define PG8_LAS __attribute__((address_space(3)))
typedef unsigned short bf16_t;
typedef short bf16x8 __attribute__((ext_vector_type(8)));
typedef float f32x4 __attribute__((ext_vector_type(4)));
typedef unsigned u32x4 __attribute__((ext_vector_type(4)));
constexpr int BM = 256, BK = 64, HALF = 128, HTB = HALF * BK * 2  , STAGE_BYTES = 8 * HTB, NXCD = 8, WGM = 8;

__host__ __device__ __forceinline__ int lds_byte(int r, int c) { const int st = (r >> 4) * 2 + (c >> 5), rr = r & 15, cc = c & 31, ob = rr * 64 + cc * 2; return st * 1024 + (ob ^ (((ob >> 9) & 1) << 5)); }
__host__ __device__ __forceinline__ void stage_rc(int b, int& R, int& C) { const int st = b / 1024, sb = b % 1024, swz = sb ^ (((sb >> 9) & 1) << 5); R = (st >> 1) * 16 + swz / 64; C = (st & 1) * 32 + (swz % 64) / 2; }
__host__ __device__ __forceinline__ int perm32(int rho) { const int n = rho >> 4, i = rho & 15; return 8 * (i >> 2) + 4 * n + (i & 3); }

struct Unit { int pm, pn; };
struct Gemm { const bf16_t* A; const bf16_t* Bt; int M, N, K, lda, ldb; };

struct StaticOrder {
    int nM, nN, nwg, G, c;
    __host__ __device__ void init(int M, int N, int G_, int c_) { nM = M / BM; nN = N / BM; nwg = nM * nN; G = G_; c = c_; }
    __host__ __device__ bool next(int i, Unit& u) const {
        const long L = (long)i * G + c; if (L >= nwg) return false;
        int wgid = (int)L; { const int q = nwg / NXCD, r = nwg % NXCD, xcd = wgid % NXCD, off = wgid / NXCD; wgid = (xcd < r ? xcd * (q + 1) : r * (q + 1) + (xcd - r) * q) + off; }
        const int nig = WGM * nN, gid = wgid / nig, fm = gid * WGM, gsz = (nM - fm) < WGM ? (nM - fm) : WGM;
        u.pm = fm + ((wgid % nig) % gsz); u.pn = (wgid % nig) / gsz; return true;
    }
    __device__ __forceinline__ void a_ready(const Unit&) const {}
    __device__ __forceinline__ void done(const Unit&) const {}
};

template <class Epi, class Sched, bool ALIGN_EPI = false, bool SP2 = false>
__device__ __forceinline__ void gemm_phase(PG8_LAS unsigned char* lds, const Gemm g, const Sched& S, const Epi& E, const int wave_in) {
    const int tid = fresh_tid(wave_in), wid = __builtin_amdgcn_readfirstlane(tid >> 6), lane = tid & 63, wr = wid >> 2, wc = wid & 3, fr = lane & 15, fq = lane >> 4;
    const int K = g.K, nt = K / BK;
    unsigned voffA[2], voffB[2];
#pragma unroll
    for (int i = 0; i < 2; ++i) { int R, C; stage_rc(tid * 16 + i * 8192, R, C); const int Rb = Epi::PERM ? ((R & ~31) + perm32(R & 31)) : R;
        voffA[i] = (unsigned)(R * g.lda + C) * 2u; voffB[i] = (unsigned)(Rb * g.ldb + C) * 2u; }
    const size_t kstep = (size_t)(BK * 2);
    const size_t hstepA = (size_t)HALF * g.lda * 2, hstepB = (size_t)HALF * g.ldb * 2;
    const size_t tstepA = 2 * hstepA, tstepB = 2 * hstepB;
    const unsigned ldsw = (unsigned)wid * 1024u;
    const int aoff = lds_byte(wr * 64 + fr, fq * 8), boff = lds_byte(wc * 32 + fr, fq * 8);
#define PG8_SA(b, h) (((b) * 2 + (h)) * HTB)
#define PG8_SB(b, h) ((4 + (b) * 2 + (h)) * HTB)
#define PG8_STAGE(bufoff, gbase, voff) do { _Pragma("unroll") for (int _i = 0; _i < 2; ++_i) \
        __builtin_amdgcn_global_load_lds((const unsigned*)((const char*)(gbase) + (voff)[_i]), (PG8_LAS unsigned*)(lds + (bufoff) + ldsw + _i * 8192), 16, 0, 0); } while (0)
#define PG8_LDA(dst, b, h) do { _Pragma("unroll") for (int m = 0; m < 4; ++m) _Pragma("unroll") for (int k = 0; k < 2; ++k) dst[m][k] = *(const PG8_LAS bf16x8*)(lds + PG8_SA(b, h) + aoff + m * 2048 + k * 1024); } while (0)
#define PG8_LDB(dst, b, h) do { _Pragma("unroll") for (int n = 0; n < 2; ++n) _Pragma("unroll") for (int k = 0; k < 2; ++k) dst[n][k] = *(const PG8_LAS bf16x8*)(lds + PG8_SB(b, h) + boff + n * 2048 + k * 1024); } while (0)
#define PG8_MMA(ai, bj, At, Bt) do { __builtin_amdgcn_s_setprio(1); _Pragma("unroll") for (int m = 0; m < 4; ++m) _Pragma("unroll") for (int n = 0; n < 2; ++n) _Pragma("unroll") for (int k = 0; k < 2; ++k) \
        acc[ai][bj][m][n] = __builtin_amdgcn_mfma_f32_16x16x32_bf16(Bt[n][k], At[m][k], acc[ai][bj][m][n], 0, 0, 0); __builtin_amdgcn_s_setprio(0); } while (0)
#define PG8_WAIT_V(n) asm volatile("s_waitcnt vmcnt(" #n ")" ::: "memory")
#define PG8_WAIT_L(n) asm volatile("s_waitcnt lgkmcnt(" #n ")" ::: "memory")
#define PG8_BAR __builtin_amdgcn_s_barrier()
#define PG8_SCHED __builtin_amdgcn_sched_barrier(0)
    Unit cur, nxt; int ui = 0;
    if (!S.next(0, cur)) return;
    f32x4 acc[2][2][4][2];
#pragma unroll
    for (int a = 0; a < 2; ++a)
#pragma unroll
        for (int b = 0; b < 2; ++b)
#pragma unroll
            for (int m = 0; m < 4; ++m)
#pragma unroll
                for (int n = 0; n < 2; ++n) acc[a][b][m][n] = (f32x4){0.f, 0.f, 0.f, 0.f};
    bf16x8 At[4][2], B0[2][2], B1[2][2];
    const char* cA = (const char*)g.A + (size_t)cur.pm * tstepA; const char* cB = (const char*)g.Bt + (size_t)cur.pn * tstepB;
    S.a_ready(cur);
    if constexpr (SP2) {
        PG8_STAGE(PG8_SB(0, 0), cB, voffB); PG8_STAGE(PG8_SB(0, 1), cB + hstepB, voffB); PG8_STAGE(PG8_SA(0, 0), cA, voffA); PG8_STAGE(PG8_SA(0, 1), cA + hstepA, voffA);
        if (wr == 1) PG8_BAR;
        PG8_WAIT_V(2); PG8_BAR;
        PG8_STAGE(PG8_SB(1, 0), cB + kstep, voffB); PG8_STAGE(PG8_SA(1, 0), cA + kstep, voffA); PG8_STAGE(PG8_SB(1, 1), cB + hstepB + kstep, voffB);
        PG8_WAIT_V(6); PG8_BAR;
    } else {
        PG8_STAGE(PG8_SB(0, 0), cB, voffB); PG8_STAGE(PG8_SA(0, 0), cA, voffA); PG8_STAGE(PG8_SB(0, 1), cB + hstepB, voffB); PG8_STAGE(PG8_SA(0, 1), cA + hstepA, voffA);
        if (wr == 1) PG8_BAR;
        PG8_WAIT_V(4); PG8_BAR;
        PG8_STAGE(PG8_SB(1, 0), cB + kstep, voffB); PG8_STAGE(PG8_SA(1, 0), cA + kstep, voffA); PG8_STAGE(PG8_SB(1, 1), cB + hstepB + kstep, voffB);
        PG8_WAIT_V(6); PG8_BAR;
    }
    for (;;) {
        const bool has_next = S.next(ui + 1, nxt);
        const char* nA = has_next ? (const char*)g.A + (size_t)nxt.pm * tstepA : cA; const char* nB = has_next ? (const char*)g.Bt + (size_t)nxt.pn * tstepB : cB;
        for (int t = 0; t < nt; t += 2) {
            const bool last = (t == nt - 2);
            const char* a1 = cA + (size_t)(t + 1) * kstep;
            const char* a2 = last ? nA : cA + (size_t)(t + 2) * kstep; const char* b2 = last ? nB : cB + (size_t)(t + 2) * kstep;
            const char* a3 = a2 + kstep; const char* b3 = b2 + kstep;
            if (last && has_next) S.a_ready(nxt);
            if constexpr (SP2) {
            PG8_LDB(B0, 0, 0); PG8_LDB(B1, 0, 1); PG8_SCHED; PG8_LDA(At, 0, 0); PG8_STAGE(PG8_SA(1, 1), a1 + hstepA, voffA);
            PG8_WAIT_V(8); PG8_WAIT_L(0); PG8_BAR; PG8_MMA(0, 0, At, B0); PG8_MMA(0, 1, At, B1); PG8_BAR; PG8_SCHED;
            PG8_LDA(At, 0, 1); PG8_STAGE(PG8_SB(0, 0), b2, voffB); PG8_STAGE(PG8_SB(0, 1), b2 + hstepB, voffB); PG8_STAGE(PG8_SA(0, 0), a2, voffA);
            PG8_WAIT_V(8); PG8_WAIT_L(0); PG8_BAR; PG8_MMA(1, 0, At, B0); PG8_MMA(1, 1, At, B1); PG8_BAR; PG8_SCHED;
            PG8_LDB(B0, 1, 0); PG8_LDB(B1, 1, 1); PG8_SCHED; PG8_LDA(At, 1, 0); PG8_STAGE(PG8_SA(0, 1), a2 + hstepA, voffA);
            PG8_WAIT_V(8); PG8_WAIT_L(0); PG8_BAR; PG8_MMA(0, 0, At, B0); PG8_MMA(0, 1, At, B1); PG8_BAR; PG8_SCHED;
            PG8_LDA(At, 1, 1); PG8_STAGE(PG8_SB(1, 0), b3, voffB); PG8_STAGE(PG8_SB(1, 1), b3 + hstepB, voffB); PG8_STAGE(PG8_SA(1, 0), a3, voffA);
            PG8_WAIT_V(8); PG8_WAIT_L(0); PG8_BAR; PG8_MMA(1, 0, At, B0); PG8_MMA(1, 1, At, B1); PG8_BAR; PG8_SCHED;
            } else {
            PG8_LDB(B0, 0, 0); PG8_SCHED; PG8_LDA(At, 0, 0); PG8_STAGE(PG8_SA(1, 1), a1 + hstepA, voffA);
            PG8_WAIT_L(8); PG8_BAR; PG8_WAIT_L(0); PG8_MMA(0, 0, At, B0); PG8_BAR; PG8_SCHED;
            PG8_LDB(B1, 0, 1); PG8_STAGE(PG8_SB(0, 0), b2, voffB);
            PG8_BAR; PG8_WAIT_L(0); PG8_MMA(0, 1, At, B1); PG8_BAR;
            PG8_LDA(At, 0, 1); PG8_STAGE(PG8_SA(0, 0), a2, voffA);
            PG8_BAR; PG8_WAIT_L(0); PG8_MMA(1, 0, At, B0); PG8_BAR; PG8_SCHED;
            PG8_STAGE(PG8_SB(0, 1), b2 + hstepB, voffB);
            PG8_WAIT_V(6); PG8_BAR; PG8_MMA(1, 1, At, B1); PG8_BAR;
            PG8_LDB(B0, 1, 0); PG8_SCHED; PG8_LDA(At, 1, 0); PG8_STAGE(PG8_SA(0, 1), a2 + hstepA, voffA);
            PG8_WAIT_L(8); PG8_BAR; PG8_WAIT_L(0); PG8_MMA(0, 0, At, B0); PG8_BAR; PG8_SCHED;
            PG8_LDB(B1, 1, 1); PG8_STAGE(PG8_SB(1, 0), b3, voffB);
            PG8_BAR; PG8_WAIT_L(0); PG8_MMA(0, 1, At, B1); PG8_BAR;
            PG8_LDA(At, 1, 1); PG8_STAGE(PG8_SA(1, 0), a3, voffA);
            PG8_BAR; PG8_WAIT_L(0); PG8_MMA(1, 0, At, B0); PG8_BAR; PG8_SCHED;
            PG8_STAGE(PG8_SB(1, 1), b3 + hstepB, voffB);
            PG8_WAIT_V(6); PG8_BAR; PG8_MMA(1, 1, At, B1); PG8_BAR;
            }
        }
        if constexpr (ALIGN_EPI) { if (wr == 0) PG8_BAR; }
        if constexpr (!Epi::AFTER_DRAIN) { E(acc, cur, wr, wc, fr, fq); S.done(cur); }
        if (!has_next) break;
#pragma unroll
        for (int a = 0; a < 2; ++a)
#pragma unroll
            for (int b = 0; b < 2; ++b)
#pragma unroll
                for (int m = 0; m < 4; ++m)
#pragma unroll
                    for (int n = 0; n < 2; ++n) acc[a][b][m][n] = (f32x4){0.f, 0.f, 0.f, 0.f};
        cur = nxt; cA = nA; cB = nB; ++ui;
        if constexpr (ALIGN_EPI) { if (wr == 1) PG8_BAR; }
    }
    PG8_WAIT_V(0);
    if constexpr (!ALIGN_EPI) { if (wr == 0) PG8_BAR; }
    PG8_BAR;
    if constexpr (Epi::AFTER_DRAIN) { E.fused(acc, cur, wr, wc, fr, fq, lds, wid, lane); S.done(cur); }
#undef PG8_SA
#undef PG8_SB
#undef PG8_STAGE
#undef PG8_LDA
#undef PG8_LDB
#undef PG8_MMA
#undef PG8_WAIT_V
#undef PG8_WAIT_L
#undef PG8_BAR
#undef PG8_SCHED
}
}

typedef unsigned short bf16;
typedef unsigned v4u __attribute__((ext_vector_type(4)));
typedef unsigned v2u __attribute__((ext_vector_type(2)));
typedef float f32x4 __attribute__((ext_vector_type(4)));
typedef short bf16x8 __attribute__((ext_vector_type(8)));

constexpr int D = 1024, MP = 16384, MS = 1024, M = MP + MS, SEQL = 2048, NBATCH = 8, DBATCH = 128;
constexpr int NPROJ = 3072, FF = 2816, NGU = 5632, DIN = 3080, MH = M / 2;
constexpr float EPS = 1e-6f;
constexpr int NTHREADS = 512, NWAVES = 8;
constexpr int LDS_BYTES = 155648;
constexpr size_t MiB = 1u << 20;
constexpr size_t WS_WOUT = 0, WS_WGU = 4 * MiB, WS_WDN = 26 * MiB, WS_XA = 37 * MiB, WS_PROJ = 71 * MiB, WS_GU = 105 * MiB, WS_SCR = 173 * MiB, WS_WIN = 239 * MiB;
constexpr size_t WS_GB = 245 * MiB, WS_SSQ = 245 * MiB + 576 * 1024, WS_WAB = 246 * MiB, WS_GL = 246 * MiB + 64 * 1024, WS_HALO = 246 * MiB + 128 * 1024, WS_BAR = 246 * MiB + 192 * 1024, WS_PART2 = 200 * MiB, WS_HAL = 247 * MiB, WS_FIXG = 249 * MiB, WS_FIXU = 251 * MiB, WS_END = 253 * MiB;
constexpr int SCR_ITEM = 73728;
constexpr size_t O_PDELTA = 17825792, O_PDCONV = 18874368, O_PPOOL = 18948096, O_PSCONV = 19009536, O_PFFN = 19017728;
constexpr size_t O_SDELTA = 19107840, O_SDCONV = 35885056, O_SPOOL = 37064704, O_SSCONV = 38047744, O_SFFN = 38178816, O_TOTAL = 39620608;

struct Params { const float* in[23]; float* out; unsigned char* ws; };
typedef const __attribute__((address_space(4))) Params* KP;
__device__ __forceinline__ KP kparams() { KP p = (KP)__builtin_amdgcn_kernarg_segment_ptr(); asm volatile("" : "+s"(p)); return p; }

#define LAUNDER(p) asm volatile("" : "+s"(p))
#define LDS_WAIT() asm volatile("s_waitcnt lgkmcnt(0)" ::: "memory")
__device__ __forceinline__ unsigned f2bf(float f) { unsigned u = __builtin_bit_cast(unsigned, f); return (u + 0x7fffu + ((u >> 16) & 1u)) >> 16; }
__device__ __forceinline__ unsigned pk2(float lo, float hi) { return f2bf(lo) | (f2bf(hi) << 16); }
__device__ __forceinline__ float bflo(unsigned u) { return __builtin_bit_cast(float, u << 16); }
__device__ __forceinline__ float bfhi(unsigned u) { return __builtin_bit_cast(float, u & 0xffff0000u); }
__device__ __forceinline__ float bf1(bf16 h) { return __builtin_bit_cast(float, ((unsigned)h) << 16); }
__device__ __forceinline__ float siluf(float x) { return x * __builtin_amdgcn_rcpf(1.f + __expf(-x)); }
__device__ __forceinline__ float wave_sum(float v) {
#pragma unroll
    for (int o = 1; o < 64; o <<= 1) v += __shfl_xor(v, o);
    return v;
}
#define UNPACK8(W_, F_) do { (F_)[0] = bflo((W_).x); (F_)[1] = bfhi((W_).x); (F_)[2] = bflo((W_).y); (F_)[3] = bfhi((W_).y); (F_)[4] = bflo((W_).z); (F_)[5] = bfhi((W_).z); (F_)[6] = bflo((W_).w); (F_)[7] = bfhi((W_).w); } while (0)
#define PACK8(F_) ((v4u){pk2((F_)[0], (F_)[1]), pk2((F_)[2], (F_)[3]), pk2((F_)[4], (F_)[5]), pk2((F_)[6], (F_)[7])})

struct EpiScale {
    static constexpr bool PERM = true, AFTER_DRAIN = false;
    bf16* O; int ldc; const float* ssq;
    __device__ __forceinline__ void operator()(const pg8::f32x4 (&acc)[2][2][4][2], const pg8::Unit& u, int wr, int wc, int fr, int fq) const {
        const int row0 = u.pm * 256 + wr * 64 + fr, col0 = u.pn * 256 + wc * 32 + 8 * fq;
#pragma unroll
        for (int ai = 0; ai < 2; ++ai)
#pragma unroll
            for (int m = 0; m < 4; ++m) {
                const int row = row0 + ai * 128 + m * 16;
                const float rs = rsqrtf(ssq[row] * (1.f / D) + EPS);
                bf16* rowp = O + (size_t)row * ldc + col0;
#pragma unroll
                for (int bj = 0; bj < 2; ++bj) {
                    pg8::f32x4 v0 = acc[ai][bj][m][0] * rs, v1 = acc[ai][bj][m][1] * rs;
                    v4u w; w.x = pk2(v0[0], v0[1]); w.y = pk2(v0[2], v0[3]); w.z = pk2(v1[0], v1[1]); w.w = pk2(v1[2], v1[3]);
                    *(v4u*)(rowp + bj * 128) = w;
                }
            }
    }
};
struct EpiResid {
    static constexpr bool PERM = true, AFTER_DRAIN = false;
    const float* xa; const float* xb_; float* xres; bf16* xb16; float* ssq; int rowbase;
    __device__ __forceinline__ void operator()(const pg8::f32x4 (&acc)[2][2][4][2], const pg8::Unit& u, int wr, int wc, int fr, int fq) const {
        const int row0 = rowbase + u.pm * 256 + wr * 64 + fr, col0 = u.pn * 256 + wc * 32 + 8 * fq;
#pragma unroll
        for (int ai = 0; ai < 2; ++ai)
#pragma unroll
            for (int m = 0; m < 4; ++m) {
                const int row = row0 + ai * 128 + m * 16;
                const float* xo = (row < MP ? xa + (size_t)row * D : xb_ + (size_t)(row - MP) * D) + col0;
                float* xr = xres + (size_t)row * D + col0;
                bf16* xh = xb16 + (size_t)row * D + col0;
                float ss = 0.f;
#pragma unroll
                for (int bj = 0; bj < 2; ++bj) {
                    const pg8::f32x4 o0 = *(const pg8::f32x4*)(xo + bj * 128), o1 = *(const pg8::f32x4*)(xo + bj * 128 + 4);
                    pg8::f32x4 v0 = acc[ai][bj][m][0] + o0, v1 = acc[ai][bj][m][1] + o1;
                    *(pg8::f32x4*)(xr + bj * 128) = v0; *(pg8::f32x4*)(xr + bj * 128 + 4) = v1;
                    v4u w; w.x = pk2(v0[0], v0[1]); w.y = pk2(v0[2], v0[3]); w.z = pk2(v1[0], v1[1]); w.w = pk2(v1[2], v1[3]);
                    *(v4u*)(xh + bj * 128) = w;
                    ss += v0[0] * v0[0] + v0[1] * v0[1] + v0[2] * v0[2] + v0[3] * v0[3] + v1[0] * v1[0] + v1[1] * v1[1] + v1[2] * v1[2] + v1[3] * v1[3];
                }
                ss += __shfl_xor(ss, 16); ss += __shfl_xor(ss, 32);
                if (fq == 0) atomicAdd(ssq + row, ss);
            }
    }
};


struct SplitOrder {
    int unit;
    __device__ __forceinline__ bool next(int i, pg8::Unit& u) const { if (i != 0 || unit < 0) return false; u.pm = unit >> 2; u.pn = unit & 3; return true; }
    __device__ __forceinline__ void a_ready(const pg8::Unit&) const {}
    __device__ __forceinline__ void done(const pg8::Unit&) const {}
};
struct EpiAtomic {
    static constexpr bool PERM = true, AFTER_DRAIN = false;
    float* X;
    __device__ __forceinline__ void operator()(const pg8::f32x4 (&acc)[2][2][4][2], const pg8::Unit& u, int wr, int wc, int fr, int fq) const {
        const int row0 = u.pm * 256 + wr * 64 + fr, col0 = u.pn * 256 + wc * 32 + 8 * fq;
#pragma unroll
        for (int ai = 0; ai < 2; ++ai)
#pragma unroll
            for (int m = 0; m < 4; ++m) {
                float* xr = X + (size_t)(row0 + ai * 128 + m * 16) * D + col0;
#pragma unroll
                for (int bj = 0; bj < 2; ++bj) { *(pg8::f32x4*)(xr + bj * 128) = acc[ai][bj][m][0]; *(pg8::f32x4*)(xr + bj * 128 + 4) = acc[ai][bj][m][1]; }
            }
    }
};
__device__ __forceinline__ void fin_sample(float* X, bf16* XB, float* ssq, const float* partA, int nA, const float* partB, int nB, int gw, int ngw, int lane) {
    for (int r = gw; r < MS; r += ngw) {
        f32x4 v[4];
#pragma unroll
        for (int j = 0; j < 4; ++j) v[j] = ((const f32x4*)(X + (size_t)r * D))[lane + 64 * j];
        for (int k = 0; k < nA; ++k) {
#pragma unroll
            for (int j = 0; j < 4; ++j) v[j] += ((const f32x4*)(partA + ((size_t)k * MS + r) * D))[lane + 64 * j];
        }
        for (int k = 0; k < nB; ++k) {
#pragma unroll
            for (int j = 0; j < 4; ++j) v[j] += ((const f32x4*)(partB + ((size_t)k * MS + r) * D))[lane + 64 * j];
        }
        float ss = 0.f;
#pragma unroll
        for (int j = 0; j < 4; ++j) { ss += v[j][0] * v[j][0] + v[j][1] * v[j][1] + v[j][2] * v[j][2] + v[j][3] * v[j][3];
            ((f32x4*)(X + (size_t)r * D))[lane + 64 * j] = v[j];
            ((v2u*)(XB + (size_t)r * D))[lane + 64 * j] = (v2u){pk2(v[j][0], v[j][1]), pk2(v[j][2], v[j][3])}; }
        ss = wave_sum(ss);
        if (lane == 0) ssq[r] = ss;
    }
}

constexpr int EPI_HALO_OFF = 131072;
__device__ __forceinline__ float dpp_f(float oldv, float src, const int ctrl_sel) {
    const int o = __builtin_bit_cast(int, oldv), v = __builtin_bit_cast(int, src); int r;
    if (ctrl_sel == 0) r = __builtin_amdgcn_update_dpp(o, v, 0x111, 0xf, 0xf, false);
    else if (ctrl_sel == 1) r = __builtin_amdgcn_update_dpp(o, v, 0x112, 0xf, 0xf, false);
    else if (ctrl_sel == 2) r = __builtin_amdgcn_update_dpp(o, v, 0x121, 0xf, 0xf, false);
    else r = __builtin_amdgcn_update_dpp(o, v, 0x122, 0xf, 0xf, false);
    return __builtin_bit_cast(float, r);
}
struct EpiGateUp {
    static constexpr bool PERM = true, AFTER_DRAIN = false;
    bf16* ACT; const float* ssq; const float* cw; const float* st; float* HAL; float* FIXG; float* FIXU; float* pffn; float* sffn; unsigned char* lds;
    __device__ __forceinline__ void operator()(const pg8::f32x4 (&acc)[2][2][4][2], const pg8::Unit& u, int wr, int wc, int fr, int fq) const {
        const int pm = u.pm, ch0 = u.pn * 128 + wc * 32 + 8 * fq, row0 = pm * 256 + wr * 64 + fr;
        const bool smp = pm >= 64;
        float* halo = (float*)(lds + EPI_HALO_OFF);
#pragma unroll
        for (int ai = 0; ai < 2; ++ai) {
            const float rs = rsqrtf(ssq[row0 + ai * 128 + 48] * (1.f / D) + EPS);
            if (fr >= 14) {
                float* hp = halo + ((ai * 2 + wr) * 2 + (fr - 14)) * 128 + wc * 32 + 8 * fq;
                *(pg8::f32x4*)hp = acc[ai][0][3][0] * rs; *(pg8::f32x4*)(hp + 4) = acc[ai][0][3][1] * rs;
            }
        }
        asm volatile("s_waitcnt lgkmcnt(0)" ::: "memory");
        __builtin_amdgcn_s_barrier();
        float w0[8], w1[8], w2[8];
#pragma unroll
        for (int e = 0; e < 8; ++e) { w0[e] = cw[ch0 + e]; w1[e] = cw[FF + ch0 + e]; w2[e] = cw[2 * FF + ch0 + e]; }
#pragma unroll
        for (int ai = 0; ai < 2; ++ai) {
            const int s = ai * 2 + wr;
            float prev[8];
#pragma unroll
            for (int e = 0; e < 8; ++e) prev[e] = 0.f;
            if (!smp && s >= 1 && fr >= 14) {
                const float* hp = halo + ((s - 1) * 2 + (fr - 14)) * 128 + wc * 32 + 8 * fq;
                const pg8::f32x4 h0 = *(const pg8::f32x4*)hp, h1 = *(const pg8::f32x4*)(hp + 4);
                prev[0] = h0[0]; prev[1] = h0[1]; prev[2] = h0[2]; prev[3] = h0[3]; prev[4] = h1[0]; prev[5] = h1[1]; prev[6] = h1[2]; prev[7] = h1[3];
            }
#pragma unroll
            for (int m = 0; m < 4; ++m) {
                const int row = row0 + ai * 128 + m * 16;
                const float rs = rsqrtf(ssq[row] * (1.f / D) + EPS);
                float cur[8], upv[8], s0v[8], s1v[8];
#pragma unroll
                for (int e = 0; e < 8; ++e) { cur[e] = acc[ai][0][m][e >> 2][e & 3] * rs; upv[e] = acc[ai][1][m][e >> 2][e & 3] * rs; s0v[e] = 0.f; s1v[e] = 0.f; }
                const int t = fr & 7, sb = (row - MP) >> 3;
                if (smp && t < 2) {
                    const float* sp = st + (size_t)(sb * 2) * FF + ch0;
#pragma unroll
                    for (int e = 0; e < 8; ++e) { s0v[e] = sp[e]; s1v[e] = sp[FF + e]; }
                }
                float a[8];
#pragma unroll
                for (int e = 0; e < 8; ++e) {
                    const float sh1 = dpp_f(cur[e], cur[e], 0), sh2 = dpp_f(cur[e], cur[e], 1), ro1 = dpp_f(prev[e], prev[e], 2), ro2 = dpp_f(prev[e], prev[e], 3);
                    float p1, p2;
                    if (smp) { p1 = t >= 1 ? sh1 : s1v[e]; p2 = t >= 2 ? sh2 : (t == 1 ? s1v[e] : s0v[e]); }
                    else { p1 = fr >= 1 ? sh1 : ro1; p2 = fr >= 2 ? sh2 : ro2; }
                    a[e] = siluf(w0[e] * p2 + w1[e] * p1 + w2[e] * cur[e]) * upv[e];
                }
                *(v4u*)(ACT + (size_t)row * FF + ch0) = PACK8(a);
                if (smp) {
                    if (t >= 6) { float* o = sffn + (size_t)(sb * 2 + t - 6) * FF + ch0;
                        *(pg8::f32x4*)o = (pg8::f32x4){cur[0], cur[1], cur[2], cur[3]}; *(pg8::f32x4*)(o + 4) = (pg8::f32x4){cur[4], cur[5], cur[6], cur[7]}; }
                } else {
                    if (s == 3 && m == 3 && fr >= 14) {
                        float* o = HAL + (size_t)(pm * 2 + fr - 14) * FF + ch0;
                        *(pg8::f32x4*)o = (pg8::f32x4){cur[0], cur[1], cur[2], cur[3]}; *(pg8::f32x4*)(o + 4) = (pg8::f32x4){cur[4], cur[5], cur[6], cur[7]};
                        if ((pm & 7) == 7) { float* o2 = pffn + (size_t)((pm >> 3) * 2 + fr - 14) * FF + ch0;
                            *(pg8::f32x4*)o2 = (pg8::f32x4){cur[0], cur[1], cur[2], cur[3]}; *(pg8::f32x4*)(o2 + 4) = (pg8::f32x4){cur[4], cur[5], cur[6], cur[7]}; }
                    }
                    if (s == 0 && m == 0 && fr < 2 && (pm & 7) != 0) {
                        float* o = FIXG + (size_t)(pm * 2 + fr) * FF + ch0; float* o2 = FIXU + (size_t)(pm * 2 + fr) * FF + ch0;
                        *(pg8::f32x4*)o = (pg8::f32x4){cur[0], cur[1], cur[2], cur[3]}; *(pg8::f32x4*)(o + 4) = (pg8::f32x4){cur[4], cur[5], cur[6], cur[7]};
                        *(pg8::f32x4*)o2 = (pg8::f32x4){upv[0], upv[1], upv[2], upv[3]}; *(pg8::f32x4*)(o2 + 4) = (pg8::f32x4){upv[4], upv[5], upv[6], upv[7]};
                    }
                }
#pragma unroll
                for (int e = 0; e < 8; ++e) prev[e] = cur[e];
            }
        }
    }
};
__device__ __forceinline__ void p4_fixup(KP P, int l, int start, int stride) {
    const float* HAL = (const float*)(P->ws + WS_HAL); const float* FIXG = (const float*)(P->ws + WS_FIXG); const float* FIXU = (const float*)(P->ws + WS_FIXU);
    bf16* ACT = (bf16*)(P->ws + WS_GU);
    const float* cw = P->in[19] + (size_t)(l * 3) * FF;
    for (int idx = start; idx < 56 * 2 * FF; idx += stride) {
        const int k = idx / (2 * FF), rem = idx % (2 * FF), rr = rem / FF, c = rem % FF;
        const int pm = (k / 7) * 8 + 1 + (k % 7);
        const float g0 = FIXG[(size_t)(pm * 2 + rr) * FF + c];
        const float g1 = rr == 0 ? HAL[(size_t)((pm - 1) * 2 + 1) * FF + c] : FIXG[(size_t)(pm * 2) * FF + c];
        const float g2 = rr == 0 ? HAL[(size_t)((pm - 1) * 2) * FF + c] : HAL[(size_t)((pm - 1) * 2 + 1) * FF + c];
        const float a = siluf(cw[c] * g2 + cw[FF + c] * g1 + cw[2 * FF + c] * g0) * FIXU[(size_t)(pm * 2 + rr) * FF + c];
        ACT[(size_t)(pm * 256 + rr) * FF + c] = (bf16)f2bf(a);
    }
}
__device__ __forceinline__ void transpose_item(const float* W, int K, int ldw, int src_col0, const float* g, bf16* WT, int dst_row0, float* scr, int kb, int lane) {
    const int k0 = 64 * kb;
    float wv[32];
#pragma unroll
    for (int i = 0; i < 32; ++i) wv[i] = W[(size_t)(k0 + 2 * i + (lane >> 5)) * ldw + src_col0 + (lane & 31)];
#pragma unroll
    for (int i = 0; i < 32; ++i) { const int kk = 2 * i + (lane >> 5); const float gs = g ? g[k0 + kk] : 1.f; scr[kk * 33 + (lane & 31)] = wv[i] * gs; }
    LDS_WAIT();
    const int c = lane & 7;
#pragma unroll
    for (int j = 0; j < 4; ++j) { const int n = (lane >> 3) + 8 * j; const float* s = scr + (8 * c) * 33 + n;
        v4u o; o.x = pk2(s[0 * 33], s[1 * 33]); o.y = pk2(s[2 * 33], s[3 * 33]); o.z = pk2(s[4 * 33], s[5 * 33]); o.w = pk2(s[6 * 33], s[7 * 33]);
        *(v4u*)(WT + (size_t)(dst_row0 + n) * K + k0 + 8 * c) = o; }
    LDS_WAIT();
}
__device__ __forceinline__ void convert_matrix(const float* W, int K, int N, int ldw, int skip_from, int skip, const float* g, bf16* WT, int dst_row0, float* scr, int gw, int ngw, int lane, int il = 0) {
    const int nnb = N / 32, nit = (K / 64) * nnb;
    for (int it = gw; it < nit; it += ngw) {
        const int kb = it / nnb, nb = it % nnb, n0 = nb * 32;
        const int drow = il ? ((n0 >> 7) * 256 + (n0 & 127) + (il == 2 ? 128 : 0)) : n0;
        transpose_item(W, K, ldw, n0 + (n0 >= skip_from ? skip : 0), g, WT, dst_row0 + drow, scr, kb, lane);
    }
}
__device__ __forceinline__ void convert_layer_rest(KP P, int l, float* scr, int gw, int ngw, int lane) {
    unsigned char* ws = P->ws;
    convert_matrix(P->in[16] + (size_t)l * D * D, D, D, D, 1 << 30, 0, nullptr, (bf16*)(ws + WS_WOUT) + (size_t)l * D * D, 0, scr, gw, ngw, lane);
    convert_matrix(P->in[18] + (size_t)l * D * FF, D, FF, FF, 1 << 30, 0, P->in[17] + l * D, (bf16*)(ws + WS_WGU) + (size_t)l * NGU * D, 0, scr, gw, ngw, lane, 1);
    convert_matrix(P->in[20] + (size_t)l * D * FF, D, FF, FF, 1 << 30, 0, P->in[17] + l * D, (bf16*)(ws + WS_WGU) + (size_t)l * NGU * D, 0, scr, gw, ngw, lane, 2);
    convert_matrix(P->in[21] + (size_t)l * FF * D, FF, D, D, 1 << 30, 0, nullptr, (bf16*)(ws + WS_WDN) + (size_t)l * D * FF, 0, scr, gw, ngw, lane);
}
__device__ __forceinline__ void convert_win(KP P, int l, float* scr, int gw, int ngw, int lane) {
    convert_matrix(P->in[8] + (size_t)l * D * DIN, D, NPROJ, DIN, 2048, 8, P->in[7] + l * D, (bf16*)(P->ws + WS_WIN), 0, scr, gw, ngw, lane);
}

constexpr int B_QF = 0, B_KF = 33792, B_VF = 67584, B_AT = 101376, B_GC = 118784, B_QKS = 120320, B_WST = 128512;
__device__ __forceinline__ void p2b_item(KP P, int l, int item, unsigned char* lds, int wave_in) {
    const int tid = fresh_tid(wave_in);
    const int h = item & 3, n = (item >> 2) & 31, b = item >> 7;
    const int lane = tid & 63, wv = __builtin_amdgcn_readfirstlane(tid >> 6), fr = lane & 15, fq = lane >> 4;
    float* QF = (float*)(lds + B_QF); float* KF = (float*)(lds + B_KF); float* VF = (float*)(lds + B_VF); float* AT = (float*)(lds + B_AT);
    float* Gs = (float*)(lds + B_GC); float* BETA = Gs + 64; float* GC = Gs + 128; float* EG = Gs + 192; float* EKD = Gs + 256;
    bf16* QKS = (bf16*)(lds + B_QKS); bf16* WST = (bf16*)(lds + B_WST);
    const bf16* PROJ = (const bf16*)(P->ws + WS_PROJ);
    const float* GB = (const float*)(P->ws + WS_GB);
    unsigned char* scr = P->ws + WS_SCR + (size_t)item * SCR_ITEM;
    if (tid < 384) {
        const int chunk = tid % 48, tg = tid / 48, part = chunk >> 4, cc = chunk & 15;
        const int col = part * 512 + h * 128 + cc * 8;
        const float* cw = P->in[9] + (size_t)(l * 4) * 1536 + col;
        float w0[8], w1[8], w2[8], w3[8];
#pragma unroll
        for (int e = 0; e < 8; ++e) { w0[e] = cw[e]; w1[e] = cw[1536 + e]; w2[e] = cw[2 * 1536 + e]; w3[e] = cw[3 * 1536 + e]; }
        const int t0 = n * 64 + tg * 8;
        const bf16* base = PROJ + (size_t)(b * SEQL) * NPROJ + col;
        float r0[8], r1[8], r2[8], r3[8];
#pragma unroll
        for (int e = 0; e < 8; ++e) { r0[e] = 0.f; r1[e] = 0.f; r2[e] = 0.f; }
        if (t0 - 3 >= 0) { const v4u w = *(const v4u*)(base + (size_t)(t0 - 3) * NPROJ); UNPACK8(w, r0); }
        if (t0 - 2 >= 0) { const v4u w = *(const v4u*)(base + (size_t)(t0 - 2) * NPROJ); UNPACK8(w, r1); }
        if (t0 - 1 >= 0) { const v4u w = *(const v4u*)(base + (size_t)(t0 - 1) * NPROJ); UNPACK8(w, r2); }
        float* dst = (float*)(lds + part * 33792) + cc * 8;
#pragma unroll
        for (int i = 0; i < 8; ++i) {
            const v4u w = *(const v4u*)(base + (size_t)(t0 + i) * NPROJ); UNPACK8(w, r3);
            float s[8];
#pragma unroll
            for (int e = 0; e < 8; ++e) { const float cv = w0[e] * r0[e] + w1[e] * r1[e] + w2[e] * r2[e] + w3[e] * r3[e]; s[e] = siluf(cv); }
            float* d = dst + (tg * 8 + i) * 132;
            *(f32x4*)d = (f32x4){s[0], s[1], s[2], s[3]}; *(f32x4*)(d + 4) = (f32x4){s[4], s[5], s[6], s[7]};
#pragma unroll
            for (int e = 0; e < 8; ++e) { r0[e] = r1[e]; r1[e] = r2[e]; r2[e] = r3[e]; }
        }
    }
    if (tid < 64) { const int row = b * SEQL + n * 64 + tid; Gs[tid] = GB[(size_t)row * 8 + h]; BETA[tid] = GB[(size_t)row * 8 + 4 + h]; }
    __syncthreads();
    {
        const int tok = tid >> 3, sub = tid & 7;
        float* qr = QF + tok * 132 + sub * 16; float* kr = KF + tok * 132 + sub * 16;
        float qv[16], kv[16]; float sq = 0.f, sk = 0.f;
#pragma unroll
        for (int e = 0; e < 16; ++e) { qv[e] = qr[e]; kv[e] = kr[e]; sq += qv[e] * qv[e]; sk += kv[e] * kv[e]; }
        sq += __shfl_xor(sq, 1); sq += __shfl_xor(sq, 2); sq += __shfl_xor(sq, 4);
        sk += __shfl_xor(sk, 1); sk += __shfl_xor(sk, 2); sk += __shfl_xor(sk, 4);
        const float rq = rsqrtf(sq + EPS) * 0.08838834764831845f, rk = rsqrtf(sk + EPS);
#pragma unroll
        for (int e = 0; e < 16; ++e) { qr[e] = qv[e] * rq; kr[e] = kv[e] * rk; }
    }
    if (tid < 64) {
        float v = Gs[tid];
#pragma unroll
        for (int o = 1; o < 64; o <<= 1) { const float t = __shfl_up(v, o); if (tid >= o) v += t; }
        const float tot = __shfl(v, 63);
        GC[tid] = v; EG[tid] = __expf(v); EKD[tid] = __expf(tot - v);
        if (tid == 0) ((float*)(P->ws + WS_GL))[item] = __expf(tot);
    }
    __syncthreads();
    {
        const int p = wv >> 2, mt = wv & 3;
        const float* X = p ? QF : KF;
        f32x4 acc[4];
#pragma unroll
        for (int nt = 0; nt < 4; ++nt) acc[nt] = (f32x4){0.f, 0.f, 0.f, 0.f};
        const float* xa = X + (mt * 16 + fr) * 132 + fq; const float* kb_ = KF + fr * 132 + fq;
#pragma unroll 8
        for (int k = 0; k < 128; k += 4) {
            const float a = xa[k];
#pragma unroll
            for (int nt = 0; nt < 4; ++nt) acc[nt] = __builtin_amdgcn_mfma_f32_16x16x4f32(a, kb_[nt * 16 * 132 + k], acc[nt], 0, 0, 0);
        }
#pragma unroll
        for (int nt = 0; nt < 4; ++nt) {
            const int j = nt * 16 + fr; const float gj = GC[j];
            float v[4];
#pragma unroll
            for (int r = 0; r < 4; ++r) {
                const int i = mt * 16 + 4 * fq + r;
                if (p == 0) v[r] = (i > j) ? BETA[i] * acc[nt][r] * __expf(GC[i] - gj) : 0.f;
                else        v[r] = (i >= j) ? acc[nt][r] * __expf(GC[i] - gj) : 0.f;
            }
            if (p == 0) *(f32x4*)(AT + j * 68 + mt * 16 + 4 * fq) = (f32x4){v[0], v[1], v[2], v[3]};
            else {
#pragma unroll
                for (int r = 0; r < 4; ++r) QKS[(mt * 16 + 4 * fq + r) * 64 + j] = (bf16)f2bf(v[r]);
            }
        }
    }
    __syncthreads();
    if (tid < 256) {
        float x[64];
        int zo = 0; asm volatile("" : "+v"(zo));
        const float* ATz = AT + zo; const float* BETAz = BETA + zo; const float* EGz = EG + zo;
        if (tid < 128) {
#pragma unroll
            for (int i = 0; i < 64; ++i) x[i] = BETAz[i] * VF[i * 132 + tid];
        } else {
#pragma unroll
            for (int i = 0; i < 64; ++i) x[i] = BETAz[i] * EGz[i] * KF[i * 132 + tid - 128];
        }
        f32x4 ab[16];
#pragma unroll
        for (int q = 0; q < 16; ++q) ab[q] = *(const f32x4*)(ATz + q * 4);
#pragma unroll
        for (int j = 0; j < 63; ++j) {
            const float xj = x[j];
#pragma unroll
            for (int q = (j + 1) / 4; q < 16; ++q) {
#pragma unroll
                for (int e = 0; e < 4; ++e) if (4 * q + e > j) x[4 * q + e] -= ab[q][e] * xj;
                if (j + 1 < 63 && q >= (j + 2) / 4) ab[q] = *(const f32x4*)(ATz + (j + 1) * 68 + q * 4);
                __builtin_amdgcn_sched_barrier(0);
            }
        }
        if (tid < 128) {
            unsigned char* up = scr + 49152 + tid * 128;
#pragma unroll
            for (int q = 0; q < 8; ++q) *(v4u*)(up + q * 16) = PACK8(x + 8 * q);
        } else {
            const int dk = tid - 128;
#pragma unroll
            for (int i = 0; i < 64; ++i) WST[i * 128 + dk] = (bf16)f2bf(-x[i]);
        }
    } else {
        const int t2 = tid - 256;
        {
            const int tok = t2 >> 2, seg = t2 & 3; const float eg = EG[tok]; const float* s = QF + tok * 132 + seg * 32;
            unsigned char* o = scr + 16384 + tok * 256 + seg * 64;
#pragma unroll
            for (int q = 0; q < 4; ++q) { float f[8];
#pragma unroll
                for (int e = 0; e < 8; ++e) f[e] = s[q * 8 + e] * eg;
                *(v4u*)(o + q * 16) = PACK8(f); }
        }
        {
            const int dk = t2 >> 1, hf = t2 & 1; unsigned char* o = scr + 32768 + dk * 128 + hf * 64;
#pragma unroll
            for (int q = 0; q < 4; ++q) { float f[8];
#pragma unroll
                for (int e = 0; e < 8; ++e) { const int tok = hf * 32 + q * 8 + e; f[e] = KF[tok * 132 + dk] * EKD[tok]; }
                *(v4u*)(o + q * 16) = PACK8(f); }
        }
#pragma unroll
        for (int q = 0; q < 2; ++q) { const int c = t2 + 256 * q; *(v4u*)(scr + 65536 + c * 16) = *(const v4u*)((const unsigned char*)QKS + c * 16); }
    }
    __syncthreads();
#pragma unroll
    for (int q = 0; q < 2; ++q) { const int c = tid + 512 * q; *(v4u*)(scr + c * 16) = *(const v4u*)((const unsigned char*)WST + c * 16); }
    __syncthreads();
}

constexpr int S_ST = 0, S_VNT = 34816, S_OPW = 53248, S_OPQG = 70656, S_OPKD = 88064, S_OPQK = 106496, S_OPU = 115712;
__device__ __forceinline__ void scan_load(v4u (&pre)[9], const unsigned char* src, int tid, int half) {
#pragma unroll
    for (int i = 0; i < 9; ++i) pre[i] = *(const v4u*)(src + (size_t)(tid + 512 * i) * 16);
}
__device__ __forceinline__ void scan_chunk(v4u (&pre)[9], f32x4 (&sacc)[8], unsigned char* lds, unsigned char* scrbase, bf16* orow, int item, int n, float egl, int tid, int w, int fr, int fq, int half) {
    asm volatile("s_waitcnt lgkmcnt(0)" ::: "memory"); __builtin_amdgcn_s_barrier(); asm volatile("" ::: "memory");
#pragma unroll
    for (int i = 0; i < 9; ++i) {
        const int e = (tid + 512 * i) * 16 - (i >> 1) * 16384;
        if (i < 4) { const int row = e >> 8, cb = e & 255; *(v4u*)(lds + (i < 2 ? S_OPW : S_OPQG) + row * 272 + cb) = pre[i]; }
        else { const int row = e >> 7, cb = e & 127; *(v4u*)(lds + (i < 6 ? S_OPKD : (i < 8 ? S_OPU : S_OPQK)) + row * 144 + cb) = pre[i]; }
    }
    asm volatile("s_waitcnt lgkmcnt(0)" ::: "memory"); __builtin_amdgcn_s_barrier(); asm volatile("" ::: "memory");
    scan_load(pre, scrbase + (size_t)(item + (n + 2 < 32 ? 8 : 0)) * SCR_ITEM, tid, half);
    if (w < 4) {
    const int dvt = half * 4 + w;
#define SB() __builtin_amdgcn_sched_barrier(0)
    bf16x8 sf[4];
#pragma unroll
    for (int ks = 0; ks < 4; ++ks) sf[ks] = *(const bf16x8*)(lds + S_ST + (16 * w + fr) * 272 + (ks * 32 + 8 * fq) * 2);
    f32x4 vt[4];
    v2u uu[4];
#pragma unroll
    for (int tt = 0; tt < 4; ++tt) uu[tt] = *(const v2u*)(lds + S_OPU + (16 * dvt + fr) * 144 + (tt * 16 + 4 * fq) * 2);
    {
        bf16x8 af[4][4];
#pragma unroll
        for (int ks = 0; ks < 4; ++ks)
#pragma unroll
            for (int tt = 0; tt < 4; ++tt) af[ks][tt] = *(const bf16x8*)(lds + S_OPW + (tt * 16 + fr) * 272 + (ks * 32 + 8 * fq) * 2);
        SB();
#pragma unroll
        for (int tt = 0; tt < 4; ++tt) vt[tt] = (f32x4){bflo(uu[tt].x), bfhi(uu[tt].x), bflo(uu[tt].y), bfhi(uu[tt].y)};
#pragma unroll
        for (int ks = 0; ks < 4; ++ks)
#pragma unroll
            for (int tt = 0; tt < 4; ++tt) vt[tt] = __builtin_amdgcn_mfma_f32_16x16x32_bf16(af[ks][tt], sf[ks], vt[tt], 0, 0, 0);
        SB();
    }
#pragma unroll
    for (int tt = 0; tt < 4; ++tt) *(v2u*)(lds + S_VNT + (16 * w + fr) * 144 + (tt * 16 + 4 * fq) * 2) = (v2u){pk2(vt[tt][0], vt[tt][1]), pk2(vt[tt][2], vt[tt][3])};
    f32x4 ot[4];
#pragma unroll
    for (int nt = 0; nt < 4; ++nt) ot[nt] = (f32x4){0.f, 0.f, 0.f, 0.f};
    {
        bf16x8 bq[4][4];
#pragma unroll
        for (int ks = 0; ks < 4; ++ks)
#pragma unroll
            for (int nt = 0; nt < 4; ++nt) bq[ks][nt] = *(const bf16x8*)(lds + S_OPQG + (nt * 16 + fr) * 272 + (ks * 32 + 8 * fq) * 2);
        SB();
#pragma unroll
        for (int ks = 0; ks < 4; ++ks)
#pragma unroll
            for (int nt = 0; nt < 4; ++nt) ot[nt] = __builtin_amdgcn_mfma_f32_16x16x32_bf16(sf[ks], bq[ks][nt], ot[nt], 0, 0, 0);
        SB();
    }
    LDS_WAIT();
    bf16x8 vf[2];
#pragma unroll
    for (int js = 0; js < 2; ++js) vf[js] = *(const bf16x8*)(lds + S_VNT + (16 * w + fr) * 144 + (js * 32 + 8 * fq) * 2);
    {
        bf16x8 bk[2][4];
#pragma unroll
        for (int js = 0; js < 2; ++js)
#pragma unroll
            for (int nt = 0; nt < 4; ++nt) bk[js][nt] = *(const bf16x8*)(lds + S_OPQK + (nt * 16 + fr) * 144 + (js * 32 + 8 * fq) * 2);
        SB();
#pragma unroll
        for (int js = 0; js < 2; ++js)
#pragma unroll
            for (int nt = 0; nt < 4; ++nt) ot[nt] = __builtin_amdgcn_mfma_f32_16x16x32_bf16(vf[js], bk[js][nt], ot[nt], 0, 0, 0);
        SB();
    }
#pragma unroll
    for (int nt = 0; nt < 4; ++nt) *(v2u*)(orow + (size_t)(nt * 16 + fr) * D + 16 * dvt + 4 * fq) = (v2u){pk2(ot[nt][0], ot[nt][1]), pk2(ot[nt][2], ot[nt][3])};
    {
        bf16x8 ak[2][8];
#pragma unroll
        for (int js = 0; js < 2; ++js)
#pragma unroll
            for (int mt = 0; mt < 8; ++mt) ak[js][mt] = *(const bf16x8*)(lds + S_OPKD + (mt * 16 + fr) * 144 + (js * 32 + 8 * fq) * 2);
        SB();
#pragma unroll
        for (int mt = 0; mt < 8; ++mt) sacc[mt] = sacc[mt] * egl;
#pragma unroll
        for (int js = 0; js < 2; ++js)
#pragma unroll
            for (int mt = 0; mt < 8; ++mt) sacc[mt] = __builtin_amdgcn_mfma_f32_16x16x32_bf16(ak[js][mt], vf[js], sacc[mt], 0, 0, 0);
        SB();
    }
#pragma unroll
    for (int mt = 0; mt < 8; ++mt) *(v2u*)(lds + S_ST + (16 * w + fr) * 272 + (mt * 16 + 4 * fq) * 2) = (v2u){pk2(sacc[mt][0], sacc[mt][1]), pk2(sacc[mt][2], sacc[mt][3])};
#undef SB
    }
    LDS_WAIT();
}
__device__ __forceinline__ void scan_wg(KP P, int l, int id, unsigned char* lds, int tid) {
    const int bh = id >> 1, half = id & 1, b = bh >> 2, h = bh & 3;
    const int lane = tid & 63, w = __builtin_amdgcn_readfirstlane(tid >> 6), fr = lane & 15, fq = lane >> 4;
    unsigned char* scrbase = P->ws + WS_SCR;
    bf16* OCAT = (bf16*)(P->ws + WS_XA);
    f32x4 sacc[8];
#pragma unroll
    for (int mt = 0; mt < 8; ++mt) sacc[mt] = (f32x4){0.f, 0.f, 0.f, 0.f};
    { unsigned zz0 = 0u; asm volatile("" : "+v"(zz0)); if (w < 4) for (int q = lane; q < 272; q += 64) *(v4u*)(lds + S_ST + (16 * w) * 272 + q * 16) = (v4u){zz0, zz0, zz0, zz0}; }
    const int item0 = (b * 32) * 4 + h;
    const float glv = ((const float*)(P->ws + WS_GL))[item0 + 4 * (lane & 31)];
    v4u preA[9], preB[9];
    scan_load(preA, scrbase + (size_t)item0 * SCR_ITEM, tid, half);
    scan_load(preB, scrbase + (size_t)(item0 + 4) * SCR_ITEM, tid, half);
    bf16* orow = OCAT + (size_t)(b * SEQL) * D + h * 128;
#pragma unroll
    for (int n = 0; n < 32; n += 2) {
        scan_chunk(preA, sacc, lds, scrbase, orow + (size_t)(n * 64) * D, item0 + 4 * n, n, __shfl(glv, n), tid, w, fr, fq, half);
        scan_chunk(preB, sacc, lds, scrbase, orow + (size_t)(n * 64 + 64) * D, item0 + 4 * n + 4, n + 1, __shfl(glv, n + 1), tid, w, fr, fq, half);
    }
    if (w < 4) {
        const int lane2 = lane_id(), fr2 = lane2 & 15, fq2 = lane2 >> 4;
        float* pd = P->out + O_PDELTA + (size_t)((l * NBATCH + b) * 4 + h) * 16384;
#pragma unroll
        for (int mt = 0; mt < 8; ++mt)
#pragma unroll
            for (int r = 0; r < 4; ++r) pd[(mt * 16 + 4 * fq2 + r) * 128 + 16 * (half * 4 + w) + fr2] = sacc[mt][r];
    }
    __syncthreads();
}
__device__ __forceinline__ void p2d(KP P, int l, int gw, int ngw, int lane) {
    const bf16* PROJ = (const bf16*)(P->ws + WS_PROJ);
    bf16* OCAT = (bf16*)(P->ws + WS_XA);
    const float on0 = P->in[12][l * 128 + lane * 2], on1 = P->in[12][l * 128 + lane * 2 + 1];
    for (int pair0 = gw; pair0 < MP * 4; pair0 += 4 * ngw) {
        float o0[4], o1[4]; unsigned zz[4];
#pragma unroll
        for (int q = 0; q < 4; ++q) {
            const int pair = pair0 + q * ngw;
            o0[q] = 0.f; o1[q] = 0.f; zz[q] = 0u;
            if (pair < MP * 4) {
                const int row = pair >> 2, h = pair & 3, b = row >> 11, t = row & 2047, n = t >> 6, tok = t & 63;
                const unsigned ow = *(const unsigned*)(OCAT + (size_t)row * D + h * 128 + lane * 2);
                o0[q] = bflo(ow); o1[q] = bfhi(ow);
                zz[q] = *(const unsigned*)(PROJ + (size_t)row * NPROJ + 1536 + h * 128 + lane * 2);
            }
        }
#pragma unroll
        for (int q = 0; q < 4; ++q) {
            const int pair = pair0 + q * ngw;
            const float rs = rsqrtf(wave_sum(o0[q] * o0[q] + o1[q] * o1[q]) * (1.f / 128.f) + EPS);
            if (pair < MP * 4) {
                const int row = pair >> 2, h = pair & 3;
                *(unsigned*)(OCAT + (size_t)row * D + h * 128 + lane * 2) = pk2(o0[q] * rs * on0 * siluf(bflo(zz[q])), o1[q] * rs * on1 * siluf(bfhi(zz[q])));
            }
        }
    }
}

__device__ __forceinline__ void sample_delta(KP P, int l, int it, unsigned char* lds, int wave_in) {
    const int tid = fresh_tid(wave_in);
    const int gq = tid >> 7, c = tid & 127, wv2 = (tid >> 6) & 1, lane = tid & 63;
    const int item = it * 4 + gq, sb = item >> 2, h = item & 3, rowbase = MP + sb * 8;
    float* QS = (float*)(lds + gq * 12288); float* KS = QS + 1024; float* VS = QS + 2048;
    float* RED2 = (float*)(lds + 49152);
    const bf16* PROJ = (const bf16*)(P->ws + WS_PROJ);
    const float* GB = (const float*)(P->ws + WS_GB);
    bf16* OCAT = (bf16*)(P->ws + WS_XA);
#pragma unroll
    for (int part = 0; part < 3; ++part) {
        const int col = part * 512 + h * 128 + c;
        const float* cw = P->in[9] + (size_t)(l * 4) * 1536 + col;
        const float w0 = cw[0], w1 = cw[1536], w2 = cw[2 * 1536], w3 = cw[3 * 1536];
        const float* hs = P->in[3] + (size_t)((l * DBATCH + sb) * 3) * 1536 + col;
        float r0 = hs[0], r1 = hs[1536], r2 = hs[2 * 1536];
        float* dst = QS + part * 1024 + c;
#pragma unroll
        for (int t = 0; t < 8; ++t) {
            const float x = bf1(PROJ[(size_t)(rowbase + t) * NPROJ + col]);
            dst[t * 128] = siluf(w0 * r0 + w1 * r1 + w2 * r2 + w3 * x);
            r0 = r1; r1 = r2; r2 = x;
        }
    }
#pragma unroll
    for (int t = 0; t < 8; ++t) {
        const float q = QS[t * 128 + c], k = KS[t * 128 + c];
        const float sq = wave_sum(q * q), sk = wave_sum(k * k);
        if (lane == 0) { RED2[(gq * 2 + wv2) * 16 + t] = sq; RED2[(gq * 2 + wv2) * 16 + 8 + t] = sk; }
    }
    __syncthreads();
#pragma unroll
    for (int t = 0; t < 8; ++t) {
        const float tq = RED2[(gq * 2) * 16 + t] + RED2[(gq * 2 + 1) * 16 + t], tk = RED2[(gq * 2) * 16 + 8 + t] + RED2[(gq * 2 + 1) * 16 + 8 + t];
        QS[t * 128 + c] *= rsqrtf(tq + EPS) * 0.08838834764831845f; KS[t * 128 + c] *= rsqrtf(tk + EPS);
    }
    __syncthreads();
    float s[128];
    {
        const float* S0 = P->in[2] + (size_t)((l * DBATCH + sb) * 4 + h) * 16384 + c;
#pragma unroll
        for (int d8 = 0; d8 < 16; ++d8) {
#pragma unroll
            for (int e = 0; e < 8; ++e) s[8 * d8 + e] = S0[e * 128];
            S0 += 8 * 128; asm volatile("" : "+v"(S0));
        }
    }
#pragma unroll 1
    for (int t = 0; t < 8; ++t) {
        const float g = GB[(size_t)(rowbase + t) * 8 + h], beta = GB[(size_t)(rowbase + t) * 8 + 4 + h], eg = __expf(g);
        const f32x4* kp = (const f32x4*)(KS + t * 128); const f32x4* qp = (const f32x4*)(QS + t * 128);
        float dot = 0.f;
#pragma unroll
        for (int d4 = 0; d4 < 32; ++d4) { const f32x4 kv = kp[d4]; dot += kv[0] * s[4 * d4] + kv[1] * s[4 * d4 + 1] + kv[2] * s[4 * d4 + 2] + kv[3] * s[4 * d4 + 3];
            if ((d4 & 3) == 3) asm volatile("" ::: "memory"); }
        const float cf = beta * (VS[t * 128 + c] - eg * dot);
        float o = 0.f;
#pragma unroll
        for (int d4 = 0; d4 < 32; ++d4) { const f32x4 kv = kp[d4], qv = qp[d4];
#pragma unroll
            for (int e = 0; e < 4; ++e) { s[4 * d4 + e] = eg * s[4 * d4 + e] + cf * kv[e]; o += qv[e] * s[4 * d4 + e]; }
            if ((d4 & 3) == 3) asm volatile("" ::: "memory"); }
        VS[t * 128 + c] = o;
    }
    {
        float* sd = P->out + O_SDELTA + (size_t)((l * DBATCH + sb) * 4 + h) * 16384 + c;
#pragma unroll
        for (int d8 = 0; d8 < 16; ++d8) {
#pragma unroll
            for (int e = 0; e < 8; ++e) sd[e * 128] = s[8 * d8 + e];
            sd += 8 * 128; asm volatile("" : "+v"(sd));
        }
    }
    __syncthreads();
#pragma unroll
    for (int t = 0; t < 8; ++t) { const float o = VS[t * 128 + c]; const float so = wave_sum(o * o); if (lane == 0) RED2[(gq * 2 + wv2) * 16 + t] = so; }
    __syncthreads();
    const float onv = P->in[12][l * 128 + c];
#pragma unroll
    for (int t = 0; t < 8; ++t) {
        const float tot = RED2[(gq * 2) * 16 + t] + RED2[(gq * 2 + 1) * 16 + t];
        const float z = bf1(PROJ[(size_t)(rowbase + t) * NPROJ + 1536 + h * 128 + c]);
        OCAT[(size_t)(rowbase + t) * D + h * 128 + c] = (bf16)f2bf(VS[t * 128 + c] * rsqrtf(tot * (1.f / 128.f) + EPS) * onv * siluf(z));
    }
    __syncthreads();
}

constexpr int PL_DT = 0, PL_PW = 33792;
__device__ __forceinline__ void pool_tile(KP P, int l, int tile, unsigned char* lds, int wave_in) {
    const int tid = fresh_tid(wave_in);
    bf16* DT = (bf16*)(lds + PL_DT);
    const bf16* PROJ = (const bf16*)(P->ws + WS_PROJ);
    bf16* OCAT = (bf16*)(P->ws + WS_XA);
#pragma unroll 1
    for (int i = 0; i < 4; ++i) {
        const int idx = tid + 512 * i, tok = idx & 63, ch8 = idx >> 6, c0 = ch8 * 8, gi = ch8 >> 3, win = 2 << gi;
        int row, t, sb = 0; bool smp;
        if (tile < 256) { t = (tile & 31) * 64 + tok; row = (tile >> 5) * SEQL + t; smp = false; }
        else { sb = (tile - 256) * 8 + (tok >> 3); t = tok & 7; row = MP + sb * 8 + t; smp = true; }
        float ssum[8], cur[8];
#pragma unroll
        for (int e = 0; e < 8; ++e) { ssum[e] = 0.f; cur[e] = 0.f; }
        {
            v4u wv[16];
#pragma unroll
            for (int j = 0; j < 16; ++j) {
                wv[j] = (v4u){0u, 0u, 0u, 0u};
                if (j < win && t - j >= 0) wv[j] = *(const v4u*)(PROJ + (size_t)(row - j) * NPROJ + 2048 + c0);
            }
#pragma unroll
            for (int j = 0; j < 16; ++j) {
                float f[8]; UNPACK8(wv[j], f);
#pragma unroll
                for (int e = 0; e < 8; ++e) { ssum[e] += f[e]; if (j == 0) cur[e] = f[e]; }
            }
            if (smp) {
                for (int j = t + 1; j < win; ++j) { const float* sp = P->in[4] + (size_t)((l * DBATCH + sb) * 15 + 15 + t - j) * 256 + c0;
#pragma unroll
                    for (int e = 0; e < 8; ++e) ssum[e] += sp[e]; }
            }
        }
        const float inv = 1.f / (float)(smp ? win : (t + 1 < win ? t + 1 : win));
        { float dd[8];
#pragma unroll
            for (int e = 0; e < 8; ++e) dd[e] = ssum[e] * inv - cur[e];
            *(v4u*)(DT + tok * 264 + c0) = PACK8(dd); }
        float u0[8], u1[8], u2[8];
#pragma unroll
        for (int j = 0; j < 3; ++j) {
            const int tt = t - j; float f[8];
            if (tt >= 0) { const v4u wc = *(const v4u*)(PROJ + (size_t)(row - j) * NPROJ + 2816 + c0); const v4u wx = *(const v4u*)(PROJ + (size_t)(row - j) * NPROJ + 2304 + c0);
                float fc[8], fx[8]; UNPACK8(wc, fc); UNPACK8(wx, fx);
#pragma unroll
                for (int e = 0; e < 8; ++e) f[e] = fc[e] * fx[e]; }
            else if (smp) { const float* sp = P->in[5] + (size_t)((l * DBATCH + sb) * 2 + 2 + tt) * 256 + c0;
#pragma unroll
                for (int e = 0; e < 8; ++e) f[e] = sp[e]; }
            else {
#pragma unroll
                for (int e = 0; e < 8; ++e) f[e] = 0.f; }
#pragma unroll
            for (int e = 0; e < 8; ++e) { if (j == 0) u0[e] = f[e]; else if (j == 1) u1[e] = f[e]; else u2[e] = f[e]; }
        }
        const float* sw = P->in[15] + (size_t)(l * 3) * 256 + c0;
        const v4u wb = *(const v4u*)(PROJ + (size_t)row * NPROJ + 2560 + c0); float fb[8]; UNPACK8(wb, fb);
        float oc[8];
#pragma unroll
        for (int e = 0; e < 8; ++e) oc[e] = fb[e] * (sw[e] * u2[e] + sw[256 + e] * u1[e] + sw[512 + e] * u0[e]);
        *(v4u*)(OCAT + (size_t)row * D + 768 + c0) = PACK8(oc);
    }
    __syncthreads();
    {
        const int lane = tid & 63, wv = tid >> 6, fr = lane & 15, fq = lane >> 4, g = wv & 3, th = wv >> 2;
        bf16x8 df[2][2], pf[4][2];
#pragma unroll
        for (int tt = 0; tt < 2; ++tt)
#pragma unroll
            for (int ks = 0; ks < 2; ++ks) df[tt][ks] = *(const bf16x8*)(lds + PL_DT + ((th * 32 + tt * 16 + fr) * 264 + g * 64 + ks * 32 + 8 * fq) * 2);
#pragma unroll
        for (int et = 0; et < 4; ++et)
#pragma unroll
            for (int ks = 0; ks < 2; ++ks) pf[et][ks] = *(const bf16x8*)(lds + PL_PW + (((g * 64 + et * 16 + fr) * 72) + ks * 32 + 8 * fq) * 2);
#pragma unroll
        for (int tt = 0; tt < 2; ++tt) {
            const int tok = th * 32 + tt * 16 + fr;
            const int row = tile < 256 ? (tile >> 5) * SEQL + (tile & 31) * 64 + tok : MP + (tile - 256) * 64 + tok;
#pragma unroll
            for (int et = 0; et < 4; ++et) {
                f32x4 acc = (f32x4){0.f, 0.f, 0.f, 0.f};
#pragma unroll
                for (int ks = 0; ks < 2; ++ks) acc = __builtin_amdgcn_mfma_f32_16x16x32_bf16(pf[et][ks], df[tt][ks], acc, 0, 0, 0);
                const int ch = g * 64 + et * 16 + 4 * fq;
                const f32x4 sc = *(const f32x4*)(P->in[14] + l * 256 + ch);
                *(v2u*)(OCAT + (size_t)row * D + 512 + ch) = (v2u){pk2(acc[0] * sc[0], acc[1] * sc[1]), pk2(acc[2] * sc[2], acc[3] * sc[3])};
            }
        }
    }
    __syncthreads();
}

__device__ __forceinline__ void state_copies(KP P, int l, int start, int stride) {
    const bf16* PROJ = (const bf16*)(P->ws + WS_PROJ);
    for (int i = start; i < 136 * 8960; i += stride) {
        const int seq = i / 8960, r = i % 8960;
        const bool smp = seq >= 8; const int sb = seq - 8;
        const int L = smp ? 8 : SEQL; const size_t row0 = smp ? (size_t)MP + sb * 8 : (size_t)seq * SEQL;
        if (r < 4608) {
            const int j = r / 1536, c = r % 1536;
            const float v = bf1(PROJ[(row0 + L - 3 + j) * NPROJ + c]);
            if (smp) P->out[O_SDCONV + (size_t)((l * DBATCH + sb) * 3 + j) * 1536 + c] = v; else P->out[O_PDCONV + (size_t)((l * NBATCH + seq) * 3 + j) * 1536 + c] = v;
        } else if (r < 4608 + 3840) {
            const int r2 = r - 4608, j = r2 / 256, c = r2 % 256;
            if (smp) { const float v = j < 7 ? P->in[4][(size_t)((l * DBATCH + sb) * 15 + 8 + j) * 256 + c] : bf1(PROJ[(row0 + j - 7) * NPROJ + 2048 + c]);
                P->out[O_SPOOL + (size_t)((l * DBATCH + sb) * 15 + j) * 256 + c] = v; }
            else P->out[O_PPOOL + (size_t)((l * NBATCH + seq) * 15 + j) * 256 + c] = bf1(PROJ[(row0 + L - 15 + j) * NPROJ + 2048 + c]);
        } else {
            const int r2 = r - 8448, j = r2 / 256, c = r2 % 256;
            const size_t row = row0 + L - 2 + j;
            const float v = bf1(PROJ[row * NPROJ + 2816 + c]) * bf1(PROJ[row * NPROJ + 2304 + c]);
            if (smp) P->out[O_SSCONV + (size_t)((l * DBATCH + sb) * 2 + j) * 256 + c] = v; else P->out[O_PSCONV + (size_t)((l * NBATCH + seq) * 2 + j) * 256 + c] = v;
        }
    }
}

__device__ __forceinline__ void p4b(KP P, int l, int hf, int start, int stride) {
    bf16* GU = (bf16*)(P->ws + WS_GU); bf16* HALO = (bf16*)(P->ws + WS_HALO);
    const float* cw = P->in[19] + (size_t)(l * 3) * FF;
    const int r0 = hf * MH;
    for (int idx = start; idx < MH * 352; idx += stride) {
        const int lr = idx / 352, c0 = (idx % 352) * 8, m = r0 + lr;
        int t, sb = 0; bool smp;
        if (m < MP) { t = m & (SEQL - 1); smp = false; } else { sb = (m - MP) >> 3; t = (m - MP) & 7; smp = true; }
        float g0[8], g1[8], g2[8];
#pragma unroll
        for (int j = 0; j < 3; ++j) {
            const int tt = t - j; float f[8];
            if (tt < 0) {
                if (smp) { const float* sp = P->in[6] + (size_t)((l * DBATCH + sb) * 2 + 2 + tt) * FF + c0;
#pragma unroll
                    for (int e = 0; e < 8; ++e) f[e] = sp[e]; }
                else {
#pragma unroll
                    for (int e = 0; e < 8; ++e) f[e] = 0.f; }
            } else {
                const v4u w = (lr - j < 0) ? *(const v4u*)(HALO + (size_t)(2 + lr - j) * FF + c0) : *(const v4u*)(GU + (size_t)(lr - j) * NGU + c0);
                UNPACK8(w, f);
            }
#pragma unroll
            for (int e = 0; e < 8; ++e) { if (j == 0) g0[e] = f[e]; else if (j == 1) g1[e] = f[e]; else g2[e] = f[e]; }
        }
        const v4u wu = *(const v4u*)(GU + (size_t)lr * NGU + FF + c0); float fu[8]; UNPACK8(wu, fu);
        float a[8];
#pragma unroll
        for (int e = 0; e < 8; ++e) a[e] = siluf(cw[c0 + e] * g2[e] + cw[FF + c0 + e] * g1[e] + cw[2 * FF + c0 + e] * g0[e]) * fu[e];
        *(v4u*)(GU + (size_t)lr * NGU + FF + c0) = PACK8(a);
        if (!smp && t >= SEQL - 2) { float* o = P->out + O_PFFN + (size_t)((l * NBATCH + (m >> 11)) * 2 + t - (SEQL - 2)) * FF + c0;
#pragma unroll
            for (int e = 0; e < 8; ++e) o[e] = g0[e]; }
        if (smp && t >= 6) { float* o = P->out + O_SFFN + (size_t)((l * DBATCH + sb) * 2 + t - 6) * FF + c0;
#pragma unroll
            for (int e = 0; e < 8; ++e) o[e] = g0[e]; }
        if (hf == 0 && lr >= MH - 2) *(v4u*)(HALO + (size_t)(lr - (MH - 2)) * FF + c0) = *(const v4u*)(GU + (size_t)lr * NGU + c0);
    }
}

#define LAS __attribute__((address_space(3)))
#define XB_TMO      128
#define XB_XCNT(j)  (256  + 64 * (j))
#define XB_XSUB(j)  (1280 + 64 * (j))
#define XB_XGEN(j)  (2304 + 64 * (j))
#define XB_TOP      3328
#define XB_TOPGEN   3392
#define XCD_BAR_WORDS 3456
#define XB_SPIN_CAP (1u << 18)

__device__ __forceinline__ unsigned xb_ld(unsigned* p)              { return __hip_atomic_load(p, __ATOMIC_RELAXED, __HIP_MEMORY_SCOPE_AGENT); }
__device__ __forceinline__ unsigned xb_add(unsigned* p, unsigned v) { return __hip_atomic_fetch_add(p, v, __ATOMIC_RELAXED, __HIP_MEMORY_SCOPE_AGENT); }
__device__ __forceinline__ unsigned xb_xcc_id() { return (unsigned)__builtin_amdgcn_s_getreg((3 << 11) | 20) & 0xFu; }
#define XB_SPIN(cond, bar) do { unsigned _sp = 0; while (cond) { __builtin_amdgcn_s_sleep(1); \
    if ((++_sp & 255u) == 0u) { if (xb_ld(&(bar)[XB_TMO])) break; if (_sp > XB_SPIN_CAP) { atomicAdd(&(bar)[XB_TMO], 1u); break; } } } } while (0)

struct XcdBarrier {
    unsigned* bar; unsigned x;
    volatile LAS unsigned* st;
    int wave;
};

__device__ __forceinline__ XcdBarrier xcd_barrier_post(unsigned* bar, volatile LAS unsigned* st) {
    XcdBarrier b; b.bar = bar; b.x = xb_xcc_id(); b.st = st; b.wave = 0;
    if (threadIdx.x == 0) (void)xb_add(&bar[XB_XCNT(b.x)], 1u);
    return b;
}
__device__ __forceinline__ void xcd_barrier_complete(unsigned* bar, unsigned x, unsigned& nloc, unsigned& nx) {
    const unsigned G = gridDim.x * gridDim.y * gridDim.z;
    unsigned sum, cnt, mine, sp = 0u;
    for (;;) {
        sum = 0u; cnt = 0u; mine = 0u;
#pragma unroll
        for (unsigned j = 0; j < 16; ++j) { const unsigned c = xb_ld(&bar[XB_XCNT(j)]); sum += c; cnt += (c > 0u) ? 1u : 0u; mine = (j == x) ? c : mine; }
        if (sum == G) break;
        __builtin_amdgcn_s_sleep(1);
        if ((++sp & 255u) == 0u) { if (xb_ld(&bar[XB_TMO])) break; if (sp > XB_SPIN_CAP) { atomicAdd(&bar[XB_TMO], 1u); break; } }
    }
    nloc = mine > 0u ? mine : 1u; nx = cnt > 0u ? cnt : 1u;
}

__device__ __forceinline__ void xcd_barrier(const XcdBarrier& b) {
    asm volatile("s_waitcnt vmcnt(0)" ::: "memory");
    __syncthreads();
    if (b.wave == 0 && lane_id() == 0) {
        unsigned* bar = b.bar;
        __builtin_amdgcn_s_waitcnt(0);
        unsigned nloc = b.st[0], nx = b.st[1];
        if (nloc == 0u) { xcd_barrier_complete(bar, b.x, nloc, nx); b.st[0] = nloc; b.st[1] = nx; }
        const unsigned old = xb_add(&bar[XB_XSUB(b.x)], 1u);
        const unsigned gen = old / nloc;
        if (old + 1u == (gen + 1u) * nloc) {
            __builtin_amdgcn_fence(__ATOMIC_RELEASE, "agent");
            asm volatile("s_waitcnt vmcnt(0)" ::: "memory");
            const unsigned og = xb_add(&bar[XB_TOP], 1u);
            const unsigned tg = og / nx;
            if (og + 1u == (tg + 1u) * nx) xb_add(&bar[XB_TOPGEN], 1u);
            else XB_SPIN(xb_ld(&bar[XB_TOPGEN]) == tg, bar);
            __builtin_amdgcn_fence(__ATOMIC_ACQUIRE, "agent");
            xb_add(&bar[XB_XGEN(b.x)], 1u);
            asm volatile("s_waitcnt vmcnt(0)" ::: "memory");
        } else {
            XB_SPIN(xb_ld(&bar[XB_XGEN(b.x)]) == gen, bar);
            __builtin_amdgcn_fence(__ATOMIC_ACQUIRE, "agent");
            asm volatile("s_waitcnt vmcnt(0)" ::: "memory");
        }
    }
    __syncthreads();
}

#define XSYNC1() do { XcdBarrier b_; b_.bar = (unsigned*)(kparams()->ws + WS_BAR); b_.x = xb_xcc_id(); b_.st = (volatile LAS unsigned*)((LAS unsigned char*)lds + (LDS_BYTES - 64)); b_.wave = wave; xcd_barrier(b_); } while (0)
#ifdef PROBE_SYNC2
#define GSYNC() do { XSYNC1(); XSYNC1(); } while (0)
#else
#define GSYNC() XSYNC1()
#endif
__global__ void __launch_bounds__(NTHREADS, 2) fwd_megakernel(Params Parg) {
    KP P = kparams();
    extern __shared__ __attribute__((aligned(16))) unsigned char lds[];
    cg::grid_group grid = cg::this_grid();
    const int wave = __builtin_amdgcn_readfirstlane((int)threadIdx.x >> 6);
    const int tid = fresh_tid(wave), lane = tid & 63;
    const int G = gridDim.x, bx = blockIdx.x;
    const int gw = bx * NWAVES + wave, ngw = G * NWAVES;
    const int gt = bx * NTHREADS + tid, ngt = G * NTHREADS;
    unsigned char* ws = P->ws;
    bf16* XA = (bf16*)(ws + WS_XA); bf16* XB2 = (bf16*)(ws + WS_PROJ); bf16* PROJ = (bf16*)(ws + WS_PROJ); bf16* GU = (bf16*)(ws + WS_GU);
    float* SSQ = (float*)(ws + WS_SSQ); float* GB = (float*)(ws + WS_GB); float* WAB = (float*)(ws + WS_WAB);
    float* XRES = P->out;
    float* wscr = (float*)(lds + wave * 16384);
    volatile LAS unsigned* xst = (volatile LAS unsigned*)((LAS unsigned char*)lds + (LDS_BYTES - 64));
    if (tid < 16) xst[tid] = 0u;
    __syncthreads();
    (void)xcd_barrier_post((unsigned*)(ws + WS_BAR), xst);

    for (int i = gt; i < 4 * M; i += ngt) SSQ[M + i] = 0.f;
    for (int i = gt; i < MS * D / 4; i += ngt) ((f32x4*)(XRES + (size_t)MP * D))[i] = ((const f32x4*)P->in[1])[i];
    for (int i = gt; i < 2 * 8 * D; i += ngt) { const int l = i >> 13, j = (i >> 10) & 7, k = i & 1023; WAB[i] = P->in[7][l * D + k] * P->in[8][(size_t)l * D * DIN + (size_t)k * DIN + 2048 + j]; }
    convert_win(P, 0, wscr, gw, ngw, lane);
    convert_layer_rest(P, 0, wscr, gw, ngw, lane);
    convert_layer_rest(P, 1, wscr, gw, ngw, lane);
    for (int m0 = gw; m0 < M; m0 += 2 * ngw) {
        f32x4 v[2][4];
#pragma unroll
        for (int q = 0; q < 2; ++q) { const int m = m0 + q * ngw;
            const float* xr = m < MP ? P->in[0] + (size_t)m * D : P->in[1] + (size_t)((m < M ? m : M - 1) - MP) * D;
#pragma unroll
            for (int j = 0; j < 4; ++j) v[q][j] = ((const f32x4*)xr)[lane + 64 * j]; }
#pragma unroll
        for (int q = 0; q < 2; ++q) { const int m = m0 + q * ngw;
            if (m < M) {
                float ss = 0.f;
#pragma unroll
                for (int j = 0; j < 4; ++j) { const f32x4 w4 = v[q][j]; ss += w4[0] * w4[0] + w4[1] * w4[1] + w4[2] * w4[2] + w4[3] * w4[3];
                    ((v2u*)(XA + (size_t)m * D))[lane + 64 * j] = (v2u){pk2(w4[0], w4[1]), pk2(w4[2], w4[3])}; }
                ss = wave_sum(ss);
                if (lane == 0) SSQ[m] = ss;
            } }
    }
    if (ws == nullptr) grid.sync();
    GSYNC();

#pragma unroll 1
    for (int l = 0; l < 2; ++l) {
#ifndef NO_P1
        {
            const bf16* gA = XA; const bf16* gB = (const bf16*)(ws + WS_WIN); LAUNDER(gA); LAUNDER(gB);
            pg8::Gemm g{gA, gB, M, NPROJ, D, D, D}; pg8::StaticOrder S; S.init(M, NPROJ, G, bx);
            EpiScale E{PROJ, NPROJ, SSQ + (size_t)(2 * l) * M};
            pg8::gemm_phase<EpiScale, pg8::StaticOrder, true, true>((PG8_LAS unsigned char*)lds, g, S, E, wave);
#ifdef PROBE_P1X2
            __syncthreads();
            pg8::gemm_phase<EpiScale, pg8::StaticOrder, true, true>((PG8_LAS unsigned char*)lds, g, S, E, wave);
#endif
        }
#endif
#ifndef NO_AB
        {
            const float* ssq = SSQ + (size_t)(2 * l) * M;
            const int tf = fresh_tid(wave), lane = tf & 63, gw = bx * NWAVES + __builtin_amdgcn_readfirstlane(tf >> 6);
            for (int m = gw; m < M; m += ngw) {
                const v4u* xr = (const v4u*)(XA + (size_t)m * D) + lane * 2;
                const v4u x0 = xr[0], x1 = xr[1]; float xf[16]; UNPACK8(x0, xf); UNPACK8(x1, xf + 8);
                float dot[8];
#pragma unroll
                for (int j = 0; j < 8; ++j) { const float* wp = WAB + (size_t)(l * 8 + j) * D + lane * 16; float s = 0.f;
#pragma unroll
                    for (int e = 0; e < 16; ++e) s += wp[e] * xf[e];
                    dot[j] = wave_sum(s); }
                float v = dot[0];
#pragma unroll
                for (int j = 1; j < 8; ++j) v = (lane == j) ? dot[j] : v;
                if (lane < 8) {
                    v *= rsqrtf(ssq[m] * (1.f / D) + EPS);
                    const int hh = lane & 3; float r;
                    if (lane < 4) { const float xx = v + P->in[11][l * 4 + hh]; const float sp = fmaxf(xx, 0.f) + __logf(1.f + __expf(-fabsf(xx))); r = -__expf(P->in[10][l * 4 + hh]) * sp; }
                    else r = __builtin_amdgcn_rcpf(1.f + __expf(-v));
                    GB[(size_t)m * 8 + lane] = r;
                }
            }
        }
#endif
        GSYNC();
#ifndef NO_P2B
        { const int tf = fresh_tid(wave); for (int item = bx; item < 1024; item += G) p2b_item(P, l, item, lds, wave); }
#ifdef PROBE_P2B2
        __syncthreads(); { const int tf = fresh_tid(wave); for (int item = bx; item < 1024; item += G) p2b_item(P, l, item, lds, wave); }
#endif
#endif
        GSYNC();
#ifdef PROBE_SCAN2
        if (bx < 64) { scan_wg(P, l, bx, lds, fresh_tid(wave)); }
#endif
#ifndef NO_SCAN
        if (bx < 64) scan_wg(P, l, bx, lds, fresh_tid(wave));
        else
#endif
        {
            const int vw = bx - 64, nm = G - 64; const int tid = fresh_tid(wave);
#ifndef NO_SAMPLE
            for (int it = nm - 1 - vw; it < 128; it += nm) sample_delta(P, l, it, lds, wave);
#endif
            for (int i = tid; i < 16384; i += NTHREADS) { const int e = i & 63, c = (i >> 6) & 63, g = i >> 12; ((bf16*)(lds + PL_PW))[(g * 64 + e) * 72 + c] = (bf16)f2bf(P->in[13][(size_t)l * 16384 + i]); }
            __syncthreads();
#ifndef NO_POOL
            for (int tile = vw; tile < 272; tile += nm) pool_tile(P, l, tile, lds, wave);
#endif
            state_copies(P, l, vw * NTHREADS + tid, nm * NTHREADS);
#ifdef PROBE_MISC2
            __syncthreads();
#ifndef NO_SAMPLE
            for (int it = nm - 1 - vw; it < 128; it += nm) sample_delta(P, l, it, lds, wave);
#endif
            for (int i = tid; i < 16384; i += NTHREADS) { const int e = i & 63, c = (i >> 6) & 63, g = i >> 12; ((bf16*)(lds + PL_PW))[(g * 64 + e) * 72 + c] = (bf16)f2bf(P->in[13][(size_t)l * 16384 + i]); }
            __syncthreads();
#ifndef NO_POOL
            for (int tile = vw; tile < 272; tile += nm) pool_tile(P, l, tile, lds, wave);
#endif
            state_copies(P, l, vw * NTHREADS + tid, nm * NTHREADS);
#endif
        }
        GSYNC();
        { const int tf = fresh_tid(wave); p2d(P, l, bx * NWAVES + __builtin_amdgcn_readfirstlane(tf >> 6), ngw, tf & 63); }
        GSYNC();
#ifdef PROBE_P2D2
        { const int tf = fresh_tid(wave); p2d(P, l, bx * NWAVES + __builtin_amdgcn_readfirstlane(tf >> 6), ngw, tf & 63); }
        GSYNC();
        { const int tf = fresh_tid(wave); p2d(P, l, bx * NWAVES + __builtin_amdgcn_readfirstlane(tf >> 6), ngw, tf & 63); }
        GSYNC();
        { const int tf = fresh_tid(wave); p2d(P, l, bx * NWAVES + __builtin_amdgcn_readfirstlane(tf >> 6), ngw, tf & 63); }
        GSYNC();
#endif
        {
            const bf16* gA = XA; const bf16* gB = (const bf16*)(ws + WS_WOUT) + (size_t)l * D * D; LAUNDER(gA); LAUNDER(gB);
            pg8::Gemm g{gA, gB, MP, D, D, D, D}; pg8::StaticOrder S; S.init(MP, D, G, bx);
            EpiResid E{l == 0 ? P->in[0] : XRES, l == 0 ? P->in[1] : XRES + (size_t)MP * D, XRES, XB2, SSQ + (size_t)(2 * l + 1) * M, 0};
            pg8::gemm_phase<EpiResid, pg8::StaticOrder, true, true>((PG8_LAS unsigned char*)lds, g, S, E, wave);
            const int ks = bx >> 4; const bf16* gA2 = XA + (size_t)MP * D + ks * 256; const bf16* gB2 = gB + ks * 256; LAUNDER(gA2); LAUNDER(gB2);
            pg8::Gemm g2{gA2, gB2, MS, D, 256, D, D}; SplitOrder S2{bx < 64 ? (bx & 15) : -1};
            EpiAtomic E2{(float*)(ws + WS_GU) + (size_t)ks * MS * D};
            pg8::gemm_phase<EpiAtomic, SplitOrder, true, true>((PG8_LAS unsigned char*)lds, g2, S2, E2, wave);
        }
        GSYNC();
        fin_sample(XRES + (size_t)MP * D, XB2 + (size_t)MP * D, SSQ + (size_t)(2 * l + 1) * M + MP, (const float*)(ws + WS_GU), 4, nullptr, 0, bx * NWAVES + wave, ngw, lane_id());
        GSYNC();
        {
            const bf16* gA = XB2; const bf16* gB = (const bf16*)(ws + WS_WGU) + (size_t)l * NGU * D; LAUNDER(gA); LAUNDER(gB);
            pg8::Gemm g{gA, gB, M, NGU, D, D, D}; pg8::StaticOrder S; S.init(M, NGU, G, bx);
            EpiGateUp E{GU, SSQ + (size_t)(2 * l + 1) * M, P->in[19] + (size_t)(l * 3) * FF, P->in[6] + (size_t)l * DBATCH * 2 * FF, (float*)(ws + WS_HAL), (float*)(ws + WS_FIXG), (float*)(ws + WS_FIXU),
                        P->out + O_PFFN + (size_t)l * NBATCH * 2 * FF, P->out + O_SFFN + (size_t)l * DBATCH * 2 * FF, lds};
            pg8::gemm_phase<EpiGateUp, pg8::StaticOrder, true, true>((PG8_LAS unsigned char*)lds, g, S, E, wave);
        }
        GSYNC();
        p4_fixup(P, l, bx * NTHREADS + fresh_tid(wave), ngt);
        if (l == 0) { const int tf = fresh_tid(wave); convert_win(P, 1, (float*)(lds + wave * 16384), bx * NWAVES + wave, ngw, tf & 63); }
        GSYNC();
        {
            const bf16* gA = GU; const bf16* gB = (const bf16*)(ws + WS_WDN) + (size_t)l * D * FF; LAUNDER(gA); LAUNDER(gB);
            pg8::Gemm g{gA, gB, MP, D, FF, FF, FF}; pg8::StaticOrder S; S.init(MP, D, G, bx);
            EpiResid E{XRES, XRES + (size_t)MP * D, XRES, XA, SSQ + (size_t)(2 * l + 2) * M, 0};
            pg8::gemm_phase<EpiResid, pg8::StaticOrder, true, true>((PG8_LAS unsigned char*)lds, g, S, E, wave);
            const int ks = bx >> 4; const bf16* gA2 = GU + (size_t)MP * FF + ks * 256; const bf16* gB2 = gB + ks * 256; LAUNDER(gA2); LAUNDER(gB2);
            pg8::Gemm g2{gA2, gB2, MS, D, 256, FF, FF}; SplitOrder S2{bx < 176 ? (bx & 15) : -1};
            EpiAtomic E2{ks < 8 ? (float*)(ws + WS_PROJ) + (size_t)ks * MS * D : (float*)(ws + WS_PART2) + (size_t)(ks - 8) * MS * D};
            pg8::gemm_phase<EpiAtomic, SplitOrder, true, true>((PG8_LAS unsigned char*)lds, g2, S2, E2, wave);
        }
        GSYNC();
        fin_sample(XRES + (size_t)MP * D, XA + (size_t)MP * D, SSQ + (size_t)(2 * l + 2) * M + MP, (const float*)(ws + WS_PROJ), 8, (const float*)(ws + WS_PART2), 3, bx * NWAVES + wave, ngw, lane_id());
        GSYNC();
    }
    {
        const float* ssq = SSQ + (size_t)4 * M; const float* fn = P->in[22];
        const int gt = bx * NTHREADS + fresh_tid(wave);
        for (int i0 = gt; i0 < M * 256; i0 += 4 * ngt) {
            f32x4 v[4]; float sq[4];
#pragma unroll
            for (int q = 0; q < 4; ++q) { const int i = i0 + q * ngt; v[q] = (f32x4){0.f, 0.f, 0.f, 0.f}; sq[q] = 1.f;
                if (i < M * 256) { v[q] = ((const f32x4*)XRES)[i]; sq[q] = ssq[i >> 8]; } }
#pragma unroll
            for (int q = 0; q < 4; ++q) { const int i = i0 + q * ngt;
                if (i < M * 256) { const float rs = rsqrtf(sq[q] * (1.f / D) + EPS); const f32x4 gv = ((const f32x4*)fn)[i & 255];
                    f32x4 o = v[q]; o[0] *= rs * gv[0]; o[1] *= rs * gv[1]; o[2] *= rs * gv[2]; o[3] *= rs * gv[3];
                    ((f32x4*)XRES)[i] = o; } }
        }
    }
}

extern "C" void kernel_launch(void* const* d_in, const int* in_sizes, int n_in, void* d_out, int out_size, void* d_ws, size_t ws_size, hipStream_t stream) {
    static int grid = 0;
    if (grid == 0) {
        if (n_in != 23 || (size_t)out_size != O_TOTAL || ws_size < WS_END) { fprintf(stderr, "kernel_launch: unexpected shapes: n_in %d out %d ws %zu\n", n_in, out_size, ws_size); grid = -1; return; }
        int dev = 0, cus = 0, per_cu = 0;
        hipGetDevice(&dev); hipDeviceGetAttribute(&cus, hipDeviceAttributeMultiprocessorCount, dev);
        if (hipFuncSetAttribute((const void*)fwd_megakernel, hipFuncAttributeMaxDynamicSharedMemorySize, LDS_BYTES) != hipSuccess) { fprintf(stderr, "kernel_launch: hipFuncSetAttribute failed\n"); grid = -1; return; }
        hipOccupancyMaxActiveBlocksPerMultiprocessor(&per_cu, (const void*)fwd_megakernel, NTHREADS, LDS_BYTES);
        (void)hipGetLastError();
        if (per_cu < 1) fprintf(stderr, "kernel_launch: occupancy query reports %d blocks per CU\n", per_cu);
        grid = cus;
    }
    if (grid < 0) return;
    if (hipMemsetAsync((char*)d_ws + WS_BAR, 0, 16384, stream) != hipSuccess) { fprintf(stderr, "kernel_launch: memset failed\n"); return; }
    Params p{};
    for (int i = 0; i < 23; ++i) p.in[i] = (const float*)d_in[i];
    p.out = (float*)d_out; p.ws = (unsigned char*)d_ws;
    void* args[] = {&p};
    hipError_t e = hipLaunchCooperativeKernel((const void*)fwd_megakernel, dim3(grid), dim3(NTHREADS), args, LDS_BYTES, stream);
    if (e != hipSuccess) fprintf(stderr, "cooperative launch failed: %s (grid %d)\n", hipGetErrorString(e), grid);
}
```

```cpp
#include <hip/hip_runtime.h>
#include <hip/hip_cooperative_groups.h>
#include <cstdio>
#include <cstdint>
namespace cg = cooperative_groups;
__device__ __forceinline__ int lane_id() { int t; asm volatile("v_mbcnt_lo_u32_b32 %0, -1, 0\n\tv_mbcnt_hi_u32_b32 %0, -1, %0" : "=v"(t)); return t; }
__device__ __forceinline__ int fresh_tid(int wave) { return (wave << 6) | lane_id(); }
namespace pg8 {
#define PG8_LAS __attribute__((address_space(3)))
typedef unsigned short bf16_t;
typedef short bf16x8 __attribute__((ext_vector_type(8)));
typedef float f32x4 __attribute__((ext_vector_type(4)));
typedef unsigned u32x4 __attribute__((ext_vector_type(4)));
constexpr int BM = 256, BK = 64, HALF = 128, HTB = HALF * BK * 2  , STAGE_BYTES = 8 * HTB, NXCD = 8, WGM = 8;

__host__ __device__ __forceinline__ int lds_byte(int r, int c) { const int st = (r >> 4) * 2 + (c >> 5), rr = r & 15, cc = c & 31, ob = rr * 64 + cc * 2; return st * 1024 + (ob ^ (((ob >> 9) & 1) << 5)); }
__host__ __device__ __forceinline__ void stage_rc(int b, int& R, int& C) { const int st = b / 1024, sb = b % 1024, swz = sb ^ (((sb >> 9) & 1) << 5); R = (st >> 1) * 16 + swz / 64; C = (st & 1) * 32 + (swz % 64) / 2; }
__host__ __device__ __forceinline__ int perm32(int rho) { const int n = rho >> 4, i = rho & 15; return 8 * (i >> 2) + 4 * n + (i & 3); }

struct Unit { int pm, pn; };
struct Gemm { const bf16_t* A; const bf16_t* Bt; int M, N, K, lda, ldb; };

struct StaticOrder {
    int nM, nN, nwg, G, c;
    __host__ __device__ void init(int M, int N, int G_, int c_) { nM = M / BM; nN = N / BM; nwg = nM * nN; G = G_; c = c_; }
    __host__ __device__ bool next(int i, Unit& u) const {
        const long L = (long)i * G + c; if (L >= nwg) return false;
        int wgid = (int)L; { const int q = nwg / NXCD, r = nwg % NXCD, xcd = wgid % NXCD, off = wgid / NXCD; wgid = (xcd < r ? xcd * (q + 1) : r * (q + 1) + (xcd - r) * q) + off; }
        const int nig = WGM * nN, gid = wgid / nig, fm = gid * WGM, gsz = (nM - fm) < WGM ? (nM - fm) : WGM;
        u.pm = fm + ((wgid % nig) % gsz); u.pn = (wgid % nig) / gsz; return true;
    }
    __device__ __forceinline__ void a_ready(const Unit&) const {}
    __device__ __forceinline__ void done(const Unit&) const {}
};

template <class Epi, class Sched, bool ALIGN_EPI = false, bool SP2 = false>
__device__ __forceinline__ void gemm_phase(PG8_LAS unsigned char* lds, const Gemm g, const Sched& S, const Epi& E, const int wave_in) {
    const int tid = fresh_tid(wave_in), wid = __builtin_amdgcn_readfirstlane(tid >> 6), lane = tid & 63, wr = wid >> 2, wc = wid & 3, fr = lane & 15, fq = lane >> 4;
    const int K = g.K, nt = K / BK;
    unsigned voffA[2], voffB[2];
#pragma unroll
    for (int i = 0; i < 2; ++i) { int R, C; stage_rc(tid * 16 + i * 8192, R, C); const int Rb = Epi::PERM ? ((R & ~31) + perm32(R & 31)) : R;
        voffA[i] = (unsigned)(R * g.lda + C) * 2u; voffB[i] = (unsigned)(Rb * g.ldb + C) * 2u; }
    const size_t kstep = (size_t)(BK * 2);
    const size_t hstepA = (size_t)HALF * g.lda * 2, hstepB = (size_t)HALF * g.ldb * 2;
    const size_t tstepA = 2 * hstepA, tstepB = 2 * hstepB;
    const unsigned ldsw = (unsigned)wid * 1024u;
    const int aoff = lds_byte(wr * 64 + fr, fq * 8), boff = lds_byte(wc * 32 + fr, fq * 8);
#define PG8_SA(b, h) (((b) * 2 + (h)) * HTB)
#define PG8_SB(b, h) ((4 + (b) * 2 + (h)) * HTB)
#define PG8_STAGE(bufoff, gbase, voff) do { _Pragma("unroll") for (int _i = 0; _i < 2; ++_i) \
        __builtin_amdgcn_global_load_lds((const unsigned*)((const char*)(gbase) + (voff)[_i]), (PG8_LAS unsigned*)(lds + (bufoff) + ldsw + _i * 8192), 16, 0, 0); } while (0)
#define PG8_LDA(dst, b, h) do { _Pragma("unroll") for (int m = 0; m < 4; ++m) _Pragma("unroll") for (int k = 0; k < 2; ++k) dst[m][k] = *(const PG8_LAS bf16x8*)(lds + PG8_SA(b, h) + aoff + m * 2048 + k * 1024); } while (0)
#define PG8_LDB(dst, b, h) do { _Pragma("unroll") for (int n = 0; n < 2; ++n) _Pragma("unroll") for (int k = 0; k < 2; ++k) dst[n][k] = *(const PG8_LAS bf16x8*)(lds + PG8_SB(b, h) + boff + n * 2048 + k * 1024); } while (0)
#define PG8_MMA(ai, bj, At, Bt) do { __builtin_amdgcn_s_setprio(1); _Pragma("unroll") for (int m = 0; m < 4; ++m) _Pragma("unroll") for (int n = 0; n < 2; ++n) _Pragma("unroll") for (int k = 0; k < 2; ++k) \
        acc[ai][bj][m][n] = __builtin_amdgcn_mfma_f32_16x16x32_bf16(Bt[n][k], At[m][k], acc[ai][bj][m][n], 0, 0, 0); __builtin_amdgcn_s_setprio(0); } while (0)
#define PG8_WAIT_V(n) asm volatile("s_waitcnt vmcnt(" #n ")" ::: "memory")
#define PG8_WAIT_L(n) asm volatile("s_waitcnt lgkmcnt(" #n ")" ::: "memory")
#define PG8_BAR __builtin_amdgcn_s_barrier()
#define PG8_SCHED __builtin_amdgcn_sched_barrier(0)
    Unit cur, nxt; int ui = 0;
    if (!S.next(0, cur)) return;
    f32x4 acc[2][2][4][2];
#pragma unroll
    for (int a = 0; a < 2; ++a)
#pragma unroll
        for (int b = 0; b < 2; ++b)
#pragma unroll
            for (int m = 0; m < 4; ++m)
#pragma unroll
                for (int n = 0; n < 2; ++n) acc[a][b][m][n] = (f32x4){0.f, 0.f, 0.f, 0.f};
    bf16x8 At[4][2], B0[2][2], B1[2][2];
    const char* cA = (const char*)g.A + (size_t)cur.pm * tstepA; const char* cB = (const char*)g.Bt + (size_t)cur.pn * tstepB;
    S.a_ready(cur);
    if constexpr (SP2) {
        PG8_STAGE(PG8_SB(0, 0), cB, voffB); PG8_STAGE(PG8_SB(0, 1), cB + hstepB, voffB); PG8_STAGE(PG8_SA(0, 0), cA, voffA); PG8_STAGE(PG8_SA(0, 1), cA + hstepA, voffA);
        if (wr == 1) PG8_BAR;
        PG8_WAIT_V(2); PG8_BAR;
        PG8_STAGE(PG8_SB(1, 0), cB + kstep, voffB); PG8_STAGE(PG8_SA(1, 0), cA + kstep, voffA); PG8_STAGE(PG8_SB(1, 1), cB + hstepB + kstep, voffB);
        PG8_WAIT_V(6); PG8_BAR;
    } else {
        PG8_STAGE(PG8_SB(0, 0), cB, voffB); PG8_STAGE(PG8_SA(0, 0), cA, voffA); PG8_STAGE(PG8_SB(0, 1), cB + hstepB, voffB); PG8_STAGE(PG8_SA(0, 1), cA + hstepA, voffA);
        if (wr == 1) PG8_BAR;
        PG8_WAIT_V(4); PG8_BAR;
        PG8_STAGE(PG8_SB(1, 0), cB + kstep, voffB); PG8_STAGE(PG8_SA(1, 0), cA + kstep, voffA); PG8_STAGE(PG8_SB(1, 1), cB + hstepB + kstep, voffB);
        PG8_WAIT_V(6); PG8_BAR;
    }
    for (;;) {
        const bool has_next = S.next(ui + 1, nxt);
        const char* nA = has_next ? (const char*)g.A + (size_t)nxt.pm * tstepA : cA; const char* nB = has_next ? (const char*)g.Bt + (size_t)nxt.pn * tstepB : cB;
        for (int t = 0; t < nt; t += 2) {
            const bool last = (t == nt - 2);
            const char* a1 = cA + (size_t)(t + 1) * kstep;
            const char* a2 = last ? nA : cA + (size_t)(t + 2) * kstep; const char* b2 = last ? nB : cB + (size_t)(t + 2) * kstep;
            const char* a3 = a2 + kstep; const char* b3 = b2 + kstep;
            if (last && has_next) S.a_ready(nxt);
            if constexpr (SP2) {
            PG8_LDB(B0, 0, 0); PG8_LDB(B1, 0, 1); PG8_SCHED; PG8_LDA(At, 0, 0); PG8_STAGE(PG8_SA(1, 1), a1 + hstepA, voffA);
            PG8_WAIT_V(8); PG8_WAIT_L(0); PG8_BAR; PG8_MMA(0, 0, At, B0); PG8_MMA(0, 1, At, B1); PG8_BAR; PG8_SCHED;
            PG8_LDA(At, 0, 1); PG8_STAGE(PG8_SB(0, 0), b2, voffB); PG8_STAGE(PG8_SB(0, 1), b2 + hstepB, voffB); PG8_STAGE(PG8_SA(0, 0), a2, voffA);
            PG8_WAIT_V(8); PG8_WAIT_L(0); PG8_BAR; PG8_MMA(1, 0, At, B0); PG8_MMA(1, 1, At, B1); PG8_BAR; PG8_SCHED;
            PG8_LDB(B0, 1, 0); PG8_LDB(B1, 1, 1); PG8_SCHED; PG8_LDA(At, 1, 0); PG8_STAGE(PG8_SA(0, 1), a2 + hstepA, voffA);
            PG8_WAIT_V(8); PG8_WAIT_L(0); PG8_BAR; PG8_MMA(0, 0, At, B0); PG8_MMA(0, 1, At, B1); PG8_BAR; PG8_SCHED;
            PG8_LDA(At, 1, 1); PG8_STAGE(PG8_SB(1, 0), b3, voffB); PG8_STAGE(PG8_SB(1, 1), b3 + hstepB, voffB); PG8_STAGE(PG8_SA(1, 0), a3, voffA);
            PG8_WAIT_V(8); PG8_WAIT_L(0); PG8_BAR; PG8_MMA(1, 0, At, B0); PG8_MMA(1, 1, At, B1); PG8_BAR; PG8_SCHED;
            } else {
            PG8_LDB(B0, 0, 0); PG8_SCHED; PG8_LDA(At, 0, 0); PG8_STAGE(PG8_SA(1, 1), a1 + hstepA, voffA);
            PG8_WAIT_L(8); PG8_BAR; PG8_WAIT_L(0); PG8_MMA(0, 0, At, B0); PG8_BAR; PG8_SCHED;
            PG8_LDB(B1, 0, 1); PG8_STAGE(PG8_SB(0, 0), b2, voffB);
            PG8_BAR; PG8_WAIT_L(0); PG8_MMA(0, 1, At, B1); PG8_BAR;
            PG8_LDA(At, 0, 1); PG8_STAGE(PG8_SA(0, 0), a2, voffA);
            PG8_BAR; PG8_WAIT_L(0); PG8_MMA(1, 0, At, B0); PG8_BAR; PG8_SCHED;
            PG8_STAGE(PG8_SB(0, 1), b2 + hstepB, voffB);
            PG8_WAIT_V(6); PG8_BAR; PG8_MMA(1, 1, At, B1); PG8_BAR;
            PG8_LDB(B0, 1, 0); PG8_SCHED; PG8_LDA(At, 1, 0); PG8_STAGE(PG8_SA(0, 1), a2 + hstepA, voffA);
            PG8_WAIT_L(8); PG8_BAR; PG8_WAIT_L(0); PG8_MMA(0, 0, At, B0); PG8_BAR; PG8_SCHED;
            PG8_LDB(B1, 1, 1); PG8_STAGE(PG8_SB(1, 0), b3, voffB);
            PG8_BAR; PG8_WAIT_L(0); PG8_MMA(0, 1, At, B1); PG8_BAR;
            PG8_LDA(At, 1, 1); PG8_STAGE(PG8_SA(1, 0), a3, voffA);
            PG8_BAR; PG8_WAIT_L(0); PG8_MMA(1, 0, At, B0); PG8_BAR; PG8_SCHED;
            PG8_STAGE(PG8_SB(1, 1), b3 + hstepB, voffB);
            PG8_WAIT_V(6); PG8_BAR; PG8_MMA(1, 1, At, B1); PG8_BAR;
            }
        }
        if constexpr (ALIGN_EPI) { if (wr == 0) PG8_BAR; }
        if constexpr (!Epi::AFTER_DRAIN) { E(acc, cur, wr, wc, fr, fq); S.done(cur); }
        if (!has_next) break;
#pragma unroll
        for (int a = 0; a < 2; ++a)
#pragma unroll
            for (int b = 0; b < 2; ++b)
#pragma unroll
                for (int m = 0; m < 4; ++m)
#pragma unroll
                    for (int n = 0; n < 2; ++n) acc[a][b][m][n] = (f32x4){0.f, 0.f, 0.f, 0.f};
        cur = nxt; cA = nA; cB = nB; ++ui;
        if constexpr (ALIGN_EPI) { if (wr == 1) PG8_BAR; }
    }
    PG8_WAIT_V(0);
    if constexpr (!ALIGN_EPI) { if (wr == 0) PG8_BAR; }
    PG8_BAR;
    if constexpr (Epi::AFTER_DRAIN) { E.fused(acc, cur, wr, wc, fr, fq, lds, wid, lane); S.done(cur); }
#undef PG8_SA
#undef PG8_SB
#undef PG8_STAGE
#undef PG8_LDA
#undef PG8_LDB
#undef PG8_MMA
#undef PG8_WAIT_V
#undef PG8_WAIT_L
#undef PG8_BAR
#undef PG8_SCHED
}
}

typedef unsigned short bf16;
typedef unsigned v4u __attribute__((ext_vector_type(4)));
typedef unsigned v2u __attribute__((ext_vector_type(2)));
typedef float f32x4 __attribute__((ext_vector_type(4)));
typedef short bf16x8 __attribute__((ext_vector_type(8)));

constexpr int D = 1024, MP = 16384, MS = 1024, M = MP + MS, SEQL = 2048, NBATCH = 8, DBATCH = 128;
constexpr int NPROJ = 3072, FF = 2816, NGU = 5632, DIN = 3080, MH = M / 2;
constexpr float EPS = 1e-6f;
constexpr int NTHREADS = 512, NWAVES = 8;
constexpr int LDS_BYTES = 155648;
constexpr size_t MiB = 1u << 20;
constexpr size_t WS_WOUT = 0, WS_WGU = 4 * MiB, WS_WDN = 26 * MiB, WS_XA = 37 * MiB, WS_PROJ = 71 * MiB, WS_GU = 105 * MiB, WS_SCR = 173 * MiB, WS_WIN = 239 * MiB;
constexpr size_t WS_GB = 245 * MiB, WS_SSQ = 245 * MiB + 576 * 1024, WS_WAB = 246 * MiB, WS_GL = 246 * MiB + 64 * 1024, WS_HALO = 246 * MiB + 128 * 1024, WS_BAR = 246 * MiB + 192 * 1024, WS_PART2 = 200 * MiB, WS_HAL = 247 * MiB, WS_FIXG = 249 * MiB, WS_FIXU = 251 * MiB, WS_END = 253 * MiB;
constexpr int SCR_ITEM = 73728;
constexpr size_t O_PDELTA = 17825792, O_PDCONV = 18874368, O_PPOOL = 18948096, O_PSCONV = 19009536, O_PFFN = 19017728;
constexpr size_t O_SDELTA = 19107840, O_SDCONV = 35885056, O_SPOOL = 37064704, O_SSCONV = 38047744, O_SFFN = 38178816, O_TOTAL = 39620608;

struct Params { const float* in[23]; float* out; unsigned char* ws; };
typedef const __attribute__((address_space(4))) Params* KP;
__device__ __forceinline__ KP kparams() { KP p = (KP)__builtin_amdgcn_kernarg_segment_ptr(); asm volatile("" : "+s"(p)); return p; }

#define LAUNDER(p) asm volatile("" : "+s"(p))
#define LDS_WAIT() asm volatile("s_waitcnt lgkmcnt(0)" ::: "memory")
__device__ __forceinline__ unsigned f2bf(float f) { unsigned u = __builtin_bit_cast(unsigned, f); return (u + 0x7fffu + ((u >> 16) & 1u)) >> 16; }
__device__ __forceinline__ unsigned pk2(float lo, float hi) { return f2bf(lo) | (f2bf(hi) << 16); }
__device__ __forceinline__ float bflo(unsigned u) { return __builtin_bit_cast(float, u << 16); }
__device__ __forceinline__ float bfhi(unsigned u) { return __builtin_bit_cast(float, u & 0xffff0000u); }
__device__ __forceinline__ float bf1(bf16 h) { return __builtin_bit_cast(float, ((unsigned)h) << 16); }
__device__ __forceinline__ float siluf(float x) { return x * __builtin_amdgcn_rcpf(1.f + __expf(-x)); }
__device__ __forceinline__ float wave_sum(float v) {
#pragma unroll
    for (int o = 1; o < 64; o <<= 1) v += __shfl_xor(v, o);
    return v;
}
#define UNPACK8(W_, F_) do { (F_)[0] = bflo((W_).x); (F_)[1] = bfhi((W_).x); (F_)[2] = bflo((W_).y); (F_)[3] = bfhi((W_).y); (F_)[4] = bflo((W_).z); (F_)[5] = bfhi((W_).z); (F_)[6] = bflo((W_).w); (F_)[7] = bfhi((W_).w); } while (0)
#define PACK8(F_) ((v4u){pk2((F_)[0], (F_)[1]), pk2((F_)[2], (F_)[3]), pk2((F_)[4], (F_)[5]), pk2((F_)[6], (F_)[7])})

struct EpiScale {
    static constexpr bool PERM = true, AFTER_DRAIN = false;
    bf16* O; int ldc; const float* ssq;
    __device__ __forceinline__ void operator()(const pg8::f32x4 (&acc)[2][2][4][2], const pg8::Unit& u, int wr, int wc, int fr, int fq) const {
        const int row0 = u.pm * 256 + wr * 64 + fr, col0 = u.pn * 256 + wc * 32 + 8 * fq;
        float sq[2][4];
#pragma unroll
        for (int ai = 0; ai < 2; ++ai)
#pragma unroll
            for (int m = 0; m < 4; ++m) sq[ai][m] = ssq[row0 + ai * 128 + m * 16];
#pragma unroll
        for (int ai = 0; ai < 2; ++ai)
#pragma unroll
            for (int m = 0; m < 4; ++m) {
                const int row = row0 + ai * 128 + m * 16;
                const float rs = rsqrtf(sq[ai][m] * (1.f / D) + EPS);
                bf16* rowp = O + (size_t)row * ldc + col0;
#pragma unroll
                for (int bj = 0; bj < 2; ++bj) {
                    pg8::f32x4 v0 = acc[ai][bj][m][0] * rs, v1 = acc[ai][bj][m][1] * rs;
                    v4u w; w.x = pk2(v0[0], v0[1]); w.y = pk2(v0[2], v0[3]); w.z = pk2(v1[0], v1[1]); w.w = pk2(v1[2], v1[3]);
                    *(v4u*)(rowp + bj * 128) = w;
                }
            }
    }
};
struct EpiResid {
    static constexpr bool PERM = true, AFTER_DRAIN = false;
    const float* xa; const float* xb_; float* xres; bf16* xb16; float* ssq; int rowbase;
    __device__ __forceinline__ void operator()(const pg8::f32x4 (&acc)[2][2][4][2], const pg8::Unit& u, int wr, int wc, int fr, int fq) const {
        const int row0 = rowbase + u.pm * 256 + wr * 64 + fr, col0 = u.pn * 256 + wc * 32 + 8 * fq;
#pragma unroll
        for (int ai = 0; ai < 2; ++ai) {
            pg8::f32x4 xo4[4][4];
#pragma unroll
            for (int m = 0; m < 4; ++m) {
                const int row = row0 + ai * 128 + m * 16;
                const float* xo = (row < MP ? xa + (size_t)row * D : xb_ + (size_t)(row - MP) * D) + col0;
                xo4[m][0] = *(const pg8::f32x4*)xo; xo4[m][1] = *(const pg8::f32x4*)(xo + 4); xo4[m][2] = *(const pg8::f32x4*)(xo + 128); xo4[m][3] = *(const pg8::f32x4*)(xo + 132);
            }
#pragma unroll
            for (int m = 0; m < 4; ++m) {
                const int row = row0 + ai * 128 + m * 16;
                float* xr = xres + (size_t)row * D + col0;
                bf16* xh = xb16 + (size_t)row * D + col0;
                float ss = 0.f;
#pragma unroll
                for (int bj = 0; bj < 2; ++bj) {
                    pg8::f32x4 v0 = acc[ai][bj][m][0] + xo4[m][2 * bj], v1 = acc[ai][bj][m][1] + xo4[m][2 * bj + 1];
                    *(pg8::f32x4*)(xr + bj * 128) = v0; *(pg8::f32x4*)(xr + bj * 128 + 4) = v1;
                    v4u w; w.x = pk2(v0[0], v0[1]); w.y = pk2(v0[2], v0[3]); w.z = pk2(v1[0], v1[1]); w.w = pk2(v1[2], v1[3]);
                    *(v4u*)(xh + bj * 128) = w;
                    ss += v0[0] * v0[0] + v0[1] * v0[1] + v0[2] * v0[2] + v0[3] * v0[3] + v1[0] * v1[0] + v1[1] * v1[1] + v1[2] * v1[2] + v1[3] * v1[3];
                }
                ss += __shfl_xor(ss, 16); ss += __shfl_xor(ss, 32);
                if (fq == 0) atomicAdd(ssq + row, ss);
            }
        }
    }
};


struct SplitOrder {
    int unit;
    __device__ __forceinline__ bool next(int i, pg8::Unit& u) const { if (i != 0 || unit < 0) return false; u.pm = unit >> 2; u.pn = unit & 3; return true; }
    __device__ __forceinline__ void a_ready(const pg8::Unit&) const {}
    __device__ __forceinline__ void done(const pg8::Unit&) const {}
};
struct EpiAtomic {
    static constexpr bool PERM = true, AFTER_DRAIN = false;
    float* X;
    __device__ __forceinline__ void operator()(const pg8::f32x4 (&acc)[2][2][4][2], const pg8::Unit& u, int wr, int wc, int fr, int fq) const {
        const int row0 = u.pm * 256 + wr * 64 + fr, col0 = u.pn * 256 + wc * 32 + 8 * fq;
#pragma unroll
        for (int ai = 0; ai < 2; ++ai)
#pragma unroll
            for (int m = 0; m < 4; ++m) {
                float* xr = X + (size_t)(row0 + ai * 128 + m * 16) * D + col0;
#pragma unroll
                for (int bj = 0; bj < 2; ++bj) { *(pg8::f32x4*)(xr + bj * 128) = acc[ai][bj][m][0]; *(pg8::f32x4*)(xr + bj * 128 + 4) = acc[ai][bj][m][1]; }
            }
    }
};
__device__ __forceinline__ void fin_sample(float* X, bf16* XB, float* ssq, const float* partA, int nA, const float* partB, int nB, int gw, int ngw, int lane) {
    for (int r = gw; r < MS; r += ngw) {
        f32x4 v[4];
#pragma unroll
        for (int j = 0; j < 4; ++j) v[j] = ((const f32x4*)(X + (size_t)r * D))[lane + 64 * j];
        for (int k = 0; k < nA; ++k) {
#pragma unroll
            for (int j = 0; j < 4; ++j) v[j] += ((const f32x4*)(partA + ((size_t)k * MS + r) * D))[lane + 64 * j];
        }
        for (int k = 0; k < nB; ++k) {
#pragma unroll
            for (int j = 0; j < 4; ++j) v[j] += ((const f32x4*)(partB + ((size_t)k * MS + r) * D))[lane + 64 * j];
        }
        float ss = 0.f;
#pragma unroll
        for (int j = 0; j < 4; ++j) { ss += v[j][0] * v[j][0] + v[j][1] * v[j][1] + v[j][2] * v[j][2] + v[j][3] * v[j][3];
            ((f32x4*)(X + (size_t)r * D))[lane + 64 * j] = v[j];
            ((v2u*)(XB + (size_t)r * D))[lane + 64 * j] = (v2u){pk2(v[j][0], v[j][1]), pk2(v[j][2], v[j][3])}; }
        ss = wave_sum(ss);
        if (lane == 0) ssq[r] = ss;
    }
}

constexpr int EPI_HALO_OFF = 131072;
__device__ __forceinline__ float dpp_f(float oldv, float src, const int ctrl_sel) {
    const int o = __builtin_bit_cast(int, oldv), v = __builtin_bit_cast(int, src); int r;
    if (ctrl_sel == 0) r = __builtin_amdgcn_update_dpp(o, v, 0x111, 0xf, 0xf, false);
    else if (ctrl_sel == 1) r = __builtin_amdgcn_update_dpp(o, v, 0x112, 0xf, 0xf, false);
    else if (ctrl_sel == 2) r = __builtin_amdgcn_update_dpp(o, v, 0x121, 0xf, 0xf, false);
    else r = __builtin_amdgcn_update_dpp(o, v, 0x122, 0xf, 0xf, false);
    return __builtin_bit_cast(float, r);
}
struct EpiGateUp {
    static constexpr bool PERM = true, AFTER_DRAIN = false;
    bf16* ACT; const float* ssq; const float* cw; const float* st; float* HAL; float* FIXG; float* FIXU; float* pffn; float* sffn; unsigned char* lds;
    __device__ __forceinline__ void operator()(const pg8::f32x4 (&acc)[2][2][4][2], const pg8::Unit& u, int wr, int wc, int fr, int fq) const {
        const int pm = u.pm, ch0 = u.pn * 128 + wc * 32 + 8 * fq, row0 = pm * 256 + wr * 64 + fr;
        const bool smp = pm >= 64;
        float* halo = (float*)(lds + EPI_HALO_OFF);
#pragma unroll
        for (int ai = 0; ai < 2; ++ai) {
            const float rs = rsqrtf(ssq[row0 + ai * 128 + 48] * (1.f / D) + EPS);
            if (fr >= 14) {
                float* hp = halo + ((ai * 2 + wr) * 2 + (fr - 14)) * 128 + wc * 32 + 8 * fq;
                *(pg8::f32x4*)hp = acc[ai][0][3][0] * rs; *(pg8::f32x4*)(hp + 4) = acc[ai][0][3][1] * rs;
            }
        }
        asm volatile("s_waitcnt lgkmcnt(0)" ::: "memory");
        __builtin_amdgcn_s_barrier();
        float w0[8], w1[8], w2[8];
#pragma unroll
        for (int e = 0; e < 8; ++e) { w0[e] = cw[ch0 + e]; w1[e] = cw[FF + ch0 + e]; w2[e] = cw[2 * FF + ch0 + e]; }
#pragma unroll
        for (int ai = 0; ai < 2; ++ai) {
            const int s = ai * 2 + wr;
            float prev[8];
#pragma unroll
            for (int e = 0; e < 8; ++e) prev[e] = 0.f;
            if (!smp && s >= 1 && fr >= 14) {
                const float* hp = halo + ((s - 1) * 2 + (fr - 14)) * 128 + wc * 32 + 8 * fq;
                const pg8::f32x4 h0 = *(const pg8::f32x4*)hp, h1 = *(const pg8::f32x4*)(hp + 4);
                prev[0] = h0[0]; prev[1] = h0[1]; prev[2] = h0[2]; prev[3] = h0[3]; prev[4] = h1[0]; prev[5] = h1[1]; prev[6] = h1[2]; prev[7] = h1[3];
            }
            float sq4[4];
#pragma unroll
            for (int m = 0; m < 4; ++m) sq4[m] = ssq[row0 + ai * 128 + m * 16];
#pragma unroll
            for (int m = 0; m < 4; ++m) {
                const int row = row0 + ai * 128 + m * 16;
                const float rs = rsqrtf(sq4[m] * (1.f / D) + EPS);
                float cur[8], upv[8], s0v[8], s1v[8];
#pragma unroll
                for (int e = 0; e < 8; ++e) { cur[e] = acc[ai][0][m][e >> 2][e & 3] * rs; upv[e] = acc[ai][1][m][e >> 2][e & 3] * rs; s0v[e] = 0.f; s1v[e] = 0.f; }
                const int t = fr & 7, sb = (row - MP) >> 3;
                if (smp && t < 2) {
                    const float* sp = st + (size_t)(sb * 2) * FF + ch0;
#pragma unroll
                    for (int e = 0; e < 8; ++e) { s0v[e] = sp[e]; s1v[e] = sp[FF + e]; }
                }
                float a[8];
#pragma unroll
                for (int e = 0; e < 8; ++e) {
                    const float sh1 = dpp_f(cur[e], cur[e], 0), sh2 = dpp_f(cur[e], cur[e], 1), ro1 = dpp_f(prev[e], prev[e], 2), ro2 = dpp_f(prev[e], prev[e], 3);
                    float p1, p2;
                    if (smp) { p1 = t >= 1 ? sh1 : s1v[e]; p2 = t >= 2 ? sh2 : (t == 1 ? s1v[e] : s0v[e]); }
                    else { p1 = fr >= 1 ? sh1 : ro1; p2 = fr >= 2 ? sh2 : ro2; }
                    a[e] = siluf(w0[e] * p2 + w1[e] * p1 + w2[e] * cur[e]) * upv[e];
                }
                *(v4u*)(ACT + (size_t)row * FF + ch0) = PACK8(a);
                if (smp) {
                    if (t >= 6) { float* o = sffn + (size_t)(sb * 2 + t - 6) * FF + ch0;
                        *(pg8::f32x4*)o = (pg8::f32x4){cur[0], cur[1], cur[2], cur[3]}; *(pg8::f32x4*)(o + 4) = (pg8::f32x4){cur[4], cur[5], cur[6], cur[7]}; }
                } else {
                    if (s == 3 && m == 3 && fr >= 14) {
                        float* o = HAL + (size_t)(pm * 2 + fr - 14) * FF + ch0;
                        *(pg8::f32x4*)o = (pg8::f32x4){cur[0], cur[1], cur[2], cur[3]}; *(pg8::f32x4*)(o + 4) = (pg8::f32x4){cur[4], cur[5], cur[6], cur[7]};
                        if ((pm & 7) == 7) { float* o2 = pffn + (size_t)((pm >> 3) * 2 + fr - 14) * FF + ch0;
                            *(pg8::f32x4*)o2 = (pg8::f32x4){cur[0], cur[1], cur[2], cur[3]}; *(pg8::f32x4*)(o2 + 4) = (pg8::f32x4){cur[4], cur[5], cur[6], cur[7]}; }
                    }
                    if (s == 0 && m == 0 && fr < 2 && (pm & 7) != 0) {
                        float* o = FIXG + (size_t)(pm * 2 + fr) * FF + ch0; float* o2 = FIXU + (size_t)(pm * 2 + fr) * FF + ch0;
                        *(pg8::f32x4*)o = (pg8::f32x4){cur[0], cur[1], cur[2], cur[3]}; *(pg8::f32x4*)(o + 4) = (pg8::f32x4){cur[4], cur[5], cur[6], cur[7]};
                        *(pg8::f32x4*)o2 = (pg8::f32x4){upv[0], upv[1], upv[2], upv[3]}; *(pg8::f32x4*)(o2 + 4) = (pg8::f32x4){upv[4], upv[5], upv[6], upv[7]};
                    }
                }
#pragma unroll
                for (int e = 0; e < 8; ++e) prev[e] = cur[e];
            }
        }
    }
};
__device__ __forceinline__ void p4_fixup(KP P, int l, int start, int stride) {
    const float* HAL = (const float*)(P->ws + WS_HAL); const float* FIXG = (const float*)(P->ws + WS_FIXG); const float* FIXU = (const float*)(P->ws + WS_FIXU);
    bf16* ACT = (bf16*)(P->ws + WS_GU);
    const float* cw = P->in[19] + (size_t)(l * 3) * FF;
    for (int idx = start; idx < 56 * 2 * FF; idx += stride) {
        const int k = idx / (2 * FF), rem = idx % (2 * FF), rr = rem / FF, c = rem % FF;
        const int pm = (k / 7) * 8 + 1 + (k % 7);
        const float g0 = FIXG[(size_t)(pm * 2 + rr) * FF + c];
        const float g1 = rr == 0 ? HAL[(size_t)((pm - 1) * 2 + 1) * FF + c] : FIXG[(size_t)(pm * 2) * FF + c];
        const float g2 = rr == 0 ? HAL[(size_t)((pm - 1) * 2) * FF + c] : HAL[(size_t)((pm - 1) * 2 + 1) * FF + c];
        const float a = siluf(cw[c] * g2 + cw[FF + c] * g1 + cw[2 * FF + c] * g0) * FIXU[(size_t)(pm * 2 + rr) * FF + c];
        ACT[(size_t)(pm * 256 + rr) * FF + c] = (bf16)f2bf(a);
    }
}
__device__ __forceinline__ void transpose_item(const float* W, int K, int ldw, int src_col0, const float* g, bf16* WT, int dst_row0, float* scr, int kb, int lane) {
    const int k0 = 64 * kb;
    float wv[32];
#pragma unroll
    for (int i = 0; i < 32; ++i) wv[i] = W[(size_t)(k0 + 2 * i + (lane >> 5)) * ldw + src_col0 + (lane & 31)];
#pragma unroll
    for (int i = 0; i < 32; ++i) { const int kk = 2 * i + (lane >> 5); const float gs = g ? g[k0 + kk] : 1.f; scr[kk * 33 + (lane & 31)] = wv[i] * gs; }
    LDS_WAIT();
    const int c = lane & 7;
#pragma unroll
    for (int j = 0; j < 4; ++j) { const int n = (lane >> 3) + 8 * j; const float* s = scr + (8 * c) * 33 + n;
        v4u o; o.x = pk2(s[0 * 33], s[1 * 33]); o.y = pk2(s[2 * 33], s[3 * 33]); o.z = pk2(s[4 * 33], s[5 * 33]); o.w = pk2(s[6 * 33], s[7 * 33]);
        *(v4u*)(WT + (size_t)(dst_row0 + n) * K + k0 + 8 * c) = o; }
    LDS_WAIT();
}
__device__ __forceinline__ void convert_matrix(const float* W, int K, int N, int ldw, int skip_from, int skip, const float* g, bf16* WT, int dst_row0, float* scr, int gw, int ngw, int lane, int il = 0) {
    const int nnb = N / 32, nit = (K / 64) * nnb;
    for (int it = gw; it < nit; it += ngw) {
        const int kb = it / nnb, nb = it % nnb, n0 = nb * 32;
        const int drow = il ? ((n0 >> 7) * 256 + (n0 & 127) + (il == 2 ? 128 : 0)) : n0;
        transpose_item(W, K, ldw, n0 + (n0 >= skip_from ? skip : 0), g, WT, dst_row0 + drow, scr, kb, lane);
    }
}
__device__ __forceinline__ void convert_layer_rest(KP P, int l, float* scr, int gw, int ngw, int lane) {
    unsigned char* ws = P->ws;
    convert_matrix(P->in[16] + (size_t)l * D * D, D, D, D, 1 << 30, 0, nullptr, (bf16*)(ws + WS_WOUT) + (size_t)l * D * D, 0, scr, gw, ngw, lane);
    convert_matrix(P->in[18] + (size_t)l * D * FF, D, FF, FF, 1 << 30, 0, P->in[17] + l * D, (bf16*)(ws + WS_WGU) + (size_t)l * NGU * D, 0, scr, gw, ngw, lane, 1);
    convert_matrix(P->in[20] + (size_t)l * D * FF, D, FF, FF, 1 << 30, 0, P->in[17] + l * D, (bf16*)(ws + WS_WGU) + (size_t)l * NGU * D, 0, scr, gw, ngw, lane, 2);
    convert_matrix(P->in[21] + (size_t)l * FF * D, FF, D, D, 1 << 30, 0, nullptr, (bf16*)(ws + WS_WDN) + (size_t)l * D * FF, 0, scr, gw, ngw, lane);
}
__device__ __forceinline__ void convert_win(KP P, int l, float* scr, int gw, int ngw, int lane) {
    convert_matrix(P->in[8] + (size_t)l * D * DIN, D, NPROJ, DIN, 2048, 8, P->in[7] + l * D, (bf16*)(P->ws + WS_WIN), 0, scr, gw, ngw, lane);
}

constexpr int B_QF = 0, B_KF = 33792, B_VF = 67584, B_AT = 101376, B_GC = 118784, B_QKS = 120320, B_WST = 128512;
__device__ __forceinline__ void p2b_item(KP P, int l, int item, unsigned char* lds, int wave_in) {
    const int tid = fresh_tid(wave_in);
    const int h = item & 3, n = (item >> 2) & 31, b = item >> 7;
    const int lane = tid & 63, wv = __builtin_amdgcn_readfirstlane(tid >> 6), fr = lane & 15, fq = lane >> 4;
    float* QF = (float*)(lds + B_QF); float* KF = (float*)(lds + B_KF); float* VF = (float*)(lds + B_VF); float* AT = (float*)(lds + B_AT);
    float* Gs = (float*)(lds + B_GC); float* BETA = Gs + 64; float* GC = Gs + 128; float* EG = Gs + 192; float* EKD = Gs + 256;
    bf16* QKS = (bf16*)(lds + B_QKS); bf16* WST = (bf16*)(lds + B_WST);
    const bf16* PROJ = (const bf16*)(P->ws + WS_PROJ);
    const float* GB = (const float*)(P->ws + WS_GB);
    unsigned char* scr = P->ws + WS_SCR + (size_t)item * SCR_ITEM;
    if (tid < 384) {
        const int chunk = tid % 48, tg = tid / 48, part = chunk >> 4, cc = chunk & 15;
        const int col = part * 512 + h * 128 + cc * 8;
        const float* cw = P->in[9] + (size_t)(l * 4) * 1536 + col;
        float w0[8], w1[8], w2[8], w3[8];
#pragma unroll
        for (int e = 0; e < 8; ++e) { w0[e] = cw[e]; w1[e] = cw[1536 + e]; w2[e] = cw[2 * 1536 + e]; w3[e] = cw[3 * 1536 + e]; }
        const int t0 = n * 64 + tg * 8;
        const bf16* base = PROJ + (size_t)(b * SEQL) * NPROJ + col;
        float r0[8], r1[8], r2[8], r3[8];
#pragma unroll
        for (int e = 0; e < 8; ++e) { r0[e] = 0.f; r1[e] = 0.f; r2[e] = 0.f; }
        if (t0 - 3 >= 0) { const v4u w = *(const v4u*)(base + (size_t)(t0 - 3) * NPROJ); UNPACK8(w, r0); }
        if (t0 - 2 >= 0) { const v4u w = *(const v4u*)(base + (size_t)(t0 - 2) * NPROJ); UNPACK8(w, r1); }
        if (t0 - 1 >= 0) { const v4u w = *(const v4u*)(base + (size_t)(t0 - 1) * NPROJ); UNPACK8(w, r2); }
        float* dst = (float*)(lds + part * 33792) + cc * 8;
#pragma unroll
        for (int i = 0; i < 8; ++i) {
            const v4u w = *(const v4u*)(base + (size_t)(t0 + i) * NPROJ); UNPACK8(w, r3);
            float s[8];
#pragma unroll
            for (int e = 0; e < 8; ++e) { const float cv = w0[e] * r0[e] + w1[e] * r1[e] + w2[e] * r2[e] + w3[e] * r3[e]; s[e] = siluf(cv); }
            float* d = dst + (tg * 8 + i) * 132;
            *(f32x4*)d = (f32x4){s[0], s[1], s[2], s[3]}; *(f32x4*)(d + 4) = (f32x4){s[4], s[5], s[6], s[7]};
#pragma unroll
            for (int e = 0; e < 8; ++e) { r0[e] = r1[e]; r1[e] = r2[e]; r2[e] = r3[e]; }
        }
    }
    if (tid < 64) { const int row = b * SEQL + n * 64 + tid; Gs[tid] = GB[(size_t)row * 8 + h]; BETA[tid] = GB[(size_t)row * 8 + 4 + h]; }
    __syncthreads();
    {
        const int tok = tid >> 3, sub = tid & 7;
        float* qr = QF + tok * 132 + sub * 16; float* kr = KF + tok * 132 + sub * 16;
        float qv[16], kv[16]; float sq = 0.f, sk = 0.f;
#pragma unroll
        for (int e = 0; e < 16; ++e) { qv[e] = qr[e]; kv[e] = kr[e]; sq += qv[e] * qv[e]; sk += kv[e] * kv[e]; }
        sq += __shfl_xor(sq, 1); sq += __shfl_xor(sq, 2); sq += __shfl_xor(sq, 4);
        sk += __shfl_xor(sk, 1); sk += __shfl_xor(sk, 2); sk += __shfl_xor(sk, 4);
        const float rq = rsqrtf(sq + EPS) * 0.08838834764831845f, rk = rsqrtf(sk + EPS);
#pragma unroll
        for (int e = 0; e < 16; ++e) { qr[e] = qv[e] * rq; kr[e] = kv[e] * rk; }
    }
    if (tid < 64) {
        float v = Gs[tid];
#pragma unroll
        for (int o = 1; o < 64; o <<= 1) { const float t = __shfl_up(v, o); if (tid >= o) v += t; }
        const float tot = __shfl(v, 63);
        GC[tid] = v; EG[tid] = __expf(v); EKD[tid] = __expf(tot - v);
        if (tid == 0) ((float*)(P->ws + WS_GL))[item] = __expf(tot);
    }
    __syncthreads();
    {
        const int p = wv >> 2, mt = wv & 3;
        const float* X = p ? QF : KF;
        f32x4 acc[4];
#pragma unroll
        for (int nt = 0; nt < 4; ++nt) acc[nt] = (f32x4){0.f, 0.f, 0.f, 0.f};
        const float* xa = X + (mt * 16 + fr) * 132 + fq; const float* kb_ = KF + fr * 132 + fq;
#pragma unroll 8
        for (int k = 0; k < 128; k += 4) {
            const float a = xa[k];
#pragma unroll
            for (int nt = 0; nt < 4; ++nt) acc[nt] = __builtin_amdgcn_mfma_f32_16x16x4f32(a, kb_[nt * 16 * 132 + k], acc[nt], 0, 0, 0);
        }
#pragma unroll
        for (int nt = 0; nt < 4; ++nt) {
            const int j = nt * 16 + fr; const float gj = GC[j];
            float v[4];
#pragma unroll
            for (int r = 0; r < 4; ++r) {
                const int i = mt * 16 + 4 * fq + r;
                if (p == 0) v[r] = (i > j) ? BETA[i] * acc[nt][r] * __expf(GC[i] - gj) : 0.f;
                else        v[r] = (i >= j) ? acc[nt][r] * __expf(GC[i] - gj) : 0.f;
            }
            if (p == 0) *(f32x4*)(AT + j * 68 + mt * 16 + 4 * fq) = (f32x4){v[0], v[1], v[2], v[3]};
            else {
#pragma unroll
                for (int r = 0; r < 4; ++r) QKS[(mt * 16 + 4 * fq + r) * 64 + j] = (bf16)f2bf(v[r]);
            }
        }
    }
    __syncthreads();
    if (tid < 256) {
        float x[64];
        int zo = 0; asm volatile("" : "+v"(zo));
        const float* ATz = AT + zo; const float* BETAz = BETA + zo; const float* EGz = EG + zo;
        if (tid < 128) {
#pragma unroll
            for (int i = 0; i < 64; ++i) x[i] = BETAz[i] * VF[i * 132 + tid];
        } else {
#pragma unroll
            for (int i = 0; i < 64; ++i) x[i] = BETAz[i] * EGz[i] * KF[i * 132 + tid - 128];
        }
        f32x4 ab[16];
#pragma unroll
        for (int q = 0; q < 16; ++q) ab[q] = *(const f32x4*)(ATz + q * 4);
#pragma unroll
        for (int j = 0; j < 63; ++j) {
            const float xj = x[j];
#pragma unroll
            for (int q = (j + 1) / 4; q < 16; ++q) {
#pragma unroll
                for (int e = 0; e < 4; ++e) if (4 * q + e > j) x[4 * q + e] -= ab[q][e] * xj;
                if (j + 1 < 63 && q >= (j + 2) / 4) ab[q] = *(const f32x4*)(ATz + (j + 1) * 68 + q * 4);
                __builtin_amdgcn_sched_barrier(0);
            }
        }
        if (tid < 128) {
            unsigned char* up = scr + 49152 + tid * 128;
#pragma unroll
            for (int q = 0; q < 8; ++q) *(v4u*)(up + q * 16) = PACK8(x + 8 * q);
        } else {
            const int dk = tid - 128;
#pragma unroll
            for (int i = 0; i < 64; ++i) WST[i * 128 + dk] = (bf16)f2bf(-x[i]);
        }
    } else {
        const int t2 = tid - 256;
        {
            const int tok = t2 >> 2, seg = t2 & 3; const float eg = EG[tok]; const float* s = QF + tok * 132 + seg * 32;
            unsigned char* o = scr + 16384 + tok * 256 + seg * 64;
#pragma unroll
            for (int q = 0; q < 4; ++q) { float f[8];
#pragma unroll
                for (int e = 0; e < 8; ++e) f[e] = s[q * 8 + e] * eg;
                *(v4u*)(o + q * 16) = PACK8(f); }
        }
        {
            const int dk = t2 >> 1, hf = t2 & 1; unsigned char* o = scr + 32768 + dk * 128 + hf * 64;
#pragma unroll
            for (int q = 0; q < 4; ++q) { float f[8];
#pragma unroll
                for (int e = 0; e < 8; ++e) { const int tok = hf * 32 + q * 8 + e; f[e] = KF[tok * 132 + dk] * EKD[tok]; }
                *(v4u*)(o + q * 16) = PACK8(f); }
        }
#pragma unroll
        for (int q = 0; q < 2; ++q) { const int c = t2 + 256 * q; *(v4u*)(scr + 65536 + c * 16) = *(const v4u*)((const unsigned char*)QKS + c * 16); }
    }
    __syncthreads();
#pragma unroll
    for (int q = 0; q < 2; ++q) { const int c = tid + 512 * q; *(v4u*)(scr + c * 16) = *(const v4u*)((const unsigned char*)WST + c * 16); }
    __syncthreads();
}

constexpr int S_ST = 0, S_VNT = 34816, S_OPW = 53248, S_OPQG = 70656, S_OPKD = 88064, S_OPQK = 106496, S_OPU = 115712;
__device__ __forceinline__ void scan_load(v4u (&pre)[9], const unsigned char* src, int tid, int half) {
#pragma unroll
    for (int i = 0; i < 9; ++i) pre[i] = *(const v4u*)(src + (size_t)(tid + 512 * i) * 16);
}
__device__ __forceinline__ void scan_chunk(v4u (&pre)[9], f32x4 (&sacc)[8], unsigned char* lds, unsigned char* scrbase, bf16* orow, int item, int n, float egl, int tid, int w, int fr, int fq, int half) {
    asm volatile("s_waitcnt lgkmcnt(0)" ::: "memory"); __builtin_amdgcn_s_barrier(); asm volatile("" ::: "memory");
#pragma unroll
    for (int i = 0; i < 9; ++i) {
        const int e = (tid + 512 * i) * 16 - (i >> 1) * 16384;
        if (i < 4) { const int row = e >> 8, cb = e & 255; *(v4u*)(lds + (i < 2 ? S_OPW : S_OPQG) + row * 272 + cb) = pre[i]; }
        else { const int row = e >> 7, cb = e & 127; *(v4u*)(lds + (i < 6 ? S_OPKD : (i < 8 ? S_OPU : S_OPQK)) + row * 144 + cb) = pre[i]; }
    }
    asm volatile("s_waitcnt lgkmcnt(0)" ::: "memory"); __builtin_amdgcn_s_barrier(); asm volatile("" ::: "memory");
    scan_load(pre, scrbase + (size_t)(item + (n + 2 < 32 ? 8 : 0)) * SCR_ITEM, tid, half);
    if (w < 4) {
    const int dvt = half * 4 + w;
#define SB() __builtin_amdgcn_sched_barrier(0)
    bf16x8 sf[4];
#pragma unroll
    for (int ks = 0; ks < 4; ++ks) sf[ks] = *(const bf16x8*)(lds + S_ST + (16 * w + fr) * 272 + (ks * 32 + 8 * fq) * 2);
    f32x4 vt[4];
    v2u uu[4];
#pragma unroll
    for (int tt = 0; tt < 4; ++tt) uu[tt] = *(const v2u*)(lds + S_OPU + (16 * dvt + fr) * 144 + (tt * 16 + 4 * fq) * 2);
    {
        bf16x8 af[4][4];
#pragma unroll
        for (int ks = 0; ks < 4; ++ks)
#pragma unroll
            for (int tt = 0; tt < 4; ++tt) af[ks][tt] = *(const bf16x8*)(lds + S_OPW + (tt * 16 + fr) * 272 + (ks * 32 + 8 * fq) * 2);
        SB();
#pragma unroll
        for (int tt = 0; tt < 4; ++tt) vt[tt] = (f32x4){bflo(uu[tt].x), bfhi(uu[tt].x), bflo(uu[tt].y), bfhi(uu[tt].y)};
#pragma unroll
        for (int ks = 0; ks < 4; ++ks)
#pragma unroll
            for (int tt = 0; tt < 4; ++tt) vt[tt] = __builtin_amdgcn_mfma_f32_16x16x32_bf16(af[ks][tt], sf[ks], vt[tt], 0, 0, 0);
        SB();
    }
#pragma unroll
    for (int tt = 0; tt < 4; ++tt) *(v2u*)(lds + S_VNT + (16 * w + fr) * 144 + (tt * 16 + 4 * fq) * 2) = (v2u){pk2(vt[tt][0], vt[tt][1]), pk2(vt[tt][2], vt[tt][3])};
    f32x4 ot[4];
#pragma unroll
    for (int nt = 0; nt < 4; ++nt) ot[nt] = (f32x4){0.f, 0.f, 0.f, 0.f};
    {
        bf16x8 bq[4][4];
#pragma unroll
        for (int ks = 0; ks < 4; ++ks)
#pragma unroll
            for (int nt = 0; nt < 4; ++nt) bq[ks][nt] = *(const bf16x8*)(lds + S_OPQG + (nt * 16 + fr) * 272 + (ks * 32 + 8 * fq) * 2);
        SB();
#pragma unroll
        for (int ks = 0; ks < 4; ++ks)
#pragma unroll
            for (int nt = 0; nt < 4; ++nt) ot[nt] = __builtin_amdgcn_mfma_f32_16x16x32_bf16(sf[ks], bq[ks][nt], ot[nt], 0, 0, 0);
        SB();
    }
    LDS_WAIT();
    bf16x8 vf[2];
#pragma unroll
    for (int js = 0; js < 2; ++js) vf[js] = *(const bf16x8*)(lds + S_VNT + (16 * w + fr) * 144 + (js * 32 + 8 * fq) * 2);
    {
        bf16x8 bk[2][4];
#pragma unroll
        for (int js = 0; js < 2; ++js)
#pragma unroll
            for (int nt = 0; nt < 4; ++nt) bk[js][nt] = *(const bf16x8*)(lds + S_OPQK + (nt * 16 + fr) * 144 + (js * 32 + 8 * fq) * 2);
        SB();
#pragma unroll
        for (int js = 0; js < 2; ++js)
#pragma unroll
            for (int nt = 0; nt < 4; ++nt) ot[nt] = __builtin_amdgcn_mfma_f32_16x16x32_bf16(vf[js], bk[js][nt], ot[nt], 0, 0, 0);
        SB();
    }
#pragma unroll
    for (int nt = 0; nt < 4; ++nt) *(v2u*)(orow + (size_t)(nt * 16 + fr) * D + 16 * dvt + 4 * fq) = (v2u){pk2(ot[nt][0], ot[nt][1]), pk2(ot[nt][2], ot[nt][3])};
    {
        bf16x8 ak[2][8];
#pragma unroll
        for (int js = 0; js < 2; ++js)
#pragma unroll
            for (int mt = 0; mt < 8; ++mt) ak[js][mt] = *(const bf16x8*)(lds + S_OPKD + (mt * 16 + fr) * 144 + (js * 32 + 8 * fq) * 2);
        SB();
#pragma unroll
        for (int mt = 0; mt < 8; ++mt) sacc[mt] = sacc[mt] * egl;
#pragma unroll
        for (int js = 0; js < 2; ++js)
#pragma unroll
            for (int mt = 0; mt < 8; ++mt) sacc[mt] = __builtin_amdgcn_mfma_f32_16x16x32_bf16(ak[js][mt], vf[js], sacc[mt], 0, 0, 0);
        SB();
    }
#pragma unroll
    for (int mt = 0; mt < 8; ++mt) *(v2u*)(lds + S_ST + (16 * w + fr) * 272 + (mt * 16 + 4 * fq) * 2) = (v2u){pk2(sacc[mt][0], sacc[mt][1]), pk2(sacc[mt][2], sacc[mt][3])};
#undef SB
    }
    LDS_WAIT();
}
__device__ __forceinline__ void scan_wg(KP P, int l, int id, unsigned char* lds, int tid) {
    const int bh = id >> 1, half = id & 1, b = bh >> 2, h = bh & 3;
    const int lane = tid & 63, w = __builtin_amdgcn_readfirstlane(tid >> 6), fr = lane & 15, fq = lane >> 4;
    unsigned char* scrbase = P->ws + WS_SCR;
    bf16* OCAT = (bf16*)(P->ws + WS_XA);
    f32x4 sacc[8];
#pragma unroll
    for (int mt = 0; mt < 8; ++mt) sacc[mt] = (f32x4){0.f, 0.f, 0.f, 0.f};
    { unsigned zz0 = 0u; asm volatile("" : "+v"(zz0)); if (w < 4) for (int q = lane; q < 272; q += 64) *(v4u*)(lds + S_ST + (16 * w) * 272 + q * 16) = (v4u){zz0, zz0, zz0, zz0}; }
    const int item0 = (b * 32) * 4 + h;
    const float glv = ((const float*)(P->ws + WS_GL))[item0 + 4 * (lane & 31)];
    v4u preA[9], preB[9];
    scan_load(preA, scrbase + (size_t)item0 * SCR_ITEM, tid, half);
    scan_load(preB, scrbase + (size_t)(item0 + 4) * SCR_ITEM, tid, half);
    bf16* orow = OCAT + (size_t)(b * SEQL) * D + h * 128;
#pragma unroll
    for (int n = 0; n < 32; n += 2) {
        scan_chunk(preA, sacc, lds, scrbase, orow + (size_t)(n * 64) * D, item0 + 4 * n, n, __shfl(glv, n), tid, w, fr, fq, half);
        scan_chunk(preB, sacc, lds, scrbase, orow + (size_t)(n * 64 + 64) * D, item0 + 4 * n + 4, n + 1, __shfl(glv, n + 1), tid, w, fr, fq, half);
    }
    if (w < 4) {
        const int lane2 = lane_id(), fr2 = lane2 & 15, fq2 = lane2 >> 4;
        float* pd = P->out + O_PDELTA + (size_t)((l * NBATCH + b) * 4 + h) * 16384;
#pragma unroll
        for (int mt = 0; mt < 8; ++mt)
#pragma unroll
            for (int r = 0; r < 4; ++r) pd[(mt * 16 + 4 * fq2 + r) * 128 + 16 * (half * 4 + w) + fr2] = sacc[mt][r];
    }
    __syncthreads();
}
__device__ __forceinline__ void p2d(KP P, int l, int gw, int ngw, int lane) {
    const bf16* PROJ = (const bf16*)(P->ws + WS_PROJ);
    bf16* OCAT = (bf16*)(P->ws + WS_XA);
    const float on0 = P->in[12][l * 128 + lane * 2], on1 = P->in[12][l * 128 + lane * 2 + 1];
    for (int pair0 = gw; pair0 < MP * 4; pair0 += 4 * ngw) {
        float o0[4], o1[4]; unsigned zz[4];
#pragma unroll
        for (int q = 0; q < 4; ++q) {
            const int pair = pair0 + q * ngw;
            o0[q] = 0.f; o1[q] = 0.f; zz[q] = 0u;
            if (pair < MP * 4) {
                const int row = pair >> 2, h = pair & 3, b = row >> 11, t = row & 2047, n = t >> 6, tok = t & 63;
                const unsigned ow = *(const unsigned*)(OCAT + (size_t)row * D + h * 128 + lane * 2);
                o0[q] = bflo(ow); o1[q] = bfhi(ow);
                zz[q] = *(const unsigned*)(PROJ + (size_t)row * NPROJ + 1536 + h * 128 + lane * 2);
            }
        }
#pragma unroll
        for (int q = 0; q < 4; ++q) {
            const int pair = pair0 + q * ngw;
            const float rs = rsqrtf(wave_sum(o0[q] * o0[q] + o1[q] * o1[q]) * (1.f / 128.f) + EPS);
            if (pair < MP * 4) {
                const int row = pair >> 2, h = pair & 3;
                *(unsigned*)(OCAT + (size_t)row * D + h * 128 + lane * 2) = pk2(o0[q] * rs * on0 * siluf(bflo(zz[q])), o1[q] * rs * on1 * siluf(bfhi(zz[q])));
            }
        }
    }
}

__device__ __forceinline__ void sample_delta(KP P, int l, int it, unsigned char* lds, int wave_in) {
    const int tid = fresh_tid(wave_in);
    const int gq = tid >> 7, c = tid & 127, wv2 = (tid >> 6) & 1, lane = tid & 63;
    const int item = it * 4 + gq, sb = item >> 2, h = item & 3, rowbase = MP + sb * 8;
    float* QS = (float*)(lds + gq * 12288); float* KS = QS + 1024; float* VS = QS + 2048;
    float* RED2 = (float*)(lds + 49152);
    const bf16* PROJ = (const bf16*)(P->ws + WS_PROJ);
    const float* GB = (const float*)(P->ws + WS_GB);
    bf16* OCAT = (bf16*)(P->ws + WS_XA);
#pragma unroll
    for (int part = 0; part < 3; ++part) {
        const int col = part * 512 + h * 128 + c;
        const float* cw = P->in[9] + (size_t)(l * 4) * 1536 + col;
        const float w0 = cw[0], w1 = cw[1536], w2 = cw[2 * 1536], w3 = cw[3 * 1536];
        const float* hs = P->in[3] + (size_t)((l * DBATCH + sb) * 3) * 1536 + col;
        float r0 = hs[0], r1 = hs[1536], r2 = hs[2 * 1536];
        float* dst = QS + part * 1024 + c;
#pragma unroll
        for (int t = 0; t < 8; ++t) {
            const float x = bf1(PROJ[(size_t)(rowbase + t) * NPROJ + col]);
            dst[t * 128] = siluf(w0 * r0 + w1 * r1 + w2 * r2 + w3 * x);
            r0 = r1; r1 = r2; r2 = x;
        }
    }
#pragma unroll
    for (int t = 0; t < 8; ++t) {
        const float q = QS[t * 128 + c], k = KS[t * 128 + c];
        const float sq = wave_sum(q * q), sk = wave_sum(k * k);
        if (lane == 0) { RED2[(gq * 2 + wv2) * 16 + t] = sq; RED2[(gq * 2 + wv2) * 16 + 8 + t] = sk; }
    }
    __syncthreads();
#pragma unroll
    for (int t = 0; t < 8; ++t) {
        const float tq = RED2[(gq * 2) * 16 + t] + RED2[(gq * 2 + 1) * 16 + t], tk = RED2[(gq * 2) * 16 + 8 + t] + RED2[(gq * 2 + 1) * 16 + 8 + t];
        QS[t * 128 + c] *= rsqrtf(tq + EPS) * 0.08838834764831845f; KS[t * 128 + c] *= rsqrtf(tk + EPS);
    }
    __syncthreads();
    float s[128];
    {
        const float* S0 = P->in[2] + (size_t)((l * DBATCH + sb) * 4 + h) * 16384 + c;
#pragma unroll
        for (int d8 = 0; d8 < 16; ++d8) {
#pragma unroll
            for (int e = 0; e < 8; ++e) s[8 * d8 + e] = S0[e * 128];
            S0 += 8 * 128; asm volatile("" : "+v"(S0));
        }
    }
#pragma unroll 1
    for (int t = 0; t < 8; ++t) {
        const float g = GB[(size_t)(rowbase + t) * 8 + h], beta = GB[(size_t)(rowbase + t) * 8 + 4 + h], eg = __expf(g);
        const f32x4* kp = (const f32x4*)(KS + t * 128); const f32x4* qp = (const f32x4*)(QS + t * 128);
        float dot = 0.f;
#pragma unroll
        for (int d4 = 0; d4 < 32; ++d4) { const f32x4 kv = kp[d4]; dot += kv[0] * s[4 * d4] + kv[1] * s[4 * d4 + 1] + kv[2] * s[4 * d4 + 2] + kv[3] * s[4 * d4 + 3];
            if ((d4 & 3) == 3) asm volatile("" ::: "memory"); }
        const float cf = beta * (VS[t * 128 + c] - eg * dot);
        float o = 0.f;
#pragma unroll
        for (int d4 = 0; d4 < 32; ++d4) { const f32x4 kv = kp[d4], qv = qp[d4];
#pragma unroll
            for (int e = 0; e < 4; ++e) { s[4 * d4 + e] = eg * s[4 * d4 + e] + cf * kv[e]; o += qv[e] * s[4 * d4 + e]; }
            if ((d4 & 3) == 3) asm volatile("" ::: "memory"); }
        VS[t * 128 + c] = o;
    }
    {
        float* sd = P->out + O_SDELTA + (size_t)((l * DBATCH + sb) * 4 + h) * 16384 + c;
#pragma unroll
        for (int d8 = 0; d8 < 16; ++d8) {
#pragma unroll
            for (int e = 0; e < 8; ++e) sd[e * 128] = s[8 * d8 + e];
            sd += 8 * 128; asm volatile("" : "+v"(sd));
        }
    }
    __syncthreads();
#pragma unroll
    for (int t = 0; t < 8; ++t) { const float o = VS[t * 128 + c]; const float so = wave_sum(o * o); if (lane == 0) RED2[(gq * 2 + wv2) * 16 + t] = so; }
    __syncthreads();
    const float onv = P->in[12][l * 128 + c];
#pragma unroll
    for (int t = 0; t < 8; ++t) {
        const float tot = RED2[(gq * 2) * 16 + t] + RED2[(gq * 2 + 1) * 16 + t];
        const float z = bf1(PROJ[(size_t)(rowbase + t) * NPROJ + 1536 + h * 128 + c]);
        OCAT[(size_t)(rowbase + t) * D + h * 128 + c] = (bf16)f2bf(VS[t * 128 + c] * rsqrtf(tot * (1.f / 128.f) + EPS) * onv * siluf(z));
    }
    __syncthreads();
}

constexpr int PL_DT = 0, PL_PW = 33792;
__device__ __forceinline__ void pool_tile(KP P, int l, int tile, unsigned char* lds, int wave_in) {
    const int tid = fresh_tid(wave_in);
    bf16* DT = (bf16*)(lds + PL_DT);
    const bf16* PROJ = (const bf16*)(P->ws + WS_PROJ);
    bf16* OCAT = (bf16*)(P->ws + WS_XA);
#pragma unroll 1
    for (int i = 0; i < 4; ++i) {
        const int idx = tid + 512 * i, tok = idx & 63, ch8 = idx >> 6, c0 = ch8 * 8, gi = ch8 >> 3, win = 2 << gi;
        int row, t, sb = 0; bool smp;
        if (tile < 256) { t = (tile & 31) * 64 + tok; row = (tile >> 5) * SEQL + t; smp = false; }
        else { sb = (tile - 256) * 8 + (tok >> 3); t = tok & 7; row = MP + sb * 8 + t; smp = true; }
        float ssum[8], cur[8];
#pragma unroll
        for (int e = 0; e < 8; ++e) { ssum[e] = 0.f; cur[e] = 0.f; }
        {
            v4u wv[16];
#pragma unroll
            for (int j = 0; j < 16; ++j) {
                wv[j] = (v4u){0u, 0u, 0u, 0u};
                if (j < win && t - j >= 0) wv[j] = *(const v4u*)(PROJ + (size_t)(row - j) * NPROJ + 2048 + c0);
            }
#pragma unroll
            for (int j = 0; j < 16; ++j) {
                float f[8]; UNPACK8(wv[j], f);
#pragma unroll
                for (int e = 0; e < 8; ++e) { ssum[e] += f[e]; if (j == 0) cur[e] = f[e]; }
            }
            if (smp) {
                for (int j = t + 1; j < win; ++j) { const float* sp = P->in[4] + (size_t)((l * DBATCH + sb) * 15 + 15 + t - j) * 256 + c0;
#pragma unroll
                    for (int e = 0; e < 8; ++e) ssum[e] += sp[e]; }
            }
        }
        const float inv = 1.f / (float)(smp ? win : (t + 1 < win ? t + 1 : win));
        { float dd[8];
#pragma unroll
            for (int e = 0; e < 8; ++e) dd[e] = ssum[e] * inv - cur[e];
            *(v4u*)(DT + tok * 264 + c0) = PACK8(dd); }
        float u0[8], u1[8], u2[8];
#pragma unroll
        for (int j = 0; j < 3; ++j) {
            const int tt = t - j; float f[8];
            if (tt >= 0) { const v4u wc = *(const v4u*)(PROJ + (size_t)(row - j) * NPROJ + 2816 + c0); const v4u wx = *(const v4u*)(PROJ + (size_t)(row - j) * NPROJ + 2304 + c0);
                float fc[8], fx[8]; UNPACK8(wc, fc); UNPACK8(wx, fx);
#pragma unroll
                for (int e = 0; e < 8; ++e) f[e] = fc[e] * fx[e]; }
            else if (smp) { const float* sp = P->in[5] + (size_t)((l * DBATCH + sb) * 2 + 2 + tt) * 256 + c0;
#pragma unroll
                for (int e = 0; e < 8; ++e) f[e] = sp[e]; }
            else {
#pragma unroll
                for (int e = 0; e < 8; ++e) f[e] = 0.f; }
#pragma unroll
            for (int e = 0; e < 8; ++e) { if (j == 0) u0[e] = f[e]; else if (j == 1) u1[e] = f[e]; else u2[e] = f[e]; }
        }
        const float* sw = P->in[15] + (size_t)(l * 3) * 256 + c0;
        const v4u wb = *(const v4u*)(PROJ + (size_t)row * NPROJ + 2560 + c0); float fb[8]; UNPACK8(wb, fb);
        float oc[8];
#pragma unroll
        for (int e = 0; e < 8; ++e) oc[e] = fb[e] * (sw[e] * u2[e] + sw[256 + e] * u1[e] + sw[512 + e] * u0[e]);
        *(v4u*)(OCAT + (size_t)row * D + 768 + c0) = PACK8(oc);
    }
    __syncthreads();
    {
        const int lane = tid & 63, wv = tid >> 6, fr = lane & 15, fq = lane >> 4, g = wv & 3, th = wv >> 2;
        bf16x8 df[2][2], pf[4][2];
#pragma unroll
        for (int tt = 0; tt < 2; ++tt)
#pragma unroll
            for (int ks = 0; ks < 2; ++ks) df[tt][ks] = *(const bf16x8*)(lds + PL_DT + ((th * 32 + tt * 16 + fr) * 264 + g * 64 + ks * 32 + 8 * fq) * 2);
#pragma unroll
        for (int et = 0; et < 4; ++et)
#pragma unroll
            for (int ks = 0; ks < 2; ++ks) pf[et][ks] = *(const bf16x8*)(lds + PL_PW + (((g * 64 + et * 16 + fr) * 72) + ks * 32 + 8 * fq) * 2);
#pragma unroll
        for (int tt = 0; tt < 2; ++tt) {
            const int tok = th * 32 + tt * 16 + fr;
            const int row = tile < 256 ? (tile >> 5) * SEQL + (tile & 31) * 64 + tok : MP + (tile - 256) * 64 + tok;
#pragma unroll
            for (int et = 0; et < 4; ++et) {
                f32x4 acc = (f32x4){0.f, 0.f, 0.f, 0.f};
#pragma unroll
                for (int ks = 0; ks < 2; ++ks) acc = __builtin_amdgcn_mfma_f32_16x16x32_bf16(pf[et][ks], df[tt][ks], acc, 0, 0, 0);
                const int ch = g * 64 + et * 16 + 4 * fq;
                const f32x4 sc = *(const f32x4*)(P->in[14] + l * 256 + ch);
                *(v2u*)(OCAT + (size_t)row * D + 512 + ch) = (v2u){pk2(acc[0] * sc[0], acc[1] * sc[1]), pk2(acc[2] * sc[2], acc[3] * sc[3])};
            }
        }
    }
    __syncthreads();
}

__device__ __forceinline__ void state_copies(KP P, int l, int start, int stride) {
    const bf16* PROJ = (const bf16*)(P->ws + WS_PROJ);
    for (int i = start; i < 136 * 1120; i += stride) {
        const int seq = i / 1120, r = (i % 1120) * 8;
        const bool smp = seq >= 8; const int sb = seq - 8;
        const int L = smp ? 8 : SEQL; const size_t row0 = smp ? (size_t)MP + sb * 8 : (size_t)seq * SEQL;
        float f[8]; float* o;
        if (r < 4608) {
            const int j = r / 1536, c = r % 1536;
            const v4u w = *(const v4u*)(PROJ + (row0 + L - 3 + j) * NPROJ + c); UNPACK8(w, f);
            o = smp ? P->out + O_SDCONV + (size_t)((l * DBATCH + sb) * 3 + j) * 1536 + c : P->out + O_PDCONV + (size_t)((l * NBATCH + seq) * 3 + j) * 1536 + c;
        } else if (r < 4608 + 3840) {
            const int r2 = r - 4608, j = r2 / 256, c = r2 % 256;
            if (smp) {
                if (j < 7) { const float* sp = P->in[4] + (size_t)((l * DBATCH + sb) * 15 + 8 + j) * 256 + c;
#pragma unroll
                    for (int e = 0; e < 8; ++e) f[e] = sp[e]; }
                else { const v4u w = *(const v4u*)(PROJ + (row0 + j - 7) * NPROJ + 2048 + c); UNPACK8(w, f); }
                o = P->out + O_SPOOL + (size_t)((l * DBATCH + sb) * 15 + j) * 256 + c;
            } else {
                const v4u w = *(const v4u*)(PROJ + (row0 + L - 15 + j) * NPROJ + 2048 + c); UNPACK8(w, f);
                o = P->out + O_PPOOL + (size_t)((l * NBATCH + seq) * 15 + j) * 256 + c;
            }
        } else {
            const int r2 = r - 8448, j = r2 / 256, c = r2 % 256;
            const size_t row = row0 + L - 2 + j;
            const v4u wc = *(const v4u*)(PROJ + row * NPROJ + 2816 + c); const v4u wx = *(const v4u*)(PROJ + row * NPROJ + 2304 + c);
            float fc[8], fx[8]; UNPACK8(wc, fc); UNPACK8(wx, fx);
#pragma unroll
            for (int e = 0; e < 8; ++e) f[e] = fc[e] * fx[e];
            o = smp ? P->out + O_SSCONV + (size_t)((l * DBATCH + sb) * 2 + j) * 256 + c : P->out + O_PSCONV + (size_t)((l * NBATCH + seq) * 2 + j) * 256 + c;
        }
        *(f32x4*)o = (f32x4){f[0], f[1], f[2], f[3]}; *(f32x4*)(o + 4) = (f32x4){f[4], f[5], f[6], f[7]};
    }
}

__device__ __forceinline__ void p4b(KP P, int l, int hf, int start, int stride) {
    bf16* GU = (bf16*)(P->ws + WS_GU); bf16* HALO = (bf16*)(P->ws + WS_HALO);
    const float* cw = P->in[19] + (size_t)(l * 3) * FF;
    const int r0 = hf * MH;
    for (int idx = start; idx < MH * 352; idx += stride) {
        const int lr = idx / 352, c0 = (idx % 352) * 8, m = r0 + lr;
        int t, sb = 0; bool smp;
        if (m < MP) { t = m & (SEQL - 1); smp = false; } else { sb = (m - MP) >> 3; t = (m - MP) & 7; smp = true; }
        float g0[8], g1[8], g2[8];
#pragma unroll
        for (int j = 0; j < 3; ++j) {
            const int tt = t - j; float f[8];
            if (tt < 0) {
                if (smp) { const float* sp = P->in[6] + (size_t)((l * DBATCH + sb) * 2 + 2 + tt) * FF + c0;
#pragma unroll
                    for (int e = 0; e < 8; ++e) f[e] = sp[e]; }
                else {
#pragma unroll
                    for (int e = 0; e < 8; ++e) f[e] = 0.f; }
            } else {
                const v4u w = (lr - j < 0) ? *(const v4u*)(HALO + (size_t)(2 + lr - j) * FF + c0) : *(const v4u*)(GU + (size_t)(lr - j) * NGU + c0);
                UNPACK8(w, f);
            }
#pragma unroll
            for (int e = 0; e < 8; ++e) { if (j == 0) g0[e] = f[e]; else if (j == 1) g1[e] = f[e]; else g2[e] = f[e]; }
        }
        const v4u wu = *(const v4u*)(GU + (size_t)lr * NGU + FF + c0); float fu[8]; UNPACK8(wu, fu);
        float a[8];
#pragma unroll
        for (int e = 0; e < 8; ++e) a[e] = siluf(cw[c0 + e] * g2[e] + cw[FF + c0 + e] * g1[e] + cw[2 * FF + c0 + e] * g0[e]) * fu[e];
        *(v4u*)(GU + (size_t)lr * NGU + FF + c0) = PACK8(a);
        if (!smp && t >= SEQL - 2) { float* o = P->out + O_PFFN + (size_t)((l * NBATCH + (m >> 11)) * 2 + t - (SEQL - 2)) * FF + c0;
#pragma unroll
            for (int e = 0; e < 8; ++e) o[e] = g0[e]; }
        if (smp && t >= 6) { float* o = P->out + O_SFFN + (size_t)((l * DBATCH + sb) * 2 + t - 6) * FF + c0;
#pragma unroll
            for (int e = 0; e < 8; ++e) o[e] = g0[e]; }
        if (hf == 0 && lr >= MH - 2) *(v4u*)(HALO + (size_t)(lr - (MH - 2)) * FF + c0) = *(const v4u*)(GU + (size_t)lr * NGU + c0);
    }
}

#define LAS __attribute__((address_space(3)))
#define XB_TMO      128
#define XB_XCNT(j)  (256  + 64 * (j))
#define XB_XSUB(j)  (1280 + 64 * (j))
#define XB_XGEN(j)  (2304 + 64 * (j))
#define XB_TOP      3328
#define XB_TOPGEN   3392
#define XCD_BAR_WORDS 3456
#define XB_SPIN_CAP (1u << 18)

__device__ __forceinline__ unsigned xb_ld(unsigned* p)              { return __hip_atomic_load(p, __ATOMIC_RELAXED, __HIP_MEMORY_SCOPE_AGENT); }
__device__ __forceinline__ unsigned xb_add(unsigned* p, unsigned v) { return __hip_atomic_fetch_add(p, v, __ATOMIC_RELAXED, __HIP_MEMORY_SCOPE_AGENT); }
__device__ __forceinline__ unsigned xb_xcc_id() { return (unsigned)__builtin_amdgcn_s_getreg((3 << 11) | 20) & 0xFu; }
#define XB_SPIN(cond, bar) do { unsigned _sp = 0; while (cond) { __builtin_amdgcn_s_sleep(1); \
    if ((++_sp & 255u) == 0u) { if (xb_ld(&(bar)[XB_TMO])) break; if (_sp > XB_SPIN_CAP) { atomicAdd(&(bar)[XB_TMO], 1u); break; } } } } while (0)

struct XcdBarrier {
    unsigned* bar; unsigned x;
    volatile LAS unsigned* st;
    int wave;
};

__device__ __forceinline__ XcdBarrier xcd_barrier_post(unsigned* bar, volatile LAS unsigned* st) {
    XcdBarrier b; b.bar = bar; b.x = xb_xcc_id(); b.st = st; b.wave = 0;
    if (threadIdx.x == 0) (void)xb_add(&bar[XB_XCNT(b.x)], 1u);
    return b;
}
__device__ __forceinline__ void xcd_barrier_complete(unsigned* bar, unsigned x, unsigned& nloc, unsigned& nx) {
    const unsigned G = gridDim.x * gridDim.y * gridDim.z;
    unsigned sum, cnt, mine, sp = 0u;
    for (;;) {
        sum = 0u; cnt = 0u; mine = 0u;
#pragma unroll
        for (unsigned j = 0; j < 16; ++j) { const unsigned c = xb_ld(&bar[XB_XCNT(j)]); sum += c; cnt += (c > 0u) ? 1u : 0u; mine = (j == x) ? c : mine; }
        if (sum == G) break;
        __builtin_amdgcn_s_sleep(1);
        if ((++sp & 255u) == 0u) { if (xb_ld(&bar[XB_TMO])) break; if (sp > XB_SPIN_CAP) { atomicAdd(&bar[XB_TMO], 1u); break; } }
    }
    nloc = mine > 0u ? mine : 1u; nx = cnt > 0u ? cnt : 1u;
}

__device__ __forceinline__ void xcd_barrier(const XcdBarrier& b) {
    asm volatile("s_waitcnt vmcnt(0)" ::: "memory");
    __syncthreads();
    if (b.wave == 0 && lane_id() == 0) {
        unsigned* bar = b.bar;
        __builtin_amdgcn_s_waitcnt(0);
        unsigned nloc = b.st[0], nx = b.st[1];
        if (nloc == 0u) { xcd_barrier_complete(bar, b.x, nloc, nx); b.st[0] = nloc; b.st[1] = nx; }
        const unsigned old = xb_add(&bar[XB_XSUB(b.x)], 1u);
        const unsigned gen = old / nloc;
        if (old + 1u == (gen + 1u) * nloc) {
            __builtin_amdgcn_fence(__ATOMIC_RELEASE, "agent");
            asm volatile("s_waitcnt vmcnt(0)" ::: "memory");
            const unsigned og = xb_add(&bar[XB_TOP], 1u);
            const unsigned tg = og / nx;
            if (og + 1u == (tg + 1u) * nx) xb_add(&bar[XB_TOPGEN], 1u);
            else XB_SPIN(xb_ld(&bar[XB_TOPGEN]) == tg, bar);
            __builtin_amdgcn_fence(__ATOMIC_ACQUIRE, "agent");
            xb_add(&bar[XB_XGEN(b.x)], 1u);
            asm volatile("s_waitcnt vmcnt(0)" ::: "memory");
        } else {
            XB_SPIN(xb_ld(&bar[XB_XGEN(b.x)]) == gen, bar);
            __builtin_amdgcn_fence(__ATOMIC_ACQUIRE, "agent");
            asm volatile("s_waitcnt vmcnt(0)" ::: "memory");
        }
    }
    __syncthreads();
}

#define XSYNC1() do { XcdBarrier b_; b_.bar = (unsigned*)(kparams()->ws + WS_BAR); b_.x = xb_xcc_id(); b_.st = (volatile LAS unsigned*)((LAS unsigned char*)lds + (LDS_BYTES - 64)); b_.wave = wave; xcd_barrier(b_); } while (0)
#ifdef PROBE_SYNC2
#define GSYNC() do { XSYNC1(); XSYNC1(); } while (0)
#else
#define GSYNC() XSYNC1()
#endif
__global__ void __launch_bounds__(NTHREADS, 2) fwd_megakernel(Params Parg) {
    KP P = kparams();
    extern __shared__ __attribute__((aligned(16))) unsigned char lds[];
    cg::grid_group grid = cg::this_grid();
    const int wave = __builtin_amdgcn_readfirstlane((int)threadIdx.x >> 6);
    const int tid = fresh_tid(wave), lane = tid & 63;
    const int G = gridDim.x, bx = blockIdx.x;
    const int gw = bx * NWAVES + wave, ngw = G * NWAVES;
    const int gt = bx * NTHREADS + tid, ngt = G * NTHREADS;
    unsigned char* ws = P->ws;
    bf16* XA = (bf16*)(ws + WS_XA); bf16* XB2 = (bf16*)(ws + WS_PROJ); bf16* PROJ = (bf16*)(ws + WS_PROJ); bf16* GU = (bf16*)(ws + WS_GU);
    float* SSQ = (float*)(ws + WS_SSQ); float* GB = (float*)(ws + WS_GB); float* WAB = (float*)(ws + WS_WAB);
    float* XRES = P->out;
    float* wscr = (float*)(lds + wave * 16384);
    volatile LAS unsigned* xst = (volatile LAS unsigned*)((LAS unsigned char*)lds + (LDS_BYTES - 64));
    if (tid < 16) xst[tid] = 0u;
    __syncthreads();
    (void)xcd_barrier_post((unsigned*)(ws + WS_BAR), xst);

    for (int i = gt; i < 4 * M; i += ngt) SSQ[M + i] = 0.f;
    for (int i = gt; i < MS * D / 4; i += ngt) ((f32x4*)(XRES + (size_t)MP * D))[i] = ((const f32x4*)P->in[1])[i];
    for (int i = gt; i < 2 * 8 * D; i += ngt) { const int l = i >> 13, j = (i >> 10) & 7, k = i & 1023; WAB[i] = P->in[7][l * D + k] * P->in[8][(size_t)l * D * DIN + (size_t)k * DIN + 2048 + j]; }
    convert_win(P, 0, wscr, gw, ngw, lane);
    convert_layer_rest(P, 0, wscr, gw, ngw, lane);
    convert_layer_rest(P, 1, wscr, gw, ngw, lane);
    for (int m0 = gw; m0 < M; m0 += 2 * ngw) {
        f32x4 v[2][4];
#pragma unroll
        for (int q = 0; q < 2; ++q) { const int m = m0 + q * ngw;
            const float* xr = m < MP ? P->in[0] + (size_t)m * D : P->in[1] + (size_t)((m < M ? m : M - 1) - MP) * D;
#pragma unroll
            for (int j = 0; j < 4; ++j) v[q][j] = ((const f32x4*)xr)[lane + 64 * j]; }
#pragma unroll
        for (int q = 0; q < 2; ++q) { const int m = m0 + q * ngw;
            if (m < M) {
                float ss = 0.f;
#pragma unroll
                for (int j = 0; j < 4; ++j) { const f32x4 w4 = v[q][j]; ss += w4[0] * w4[0] + w4[1] * w4[1] + w4[2] * w4[2] + w4[3] * w4[3];
                    ((v2u*)(XA + (size_t)m * D))[lane + 64 * j] = (v2u){pk2(w4[0], w4[1]), pk2(w4[2], w4[3])}; }
                ss = wave_sum(ss);
                if (lane == 0) SSQ[m] = ss;
            } }
    }
    if (ws == nullptr) grid.sync();
    GSYNC();

#pragma unroll 1
    for (int l = 0; l < 2; ++l) {
#ifndef NO_P1
        {
            const bf16* gA = XA; const bf16* gB = (const bf16*)(ws + WS_WIN); LAUNDER(gA); LAUNDER(gB);
            pg8::Gemm g{gA, gB, M, NPROJ, D, D, D}; pg8::StaticOrder S; S.init(M, NPROJ, G, bx);
            EpiScale E{PROJ, NPROJ, SSQ + (size_t)(2 * l) * M};
            pg8::gemm_phase<EpiScale, pg8::StaticOrder, true, true>((PG8_LAS unsigned char*)lds, g, S, E, wave);
#ifdef PROBE_P1X2
            __syncthreads();
            pg8::gemm_phase<EpiScale, pg8::StaticOrder, true, true>((PG8_LAS unsigned char*)lds, g, S, E, wave);
#endif
        }
#endif
#ifndef NO_AB
        {
            const float* ssq = SSQ + (size_t)(2 * l) * M;
            const int tf = fresh_tid(wave), lane = tf & 63, gw = bx * NWAVES + __builtin_amdgcn_readfirstlane(tf >> 6);
            for (int m0 = gw; m0 < M; m0 += 2 * ngw) {
                v4u xq[2][2]; float sqv[2];
#pragma unroll
                for (int q = 0; q < 2; ++q) { const int m = (m0 + q * ngw) < M ? (m0 + q * ngw) : (M - 1);
                    const v4u* xr = (const v4u*)(XA + (size_t)m * D) + lane * 2; xq[q][0] = xr[0]; xq[q][1] = xr[1]; sqv[q] = ssq[m]; }
#pragma unroll
                for (int q = 0; q < 2; ++q) {
                    const int m = m0 + q * ngw;
                    float xf[16]; UNPACK8(xq[q][0], xf); UNPACK8(xq[q][1], xf + 8);
                    float dot[8];
#pragma unroll
                    for (int j = 0; j < 8; ++j) { const float* wp = WAB + (size_t)(l * 8 + j) * D + lane * 16; float s2 = 0.f;
#pragma unroll
                        for (int e = 0; e < 16; ++e) s2 += wp[e] * xf[e];
                        dot[j] = wave_sum(s2); }
                    float v = dot[0];
#pragma unroll
                    for (int j = 1; j < 8; ++j) v = (lane == j) ? dot[j] : v;
                    if (lane < 8 && m < M) {
                        v *= rsqrtf(sqv[q] * (1.f / D) + EPS);
                        const int hh = lane & 3; float r;
                        if (lane < 4) { const float xx = v + P->in[11][l * 4 + hh]; const float sp = fmaxf(xx, 0.f) + __logf(1.f + __expf(-fabsf(xx))); r = -__expf(P->in[10][l * 4 + hh]) * sp; }
                        else r = __builtin_amdgcn_rcpf(1.f + __expf(-v));
                        GB[(size_t)m * 8 + lane] = r;
                    }
                }
            }
        }
#endif
        GSYNC();
#ifndef NO_P2B
        { const int tf = fresh_tid(wave); for (int item = bx; item < 1024; item += G) p2b_item(P, l, item, lds, wave); }
#ifdef PROBE_P2B2
        __syncthreads(); { const int tf = fresh_tid(wave); for (int item = bx; item < 1024; item += G) p2b_item(P, l, item, lds, wave); }
#endif
#endif
        GSYNC();
#ifdef PROBE_SCAN2
        if (bx < 64) { scan_wg(P, l, bx, lds, fresh_tid(wave)); }
#endif
#ifndef NO_SCAN
        if (bx < 64) scan_wg(P, l, bx, lds, fresh_tid(wave));
        else
#endif
        {
            const int vw = bx - 64, nm = G - 64; const int tid = fresh_tid(wave);
#ifndef NO_SAMPLE
            for (int it = nm - 1 - vw; it < 128; it += nm) sample_delta(P, l, it, lds, wave);
#endif
            for (int i = tid; i < 16384; i += NTHREADS) { const int e = i & 63, c = (i >> 6) & 63, g = i >> 12; ((bf16*)(lds + PL_PW))[(g * 64 + e) * 72 + c] = (bf16)f2bf(P->in[13][(size_t)l * 16384 + i]); }
            __syncthreads();
#ifndef NO_POOL
            for (int tile = vw; tile < 272; tile += nm) pool_tile(P, l, tile, lds, wave);
#endif
            state_copies(P, l, vw * NTHREADS + tid, nm * NTHREADS);
#ifdef PROBE_MISC2
            __syncthreads();
#ifndef NO_SAMPLE
            for (int it = nm - 1 - vw; it < 128; it += nm) sample_delta(P, l, it, lds, wave);
#endif
            for (int i = tid; i < 16384; i += NTHREADS) { const int e = i & 63, c = (i >> 6) & 63, g = i >> 12; ((bf16*)(lds + PL_PW))[(g * 64 + e) * 72 + c] = (bf16)f2bf(P->in[13][(size_t)l * 16384 + i]); }
            __syncthreads();
#ifndef NO_POOL
            for (int tile = vw; tile < 272; tile += nm) pool_tile(P, l, tile, lds, wave);
#endif
            state_copies(P, l, vw * NTHREADS + tid, nm * NTHREADS);
#endif
        }
        GSYNC();
        { const int tf = fresh_tid(wave); p2d(P, l, bx * NWAVES + __builtin_amdgcn_readfirstlane(tf >> 6), ngw, tf & 63); }
        GSYNC();
#ifdef PROBE_P2D2
        { const int tf = fresh_tid(wave); p2d(P, l, bx * NWAVES + __builtin_amdgcn_readfirstlane(tf >> 6), ngw, tf & 63); }
        GSYNC();
        { const int tf = fresh_tid(wave); p2d(P, l, bx * NWAVES + __builtin_amdgcn_readfirstlane(tf >> 6), ngw, tf & 63); }
        GSYNC();
        { const int tf = fresh_tid(wave); p2d(P, l, bx * NWAVES + __builtin_amdgcn_readfirstlane(tf >> 6), ngw, tf & 63); }
        GSYNC();
#endif
        {
            const bf16* gA = XA; const bf16* gB = (const bf16*)(ws + WS_WOUT) + (size_t)l * D * D; LAUNDER(gA); LAUNDER(gB);
            pg8::Gemm g{gA, gB, MP, D, D, D, D}; pg8::StaticOrder S; S.init(MP, D, G, bx);
            EpiResid E{l == 0 ? P->in[0] : XRES, l == 0 ? P->in[1] : XRES + (size_t)MP * D, XRES, XB2, SSQ + (size_t)(2 * l + 1) * M, 0};
            pg8::gemm_phase<EpiResid, pg8::StaticOrder, true, true>((PG8_LAS unsigned char*)lds, g, S, E, wave);
            const int ks = bx >> 4; const bf16* gA2 = XA + (size_t)MP * D + ks * 256; const bf16* gB2 = gB + ks * 256; LAUNDER(gA2); LAUNDER(gB2);
            pg8::Gemm g2{gA2, gB2, MS, D, 256, D, D}; SplitOrder S2{bx < 64 ? (bx & 15) : -1};
            EpiAtomic E2{(float*)(ws + WS_GU) + (size_t)ks * MS * D};
            pg8::gemm_phase<EpiAtomic, SplitOrder, true, true>((PG8_LAS unsigned char*)lds, g2, S2, E2, wave);
        }
        GSYNC();
        fin_sample(XRES + (size_t)MP * D, XB2 + (size_t)MP * D, SSQ + (size_t)(2 * l + 1) * M + MP, (const float*)(ws + WS_GU), 4, nullptr, 0, bx * NWAVES + wave, ngw, lane_id());
        GSYNC();
        {
            const bf16* gA = XB2; const bf16* gB = (const bf16*)(ws + WS_WGU) + (size_t)l * NGU * D; LAUNDER(gA); LAUNDER(gB);
            pg8::Gemm g{gA, gB, M, NGU, D, D, D}; pg8::StaticOrder S; S.init(M, NGU, G, bx);
            EpiGateUp E{GU, SSQ + (size_t)(2 * l + 1) * M, P->in[19] + (size_t)(l * 3) * FF, P->in[6] + (size_t)l * DBATCH * 2 * FF, (float*)(ws + WS_HAL), (float*)(ws + WS_FIXG), (float*)(ws + WS_FIXU),
                        P->out + O_PFFN + (size_t)l * NBATCH * 2 * FF, P->out + O_SFFN + (size_t)l * DBATCH * 2 * FF, lds};
            pg8::gemm_phase<EpiGateUp, pg8::StaticOrder, true, true>((PG8_LAS unsigned char*)lds, g, S, E, wave);
#ifdef PROBE_P4X2
            __syncthreads();
            pg8::gemm_phase<EpiGateUp, pg8::StaticOrder, true, true>((PG8_LAS unsigned char*)lds, g, S, E, wave);
#endif
        }
        GSYNC();
        p4_fixup(P, l, bx * NTHREADS + fresh_tid(wave), ngt);
        if (l == 0) { const int tf = fresh_tid(wave); convert_win(P, 1, (float*)(lds + wave * 16384), bx * NWAVES + wave, ngw, tf & 63); }
        GSYNC();
        {
            const bf16* gA = GU; const bf16* gB = (const bf16*)(ws + WS_WDN) + (size_t)l * D * FF; LAUNDER(gA); LAUNDER(gB);
            pg8::Gemm g{gA, gB, MP, D, FF, FF, FF}; pg8::StaticOrder S; S.init(MP, D, G, bx);
            EpiResid E{XRES, XRES + (size_t)MP * D, XRES, XA, SSQ + (size_t)(2 * l + 2) * M, 0};
            pg8::gemm_phase<EpiResid, pg8::StaticOrder, true, true>((PG8_LAS unsigned char*)lds, g, S, E, wave);
            const int ks = bx >> 4; const bf16* gA2 = GU + (size_t)MP * FF + ks * 256; const bf16* gB2 = gB + ks * 256; LAUNDER(gA2); LAUNDER(gB2);
            pg8::Gemm g2{gA2, gB2, MS, D, 256, FF, FF}; SplitOrder S2{bx < 176 ? (bx & 15) : -1};
            EpiAtomic E2{ks < 8 ? (float*)(ws + WS_PROJ) + (size_t)ks * MS * D : (float*)(ws + WS_PART2) + (size_t)(ks - 8) * MS * D};
            pg8::gemm_phase<EpiAtomic, SplitOrder, true, true>((PG8_LAS unsigned char*)lds, g2, S2, E2, wave);
        }
        GSYNC();
        fin_sample(XRES + (size_t)MP * D, XA + (size_t)MP * D, SSQ + (size_t)(2 * l + 2) * M + MP, (const float*)(ws + WS_PROJ), 8, (const float*)(ws + WS_PART2), 3, bx * NWAVES + wave, ngw, lane_id());
        GSYNC();
    }
    {
        const float* ssq = SSQ + (size_t)4 * M; const float* fn = P->in[22];
        const int gt = bx * NTHREADS + fresh_tid(wave);
        for (int i0 = gt; i0 < M * 256; i0 += 4 * ngt) {
            f32x4 v[4]; float sq[4];
#pragma unroll
            for (int q = 0; q < 4; ++q) { const int i = i0 + q * ngt; v[q] = (f32x4){0.f, 0.f, 0.f, 0.f}; sq[q] = 1.f;
                if (i < M * 256) { v[q] = ((const f32x4*)XRES)[i]; sq[q] = ssq[i >> 8]; } }
#pragma unroll
            for (int q = 0; q < 4; ++q) { const int i = i0 + q * ngt;
                if (i < M * 256) { const float rs = rsqrtf(sq[q] * (1.f / D) + EPS); const f32x4 gv = ((const f32x4*)fn)[i & 255];
                    f32x4 o = v[q]; o[0] *= rs * gv[0]; o[1] *= rs * gv[1]; o[2] *= rs * gv[2]; o[3] *= rs * gv[3];
                    ((f32x4*)XRES)[i] = o; } }
        }
    }
}

extern "C" void kernel_launch(void* const* d_in, const int* in_sizes, int n_in, void* d_out, int out_size, void* d_ws, size_t ws_size, hipStream_t stream) {
    static int grid = 0;
    if (grid == 0) {
        if (n_in != 23 || (size_t)out_size != O_TOTAL || ws_size < WS_END) { fprintf(stderr, "kernel_launch: unexpected shapes: n_in %d out %d ws %zu\n", n_in, out_size, ws_size); grid = -1; return; }
        int dev = 0, cus = 0, per_cu = 0;
        hipGetDevice(&dev); hipDeviceGetAttribute(&cus, hipDeviceAttributeMultiprocessorCount, dev);
        if (hipFuncSetAttribute((const void*)fwd_megakernel, hipFuncAttributeMaxDynamicSharedMemorySize, LDS_BYTES) != hipSuccess) { fprintf(stderr, "kernel_launch: hipFuncSetAttribute failed\n"); grid = -1; return; }
        hipOccupancyMaxActiveBlocksPerMultiprocessor(&per_cu, (const void*)fwd_megakernel, NTHREADS, LDS_BYTES);
        (void)hipGetLastError();
        if (per_cu < 1) fprintf(stderr, "kernel_launch: occupancy query reports %d blocks per CU\n", per_cu);
        grid = cus;
    }
    if (grid < 0) return;
    if (hipMemsetAsync((char*)d_ws + WS_BAR, 0, 16384, stream) != hipSuccess) { fprintf(stderr, "kernel_launch: memset failed\n"); return; }
    Params p{};
    for (int i = 0; i < 23; ++i) p.in[i] = (const float*)d_in[i];
    p.out = (float*)d_out; p.ws = (unsigned char*)d_ws;
    void* args[] = {&p};
    hipError_t e = hipLaunchCooperativeKernel((const void*)fwd_megakernel, dim3(grid), dim3(NTHREADS), args, LDS_BYTES, stream);
    if (e != hipSuccess) fprintf(stderr, "cooperative launch failed: %s (grid %d)\n", hipGetErrorString(e), grid);
}
```

```cpp
#include <hip/hip_runtime.h>
#include <hip/hip_cooperative_groups.h>
#include <cstdio>
#include <cstdint>
namespace cg = cooperative_groups;
__device__ __forceinline__ int lane_id() { int t; asm volatile("v_mbcnt_lo_u32_b32 %0, -1, 0\n\tv_mbcnt_hi_u32_b32 %0, -1, %0" : "=v"(t)); return t; }
__device__ __forceinline__ int fresh_tid(int wave) { return (wave << 6) | lane_id(); }
namespace pg8 {
#define PG8_LAS __attribute__((address_space(3)))
typedef unsigned short bf16_t;
typedef short bf16x8 __attribute__((ext_vector_type(8)));
typedef float f32x4 __attribute__((ext_vector_type(4)));
typedef unsigned u32x4 __attribute__((ext_vector_type(4)));
constexpr int BM = 256, BK = 64, HALF = 128, HTB = HALF * BK * 2  , STAGE_BYTES = 8 * HTB, NXCD = 8, WGM = 8;

__host__ __device__ __forceinline__ int lds_byte(int r, int c) { const int st = (r >> 4) * 2 + (c >> 5), rr = r & 15, cc = c & 31, ob = rr * 64 + cc * 2; return st * 1024 + (ob ^ (((ob >> 9) & 1) << 5)); }
__host__ __device__ __forceinline__ void stage_rc(int b, int& R, int& C) { const int st = b / 1024, sb = b % 1024, swz = sb ^ (((sb >> 9) & 1) << 5); R = (st >> 1) * 16 + swz / 64; C = (st & 1) * 32 + (swz % 64) / 2; }
__host__ __device__ __forceinline__ int perm32(int rho) { const int n = rho >> 4, i = rho & 15; return 8 * (i >> 2) + 4 * n + (i & 3); }

struct Unit { int pm, pn; };
struct Gemm { const bf16_t* A; const bf16_t* Bt; int M, N, K, lda, ldb; };

struct StaticOrder {
    int nM, nN, nwg, G, c;
    __host__ __device__ void init(int M, int N, int G_, int c_) { nM = M / BM; nN = N / BM; nwg = nM * nN; G = G_; c = c_; }
    __host__ __device__ bool next(int i, Unit& u) const {
        const long L = (long)i * G + c; if (L >= nwg) return false;
        int wgid = (int)L; { const int q = nwg / NXCD, r = nwg % NXCD, xcd = wgid % NXCD, off = wgid / NXCD; wgid = (xcd < r ? xcd * (q + 1) : r * (q + 1) + (xcd - r) * q) + off; }
        const int nig = WGM * nN, gid = wgid / nig, fm = gid * WGM, gsz = (nM - fm) < WGM ? (nM - fm) : WGM;
        u.pm = fm + ((wgid % nig) % gsz); u.pn = (wgid % nig) / gsz; return true;
    }
    __device__ __forceinline__ void a_ready(const Unit&) const {}
    __device__ __forceinline__ void done(const Unit&) const {}
};

template <class Epi, class Sched, bool ALIGN_EPI = false, bool SP2 = false>
__device__ __forceinline__ void gemm_phase(PG8_LAS unsigned char* lds, const Gemm g, const Sched& S, const Epi& E, const int wave_in) {
    const int tid = fresh_tid(wave_in), wid = __builtin_amdgcn_readfirstlane(tid >> 6), lane = tid & 63, wr = wid >> 2, wc = wid & 3, fr = lane & 15, fq = lane >> 4;
    const int K = g.K, nt = K / BK;
    unsigned voffA[2], voffB[2];
#pragma unroll
    for (int i = 0; i < 2; ++i) { int R, C; stage_rc(tid * 16 + i * 8192, R, C); const int Rb = Epi::PERM ? ((R & ~31) + perm32(R & 31)) : R;
        voffA[i] = (unsigned)(R * g.lda + C) * 2u; voffB[i] = (unsigned)(Rb * g.ldb + C) * 2u; }
    const size_t kstep = (size_t)(BK * 2);
    const size_t hstepA = (size_t)HALF * g.lda * 2, hstepB = (size_t)HALF * g.ldb * 2;
    const size_t tstepA = 2 * hstepA, tstepB = 2 * hstepB;
    const unsigned ldsw = (unsigned)wid * 1024u;
    const int aoff = lds_byte(wr * 64 + fr, fq * 8), boff = lds_byte(wc * 32 + fr, fq * 8);
#define PG8_SA(b, h) (((b) * 2 + (h)) * HTB)
#define PG8_SB(b, h) ((4 + (b) * 2 + (h)) * HTB)
#define PG8_STAGE(bufoff, gbase, voff) do { _Pragma("unroll") for (int _i = 0; _i < 2; ++_i) \
        __builtin_amdgcn_global_load_lds((const unsigned*)((const char*)(gbase) + (voff)[_i]), (PG8_LAS unsigned*)(lds + (bufoff) + ldsw + _i * 8192), 16, 0, 0); } while (0)
#define PG8_LDA(dst, b, h) do { _Pragma("unroll") for (int m = 0; m < 4; ++m) _Pragma("unroll") for (int k = 0; k < 2; ++k) dst[m][k] = *(const PG8_LAS bf16x8*)(lds + PG8_SA(b, h) + aoff + m * 2048 + k * 1024); } while (0)
#define PG8_LDB(dst, b, h) do { _Pragma("unroll") for (int n = 0; n < 2; ++n) _Pragma("unroll") for (int k = 0; k < 2; ++k) dst[n][k] = *(const PG8_LAS bf16x8*)(lds + PG8_SB(b, h) + boff + n * 2048 + k * 1024); } while (0)
#define PG8_MMA(ai, bj, At, Bt) do { __builtin_amdgcn_s_setprio(1); _Pragma("unroll") for (int m = 0; m < 4; ++m) _Pragma("unroll") for (int n = 0; n < 2; ++n) _Pragma("unroll") for (int k = 0; k < 2; ++k) \
        acc[ai][bj][m][n] = __builtin_amdgcn_mfma_f32_16x16x32_bf16(Bt[n][k], At[m][k], acc[ai][bj][m][n], 0, 0, 0); __builtin_amdgcn_s_setprio(0); } while (0)
#define PG8_WAIT_V(n) asm volatile("s_waitcnt vmcnt(" #n ")" ::: "memory")
#define PG8_WAIT_L(n) asm volatile("s_waitcnt lgkmcnt(" #n ")" ::: "memory")
#define PG8_BAR __builtin_amdgcn_s_barrier()
#define PG8_SCHED __builtin_amdgcn_sched_barrier(0)
    Unit cur, nxt; int ui = 0;
    if (!S.next(0, cur)) return;
    f32x4 acc[2][2][4][2];
#pragma unroll
    for (int a = 0; a < 2; ++a)
#pragma unroll
        for (int b = 0; b < 2; ++b)
#pragma unroll
            for (int m = 0; m < 4; ++m)
#pragma unroll
                for (int n = 0; n < 2; ++n) acc[a][b][m][n] = (f32x4){0.f, 0.f, 0.f, 0.f};
    bf16x8 At[4][2], B0[2][2], B1[2][2];
    const char* cA = (const char*)g.A + (size_t)cur.pm * tstepA; const char* cB = (const char*)g.Bt + (size_t)cur.pn * tstepB;
    S.a_ready(cur);
    if constexpr (SP2) {
        PG8_STAGE(PG8_SB(0, 0), cB, voffB); PG8_STAGE(PG8_SB(0, 1), cB + hstepB, voffB); PG8_STAGE(PG8_SA(0, 0), cA, voffA); PG8_STAGE(PG8_SA(0, 1), cA + hstepA, voffA);
        if (wr == 1) PG8_BAR;
        PG8_WAIT_V(2); PG8_BAR;
        PG8_STAGE(PG8_SB(1, 0), cB + kstep, voffB); PG8_STAGE(PG8_SA(1, 0), cA + kstep, voffA); PG8_STAGE(PG8_SB(1, 1), cB + hstepB + kstep, voffB);
        PG8_WAIT_V(6); PG8_BAR;
    } else {
        PG8_STAGE(PG8_SB(0, 0), cB, voffB); PG8_STAGE(PG8_SA(0, 0), cA, voffA); PG8_STAGE(PG8_SB(0, 1), cB + hstepB, voffB); PG8_STAGE(PG8_SA(0, 1), cA + hstepA, voffA);
        if (wr == 1) PG8_BAR;
        PG8_WAIT_V(4); PG8_BAR;
        PG8_STAGE(PG8_SB(1, 0), cB + kstep, voffB); PG8_STAGE(PG8_SA(1, 0), cA + kstep, voffA); PG8_STAGE(PG8_SB(1, 1), cB + hstepB + kstep, voffB);
        PG8_WAIT_V(6); PG8_BAR;
    }
    for (;;) {
        const bool has_next = S.next(ui + 1, nxt);
        const char* nA = has_next ? (const char*)g.A + (size_t)nxt.pm * tstepA : cA; const char* nB = has_next ? (const char*)g.Bt + (size_t)nxt.pn * tstepB : cB;
        for (int t = 0; t < nt; t += 2) {
            const bool last = (t == nt - 2);
            const char* a1 = cA + (size_t)(t + 1) * kstep;
            const char* a2 = last ? nA : cA + (size_t)(t + 2) * kstep; const char* b2 = last ? nB : cB + (size_t)(t + 2) * kstep;
            const char* a3 = a2 + kstep; const char* b3 = b2 + kstep;
            if (last && has_next) S.a_ready(nxt);
            if constexpr (SP2) {
            PG8_LDB(B0, 0, 0); PG8_LDB(B1, 0, 1); PG8_SCHED; PG8_LDA(At, 0, 0); PG8_STAGE(PG8_SA(1, 1), a1 + hstepA, voffA);
            PG8_WAIT_V(8); PG8_WAIT_L(0); PG8_BAR; PG8_MMA(0, 0, At, B0); PG8_MMA(0, 1, At, B1); PG8_BAR; PG8_SCHED;
            PG8_LDA(At, 0, 1); PG8_STAGE(PG8_SB(0, 0), b2, voffB); PG8_STAGE(PG8_SB(0, 1), b2 + hstepB, voffB); PG8_STAGE(PG8_SA(0, 0), a2, voffA);
            PG8_WAIT_V(8); PG8_WAIT_L(0); PG8_BAR; PG8_MMA(1, 0, At, B0); PG8_MMA(1, 1, At, B1); PG8_BAR; PG8_SCHED;
            PG8_LDB(B0, 1, 0); PG8_LDB(B1, 1, 1); PG8_SCHED; PG8_LDA(At, 1, 0); PG8_STAGE(PG8_SA(0, 1), a2 + hstepA, voffA);
            PG8_WAIT_V(8); PG8_WAIT_L(0); PG8_BAR; PG8_MMA(0, 0, At, B0); PG8_MMA(0, 1, At, B1); PG8_BAR; PG8_SCHED;
            PG8_LDA(At, 1, 1); PG8_STAGE(PG8_SB(1, 0), b3, voffB); PG8_STAGE(PG8_SB(1, 1), b3 + hstepB, voffB); PG8_STAGE(PG8_SA(1, 0), a3, voffA);
            PG8_WAIT_V(8); PG8_WAIT_L(0); PG8_BAR; PG8_MMA(1, 0, At, B0); PG8_MMA(1, 1, At, B1); PG8_BAR; PG8_SCHED;
            } else {
            PG8_LDB(B0, 0, 0); PG8_SCHED; PG8_LDA(At, 0, 0); PG8_STAGE(PG8_SA(1, 1), a1 + hstepA, voffA);
            PG8_WAIT_L(8); PG8_BAR; PG8_WAIT_L(0); PG8_MMA(0, 0, At, B0); PG8_BAR; PG8_SCHED;
            PG8_LDB(B1, 0, 1); PG8_STAGE(PG8_SB(0, 0), b2, voffB);
            PG8_BAR; PG8_WAIT_L(0); PG8_MMA(0, 1, At, B1); PG8_BAR;
            PG8_LDA(At, 0, 1); PG8_STAGE(PG8_SA(0, 0), a2, voffA);
            PG8_BAR; PG8_WAIT_L(0); PG8_MMA(1, 0, At, B0); PG8_BAR; PG8_SCHED;
            PG8_STAGE(PG8_SB(0, 1), b2 + hstepB, voffB);
            PG8_WAIT_V(6); PG8_BAR; PG8_MMA(1, 1, At, B1); PG8_BAR;
            PG8_LDB(B0, 1, 0); PG8_SCHED; PG8_LDA(At, 1, 0); PG8_STAGE(PG8_SA(0, 1), a2 + hstepA, voffA);
            PG8_WAIT_L(8); PG8_BAR; PG8_WAIT_L(0); PG8_MMA(0, 0, At, B0); PG8_BAR; PG8_SCHED;
            PG8_LDB(B1, 1, 1); PG8_STAGE(PG8_SB(1, 0), b3, voffB);
            PG8_BAR; PG8_WAIT_L(0); PG8_MMA(0, 1, At, B1); PG8_BAR;
            PG8_LDA(At, 1, 1); PG8_STAGE(PG8_SA(1, 0), a3, voffA);
            PG8_BAR; PG8_WAIT_L(0); PG8_MMA(1, 0, At, B0); PG8_BAR; PG8_SCHED;
            PG8_STAGE(PG8_SB(1, 1), b3 + hstepB, voffB);
            PG8_WAIT_V(6); PG8_BAR; PG8_MMA(1, 1, At, B1); PG8_BAR;
            }
        }
        if constexpr (ALIGN_EPI) { if (wr == 0) PG8_BAR; }
        if constexpr (!Epi::AFTER_DRAIN) { E(acc, cur, wr, wc, fr, fq); S.done(cur); }
        if (!has_next) break;
#pragma unroll
        for (int a = 0; a < 2; ++a)
#pragma unroll
            for (int b = 0; b < 2; ++b)
#pragma unroll
                for (int m = 0; m < 4; ++m)
#pragma unroll
                    for (int n = 0; n < 2; ++n) acc[a][b][m][n] = (f32x4){0.f, 0.f, 0.f, 0.f};
        cur = nxt; cA = nA; cB = nB; ++ui;
        if constexpr (ALIGN_EPI) { if (wr == 1) PG8_BAR; }
    }
    PG8_WAIT_V(0);
    if constexpr (!ALIGN_EPI) { if (wr == 0) PG8_BAR; }
    PG8_BAR;
    if constexpr (Epi::AFTER_DRAIN) { E.fused(acc, cur, wr, wc, fr, fq, lds, wid, lane); S.done(cur); }
#undef PG8_SA
#undef PG8_SB
#undef PG8_STAGE
#undef PG8_LDA
#undef PG8_LDB
#undef PG8_MMA
#undef PG8_WAIT_V
#undef PG8_WAIT_L
#undef PG8_BAR
#undef PG8_SCHED
}
}

typedef unsigned short bf16;
typedef unsigned v4u __attribute__((ext_vector_type(4)));
typedef unsigned v2u __attribute__((ext_vector_type(2)));
typedef float f32x4 __attribute__((ext_vector_type(4)));
typedef short bf16x8 __attribute__((ext_vector_type(8)));

constexpr int D = 1024, MP = 16384, MS = 1024, M = MP + MS, SEQL = 2048, NBATCH = 8, DBATCH = 128;
constexpr int NPROJ = 3072, FF = 2816, NGU = 5632, DIN = 3080, MH = M / 2;
constexpr float EPS = 1e-6f;
constexpr int NTHREADS = 512, NWAVES = 8;
constexpr int LDS_BYTES = 155648;
constexpr size_t MiB = 1u << 20;
constexpr size_t WS_WOUT = 0, WS_WGU = 4 * MiB, WS_WDN = 26 * MiB, WS_XA = 37 * MiB, WS_PROJ = 71 * MiB, WS_GU = 105 * MiB, WS_SCR = 173 * MiB, WS_WIN = 239 * MiB;
constexpr size_t WS_GB = 245 * MiB, WS_SSQ = 245 * MiB + 576 * 1024, WS_WAB = 246 * MiB, WS_GL = 246 * MiB + 64 * 1024, WS_HALO = 246 * MiB + 128 * 1024, WS_BAR = 246 * MiB + 192 * 1024, WS_PART2 = 200 * MiB, WS_HAL = 247 * MiB, WS_FIXG = 249 * MiB, WS_FIXU = 251 * MiB, WS_END = 253 * MiB;
constexpr int SCR_ITEM = 73728;
constexpr size_t O_PDELTA = 17825792, O_PDCONV = 18874368, O_PPOOL = 18948096, O_PSCONV = 19009536, O_PFFN = 19017728;
constexpr size_t O_SDELTA = 19107840, O_SDCONV = 35885056, O_SPOOL = 37064704, O_SSCONV = 38047744, O_SFFN = 38178816, O_TOTAL = 39620608;

struct Params { const float* in[23]; float* out; unsigned char* ws; };
typedef const __attribute__((address_space(4))) Params* KP;
__device__ __forceinline__ KP kparams() { KP p = (KP)__builtin_amdgcn_kernarg_segment_ptr(); asm volatile("" : "+s"(p)); return p; }

#define LAUNDER(p) asm volatile("" : "+s"(p))
#define LDS_WAIT() asm volatile("s_waitcnt lgkmcnt(0)" ::: "memory")
__device__ __forceinline__ unsigned f2bf(float f) { unsigned u = __builtin_bit_cast(unsigned, f); return (u + 0x7fffu + ((u >> 16) & 1u)) >> 16; }
__device__ __forceinline__ unsigned pk2(float lo, float hi) { return f2bf(lo) | (f2bf(hi) << 16); }
__device__ __forceinline__ float bflo(unsigned u) { return __builtin_bit_cast(float, u << 16); }
__device__ __forceinline__ float bfhi(unsigned u) { return __builtin_bit_cast(float, u & 0xffff0000u); }
__device__ __forceinline__ float bf1(bf16 h) { return __builtin_bit_cast(float, ((unsigned)h) << 16); }
__device__ __forceinline__ float siluf(float x) { return x * __builtin_amdgcn_rcpf(1.f + __expf(-x)); }
__device__ __forceinline__ float shx(float v, int m) { return __builtin_bit_cast(float, __builtin_amdgcn_ds_bpermute((lane_id() ^ m) << 2, __builtin_bit_cast(int, v))); }
__device__ __forceinline__ float rdl(float v, int l) { return __builtin_bit_cast(float, __builtin_amdgcn_readlane(__builtin_bit_cast(int, v), l)); }
template <int CTRL> __device__ __forceinline__ float dpp_mov(float v) { const int i = __builtin_bit_cast(int, v); return __builtin_bit_cast(float, __builtin_amdgcn_update_dpp(i, i, CTRL, 0xf, 0xf, false)); }
__device__ __forceinline__ float wave_sum(float v) {
    v += dpp_mov<0x128>(v); v += dpp_mov<0x124>(v); v += dpp_mov<0x122>(v); v += dpp_mov<0x121>(v);
    const int i = __builtin_bit_cast(int, v);
    return (__builtin_bit_cast(float, __builtin_amdgcn_readlane(i, 0)) + __builtin_bit_cast(float, __builtin_amdgcn_readlane(i, 16))) +
           (__builtin_bit_cast(float, __builtin_amdgcn_readlane(i, 32)) + __builtin_bit_cast(float, __builtin_amdgcn_readlane(i, 48)));
}
#define UNPACK8(W_, F_) do { (F_)[0] = bflo((W_).x); (F_)[1] = bfhi((W_).x); (F_)[2] = bflo((W_).y); (F_)[3] = bfhi((W_).y); (F_)[4] = bflo((W_).z); (F_)[5] = bfhi((W_).z); (F_)[6] = bflo((W_).w); (F_)[7] = bfhi((W_).w); } while (0)
#define PACK8(F_) ((v4u){pk2((F_)[0], (F_)[1]), pk2((F_)[2], (F_)[3]), pk2((F_)[4], (F_)[5]), pk2((F_)[6], (F_)[7])})

struct EpiScale {
    static constexpr bool PERM = true, AFTER_DRAIN = false;
    bf16* O; int ldc; const float* ssq;
    __device__ __forceinline__ void operator()(const pg8::f32x4 (&acc)[2][2][4][2], const pg8::Unit& u, int wr, int wc, int fr, int fq) const {
        const int row0 = u.pm * 256 + wr * 64 + fr, col0 = u.pn * 256 + wc * 32 + 8 * fq;
        float sq[2][4];
#pragma unroll
        for (int ai = 0; ai < 2; ++ai)
#pragma unroll
            for (int m = 0; m < 4; ++m) sq[ai][m] = ssq[row0 + ai * 128 + m * 16];
#pragma unroll
        for (int ai = 0; ai < 2; ++ai)
#pragma unroll
            for (int m = 0; m < 4; ++m) {
                const int row = row0 + ai * 128 + m * 16;
                const float rs = rsqrtf(sq[ai][m] * (1.f / D) + EPS);
                bf16* rowp = O + (size_t)row * ldc + col0;
#pragma unroll
                for (int bj = 0; bj < 2; ++bj) {
                    pg8::f32x4 v0 = acc[ai][bj][m][0] * rs, v1 = acc[ai][bj][m][1] * rs;
                    v4u w; w.x = pk2(v0[0], v0[1]); w.y = pk2(v0[2], v0[3]); w.z = pk2(v1[0], v1[1]); w.w = pk2(v1[2], v1[3]);
                    *(v4u*)(rowp + bj * 128) = w;
                }
            }
    }
};
struct EpiResid {
    static constexpr bool PERM = true, AFTER_DRAIN = false;
    const float* xa; const float* xb_; float* xres; bf16* xb16; float* ssq; int rowbase;
    __device__ __forceinline__ void operator()(const pg8::f32x4 (&acc)[2][2][4][2], const pg8::Unit& u, int wr, int wc, int fr, int fq) const {
        const int row0 = rowbase + u.pm * 256 + wr * 64 + fr, col0 = u.pn * 256 + wc * 32 + 8 * fq;
#pragma unroll
        for (int ai = 0; ai < 2; ++ai) {
            pg8::f32x4 xo4[4][4];
#pragma unroll
            for (int m = 0; m < 4; ++m) {
                const int row = row0 + ai * 128 + m * 16;
                const float* xo = (row < MP ? xa + (size_t)row * D : xb_ + (size_t)(row - MP) * D) + col0;
                xo4[m][0] = *(const pg8::f32x4*)xo; xo4[m][1] = *(const pg8::f32x4*)(xo + 4); xo4[m][2] = *(const pg8::f32x4*)(xo + 128); xo4[m][3] = *(const pg8::f32x4*)(xo + 132);
            }
#pragma unroll
            for (int m = 0; m < 4; ++m) {
                const int row = row0 + ai * 128 + m * 16;
                float* xr = xres + (size_t)row * D + col0;
                bf16* xh = xb16 + (size_t)row * D + col0;
                float ss = 0.f;
#pragma unroll
                for (int bj = 0; bj < 2; ++bj) {
                    pg8::f32x4 v0 = acc[ai][bj][m][0] + xo4[m][2 * bj], v1 = acc[ai][bj][m][1] + xo4[m][2 * bj + 1];
                    *(pg8::f32x4*)(xr + bj * 128) = v0; *(pg8::f32x4*)(xr + bj * 128 + 4) = v1;
                    v4u w; w.x = pk2(v0[0], v0[1]); w.y = pk2(v0[2], v0[3]); w.z = pk2(v1[0], v1[1]); w.w = pk2(v1[2], v1[3]);
                    *(v4u*)(xh + bj * 128) = w;
                    ss += v0[0] * v0[0] + v0[1] * v0[1] + v0[2] * v0[2] + v0[3] * v0[3] + v1[0] * v1[0] + v1[1] * v1[1] + v1[2] * v1[2] + v1[3] * v1[3];
                }
                ss += shx(ss, 16); ss += shx(ss, 32);
                if (fq == 0) atomicAdd(ssq + row, ss);
            }
        }
    }
};


struct SplitOrder {
    int unit;
    __device__ __forceinline__ bool next(int i, pg8::Unit& u) const { if (i != 0 || unit < 0) return false; u.pm = unit >> 2; u.pn = unit & 3; return true; }
    __device__ __forceinline__ void a_ready(const pg8::Unit&) const {}
    __device__ __forceinline__ void done(const pg8::Unit&) const {}
};
struct EpiAtomic {
    static constexpr bool PERM = true, AFTER_DRAIN = false;
    float* X;
    __device__ __forceinline__ void operator()(const pg8::f32x4 (&acc)[2][2][4][2], const pg8::Unit& u, int wr, int wc, int fr, int fq) const {
        const int row0 = u.pm * 256 + wr * 64 + fr, col0 = u.pn * 256 + wc * 32 + 8 * fq;
#pragma unroll
        for (int ai = 0; ai < 2; ++ai)
#pragma unroll
            for (int m = 0; m < 4; ++m) {
                float* xr = X + (size_t)(row0 + ai * 128 + m * 16) * D + col0;
#pragma unroll
                for (int bj = 0; bj < 2; ++bj) { *(pg8::f32x4*)(xr + bj * 128) = acc[ai][bj][m][0]; *(pg8::f32x4*)(xr + bj * 128 + 4) = acc[ai][bj][m][1]; }
            }
    }
};
__device__ __forceinline__ void fin_sample(float* X, bf16* XB, float* ssq, const float* partA, int nA, const float* partB, int nB, int gw, int ngw, int lane) {
    for (int r = gw; r < MS; r += ngw) {
        f32x4 v[4];
#pragma unroll
        for (int j = 0; j < 4; ++j) v[j] = ((const f32x4*)(X + (size_t)r * D))[lane + 64 * j];
        for (int k = 0; k < nA; ++k) {
#pragma unroll
            for (int j = 0; j < 4; ++j) v[j] += ((const f32x4*)(partA + ((size_t)k * MS + r) * D))[lane + 64 * j];
        }
        for (int k = 0; k < nB; ++k) {
#pragma unroll
            for (int j = 0; j < 4; ++j) v[j] += ((const f32x4*)(partB + ((size_t)k * MS + r) * D))[lane + 64 * j];
        }
        float ss = 0.f;
#pragma unroll
        for (int j = 0; j < 4; ++j) { ss += v[j][0] * v[j][0] + v[j][1] * v[j][1] + v[j][2] * v[j][2] + v[j][3] * v[j][3];
            ((f32x4*)(X + (size_t)r * D))[lane + 64 * j] = v[j];
            ((v2u*)(XB + (size_t)r * D))[lane + 64 * j] = (v2u){pk2(v[j][0], v[j][1]), pk2(v[j][2], v[j][3])}; }
        ss = wave_sum(ss);
        if (lane == 0) ssq[r] = ss;
    }
}

constexpr int EPI_HALO_OFF = 131072;
__device__ __forceinline__ float dpp_f(float oldv, float src, const int ctrl_sel) {
    const int o = __builtin_bit_cast(int, oldv), v = __builtin_bit_cast(int, src); int r;
    if (ctrl_sel == 0) r = __builtin_amdgcn_update_dpp(o, v, 0x111, 0xf, 0xf, false);
    else if (ctrl_sel == 1) r = __builtin_amdgcn_update_dpp(o, v, 0x112, 0xf, 0xf, false);
    else if (ctrl_sel == 2) r = __builtin_amdgcn_update_dpp(o, v, 0x121, 0xf, 0xf, false);
    else r = __builtin_amdgcn_update_dpp(o, v, 0x122, 0xf, 0xf, false);
    return __builtin_bit_cast(float, r);
}
struct EpiGateUp {
    static constexpr bool PERM = true, AFTER_DRAIN = false;
    bf16* ACT; const float* ssq; const float* cw; const float* st; float* HAL; float* FIXG; float* FIXU; float* pffn; float* sffn; unsigned char* lds;
    __device__ __forceinline__ void operator()(const pg8::f32x4 (&acc)[2][2][4][2], const pg8::Unit& u, int wr, int wc, int fr, int fq) const {
        const int pm = u.pm, ch0 = u.pn * 128 + wc * 32 + 8 * fq, row0 = pm * 256 + wr * 64 + fr;
        const bool smp = pm >= 64;
        float* halo = (float*)(lds + EPI_HALO_OFF);
#pragma unroll
        for (int ai = 0; ai < 2; ++ai) {
            const float rs = rsqrtf(ssq[row0 + ai * 128 + 48] * (1.f / D) + EPS);
            if (fr >= 14) {
                float* hp = halo + ((ai * 2 + wr) * 2 + (fr - 14)) * 128 + wc * 32 + 8 * fq;
                *(pg8::f32x4*)hp = acc[ai][0][3][0] * rs; *(pg8::f32x4*)(hp + 4) = acc[ai][0][3][1] * rs;
            }
        }
        asm volatile("s_waitcnt lgkmcnt(0)" ::: "memory");
        __builtin_amdgcn_s_barrier();
        float w0[8], w1[8], w2[8];
#pragma unroll
        for (int e = 0; e < 8; ++e) { w0[e] = cw[ch0 + e]; w1[e] = cw[FF + ch0 + e]; w2[e] = cw[2 * FF + ch0 + e]; }
#pragma unroll
        for (int ai = 0; ai < 2; ++ai) {
            const int s = ai * 2 + wr;
            float prev[8];
#pragma unroll
            for (int e = 0; e < 8; ++e) prev[e] = 0.f;
            if (!smp && s >= 1 && fr >= 14) {
                const float* hp = halo + ((s - 1) * 2 + (fr - 14)) * 128 + wc * 32 + 8 * fq;
                const pg8::f32x4 h0 = *(const pg8::f32x4*)hp, h1 = *(const pg8::f32x4*)(hp + 4);
                prev[0] = h0[0]; prev[1] = h0[1]; prev[2] = h0[2]; prev[3] = h0[3]; prev[4] = h1[0]; prev[5] = h1[1]; prev[6] = h1[2]; prev[7] = h1[3];
            }
            float sq4[4];
#pragma unroll
            for (int m = 0; m < 4; ++m) sq4[m] = ssq[row0 + ai * 128 + m * 16];
#pragma unroll
            for (int m = 0; m < 4; ++m) {
                const int row = row0 + ai * 128 + m * 16;
                const float rs = rsqrtf(sq4[m] * (1.f / D) + EPS);
                float cur[8], upv[8], s0v[8], s1v[8];
#pragma unroll
                for (int e = 0; e < 8; ++e) { cur[e] = acc[ai][0][m][e >> 2][e & 3] * rs; upv[e] = acc[ai][1][m][e >> 2][e & 3] * rs; s0v[e] = 0.f; s1v[e] = 0.f; }
                const int t = fr & 7, sb = (row - MP) >> 3;
                if (smp && t < 2) {
                    const float* sp = st + (size_t)(sb * 2) * FF + ch0;
#pragma unroll
                    for (int e = 0; e < 8; ++e) { s0v[e] = sp[e]; s1v[e] = sp[FF + e]; }
                }
                float a[8];
#pragma unroll
                for (int e = 0; e < 8; ++e) {
                    const float sh1 = dpp_f(cur[e], cur[e], 0), sh2 = dpp_f(cur[e], cur[e], 1), ro1 = dpp_f(prev[e], prev[e], 2), ro2 = dpp_f(prev[e], prev[e], 3);
                    float p1, p2;
                    if (smp) { p1 = t >= 1 ? sh1 : s1v[e]; p2 = t >= 2 ? sh2 : (t == 1 ? s1v[e] : s0v[e]); }
                    else { p1 = fr >= 1 ? sh1 : ro1; p2 = fr >= 2 ? sh2 : ro2; }
                    a[e] = siluf(w0[e] * p2 + w1[e] * p1 + w2[e] * cur[e]) * upv[e];
                }
                *(v4u*)(ACT + (size_t)row * FF + ch0) = PACK8(a);
                if (smp) {
                    if (t >= 6) { float* o = sffn + (size_t)(sb * 2 + t - 6) * FF + ch0;
                        *(pg8::f32x4*)o = (pg8::f32x4){cur[0], cur[1], cur[2], cur[3]}; *(pg8::f32x4*)(o + 4) = (pg8::f32x4){cur[4], cur[5], cur[6], cur[7]}; }
                } else {
                    if (s == 3 && m == 3 && fr >= 14) {
                        float* o = HAL + (size_t)(pm * 2 + fr - 14) * FF + ch0;
                        *(pg8::f32x4*)o = (pg8::f32x4){cur[0], cur[1], cur[2], cur[3]}; *(pg8::f32x4*)(o + 4) = (pg8::f32x4){cur[4], cur[5], cur[6], cur[7]};
                        if ((pm & 7) == 7) { float* o2 = pffn + (size_t)((pm >> 3) * 2 + fr - 14) * FF + ch0;
                            *(pg8::f32x4*)o2 = (pg8::f32x4){cur[0], cur[1], cur[2], cur[3]}; *(pg8::f32x4*)(o2 + 4) = (pg8::f32x4){cur[4], cur[5], cur[6], cur[7]}; }
                    }
                    if (s == 0 && m == 0 && fr < 2 && (pm & 7) != 0) {
                        float* o = FIXG + (size_t)(pm * 2 + fr) * FF + ch0; float* o2 = FIXU + (size_t)(pm * 2 + fr) * FF + ch0;
                        *(pg8::f32x4*)o = (pg8::f32x4){cur[0], cur[1], cur[2], cur[3]}; *(pg8::f32x4*)(o + 4) = (pg8::f32x4){cur[4], cur[5], cur[6], cur[7]};
                        *(pg8::f32x4*)o2 = (pg8::f32x4){upv[0], upv[1], upv[2], upv[3]}; *(pg8::f32x4*)(o2 + 4) = (pg8::f32x4){upv[4], upv[5], upv[6], upv[7]};
                    }
                }
#pragma unroll
                for (int e = 0; e < 8; ++e) prev[e] = cur[e];
            }
        }
    }
};
__device__ __forceinline__ void p4_fixup(KP P, int l, int start, int stride) {
    const float* HAL = (const float*)(P->ws + WS_HAL); const float* FIXG = (const float*)(P->ws + WS_FIXG); const float* FIXU = (const float*)(P->ws + WS_FIXU);
    bf16* ACT = (bf16*)(P->ws + WS_GU);
    const float* cw = P->in[19] + (size_t)(l * 3) * FF;
    for (int idx = start; idx < 56 * 2 * FF; idx += stride) {
        const int k = idx / (2 * FF), rem = idx % (2 * FF), rr = rem / FF, c = rem % FF;
        const int pm = (k / 7) * 8 + 1 + (k % 7);
        const float g0 = FIXG[(size_t)(pm * 2 + rr) * FF + c];
        const float g1 = rr == 0 ? HAL[(size_t)((pm - 1) * 2 + 1) * FF + c] : FIXG[(size_t)(pm * 2) * FF + c];
        const float g2 = rr == 0 ? HAL[(size_t)((pm - 1) * 2) * FF + c] : HAL[(size_t)((pm - 1) * 2 + 1) * FF + c];
        const float a = siluf(cw[c] * g2 + cw[FF + c] * g1 + cw[2 * FF + c] * g0) * FIXU[(size_t)(pm * 2 + rr) * FF + c];
        ACT[(size_t)(pm * 256 + rr) * FF + c] = (bf16)f2bf(a);
    }
}
__device__ __forceinline__ void transpose_item(const float* W, int K, int ldw, int src_col0, const float* g, bf16* WT, int dst_row0, float* scr, int kb, int lane) {
    const int k0 = 64 * kb;
    float wv[32];
#pragma unroll
    for (int i = 0; i < 32; ++i) wv[i] = W[(size_t)(k0 + 2 * i + (lane >> 5)) * ldw + src_col0 + (lane & 31)];
#pragma unroll
    for (int i = 0; i < 32; ++i) { const int kk = 2 * i + (lane >> 5); const float gs = g ? g[k0 + kk] : 1.f; scr[kk * 33 + (lane & 31)] = wv[i] * gs; }
    LDS_WAIT();
    const int c = lane & 7;
#pragma unroll
    for (int j = 0; j < 4; ++j) { const int n = (lane >> 3) + 8 * j; const float* s = scr + (8 * c) * 33 + n;
        v4u o; o.x = pk2(s[0 * 33], s[1 * 33]); o.y = pk2(s[2 * 33], s[3 * 33]); o.z = pk2(s[4 * 33], s[5 * 33]); o.w = pk2(s[6 * 33], s[7 * 33]);
        *(v4u*)(WT + (size_t)(dst_row0 + n) * K + k0 + 8 * c) = o; }
    LDS_WAIT();
}
__device__ __forceinline__ void convert_matrix(const float* W, int K, int N, int ldw, int skip_from, int skip, const float* g, bf16* WT, int dst_row0, float* scr, int gw, int ngw, int lane, int il = 0) {
    const int nnb = N / 32, nit = (K / 64) * nnb;
    for (int it = gw; it < nit; it += ngw) {
        const int kb = it / nnb, nb = it % nnb, n0 = nb * 32;
        const int drow = il ? ((n0 >> 7) * 256 + (n0 & 127) + (il == 2 ? 128 : 0)) : n0;
        transpose_item(W, K, ldw, n0 + (n0 >= skip_from ? skip : 0), g, WT, dst_row0 + drow, scr, kb, lane);
    }
}
__device__ __forceinline__ void convert_layer_rest(KP P, int l, float* scr, int gw, int ngw, int lane) {
    unsigned char* ws = P->ws;
    convert_matrix(P->in[16] + (size_t)l * D * D, D, D, D, 1 << 30, 0, nullptr, (bf16*)(ws + WS_WOUT) + (size_t)l * D * D, 0, scr, gw, ngw, lane);
    convert_matrix(P->in[18] + (size_t)l * D * FF, D, FF, FF, 1 << 30, 0, P->in[17] + l * D, (bf16*)(ws + WS_WGU) + (size_t)l * NGU * D, 0, scr, gw, ngw, lane, 1);
    convert_matrix(P->in[20] + (size_t)l * D * FF, D, FF, FF, 1 << 30, 0, P->in[17] + l * D, (bf16*)(ws + WS_WGU) + (size_t)l * NGU * D, 0, scr, gw, ngw, lane, 2);
    convert_matrix(P->in[21] + (size_t)l * FF * D, FF, D, D, 1 << 30, 0, nullptr, (bf16*)(ws + WS_WDN) + (size_t)l * D * FF, 0, scr, gw, ngw, lane);
}
__device__ __forceinline__ void convert_win(KP P, int l, float* scr, int gw, int ngw, int lane) {
    convert_matrix(P->in[8] + (size_t)l * D * DIN, D, NPROJ, DIN, 2048, 8, P->in[7] + l * D, (bf16*)(P->ws + WS_WIN), 0, scr, gw, ngw, lane);
}

constexpr int B_QF = 0, B_KF = 33792, B_VF = 67584, B_AT = 101376, B_GC = 118784, B_QKS = 120320, B_WST = 128512;
__device__ __forceinline__ void p2b_item(KP P, int l, int item, unsigned char* lds, int wave_in) {
    const int tid = fresh_tid(wave_in);
    const int h = item & 3, n = (item >> 2) & 31, b = item >> 7;
    const int lane = tid & 63, wv = __builtin_amdgcn_readfirstlane(tid >> 6), fr = lane & 15, fq = lane >> 4;
    float* QF = (float*)(lds + B_QF); float* KF = (float*)(lds + B_KF); float* VF = (float*)(lds + B_VF); float* AT = (float*)(lds + B_AT);
    float* Gs = (float*)(lds + B_GC); float* BETA = Gs + 64; float* GC = Gs + 128; float* EG = Gs + 192; float* EKD = Gs + 256;
    bf16* QKS = (bf16*)(lds + B_QKS); bf16* WST = (bf16*)(lds + B_WST);
    const bf16* PROJ = (const bf16*)(P->ws + WS_PROJ);
    const float* GB = (const float*)(P->ws + WS_GB);
    unsigned char* scr = P->ws + WS_SCR + (size_t)item * SCR_ITEM;
    if (tid < 384) {
        const int chunk = tid % 48, tg = tid / 48, part = chunk >> 4, cc = chunk & 15;
        const int col = part * 512 + h * 128 + cc * 8;
        const float* cw = P->in[9] + (size_t)(l * 4) * 1536 + col;
        float w0[8], w1[8], w2[8], w3[8];
#pragma unroll
        for (int e = 0; e < 8; ++e) { w0[e] = cw[e]; w1[e] = cw[1536 + e]; w2[e] = cw[2 * 1536 + e]; w3[e] = cw[3 * 1536 + e]; }
        const int t0 = n * 64 + tg * 8;
        const bf16* base = PROJ + (size_t)(b * SEQL) * NPROJ + col;
        float r0[8], r1[8], r2[8], r3[8];
#pragma unroll
        for (int e = 0; e < 8; ++e) { r0[e] = 0.f; r1[e] = 0.f; r2[e] = 0.f; }
        if (t0 - 3 >= 0) { const v4u w = *(const v4u*)(base + (size_t)(t0 - 3) * NPROJ); UNPACK8(w, r0); }
        if (t0 - 2 >= 0) { const v4u w = *(const v4u*)(base + (size_t)(t0 - 2) * NPROJ); UNPACK8(w, r1); }
        if (t0 - 1 >= 0) { const v4u w = *(const v4u*)(base + (size_t)(t0 - 1) * NPROJ); UNPACK8(w, r2); }
        float* dst = (float*)(lds + part * 33792) + cc * 8;
#pragma unroll
        for (int i = 0; i < 8; ++i) {
            const v4u w = *(const v4u*)(base + (size_t)(t0 + i) * NPROJ); UNPACK8(w, r3);
            float s[8];
#pragma unroll
            for (int e = 0; e < 8; ++e) { const float cv = w0[e] * r0[e] + w1[e] * r1[e] + w2[e] * r2[e] + w3[e] * r3[e]; s[e] = siluf(cv); }
            float* d = dst + (tg * 8 + i) * 132;
            *(f32x4*)d = (f32x4){s[0], s[1], s[2], s[3]}; *(f32x4*)(d + 4) = (f32x4){s[4], s[5], s[6], s[7]};
#pragma unroll
            for (int e = 0; e < 8; ++e) { r0[e] = r1[e]; r1[e] = r2[e]; r2[e] = r3[e]; }
        }
    }
    if (tid < 64) { const int row = b * SEQL + n * 64 + tid; Gs[tid] = GB[(size_t)row * 8 + h]; BETA[tid] = GB[(size_t)row * 8 + 4 + h]; }
    __syncthreads();
    {
        const int tok = tid >> 3, sub = tid & 7;
        float* qr = QF + tok * 132 + sub * 16; float* kr = KF + tok * 132 + sub * 16;
        float qv[16], kv[16]; float sq = 0.f, sk = 0.f;
#pragma unroll
        for (int e = 0; e < 16; ++e) { qv[e] = qr[e]; kv[e] = kr[e]; sq += qv[e] * qv[e]; sk += kv[e] * kv[e]; }
        sq += shx(sq, 1); sq += shx(sq, 2); sq += shx(sq, 4);
        sk += shx(sk, 1); sk += shx(sk, 2); sk += shx(sk, 4);
        const float rq = rsqrtf(sq + EPS) * 0.08838834764831845f, rk = rsqrtf(sk + EPS);
#pragma unroll
        for (int e = 0; e < 16; ++e) { qr[e] = qv[e] * rq; kr[e] = kv[e] * rk; }
    }
    if (tid < 64) {
        float v = Gs[tid];
#pragma unroll
        for (int o = 1; o < 64; o <<= 1) { const int src = tid >= o ? tid - o : tid; const float t = __builtin_bit_cast(float, __builtin_amdgcn_ds_bpermute(src << 2, __builtin_bit_cast(int, v))); if (tid >= o) v += t; }
        const float tot = rdl(v, 63);
        GC[tid] = v; EG[tid] = __expf(v); EKD[tid] = __expf(tot - v);
        if (tid == 0) ((float*)(P->ws + WS_GL))[item] = __expf(tot);
    }
    __syncthreads();
    {
        const int p = wv >> 2, mt = wv & 3;
        const float* X = p ? QF : KF;
        f32x4 acc[4];
#pragma unroll
        for (int nt = 0; nt < 4; ++nt) acc[nt] = (f32x4){0.f, 0.f, 0.f, 0.f};
        const float* xa = X + (mt * 16 + fr) * 132 + fq; const float* kb_ = KF + fr * 132 + fq;
#pragma unroll 8
        for (int k = 0; k < 128; k += 4) {
            const float a = xa[k];
#pragma unroll
            for (int nt = 0; nt < 4; ++nt) acc[nt] = __builtin_amdgcn_mfma_f32_16x16x4f32(a, kb_[nt * 16 * 132 + k], acc[nt], 0, 0, 0);
        }
#pragma unroll
        for (int nt = 0; nt < 4; ++nt) {
            const int j = nt * 16 + fr; const float gj = GC[j];
            float v[4];
#pragma unroll
            for (int r = 0; r < 4; ++r) {
                const int i = mt * 16 + 4 * fq + r;
                if (p == 0) v[r] = (i > j) ? BETA[i] * acc[nt][r] * __expf(GC[i] - gj) : 0.f;
                else        v[r] = (i >= j) ? acc[nt][r] * __expf(GC[i] - gj) : 0.f;
            }
            if (p == 0) *(f32x4*)(AT + j * 68 + mt * 16 + 4 * fq) = (f32x4){v[0], v[1], v[2], v[3]};
            else {
#pragma unroll
                for (int r = 0; r < 4; ++r) QKS[(mt * 16 + 4 * fq + r) * 64 + j] = (bf16)f2bf(v[r]);
            }
        }
    }
    __syncthreads();
    const int tid4 = fresh_tid(wave_in);
    if (tid4 < 256) {
        float x[64];
        int zo = 0; asm volatile("" : "+v"(zo));
        const float* ATz = AT + zo; const float* BETAz = BETA + zo; const float* EGz = EG + zo;
        if (tid4 < 128) {
#pragma unroll
            for (int i = 0; i < 64; ++i) x[i] = BETAz[i] * VF[i * 132 + tid4];
        } else {
#pragma unroll
            for (int i = 0; i < 64; ++i) x[i] = BETAz[i] * EGz[i] * KF[i * 132 + tid4 - 128];
        }
        f32x4 ab[16];
#pragma unroll
        for (int q = 0; q < 16; ++q) ab[q] = *(const f32x4*)(ATz + q * 4);
#pragma unroll
        for (int j = 0; j < 63; ++j) {
            const float xj = x[j];
#pragma unroll
            for (int q = (j + 1) / 4; q < 16; ++q) {
#pragma unroll
                for (int e = 0; e < 4; ++e) if (4 * q + e > j) x[4 * q + e] -= ab[q][e] * xj;
                if (j + 1 < 63 && q >= (j + 2) / 4) ab[q] = *(const f32x4*)(ATz + (j + 1) * 68 + q * 4);
                __builtin_amdgcn_sched_barrier(0);
            }
        }
        if (tid4 < 128) {
            unsigned char* up = scr + 49152 + tid4 * 128;
#pragma unroll
            for (int q = 0; q < 8; ++q) *(v4u*)(up + q * 16) = PACK8(x + 8 * q);
        } else {
            const int dk = tid4 - 128;
#pragma unroll
            for (int i = 0; i < 64; ++i) WST[i * 128 + dk] = (bf16)f2bf(-x[i]);
        }
    } else {
        const int t2 = tid4 - 256;
        {
            const int tok = t2 >> 2, seg = t2 & 3; const float eg = EG[tok]; const float* s = QF + tok * 132 + seg * 32;
            unsigned char* o = scr + 16384 + tok * 256 + seg * 64;
#pragma unroll
            for (int q = 0; q < 4; ++q) { float f[8];
#pragma unroll
                for (int e = 0; e < 8; ++e) f[e] = s[q * 8 + e] * eg;
                *(v4u*)(o + q * 16) = PACK8(f); }
        }
        {
            const int dk = t2 >> 1, hf = t2 & 1; unsigned char* o = scr + 32768 + dk * 128 + hf * 64;
#pragma unroll
            for (int q = 0; q < 4; ++q) { float f[8];
#pragma unroll
                for (int e = 0; e < 8; ++e) { const int tok = hf * 32 + q * 8 + e; f[e] = KF[tok * 132 + dk] * EKD[tok]; }
                *(v4u*)(o + q * 16) = PACK8(f); }
        }
#pragma unroll
        for (int q = 0; q < 2; ++q) { const int c = t2 + 256 * q; *(v4u*)(scr + 65536 + c * 16) = *(const v4u*)((const unsigned char*)QKS + c * 16); }
    }
    __syncthreads();
#pragma unroll
    for (int q = 0; q < 2; ++q) { const int c = tid4 + 512 * q; *(v4u*)(scr + c * 16) = *(const v4u*)((const unsigned char*)WST + c * 16); }
    __syncthreads();
}

constexpr int S_ST = 0, S_VNT = 34816, S_OPW = 53248, S_OPQG = 70656, S_OPKD = 88064, S_OPQK = 106496, S_OPU = 115712;
__device__ __forceinline__ void scan_load(v4u (&pre)[9], const unsigned char* src, int tid, int half) {
#pragma unroll
    for (int i = 0; i < 9; ++i) pre[i] = *(const v4u*)(src + (size_t)(tid + 512 * i) * 16);
}
__device__ __forceinline__ void scan_chunk(v4u (&pre)[9], f32x4 (&sacc)[8], unsigned char* lds, unsigned char* scrbase, bf16* orow, int item, int n, float egl, int tid, int w, int fr, int fq, int half) {
    asm volatile("s_waitcnt lgkmcnt(0)" ::: "memory"); __builtin_amdgcn_s_barrier(); asm volatile("" ::: "memory");
#pragma unroll
    for (int i = 0; i < 9; ++i) {
        const int e = (tid + 512 * i) * 16 - (i >> 1) * 16384;
        if (i < 4) { const int row = e >> 8, cb = e & 255; *(v4u*)(lds + (i < 2 ? S_OPW : S_OPQG) + row * 272 + cb) = pre[i]; }
        else { const int row = e >> 7, cb = e & 127; *(v4u*)(lds + (i < 6 ? S_OPKD : (i < 8 ? S_OPU : S_OPQK)) + row * 144 + cb) = pre[i]; }
    }
    asm volatile("s_waitcnt lgkmcnt(0)" ::: "memory"); __builtin_amdgcn_s_barrier(); asm volatile("" ::: "memory");
    scan_load(pre, scrbase + (size_t)(item + (n + 2 < 32 ? 8 : 0)) * SCR_ITEM, tid, half);
    if (w < 4) {
    const int dvt = half * 4 + w;
#define SB() __builtin_amdgcn_sched_barrier(0)
    bf16x8 sf[4];
#pragma unroll
    for (int ks = 0; ks < 4; ++ks) sf[ks] = *(const bf16x8*)(lds + S_ST + (16 * w + fr) * 272 + (ks * 32 + 8 * fq) * 2);
    f32x4 vt[4];
    v2u uu[4];
#pragma unroll
    for (int tt = 0; tt < 4; ++tt) uu[tt] = *(const v2u*)(lds + S_OPU + (16 * dvt + fr) * 144 + (tt * 16 + 4 * fq) * 2);
    {
        bf16x8 af[4][4];
#pragma unroll
        for (int ks = 0; ks < 4; ++ks)
#pragma unroll
            for (int tt = 0; tt < 4; ++tt) af[ks][tt] = *(const bf16x8*)(lds + S_OPW + (tt * 16 + fr) * 272 + (ks * 32 + 8 * fq) * 2);
        SB();
#pragma unroll
        for (int tt = 0; tt < 4; ++tt) vt[tt] = (f32x4){bflo(uu[tt].x), bfhi(uu[tt].x), bflo(uu[tt].y), bfhi(uu[tt].y)};
#pragma unroll
        for (int ks = 0; ks < 4; ++ks)
#pragma unroll
            for (int tt = 0; tt < 4; ++tt) vt[tt] = __builtin_amdgcn_mfma_f32_16x16x32_bf16(af[ks][tt], sf[ks], vt[tt], 0, 0, 0);
        SB();
    }
#pragma unroll
    for (int tt = 0; tt < 4; ++tt) *(v2u*)(lds + S_VNT + (16 * w + fr) * 144 + (tt * 16 + 4 * fq) * 2) = (v2u){pk2(vt[tt][0], vt[tt][1]), pk2(vt[tt][2], vt[tt][3])};
    f32x4 ot[4];
#pragma unroll
    for (int nt = 0; nt < 4; ++nt) ot[nt] = (f32x4){0.f, 0.f, 0.f, 0.f};
    {
        bf16x8 bq[4][4];
#pragma unroll
        for (int ks = 0; ks < 4; ++ks)
#pragma unroll
            for (int nt = 0; nt < 4; ++nt) bq[ks][nt] = *(const bf16x8*)(lds + S_OPQG + (nt * 16 + fr) * 272 + (ks * 32 + 8 * fq) * 2);
        SB();
#pragma unroll
        for (int ks = 0; ks < 4; ++ks)
#pragma unroll
            for (int nt = 0; nt < 4; ++nt) ot[nt] = __builtin_amdgcn_mfma_f32_16x16x32_bf16(sf[ks], bq[ks][nt], ot[nt], 0, 0, 0);
        SB();
    }
    LDS_WAIT();
    bf16x8 vf[2];
#pragma unroll
    for (int js = 0; js < 2; ++js) vf[js] = *(const bf16x8*)(lds + S_VNT + (16 * w + fr) * 144 + (js * 32 + 8 * fq) * 2);
    {
        bf16x8 bk[2][4];
#pragma unroll
        for (int js = 0; js < 2; ++js)
#pragma unroll
            for (int nt = 0; nt < 4; ++nt) bk[js][nt] = *(const bf16x8*)(lds + S_OPQK + (nt * 16 + fr) * 144 + (js * 32 + 8 * fq) * 2);
        SB();
#pragma unroll
        for (int js = 0; js < 2; ++js)
#pragma unroll
            for (int nt = 0; nt < 4; ++nt) ot[nt] = __builtin_amdgcn_mfma_f32_16x16x32_bf16(vf[js], bk[js][nt], ot[nt], 0, 0, 0);
        SB();
    }
#pragma unroll
    for (int nt = 0; nt < 4; ++nt) *(v2u*)(orow + (size_t)(nt * 16 + fr) * D + 16 * dvt + 4 * fq) = (v2u){pk2(ot[nt][0], ot[nt][1]), pk2(ot[nt][2], ot[nt][3])};
    {
        bf16x8 ak[2][8];
#pragma unroll
        for (int js = 0; js < 2; ++js)
#pragma unroll
            for (int mt = 0; mt < 8; ++mt) ak[js][mt] = *(const bf16x8*)(lds + S_OPKD + (mt * 16 + fr) * 144 + (js * 32 + 8 * fq) * 2);
        SB();
#pragma unroll
        for (int mt = 0; mt < 8; ++mt) sacc[mt] = sacc[mt] * egl;
#pragma unroll
        for (int js = 0; js < 2; ++js)
#pragma unroll
            for (int mt = 0; mt < 8; ++mt) sacc[mt] = __builtin_amdgcn_mfma_f32_16x16x32_bf16(ak[js][mt], vf[js], sacc[mt], 0, 0, 0);
        SB();
    }
#pragma unroll
    for (int mt = 0; mt < 8; ++mt) *(v2u*)(lds + S_ST + (16 * w + fr) * 272 + (mt * 16 + 4 * fq) * 2) = (v2u){pk2(sacc[mt][0], sacc[mt][1]), pk2(sacc[mt][2], sacc[mt][3])};
#undef SB
    }
    LDS_WAIT();
}
__device__ __forceinline__ void scan_wg(KP P, int l, int id, unsigned char* lds, int tid) {
    const int bh = id >> 1, half = id & 1, b = bh >> 2, h = bh & 3;
    const int lane = tid & 63, w = __builtin_amdgcn_readfirstlane(tid >> 6), fr = lane & 15, fq = lane >> 4;
    unsigned char* scrbase = P->ws + WS_SCR;
    bf16* OCAT = (bf16*)(P->ws + WS_XA);
    f32x4 sacc[8];
#pragma unroll
    for (int mt = 0; mt < 8; ++mt) sacc[mt] = (f32x4){0.f, 0.f, 0.f, 0.f};
    { unsigned zz0 = 0u; asm volatile("" : "+v"(zz0)); if (w < 4) for (int q = lane; q < 272; q += 64) *(v4u*)(lds + S_ST + (16 * w) * 272 + q * 16) = (v4u){zz0, zz0, zz0, zz0}; }
    const int item0 = (b * 32) * 4 + h;
    const float glv = ((const float*)(P->ws + WS_GL))[item0 + 4 * (lane & 31)];
    v4u preA[9], preB[9];
    scan_load(preA, scrbase + (size_t)item0 * SCR_ITEM, tid, half);
    scan_load(preB, scrbase + (size_t)(item0 + 4) * SCR_ITEM, tid, half);
    bf16* orow = OCAT + (size_t)(b * SEQL) * D + h * 128;
#pragma unroll
    for (int n = 0; n < 32; n += 2) {
        scan_chunk(preA, sacc, lds, scrbase, orow + (size_t)(n * 64) * D, item0 + 4 * n, n, rdl(glv, n), tid, w, fr, fq, half);
        scan_chunk(preB, sacc, lds, scrbase, orow + (size_t)(n * 64 + 64) * D, item0 + 4 * n + 4, n + 1, rdl(glv, n + 1), tid, w, fr, fq, half);
    }
    if (w < 4) {
        const int lane2 = lane_id(), fr2 = lane2 & 15, fq2 = lane2 >> 4;
        float* pd = P->out + O_PDELTA + (size_t)((l * NBATCH + b) * 4 + h) * 16384;
#pragma unroll
        for (int mt = 0; mt < 8; ++mt)
#pragma unroll
            for (int r = 0; r < 4; ++r) pd[(mt * 16 + 4 * fq2 + r) * 128 + 16 * (half * 4 + w) + fr2] = sacc[mt][r];
    }
    __syncthreads();
}
__device__ __forceinline__ void p2d(KP P, int l, int gw, int ngw, int lane) {
    const bf16* PROJ = (const bf16*)(P->ws + WS_PROJ);
    bf16* OCAT = (bf16*)(P->ws + WS_XA);
    const float on0 = P->in[12][l * 128 + lane * 2], on1 = P->in[12][l * 128 + lane * 2 + 1];
    for (int pair0 = gw; pair0 < MP * 4; pair0 += 4 * ngw) {
        float o0[4], o1[4]; unsigned zz[4];
#pragma unroll
        for (int q = 0; q < 4; ++q) {
            const int pair = pair0 + q * ngw;
            o0[q] = 0.f; o1[q] = 0.f; zz[q] = 0u;
            if (pair < MP * 4) {
                const int row = pair >> 2, h = pair & 3, b = row >> 11, t = row & 2047, n = t >> 6, tok = t & 63;
                const unsigned ow = *(const unsigned*)(OCAT + (size_t)row * D + h * 128 + lane * 2);
                o0[q] = bflo(ow); o1[q] = bfhi(ow);
                zz[q] = *(const unsigned*)(PROJ + (size_t)row * NPROJ + 1536 + h * 128 + lane * 2);
            }
        }
#pragma unroll
        for (int q = 0; q < 4; ++q) {
            const int pair = pair0 + q * ngw;
            const float rs = rsqrtf(wave_sum(o0[q] * o0[q] + o1[q] * o1[q]) * (1.f / 128.f) + EPS);
            if (pair < MP * 4) {
                const int row = pair >> 2, h = pair & 3;
                *(unsigned*)(OCAT + (size_t)row * D + h * 128 + lane * 2) = pk2(o0[q] * rs * on0 * siluf(bflo(zz[q])), o1[q] * rs * on1 * siluf(bfhi(zz[q])));
            }
        }
    }
}

__device__ __forceinline__ void sample_delta(KP P, int l, int it, unsigned char* lds, int wave_in) {
    const int tid = fresh_tid(wave_in);
    const int gq = tid >> 7, c = tid & 127, wv2 = (tid >> 6) & 1, lane = tid & 63;
    const int item = it * 4 + gq, sb = item >> 2, h = item & 3, rowbase = MP + sb * 8;
    float* QS = (float*)(lds + gq * 12288); float* KS = QS + 1024; float* VS = QS + 2048;
    float* RED2 = (float*)(lds + 49152);
    const bf16* PROJ = (const bf16*)(P->ws + WS_PROJ);
    const float* GB = (const float*)(P->ws + WS_GB);
    bf16* OCAT = (bf16*)(P->ws + WS_XA);
#pragma unroll
    for (int part = 0; part < 3; ++part) {
        const int col = part * 512 + h * 128 + c;
        const float* cw = P->in[9] + (size_t)(l * 4) * 1536 + col;
        const float w0 = cw[0], w1 = cw[1536], w2 = cw[2 * 1536], w3 = cw[3 * 1536];
        const float* hs = P->in[3] + (size_t)((l * DBATCH + sb) * 3) * 1536 + col;
        float r0 = hs[0], r1 = hs[1536], r2 = hs[2 * 1536];
        float* dst = QS + part * 1024 + c;
#pragma unroll
        for (int t = 0; t < 8; ++t) {
            const float x = bf1(PROJ[(size_t)(rowbase + t) * NPROJ + col]);
            dst[t * 128] = siluf(w0 * r0 + w1 * r1 + w2 * r2 + w3 * x);
            r0 = r1; r1 = r2; r2 = x;
        }
    }
#pragma unroll
    for (int t = 0; t < 8; ++t) {
        const float q = QS[t * 128 + c], k = KS[t * 128 + c];
        const float sq = wave_sum(q * q), sk = wave_sum(k * k);
        if (lane == 0) { RED2[(gq * 2 + wv2) * 16 + t] = sq; RED2[(gq * 2 + wv2) * 16 + 8 + t] = sk; }
    }
    __syncthreads();
#pragma unroll
    for (int t = 0; t < 8; ++t) {
        const float tq = RED2[(gq * 2) * 16 + t] + RED2[(gq * 2 + 1) * 16 + t], tk = RED2[(gq * 2) * 16 + 8 + t] + RED2[(gq * 2 + 1) * 16 + 8 + t];
        QS[t * 128 + c] *= rsqrtf(tq + EPS) * 0.08838834764831845f; KS[t * 128 + c] *= rsqrtf(tk + EPS);
    }
    __syncthreads();
    float s[128];
    {
        const float* S0 = P->in[2] + (size_t)((l * DBATCH + sb) * 4 + h) * 16384 + c;
#pragma unroll
        for (int d8 = 0; d8 < 16; ++d8) {
#pragma unroll
            for (int e = 0; e < 8; ++e) s[8 * d8 + e] = S0[e * 128];
            S0 += 8 * 128; asm volatile("" : "+v"(S0));
        }
    }
    float* GBS = RED2 + 128 + gq * 16;
    if (c < 8) { GBS[c] = __expf(GB[(size_t)(rowbase + c) * 8 + h]); GBS[8 + c] = GB[(size_t)(rowbase + c) * 8 + 4 + h]; }
    LDS_WAIT(); __syncthreads();
#pragma unroll 1
    for (int t = 0; t < 8; ++t) {
        const float eg = GBS[t], beta = GBS[8 + t];
        const f32x4* kp = (const f32x4*)(KS + t * 128); const f32x4* qp = (const f32x4*)(QS + t * 128);
        float dot = 0.f;
#pragma unroll
        for (int d4 = 0; d4 < 32; ++d4) { const f32x4 kv = kp[d4]; dot += kv[0] * s[4 * d4] + kv[1] * s[4 * d4 + 1] + kv[2] * s[4 * d4 + 2] + kv[3] * s[4 * d4 + 3];
            if ((d4 & 3) == 3) asm volatile("" ::: "memory"); }
        const float cf = beta * (VS[t * 128 + c] - eg * dot);
        float o = 0.f;
#pragma unroll
        for (int d4 = 0; d4 < 32; ++d4) { const f32x4 kv = kp[d4], qv = qp[d4];
#pragma unroll
            for (int e = 0; e < 4; ++e) { s[4 * d4 + e] = eg * s[4 * d4 + e] + cf * kv[e]; o += qv[e] * s[4 * d4 + e]; }
            if ((d4 & 3) == 3) asm volatile("" ::: "memory"); }
        VS[t * 128 + c] = o;
    }
    {
        float* sd = P->out + O_SDELTA + (size_t)((l * DBATCH + sb) * 4 + h) * 16384 + c;
#pragma unroll
        for (int d8 = 0; d8 < 16; ++d8) {
#pragma unroll
            for (int e = 0; e < 8; ++e) sd[e * 128] = s[8 * d8 + e];
            sd += 8 * 128; asm volatile("" : "+v"(sd));
        }
    }
    __syncthreads();
#pragma unroll
    for (int t = 0; t < 8; ++t) { const float o = VS[t * 128 + c]; const float so = wave_sum(o * o); if (lane == 0) RED2[(gq * 2 + wv2) * 16 + t] = so; }
    __syncthreads();
    const float onv = P->in[12][l * 128 + c];
#pragma unroll
    for (int t = 0; t < 8; ++t) {
        const float tot = RED2[(gq * 2) * 16 + t] + RED2[(gq * 2 + 1) * 16 + t];
        const float z = bf1(PROJ[(size_t)(rowbase + t) * NPROJ + 1536 + h * 128 + c]);
        OCAT[(size_t)(rowbase + t) * D + h * 128 + c] = (bf16)f2bf(VS[t * 128 + c] * rsqrtf(tot * (1.f / 128.f) + EPS) * onv * siluf(z));
    }
    __syncthreads();
}

constexpr int PL_DT = 0, PL_PW = 33792;
__device__ __forceinline__ void pool_tile(KP P, int l, int tile, unsigned char* lds, int wave_in) {
    const int tid = fresh_tid(wave_in);
    bf16* DT = (bf16*)(lds + PL_DT);
    const bf16* PROJ = (const bf16*)(P->ws + WS_PROJ);
    bf16* OCAT = (bf16*)(P->ws + WS_XA);
#pragma unroll 1
    for (int i = 0; i < 4; ++i) {
        const int idx = tid + 512 * i, tok = idx & 63, ch8 = idx >> 6, c0 = ch8 * 8, gi = ch8 >> 3, win = 2 << gi;
        int row, t, sb = 0; bool smp;
        if (tile < 256) { t = (tile & 31) * 64 + tok; row = (tile >> 5) * SEQL + t; smp = false; }
        else { sb = (tile - 256) * 8 + (tok >> 3); t = tok & 7; row = MP + sb * 8 + t; smp = true; }
        float ssum[8], cur[8];
#pragma unroll
        for (int e = 0; e < 8; ++e) { ssum[e] = 0.f; cur[e] = 0.f; }
        {
            v4u wv[16];
#pragma unroll
            for (int j = 0; j < 16; ++j) {
                wv[j] = (v4u){0u, 0u, 0u, 0u};
                if (j < win && t - j >= 0) wv[j] = *(const v4u*)(PROJ + (size_t)(row - j) * NPROJ + 2048 + c0);
            }
#pragma unroll
            for (int j = 0; j < 16; ++j) {
                float f[8]; UNPACK8(wv[j], f);
#pragma unroll
                for (int e = 0; e < 8; ++e) { ssum[e] += f[e]; if (j == 0) cur[e] = f[e]; }
            }
            if (smp) {
                for (int j = t + 1; j < win; ++j) { const float* sp = P->in[4] + (size_t)((l * DBATCH + sb) * 15 + 15 + t - j) * 256 + c0;
#pragma unroll
                    for (int e = 0; e < 8; ++e) ssum[e] += sp[e]; }
            }
        }
        const float inv = 1.f / (float)(smp ? win : (t + 1 < win ? t + 1 : win));
        { float dd[8];
#pragma unroll
            for (int e = 0; e < 8; ++e) dd[e] = ssum[e] * inv - cur[e];
            *(v4u*)(DT + tok * 264 + c0) = PACK8(dd); }
        float u0[8], u1[8], u2[8];
#pragma unroll
        for (int j = 0; j < 3; ++j) {
            const int tt = t - j; float f[8];
            if (tt >= 0) { const v4u wc = *(const v4u*)(PROJ + (size_t)(row - j) * NPROJ + 2816 + c0); const v4u wx = *(const v4u*)(PROJ + (size_t)(row - j) * NPROJ + 2304 + c0);
                float fc[8], fx[8]; UNPACK8(wc, fc); UNPACK8(wx, fx);
#pragma unroll
                for (int e = 0; e < 8; ++e) f[e] = fc[e] * fx[e]; }
            else if (smp) { const float* sp = P->in[5] + (size_t)((l * DBATCH + sb) * 2 + 2 + tt) * 256 + c0;
#pragma unroll
                for (int e = 0; e < 8; ++e) f[e] = sp[e]; }
            else {
#pragma unroll
                for (int e = 0; e < 8; ++e) f[e] = 0.f; }
#pragma unroll
            for (int e = 0; e < 8; ++e) { if (j == 0) u0[e] = f[e]; else if (j == 1) u1[e] = f[e]; else u2[e] = f[e]; }
        }
        const float* sw = P->in[15] + (size_t)(l * 3) * 256 + c0;
        const v4u wb = *(const v4u*)(PROJ + (size_t)row * NPROJ + 2560 + c0); float fb[8]; UNPACK8(wb, fb);
        float oc[8];
#pragma unroll
        for (int e = 0; e < 8; ++e) oc[e] = fb[e] * (sw[e] * u2[e] + sw[256 + e] * u1[e] + sw[512 + e] * u0[e]);
        *(v4u*)(OCAT + (size_t)row * D + 768 + c0) = PACK8(oc);
    }
    __syncthreads();
    {
        const int lane = tid & 63, wv = tid >> 6, fr = lane & 15, fq = lane >> 4, g = wv & 3, th = wv >> 2;
        bf16x8 df[2][2], pf[4][2];
#pragma unroll
        for (int tt = 0; tt < 2; ++tt)
#pragma unroll
            for (int ks = 0; ks < 2; ++ks) df[tt][ks] = *(const bf16x8*)(lds + PL_DT + ((th * 32 + tt * 16 + fr) * 264 + g * 64 + ks * 32 + 8 * fq) * 2);
#pragma unroll
        for (int et = 0; et < 4; ++et)
#pragma unroll
            for (int ks = 0; ks < 2; ++ks) pf[et][ks] = *(const bf16x8*)(lds + PL_PW + (((g * 64 + et * 16 + fr) * 72) + ks * 32 + 8 * fq) * 2);
#pragma unroll
        for (int tt = 0; tt < 2; ++tt) {
            const int tok = th * 32 + tt * 16 + fr;
            const int row = tile < 256 ? (tile >> 5) * SEQL + (tile & 31) * 64 + tok : MP + (tile - 256) * 64 + tok;
#pragma unroll
            for (int et = 0; et < 4; ++et) {
                f32x4 acc = (f32x4){0.f, 0.f, 0.f, 0.f};
#pragma unroll
                for (int ks = 0; ks < 2; ++ks) acc = __builtin_amdgcn_mfma_f32_16x16x32_bf16(pf[et][ks], df[tt][ks], acc, 0, 0, 0);
                const int ch = g * 64 + et * 16 + 4 * fq;
                const f32x4 sc = *(const f32x4*)(P->in[14] + l * 256 + ch);
                *(v2u*)(OCAT + (size_t)row * D + 512 + ch) = (v2u){pk2(acc[0] * sc[0], acc[1] * sc[1]), pk2(acc[2] * sc[2], acc[3] * sc[3])};
            }
        }
    }
    __syncthreads();
}

__device__ __forceinline__ void state_copies(KP P, int l, int start, int stride) {
    const bf16* PROJ = (const bf16*)(P->ws + WS_PROJ);
    for (int i = start; i < 136 * 1120; i += stride) {
        const int seq = i / 1120, r = (i % 1120) * 8;
        const bool smp = seq >= 8; const int sb = seq - 8;
        const int L = smp ? 8 : SEQL; const size_t row0 = smp ? (size_t)MP + sb * 8 : (size_t)seq * SEQL;
        float f[8]; float* o;
        if (r < 4608) {
            const int j = r / 1536, c = r % 1536;
            const v4u w = *(const v4u*)(PROJ + (row0 + L - 3 + j) * NPROJ + c); UNPACK8(w, f);
            o = smp ? P->out + O_SDCONV + (size_t)((l * DBATCH + sb) * 3 + j) * 1536 + c : P->out + O_PDCONV + (size_t)((l * NBATCH + seq) * 3 + j) * 1536 + c;
        } else if (r < 4608 + 3840) {
            const int r2 = r - 4608, j = r2 / 256, c = r2 % 256;
            if (smp) {
                if (j < 7) { const float* sp = P->in[4] + (size_t)((l * DBATCH + sb) * 15 + 8 + j) * 256 + c;
#pragma unroll
                    for (int e = 0; e < 8; ++e) f[e] = sp[e]; }
                else { const v4u w = *(const v4u*)(PROJ + (row0 + j - 7) * NPROJ + 2048 + c); UNPACK8(w, f); }
                o = P->out + O_SPOOL + (size_t)((l * DBATCH + sb) * 15 + j) * 256 + c;
            } else {
                const v4u w = *(const v4u*)(PROJ + (row0 + L - 15 + j) * NPROJ + 2048 + c); UNPACK8(w, f);
                o = P->out + O_PPOOL + (size_t)((l * NBATCH + seq) * 15 + j) * 256 + c;
            }
        } else {
            const int r2 = r - 8448, j = r2 / 256, c = r2 % 256;
            const size_t row = row0 + L - 2 + j;
            const v4u wc = *(const v4u*)(PROJ + row * NPROJ + 2816 + c); const v4u wx = *(const v4u*)(PROJ + row * NPROJ + 2304 + c);
            float fc[8], fx[8]; UNPACK8(wc, fc); UNPACK8(wx, fx);
#pragma unroll
            for (int e = 0; e < 8; ++e) f[e] = fc[e] * fx[e];
            o = smp ? P->out + O_SSCONV + (size_t)((l * DBATCH + sb) * 2 + j) * 256 + c : P->out + O_PSCONV + (size_t)((l * NBATCH + seq) * 2 + j) * 256 + c;
        }
        *(f32x4*)o = (f32x4){f[0], f[1], f[2], f[3]}; *(f32x4*)(o + 4) = (f32x4){f[4], f[5], f[6], f[7]};
    }
}

__device__ __forceinline__ void p4b(KP P, int l, int hf, int start, int stride) {
    bf16* GU = (bf16*)(P->ws + WS_GU); bf16* HALO = (bf16*)(P->ws + WS_HALO);
    const float* cw = P->in[19] + (size_t)(l * 3) * FF;
    const int r0 = hf * MH;
    for (int idx = start; idx < MH * 352; idx += stride) {
        const int lr = idx / 352, c0 = (idx % 352) * 8, m = r0 + lr;
        int t, sb = 0; bool smp;
        if (m < MP) { t = m & (SEQL - 1); smp = false; } else { sb = (m - MP) >> 3; t = (m - MP) & 7; smp = true; }
        float g0[8], g1[8], g2[8];
#pragma unroll
        for (int j = 0; j < 3; ++j) {
            const int tt = t - j; float f[8];
            if (tt < 0) {
                if (smp) { const float* sp = P->in[6] + (size_t)((l * DBATCH + sb) * 2 + 2 + tt) * FF + c0;
#pragma unroll
                    for (int e = 0; e < 8; ++e) f[e] = sp[e]; }
                else {
#pragma unroll
                    for (int e = 0; e < 8; ++e) f[e] = 0.f; }
            } else {
                const v4u w = (lr - j < 0) ? *(const v4u*)(HALO + (size_t)(2 + lr - j) * FF + c0) : *(const v4u*)(GU + (size_t)(lr - j) * NGU + c0);
                UNPACK8(w, f);
            }
#pragma unroll
            for (int e = 0; e < 8; ++e) { if (j == 0) g0[e] = f[e]; else if (j == 1) g1[e] = f[e]; else g2[e] = f[e]; }
        }
        const v4u wu = *(const v4u*)(GU + (size_t)lr * NGU + FF + c0); float fu[8]; UNPACK8(wu, fu);
        float a[8];
#pragma unroll
        for (int e = 0; e < 8; ++e) a[e] = siluf(cw[c0 + e] * g2[e] + cw[FF + c0 + e] * g1[e] + cw[2 * FF + c0 + e] * g0[e]) * fu[e];
        *(v4u*)(GU + (size_t)lr * NGU + FF + c0) = PACK8(a);
        if (!smp && t >= SEQL - 2) { float* o = P->out + O_PFFN + (size_t)((l * NBATCH + (m >> 11)) * 2 + t - (SEQL - 2)) * FF + c0;
#pragma unroll
            for (int e = 0; e < 8; ++e) o[e] = g0[e]; }
        if (smp && t >= 6) { float* o = P->out + O_SFFN + (size_t)((l * DBATCH + sb) * 2 + t - 6) * FF + c0;
#pragma unroll
            for (int e = 0; e < 8; ++e) o[e] = g0[e]; }
        if (hf == 0 && lr >= MH - 2) *(v4u*)(HALO + (size_t)(lr - (MH - 2)) * FF + c0) = *(const v4u*)(GU + (size_t)lr * NGU + c0);
    }
}

#define LAS __attribute__((address_space(3)))
#define XB_TMO      128
#define XB_XCNT(j)  (256  + 64 * (j))
#define XB_XSUB(j)  (1280 + 64 * (j))
#define XB_XGEN(j)  (2304 + 64 * (j))
#define XB_TOP      3328
#define XB_TOPGEN   3392
#define XCD_BAR_WORDS 3456
#define XB_SPIN_CAP (1u << 18)

__device__ __forceinline__ unsigned xb_ld(unsigned* p)              { return __hip_atomic_load(p, __ATOMIC_RELAXED, __HIP_MEMORY_SCOPE_AGENT); }
__device__ __forceinline__ unsigned xb_add(unsigned* p, unsigned v) { return __hip_atomic_fetch_add(p, v, __ATOMIC_RELAXED, __HIP_MEMORY_SCOPE_AGENT); }
__device__ __forceinline__ unsigned xb_xcc_id() { return (unsigned)__builtin_amdgcn_s_getreg((3 << 11) | 20) & 0xFu; }
#define XB_SPIN(cond, bar) do { unsigned _sp = 0; while (cond) { __builtin_amdgcn_s_sleep(1); \
    if ((++_sp & 255u) == 0u) { if (xb_ld(&(bar)[XB_TMO])) break; if (_sp > XB_SPIN_CAP) { atomicAdd(&(bar)[XB_TMO], 1u); break; } } } } while (0)

struct XcdBarrier {
    unsigned* bar; unsigned x;
    volatile LAS unsigned* st;
    int wave;
};

__device__ __forceinline__ XcdBarrier xcd_barrier_post(unsigned* bar, volatile LAS unsigned* st) {
    XcdBarrier b; b.bar = bar; b.x = xb_xcc_id(); b.st = st; b.wave = 0;
    if (threadIdx.x == 0) (void)xb_add(&bar[XB_XCNT(b.x)], 1u);
    return b;
}
__device__ __forceinline__ void xcd_barrier_complete(unsigned* bar, unsigned x, unsigned& nloc, unsigned& nx) {
    const unsigned G = gridDim.x * gridDim.y * gridDim.z;
    unsigned sum, cnt, mine, sp = 0u;
    for (;;) {
        sum = 0u; cnt = 0u; mine = 0u;
#pragma unroll
        for (unsigned j = 0; j < 16; ++j) { const unsigned c = xb_ld(&bar[XB_XCNT(j)]); sum += c; cnt += (c > 0u) ? 1u : 0u; mine = (j == x) ? c : mine; }
        if (sum == G) break;
        __builtin_amdgcn_s_sleep(1);
        if ((++sp & 255u) == 0u) { if (xb_ld(&bar[XB_TMO])) break; if (sp > XB_SPIN_CAP) { atomicAdd(&bar[XB_TMO], 1u); break; } }
    }
    nloc = mine > 0u ? mine : 1u; nx = cnt > 0u ? cnt : 1u;
}

__device__ __forceinline__ void xcd_barrier(const XcdBarrier& b) {
    asm volatile("s_waitcnt vmcnt(0)" ::: "memory");
    __syncthreads();
    if (b.wave == 0 && lane_id() == 0) {
        unsigned* bar = b.bar;
        __builtin_amdgcn_s_waitcnt(0);
        unsigned nloc = b.st[0], nx = b.st[1];
        if (nloc == 0u) { xcd_barrier_complete(bar, b.x, nloc, nx); b.st[0] = nloc; b.st[1] = nx; }
        const unsigned old = xb_add(&bar[XB_XSUB(b.x)], 1u);
        const unsigned gen = old / nloc;
        if (old + 1u == (gen + 1u) * nloc) {
            __builtin_amdgcn_fence(__ATOMIC_RELEASE, "agent");
            asm volatile("s_waitcnt vmcnt(0)" ::: "memory");
            const unsigned og = xb_add(&bar[XB_TOP], 1u);
            const unsigned tg = og / nx;
            if (og + 1u == (tg + 1u) * nx) xb_add(&bar[XB_TOPGEN], 1u);
            else XB_SPIN(xb_ld(&bar[XB_TOPGEN]) == tg, bar);
            __builtin_amdgcn_fence(__ATOMIC_ACQUIRE, "agent");
            xb_add(&bar[XB_XGEN(b.x)], 1u);
            asm volatile("s_waitcnt vmcnt(0)" ::: "memory");
        } else {
            XB_SPIN(xb_ld(&bar[XB_XGEN(b.x)]) == gen, bar);
            __builtin_amdgcn_fence(__ATOMIC_ACQUIRE, "agent");
            asm volatile("s_waitcnt vmcnt(0)" ::: "memory");
        }
    }
    __syncthreads();
}

#define XSYNC1() do { XcdBarrier b_; b_.bar = (unsigned*)(kparams()->ws + WS_BAR); b_.x = xb_xcc_id(); b_.st = (volatile LAS unsigned*)((LAS unsigned char*)lds + (LDS_BYTES - 64)); b_.wave = wave; xcd_barrier(b_); } while (0)
#ifdef PROBE_SYNC2
#define GSYNC() do { XSYNC1(); XSYNC1(); } while (0)
#else
#define GSYNC() XSYNC1()
#endif
__global__ void __launch_bounds__(NTHREADS, 2) fwd_megakernel(Params Parg) {
    KP P = kparams();
    extern __shared__ __attribute__((aligned(16))) unsigned char lds[];
    cg::grid_group grid = cg::this_grid();
    const int wave = __builtin_amdgcn_readfirstlane((int)threadIdx.x >> 6);
    const int tid = fresh_tid(wave), lane = tid & 63;
    const int G = gridDim.x, bx = blockIdx.x;
    const int gw = bx * NWAVES + wave, ngw = G * NWAVES;
    const int gt = bx * NTHREADS + tid, ngt = G * NTHREADS;
    unsigned char* ws = P->ws;
    bf16* XA = (bf16*)(ws + WS_XA); bf16* XB2 = (bf16*)(ws + WS_PROJ); bf16* PROJ = (bf16*)(ws + WS_PROJ); bf16* GU = (bf16*)(ws + WS_GU);
    float* SSQ = (float*)(ws + WS_SSQ); float* GB = (float*)(ws + WS_GB); float* WAB = (float*)(ws + WS_WAB);
    float* XRES = P->out;
    float* wscr = (float*)(lds + wave * 16384);
    volatile LAS unsigned* xst = (volatile LAS unsigned*)((LAS unsigned char*)lds + (LDS_BYTES - 64));
    if (tid < 16) xst[tid] = 0u;
    __syncthreads();
    (void)xcd_barrier_post((unsigned*)(ws + WS_BAR), xst);

    for (int i = gt; i < 4 * M; i += ngt) SSQ[M + i] = 0.f;
    for (int i = gt; i < MS * D / 4; i += ngt) ((f32x4*)(XRES + (size_t)MP * D))[i] = ((const f32x4*)P->in[1])[i];
    for (int i = gt; i < 2 * 8 * D; i += ngt) { const int l = i >> 13, j = (i >> 10) & 7, k = i & 1023; WAB[i] = P->in[7][l * D + k] * P->in[8][(size_t)l * D * DIN + (size_t)k * DIN + 2048 + j]; }
    convert_win(P, 0, wscr, gw, ngw, lane);
    convert_layer_rest(P, 0, wscr, gw, ngw, lane);
    convert_layer_rest(P, 1, wscr, gw, ngw, lane);
    for (int m0 = gw; m0 < M; m0 += 2 * ngw) {
        f32x4 v[2][4];
#pragma unroll
        for (int q = 0; q < 2; ++q) { const int m = m0 + q * ngw;
            const float* xr = m < MP ? P->in[0] + (size_t)m * D : P->in[1] + (size_t)((m < M ? m : M - 1) - MP) * D;
#pragma unroll
            for (int j = 0; j < 4; ++j) v[q][j] = ((const f32x4*)xr)[lane + 64 * j]; }
#pragma unroll
        for (int q = 0; q < 2; ++q) { const int m = m0 + q * ngw;
            if (m < M) {
                float ss = 0.f;
#pragma unroll
                for (int j = 0; j < 4; ++j) { const f32x4 w4 = v[q][j]; ss += w4[0] * w4[0] + w4[1] * w4[1] + w4[2] * w4[2] + w4[3] * w4[3];
                    ((v2u*)(XA + (size_t)m * D))[lane + 64 * j] = (v2u){pk2(w4[0], w4[1]), pk2(w4[2], w4[3])}; }
                ss = wave_sum(ss);
                if (lane == 0) SSQ[m] = ss;
            } }
    }
    if (ws == nullptr) grid.sync();
    GSYNC();

#pragma unroll 1
    for (int l = 0; l < 2; ++l) {
#ifndef NO_P1
        {
            const bf16* gA = XA; const bf16* gB = (const bf16*)(ws + WS_WIN); LAUNDER(gA); LAUNDER(gB);
            pg8::Gemm g{gA, gB, M, NPROJ, D, D, D}; pg8::StaticOrder S; S.init(M, NPROJ, G, bx);
            EpiScale E{PROJ, NPROJ, SSQ + (size_t)(2 * l) * M};
            pg8::gemm_phase<EpiScale, pg8::StaticOrder, true, true>((PG8_LAS unsigned char*)lds, g, S, E, wave);
#ifdef PROBE_P1X2
            __syncthreads();
            pg8::gemm_phase<EpiScale, pg8::StaticOrder, true, true>((PG8_LAS unsigned char*)lds, g, S, E, wave);
#endif
        }
#endif
#ifndef NO_AB
        {
            const float* ssq = SSQ + (size_t)(2 * l) * M;
            const int tf = fresh_tid(wave), lane = tf & 63, gw = bx * NWAVES + __builtin_amdgcn_readfirstlane(tf >> 6);
            for (int m0 = gw; m0 < M; m0 += 2 * ngw) {
                v4u xq[2][2]; float sqv[2];
#pragma unroll
                for (int q = 0; q < 2; ++q) { const int m = (m0 + q * ngw) < M ? (m0 + q * ngw) : (M - 1);
                    const v4u* xr = (const v4u*)(XA + (size_t)m * D) + lane * 2; xq[q][0] = xr[0]; xq[q][1] = xr[1]; sqv[q] = ssq[m]; }
#pragma unroll
                for (int q = 0; q < 2; ++q) {
                    const int m = m0 + q * ngw;
                    float xf[16]; UNPACK8(xq[q][0], xf); UNPACK8(xq[q][1], xf + 8);
                    float dot[8];
#pragma unroll
                    for (int j = 0; j < 8; ++j) { const float* wp = WAB + (size_t)(l * 8 + j) * D + lane * 16; float s2 = 0.f;
#pragma unroll
                        for (int e = 0; e < 16; ++e) s2 += wp[e] * xf[e];
                        dot[j] = wave_sum(s2); }
                    float v = dot[0];
#pragma unroll
                    for (int j = 1; j < 8; ++j) v = (lane == j) ? dot[j] : v;
                    if (lane < 8 && m < M) {
                        v *= rsqrtf(sqv[q] * (1.f / D) + EPS);
                        const int hh = lane & 3; float r;
                        if (lane < 4) { const float xx = v + P->in[11][l * 4 + hh]; const float sp = fmaxf(xx, 0.f) + __logf(1.f + __expf(-fabsf(xx))); r = -__expf(P->in[10][l * 4 + hh]) * sp; }
                        else r = __builtin_amdgcn_rcpf(1.f + __expf(-v));
                        GB[(size_t)m * 8 + lane] = r;
                    }
                }
            }
        }
#endif
        GSYNC();
#ifndef NO_P2B
        { const int tf = fresh_tid(wave); for (int item = bx; item < 1024; item += G) p2b_item(P, l, item, lds, wave); }
#ifdef PROBE_P2B2
        __syncthreads(); { const int tf = fresh_tid(wave); for (int item = bx; item < 1024; item += G) p2b_item(P, l, item, lds, wave); }
#endif
#endif
        GSYNC();
#ifdef PROBE_SCAN2
        if (bx < 64) { scan_wg(P, l, bx, lds, fresh_tid(wave)); }
#endif
#ifndef NO_SCAN
        if (bx < 64) scan_wg(P, l, bx, lds, fresh_tid(wave));
#endif
        {
            unsigned* qctr = (unsigned*)(ws + WS_BAR) + 3600 + l;
            volatile unsigned* qslot = (volatile unsigned*)(lds + LDS_BYTES - 128);
            bool have_pw = false;
            for (;;) {
                const int tid = fresh_tid(wave);
                __syncthreads();
                if (tid == 0) *qslot = atomicAdd(qctr, 1u);
                __syncthreads();
                const int it = (int)*qslot;
                if (it >= 128 + 272 + 64) break;
                if (it < 128) { sample_delta(P, l, it, lds, wave); have_pw = false; }
                else if (it < 400) {
                    if (!have_pw) {
                        for (int i = tid; i < 16384; i += NTHREADS) { const int e = i & 63, c = (i >> 6) & 63, g = i >> 12; ((bf16*)(lds + PL_PW))[(g * 64 + e) * 72 + c] = (bf16)f2bf(P->in[13][(size_t)l * 16384 + i]); }
                        __syncthreads(); have_pw = true;
                    }
                    pool_tile(P, l, it - 128, lds, wave);
                } else state_copies(P, l, (it - 400) * NTHREADS + tid, 64 * NTHREADS);
            }
        }
        GSYNC();
        { const int tf = fresh_tid(wave); p2d(P, l, bx * NWAVES + __builtin_amdgcn_readfirstlane(tf >> 6), ngw, tf & 63); }
        GSYNC();
#ifdef PROBE_P2D2
        { const int tf = fresh_tid(wave); p2d(P, l, bx * NWAVES + __builtin_amdgcn_readfirstlane(tf >> 6), ngw, tf & 63); }
        GSYNC();
        { const int tf = fresh_tid(wave); p2d(P, l, bx * NWAVES + __builtin_amdgcn_readfirstlane(tf >> 6), ngw, tf & 63); }
        GSYNC();
        { const int tf = fresh_tid(wave); p2d(P, l, bx * NWAVES + __builtin_amdgcn_readfirstlane(tf >> 6), ngw, tf & 63); }
        GSYNC();
#endif
        {
            const bf16* gA = XA; const bf16* gB = (const bf16*)(ws + WS_WOUT) + (size_t)l * D * D; LAUNDER(gA); LAUNDER(gB);
            pg8::Gemm g{gA, gB, MP, D, D, D, D}; pg8::StaticOrder S; S.init(MP, D, G, bx);
            EpiResid E{l == 0 ? P->in[0] : XRES, l == 0 ? P->in[1] : XRES + (size_t)MP * D, XRES, XB2, SSQ + (size_t)(2 * l + 1) * M, 0};
            pg8::gemm_phase<EpiResid, pg8::StaticOrder, true, true>((PG8_LAS unsigned char*)lds, g, S, E, wave);
            const int ks = bx >> 4; const bf16* gA2 = XA + (size_t)MP * D + ks * 256; const bf16* gB2 = gB + ks * 256; LAUNDER(gA2); LAUNDER(gB2);
            pg8::Gemm g2{gA2, gB2, MS, D, 256, D, D}; SplitOrder S2{bx < 64 ? (bx & 15) : -1};
            EpiAtomic E2{(float*)(ws + WS_GU) + (size_t)ks * MS * D};
            pg8::gemm_phase<EpiAtomic, SplitOrder, true, true>((PG8_LAS unsigned char*)lds, g2, S2, E2, wave);
        }
        GSYNC();
        fin_sample(XRES + (size_t)MP * D, XB2 + (size_t)MP * D, SSQ + (size_t)(2 * l + 1) * M + MP, (const float*)(ws + WS_GU), 4, nullptr, 0, bx * NWAVES + wave, ngw, lane_id());
        GSYNC();
        {
            const bf16* gA = XB2; const bf16* gB = (const bf16*)(ws + WS_WGU) + (size_t)l * NGU * D; LAUNDER(gA); LAUNDER(gB);
            pg8::Gemm g{gA, gB, M, NGU, D, D, D}; pg8::StaticOrder S; S.init(M, NGU, G, bx);
            EpiGateUp E{GU, SSQ + (size_t)(2 * l + 1) * M, P->in[19] + (size_t)(l * 3) * FF, P->in[6] + (size_t)l * DBATCH * 2 * FF, (float*)(ws + WS_HAL), (float*)(ws + WS_FIXG), (float*)(ws + WS_FIXU),
                        P->out + O_PFFN + (size_t)l * NBATCH * 2 * FF, P->out + O_SFFN + (size_t)l * DBATCH * 2 * FF, lds};
            pg8::gemm_phase<EpiGateUp, pg8::StaticOrder, true, true>((PG8_LAS unsigned char*)lds, g, S, E, wave);
#ifdef PROBE_P4X2
            __syncthreads();
            pg8::gemm_phase<EpiGateUp, pg8::StaticOrder, true, true>((PG8_LAS unsigned char*)lds, g, S, E, wave);
#endif
        }
        GSYNC();
        p4_fixup(P, l, bx * NTHREADS + fresh_tid(wave), ngt);
        if (l == 0) { const int tf = fresh_tid(wave); convert_win(P, 1, (float*)(lds + wave * 16384), bx * NWAVES + wave, ngw, tf & 63); }
        GSYNC();
        {
            const bf16* gA = GU; const bf16* gB = (const bf16*)(ws + WS_WDN) + (size_t)l * D * FF; LAUNDER(gA); LAUNDER(gB);
            pg8::Gemm g{gA, gB, MP, D, FF, FF, FF}; pg8::StaticOrder S; S.init(MP, D, G, bx);
            EpiResid E{XRES, XRES + (size_t)MP * D, XRES, XA, SSQ + (size_t)(2 * l + 2) * M, 0};
            pg8::gemm_phase<EpiResid, pg8::StaticOrder, true, true>((PG8_LAS unsigned char*)lds, g, S, E, wave);
            const int ks = bx >> 4; const bf16* gA2 = GU + (size_t)MP * FF + ks * 256; const bf16* gB2 = gB + ks * 256; LAUNDER(gA2); LAUNDER(gB2);
            pg8::Gemm g2{gA2, gB2, MS, D, 256, FF, FF}; SplitOrder S2{bx < 176 ? (bx & 15) : -1};
            EpiAtomic E2{ks < 8 ? (float*)(ws + WS_PROJ) + (size_t)ks * MS * D : (float*)(ws + WS_PART2) + (size_t)(ks - 8) * MS * D};
            pg8::gemm_phase<EpiAtomic, SplitOrder, true, true>((PG8_LAS unsigned char*)lds, g2, S2, E2, wave);
        }
        GSYNC();
        fin_sample(XRES + (size_t)MP * D, XA + (size_t)MP * D, SSQ + (size_t)(2 * l + 2) * M + MP, (const float*)(ws + WS_PROJ), 8, (const float*)(ws + WS_PART2), 3, bx * NWAVES + wave, ngw, lane_id());
        GSYNC();
    }
    {
        const float* ssq = SSQ + (size_t)4 * M; const float* fn = P->in[22];
        const int gt = bx * NTHREADS + fresh_tid(wave);
        for (int i0 = gt; i0 < M * 256; i0 += 4 * ngt) {
            f32x4 v[4]; float sq[4];
#pragma unroll
            for (int q = 0; q < 4; ++q) { const int i = i0 + q * ngt; v[q] = (f32x4){0.f, 0.f, 0.f, 0.f}; sq[q] = 1.f;
                if (i < M * 256) { v[q] = ((const f32x4*)XRES)[i]; sq[q] = ssq[i >> 8]; } }
#pragma unroll
            for (int q = 0; q < 4; ++q) { const int i = i0 + q * ngt;
                if (i < M * 256) { const float rs = rsqrtf(sq[q] * (1.f / D) + EPS); const f32x4 gv = ((const f32x4*)fn)[i & 255];
                    f32x4 o = v[q]; o[0] *= rs * gv[0]; o[1] *= rs * gv[1]; o[2] *= rs * gv[2]; o[3] *= rs * gv[3];
                    ((f32x4*)XRES)[i] = o; } }
        }
    }
}

extern "C" void kernel_launch(void* const* d_in, const int* in_sizes, int n_in, void* d_out, int out_size, void* d_ws, size_t ws_size, hipStream_t stream) {
    static int grid = 0;
    if (grid == 0) {
        if (n_in != 23 || (size_t)out_size != O_TOTAL || ws_size < WS_END) { fprintf(stderr, "kernel_launch: unexpected shapes: n_in %d out %d ws %zu\n", n_in, out_size, ws_size); grid = -1; return; }
        int dev = 0, cus = 0, per_cu = 0;
        hipGetDevice(&dev); hipDeviceGetAttribute(&cus, hipDeviceAttributeMultiprocessorCount, dev);
        if (hipFuncSetAttribute((const void*)fwd_megakernel, hipFuncAttributeMaxDynamicSharedMemorySize, LDS_BYTES) != hipSuccess) { fprintf(stderr, "kernel_launch: hipFuncSetAttribute failed\n"); grid = -1; return; }
        hipOccupancyMaxActiveBlocksPerMultiprocessor(&per_cu, (const void*)fwd_megakernel, NTHREADS, LDS_BYTES);
        (void)hipGetLastError();
        if (per_cu < 1) fprintf(stderr, "kernel_launch: occupancy query reports %d blocks per CU\n", per_cu);
        grid = cus;
    }
    if (grid < 0) return;
    if (hipMemsetAsync((char*)d_ws + WS_BAR, 0, 16384, stream) != hipSuccess) { fprintf(stderr, "kernel_launch: memset failed\n"); return; }
    Params p{};
    for (int i = 0; i < 23; ++i) p.in[i] = (const float*)d_in[i];
    p.out = (float*)d_out; p.ws = (unsigned char*)d_ws;
    void* args[] = {&p};
    hipError_t e = hipLaunchCooperativeKernel((const void*)fwd_megakernel, dim3(grid), dim3(NTHREADS), args, LDS_BYTES, stream);
    if (e != hipSuccess) fprintf(stderr, "cooperative launch failed: %s (grid %d)\n", hipGetErrorString(e), grid);
}
```

```cpp
#include <hip/hip_runtime.h>
#include <hip/hip_cooperative_groups.h>
#include <cstdio>
#include <cstdint>
namespace cg = cooperative_groups;
__device__ __forceinline__ int lane_id() { int t; asm volatile("v_mbcnt_lo_u32_b32 %0, -1, 0\n\tv_mbcnt_hi_u32_b32 %0, -1, %0" : "=v"(t)); return t; }
__device__ __forceinline__ int fresh_tid(int wave) { return (wave << 6) | lane_id(); }
namespace pg8 {
#define PG8_LAS __attribute__((address_space(3)))
typedef unsigned short bf16_t;
typedef short bf16x8 __attribute__((ext_vector_type(8)));
typedef float f32x4 __attribute__((ext_vector_type(4)));
typedef unsigned u32x4 __attribute__((ext_vector_type(4)));
constexpr int BM = 256, BK = 64, HALF = 128, HTB = HALF * BK * 2  , STAGE_BYTES = 8 * HTB, NXCD = 8, WGM = 8;

__host__ __device__ __forceinline__ int lds_byte(int r, int c) { const int st = (r >> 4) * 2 + (c >> 5), rr = r & 15, cc = c & 31, ob = rr * 64 + cc * 2; return st * 1024 + (ob ^ (((ob >> 9) & 1) << 5)); }
__host__ __device__ __forceinline__ void stage_rc(int b, int& R, int& C) { const int st = b / 1024, sb = b % 1024, swz = sb ^ (((sb >> 9) & 1) << 5); R = (st >> 1) * 16 + swz / 64; C = (st & 1) * 32 + (swz % 64) / 2; }
__host__ __device__ __forceinline__ int perm32(int rho) { const int n = rho >> 4, i = rho & 15; return 8 * (i >> 2) + 4 * n + (i & 3); }

struct Unit { int pm, pn; };
struct Gemm { const bf16_t* A; const bf16_t* Bt; int M, N, K, lda, ldb; };

struct StaticOrder {
    int nM, nN, nwg, G, c;
    __host__ __device__ void init(int M, int N, int G_, int c_) { nM = M / BM; nN = N / BM; nwg = nM * nN; G = G_; c = c_; }
    __host__ __device__ bool next(int i, Unit& u) const {
        const long L = (long)i * G + c; if (L >= nwg) return false;
        int wgid = (int)L; { const int q = nwg / NXCD, r = nwg % NXCD, xcd = wgid % NXCD, off = wgid / NXCD; wgid = (xcd < r ? xcd * (q + 1) : r * (q + 1) + (xcd - r) * q) + off; }
        const int nig = WGM * nN, gid = wgid / nig, fm = gid * WGM, gsz = (nM - fm) < WGM ? (nM - fm) : WGM;
        u.pm = fm + ((wgid % nig) % gsz); u.pn = (wgid % nig) / gsz; return true;
    }
    __device__ __forceinline__ void a_ready(const Unit&) const {}
    __device__ __forceinline__ void done(const Unit&) const {}
};

template <class Epi, class Sched, bool ALIGN_EPI = false, bool SP2 = false>
__device__ __forceinline__ void gemm_phase(PG8_LAS unsigned char* lds, const Gemm g, const Sched& S, const Epi& E, const int wave_in) {
    const int tid = fresh_tid(wave_in), wid = __builtin_amdgcn_readfirstlane(tid >> 6), lane = tid & 63, wr = wid >> 2, wc = wid & 3, fr = lane & 15, fq = lane >> 4;
    const int K = g.K, nt = K / BK;
    unsigned voffA[2], voffB[2];
#pragma unroll
    for (int i = 0; i < 2; ++i) { int R, C; stage_rc(tid * 16 + i * 8192, R, C); const int Rb = Epi::PERM ? ((R & ~31) + perm32(R & 31)) : R;
        voffA[i] = (unsigned)(R * g.lda + C) * 2u; voffB[i] = (unsigned)(Rb * g.ldb + C) * 2u; }
    const size_t kstep = (size_t)(BK * 2);
    const size_t hstepA = (size_t)HALF * g.lda * 2, hstepB = (size_t)HALF * g.ldb * 2;
    const size_t tstepA = 2 * hstepA, tstepB = 2 * hstepB;
    const unsigned ldsw = (unsigned)wid * 1024u;
    const int aoff = lds_byte(wr * 64 + fr, fq * 8), boff = lds_byte(wc * 32 + fr, fq * 8);
#define PG8_SA(b, h) (((b) * 2 + (h)) * HTB)
#define PG8_SB(b, h) ((4 + (b) * 2 + (h)) * HTB)
#define PG8_STAGE(bufoff, gbase, voff) do { _Pragma("unroll") for (int _i = 0; _i < 2; ++_i) \
        __builtin_amdgcn_global_load_lds((const unsigned*)((const char*)(gbase) + (voff)[_i]), (PG8_LAS unsigned*)(lds + (bufoff) + ldsw + _i * 8192), 16, 0, 0); } while (0)
#define PG8_LDA(dst, b, h) do { _Pragma("unroll") for (int m = 0; m < 4; ++m) _Pragma("unroll") for (int k = 0; k < 2; ++k) dst[m][k] = *(const PG8_LAS bf16x8*)(lds + PG8_SA(b, h) + aoff + m * 2048 + k * 1024); } while (0)
#define PG8_LDB(dst, b, h) do { _Pragma("unroll") for (int n = 0; n < 2; ++n) _Pragma("unroll") for (int k = 0; k < 2; ++k) dst[n][k] = *(const PG8_LAS bf16x8*)(lds + PG8_SB(b, h) + boff + n * 2048 + k * 1024); } while (0)
#define PG8_MMA(ai, bj, At, Bt) do { __builtin_amdgcn_s_setprio(1); _Pragma("unroll") for (int m = 0; m < 4; ++m) _Pragma("unroll") for (int n = 0; n < 2; ++n) _Pragma("unroll") for (int k = 0; k < 2; ++k) \
        acc[ai][bj][m][n] = __builtin_amdgcn_mfma_f32_16x16x32_bf16(Bt[n][k], At[m][k], acc[ai][bj][m][n], 0, 0, 0); __builtin_amdgcn_s_setprio(0); } while (0)
#define PG8_WAIT_V(n) asm volatile("s_waitcnt vmcnt(" #n ")" ::: "memory")
#define PG8_WAIT_L(n) asm volatile("s_waitcnt lgkmcnt(" #n ")" ::: "memory")
#define PG8_BAR __builtin_amdgcn_s_barrier()
#define PG8_SCHED __builtin_amdgcn_sched_barrier(0)
    Unit cur, nxt; int ui = 0;
    if (!S.next(0, cur)) return;
    f32x4 acc[2][2][4][2];
#pragma unroll
    for (int a = 0; a < 2; ++a)
#pragma unroll
        for (int b = 0; b < 2; ++b)
#pragma unroll
            for (int m = 0; m < 4; ++m)
#pragma unroll
                for (int n = 0; n < 2; ++n) acc[a][b][m][n] = (f32x4){0.f, 0.f, 0.f, 0.f};
    bf16x8 At[4][2], B0[2][2], B1[2][2];
    const char* cA = (const char*)g.A + (size_t)cur.pm * tstepA; const char* cB = (const char*)g.Bt + (size_t)cur.pn * tstepB;
    S.a_ready(cur);
    if constexpr (SP2) {
        PG8_STAGE(PG8_SB(0, 0), cB, voffB); PG8_STAGE(PG8_SB(0, 1), cB + hstepB, voffB); PG8_STAGE(PG8_SA(0, 0), cA, voffA); PG8_STAGE(PG8_SA(0, 1), cA + hstepA, voffA);
        if (wr == 1) PG8_BAR;
        PG8_WAIT_V(2); PG8_BAR;
        PG8_STAGE(PG8_SB(1, 0), cB + kstep, voffB); PG8_STAGE(PG8_SA(1, 0), cA + kstep, voffA); PG8_STAGE(PG8_SB(1, 1), cB + hstepB + kstep, voffB);
        PG8_WAIT_V(6); PG8_BAR;
    } else {
        PG8_STAGE(PG8_SB(0, 0), cB, voffB); PG8_STAGE(PG8_SA(0, 0), cA, voffA); PG8_STAGE(PG8_SB(0, 1), cB + hstepB, voffB); PG8_STAGE(PG8_SA(0, 1), cA + hstepA, voffA);
        if (wr == 1) PG8_BAR;
        PG8_WAIT_V(4); PG8_BAR;
        PG8_STAGE(PG8_SB(1, 0), cB + kstep, voffB); PG8_STAGE(PG8_SA(1, 0), cA + kstep, voffA); PG8_STAGE(PG8_SB(1, 1), cB + hstepB + kstep, voffB);
        PG8_WAIT_V(6); PG8_BAR;
    }
    for (;;) {
        const bool has_next = S.next(ui + 1, nxt);
        const char* nA = has_next ? (const char*)g.A + (size_t)nxt.pm * tstepA : cA; const char* nB = has_next ? (const char*)g.Bt + (size_t)nxt.pn * tstepB : cB;
        for (int t = 0; t < nt; t += 2) {
            const bool last = (t == nt - 2);
            const char* a1 = cA + (size_t)(t + 1) * kstep;
            const char* a2 = last ? nA : cA + (size_t)(t + 2) * kstep; const char* b2 = last ? nB : cB + (size_t)(t + 2) * kstep;
            const char* a3 = a2 + kstep; const char* b3 = b2 + kstep;
            if (last && has_next) S.a_ready(nxt);
            if constexpr (SP2) {
            PG8_LDB(B0, 0, 0); PG8_LDB(B1, 0, 1); PG8_SCHED; PG8_LDA(At, 0, 0); PG8_STAGE(PG8_SA(1, 1), a1 + hstepA, voffA);
            PG8_WAIT_V(8); PG8_WAIT_L(0); PG8_BAR; PG8_MMA(0, 0, At, B0); PG8_MMA(0, 1, At, B1); PG8_BAR; PG8_SCHED;
            PG8_LDA(At, 0, 1); PG8_STAGE(PG8_SB(0, 0), b2, voffB); PG8_STAGE(PG8_SB(0, 1), b2 + hstepB, voffB); PG8_STAGE(PG8_SA(0, 0), a2, voffA);
            PG8_WAIT_V(8); PG8_WAIT_L(0); PG8_BAR; PG8_MMA(1, 0, At, B0); PG8_MMA(1, 1, At, B1); PG8_BAR; PG8_SCHED;
            PG8_LDB(B0, 1, 0); PG8_LDB(B1, 1, 1); PG8_SCHED; PG8_LDA(At, 1, 0); PG8_STAGE(PG8_SA(0, 1), a2 + hstepA, voffA);
            PG8_WAIT_V(8); PG8_WAIT_L(0); PG8_BAR; PG8_MMA(0, 0, At, B0); PG8_MMA(0, 1, At, B1); PG8_BAR; PG8_SCHED;
            PG8_LDA(At, 1, 1); PG8_STAGE(PG8_SB(1, 0), b3, voffB); PG8_STAGE(PG8_SB(1, 1), b3 + hstepB, voffB); PG8_STAGE(PG8_SA(1, 0), a3, voffA);
            PG8_WAIT_V(8); PG8_WAIT_L(0); PG8_BAR; PG8_MMA(1, 0, At, B0); PG8_MMA(1, 1, At, B1); PG8_BAR; PG8_SCHED;
            } else {
            PG8_LDB(B0, 0, 0); PG8_SCHED; PG8_LDA(At, 0, 0); PG8_STAGE(PG8_SA(1, 1), a1 + hstepA, voffA);
            PG8_WAIT_L(8); PG8_BAR; PG8_WAIT_L(0); PG8_MMA(0, 0, At, B0); PG8_BAR; PG8_SCHED;
            PG8_LDB(B1, 0, 1); PG8_STAGE(PG8_SB(0, 0), b2, voffB);
            PG8_BAR; PG8_WAIT_L(0); PG8_MMA(0, 1, At, B1); PG8_BAR;
            PG8_LDA(At, 0, 1); PG8_STAGE(PG8_SA(0, 0), a2, voffA);
            PG8_BAR; PG8_WAIT_L(0); PG8_MMA(1, 0, At, B0); PG8_BAR; PG8_SCHED;
            PG8_STAGE(PG8_SB(0, 1), b2 + hstepB, voffB);
            PG8_WAIT_V(6); PG8_BAR; PG8_MMA(1, 1, At, B1); PG8_BAR;
            PG8_LDB(B0, 1, 0); PG8_SCHED; PG8_LDA(At, 1, 0); PG8_STAGE(PG8_SA(0, 1), a2 + hstepA, voffA);
            PG8_WAIT_L(8); PG8_BAR; PG8_WAIT_L(0); PG8_MMA(0, 0, At, B0); PG8_BAR; PG8_SCHED;
            PG8_LDB(B1, 1, 1); PG8_STAGE(PG8_SB(1, 0), b3, voffB);
            PG8_BAR; PG8_WAIT_L(0); PG8_MMA(0, 1, At, B1); PG8_BAR;
            PG8_LDA(At, 1, 1); PG8_STAGE(PG8_SA(1, 0), a3, voffA);
            PG8_BAR; PG8_WAIT_L(0); PG8_MMA(1, 0, At, B0); PG8_BAR; PG8_SCHED;
            PG8_STAGE(PG8_SB(1, 1), b3 + hstepB, voffB);
            PG8_WAIT_V(6); PG8_BAR; PG8_MMA(1, 1, At, B1); PG8_BAR;
            }
        }
        if constexpr (ALIGN_EPI) { if (wr == 0) PG8_BAR; }
        if constexpr (!Epi::AFTER_DRAIN) { E(acc, cur, wr, wc, fr, fq); S.done(cur); }
        if (!has_next) break;
#pragma unroll
        for (int a = 0; a < 2; ++a)
#pragma unroll
            for (int b = 0; b < 2; ++b)
#pragma unroll
                for (int m = 0; m < 4; ++m)
#pragma unroll
                    for (int n = 0; n < 2; ++n) acc[a][b][m][n] = (f32x4){0.f, 0.f, 0.f, 0.f};
        cur = nxt; cA = nA; cB = nB; ++ui;
        if constexpr (ALIGN_EPI) { if (wr == 1) PG8_BAR; }
    }
    PG8_WAIT_V(0);
    if constexpr (!ALIGN_EPI) { if (wr == 0) PG8_BAR; }
    PG8_BAR;
    if constexpr (Epi::AFTER_DRAIN) { E.fused(acc, cur, wr, wc, fr, fq, lds, wid, lane); S.done(cur); }
#undef PG8_SA
#undef PG8_SB
#undef PG8_STAGE
#undef PG8_LDA
#undef PG8_LDB
#undef PG8_MMA
#undef PG8_WAIT_V
#undef PG8_WAIT_L
#undef PG8_BAR
#undef PG8_SCHED
}
}

typedef unsigned short bf16;
typedef unsigned v4u __attribute__((ext_vector_type(4)));
typedef unsigned v2u __attribute__((ext_vector_type(2)));
typedef float f32x4 __attribute__((ext_vector_type(4)));
typedef short bf16x8 __attribute__((ext_vector_type(8)));

constexpr int D = 1024, MP = 16384, MS = 1024, M = MP + MS, SEQL = 2048, NBATCH = 8, DBATCH = 128;
constexpr int NPROJ = 3072, FF = 2816, NGU = 5632, DIN = 3080, MH = M / 2;
constexpr float EPS = 1e-6f;
constexpr int NTHREADS = 512, NWAVES = 8;
constexpr int LDS_BYTES = 155648;
constexpr size_t MiB = 1u << 20;
constexpr size_t WS_WOUT = 0, WS_WGU = 4 * MiB, WS_WDN = 26 * MiB, WS_XA = 37 * MiB, WS_PROJ = 71 * MiB, WS_GU = 105 * MiB, WS_SCR = 173 * MiB, WS_WIN = 239 * MiB;
constexpr size_t WS_GB = 245 * MiB, WS_SSQ = 245 * MiB + 576 * 1024, WS_WAB = 246 * MiB, WS_GL = 246 * MiB + 64 * 1024, WS_HALO = 246 * MiB + 128 * 1024, WS_BAR = 246 * MiB + 192 * 1024, WS_PART2 = 200 * MiB, WS_HAL = 247 * MiB, WS_FIXG = 249 * MiB, WS_FIXU = 251 * MiB, WS_END = 253 * MiB;
constexpr int SCR_ITEM = 73728;
constexpr size_t O_PDELTA = 17825792, O_PDCONV = 18874368, O_PPOOL = 18948096, O_PSCONV = 19009536, O_PFFN = 19017728;
constexpr size_t O_SDELTA = 19107840, O_SDCONV = 35885056, O_SPOOL = 37064704, O_SSCONV = 38047744, O_SFFN = 38178816, O_TOTAL = 39620608;

struct Params { const float* in[23]; float* out; unsigned char* ws; };
typedef const __attribute__((address_space(4))) Params* KP;
__device__ __forceinline__ KP kparams() { KP p = (KP)__builtin_amdgcn_kernarg_segment_ptr(); asm volatile("" : "+s"(p)); return p; }

#define LAUNDER(p) asm volatile("" : "+s"(p))
#define LDS_WAIT() asm volatile("s_waitcnt lgkmcnt(0)" ::: "memory")
__device__ __forceinline__ unsigned f2bf(float f) { unsigned u = __builtin_bit_cast(unsigned, f); return (u + 0x7fffu + ((u >> 16) & 1u)) >> 16; }
__device__ __forceinline__ unsigned pk2(float lo, float hi) { return f2bf(lo) | (f2bf(hi) << 16); }
__device__ __forceinline__ float bflo(unsigned u) { return __builtin_bit_cast(float, u << 16); }
__device__ __forceinline__ float bfhi(unsigned u) { return __builtin_bit_cast(float, u & 0xffff0000u); }
__device__ __forceinline__ float bf1(bf16 h) { return __builtin_bit_cast(float, ((unsigned)h) << 16); }
__device__ __forceinline__ float siluf(float x) { return x * __builtin_amdgcn_rcpf(1.f + __expf(-x)); }
__device__ __forceinline__ float shx(float v, int m) { return __builtin_bit_cast(float, __builtin_amdgcn_ds_bpermute((lane_id() ^ m) << 2, __builtin_bit_cast(int, v))); }
__device__ __forceinline__ float rdl(float v, int l) { return __builtin_bit_cast(float, __builtin_amdgcn_readlane(__builtin_bit_cast(int, v), l)); }
template <int CTRL> __device__ __forceinline__ float dpp_mov(float v) { const int i = __builtin_bit_cast(int, v); return __builtin_bit_cast(float, __builtin_amdgcn_update_dpp(i, i, CTRL, 0xf, 0xf, false)); }
__device__ __forceinline__ float wave_sum(float v) {
    v += dpp_mov<0x128>(v); v += dpp_mov<0x124>(v); v += dpp_mov<0x122>(v); v += dpp_mov<0x121>(v);
    const int i = __builtin_bit_cast(int, v);
    return (__builtin_bit_cast(float, __builtin_amdgcn_readlane(i, 0)) + __builtin_bit_cast(float, __builtin_amdgcn_readlane(i, 16))) +
           (__builtin_bit_cast(float, __builtin_amdgcn_readlane(i, 32)) + __builtin_bit_cast(float, __builtin_amdgcn_readlane(i, 48)));
}
#define UNPACK8(W_, F_) do { (F_)[0] = bflo((W_).x); (F_)[1] = bfhi((W_).x); (F_)[2] = bflo((W_).y); (F_)[3] = bfhi((W_).y); (F_)[4] = bflo((W_).z); (F_)[5] = bfhi((W_).z); (F_)[6] = bflo((W_).w); (F_)[7] = bfhi((W_).w); } while (0)
#define PACK8(F_) ((v4u){pk2((F_)[0], (F_)[1]), pk2((F_)[2], (F_)[3]), pk2((F_)[4], (F_)[5]), pk2((F_)[6], (F_)[7])})

struct EpiScale {
    static constexpr bool PERM = true, AFTER_DRAIN = false;
    bf16* O; int ldc; const float* ssq;
    __device__ __forceinline__ void operator()(const pg8::f32x4 (&acc)[2][2][4][2], const pg8::Unit& u, int wr, int wc, int fr, int fq) const {
        const int row0 = u.pm * 256 + wr * 64 + fr, col0 = u.pn * 256 + wc * 32 + 8 * fq;
        float sq[2][4];
#pragma unroll
        for (int ai = 0; ai < 2; ++ai)
#pragma unroll
            for (int m = 0; m < 4; ++m) sq[ai][m] = ssq[row0 + ai * 128 + m * 16];
#pragma unroll
        for (int ai = 0; ai < 2; ++ai)
#pragma unroll
            for (int m = 0; m < 4; ++m) {
                const int row = row0 + ai * 128 + m * 16;
                const float rs = rsqrtf(sq[ai][m] * (1.f / D) + EPS);
                bf16* rowp = O + (size_t)row * ldc + col0;
#pragma unroll
                for (int bj = 0; bj < 2; ++bj) {
                    pg8::f32x4 v0 = acc[ai][bj][m][0] * rs, v1 = acc[ai][bj][m][1] * rs;
                    v4u w; w.x = pk2(v0[0], v0[1]); w.y = pk2(v0[2], v0[3]); w.z = pk2(v1[0], v1[1]); w.w = pk2(v1[2], v1[3]);
                    *(v4u*)(rowp + bj * 128) = w;
                }
            }
    }
};
struct EpiResid {
    static constexpr bool PERM = true, AFTER_DRAIN = false;
    const float* xa; const float* xb_; float* xres; bf16* xb16; float* ssq; int rowbase;
    __device__ __forceinline__ void operator()(const pg8::f32x4 (&acc)[2][2][4][2], const pg8::Unit& u, int wr, int wc, int fr, int fq) const {
        const int row0 = rowbase + u.pm * 256 + wr * 64 + fr, col0 = u.pn * 256 + wc * 32 + 8 * fq;
#pragma unroll
        for (int ai = 0; ai < 2; ++ai) {
            pg8::f32x4 xo4[4][4];
#pragma unroll
            for (int m = 0; m < 4; ++m) {
                const int row = row0 + ai * 128 + m * 16;
                const float* xo = (row < MP ? xa + (size_t)row * D : xb_ + (size_t)(row - MP) * D) + col0;
                xo4[m][0] = *(const pg8::f32x4*)xo; xo4[m][1] = *(const pg8::f32x4*)(xo + 4); xo4[m][2] = *(const pg8::f32x4*)(xo + 128); xo4[m][3] = *(const pg8::f32x4*)(xo + 132);
            }
#pragma unroll
            for (int m = 0; m < 4; ++m) {
                const int row = row0 + ai * 128 + m * 16;
                float* xr = xres + (size_t)row * D + col0;
                bf16* xh = xb16 + (size_t)row * D + col0;
                float ss = 0.f;
#pragma unroll
                for (int bj = 0; bj < 2; ++bj) {
                    pg8::f32x4 v0 = acc[ai][bj][m][0] + xo4[m][2 * bj], v1 = acc[ai][bj][m][1] + xo4[m][2 * bj + 1];
                    *(pg8::f32x4*)(xr + bj * 128) = v0; *(pg8::f32x4*)(xr + bj * 128 + 4) = v1;
                    v4u w; w.x = pk2(v0[0], v0[1]); w.y = pk2(v0[2], v0[3]); w.z = pk2(v1[0], v1[1]); w.w = pk2(v1[2], v1[3]);
                    *(v4u*)(xh + bj * 128) = w;
                    ss += v0[0] * v0[0] + v0[1] * v0[1] + v0[2] * v0[2] + v0[3] * v0[3] + v1[0] * v1[0] + v1[1] * v1[1] + v1[2] * v1[2] + v1[3] * v1[3];
                }
                ss += shx(ss, 16); ss += shx(ss, 32);
                if (fq == 0) atomicAdd(ssq + row, ss);
            }
        }
    }
};


struct SplitOrder {
    int unit;
    __device__ __forceinline__ bool next(int i, pg8::Unit& u) const { if (i != 0 || unit < 0) return false; u.pm = unit >> 2; u.pn = unit & 3; return true; }
    __device__ __forceinline__ void a_ready(const pg8::Unit&) const {}
    __device__ __forceinline__ void done(const pg8::Unit&) const {}
};
struct EpiAtomic {
    static constexpr bool PERM = true, AFTER_DRAIN = false;
    float* X;
    __device__ __forceinline__ void operator()(const pg8::f32x4 (&acc)[2][2][4][2], const pg8::Unit& u, int wr, int wc, int fr, int fq) const {
        const int row0 = u.pm * 256 + wr * 64 + fr, col0 = u.pn * 256 + wc * 32 + 8 * fq;
#pragma unroll
        for (int ai = 0; ai < 2; ++ai)
#pragma unroll
            for (int m = 0; m < 4; ++m) {
                float* xr = X + (size_t)(row0 + ai * 128 + m * 16) * D + col0;
#pragma unroll
                for (int bj = 0; bj < 2; ++bj) { *(pg8::f32x4*)(xr + bj * 128) = acc[ai][bj][m][0]; *(pg8::f32x4*)(xr + bj * 128 + 4) = acc[ai][bj][m][1]; }
            }
    }
};
__device__ __forceinline__ void fin_sample(float* X, bf16* XB, float* ssq, const float* partA, int nA, const float* partB, int nB, int gw, int ngw, int lane) {
    for (int r = gw; r < MS; r += ngw) {
        f32x4 v[4];
#pragma unroll
        for (int j = 0; j < 4; ++j) v[j] = ((const f32x4*)(X + (size_t)r * D))[lane + 64 * j];
        for (int k = 0; k < nA; ++k) {
#pragma unroll
            for (int j = 0; j < 4; ++j) v[j] += ((const f32x4*)(partA + ((size_t)k * MS + r) * D))[lane + 64 * j];
        }
        for (int k = 0; k < nB; ++k) {
#pragma unroll
            for (int j = 0; j < 4; ++j) v[j] += ((const f32x4*)(partB + ((size_t)k * MS + r) * D))[lane + 64 * j];
        }
        float ss = 0.f;
#pragma unroll
        for (int j = 0; j < 4; ++j) { ss += v[j][0] * v[j][0] + v[j][1] * v[j][1] + v[j][2] * v[j][2] + v[j][3] * v[j][3];
            ((f32x4*)(X + (size_t)r * D))[lane + 64 * j] = v[j];
            ((v2u*)(XB + (size_t)r * D))[lane + 64 * j] = (v2u){pk2(v[j][0], v[j][1]), pk2(v[j][2], v[j][3])}; }
        ss = wave_sum(ss);
        if (lane == 0) ssq[r] = ss;
    }
}

constexpr int EPI_HALO_OFF = 131072;
__device__ __forceinline__ float dpp_f(float oldv, float src, const int ctrl_sel) {
    const int o = __builtin_bit_cast(int, oldv), v = __builtin_bit_cast(int, src); int r;
    if (ctrl_sel == 0) r = __builtin_amdgcn_update_dpp(o, v, 0x111, 0xf, 0xf, false);
    else if (ctrl_sel == 1) r = __builtin_amdgcn_update_dpp(o, v, 0x112, 0xf, 0xf, false);
    else if (ctrl_sel == 2) r = __builtin_amdgcn_update_dpp(o, v, 0x121, 0xf, 0xf, false);
    else r = __builtin_amdgcn_update_dpp(o, v, 0x122, 0xf, 0xf, false);
    return __builtin_bit_cast(float, r);
}
struct EpiGateUp {
    static constexpr bool PERM = true, AFTER_DRAIN = false;
    bf16* ACT; const float* ssq; const float* cw; const float* st; float* HAL; float* FIXG; float* FIXU; float* pffn; float* sffn; unsigned char* lds;
    __device__ __forceinline__ void operator()(const pg8::f32x4 (&acc)[2][2][4][2], const pg8::Unit& u, int wr, int wc, int fr, int fq) const {
        const int pm = u.pm, ch0 = u.pn * 128 + wc * 32 + 8 * fq, row0 = pm * 256 + wr * 64 + fr;
        const bool smp = pm >= 64;
        float* halo = (float*)(lds + EPI_HALO_OFF);
#pragma unroll
        for (int ai = 0; ai < 2; ++ai) {
            const float rs = rsqrtf(ssq[row0 + ai * 128 + 48] * (1.f / D) + EPS);
            if (fr >= 14) {
                float* hp = halo + ((ai * 2 + wr) * 2 + (fr - 14)) * 128 + wc * 32 + 8 * fq;
                *(pg8::f32x4*)hp = acc[ai][0][3][0] * rs; *(pg8::f32x4*)(hp + 4) = acc[ai][0][3][1] * rs;
            }
        }
        asm volatile("s_waitcnt lgkmcnt(0)" ::: "memory");
        __builtin_amdgcn_s_barrier();
        float w0[8], w1[8], w2[8];
#pragma unroll
        for (int e = 0; e < 8; ++e) { w0[e] = cw[ch0 + e]; w1[e] = cw[FF + ch0 + e]; w2[e] = cw[2 * FF + ch0 + e]; }
#pragma unroll
        for (int ai = 0; ai < 2; ++ai) {
            const int s = ai * 2 + wr;
            float prev[8];
#pragma unroll
            for (int e = 0; e < 8; ++e) prev[e] = 0.f;
            if (!smp && s >= 1 && fr >= 14) {
                const float* hp = halo + ((s - 1) * 2 + (fr - 14)) * 128 + wc * 32 + 8 * fq;
                const pg8::f32x4 h0 = *(const pg8::f32x4*)hp, h1 = *(const pg8::f32x4*)(hp + 4);
                prev[0] = h0[0]; prev[1] = h0[1]; prev[2] = h0[2]; prev[3] = h0[3]; prev[4] = h1[0]; prev[5] = h1[1]; prev[6] = h1[2]; prev[7] = h1[3];
            }
            float sq4[4];
#pragma unroll
            for (int m = 0; m < 4; ++m) sq4[m] = ssq[row0 + ai * 128 + m * 16];
#pragma unroll
            for (int m = 0; m < 4; ++m) {
                const int row = row0 + ai * 128 + m * 16;
                const float rs = rsqrtf(sq4[m] * (1.f / D) + EPS);
                float cur[8], upv[8], s0v[8], s1v[8];
#pragma unroll
                for (int e = 0; e < 8; ++e) { cur[e] = acc[ai][0][m][e >> 2][e & 3] * rs; upv[e] = acc[ai][1][m][e >> 2][e & 3] * rs; s0v[e] = 0.f; s1v[e] = 0.f; }
                const int t = fr & 7, sb = (row - MP) >> 3;
                if (smp && t < 2) {
                    const float* sp = st + (size_t)(sb * 2) * FF + ch0;
#pragma unroll
                    for (int e = 0; e < 8; ++e) { s0v[e] = sp[e]; s1v[e] = sp[FF + e]; }
                }
                float a[8];
#pragma unroll
                for (int e = 0; e < 8; ++e) {
                    const float sh1 = dpp_f(cur[e], cur[e], 0), sh2 = dpp_f(cur[e], cur[e], 1), ro1 = dpp_f(prev[e], prev[e], 2), ro2 = dpp_f(prev[e], prev[e], 3);
                    float p1, p2;
                    if (smp) { p1 = t >= 1 ? sh1 : s1v[e]; p2 = t >= 2 ? sh2 : (t == 1 ? s1v[e] : s0v[e]); }
                    else { p1 = fr >= 1 ? sh1 : ro1; p2 = fr >= 2 ? sh2 : ro2; }
                    a[e] = siluf(w0[e] * p2 + w1[e] * p1 + w2[e] * cur[e]) * upv[e];
                }
                *(v4u*)(ACT + (size_t)row * FF + ch0) = PACK8(a);
                if (smp) {
                    if (t >= 6) { float* o = sffn + (size_t)(sb * 2 + t - 6) * FF + ch0;
                        *(pg8::f32x4*)o = (pg8::f32x4){cur[0], cur[1], cur[2], cur[3]}; *(pg8::f32x4*)(o + 4) = (pg8::f32x4){cur[4], cur[5], cur[6], cur[7]}; }
                } else {
                    if (s == 3 && m == 3 && fr >= 14) {
                        float* o = HAL + (size_t)(pm * 2 + fr - 14) * FF + ch0;
                        *(pg8::f32x4*)o = (pg8::f32x4){cur[0], cur[1], cur[2], cur[3]}; *(pg8::f32x4*)(o + 4) = (pg8::f32x4){cur[4], cur[5], cur[6], cur[7]};
                        if ((pm & 7) == 7) { float* o2 = pffn + (size_t)((pm >> 3) * 2 + fr - 14) * FF + ch0;
                            *(pg8::f32x4*)o2 = (pg8::f32x4){cur[0], cur[1], cur[2], cur[3]}; *(pg8::f32x4*)(o2 + 4) = (pg8::f32x4){cur[4], cur[5], cur[6], cur[7]}; }
                    }
                    if (s == 0 && m == 0 && fr < 2 && (pm & 7) != 0) {
                        float* o = FIXG + (size_t)(pm * 2 + fr) * FF + ch0; float* o2 = FIXU + (size_t)(pm * 2 + fr) * FF + ch0;
                        *(pg8::f32x4*)o = (pg8::f32x4){cur[0], cur[1], cur[2], cur[3]}; *(pg8::f32x4*)(o + 4) = (pg8::f32x4){cur[4], cur[5], cur[6], cur[7]};
                        *(pg8::f32x4*)o2 = (pg8::f32x4){upv[0], upv[1], upv[2], upv[3]}; *(pg8::f32x4*)(o2 + 4) = (pg8::f32x4){upv[4], upv[5], upv[6], upv[7]};
                    }
                }
#pragma unroll
                for (int e = 0; e < 8; ++e) prev[e] = cur[e];
            }
        }
    }
};
__device__ __forceinline__ void p4_fixup(KP P, int l, int start, int stride) {
    const float* HAL = (const float*)(P->ws + WS_HAL); const float* FIXG = (const float*)(P->ws + WS_FIXG); const float* FIXU = (const float*)(P->ws + WS_FIXU);
    bf16* ACT = (bf16*)(P->ws + WS_GU);
    const float* cw = P->in[19] + (size_t)(l * 3) * FF;
    for (int idx = start; idx < 56 * 2 * FF; idx += stride) {
        const int k = idx / (2 * FF), rem = idx % (2 * FF), rr = rem / FF, c = rem % FF;
        const int pm = (k / 7) * 8 + 1 + (k % 7);
        const float g0 = FIXG[(size_t)(pm * 2 + rr) * FF + c];
        const float g1 = rr == 0 ? HAL[(size_t)((pm - 1) * 2 + 1) * FF + c] : FIXG[(size_t)(pm * 2) * FF + c];
        const float g2 = rr == 0 ? HAL[(size_t)((pm - 1) * 2) * FF + c] : HAL[(size_t)((pm - 1) * 2 + 1) * FF + c];
        const float a = siluf(cw[c] * g2 + cw[FF + c] * g1 + cw[2 * FF + c] * g0) * FIXU[(size_t)(pm * 2 + rr) * FF + c];
        ACT[(size_t)(pm * 256 + rr) * FF + c] = (bf16)f2bf(a);
    }
}
__device__ __forceinline__ void transpose_item(const float* W, int K, int ldw, int src_col0, const float* g, bf16* WT, int dst_row0, float* scr, int kb, int lane) {
    const int k0 = 64 * kb;
    float wv[32];
#pragma unroll
    for (int i = 0; i < 32; ++i) wv[i] = W[(size_t)(k0 + 2 * i + (lane >> 5)) * ldw + src_col0 + (lane & 31)];
#pragma unroll
    for (int i = 0; i < 32; ++i) { const int kk = 2 * i + (lane >> 5); const float gs = g ? g[k0 + kk] : 1.f; scr[kk * 33 + (lane & 31)] = wv[i] * gs; }
    LDS_WAIT();
    const int c = lane & 7;
#pragma unroll
    for (int j = 0; j < 4; ++j) { const int n = (lane >> 3) + 8 * j; const float* s = scr + (8 * c) * 33 + n;
        v4u o; o.x = pk2(s[0 * 33], s[1 * 33]); o.y = pk2(s[2 * 33], s[3 * 33]); o.z = pk2(s[4 * 33], s[5 * 33]); o.w = pk2(s[6 * 33], s[7 * 33]);
        *(v4u*)(WT + (size_t)(dst_row0 + n) * K + k0 + 8 * c) = o; }
    LDS_WAIT();
}
__device__ __forceinline__ void convert_matrix(const float* W, int K, int N, int ldw, int skip_from, int skip, const float* g, bf16* WT, int dst_row0, float* scr, int gw, int ngw, int lane, int il = 0) {
    const int nnb = N / 32, nit = (K / 64) * nnb;
    for (int it = gw; it < nit; it += ngw) {
        const int kb = it / nnb, nb = it % nnb, n0 = nb * 32;
        const int drow = il ? ((n0 >> 7) * 256 + (n0 & 127) + (il == 2 ? 128 : 0)) : n0;
        transpose_item(W, K, ldw, n0 + (n0 >= skip_from ? skip : 0), g, WT, dst_row0 + drow, scr, kb, lane);
    }
}
__device__ __forceinline__ void convert_layer_rest(KP P, int l, float* scr, int gw, int ngw, int lane) {
    unsigned char* ws = P->ws;
    convert_matrix(P->in[16] + (size_t)l * D * D, D, D, D, 1 << 30, 0, nullptr, (bf16*)(ws + WS_WOUT) + (size_t)l * D * D, 0, scr, gw, ngw, lane);
    convert_matrix(P->in[18] + (size_t)l * D * FF, D, FF, FF, 1 << 30, 0, P->in[17] + l * D, (bf16*)(ws + WS_WGU) + (size_t)l * NGU * D, 0, scr, gw, ngw, lane, 1);
    convert_matrix(P->in[20] + (size_t)l * D * FF, D, FF, FF, 1 << 30, 0, P->in[17] + l * D, (bf16*)(ws + WS_WGU) + (size_t)l * NGU * D, 0, scr, gw, ngw, lane, 2);
    convert_matrix(P->in[21] + (size_t)l * FF * D, FF, D, D, 1 << 30, 0, nullptr, (bf16*)(ws + WS_WDN) + (size_t)l * D * FF, 0, scr, gw, ngw, lane);
}
__device__ __forceinline__ void convert_win(KP P, int l, float* scr, int gw, int ngw, int lane) {
    convert_matrix(P->in[8] + (size_t)l * D * DIN, D, NPROJ, DIN, 2048, 8, P->in[7] + l * D, (bf16*)(P->ws + WS_WIN), 0, scr, gw, ngw, lane);
}

constexpr int B_QF = 0, B_KF = 33792, B_VF = 67584, B_AT = 101376, B_GC = 118784, B_QKS = 120320, B_WST = 128512;
__device__ __forceinline__ void p2b_item(KP P, int l, int item, unsigned char* lds, int wave_in) {
    const int tid = fresh_tid(wave_in);
    const int h = item & 3, n = (item >> 2) & 31, b = item >> 7;
    const int lane = tid & 63, wv = __builtin_amdgcn_readfirstlane(tid >> 6), fr = lane & 15, fq = lane >> 4;
    float* QF = (float*)(lds + B_QF); float* KF = (float*)(lds + B_KF); float* VF = (float*)(lds + B_VF); float* AT = (float*)(lds + B_AT);
    float* Gs = (float*)(lds + B_GC); float* BETA = Gs + 64; float* GC = Gs + 128; float* EG = Gs + 192; float* EKD = Gs + 256;
    bf16* QKS = (bf16*)(lds + B_QKS); bf16* WST = (bf16*)(lds + B_WST);
    const bf16* PROJ = (const bf16*)(P->ws + WS_PROJ);
    const float* GB = (const float*)(P->ws + WS_GB);
    unsigned char* scr = P->ws + WS_SCR + (size_t)item * SCR_ITEM;
    if (tid < 384) {
        const int chunk = tid % 48, tg = tid / 48, part = chunk >> 4, cc = chunk & 15;
        const int col = part * 512 + h * 128 + cc * 8;
        const float* cw = P->in[9] + (size_t)(l * 4) * 1536 + col;
        float w0[8], w1[8], w2[8], w3[8];
#pragma unroll
        for (int e = 0; e < 8; ++e) { w0[e] = cw[e]; w1[e] = cw[1536 + e]; w2[e] = cw[2 * 1536 + e]; w3[e] = cw[3 * 1536 + e]; }
        const int t0 = n * 64 + tg * 8;
        const bf16* base = PROJ + (size_t)(b * SEQL) * NPROJ + col;
        float r0[8], r1[8], r2[8], r3[8];
#pragma unroll
        for (int e = 0; e < 8; ++e) { r0[e] = 0.f; r1[e] = 0.f; r2[e] = 0.f; }
        if (t0 - 3 >= 0) { const v4u w = *(const v4u*)(base + (size_t)(t0 - 3) * NPROJ); UNPACK8(w, r0); }
        if (t0 - 2 >= 0) { const v4u w = *(const v4u*)(base + (size_t)(t0 - 2) * NPROJ); UNPACK8(w, r1); }
        if (t0 - 1 >= 0) { const v4u w = *(const v4u*)(base + (size_t)(t0 - 1) * NPROJ); UNPACK8(w, r2); }
        float* dst = (float*)(lds + part * 33792) + cc * 8;
#pragma unroll
        for (int i = 0; i < 8; ++i) {
            const v4u w = *(const v4u*)(base + (size_t)(t0 + i) * NPROJ); UNPACK8(w, r3);
            float s[8];
#pragma unroll
            for (int e = 0; e < 8; ++e) { const float cv = w0[e] * r0[e] + w1[e] * r1[e] + w2[e] * r2[e] + w3[e] * r3[e]; s[e] = siluf(cv); }
            float* d = dst + (tg * 8 + i) * 132;
            *(f32x4*)d = (f32x4){s[0], s[1], s[2], s[3]}; *(f32x4*)(d + 4) = (f32x4){s[4], s[5], s[6], s[7]};
#pragma unroll
            for (int e = 0; e < 8; ++e) { r0[e] = r1[e]; r1[e] = r2[e]; r2[e] = r3[e]; }
        }
    }
    if (tid < 64) { const int row = b * SEQL + n * 64 + tid; Gs[tid] = GB[(size_t)row * 8 + h]; BETA[tid] = GB[(size_t)row * 8 + 4 + h]; }
    __syncthreads();
    {
        const int tok = tid >> 3, sub = tid & 7;
        float* qr = QF + tok * 132 + sub * 16; float* kr = KF + tok * 132 + sub * 16;
        float qv[16], kv[16]; float sq = 0.f, sk = 0.f;
#pragma unroll
        for (int e = 0; e < 16; ++e) { qv[e] = qr[e]; kv[e] = kr[e]; sq += qv[e] * qv[e]; sk += kv[e] * kv[e]; }
        sq += shx(sq, 1); sq += shx(sq, 2); sq += shx(sq, 4);
        sk += shx(sk, 1); sk += shx(sk, 2); sk += shx(sk, 4);
        const float rq = rsqrtf(sq + EPS) * 0.08838834764831845f, rk = rsqrtf(sk + EPS);
#pragma unroll
        for (int e = 0; e < 16; ++e) { qr[e] = qv[e] * rq; kr[e] = kv[e] * rk; }
    }
    if (tid < 64) {
        float v = Gs[tid];
#pragma unroll
        for (int o = 1; o < 64; o <<= 1) { const int src = tid >= o ? tid - o : tid; const float t = __builtin_bit_cast(float, __builtin_amdgcn_ds_bpermute(src << 2, __builtin_bit_cast(int, v))); if (tid >= o) v += t; }
        const float tot = rdl(v, 63);
        GC[tid] = v; EG[tid] = __expf(v); EKD[tid] = __expf(tot - v);
        if (tid == 0) ((float*)(P->ws + WS_GL))[item] = __expf(tot);
    }
    __syncthreads();
    {
        const int p = wv >> 2, mt = wv & 3;
        const float* X = p ? QF : KF;
        f32x4 acc[4];
#pragma unroll
        for (int nt = 0; nt < 4; ++nt) acc[nt] = (f32x4){0.f, 0.f, 0.f, 0.f};
        const float* xa = X + (mt * 16 + fr) * 132 + fq; const float* kb_ = KF + fr * 132 + fq;
#pragma unroll 8
        for (int k = 0; k < 128; k += 4) {
            const float a = xa[k];
#pragma unroll
            for (int nt = 0; nt < 4; ++nt) acc[nt] = __builtin_amdgcn_mfma_f32_16x16x4f32(a, kb_[nt * 16 * 132 + k], acc[nt], 0, 0, 0);
        }
#pragma unroll
        for (int nt = 0; nt < 4; ++nt) {
            const int j = nt * 16 + fr; const float gj = GC[j];
            float v[4];
#pragma unroll
            for (int r = 0; r < 4; ++r) {
                const int i = mt * 16 + 4 * fq + r;
                if (p == 0) v[r] = (i > j) ? BETA[i] * acc[nt][r] * __expf(GC[i] - gj) : 0.f;
                else        v[r] = (i >= j) ? acc[nt][r] * __expf(GC[i] - gj) : 0.f;
            }
            if (p == 0) *(f32x4*)(AT + j * 68 + mt * 16 + 4 * fq) = (f32x4){v[0], v[1], v[2], v[3]};
            else {
#pragma unroll
                for (int r = 0; r < 4; ++r) QKS[(mt * 16 + 4 * fq + r) * 64 + j] = (bf16)f2bf(v[r]);
            }
        }
    }
    __syncthreads();
    const int tid4 = fresh_tid(wave_in);
    if (tid4 < 256) {
        float x[64];
        int zo = 0; asm volatile("" : "+v"(zo));
        const float* ATz = AT + zo; const float* BETAz = BETA + zo; const float* EGz = EG + zo;
        if (tid4 < 128) {
#pragma unroll
            for (int i = 0; i < 64; ++i) x[i] = BETAz[i] * VF[i * 132 + tid4];
        } else {
#pragma unroll
            for (int i = 0; i < 64; ++i) x[i] = BETAz[i] * EGz[i] * KF[i * 132 + tid4 - 128];
        }
        f32x4 ab[16];
#pragma unroll
        for (int q = 0; q < 16; ++q) ab[q] = *(const f32x4*)(ATz + q * 4);
#pragma unroll
        for (int j = 0; j < 63; ++j) {
            const float xj = x[j];
#pragma unroll
            for (int q = (j + 1) / 4; q < 16; ++q) {
#pragma unroll
                for (int e = 0; e < 4; ++e) if (4 * q + e > j) x[4 * q + e] -= ab[q][e] * xj;
                if (j + 1 < 63 && q >= (j + 2) / 4) ab[q] = *(const f32x4*)(ATz + (j + 1) * 68 + q * 4);
                __builtin_amdgcn_sched_barrier(0);
            }
        }
        if (tid4 < 128) {
            unsigned char* up = scr + 49152 + tid4 * 128;
#pragma unroll
            for (int q = 0; q < 8; ++q) *(v4u*)(up + q * 16) = PACK8(x + 8 * q);
        } else {
            const int dk = tid4 - 128;
#pragma unroll
            for (int i = 0; i < 64; ++i) WST[i * 128 + dk] = (bf16)f2bf(-x[i]);
        }
    } else {
        const int t2 = tid4 - 256;
        {
            const int tok = t2 >> 2, seg = t2 & 3; const float eg = EG[tok]; const float* s = QF + tok * 132 + seg * 32;
            unsigned char* o = scr + 16384 + tok * 256 + seg * 64;
#pragma unroll
            for (int q = 0; q < 4; ++q) { float f[8];
#pragma unroll
                for (int e = 0; e < 8; ++e) f[e] = s[q * 8 + e] * eg;
                *(v4u*)(o + q * 16) = PACK8(f); }
        }
        {
            const int dk = t2 >> 1, hf = t2 & 1; unsigned char* o = scr + 32768 + dk * 128 + hf * 64;
#pragma unroll
            for (int q = 0; q < 4; ++q) { float f[8];
#pragma unroll
                for (int e = 0; e < 8; ++e) { const int tok = hf * 32 + q * 8 + e; f[e] = KF[tok * 132 + dk] * EKD[tok]; }
                *(v4u*)(o + q * 16) = PACK8(f); }
        }
#pragma unroll
        for (int q = 0; q < 2; ++q) { const int c = t2 + 256 * q; *(v4u*)(scr + 65536 + c * 16) = *(const v4u*)((const unsigned char*)QKS + c * 16); }
    }
    __syncthreads();
#pragma unroll
    for (int q = 0; q < 2; ++q) { const int c = tid4 + 512 * q; *(v4u*)(scr + c * 16) = *(const v4u*)((const unsigned char*)WST + c * 16); }
    __syncthreads();
}

constexpr int S_ST = 0, S_VNT = 34816, S_OPW = 53248, S_OPQG = 70656, S_OPKD = 88064, S_OPQK = 106496, S_OPU = 115712;
__device__ __forceinline__ void scan_load(v4u (&pre)[9], const unsigned char* src, int tid, int half) {
#pragma unroll
    for (int i = 0; i < 9; ++i) pre[i] = *(const v4u*)(src + (size_t)(tid + 512 * i) * 16);
}
__device__ __forceinline__ void scan_chunk(v4u (&pre)[9], f32x4 (&sacc)[8], unsigned char* lds, unsigned char* scrbase, bf16* orow, int item, int n, float egl, int tid, int w, int fr, int fq, int half) {
    asm volatile("s_waitcnt lgkmcnt(0)" ::: "memory"); __builtin_amdgcn_s_barrier(); asm volatile("" ::: "memory");
#pragma unroll
    for (int i = 0; i < 9; ++i) {
        const int e = (tid + 512 * i) * 16 - (i >> 1) * 16384;
        if (i < 4) { const int row = e >> 8, cb = e & 255; *(v4u*)(lds + (i < 2 ? S_OPW : S_OPQG) + row * 272 + cb) = pre[i]; }
        else { const int row = e >> 7, cb = e & 127; *(v4u*)(lds + (i < 6 ? S_OPKD : (i < 8 ? S_OPU : S_OPQK)) + row * 144 + cb) = pre[i]; }
    }
    asm volatile("s_waitcnt lgkmcnt(0)" ::: "memory"); __builtin_amdgcn_s_barrier(); asm volatile("" ::: "memory");
    scan_load(pre, scrbase + (size_t)(item + (n + 2 < 32 ? 8 : 0)) * SCR_ITEM, tid, half);
    if (w < 4) {
    const int dvt = half * 4 + w;
#define SB() __builtin_amdgcn_sched_barrier(0)
    bf16x8 sf[4];
#pragma unroll
    for (int ks = 0; ks < 4; ++ks) sf[ks] = *(const bf16x8*)(lds + S_ST + (16 * w + fr) * 272 + (ks * 32 + 8 * fq) * 2);
    f32x4 vt[4];
    v2u uu[4];
#pragma unroll
    for (int tt = 0; tt < 4; ++tt) uu[tt] = *(const v2u*)(lds + S_OPU + (16 * dvt + fr) * 144 + (tt * 16 + 4 * fq) * 2);
    {
        bf16x8 af[4][4];
#pragma unroll
        for (int ks = 0; ks < 4; ++ks)
#pragma unroll
            for (int tt = 0; tt < 4; ++tt) af[ks][tt] = *(const bf16x8*)(lds + S_OPW + (tt * 16 + fr) * 272 + (ks * 32 + 8 * fq) * 2);
        SB();
#pragma unroll
        for (int tt = 0; tt < 4; ++tt) vt[tt] = (f32x4){bflo(uu[tt].x), bfhi(uu[tt].x), bflo(uu[tt].y), bfhi(uu[tt].y)};
#pragma unroll
        for (int ks = 0; ks < 4; ++ks)
#pragma unroll
            for (int tt = 0; tt < 4; ++tt) vt[tt] = __builtin_amdgcn_mfma_f32_16x16x32_bf16(af[ks][tt], sf[ks], vt[tt], 0, 0, 0);
        SB();
    }
#pragma unroll
    for (int tt = 0; tt < 4; ++tt) *(v2u*)(lds + S_VNT + (16 * w + fr) * 144 + (tt * 16 + 4 * fq) * 2) = (v2u){pk2(vt[tt][0], vt[tt][1]), pk2(vt[tt][2], vt[tt][3])};
    f32x4 ot[4];
#pragma unroll
    for (int nt = 0; nt < 4; ++nt) ot[nt] = (f32x4){0.f, 0.f, 0.f, 0.f};
    {
        bf16x8 bq[4][4];
#pragma unroll
        for (int ks = 0; ks < 4; ++ks)
#pragma unroll
            for (int nt = 0; nt < 4; ++nt) bq[ks][nt] = *(const bf16x8*)(lds + S_OPQG + (nt * 16 + fr) * 272 + (ks * 32 + 8 * fq) * 2);
        SB();
#pragma unroll
        for (int ks = 0; ks < 4; ++ks)
#pragma unroll
            for (int nt = 0; nt < 4; ++nt) ot[nt] = __builtin_amdgcn_mfma_f32_16x16x32_bf16(sf[ks], bq[ks][nt], ot[nt], 0, 0, 0);
        SB();
    }
    LDS_WAIT();
    bf16x8 vf[2];
#pragma unroll
    for (int js = 0; js < 2; ++js) vf[js] = *(const bf16x8*)(lds + S_VNT + (16 * w + fr) * 144 + (js * 32 + 8 * fq) * 2);
    {
        bf16x8 bk[2][4];
#pragma unroll
        for (int js = 0; js < 2; ++js)
#pragma unroll
            for (int nt = 0; nt < 4; ++nt) bk[js][nt] = *(const bf16x8*)(lds + S_OPQK + (nt * 16 + fr) * 144 + (js * 32 + 8 * fq) * 2);
        SB();
#pragma unroll
        for (int js = 0; js < 2; ++js)
#pragma unroll
            for (int nt = 0; nt < 4; ++nt) ot[nt] = __builtin_amdgcn_mfma_f32_16x16x32_bf16(vf[js], bk[js][nt], ot[nt], 0, 0, 0);
        SB();
    }
#pragma unroll
    for (int nt = 0; nt < 4; ++nt) *(v2u*)(orow + (size_t)(nt * 16 + fr) * D + 16 * dvt + 4 * fq) = (v2u){pk2(ot[nt][0], ot[nt][1]), pk2(ot[nt][2], ot[nt][3])};
    {
        bf16x8 ak[2][8];
#pragma unroll
        for (int js = 0; js < 2; ++js)
#pragma unroll
            for (int mt = 0; mt < 8; ++mt) ak[js][mt] = *(const bf16x8*)(lds + S_OPKD + (mt * 16 + fr) * 144 + (js * 32 + 8 * fq) * 2);
        SB();
#pragma unroll
        for (int mt = 0; mt < 8; ++mt) sacc[mt] = sacc[mt] * egl;
#pragma unroll
        for (int js = 0; js < 2; ++js)
#pragma unroll
            for (int mt = 0; mt < 8; ++mt) sacc[mt] = __builtin_amdgcn_mfma_f32_16x16x32_bf16(ak[js][mt], vf[js], sacc[mt], 0, 0, 0);
        SB();
    }
#pragma unroll
    for (int mt = 0; mt < 8; ++mt) *(v2u*)(lds + S_ST + (16 * w + fr) * 272 + (mt * 16 + 4 * fq) * 2) = (v2u){pk2(sacc[mt][0], sacc[mt][1]), pk2(sacc[mt][2], sacc[mt][3])};
#undef SB
    }
    LDS_WAIT();
}
__device__ __forceinline__ void scan_wg(KP P, int l, int id, unsigned char* lds, int tid) {
    const int bh = id >> 1, half = id & 1, b = bh >> 2, h = bh & 3;
    const int lane = tid & 63, w = __builtin_amdgcn_readfirstlane(tid >> 6), fr = lane & 15, fq = lane >> 4;
    unsigned char* scrbase = P->ws + WS_SCR;
    bf16* OCAT = (bf16*)(P->ws + WS_XA);
    f32x4 sacc[8];
#pragma unroll
    for (int mt = 0; mt < 8; ++mt) sacc[mt] = (f32x4){0.f, 0.f, 0.f, 0.f};
    { unsigned zz0 = 0u; asm volatile("" : "+v"(zz0)); if (w < 4) for (int q = lane; q < 272; q += 64) *(v4u*)(lds + S_ST + (16 * w) * 272 + q * 16) = (v4u){zz0, zz0, zz0, zz0}; }
    const int item0 = (b * 32) * 4 + h;
    const float glv = ((const float*)(P->ws + WS_GL))[item0 + 4 * (lane & 31)];
    v4u preA[9], preB[9];
    scan_load(preA, scrbase + (size_t)item0 * SCR_ITEM, tid, half);
    scan_load(preB, scrbase + (size_t)(item0 + 4) * SCR_ITEM, tid, half);
    bf16* orow = OCAT + (size_t)(b * SEQL) * D + h * 128;
#pragma unroll
    for (int n = 0; n < 32; n += 2) {
        scan_chunk(preA, sacc, lds, scrbase, orow + (size_t)(n * 64) * D, item0 + 4 * n, n, rdl(glv, n), tid, w, fr, fq, half);
        scan_chunk(preB, sacc, lds, scrbase, orow + (size_t)(n * 64 + 64) * D, item0 + 4 * n + 4, n + 1, rdl(glv, n + 1), tid, w, fr, fq, half);
    }
    if (w < 4) {
        const int lane2 = lane_id(), fr2 = lane2 & 15, fq2 = lane2 >> 4;
        float* pd = P->out + O_PDELTA + (size_t)((l * NBATCH + b) * 4 + h) * 16384;
#pragma unroll
        for (int mt = 0; mt < 8; ++mt)
#pragma unroll
            for (int r = 0; r < 4; ++r) pd[(mt * 16 + 4 * fq2 + r) * 128 + 16 * (half * 4 + w) + fr2] = sacc[mt][r];
    }
    __syncthreads();
}
__device__ __forceinline__ void p2d(KP P, int l, int gw, int ngw, int lane) {
    const bf16* PROJ = (const bf16*)(P->ws + WS_PROJ);
    bf16* OCAT = (bf16*)(P->ws + WS_XA);
    const float on0 = P->in[12][l * 128 + lane * 2], on1 = P->in[12][l * 128 + lane * 2 + 1];
    for (int pair0 = gw; pair0 < MP * 4; pair0 += 4 * ngw) {
        float o0[4], o1[4]; unsigned zz[4];
#pragma unroll
        for (int q = 0; q < 4; ++q) {
            const int pair = pair0 + q * ngw;
            o0[q] = 0.f; o1[q] = 0.f; zz[q] = 0u;
            if (pair < MP * 4) {
                const int row = pair >> 2, h = pair & 3, b = row >> 11, t = row & 2047, n = t >> 6, tok = t & 63;
                const unsigned ow = *(const unsigned*)(OCAT + (size_t)row * D + h * 128 + lane * 2);
                o0[q] = bflo(ow); o1[q] = bfhi(ow);
                zz[q] = *(const unsigned*)(PROJ + (size_t)row * NPROJ + 1536 + h * 128 + lane * 2);
            }
        }
#pragma unroll
        for (int q = 0; q < 4; ++q) {
            const int pair = pair0 + q * ngw;
            const float rs = rsqrtf(wave_sum(o0[q] * o0[q] + o1[q] * o1[q]) * (1.f / 128.f) + EPS);
            if (pair < MP * 4) {
                const int row = pair >> 2, h = pair & 3;
                *(unsigned*)(OCAT + (size_t)row * D + h * 128 + lane * 2) = pk2(o0[q] * rs * on0 * siluf(bflo(zz[q])), o1[q] * rs * on1 * siluf(bfhi(zz[q])));
            }
        }
    }
}

__device__ __forceinline__ void sample_delta(KP P, int l, int it, unsigned char* lds, int wave_in) {
    const int tid = fresh_tid(wave_in);
    const int gq = tid >> 7, c = tid & 127, wv2 = (tid >> 6) & 1, lane = tid & 63;
    const int item = it * 4 + gq, sb = item >> 2, h = item & 3, rowbase = MP + sb * 8;
    float* QS = (float*)(lds + gq * 12288); float* KS = QS + 1024; float* VS = QS + 2048;
    float* RED2 = (float*)(lds + 49152);
    const bf16* PROJ = (const bf16*)(P->ws + WS_PROJ);
    const float* GB = (const float*)(P->ws + WS_GB);
    bf16* OCAT = (bf16*)(P->ws + WS_XA);
#pragma unroll
    for (int part = 0; part < 3; ++part) {
        const int col = part * 512 + h * 128 + c;
        const float* cw = P->in[9] + (size_t)(l * 4) * 1536 + col;
        const float w0 = cw[0], w1 = cw[1536], w2 = cw[2 * 1536], w3 = cw[3 * 1536];
        const float* hs = P->in[3] + (size_t)((l * DBATCH + sb) * 3) * 1536 + col;
        float r0 = hs[0], r1 = hs[1536], r2 = hs[2 * 1536];
        float* dst = QS + part * 1024 + c;
#pragma unroll
        for (int t = 0; t < 8; ++t) {
            const float x = bf1(PROJ[(size_t)(rowbase + t) * NPROJ + col]);
            dst[t * 128] = siluf(w0 * r0 + w1 * r1 + w2 * r2 + w3 * x);
            r0 = r1; r1 = r2; r2 = x;
        }
    }
#pragma unroll
    for (int t = 0; t < 8; ++t) {
        const float q = QS[t * 128 + c], k = KS[t * 128 + c];
        const float sq = wave_sum(q * q), sk = wave_sum(k * k);
        if (lane == 0) { RED2[(gq * 2 + wv2) * 16 + t] = sq; RED2[(gq * 2 + wv2) * 16 + 8 + t] = sk; }
    }
    __syncthreads();
#pragma unroll
    for (int t = 0; t < 8; ++t) {
        const float tq = RED2[(gq * 2) * 16 + t] + RED2[(gq * 2 + 1) * 16 + t], tk = RED2[(gq * 2) * 16 + 8 + t] + RED2[(gq * 2 + 1) * 16 + 8 + t];
        QS[t * 128 + c] *= rsqrtf(tq + EPS) * 0.08838834764831845f; KS[t * 128 + c] *= rsqrtf(tk + EPS);
    }
    __syncthreads();
    float s[128];
    {
        const float* S0 = P->in[2] + (size_t)((l * DBATCH + sb) * 4 + h) * 16384 + c;
#pragma unroll
        for (int d8 = 0; d8 < 16; ++d8) {
#pragma unroll
            for (int e = 0; e < 8; ++e) s[8 * d8 + e] = S0[e * 128];
            S0 += 8 * 128; asm volatile("" : "+v"(S0));
        }
    }
    float* GBS = RED2 + 128 + gq * 16;
    if (c < 8) { GBS[c] = __expf(GB[(size_t)(rowbase + c) * 8 + h]); GBS[8 + c] = GB[(size_t)(rowbase + c) * 8 + 4 + h]; }
    LDS_WAIT(); __syncthreads();
#pragma unroll 1
    for (int t = 0; t < 8; ++t) {
        const float eg = GBS[t], beta = GBS[8 + t];
        const f32x4* kp = (const f32x4*)(KS + t * 128); const f32x4* qp = (const f32x4*)(QS + t * 128);
        float dot = 0.f;
#pragma unroll
        for (int d4 = 0; d4 < 32; ++d4) { const f32x4 kv = kp[d4]; dot += kv[0] * s[4 * d4] + kv[1] * s[4 * d4 + 1] + kv[2] * s[4 * d4 + 2] + kv[3] * s[4 * d4 + 3];
            if ((d4 & 3) == 3) asm volatile("" ::: "memory"); }
        const float cf = beta * (VS[t * 128 + c] - eg * dot);
        float o = 0.f;
#pragma unroll
        for (int d4 = 0; d4 < 32; ++d4) { const f32x4 kv = kp[d4], qv = qp[d4];
#pragma unroll
            for (int e = 0; e < 4; ++e) { s[4 * d4 + e] = eg * s[4 * d4 + e] + cf * kv[e]; o += qv[e] * s[4 * d4 + e]; }
            if ((d4 & 3) == 3) asm volatile("" ::: "memory"); }
        VS[t * 128 + c] = o;
    }
    {
        float* sd = P->out + O_SDELTA + (size_t)((l * DBATCH + sb) * 4 + h) * 16384 + c;
#pragma unroll
        for (int d8 = 0; d8 < 16; ++d8) {
#pragma unroll
            for (int e = 0; e < 8; ++e) sd[e * 128] = s[8 * d8 + e];
            sd += 8 * 128; asm volatile("" : "+v"(sd));
        }
    }
    __syncthreads();
#pragma unroll
    for (int t = 0; t < 8; ++t) { const float o = VS[t * 128 + c]; const float so = wave_sum(o * o); if (lane == 0) RED2[(gq * 2 + wv2) * 16 + t] = so; }
    __syncthreads();
    const float onv = P->in[12][l * 128 + c];
#pragma unroll
    for (int t = 0; t < 8; ++t) {
        const float tot = RED2[(gq * 2) * 16 + t] + RED2[(gq * 2 + 1) * 16 + t];
        const float z = bf1(PROJ[(size_t)(rowbase + t) * NPROJ + 1536 + h * 128 + c]);
        OCAT[(size_t)(rowbase + t) * D + h * 128 + c] = (bf16)f2bf(VS[t * 128 + c] * rsqrtf(tot * (1.f / 128.f) + EPS) * onv * siluf(z));
    }
    __syncthreads();
}

constexpr int PL_DT = 0, PL_PW = 33792;
__device__ __forceinline__ void pool_tile(KP P, int l, int tile, unsigned char* lds, int wave_in) {
    const int tid = fresh_tid(wave_in);
    bf16* DT = (bf16*)(lds + PL_DT);
    const bf16* PROJ = (const bf16*)(P->ws + WS_PROJ);
    bf16* OCAT = (bf16*)(P->ws + WS_XA);
#pragma unroll 1
    for (int i = 0; i < 4; ++i) {
        const int idx = tid + 512 * i, tok = idx & 63, ch8 = idx >> 6, c0 = ch8 * 8, gi = ch8 >> 3, win = 2 << gi;
        int row, t, sb = 0; bool smp;
        if (tile < 256) { t = (tile & 31) * 64 + tok; row = (tile >> 5) * SEQL + t; smp = false; }
        else { sb = (tile - 256) * 8 + (tok >> 3); t = tok & 7; row = MP + sb * 8 + t; smp = true; }
        float ssum[8], cur[8];
#pragma unroll
        for (int e = 0; e < 8; ++e) { ssum[e] = 0.f; cur[e] = 0.f; }
        {
            v4u wv[16];
#pragma unroll
            for (int j = 0; j < 16; ++j) {
                wv[j] = (v4u){0u, 0u, 0u, 0u};
                if (j < win && t - j >= 0) wv[j] = *(const v4u*)(PROJ + (size_t)(row - j) * NPROJ + 2048 + c0);
            }
#pragma unroll
            for (int j = 0; j < 16; ++j) {
                float f[8]; UNPACK8(wv[j], f);
#pragma unroll
                for (int e = 0; e < 8; ++e) { ssum[e] += f[e]; if (j == 0) cur[e] = f[e]; }
            }
            if (smp) {
                for (int j = t + 1; j < win; ++j) { const float* sp = P->in[4] + (size_t)((l * DBATCH + sb) * 15 + 15 + t - j) * 256 + c0;
#pragma unroll
                    for (int e = 0; e < 8; ++e) ssum[e] += sp[e]; }
            }
        }
        const float inv = 1.f / (float)(smp ? win : (t + 1 < win ? t + 1 : win));
        { float dd[8];
#pragma unroll
            for (int e = 0; e < 8; ++e) dd[e] = ssum[e] * inv - cur[e];
            *(v4u*)(DT + tok * 264 + c0) = PACK8(dd); }
        float u0[8], u1[8], u2[8];
#pragma unroll
        for (int j = 0; j < 3; ++j) {
            const int tt = t - j; float f[8];
            if (tt >= 0) { const v4u wc = *(const v4u*)(PROJ + (size_t)(row - j) * NPROJ + 2816 + c0); const v4u wx = *(const v4u*)(PROJ + (size_t)(row - j) * NPROJ + 2304 + c0);
                float fc[8], fx[8]; UNPACK8(wc, fc); UNPACK8(wx, fx);
#pragma unroll
                for (int e = 0; e < 8; ++e) f[e] = fc[e] * fx[e]; }
            else if (smp) { const float* sp = P->in[5] + (size_t)((l * DBATCH + sb) * 2 + 2 + tt) * 256 + c0;
#pragma unroll
                for (int e = 0; e < 8; ++e) f[e] = sp[e]; }
            else {
#pragma unroll
                for (int e = 0; e < 8; ++e) f[e] = 0.f; }
#pragma unroll
            for (int e = 0; e < 8; ++e) { if (j == 0) u0[e] = f[e]; else if (j == 1) u1[e] = f[e]; else u2[e] = f[e]; }
        }
        const float* sw = P->in[15] + (size_t)(l * 3) * 256 + c0;
        const v4u wb = *(const v4u*)(PROJ + (size_t)row * NPROJ + 2560 + c0); float fb[8]; UNPACK8(wb, fb);
        float oc[8];
#pragma unroll
        for (int e = 0; e < 8; ++e) oc[e] = fb[e] * (sw[e] * u2[e] + sw[256 + e] * u1[e] + sw[512 + e] * u0[e]);
        *(v4u*)(OCAT + (size_t)row * D + 768 + c0) = PACK8(oc);
    }
    __syncthreads();
    {
        const int lane = tid & 63, wv = tid >> 6, fr = lane & 15, fq = lane >> 4, g = wv & 3, th = wv >> 2;
        bf16x8 df[2][2], pf[4][2];
#pragma unroll
        for (int tt = 0; tt < 2; ++tt)
#pragma unroll
            for (int ks = 0; ks < 2; ++ks) df[tt][ks] = *(const bf16x8*)(lds + PL_DT + ((th * 32 + tt * 16 + fr) * 264 + g * 64 + ks * 32 + 8 * fq) * 2);
#pragma unroll
        for (int et = 0; et < 4; ++et)
#pragma unroll
            for (int ks = 0; ks < 2; ++ks) pf[et][ks] = *(const bf16x8*)(lds + PL_PW + (((g * 64 + et * 16 + fr) * 72) + ks * 32 + 8 * fq) * 2);
#pragma unroll
        for (int tt = 0; tt < 2; ++tt) {
            const int tok = th * 32 + tt * 16 + fr;
            const int row = tile < 256 ? (tile >> 5) * SEQL + (tile & 31) * 64 + tok : MP + (tile - 256) * 64 + tok;
#pragma unroll
            for (int et = 0; et < 4; ++et) {
                f32x4 acc = (f32x4){0.f, 0.f, 0.f, 0.f};
#pragma unroll
                for (int ks = 0; ks < 2; ++ks) acc = __builtin_amdgcn_mfma_f32_16x16x32_bf16(pf[et][ks], df[tt][ks], acc, 0, 0, 0);
                const int ch = g * 64 + et * 16 + 4 * fq;
                const f32x4 sc = *(const f32x4*)(P->in[14] + l * 256 + ch);
                *(v2u*)(OCAT + (size_t)row * D + 512 + ch) = (v2u){pk2(acc[0] * sc[0], acc[1] * sc[1]), pk2(acc[2] * sc[2], acc[3] * sc[3])};
            }
        }
    }
    __syncthreads();
}

__device__ __forceinline__ void state_copies(KP P, int l, int start, int stride) {
    const bf16* PROJ = (const bf16*)(P->ws + WS_PROJ);
    for (int i = start; i < 136 * 1120; i += stride) {
        const int seq = i / 1120, r = (i % 1120) * 8;
        const bool smp = seq >= 8; const int sb = seq - 8;
        const int L = smp ? 8 : SEQL; const size_t row0 = smp ? (size_t)MP + sb * 8 : (size_t)seq * SEQL;
        float f[8]; float* o;
        if (r < 4608) {
            const int j = r / 1536, c = r % 1536;
            const v4u w = *(const v4u*)(PROJ + (row0 + L - 3 + j) * NPROJ + c); UNPACK8(w, f);
            o = smp ? P->out + O_SDCONV + (size_t)((l * DBATCH + sb) * 3 + j) * 1536 + c : P->out + O_PDCONV + (size_t)((l * NBATCH + seq) * 3 + j) * 1536 + c;
        } else if (r < 4608 + 3840) {
            const int r2 = r - 4608, j = r2 / 256, c = r2 % 256;
            if (smp) {
                if (j < 7) { const float* sp = P->in[4] + (size_t)((l * DBATCH + sb) * 15 + 8 + j) * 256 + c;
#pragma unroll
                    for (int e = 0; e < 8; ++e) f[e] = sp[e]; }
                else { const v4u w = *(const v4u*)(PROJ + (row0 + j - 7) * NPROJ + 2048 + c); UNPACK8(w, f); }
                o = P->out + O_SPOOL + (size_t)((l * DBATCH + sb) * 15 + j) * 256 + c;
            } else {
                const v4u w = *(const v4u*)(PROJ + (row0 + L - 15 + j) * NPROJ + 2048 + c); UNPACK8(w, f);
                o = P->out + O_PPOOL + (size_t)((l * NBATCH + seq) * 15 + j) * 256 + c;
            }
        } else {
            const int r2 = r - 8448, j = r2 / 256, c = r2 % 256;
            const size_t row = row0 + L - 2 + j;
            const v4u wc = *(const v4u*)(PROJ + row * NPROJ + 2816 + c); const v4u wx = *(const v4u*)(PROJ + row * NPROJ + 2304 + c);
            float fc[8], fx[8]; UNPACK8(wc, fc); UNPACK8(wx, fx);
#pragma unroll
            for (int e = 0; e < 8; ++e) f[e] = fc[e] * fx[e];
            o = smp ? P->out + O_SSCONV + (size_t)((l * DBATCH + sb) * 2 + j) * 256 + c : P->out + O_PSCONV + (size_t)((l * NBATCH + seq) * 2 + j) * 256 + c;
        }
        *(f32x4*)o = (f32x4){f[0], f[1], f[2], f[3]}; *(f32x4*)(o + 4) = (f32x4){f[4], f[5], f[6], f[7]};
    }
}

__device__ __forceinline__ void p4b(KP P, int l, int hf, int start, int stride) {
    bf16* GU = (bf16*)(P->ws + WS_GU); bf16* HALO = (bf16*)(P->ws + WS_HALO);
    const float* cw = P->in[19] + (size_t)(l * 3) * FF;
    const int r0 = hf * MH;
    for (int idx = start; idx < MH * 352; idx += stride) {
        const int lr = idx / 352, c0 = (idx % 352) * 8, m = r0 + lr;
        int t, sb = 0; bool smp;
        if (m < MP) { t = m & (SEQL - 1); smp = false; } else { sb = (m - MP) >> 3; t = (m - MP) & 7; smp = true; }
        float g0[8], g1[8], g2[8];
#pragma unroll
        for (int j = 0; j < 3; ++j) {
            const int tt = t - j; float f[8];
            if (tt < 0) {
                if (smp) { const float* sp = P->in[6] + (size_t)((l * DBATCH + sb) * 2 + 2 + tt) * FF + c0;
#pragma unroll
                    for (int e = 0; e < 8; ++e) f[e] = sp[e]; }
                else {
#pragma unroll
                    for (int e = 0; e < 8; ++e) f[e] = 0.f; }
            } else {
                const v4u w = (lr - j < 0) ? *(const v4u*)(HALO + (size_t)(2 + lr - j) * FF + c0) : *(const v4u*)(GU + (size_t)(lr - j) * NGU + c0);
                UNPACK8(w, f);
            }
#pragma unroll
            for (int e = 0; e < 8; ++e) { if (j == 0) g0[e] = f[e]; else if (j == 1) g1[e] = f[e]; else g2[e] = f[e]; }
        }
        const v4u wu = *(const v4u*)(GU + (size_t)lr * NGU + FF + c0); float fu[8]; UNPACK8(wu, fu);
        float a[8];
#pragma unroll
        for (int e = 0; e < 8; ++e) a[e] = siluf(cw[c0 + e] * g2[e] + cw[FF + c0 + e] * g1[e] + cw[2 * FF + c0 + e] * g0[e]) * fu[e];
        *(v4u*)(GU + (size_t)lr * NGU + FF + c0) = PACK8(a);
        if (!smp && t >= SEQL - 2) { float* o = P->out + O_PFFN + (size_t)((l * NBATCH + (m >> 11)) * 2 + t - (SEQL - 2)) * FF + c0;
#pragma unroll
            for (int e = 0; e < 8; ++e) o[e] = g0[e]; }
        if (smp && t >= 6) { float* o = P->out + O_SFFN + (size_t)((l * DBATCH + sb) * 2 + t - 6) * FF + c0;
#pragma unroll
            for (int e = 0; e < 8; ++e) o[e] = g0[e]; }
        if (hf == 0 && lr >= MH - 2) *(v4u*)(HALO + (size_t)(lr - (MH - 2)) * FF + c0) = *(const v4u*)(GU + (size_t)lr * NGU + c0);
    }
}

#define LAS __attribute__((address_space(3)))
#define XB_TMO      128
#define XB_XCNT(j)  (256  + 64 * (j))
#define XB_XSUB(j)  (1280 + 64 * (j))
#define XB_XGEN(j)  (2304 + 64 * (j))
#define XB_TOP      3328
#define XB_TOPGEN   3392
#define XCD_BAR_WORDS 3456
#define XB_SPIN_CAP (1u << 18)

__device__ __forceinline__ unsigned xb_ld(unsigned* p)              { return __hip_atomic_load(p, __ATOMIC_RELAXED, __HIP_MEMORY_SCOPE_AGENT); }
__device__ __forceinline__ unsigned xb_add(unsigned* p, unsigned v) { return __hip_atomic_fetch_add(p, v, __ATOMIC_RELAXED, __HIP_MEMORY_SCOPE_AGENT); }
__device__ __forceinline__ unsigned xb_xcc_id() { return (unsigned)__builtin_amdgcn_s_getreg((3 << 11) | 20) & 0xFu; }
#define XB_SPIN(cond, bar) do { unsigned _sp = 0; while (cond) { __builtin_amdgcn_s_sleep(1); \
    if ((++_sp & 255u) == 0u) { if (xb_ld(&(bar)[XB_TMO])) break; if (_sp > XB_SPIN_CAP) { atomicAdd(&(bar)[XB_TMO], 1u); break; } } } } while (0)

struct XcdBarrier {
    unsigned* bar; unsigned x;
    volatile LAS unsigned* st;
    int wave;
};

__device__ __forceinline__ XcdBarrier xcd_barrier_post(unsigned* bar, volatile LAS unsigned* st) {
    XcdBarrier b; b.bar = bar; b.x = xb_xcc_id(); b.st = st; b.wave = 0;
    if (threadIdx.x == 0) (void)xb_add(&bar[XB_XCNT(b.x)], 1u);
    return b;
}
__device__ __forceinline__ void xcd_barrier_complete(unsigned* bar, unsigned x, unsigned& nloc, unsigned& nx) {
    const unsigned G = gridDim.x * gridDim.y * gridDim.z;
    unsigned sum, cnt, mine, sp = 0u;
    for (;;) {
        sum = 0u; cnt = 0u; mine = 0u;
#pragma unroll
        for (unsigned j = 0; j < 16; ++j) { const unsigned c = xb_ld(&bar[XB_XCNT(j)]); sum += c; cnt += (c > 0u) ? 1u : 0u; mine = (j == x) ? c : mine; }
        if (sum == G) break;
        __builtin_amdgcn_s_sleep(1);
        if ((++sp & 255u) == 0u) { if (xb_ld(&bar[XB_TMO])) break; if (sp > XB_SPIN_CAP) { atomicAdd(&bar[XB_TMO], 1u); break; } }
    }
    nloc = mine > 0u ? mine : 1u; nx = cnt > 0u ? cnt : 1u;
}

__device__ __forceinline__ void xcd_barrier(const XcdBarrier& b) {
    asm volatile("s_waitcnt vmcnt(0)" ::: "memory");
    __syncthreads();
    if (b.wave == 0 && lane_id() == 0) {
        unsigned* bar = b.bar;
        __builtin_amdgcn_s_waitcnt(0);
        unsigned nloc = b.st[0], nx = b.st[1];
        if (nloc == 0u) { xcd_barrier_complete(bar, b.x, nloc, nx); b.st[0] = nloc; b.st[1] = nx; }
        const unsigned old = xb_add(&bar[XB_XSUB(b.x)], 1u);
        const unsigned gen = old / nloc;
        if (old + 1u == (gen + 1u) * nloc) {
            __builtin_amdgcn_fence(__ATOMIC_RELEASE, "agent");
            asm volatile("s_waitcnt vmcnt(0)" ::: "memory");
            const unsigned og = xb_add(&bar[XB_TOP], 1u);
            const unsigned tg = og / nx;
            if (og + 1u == (tg + 1u) * nx) xb_add(&bar[XB_TOPGEN], 1u);
            else XB_SPIN(xb_ld(&bar[XB_TOPGEN]) == tg, bar);
            __builtin_amdgcn_fence(__ATOMIC_ACQUIRE, "agent");
            xb_add(&bar[XB_XGEN(b.x)], 1u);
            asm volatile("s_waitcnt vmcnt(0)" ::: "memory");
        } else {
            XB_SPIN(xb_ld(&bar[XB_XGEN(b.x)]) == gen, bar);
            __builtin_amdgcn_fence(__ATOMIC_ACQUIRE, "agent");
            asm volatile("s_waitcnt vmcnt(0)" ::: "memory");
        }
    }
    __syncthreads();
}

#define XSYNC1() do { XcdBarrier b_; b_.bar = (unsigned*)(kparams()->ws + WS_BAR); b_.x = xb_xcc_id(); b_.st = (volatile LAS unsigned*)((LAS unsigned char*)lds + (LDS_BYTES - 64)); b_.wave = wave; xcd_barrier(b_); } while (0)
#ifdef PROBE_SYNC2
#define GSYNC() do { XSYNC1(); XSYNC1(); } while (0)
#else
#define GSYNC() XSYNC1()
#endif
__global__ void __launch_bounds__(NTHREADS, 2) fwd_megakernel(Params Parg) {
    KP P = kparams();
    extern __shared__ __attribute__((aligned(16))) unsigned char lds[];
    cg::grid_group grid = cg::this_grid();
    const int wave = __builtin_amdgcn_readfirstlane((int)threadIdx.x >> 6);
    const int tid = fresh_tid(wave), lane = tid & 63;
    const int G = gridDim.x, bx = blockIdx.x;
    const int gw = bx * NWAVES + wave, ngw = G * NWAVES;
    const int gt = bx * NTHREADS + tid, ngt = G * NTHREADS;
    unsigned char* ws = P->ws;
    bf16* XA = (bf16*)(ws + WS_XA); bf16* XB2 = (bf16*)(ws + WS_PROJ); bf16* PROJ = (bf16*)(ws + WS_PROJ); bf16* GU = (bf16*)(ws + WS_GU);
    float* SSQ = (float*)(ws + WS_SSQ); float* GB = (float*)(ws + WS_GB); float* WAB = (float*)(ws + WS_WAB);
    float* XRES = P->out;
    float* wscr = (float*)(lds + wave * 16384);
    volatile LAS unsigned* xst = (volatile LAS unsigned*)((LAS unsigned char*)lds + (LDS_BYTES - 64));
    if (tid < 16) xst[tid] = 0u;
    __syncthreads();
    (void)xcd_barrier_post((unsigned*)(ws + WS_BAR), xst);

    for (int i = gt; i < 4 * M; i += ngt) SSQ[M + i] = 0.f;
    for (int i = gt; i < MS * D / 4; i += ngt) ((f32x4*)(XRES + (size_t)MP * D))[i] = ((const f32x4*)P->in[1])[i];
    for (int i = gt; i < 2 * 8 * D; i += ngt) { const int l = i >> 13, j = (i >> 10) & 7, k = i & 1023; WAB[i] = P->in[7][l * D + k] * P->in[8][(size_t)l * D * DIN + (size_t)k * DIN + 2048 + j]; }
    convert_win(P, 0, wscr, gw, ngw, lane);
    convert_layer_rest(P, 0, wscr, gw, ngw, lane);
    convert_layer_rest(P, 1, wscr, gw, ngw, lane);
    for (int m0 = gw; m0 < M; m0 += 2 * ngw) {
        f32x4 v[2][4];
#pragma unroll
        for (int q = 0; q < 2; ++q) { const int m = m0 + q * ngw;
            const float* xr = m < MP ? P->in[0] + (size_t)m * D : P->in[1] + (size_t)((m < M ? m : M - 1) - MP) * D;
#pragma unroll
            for (int j = 0; j < 4; ++j) v[q][j] = ((const f32x4*)xr)[lane + 64 * j]; }
#pragma unroll
        for (int q = 0; q < 2; ++q) { const int m = m0 + q * ngw;
            if (m < M) {
                float ss = 0.f;
#pragma unroll
                for (int j = 0; j < 4; ++j) { const f32x4 w4 = v[q][j]; ss += w4[0] * w4[0] + w4[1] * w4[1] + w4[2] * w4[2] + w4[3] * w4[3];
                    ((v2u*)(XA + (size_t)m * D))[lane + 64 * j] = (v2u){pk2(w4[0], w4[1]), pk2(w4[2], w4[3])}; }
                ss = wave_sum(ss);
                if (lane == 0) SSQ[m] = ss;
            } }
    }
    if (ws == nullptr) grid.sync();
    GSYNC();

#pragma unroll 1
    for (int l = 0; l < 2; ++l) {
#ifndef NO_P1
        {
            const bf16* gA = XA; const bf16* gB = (const bf16*)(ws + WS_WIN); LAUNDER(gA); LAUNDER(gB);
            pg8::Gemm g{gA, gB, M, NPROJ, D, D, D}; pg8::StaticOrder S; S.init(M, NPROJ, G, bx);
            EpiScale E{PROJ, NPROJ, SSQ + (size_t)(2 * l) * M};
            pg8::gemm_phase<EpiScale, pg8::StaticOrder, true, true>((PG8_LAS unsigned char*)lds, g, S, E, wave);
#ifdef PROBE_P1X2
            __syncthreads();
            pg8::gemm_phase<EpiScale, pg8::StaticOrder, true, true>((PG8_LAS unsigned char*)lds, g, S, E, wave);
#endif
        }
#endif
#ifndef NO_AB
        {
            const float* ssq = SSQ + (size_t)(2 * l) * M;
            const int nab = (G > 96 ? G - 48 : G), bab = (G > 96 ? bx - 48 : bx);
            const int tf = fresh_tid(wave), lane = tf & 63, gw = bab * NWAVES + __builtin_amdgcn_readfirstlane(tf >> 6), ngw = nab * NWAVES;
            if (bab >= 0)
            for (int m0 = gw; m0 < M; m0 += 2 * ngw) {
                v4u xq[2][2]; float sqv[2];
#pragma unroll
                for (int q = 0; q < 2; ++q) { const int m = (m0 + q * ngw) < M ? (m0 + q * ngw) : (M - 1);
                    const v4u* xr = (const v4u*)(XA + (size_t)m * D) + lane * 2; xq[q][0] = xr[0]; xq[q][1] = xr[1]; sqv[q] = ssq[m]; }
#pragma unroll
                for (int q = 0; q < 2; ++q) {
                    const int m = m0 + q * ngw;
                    float xf[16]; UNPACK8(xq[q][0], xf); UNPACK8(xq[q][1], xf + 8);
                    float dot[8];
#pragma unroll
                    for (int j = 0; j < 8; ++j) { const float* wp = WAB + (size_t)(l * 8 + j) * D + lane * 16; float s2 = 0.f;
#pragma unroll
                        for (int e = 0; e < 16; ++e) s2 += wp[e] * xf[e];
                        dot[j] = wave_sum(s2); }
                    float v = dot[0];
#pragma unroll
                    for (int j = 1; j < 8; ++j) v = (lane == j) ? dot[j] : v;
                    if (lane < 8 && m < M) {
                        v *= rsqrtf(sqv[q] * (1.f / D) + EPS);
                        const int hh = lane & 3; float r;
                        if (lane < 4) { const float xx = v + P->in[11][l * 4 + hh]; const float sp = fmaxf(xx, 0.f) + __logf(1.f + __expf(-fabsf(xx))); r = -__expf(P->in[10][l * 4 + hh]) * sp; }
                        else r = __builtin_amdgcn_rcpf(1.f + __expf(-v));
                        GB[(size_t)m * 8 + lane] = r;
                    }
                }
            }
        }
#endif
        GSYNC();
#ifndef NO_P2B
        { const int tf = fresh_tid(wave); for (int item = bx; item < 1024; item += G) p2b_item(P, l, item, lds, wave); }
#ifdef PROBE_P2B2
        __syncthreads(); { const int tf = fresh_tid(wave); for (int item = bx; item < 1024; item += G) p2b_item(P, l, item, lds, wave); }
#endif
#endif
        GSYNC();
#ifdef PROBE_SCAN2
        if (bx < 64) { scan_wg(P, l, bx, lds, fresh_tid(wave)); }
#endif
#ifndef NO_SCAN
        if (bx < 64) scan_wg(P, l, bx, lds, fresh_tid(wave));
#endif
        {
            unsigned* qctr = (unsigned*)(ws + WS_BAR) + 3600 + l;
            volatile unsigned* qslot = (volatile unsigned*)(lds + LDS_BYTES - 128);
            bool have_pw = false;
            for (;;) {
                const int tid = fresh_tid(wave);
                __syncthreads();
                if (tid == 0) *qslot = atomicAdd(qctr, 1u);
                __syncthreads();
                const int it = (int)*qslot;
                if (it >= 128 + 272 + 64) break;
                if (it < 128) { sample_delta(P, l, it, lds, wave); have_pw = false; }
                else if (it < 400) {
                    if (!have_pw) {
                        for (int i = tid; i < 16384; i += NTHREADS) { const int e = i & 63, c = (i >> 6) & 63, g = i >> 12; ((bf16*)(lds + PL_PW))[(g * 64 + e) * 72 + c] = (bf16)f2bf(P->in[13][(size_t)l * 16384 + i]); }
                        __syncthreads(); have_pw = true;
                    }
                    pool_tile(P, l, it - 128, lds, wave);
                } else state_copies(P, l, (it - 400) * NTHREADS + tid, 64 * NTHREADS);
            }
        }
        GSYNC();
        { const int tf = fresh_tid(wave); p2d(P, l, bx * NWAVES + __builtin_amdgcn_readfirstlane(tf >> 6), ngw, tf & 63); }
        GSYNC();
#ifdef PROBE_P2D2
        { const int tf = fresh_tid(wave); p2d(P, l, bx * NWAVES + __builtin_amdgcn_readfirstlane(tf >> 6), ngw, tf & 63); }
        GSYNC();
        { const int tf = fresh_tid(wave); p2d(P, l, bx * NWAVES + __builtin_amdgcn_readfirstlane(tf >> 6), ngw, tf & 63); }
        GSYNC();
        { const int tf = fresh_tid(wave); p2d(P, l, bx * NWAVES + __builtin_amdgcn_readfirstlane(tf >> 6), ngw, tf & 63); }
        GSYNC();
#endif
        {
            const bf16* gA = XA; const bf16* gB = (const bf16*)(ws + WS_WOUT) + (size_t)l * D * D; LAUNDER(gA); LAUNDER(gB);
            pg8::Gemm g{gA, gB, MP, D, D, D, D}; pg8::StaticOrder S; S.init(MP, D, G, bx);
            EpiResid E{l == 0 ? P->in[0] : XRES, l == 0 ? P->in[1] : XRES + (size_t)MP * D, XRES, XB2, SSQ + (size_t)(2 * l + 1) * M, 0};
            pg8::gemm_phase<EpiResid, pg8::StaticOrder, true, true>((PG8_LAS unsigned char*)lds, g, S, E, wave);
            const int ks = bx >> 4; const bf16* gA2 = XA + (size_t)MP * D + ks * 256; const bf16* gB2 = gB + ks * 256; LAUNDER(gA2); LAUNDER(gB2);
            pg8::Gemm g2{gA2, gB2, MS, D, 256, D, D}; SplitOrder S2{bx < 64 ? (bx & 15) : -1};
            EpiAtomic E2{(float*)(ws + WS_GU) + (size_t)ks * MS * D};
            pg8::gemm_phase<EpiAtomic, SplitOrder, true, true>((PG8_LAS unsigned char*)lds, g2, S2, E2, wave);
        }
        GSYNC();
        fin_sample(XRES + (size_t)MP * D, XB2 + (size_t)MP * D, SSQ + (size_t)(2 * l + 1) * M + MP, (const float*)(ws + WS_GU), 4, nullptr, 0, bx * NWAVES + wave, ngw, lane_id());
        GSYNC();
        {
            const bf16* gA = XB2; const bf16* gB = (const bf16*)(ws + WS_WGU) + (size_t)l * NGU * D; LAUNDER(gA); LAUNDER(gB);
            pg8::Gemm g{gA, gB, M, NGU, D, D, D}; pg8::StaticOrder S; S.init(M, NGU, G, bx);
            EpiGateUp E{GU, SSQ + (size_t)(2 * l + 1) * M, P->in[19] + (size_t)(l * 3) * FF, P->in[6] + (size_t)l * DBATCH * 2 * FF, (float*)(ws + WS_HAL), (float*)(ws + WS_FIXG), (float*)(ws + WS_FIXU),
                        P->out + O_PFFN + (size_t)l * NBATCH * 2 * FF, P->out + O_SFFN + (size_t)l * DBATCH * 2 * FF, lds};
            pg8::gemm_phase<EpiGateUp, pg8::StaticOrder, true, true>((PG8_LAS unsigned char*)lds, g, S, E, wave);
#ifdef PROBE_P4X2
            __syncthreads();
            pg8::gemm_phase<EpiGateUp, pg8::StaticOrder, true, true>((PG8_LAS unsigned char*)lds, g, S, E, wave);
#endif
        }
        GSYNC();
        p4_fixup(P, l, bx * NTHREADS + fresh_tid(wave), ngt);
        if (l == 0) { const int tf = fresh_tid(wave); convert_win(P, 1, (float*)(lds + wave * 16384), bx * NWAVES + wave, ngw, tf & 63); }
        GSYNC();
        {
            const bf16* gA = GU; const bf16* gB = (const bf16*)(ws + WS_WDN) + (size_t)l * D * FF; LAUNDER(gA); LAUNDER(gB);
            pg8::Gemm g{gA, gB, MP, D, FF, FF, FF}; pg8::StaticOrder S; S.init(MP, D, G, bx);
            EpiResid E{XRES, XRES + (size_t)MP * D, XRES, XA, SSQ + (size_t)(2 * l + 2) * M, 0};
            pg8::gemm_phase<EpiResid, pg8::StaticOrder, true, true>((PG8_LAS unsigned char*)lds, g, S, E, wave);
            const int ks = bx >> 4; const bf16* gA2 = GU + (size_t)MP * FF + ks * 256; const bf16* gB2 = gB + ks * 256; LAUNDER(gA2); LAUNDER(gB2);
            pg8::Gemm g2{gA2, gB2, MS, D, 256, FF, FF}; SplitOrder S2{bx < 176 ? (bx & 15) : -1};
            EpiAtomic E2{ks < 8 ? (float*)(ws + WS_PROJ) + (size_t)ks * MS * D : (float*)(ws + WS_PART2) + (size_t)(ks - 8) * MS * D};
            pg8::gemm_phase<EpiAtomic, SplitOrder, true, true>((PG8_LAS unsigned char*)lds, g2, S2, E2, wave);
        }
        GSYNC();
        fin_sample(XRES + (size_t)MP * D, XA + (size_t)MP * D, SSQ + (size_t)(2 * l + 2) * M + MP, (const float*)(ws + WS_PROJ), 8, (const float*)(ws + WS_PART2), 3, bx * NWAVES + wave, ngw, lane_id());
        GSYNC();
    }
    {
        const float* ssq = SSQ + (size_t)4 * M; const float* fn = P->in[22];
        const int gt = bx * NTHREADS + fresh_tid(wave);
        for (int i0 = gt; i0 < M * 256; i0 += 4 * ngt) {
            f32x4 v[4]; float sq[4];
#pragma unroll
            for (int q = 0; q < 4; ++q) { const int i = i0 + q * ngt; v[q] = (f32x4){0.f, 0.f, 0.f, 0.f}; sq[q] = 1.f;
                if (i < M * 256) { v[q] = ((const f32x4*)XRES)[i]; sq[q] = ssq[i >> 8]; } }
#pragma unroll
            for (int q = 0; q < 4; ++q) { const int i = i0 + q * ngt;
                if (i < M * 256) { const float rs = rsqrtf(sq[q] * (1.f / D) + EPS); const f32x4 gv = ((const f32x4*)fn)[i & 255];
                    f32x4 o = v[q]; o[0] *= rs * gv[0]; o[1] *= rs * gv[1]; o[2] *= rs * gv[2]; o[3] *= rs * gv[3];
                    ((f32x4*)XRES)[i] = o; } }
        }
    }
}

extern "C" void kernel_launch(void* const* d_in, const int* in_sizes, int n_in, void* d_out, int out_size, void* d_ws, size_t ws_size, hipStream_t stream) {
    static int grid = 0;
    if (grid == 0) {
        if (n_in != 23 || (size_t)out_size != O_TOTAL || ws_size < WS_END) { fprintf(stderr, "kernel_launch: unexpected shapes: n_in %d out %d ws %zu\n", n_in, out_size, ws_size); grid = -1; return; }
        int dev = 0, cus = 0, per_cu = 0;
        hipGetDevice(&dev); hipDeviceGetAttribute(&cus, hipDeviceAttributeMultiprocessorCount, dev);
        if (hipFuncSetAttribute((const void*)fwd_megakernel, hipFuncAttributeMaxDynamicSharedMemorySize, LDS_BYTES) != hipSuccess) { fprintf(stderr, "kernel_launch: hipFuncSetAttribute failed\n"); grid = -1; return; }
        hipOccupancyMaxActiveBlocksPerMultiprocessor(&per_cu, (const void*)fwd_megakernel, NTHREADS, LDS_BYTES);
        (void)hipGetLastError();
        if (per_cu < 1) fprintf(stderr, "kernel_launch: occupancy query reports %d blocks per CU\n", per_cu);
        grid = cus;
    }
    if (grid < 0) return;
    if (hipMemsetAsync((char*)d_ws + WS_BAR, 0, 16384, stream) != hipSuccess) { fprintf(stderr, "kernel_launch: memset failed\n"); return; }
    Params p{};
    for (int i = 0; i < 23; ++i) p.in[i] = (const float*)d_in[i];
    p.out = (float*)d_out; p.ws = (unsigned char*)d_ws;
    void* args[] = {&p};
    hipError_t e = hipLaunchCooperativeKernel((const void*)fwd_megakernel, dim3(grid), dim3(NTHREADS), args, LDS_BYTES, stream);
    if (e != hipSuccess) fprintf(stderr, "cooperative launch failed: %s (grid %d)\n", hipGetErrorString(e), grid);
}
```

```cpp
#include <hip/hip_runtime.h>
#include <hip/hip_cooperative_groups.h>
#include <cstdio>
#include <cstdint>
namespace cg = cooperative_groups;
__device__ __forceinline__ int lane_id() { int t; asm volatile("v_mbcnt_lo_u32_b32 %0, -1, 0\n\tv_mbcnt_hi_u32_b32 %0, -1, %0" : "=v"(t)); return t; }
__device__ __forceinline__ int fresh_tid(int wave) { return (wave << 6) | lane_id(); }
namespace pg8 {
#define PG8_LAS __attribute__((address_space(3)))
typedef unsigned short bf16_t;
typedef short bf16x8 __attribute__((ext_vector_type(8)));
typedef float f32x4 __attribute__((ext_vector_type(4)));
typedef unsigned u32x4 __attribute__((ext_vector_type(4)));
constexpr int BM = 256, BK = 64, HALF = 128, HTB = HALF * BK * 2  , STAGE_BYTES = 8 * HTB, NXCD = 8, WGM = 8;

__host__ __device__ __forceinline__ int lds_byte(int r, int c) { const int st = (r >> 4) * 2 + (c >> 5), rr = r & 15, cc = c & 31, ob = rr * 64 + cc * 2; return st * 1024 + (ob ^ (((ob >> 9) & 1) << 5)); }
__host__ __device__ __forceinline__ void stage_rc(int b, int& R, int& C) { const int st = b / 1024, sb = b % 1024, swz = sb ^ (((sb >> 9) & 1) << 5); R = (st >> 1) * 16 + swz / 64; C = (st & 1) * 32 + (swz % 64) / 2; }
__host__ __device__ __forceinline__ int perm32(int rho) { const int n = rho >> 4, i = rho & 15; return 8 * (i >> 2) + 4 * n + (i & 3); }

struct Unit { int pm, pn; };
struct Gemm { const bf16_t* A; const bf16_t* Bt; int M, N, K, lda, ldb; };

struct StaticOrder {
    int nM, nN, nwg, G, c;
    __host__ __device__ void init(int M, int N, int G_, int c_) { nM = M / BM; nN = N / BM; nwg = nM * nN; G = G_; c = c_; }
    __host__ __device__ bool next(int i, Unit& u) const {
        const long L = (long)i * G + c; if (L >= nwg) return false;
        int wgid = (int)L; { const int q = nwg / NXCD, r = nwg % NXCD, xcd = wgid % NXCD, off = wgid / NXCD; wgid = (xcd < r ? xcd * (q + 1) : r * (q + 1) + (xcd - r) * q) + off; }
        const int nig = WGM * nN, gid = wgid / nig, fm = gid * WGM, gsz = (nM - fm) < WGM ? (nM - fm) : WGM;
        u.pm = fm + ((wgid % nig) % gsz); u.pn = (wgid % nig) / gsz; return true;
    }
    __device__ __forceinline__ void a_ready(const Unit&) const {}
    __device__ __forceinline__ void done(const Unit&) const {}
};

template <class Epi, class Sched, bool ALIGN_EPI = false, bool SP2 = false>
__device__ __forceinline__ void gemm_phase(PG8_LAS unsigned char* lds, const Gemm g, const Sched& S, const Epi& E, const int wave_in) {
    const int tid = fresh_tid(wave_in), wid = __builtin_amdgcn_readfirstlane(tid >> 6), lane = tid & 63, wr = wid >> 2, wc = wid & 3, fr = lane & 15, fq = lane >> 4;
    const int K = g.K, nt = K / BK;
    unsigned voffA[2], voffB[2];
#pragma unroll
    for (int i = 0; i < 2; ++i) { int R, C; stage_rc(tid * 16 + i * 8192, R, C); const int Rb = Epi::PERM ? ((R & ~31) + perm32(R & 31)) : R;
        voffA[i] = (unsigned)(R * g.lda + C) * 2u; voffB[i] = (unsigned)(Rb * g.ldb + C) * 2u; }
    const size_t kstep = (size_t)(BK * 2);
    const size_t hstepA = (size_t)HALF * g.lda * 2, hstepB = (size_t)HALF * g.ldb * 2;
    const size_t tstepA = 2 * hstepA, tstepB = 2 * hstepB;
    const unsigned ldsw = (unsigned)wid * 1024u;
    const int aoff = lds_byte(wr * 64 + fr, fq * 8), boff = lds_byte(wc * 32 + fr, fq * 8);
#define PG8_SA(b, h) (((b) * 2 + (h)) * HTB)
#define PG8_SB(b, h) ((4 + (b) * 2 + (h)) * HTB)
#define PG8_STAGE(bufoff, gbase, voff) do { _Pragma("unroll") for (int _i = 0; _i < 2; ++_i) \
        __builtin_amdgcn_global_load_lds((const unsigned*)((const char*)(gbase) + (voff)[_i]), (PG8_LAS unsigned*)(lds + (bufoff) + ldsw + _i * 8192), 16, 0, 0); } while (0)
#define PG8_LDA(dst, b, h) do { _Pragma("unroll") for (int m = 0; m < 4; ++m) _Pragma("unroll") for (int k = 0; k < 2; ++k) dst[m][k] = *(const PG8_LAS bf16x8*)(lds + PG8_SA(b, h) + aoff + m * 2048 + k * 1024); } while (0)
#define PG8_LDB(dst, b, h) do { _Pragma("unroll") for (int n = 0; n < 2; ++n) _Pragma("unroll") for (int k = 0; k < 2; ++k) dst[n][k] = *(const PG8_LAS bf16x8*)(lds + PG8_SB(b, h) + boff + n * 2048 + k * 1024); } while (0)
#define PG8_MMA(ai, bj, At, Bt) do { __builtin_amdgcn_s_setprio(1); _Pragma("unroll") for (int m = 0; m < 4; ++m) _Pragma("unroll") for (int n = 0; n < 2; ++n) _Pragma("unroll") for (int k = 0; k < 2; ++k) \
        acc[ai][bj][m][n] = __builtin_amdgcn_mfma_f32_16x16x32_bf16(Bt[n][k], At[m][k], acc[ai][bj][m][n], 0, 0, 0); __builtin_amdgcn_s_setprio(0); } while (0)
#define PG8_WAIT_V(n) asm volatile("s_waitcnt vmcnt(" #n ")" ::: "memory")
#define PG8_WAIT_L(n) asm volatile("s_waitcnt lgkmcnt(" #n ")" ::: "memory")
#define PG8_BAR __builtin_amdgcn_s_barrier()
#define PG8_SCHED __builtin_amdgcn_sched_barrier(0)
    Unit cur, nxt; int ui = 0;
    if (!S.next(0, cur)) return;
    f32x4 acc[2][2][4][2];
#pragma unroll
    for (int a = 0; a < 2; ++a)
#pragma unroll
        for (int b = 0; b < 2; ++b)
#pragma unroll
            for (int m = 0; m < 4; ++m)
#pragma unroll
                for (int n = 0; n < 2; ++n) acc[a][b][m][n] = (f32x4){0.f, 0.f, 0.f, 0.f};
    bf16x8 At[4][2], B0[2][2], B1[2][2];
    const char* cA = (const char*)g.A + (size_t)cur.pm * tstepA; const char* cB = (const char*)g.Bt + (size_t)cur.pn * tstepB;
    S.a_ready(cur);
    if constexpr (SP2) {
        PG8_STAGE(PG8_SB(0, 0), cB, voffB); PG8_STAGE(PG8_SB(0, 1), cB + hstepB, voffB); PG8_STAGE(PG8_SA(0, 0), cA, voffA); PG8_STAGE(PG8_SA(0, 1), cA + hstepA, voffA);
        if (wr == 1) PG8_BAR;
        PG8_WAIT_V(2); PG8_BAR;
        PG8_STAGE(PG8_SB(1, 0), cB + kstep, voffB); PG8_STAGE(PG8_SA(1, 0), cA + kstep, voffA); PG8_STAGE(PG8_SB(1, 1), cB + hstepB + kstep, voffB);
        PG8_WAIT_V(6); PG8_BAR;
    } else {
        PG8_STAGE(PG8_SB(0, 0), cB, voffB); PG8_STAGE(PG8_SA(0, 0), cA, voffA); PG8_STAGE(PG8_SB(0, 1), cB + hstepB, voffB); PG8_STAGE(PG8_SA(0, 1), cA + hstepA, voffA);
        if (wr == 1) PG8_BAR;
        PG8_WAIT_V(4); PG8_BAR;
        PG8_STAGE(PG8_SB(1, 0), cB + kstep, voffB); PG8_STAGE(PG8_SA(1, 0), cA + kstep, voffA); PG8_STAGE(PG8_SB(1, 1), cB + hstepB + kstep, voffB);
        PG8_WAIT_V(6); PG8_BAR;
    }
    for (;;) {
        const bool has_next = S.next(ui + 1, nxt);
        const char* nA = has_next ? (const char*)g.A + (size_t)nxt.pm * tstepA : cA; const char* nB = has_next ? (const char*)g.Bt + (size_t)nxt.pn * tstepB : cB;
        for (int t = 0; t < nt; t += 2) {
            const bool last = (t == nt - 2);
            const char* a1 = cA + (size_t)(t + 1) * kstep;
            const char* a2 = last ? nA : cA + (size_t)(t + 2) * kstep; const char* b2 = last ? nB : cB + (size_t)(t + 2) * kstep;
            const char* a3 = a2 + kstep; const char* b3 = b2 + kstep;
            if (last && has_next) S.a_ready(nxt);
            if constexpr (SP2) {
            PG8_LDB(B0, 0, 0); PG8_LDB(B1, 0, 1); PG8_SCHED; PG8_LDA(At, 0, 0); PG8_STAGE(PG8_SA(1, 1), a1 + hstepA, voffA);
            PG8_WAIT_V(8); PG8_WAIT_L(0); PG8_BAR; PG8_MMA(0, 0, At, B0); PG8_MMA(0, 1, At, B1); PG8_BAR; PG8_SCHED;
            PG8_LDA(At, 0, 1); PG8_STAGE(PG8_SB(0, 0), b2, voffB); PG8_STAGE(PG8_SB(0, 1), b2 + hstepB, voffB); PG8_STAGE(PG8_SA(0, 0), a2, voffA);
            PG8_WAIT_V(8); PG8_WAIT_L(0); PG8_BAR; PG8_MMA(1, 0, At, B0); PG8_MMA(1, 1, At, B1); PG8_BAR; PG8_SCHED;
            PG8_LDB(B0, 1, 0); PG8_LDB(B1, 1, 1); PG8_SCHED; PG8_LDA(At, 1, 0); PG8_STAGE(PG8_SA(0, 1), a2 + hstepA, voffA);
            PG8_WAIT_V(8); PG8_WAIT_L(0); PG8_BAR; PG8_MMA(0, 0, At, B0); PG8_MMA(0, 1, At, B1); PG8_BAR; PG8_SCHED;
            PG8_LDA(At, 1, 1); PG8_STAGE(PG8_SB(1, 0), b3, voffB); PG8_STAGE(PG8_SB(1, 1), b3 + hstepB, voffB); PG8_STAGE(PG8_SA(1, 0), a3, voffA);
            PG8_WAIT_V(8); PG8_WAIT_L(0); PG8_BAR; PG8_MMA(1, 0, At, B0); PG8_MMA(1, 1, At, B1); PG8_BAR; PG8_SCHED;
            } else {
            PG8_LDB(B0, 0, 0); PG8_SCHED; PG8_LDA(At, 0, 0); PG8_STAGE(PG8_SA(1, 1), a1 + hstepA, voffA);
            PG8_WAIT_L(8); PG8_BAR; PG8_WAIT_L(0); PG8_MMA(0, 0, At, B0); PG8_BAR; PG8_SCHED;
            PG8_LDB(B1, 0, 1); PG8_STAGE(PG8_SB(0, 0), b2, voffB);
            PG8_BAR; PG8_WAIT_L(0); PG8_MMA(0, 1, At, B1); PG8_BAR;
            PG8_LDA(At, 0, 1); PG8_STAGE(PG8_SA(0, 0), a2, voffA);
            PG8_BAR; PG8_WAIT_L(0); PG8_MMA(1, 0, At, B0); PG8_BAR; PG8_SCHED;
            PG8_STAGE(PG8_SB(0, 1), b2 + hstepB, voffB);
            PG8_WAIT_V(6); PG8_BAR; PG8_MMA(1, 1, At, B1); PG8_BAR;
            PG8_LDB(B0, 1, 0); PG8_SCHED; PG8_LDA(At, 1, 0); PG8_STAGE(PG8_SA(0, 1), a2 + hstepA, voffA);
            PG8_WAIT_L(8); PG8_BAR; PG8_WAIT_L(0); PG8_MMA(0, 0, At, B0); PG8_BAR; PG8_SCHED;
            PG8_LDB(B1, 1, 1); PG8_STAGE(PG8_SB(1, 0), b3, voffB);
            PG8_BAR; PG8_WAIT_L(0); PG8_MMA(0, 1, At, B1); PG8_BAR;
            PG8_LDA(At, 1, 1); PG8_STAGE(PG8_SA(1, 0), a3, voffA);
            PG8_BAR; PG8_WAIT_L(0); PG8_MMA(1, 0, At, B0); PG8_BAR; PG8_SCHED;
            PG8_STAGE(PG8_SB(1, 1), b3 + hstepB, voffB);
            PG8_WAIT_V(6); PG8_BAR; PG8_MMA(1, 1, At, B1); PG8_BAR;
            }
        }
        if constexpr (ALIGN_EPI) { if (wr == 0) PG8_BAR; }
        if constexpr (!Epi::AFTER_DRAIN) { E(acc, cur, wr, wc, fr, fq); S.done(cur); }
        if (!has_next) break;
#pragma unroll
        for (int a = 0; a < 2; ++a)
#pragma unroll
            for (int b = 0; b < 2; ++b)
#pragma unroll
                for (int m = 0; m < 4; ++m)
#pragma unroll
                    for (int n = 0; n < 2; ++n) acc[a][b][m][n] = (f32x4){0.f, 0.f, 0.f, 0.f};
        cur = nxt; cA = nA; cB = nB; ++ui;
        if constexpr (ALIGN_EPI) { if (wr == 1) PG8_BAR; }
    }
    PG8_WAIT_V(0);
    if constexpr (!ALIGN_EPI) { if (wr == 0) PG8_BAR; }
    PG8_BAR;
    if constexpr (Epi::AFTER_DRAIN) { E.fused(acc, cur, wr, wc, fr, fq, lds, wid, lane); S.done(cur); }
#undef PG8_SA
#undef PG8_SB
#undef PG8_STAGE
#undef PG8_LDA
#undef PG8_LDB
#undef PG8_MMA
#undef PG8_WAIT_V
#undef PG8_WAIT_L
#undef PG8_BAR
#undef PG8_SCHED
}
}

typedef unsigned short bf16;
typedef unsigned v4u __attribute__((ext_vector_type(4)));
typedef unsigned v2u __attribute__((ext_vector_type(2)));
typedef float f32x4 __attribute__((ext_vector_type(4)));
typedef short bf16x8 __attribute__((ext_vector_type(8)));

constexpr int D = 1024, MP = 16384, MS = 1024, M = MP + MS, SEQL = 2048, NBATCH = 8, DBATCH = 128;
constexpr int NPROJ = 3072, FF = 2816, NGU = 5632, DIN = 3080, MH = M / 2;
constexpr float EPS = 1e-6f;
constexpr int NTHREADS = 512, NWAVES = 8;
constexpr int LDS_BYTES = 155648;
constexpr size_t MiB = 1u << 20;
constexpr size_t WS_WOUT = 0, WS_WGU = 4 * MiB, WS_WDN = 26 * MiB, WS_XA = 37 * MiB, WS_PROJ = 71 * MiB, WS_GU = 105 * MiB, WS_SCR = 173 * MiB, WS_WIN = 239 * MiB;
constexpr size_t WS_GB = 245 * MiB, WS_SSQ = 245 * MiB + 576 * 1024, WS_WAB = 246 * MiB, WS_GL = 246 * MiB + 64 * 1024, WS_HALO = 246 * MiB + 128 * 1024, WS_BAR = 246 * MiB + 192 * 1024, WS_PART2 = 200 * MiB, WS_HAL = 247 * MiB, WS_FIXG = 249 * MiB, WS_FIXU = 251 * MiB, WS_END = 253 * MiB;
constexpr int SCR_ITEM = 73728;
constexpr size_t O_PDELTA = 17825792, O_PDCONV = 18874368, O_PPOOL = 18948096, O_PSCONV = 19009536, O_PFFN = 19017728;
constexpr size_t O_SDELTA = 19107840, O_SDCONV = 35885056, O_SPOOL = 37064704, O_SSCONV = 38047744, O_SFFN = 38178816, O_TOTAL = 39620608;

struct Params { const float* in[23]; float* out; unsigned char* ws; };
typedef const __attribute__((address_space(4))) Params* KP;
__device__ __forceinline__ KP kparams() { KP p = (KP)__builtin_amdgcn_kernarg_segment_ptr(); asm volatile("" : "+s"(p)); return p; }

#define LAUNDER(p) asm volatile("" : "+s"(p))
#define LDS_WAIT() asm volatile("s_waitcnt lgkmcnt(0)" ::: "memory")
__device__ __forceinline__ unsigned f2bf(float f) { unsigned u = __builtin_bit_cast(unsigned, f); return (u + 0x7fffu + ((u >> 16) & 1u)) >> 16; }
__device__ __forceinline__ unsigned pk2(float lo, float hi) { return f2bf(lo) | (f2bf(hi) << 16); }
__device__ __forceinline__ float bflo(unsigned u) { return __builtin_bit_cast(float, u << 16); }
__device__ __forceinline__ float bfhi(unsigned u) { return __builtin_bit_cast(float, u & 0xffff0000u); }
__device__ __forceinline__ float bf1(bf16 h) { return __builtin_bit_cast(float, ((unsigned)h) << 16); }
__device__ __forceinline__ float siluf(float x) { return x * __builtin_amdgcn_rcpf(1.f + __expf(-x)); }
__device__ __forceinline__ float shx(float v, int m) { return __builtin_bit_cast(float, __builtin_amdgcn_ds_bpermute((lane_id() ^ m) << 2, __builtin_bit_cast(int, v))); }
__device__ __forceinline__ float rdl(float v, int l) { return __builtin_bit_cast(float, __builtin_amdgcn_readlane(__builtin_bit_cast(int, v), l)); }
template <int CTRL> __device__ __forceinline__ float dpp_mov(float v) { const int i = __builtin_bit_cast(int, v); return __builtin_bit_cast(float, __builtin_amdgcn_update_dpp(i, i, CTRL, 0xf, 0xf, false)); }
__device__ __forceinline__ float wave_sum(float v) {
    v += dpp_mov<0x128>(v); v += dpp_mov<0x124>(v); v += dpp_mov<0x122>(v); v += dpp_mov<0x121>(v);
    const int i = __builtin_bit_cast(int, v);
    return (__builtin_bit_cast(float, __builtin_amdgcn_readlane(i, 0)) + __builtin_bit_cast(float, __builtin_amdgcn_readlane(i, 16))) +
           (__builtin_bit_cast(float, __builtin_amdgcn_readlane(i, 32)) + __builtin_bit_cast(float, __builtin_amdgcn_readlane(i, 48)));
}
#define UNPACK8(W_, F_) do { (F_)[0] = bflo((W_).x); (F_)[1] = bfhi((W_).x); (F_)[2] = bflo((W_).y); (F_)[3] = bfhi((W_).y); (F_)[4] = bflo((W_).z); (F_)[5] = bfhi((W_).z); (F_)[6] = bflo((W_).w); (F_)[7] = bfhi((W_).w); } while (0)
#define PACK8(F_) ((v4u){pk2((F_)[0], (F_)[1]), pk2((F_)[2], (F_)[3]), pk2((F_)[4], (F_)[5]), pk2((F_)[6], (F_)[7])})

struct EpiScale {
    static constexpr bool PERM = true, AFTER_DRAIN = false;
    bf16* O; int ldc; const float* ssq;
    __device__ __forceinline__ void operator()(const pg8::f32x4 (&acc)[2][2][4][2], const pg8::Unit& u, int wr, int wc, int fr, int fq) const {
        const int row0 = u.pm * 256 + wr * 64 + fr, col0 = u.pn * 256 + wc * 32 + 8 * fq;
        float sq[2][4];
#pragma unroll
        for (int ai = 0; ai < 2; ++ai)
#pragma unroll
            for (int m = 0; m < 4; ++m) sq[ai][m] = ssq[row0 + ai * 128 + m * 16];
#pragma unroll
        for (int ai = 0; ai < 2; ++ai)
#pragma unroll
            for (int m = 0; m < 4; ++m) {
                const int row = row0 + ai * 128 + m * 16;
                const float rs = rsqrtf(sq[ai][m] * (1.f / D) + EPS);
                bf16* rowp = O + (size_t)row * ldc + col0;
#pragma unroll
                for (int bj = 0; bj < 2; ++bj) {
                    pg8::f32x4 v0 = acc[ai][bj][m][0] * rs, v1 = acc[ai][bj][m][1] * rs;
                    v4u w; w.x = pk2(v0[0], v0[1]); w.y = pk2(v0[2], v0[3]); w.z = pk2(v1[0], v1[1]); w.w = pk2(v1[2], v1[3]);
                    *(v4u*)(rowp + bj * 128) = w;
                }
            }
    }
};
struct EpiResid {
    static constexpr bool PERM = true, AFTER_DRAIN = false;
    const float* xa; const float* xb_; float* xres; bf16* xb16; float* ssq; int rowbase;
    __device__ __forceinline__ void operator()(const pg8::f32x4 (&acc)[2][2][4][2], const pg8::Unit& u, int wr, int wc, int fr, int fq) const {
        const int row0 = rowbase + u.pm * 256 + wr * 64 + fr, col0 = u.pn * 256 + wc * 32 + 8 * fq;
#pragma unroll
        for (int ai = 0; ai < 2; ++ai) {
            pg8::f32x4 xo4[4][4];
#pragma unroll
            for (int m = 0; m < 4; ++m) {
                const int row = row0 + ai * 128 + m * 16;
                const float* xo = (row < MP ? xa + (size_t)row * D : xb_ + (size_t)(row - MP) * D) + col0;
                xo4[m][0] = *(const pg8::f32x4*)xo; xo4[m][1] = *(const pg8::f32x4*)(xo + 4); xo4[m][2] = *(const pg8::f32x4*)(xo + 128); xo4[m][3] = *(const pg8::f32x4*)(xo + 132);
            }
#pragma unroll
            for (int m = 0; m < 4; ++m) {
                const int row = row0 + ai * 128 + m * 16;
                float* xr = xres + (size_t)row * D + col0;
                bf16* xh = xb16 + (size_t)row * D + col0;
                float ss = 0.f;
#pragma unroll
                for (int bj = 0; bj < 2; ++bj) {
                    pg8::f32x4 v0 = acc[ai][bj][m][0] + xo4[m][2 * bj], v1 = acc[ai][bj][m][1] + xo4[m][2 * bj + 1];
                    *(pg8::f32x4*)(xr + bj * 128) = v0; *(pg8::f32x4*)(xr + bj * 128 + 4) = v1;
                    v4u w; w.x = pk2(v0[0], v0[1]); w.y = pk2(v0[2], v0[3]); w.z = pk2(v1[0], v1[1]); w.w = pk2(v1[2], v1[3]);
                    *(v4u*)(xh + bj * 128) = w;
                    ss += v0[0] * v0[0] + v0[1] * v0[1] + v0[2] * v0[2] + v0[3] * v0[3] + v1[0] * v1[0] + v1[1] * v1[1] + v1[2] * v1[2] + v1[3] * v1[3];
                }
                ss += shx(ss, 16); ss += shx(ss, 32);
                if (fq == 0) atomicAdd(ssq + row, ss);
            }
        }
    }
};


struct SplitOrder {
    int unit;
    __device__ __forceinline__ bool next(int i, pg8::Unit& u) const { if (i != 0 || unit < 0) return false; u.pm = unit >> 2; u.pn = unit & 3; return true; }
    __device__ __forceinline__ void a_ready(const pg8::Unit&) const {}
    __device__ __forceinline__ void done(const pg8::Unit&) const {}
};
struct EpiAtomic {
    static constexpr bool PERM = true, AFTER_DRAIN = false;
    float* X;
    __device__ __forceinline__ void operator()(const pg8::f32x4 (&acc)[2][2][4][2], const pg8::Unit& u, int wr, int wc, int fr, int fq) const {
        const int row0 = u.pm * 256 + wr * 64 + fr, col0 = u.pn * 256 + wc * 32 + 8 * fq;
#pragma unroll
        for (int ai = 0; ai < 2; ++ai)
#pragma unroll
            for (int m = 0; m < 4; ++m) {
                float* xr = X + (size_t)(row0 + ai * 128 + m * 16) * D + col0;
#pragma unroll
                for (int bj = 0; bj < 2; ++bj) { *(pg8::f32x4*)(xr + bj * 128) = acc[ai][bj][m][0]; *(pg8::f32x4*)(xr + bj * 128 + 4) = acc[ai][bj][m][1]; }
            }
    }
};
__device__ __forceinline__ void fin_sample(float* X, bf16* XB, float* ssq, const float* partA, int nA, const float* partB, int nB, int gw, int ngw, int lane) {
    for (int r = gw; r < MS; r += ngw) {
        f32x4 v[4];
#pragma unroll
        for (int j = 0; j < 4; ++j) v[j] = ((const f32x4*)(X + (size_t)r * D))[lane + 64 * j];
        for (int k = 0; k < nA; ++k) {
#pragma unroll
            for (int j = 0; j < 4; ++j) v[j] += ((const f32x4*)(partA + ((size_t)k * MS + r) * D))[lane + 64 * j];
        }
        for (int k = 0; k < nB; ++k) {
#pragma unroll
            for (int j = 0; j < 4; ++j) v[j] += ((const f32x4*)(partB + ((size_t)k * MS + r) * D))[lane + 64 * j];
        }
        float ss = 0.f;
#pragma unroll
        for (int j = 0; j < 4; ++j) { ss += v[j][0] * v[j][0] + v[j][1] * v[j][1] + v[j][2] * v[j][2] + v[j][3] * v[j][3];
            ((f32x4*)(X + (size_t)r * D))[lane + 64 * j] = v[j];
            ((v2u*)(XB + (size_t)r * D))[lane + 64 * j] = (v2u){pk2(v[j][0], v[j][1]), pk2(v[j][2], v[j][3])}; }
        ss = wave_sum(ss);
        if (lane == 0) ssq[r] = ss;
    }
}

constexpr int EPI_HALO_OFF = 131072;
__device__ __forceinline__ float dpp_f(float oldv, float src, const int ctrl_sel) {
    const int o = __builtin_bit_cast(int, oldv), v = __builtin_bit_cast(int, src); int r;
    if (ctrl_sel == 0) r = __builtin_amdgcn_update_dpp(o, v, 0x111, 0xf, 0xf, false);
    else if (ctrl_sel == 1) r = __builtin_amdgcn_update_dpp(o, v, 0x112, 0xf, 0xf, false);
    else if (ctrl_sel == 2) r = __builtin_amdgcn_update_dpp(o, v, 0x121, 0xf, 0xf, false);
    else r = __builtin_amdgcn_update_dpp(o, v, 0x122, 0xf, 0xf, false);
    return __builtin_bit_cast(float, r);
}
struct EpiGateUp {
    static constexpr bool PERM = true, AFTER_DRAIN = false;
    bf16* ACT; const float* ssq; const float* cw; const float* st; float* HAL; float* FIXG; float* FIXU; float* pffn; float* sffn; unsigned char* lds;
    __device__ __forceinline__ void operator()(const pg8::f32x4 (&acc)[2][2][4][2], const pg8::Unit& u, int wr, int wc, int fr, int fq) const {
        const int pm = u.pm, ch0 = u.pn * 128 + wc * 32 + 8 * fq, row0 = pm * 256 + wr * 64 + fr;
        const bool smp = pm >= 64;
        float* halo = (float*)(lds + EPI_HALO_OFF);
#pragma unroll
        for (int ai = 0; ai < 2; ++ai) {
            const float rs = rsqrtf(ssq[row0 + ai * 128 + 48] * (1.f / D) + EPS);
            if (fr >= 14) {
                float* hp = halo + ((ai * 2 + wr) * 2 + (fr - 14)) * 128 + wc * 32 + 8 * fq;
                *(pg8::f32x4*)hp = acc[ai][0][3][0] * rs; *(pg8::f32x4*)(hp + 4) = acc[ai][0][3][1] * rs;
            }
        }
        asm volatile("s_waitcnt lgkmcnt(0)" ::: "memory");
        __builtin_amdgcn_s_barrier();
        float w0[8], w1[8], w2[8];
#pragma unroll
        for (int e = 0; e < 8; ++e) { w0[e] = cw[ch0 + e]; w1[e] = cw[FF + ch0 + e]; w2[e] = cw[2 * FF + ch0 + e]; }
#pragma unroll
        for (int ai = 0; ai < 2; ++ai) {
            const int s = ai * 2 + wr;
            float prev[8];
#pragma unroll
            for (int e = 0; e < 8; ++e) prev[e] = 0.f;
            if (!smp && s >= 1 && fr >= 14) {
                const float* hp = halo + ((s - 1) * 2 + (fr - 14)) * 128 + wc * 32 + 8 * fq;
                const pg8::f32x4 h0 = *(const pg8::f32x4*)hp, h1 = *(const pg8::f32x4*)(hp + 4);
                prev[0] = h0[0]; prev[1] = h0[1]; prev[2] = h0[2]; prev[3] = h0[3]; prev[4] = h1[0]; prev[5] = h1[1]; prev[6] = h1[2]; prev[7] = h1[3];
            }
            float sq4[4];
#pragma unroll
            for (int m = 0; m < 4; ++m) sq4[m] = ssq[row0 + ai * 128 + m * 16];
#pragma unroll
            for (int m = 0; m < 4; ++m) {
                const int row = row0 + ai * 128 + m * 16;
                const float rs = rsqrtf(sq4[m] * (1.f / D) + EPS);
                float cur[8], upv[8], s0v[8], s1v[8];
#pragma unroll
                for (int e = 0; e < 8; ++e) { cur[e] = acc[ai][0][m][e >> 2][e & 3] * rs; upv[e] = acc[ai][1][m][e >> 2][e & 3] * rs; s0v[e] = 0.f; s1v[e] = 0.f; }
                const int t = fr & 7, sb = (row - MP) >> 3;
                if (smp && t < 2) {
                    const float* sp = st + (size_t)(sb * 2) * FF + ch0;
#pragma unroll
                    for (int e = 0; e < 8; ++e) { s0v[e] = sp[e]; s1v[e] = sp[FF + e]; }
                }
                float a[8];
#pragma unroll
                for (int e = 0; e < 8; ++e) {
                    const float sh1 = dpp_f(cur[e], cur[e], 0), sh2 = dpp_f(cur[e], cur[e], 1), ro1 = dpp_f(prev[e], prev[e], 2), ro2 = dpp_f(prev[e], prev[e], 3);
                    float p1, p2;
                    if (smp) { p1 = t >= 1 ? sh1 : s1v[e]; p2 = t >= 2 ? sh2 : (t == 1 ? s1v[e] : s0v[e]); }
                    else { p1 = fr >= 1 ? sh1 : ro1; p2 = fr >= 2 ? sh2 : ro2; }
                    a[e] = siluf(w0[e] * p2 + w1[e] * p1 + w2[e] * cur[e]) * upv[e];
                }
                *(v4u*)(ACT + (size_t)row * FF + ch0) = PACK8(a);
                if (smp) {
                    if (t >= 6) { float* o = sffn + (size_t)(sb * 2 + t - 6) * FF + ch0;
                        *(pg8::f32x4*)o = (pg8::f32x4){cur[0], cur[1], cur[2], cur[3]}; *(pg8::f32x4*)(o + 4) = (pg8::f32x4){cur[4], cur[5], cur[6], cur[7]}; }
                } else {
                    if (s == 3 && m == 3 && fr >= 14) {
                        float* o = HAL + (size_t)(pm * 2 + fr - 14) * FF + ch0;
                        *(pg8::f32x4*)o = (pg8::f32x4){cur[0], cur[1], cur[2], cur[3]}; *(pg8::f32x4*)(o + 4) = (pg8::f32x4){cur[4], cur[5], cur[6], cur[7]};
                        if ((pm & 7) == 7) { float* o2 = pffn + (size_t)((pm >> 3) * 2 + fr - 14) * FF + ch0;
                            *(pg8::f32x4*)o2 = (pg8::f32x4){cur[0], cur[1], cur[2], cur[3]}; *(pg8::f32x4*)(o2 + 4) = (pg8::f32x4){cur[4], cur[5], cur[6], cur[7]}; }
                    }
                    if (s == 0 && m == 0 && fr < 2 && (pm & 7) != 0) {
                        float* o = FIXG + (size_t)(pm * 2 + fr) * FF + ch0; float* o2 = FIXU + (size_t)(pm * 2 + fr) * FF + ch0;
                        *(pg8::f32x4*)o = (pg8::f32x4){cur[0], cur[1], cur[2], cur[3]}; *(pg8::f32x4*)(o + 4) = (pg8::f32x4){cur[4], cur[5], cur[6], cur[7]};
                        *(pg8::f32x4*)o2 = (pg8::f32x4){upv[0], upv[1], upv[2], upv[3]}; *(pg8::f32x4*)(o2 + 4) = (pg8::f32x4){upv[4], upv[5], upv[6], upv[7]};
                    }
                }
#pragma unroll
                for (int e = 0; e < 8; ++e) prev[e] = cur[e];
            }
        }
    }
};
__device__ __forceinline__ void p4_fixup(KP P, int l, int start, int stride) {
    const float* HAL = (const float*)(P->ws + WS_HAL); const float* FIXG = (const float*)(P->ws + WS_FIXG); const float* FIXU = (const float*)(P->ws + WS_FIXU);
    bf16* ACT = (bf16*)(P->ws + WS_GU);
    const float* cw = P->in[19] + (size_t)(l * 3) * FF;
    for (int idx = start; idx < 56 * 2 * FF; idx += stride) {
        const int k = idx / (2 * FF), rem = idx % (2 * FF), rr = rem / FF, c = rem % FF;
        const int pm = (k / 7) * 8 + 1 + (k % 7);
        const float g0 = FIXG[(size_t)(pm * 2 + rr) * FF + c];
        const float g1 = rr == 0 ? HAL[(size_t)((pm - 1) * 2 + 1) * FF + c] : FIXG[(size_t)(pm * 2) * FF + c];
        const float g2 = rr == 0 ? HAL[(size_t)((pm - 1) * 2) * FF + c] : HAL[(size_t)((pm - 1) * 2 + 1) * FF + c];
        const float a = siluf(cw[c] * g2 + cw[FF + c] * g1 + cw[2 * FF + c] * g0) * FIXU[(size_t)(pm * 2 + rr) * FF + c];
        ACT[(size_t)(pm * 256 + rr) * FF + c] = (bf16)f2bf(a);
    }
}
__device__ __forceinline__ void transpose_item(const float* W, int K, int ldw, int src_col0, const float* g, bf16* WT, int dst_row0, float* scr, int kb, int lane) {
    const int k0 = 64 * kb;
    float wv[32];
#pragma unroll
    for (int i = 0; i < 32; ++i) wv[i] = W[(size_t)(k0 + 2 * i + (lane >> 5)) * ldw + src_col0 + (lane & 31)];
#pragma unroll
    for (int i = 0; i < 32; ++i) { const int kk = 2 * i + (lane >> 5); const float gs = g ? g[k0 + kk] : 1.f; scr[kk * 33 + (lane & 31)] = wv[i] * gs; }
    LDS_WAIT();
    const int c = lane & 7;
#pragma unroll
    for (int j = 0; j < 4; ++j) { const int n = (lane >> 3) + 8 * j; const float* s = scr + (8 * c) * 33 + n;
        v4u o; o.x = pk2(s[0 * 33], s[1 * 33]); o.y = pk2(s[2 * 33], s[3 * 33]); o.z = pk2(s[4 * 33], s[5 * 33]); o.w = pk2(s[6 * 33], s[7 * 33]);
        *(v4u*)(WT + (size_t)(dst_row0 + n) * K + k0 + 8 * c) = o; }
    LDS_WAIT();
}
__device__ __forceinline__ void convert_matrix(const float* W, int K, int N, int ldw, int skip_from, int skip, const float* g, bf16* WT, int dst_row0, float* scr, int gw, int ngw, int lane, int il = 0) {
    const int nnb = N / 32, nit = (K / 64) * nnb;
    for (int it = gw; it < nit; it += ngw) {
        const int kb = it / nnb, nb = it % nnb, n0 = nb * 32;
        const int drow = il ? ((n0 >> 7) * 256 + (n0 & 127) + (il == 2 ? 128 : 0)) : n0;
        transpose_item(W, K, ldw, n0 + (n0 >= skip_from ? skip : 0), g, WT, dst_row0 + drow, scr, kb, lane);
    }
}
__device__ __forceinline__ void convert_layer_rest(KP P, int l, float* scr, int gw, int ngw, int lane) {
    unsigned char* ws = P->ws;
    convert_matrix(P->in[16] + (size_t)l * D * D, D, D, D, 1 << 30, 0, nullptr, (bf16*)(ws + WS_WOUT) + (size_t)l * D * D, 0, scr, gw, ngw, lane);
    convert_matrix(P->in[18] + (size_t)l * D * FF, D, FF, FF, 1 << 30, 0, P->in[17] + l * D, (bf16*)(ws + WS_WGU) + (size_t)l * NGU * D, 0, scr, gw, ngw, lane, 1);
    convert_matrix(P->in[20] + (size_t)l * D * FF, D, FF, FF, 1 << 30, 0, P->in[17] + l * D, (bf16*)(ws + WS_WGU) + (size_t)l * NGU * D, 0, scr, gw, ngw, lane, 2);
    convert_matrix(P->in[21] + (size_t)l * FF * D, FF, D, D, 1 << 30, 0, nullptr, (bf16*)(ws + WS_WDN) + (size_t)l * D * FF, 0, scr, gw, ngw, lane);
}
__device__ __forceinline__ void convert_win(KP P, int l, float* scr, int gw, int ngw, int lane) {
    convert_matrix(P->in[8] + (size_t)l * D * DIN, D, NPROJ, DIN, 2048, 8, P->in[7] + l * D, (bf16*)(P->ws + WS_WIN), 0, scr, gw, ngw, lane);
}

constexpr int B_QF = 0, B_KF = 33792, B_VF = 67584, B_AT = 101376, B_GC = 118784, B_QKS = 120320, B_WST = 128512;
__device__ __forceinline__ void p2b_item(KP P, int l, int item, unsigned char* lds, int wave_in) {
    const int tid = fresh_tid(wave_in);
    const int h = item & 3, n = (item >> 2) & 31, b = item >> 7;
    const int lane = tid & 63, wv = __builtin_amdgcn_readfirstlane(tid >> 6), fr = lane & 15, fq = lane >> 4;
    float* QF = (float*)(lds + B_QF); float* KF = (float*)(lds + B_KF); float* VF = (float*)(lds + B_VF); float* AT = (float*)(lds + B_AT);
    float* Gs = (float*)(lds + B_GC); float* BETA = Gs + 64; float* GC = Gs + 128; float* EG = Gs + 192; float* EKD = Gs + 256;
    bf16* QKS = (bf16*)(lds + B_QKS); bf16* WST = (bf16*)(lds + B_WST);
    const bf16* PROJ = (const bf16*)(P->ws + WS_PROJ);
    const float* GB = (const float*)(P->ws + WS_GB);
    unsigned char* scr = P->ws + WS_SCR + (size_t)item * SCR_ITEM;
    if (tid < 384) {
        const int chunk = tid % 48, tg = tid / 48, part = chunk >> 4, cc = chunk & 15;
        const int col = part * 512 + h * 128 + cc * 8;
        const float* cw = P->in[9] + (size_t)(l * 4) * 1536 + col;
        float w0[8], w1[8], w2[8], w3[8];
#pragma unroll
        for (int e = 0; e < 8; ++e) { w0[e] = cw[e]; w1[e] = cw[1536 + e]; w2[e] = cw[2 * 1536 + e]; w3[e] = cw[3 * 1536 + e]; }
        const int t0 = n * 64 + tg * 8;
        const bf16* base = PROJ + (size_t)(b * SEQL) * NPROJ + col;
        float r0[8], r1[8], r2[8], r3[8];
#pragma unroll
        for (int e = 0; e < 8; ++e) { r0[e] = 0.f; r1[e] = 0.f; r2[e] = 0.f; }
        if (t0 - 3 >= 0) { const v4u w = *(const v4u*)(base + (size_t)(t0 - 3) * NPROJ); UNPACK8(w, r0); }
        if (t0 - 2 >= 0) { const v4u w = *(const v4u*)(base + (size_t)(t0 - 2) * NPROJ); UNPACK8(w, r1); }
        if (t0 - 1 >= 0) { const v4u w = *(const v4u*)(base + (size_t)(t0 - 1) * NPROJ); UNPACK8(w, r2); }
        float* dst = (float*)(lds + part * 33792) + cc * 8;
#pragma unroll
        for (int i = 0; i < 8; ++i) {
            const v4u w = *(const v4u*)(base + (size_t)(t0 + i) * NPROJ); UNPACK8(w, r3);
            float s[8];
#pragma unroll
            for (int e = 0; e < 8; ++e) { const float cv = w0[e] * r0[e] + w1[e] * r1[e] + w2[e] * r2[e] + w3[e] * r3[e]; s[e] = siluf(cv); }
            float* d = dst + (tg * 8 + i) * 132;
            *(f32x4*)d = (f32x4){s[0], s[1], s[2], s[3]}; *(f32x4*)(d + 4) = (f32x4){s[4], s[5], s[6], s[7]};
#pragma unroll
            for (int e = 0; e < 8; ++e) { r0[e] = r1[e]; r1[e] = r2[e]; r2[e] = r3[e]; }
        }
    }
    if (tid < 64) { const int row = b * SEQL + n * 64 + tid; Gs[tid] = GB[(size_t)row * 8 + h]; BETA[tid] = GB[(size_t)row * 8 + 4 + h]; }
    __syncthreads();
    {
        const int tok = tid >> 3, sub = tid & 7;
        float* qr = QF + tok * 132 + sub * 16; float* kr = KF + tok * 132 + sub * 16;
        float qv[16], kv[16]; float sq = 0.f, sk = 0.f;
#pragma unroll
        for (int e = 0; e < 16; ++e) { qv[e] = qr[e]; kv[e] = kr[e]; sq += qv[e] * qv[e]; sk += kv[e] * kv[e]; }
        sq += shx(sq, 1); sq += shx(sq, 2); sq += shx(sq, 4);
        sk += shx(sk, 1); sk += shx(sk, 2); sk += shx(sk, 4);
        const float rq = rsqrtf(sq + EPS) * 0.08838834764831845f, rk = rsqrtf(sk + EPS);
#pragma unroll
        for (int e = 0; e < 16; ++e) { qr[e] = qv[e] * rq; kr[e] = kv[e] * rk; }
    }
    if (tid < 64) {
        float v = Gs[tid];
#pragma unroll
        for (int o = 1; o < 64; o <<= 1) { const int src = tid >= o ? tid - o : tid; const float t = __builtin_bit_cast(float, __builtin_amdgcn_ds_bpermute(src << 2, __builtin_bit_cast(int, v))); if (tid >= o) v += t; }
        const float tot = rdl(v, 63);
        GC[tid] = v; EG[tid] = __expf(v); EKD[tid] = __expf(tot - v);
        if (tid == 0) ((float*)(P->ws + WS_GL))[item] = __expf(tot);
    }
    __syncthreads();
    {
        const int p = wv >> 2, mt = wv & 3;
        const float* X = p ? QF : KF;
        f32x4 acc[4];
#pragma unroll
        for (int nt = 0; nt < 4; ++nt) acc[nt] = (f32x4){0.f, 0.f, 0.f, 0.f};
        const float* xa = X + (mt * 16 + fr) * 132 + fq; const float* kb_ = KF + fr * 132 + fq;
#pragma unroll 8
        for (int k = 0; k < 128; k += 4) {
            const float a = xa[k];
#pragma unroll
            for (int nt = 0; nt < 4; ++nt) acc[nt] = __builtin_amdgcn_mfma_f32_16x16x4f32(a, kb_[nt * 16 * 132 + k], acc[nt], 0, 0, 0);
        }
#pragma unroll
        for (int nt = 0; nt < 4; ++nt) {
            const int j = nt * 16 + fr; const float gj = GC[j];
            float v[4];
#pragma unroll
            for (int r = 0; r < 4; ++r) {
                const int i = mt * 16 + 4 * fq + r;
                if (p == 0) v[r] = (i > j) ? BETA[i] * acc[nt][r] * __expf(GC[i] - gj) : 0.f;
                else        v[r] = (i >= j) ? acc[nt][r] * __expf(GC[i] - gj) : 0.f;
            }
            if (p == 0) *(f32x4*)(AT + j * 68 + mt * 16 + 4 * fq) = (f32x4){v[0], v[1], v[2], v[3]};
            else {
#pragma unroll
                for (int r = 0; r < 4; ++r) QKS[(mt * 16 + 4 * fq + r) * 64 + j] = (bf16)f2bf(v[r]);
            }
        }
    }
    __syncthreads();
    const int tid4 = fresh_tid(wave_in);
    if (tid4 < 256) {
        float x[64];
        int zo = 0; asm volatile("" : "+v"(zo));
        const float* ATz = AT + zo; const float* BETAz = BETA + zo; const float* EGz = EG + zo;
        if (tid4 < 128) {
#pragma unroll
            for (int i = 0; i < 64; ++i) x[i] = BETAz[i] * VF[i * 132 + tid4];
        } else {
#pragma unroll
            for (int i = 0; i < 64; ++i) x[i] = BETAz[i] * EGz[i] * KF[i * 132 + tid4 - 128];
        }
        f32x4 ab[16];
#pragma unroll
        for (int q = 0; q < 16; ++q) ab[q] = *(const f32x4*)(ATz + q * 4);
#pragma unroll
        for (int j = 0; j < 63; ++j) {
            const float xj = x[j];
#pragma unroll
            for (int q = (j + 1) / 4; q < 16; ++q) {
#pragma unroll
                for (int e = 0; e < 4; ++e) if (4 * q + e > j) x[4 * q + e] -= ab[q][e] * xj;
                if (j + 1 < 63 && q >= (j + 2) / 4) ab[q] = *(const f32x4*)(ATz + (j + 1) * 68 + q * 4);
                __builtin_amdgcn_sched_barrier(0);
            }
        }
        if (tid4 < 128) {
            unsigned char* up = scr + 49152 + tid4 * 128;
#pragma unroll
            for (int q = 0; q < 8; ++q) *(v4u*)(up + q * 16) = PACK8(x + 8 * q);
        } else {
            const int dk = tid4 - 128;
#pragma unroll
            for (int i = 0; i < 64; ++i) WST[i * 128 + dk] = (bf16)f2bf(-x[i]);
        }
    } else {
        const int t2 = tid4 - 256;
        {
            const int tok = t2 >> 2, seg = t2 & 3; const float eg = EG[tok]; const float* s = QF + tok * 132 + seg * 32;
            unsigned char* o = scr + 16384 + tok * 256 + seg * 64;
#pragma unroll
            for (int q = 0; q < 4; ++q) { float f[8];
#pragma unroll
                for (int e = 0; e < 8; ++e) f[e] = s[q * 8 + e] * eg;
                *(v4u*)(o + q * 16) = PACK8(f); }
        }
        {
            const int dk = t2 >> 1, hf = t2 & 1; unsigned char* o = scr + 32768 + dk * 128 + hf * 64;
#pragma unroll
            for (int q = 0; q < 4; ++q) { float f[8];
#pragma unroll
                for (int e = 0; e < 8; ++e) { const int tok = hf * 32 + q * 8 + e; f[e] = KF[tok * 132 + dk] * EKD[tok]; }
                *(v4u*)(o + q * 16) = PACK8(f); }
        }
#pragma unroll
        for (int q = 0; q < 2; ++q) { const int c = t2 + 256 * q; *(v4u*)(scr + 65536 + c * 16) = *(const v4u*)((const unsigned char*)QKS + c * 16); }
    }
    __syncthreads();
#pragma unroll
    for (int q = 0; q < 2; ++q) { const int c = tid4 + 512 * q; *(v4u*)(scr + c * 16) = *(const v4u*)((const unsigned char*)WST + c * 16); }
    __syncthreads();
}

constexpr int S_ST = 0, S_VNT = 34816, S_OPW = 53248, S_OPQG = 70656, S_OPKD = 88064, S_OPQK = 106496, S_OPU = 115712;
__device__ __forceinline__ void scan_load(v4u (&pre)[9], const unsigned char* src, int tid, int half) {
#pragma unroll
    for (int i = 0; i < 9; ++i) pre[i] = *(const v4u*)(src + (size_t)(tid + 512 * i) * 16);
}
__device__ __forceinline__ void scan_chunk(v4u (&pre)[9], f32x4 (&sacc)[8], unsigned char* lds, unsigned char* scrbase, bf16* orow, int item, int n, float egl, int tid, int w, int fr, int fq, int half) {
    asm volatile("s_waitcnt lgkmcnt(0)" ::: "memory"); __builtin_amdgcn_s_barrier(); asm volatile("" ::: "memory");
#pragma unroll
    for (int i = 0; i < 9; ++i) {
        const int e = (tid + 512 * i) * 16 - (i >> 1) * 16384;
        if (i < 4) { const int row = e >> 8, cb = e & 255; *(v4u*)(lds + (i < 2 ? S_OPW : S_OPQG) + row * 272 + cb) = pre[i]; }
        else { const int row = e >> 7, cb = e & 127; *(v4u*)(lds + (i < 6 ? S_OPKD : (i < 8 ? S_OPU : S_OPQK)) + row * 144 + cb) = pre[i]; }
    }
    asm volatile("s_waitcnt lgkmcnt(0)" ::: "memory"); __builtin_amdgcn_s_barrier(); asm volatile("" ::: "memory");
    scan_load(pre, scrbase + (size_t)(item + (n + 2 < 32 ? 8 : 0)) * SCR_ITEM, tid, half);
    if (w < 4) {
    const int dvt = half * 4 + w;
#define SB() __builtin_amdgcn_sched_barrier(0)
    bf16x8 sf[4];
#pragma unroll
    for (int ks = 0; ks < 4; ++ks) sf[ks] = *(const bf16x8*)(lds + S_ST + (16 * w + fr) * 272 + (ks * 32 + 8 * fq) * 2);
    f32x4 vt[4];
    v2u uu[4];
#pragma unroll
    for (int tt = 0; tt < 4; ++tt) uu[tt] = *(const v2u*)(lds + S_OPU + (16 * dvt + fr) * 144 + (tt * 16 + 4 * fq) * 2);
    {
        bf16x8 af[4][4];
#pragma unroll
        for (int ks = 0; ks < 4; ++ks)
#pragma unroll
            for (int tt = 0; tt < 4; ++tt) af[ks][tt] = *(const bf16x8*)(lds + S_OPW + (tt * 16 + fr) * 272 + (ks * 32 + 8 * fq) * 2);
        SB();
#pragma unroll
        for (int tt = 0; tt < 4; ++tt) vt[tt] = (f32x4){bflo(uu[tt].x), bfhi(uu[tt].x), bflo(uu[tt].y), bfhi(uu[tt].y)};
#pragma unroll
        for (int ks = 0; ks < 4; ++ks)
#pragma unroll
            for (int tt = 0; tt < 4; ++tt) vt[tt] = __builtin_amdgcn_mfma_f32_16x16x32_bf16(af[ks][tt], sf[ks], vt[tt], 0, 0, 0);
        SB();
    }
#pragma unroll
    for (int tt = 0; tt < 4; ++tt) *(v2u*)(lds + S_VNT + (16 * w + fr) * 144 + (tt * 16 + 4 * fq) * 2) = (v2u){pk2(vt[tt][0], vt[tt][1]), pk2(vt[tt][2], vt[tt][3])};
    f32x4 ot[4];
#pragma unroll
    for (int nt = 0; nt < 4; ++nt) ot[nt] = (f32x4){0.f, 0.f, 0.f, 0.f};
    {
        bf16x8 bq[4][4];
#pragma unroll
        for (int ks = 0; ks < 4; ++ks)
#pragma unroll
            for (int nt = 0; nt < 4; ++nt) bq[ks][nt] = *(const bf16x8*)(lds + S_OPQG + (nt * 16 + fr) * 272 + (ks * 32 + 8 * fq) * 2);
        SB();
#pragma unroll
        for (int ks = 0; ks < 4; ++ks)
#pragma unroll
            for (int nt = 0; nt < 4; ++nt) ot[nt] = __builtin_amdgcn_mfma_f32_16x16x32_bf16(sf[ks], bq[ks][nt], ot[nt], 0, 0, 0);
        SB();
    }
    LDS_WAIT();
    bf16x8 vf[2];
#pragma unroll
    for (int js = 0; js < 2; ++js) vf[js] = *(const bf16x8*)(lds + S_VNT + (16 * w + fr) * 144 + (js * 32 + 8 * fq) * 2);
    {
        bf16x8 bk[2][4];
#pragma unroll
        for (int js = 0; js < 2; ++js)
#pragma unroll
            for (int nt = 0; nt < 4; ++nt) bk[js][nt] = *(const bf16x8*)(lds + S_OPQK + (nt * 16 + fr) * 144 + (js * 32 + 8 * fq) * 2);
        SB();
#pragma unroll
        for (int js = 0; js < 2; ++js)
#pragma unroll
            for (int nt = 0; nt < 4; ++nt) ot[nt] = __builtin_amdgcn_mfma_f32_16x16x32_bf16(vf[js], bk[js][nt], ot[nt], 0, 0, 0);
        SB();
    }
#pragma unroll
    for (int nt = 0; nt < 4; ++nt) *(v2u*)(orow + (size_t)(nt * 16 + fr) * D + 16 * dvt + 4 * fq) = (v2u){pk2(ot[nt][0], ot[nt][1]), pk2(ot[nt][2], ot[nt][3])};
    {
        bf16x8 ak[2][8];
#pragma unroll
        for (int js = 0; js < 2; ++js)
#pragma unroll
            for (int mt = 0; mt < 8; ++mt) ak[js][mt] = *(const bf16x8*)(lds + S_OPKD + (mt * 16 + fr) * 144 + (js * 32 + 8 * fq) * 2);
        SB();
#pragma unroll
        for (int mt = 0; mt < 8; ++mt) sacc[mt] = sacc[mt] * egl;
#pragma unroll
        for (int js = 0; js < 2; ++js)
#pragma unroll
            for (int mt = 0; mt < 8; ++mt) sacc[mt] = __builtin_amdgcn_mfma_f32_16x16x32_bf16(ak[js][mt], vf[js], sacc[mt], 0, 0, 0);
        SB();
    }
#pragma unroll
    for (int mt = 0; mt < 8; ++mt) *(v2u*)(lds + S_ST + (16 * w + fr) * 272 + (mt * 16 + 4 * fq) * 2) = (v2u){pk2(sacc[mt][0], sacc[mt][1]), pk2(sacc[mt][2], sacc[mt][3])};
#undef SB
    }
    LDS_WAIT();
}
__device__ __forceinline__ void scan_wg(KP P, int l, int id, unsigned char* lds, int tid) {
    const int bh = id >> 1, half = id & 1, b = bh >> 2, h = bh & 3;
    const int lane = tid & 63, w = __builtin_amdgcn_readfirstlane(tid >> 6), fr = lane & 15, fq = lane >> 4;
    unsigned char* scrbase = P->ws + WS_SCR;
    bf16* OCAT = (bf16*)(P->ws + WS_XA);
    f32x4 sacc[8];
#pragma unroll
    for (int mt = 0; mt < 8; ++mt) sacc[mt] = (f32x4){0.f, 0.f, 0.f, 0.f};
    { unsigned zz0 = 0u; asm volatile("" : "+v"(zz0)); if (w < 4) for (int q = lane; q < 272; q += 64) *(v4u*)(lds + S_ST + (16 * w) * 272 + q * 16) = (v4u){zz0, zz0, zz0, zz0}; }
    const int item0 = (b * 32) * 4 + h;
    const float glv = ((const float*)(P->ws + WS_GL))[item0 + 4 * (lane & 31)];
    v4u preA[9], preB[9];
    scan_load(preA, scrbase + (size_t)item0 * SCR_ITEM, tid, half);
    scan_load(preB, scrbase + (size_t)(item0 + 4) * SCR_ITEM, tid, half);
    bf16* orow = OCAT + (size_t)(b * SEQL) * D + h * 128;
#pragma unroll
    for (int n = 0; n < 32; n += 2) {
        scan_chunk(preA, sacc, lds, scrbase, orow + (size_t)(n * 64) * D, item0 + 4 * n, n, rdl(glv, n), tid, w, fr, fq, half);
        scan_chunk(preB, sacc, lds, scrbase, orow + (size_t)(n * 64 + 64) * D, item0 + 4 * n + 4, n + 1, rdl(glv, n + 1), tid, w, fr, fq, half);
    }
    if (w < 4) {
        const int lane2 = lane_id(), fr2 = lane2 & 15, fq2 = lane2 >> 4;
        float* pd = P->out + O_PDELTA + (size_t)((l * NBATCH + b) * 4 + h) * 16384;
#pragma unroll
        for (int mt = 0; mt < 8; ++mt)
#pragma unroll
            for (int r = 0; r < 4; ++r) pd[(mt * 16 + 4 * fq2 + r) * 128 + 16 * (half * 4 + w) + fr2] = sacc[mt][r];
    }
    __syncthreads();
}
__device__ __forceinline__ void p2d(KP P, int l, int gw, int ngw, int lane) {
    const bf16* PROJ = (const bf16*)(P->ws + WS_PROJ);
    bf16* OCAT = (bf16*)(P->ws + WS_XA);
    const float on0 = P->in[12][l * 128 + lane * 2], on1 = P->in[12][l * 128 + lane * 2 + 1];
    for (int pair0 = gw * 4; pair0 < MP * 4; pair0 += 4 * ngw) {
        float o0[4], o1[4]; unsigned zz[4];
#pragma unroll
        for (int q = 0; q < 4; ++q) {
            const int pair = pair0 + q;
            o0[q] = 0.f; o1[q] = 0.f; zz[q] = 0u;
            if (pair < MP * 4) {
                const int row = pair >> 2, h = pair & 3, b = row >> 11, t = row & 2047, n = t >> 6, tok = t & 63;
                const unsigned ow = *(const unsigned*)(OCAT + (size_t)row * D + h * 128 + lane * 2);
                o0[q] = bflo(ow); o1[q] = bfhi(ow);
                zz[q] = *(const unsigned*)(PROJ + (size_t)row * NPROJ + 1536 + h * 128 + lane * 2);
            }
        }
#pragma unroll
        for (int q = 0; q < 4; ++q) {
            const int pair = pair0 + q;
            const float rs = rsqrtf(wave_sum(o0[q] * o0[q] + o1[q] * o1[q]) * (1.f / 128.f) + EPS);
            if (pair < MP * 4) {
                const int row = pair >> 2, h = pair & 3;
                *(unsigned*)(OCAT + (size_t)row * D + h * 128 + lane * 2) = pk2(o0[q] * rs * on0 * siluf(bflo(zz[q])), o1[q] * rs * on1 * siluf(bfhi(zz[q])));
            }
        }
    }
}

__device__ __forceinline__ void sample_delta(KP P, int l, int it, unsigned char* lds, int wave_in) {
    const int tid = fresh_tid(wave_in);
    const int gq = tid >> 7, c = tid & 127, wv2 = (tid >> 6) & 1, lane = tid & 63;
    const int item = it * 4 + gq, sb = item >> 2, h = item & 3, rowbase = MP + sb * 8;
    float* QS = (float*)(lds + gq * 12288); float* KS = QS + 1024; float* VS = QS + 2048;
    float* RED2 = (float*)(lds + 49152);
    const bf16* PROJ = (const bf16*)(P->ws + WS_PROJ);
    const float* GB = (const float*)(P->ws + WS_GB);
    bf16* OCAT = (bf16*)(P->ws + WS_XA);
#pragma unroll
    for (int part = 0; part < 3; ++part) {
        const int col = part * 512 + h * 128 + c;
        const float* cw = P->in[9] + (size_t)(l * 4) * 1536 + col;
        const float w0 = cw[0], w1 = cw[1536], w2 = cw[2 * 1536], w3 = cw[3 * 1536];
        const float* hs = P->in[3] + (size_t)((l * DBATCH + sb) * 3) * 1536 + col;
        float r0 = hs[0], r1 = hs[1536], r2 = hs[2 * 1536];
        float* dst = QS + part * 1024 + c;
#pragma unroll
        for (int t = 0; t < 8; ++t) {
            const float x = bf1(PROJ[(size_t)(rowbase + t) * NPROJ + col]);
            dst[t * 128] = siluf(w0 * r0 + w1 * r1 + w2 * r2 + w3 * x);
            r0 = r1; r1 = r2; r2 = x;
        }
    }
#pragma unroll
    for (int t = 0; t < 8; ++t) {
        const float q = QS[t * 128 + c], k = KS[t * 128 + c];
        const float sq = wave_sum(q * q), sk = wave_sum(k * k);
        if (lane == 0) { RED2[(gq * 2 + wv2) * 16 + t] = sq; RED2[(gq * 2 + wv2) * 16 + 8 + t] = sk; }
    }
    __syncthreads();
#pragma unroll
    for (int t = 0; t < 8; ++t) {
        const float tq = RED2[(gq * 2) * 16 + t] + RED2[(gq * 2 + 1) * 16 + t], tk = RED2[(gq * 2) * 16 + 8 + t] + RED2[(gq * 2 + 1) * 16 + 8 + t];
        QS[t * 128 + c] *= rsqrtf(tq + EPS) * 0.08838834764831845f; KS[t * 128 + c] *= rsqrtf(tk + EPS);
    }
    __syncthreads();
    float s[128];
    {
        const float* S0 = P->in[2] + (size_t)((l * DBATCH + sb) * 4 + h) * 16384 + c;
#pragma unroll
        for (int d8 = 0; d8 < 16; ++d8) {
#pragma unroll
            for (int e = 0; e < 8; ++e) s[8 * d8 + e] = S0[e * 128];
            S0 += 8 * 128; asm volatile("" : "+v"(S0));
        }
    }
    float* GBS = RED2 + 128 + gq * 16;
    if (c < 8) { GBS[c] = __expf(GB[(size_t)(rowbase + c) * 8 + h]); GBS[8 + c] = GB[(size_t)(rowbase + c) * 8 + 4 + h]; }
    LDS_WAIT(); __syncthreads();
#pragma unroll 1
    for (int t = 0; t < 8; ++t) {
        const float eg = GBS[t], beta = GBS[8 + t];
        const f32x4* kp = (const f32x4*)(KS + t * 128); const f32x4* qp = (const f32x4*)(QS + t * 128);
        float dot = 0.f;
#pragma unroll
        for (int d4 = 0; d4 < 32; ++d4) { const f32x4 kv = kp[d4]; dot += kv[0] * s[4 * d4] + kv[1] * s[4 * d4 + 1] + kv[2] * s[4 * d4 + 2] + kv[3] * s[4 * d4 + 3];
            if ((d4 & 3) == 3) asm volatile("" ::: "memory"); }
        const float cf = beta * (VS[t * 128 + c] - eg * dot);
        float o = 0.f;
#pragma unroll
        for (int d4 = 0; d4 < 32; ++d4) { const f32x4 kv = kp[d4], qv = qp[d4];
#pragma unroll
            for (int e = 0; e < 4; ++e) { s[4 * d4 + e] = eg * s[4 * d4 + e] + cf * kv[e]; o += qv[e] * s[4 * d4 + e]; }
            if ((d4 & 3) == 3) asm volatile("" ::: "memory"); }
        VS[t * 128 + c] = o;
    }
    {
        float* sd = P->out + O_SDELTA + (size_t)((l * DBATCH + sb) * 4 + h) * 16384 + c;
#pragma unroll
        for (int d8 = 0; d8 < 16; ++d8) {
#pragma unroll
            for (int e = 0; e < 8; ++e) sd[e * 128] = s[8 * d8 + e];
            sd += 8 * 128; asm volatile("" : "+v"(sd));
        }
    }
    __syncthreads();
#pragma unroll
    for (int t = 0; t < 8; ++t) { const float o = VS[t * 128 + c]; const float so = wave_sum(o * o); if (lane == 0) RED2[(gq * 2 + wv2) * 16 + t] = so; }
    __syncthreads();
    const float onv = P->in[12][l * 128 + c];
#pragma unroll
    for (int t = 0; t < 8; ++t) {
        const float tot = RED2[(gq * 2) * 16 + t] + RED2[(gq * 2 + 1) * 16 + t];
        const float z = bf1(PROJ[(size_t)(rowbase + t) * NPROJ + 1536 + h * 128 + c]);
        OCAT[(size_t)(rowbase + t) * D + h * 128 + c] = (bf16)f2bf(VS[t * 128 + c] * rsqrtf(tot * (1.f / 128.f) + EPS) * onv * siluf(z));
    }
    __syncthreads();
}

constexpr int PL_DT = 0, PL_PW = 33792;
__device__ __forceinline__ void pool_tile(KP P, int l, int tile, unsigned char* lds, int wave_in) {
    const int tid = fresh_tid(wave_in);
    bf16* DT = (bf16*)(lds + PL_DT);
    const bf16* PROJ = (const bf16*)(P->ws + WS_PROJ);
    bf16* OCAT = (bf16*)(P->ws + WS_XA);
#pragma unroll 1
    for (int i = 0; i < 4; ++i) {
        const int idx = tid + 512 * i, tok = idx & 63, ch8 = idx >> 6, c0 = ch8 * 8, gi = ch8 >> 3, win = 2 << gi;
        int row, t, sb = 0; bool smp;
        if (tile < 256) { t = (tile & 31) * 64 + tok; row = (tile >> 5) * SEQL + t; smp = false; }
        else { sb = (tile - 256) * 8 + (tok >> 3); t = tok & 7; row = MP + sb * 8 + t; smp = true; }
        float ssum[8], cur[8];
#pragma unroll
        for (int e = 0; e < 8; ++e) { ssum[e] = 0.f; cur[e] = 0.f; }
        {
            v4u wv[16];
#pragma unroll
            for (int j = 0; j < 16; ++j) {
                wv[j] = (v4u){0u, 0u, 0u, 0u};
                if (j < win && t - j >= 0) wv[j] = *(const v4u*)(PROJ + (size_t)(row - j) * NPROJ + 2048 + c0);
            }
#pragma unroll
            for (int j = 0; j < 16; ++j) {
                float f[8]; UNPACK8(wv[j], f);
#pragma unroll
                for (int e = 0; e < 8; ++e) { ssum[e] += f[e]; if (j == 0) cur[e] = f[e]; }
            }
            if (smp) {
                for (int j = t + 1; j < win; ++j) { const float* sp = P->in[4] + (size_t)((l * DBATCH + sb) * 15 + 15 + t - j) * 256 + c0;
#pragma unroll
                    for (int e = 0; e < 8; ++e) ssum[e] += sp[e]; }
            }
        }
        const float inv = 1.f / (float)(smp ? win : (t + 1 < win ? t + 1 : win));
        { float dd[8];
#pragma unroll
            for (int e = 0; e < 8; ++e) dd[e] = ssum[e] * inv - cur[e];
            *(v4u*)(DT + tok * 264 + c0) = PACK8(dd); }
        float u0[8], u1[8], u2[8];
#pragma unroll
        for (int j = 0; j < 3; ++j) {
            const int tt = t - j; float f[8];
            if (tt >= 0) { const v4u wc = *(const v4u*)(PROJ + (size_t)(row - j) * NPROJ + 2816 + c0); const v4u wx = *(const v4u*)(PROJ + (size_t)(row - j) * NPROJ + 2304 + c0);
                float fc[8], fx[8]; UNPACK8(wc, fc); UNPACK8(wx, fx);
#pragma unroll
                for (int e = 0; e < 8; ++e) f[e] = fc[e] * fx[e]; }
            else if (smp) { const float* sp = P->in[5] + (size_t)((l * DBATCH + sb) * 2 + 2 + tt) * 256 + c0;
#pragma unroll
                for (int e = 0; e < 8; ++e) f[e] = sp[e]; }
            else {
#pragma unroll
                for (int e = 0; e < 8; ++e) f[e] = 0.f; }
#pragma unroll
            for (int e = 0; e < 8; ++e) { if (j == 0) u0[e] = f[e]; else if (j == 1) u1[e] = f[e]; else u2[e] = f[e]; }
        }
        const float* sw = P->in[15] + (size_t)(l * 3) * 256 + c0;
        const v4u wb = *(const v4u*)(PROJ + (size_t)row * NPROJ + 2560 + c0); float fb[8]; UNPACK8(wb, fb);
        float oc[8];
#pragma unroll
        for (int e = 0; e < 8; ++e) oc[e] = fb[e] * (sw[e] * u2[e] + sw[256 + e] * u1[e] + sw[512 + e] * u0[e]);
        *(v4u*)(OCAT + (size_t)row * D + 768 + c0) = PACK8(oc);
    }
    __syncthreads();
    {
        const int lane = tid & 63, wv = tid >> 6, fr = lane & 15, fq = lane >> 4, g = wv & 3, th = wv >> 2;
        bf16x8 df[2][2], pf[4][2];
#pragma unroll
        for (int tt = 0; tt < 2; ++tt)
#pragma unroll
            for (int ks = 0; ks < 2; ++ks) df[tt][ks] = *(const bf16x8*)(lds + PL_DT + ((th * 32 + tt * 16 + fr) * 264 + g * 64 + ks * 32 + 8 * fq) * 2);
#pragma unroll
        for (int et = 0; et < 4; ++et)
#pragma unroll
            for (int ks = 0; ks < 2; ++ks) pf[et][ks] = *(const bf16x8*)(lds + PL_PW + (((g * 64 + et * 16 + fr) * 72) + ks * 32 + 8 * fq) * 2);
#pragma unroll
        for (int tt = 0; tt < 2; ++tt) {
            const int tok = th * 32 + tt * 16 + fr;
            const int row = tile < 256 ? (tile >> 5) * SEQL + (tile & 31) * 64 + tok : MP + (tile - 256) * 64 + tok;
#pragma unroll
            for (int et = 0; et < 4; ++et) {
                f32x4 acc = (f32x4){0.f, 0.f, 0.f, 0.f};
#pragma unroll
                for (int ks = 0; ks < 2; ++ks) acc = __builtin_amdgcn_mfma_f32_16x16x32_bf16(pf[et][ks], df[tt][ks], acc, 0, 0, 0);
                const int ch = g * 64 + et * 16 + 4 * fq;
                const f32x4 sc = *(const f32x4*)(P->in[14] + l * 256 + ch);
                *(v2u*)(OCAT + (size_t)row * D + 512 + ch) = (v2u){pk2(acc[0] * sc[0], acc[1] * sc[1]), pk2(acc[2] * sc[2], acc[3] * sc[3])};
            }
        }
    }
    __syncthreads();
}

__device__ __forceinline__ void state_copies(KP P, int l, int start, int stride) {
    const bf16* PROJ = (const bf16*)(P->ws + WS_PROJ);
    for (int i = start; i < 136 * 1120; i += stride) {
        const int seq = i / 1120, r = (i % 1120) * 8;
        const bool smp = seq >= 8; const int sb = seq - 8;
        const int L = smp ? 8 : SEQL; const size_t row0 = smp ? (size_t)MP + sb * 8 : (size_t)seq * SEQL;
        float f[8]; float* o;
        if (r < 4608) {
            const int j = r / 1536, c = r % 1536;
            const v4u w = *(const v4u*)(PROJ + (row0 + L - 3 + j) * NPROJ + c); UNPACK8(w, f);
            o = smp ? P->out + O_SDCONV + (size_t)((l * DBATCH + sb) * 3 + j) * 1536 + c : P->out + O_PDCONV + (size_t)((l * NBATCH + seq) * 3 + j) * 1536 + c;
        } else if (r < 4608 + 3840) {
            const int r2 = r - 4608, j = r2 / 256, c = r2 % 256;
            if (smp) {
                if (j < 7) { const float* sp = P->in[4] + (size_t)((l * DBATCH + sb) * 15 + 8 + j) * 256 + c;
#pragma unroll
                    for (int e = 0; e < 8; ++e) f[e] = sp[e]; }
                else { const v4u w = *(const v4u*)(PROJ + (row0 + j - 7) * NPROJ + 2048 + c); UNPACK8(w, f); }
                o = P->out + O_SPOOL + (size_t)((l * DBATCH + sb) * 15 + j) * 256 + c;
            } else {
                const v4u w = *(const v4u*)(PROJ + (row0 + L - 15 + j) * NPROJ + 2048 + c); UNPACK8(w, f);
                o = P->out + O_PPOOL + (size_t)((l * NBATCH + seq) * 15 + j) * 256 + c;
            }
        } else {
            const int r2 = r - 8448, j = r2 / 256, c = r2 % 256;
            const size_t row = row0 + L - 2 + j;
            const v4u wc = *(const v4u*)(PROJ + row * NPROJ + 2816 + c); const v4u wx = *(const v4u*)(PROJ + row * NPROJ + 2304 + c);
            float fc[8], fx[8]; UNPACK8(wc, fc); UNPACK8(wx, fx);
#pragma unroll
            for (int e = 0; e < 8; ++e) f[e] = fc[e] * fx[e];
            o = smp ? P->out + O_SSCONV + (size_t)((l * DBATCH + sb) * 2 + j) * 256 + c : P->out + O_PSCONV + (size_t)((l * NBATCH + seq) * 2 + j) * 256 + c;
        }
        *(f32x4*)o = (f32x4){f[0], f[1], f[2], f[3]}; *(f32x4*)(o + 4) = (f32x4){f[4], f[5], f[6], f[7]};
    }
}

__device__ __forceinline__ void p4b(KP P, int l, int hf, int start, int stride) {
    bf16* GU = (bf16*)(P->ws + WS_GU); bf16* HALO = (bf16*)(P->ws + WS_HALO);
    const float* cw = P->in[19] + (size_t)(l * 3) * FF;
    const int r0 = hf * MH;
    for (int idx = start; idx < MH * 352; idx += stride) {
        const int lr = idx / 352, c0 = (idx % 352) * 8, m = r0 + lr;
        int t, sb = 0; bool smp;
        if (m < MP) { t = m & (SEQL - 1); smp = false; } else { sb = (m - MP) >> 3; t = (m - MP) & 7; smp = true; }
        float g0[8], g1[8], g2[8];
#pragma unroll
        for (int j = 0; j < 3; ++j) {
            const int tt = t - j; float f[8];
            if (tt < 0) {
                if (smp) { const float* sp = P->in[6] + (size_t)((l * DBATCH + sb) * 2 + 2 + tt) * FF + c0;
#pragma unroll
                    for (int e = 0; e < 8; ++e) f[e] = sp[e]; }
                else {
#pragma unroll
                    for (int e = 0; e < 8; ++e) f[e] = 0.f; }
            } else {
                const v4u w = (lr - j < 0) ? *(const v4u*)(HALO + (size_t)(2 + lr - j) * FF + c0) : *(const v4u*)(GU + (size_t)(lr - j) * NGU + c0);
                UNPACK8(w, f);
            }
#pragma unroll
            for (int e = 0; e < 8; ++e) { if (j == 0) g0[e] = f[e]; else if (j == 1) g1[e] = f[e]; else g2[e] = f[e]; }
        }
        const v4u wu = *(const v4u*)(GU + (size_t)lr * NGU + FF + c0); float fu[8]; UNPACK8(wu, fu);
        float a[8];
#pragma unroll
        for (int e = 0; e < 8; ++e) a[e] = siluf(cw[c0 + e] * g2[e] + cw[FF + c0 + e] * g1[e] + cw[2 * FF + c0 + e] * g0[e]) * fu[e];
        *(v4u*)(GU + (size_t)lr * NGU + FF + c0) = PACK8(a);
        if (!smp && t >= SEQL - 2) { float* o = P->out + O_PFFN + (size_t)((l * NBATCH + (m >> 11)) * 2 + t - (SEQL - 2)) * FF + c0;
#pragma unroll
            for (int e = 0; e < 8; ++e) o[e] = g0[e]; }
        if (smp && t >= 6) { float* o = P->out + O_SFFN + (size_t)((l * DBATCH + sb) * 2 + t - 6) * FF + c0;
#pragma unroll
            for (int e = 0; e < 8; ++e) o[e] = g0[e]; }
        if (hf == 0 && lr >= MH - 2) *(v4u*)(HALO + (size_t)(lr - (MH - 2)) * FF + c0) = *(const v4u*)(GU + (size_t)lr * NGU + c0);
    }
}

#define LAS __attribute__((address_space(3)))
#define XB_TMO      128
#define XB_XCNT(j)  (256  + 64 * (j))
#define XB_XSUB(j)  (1280 + 64 * (j))
#define XB_XGEN(j)  (2304 + 64 * (j))
#define XB_TOP      3328
#define XB_TOPGEN   3392
#define XCD_BAR_WORDS 3456
#define XB_SPIN_CAP (1u << 18)

__device__ __forceinline__ unsigned xb_ld(unsigned* p)              { return __hip_atomic_load(p, __ATOMIC_RELAXED, __HIP_MEMORY_SCOPE_AGENT); }
__device__ __forceinline__ unsigned xb_add(unsigned* p, unsigned v) { return __hip_atomic_fetch_add(p, v, __ATOMIC_RELAXED, __HIP_MEMORY_SCOPE_AGENT); }
__device__ __forceinline__ unsigned xb_xcc_id() { return (unsigned)__builtin_amdgcn_s_getreg((3 << 11) | 20) & 0xFu; }
#define XB_SPIN(cond, bar) do { unsigned _sp = 0; while (cond) { __builtin_amdgcn_s_sleep(1); \
    if ((++_sp & 255u) == 0u) { if (xb_ld(&(bar)[XB_TMO])) break; if (_sp > XB_SPIN_CAP) { atomicAdd(&(bar)[XB_TMO], 1u); break; } } } } while (0)

struct XcdBarrier {
    unsigned* bar; unsigned x;
    volatile LAS unsigned* st;
    int wave;
};

__device__ __forceinline__ XcdBarrier xcd_barrier_post(unsigned* bar, volatile LAS unsigned* st) {
    XcdBarrier b; b.bar = bar; b.x = xb_xcc_id(); b.st = st; b.wave = 0;
    if (threadIdx.x == 0) (void)xb_add(&bar[XB_XCNT(b.x)], 1u);
    return b;
}
__device__ __forceinline__ void xcd_barrier_complete(unsigned* bar, unsigned x, unsigned& nloc, unsigned& nx) {
    const unsigned G = gridDim.x * gridDim.y * gridDim.z;
    unsigned sum, cnt, mine, sp = 0u;
    for (;;) {
        sum = 0u; cnt = 0u; mine = 0u;
#pragma unroll
        for (unsigned j = 0; j < 16; ++j) { const unsigned c = xb_ld(&bar[XB_XCNT(j)]); sum += c; cnt += (c > 0u) ? 1u : 0u; mine = (j == x) ? c : mine; }
        if (sum == G) break;
        __builtin_amdgcn_s_sleep(1);
        if ((++sp & 255u) == 0u) { if (xb_ld(&bar[XB_TMO])) break; if (sp > XB_SPIN_CAP) { atomicAdd(&bar[XB_TMO], 1u); break; } }
    }
    nloc = mine > 0u ? mine : 1u; nx = cnt > 0u ? cnt : 1u;
}

__device__ __forceinline__ void xcd_barrier(const XcdBarrier& b) {
    asm volatile("s_waitcnt vmcnt(0)" ::: "memory");
    __syncthreads();
    if (b.wave == 0 && lane_id() == 0) {
        unsigned* bar = b.bar;
        __builtin_amdgcn_s_waitcnt(0);
        unsigned nloc = b.st[0], nx = b.st[1];
        if (nloc == 0u) { xcd_barrier_complete(bar, b.x, nloc, nx); b.st[0] = nloc; b.st[1] = nx; }
        const unsigned old = xb_add(&bar[XB_XSUB(b.x)], 1u);
        const unsigned gen = old / nloc;
        if (old + 1u == (gen + 1u) * nloc) {
            __builtin_amdgcn_fence(__ATOMIC_RELEASE, "agent");
            asm volatile("s_waitcnt vmcnt(0)" ::: "memory");
            const unsigned og = xb_add(&bar[XB_TOP], 1u);
            const unsigned tg = og / nx;
            if (og + 1u == (tg + 1u) * nx) xb_add(&bar[XB_TOPGEN], 1u);
            else XB_SPIN(xb_ld(&bar[XB_TOPGEN]) == tg, bar);
            __builtin_amdgcn_fence(__ATOMIC_ACQUIRE, "agent");
            xb_add(&bar[XB_XGEN(b.x)], 1u);
            asm volatile("s_waitcnt vmcnt(0)" ::: "memory");
        } else {
            XB_SPIN(xb_ld(&bar[XB_XGEN(b.x)]) == gen, bar);
            __builtin_amdgcn_fence(__ATOMIC_ACQUIRE, "agent");
            asm volatile("s_waitcnt vmcnt(0)" ::: "memory");
        }
    }
    __syncthreads();
}

#define XSYNC1() do { XcdBarrier b_; b_.bar = (unsigned*)(kparams()->ws + WS_BAR); b_.x = xb_xcc_id(); b_.st = (volatile LAS unsigned*)((LAS unsigned char*)lds + (LDS_BYTES - 64)); b_.wave = wave; xcd_barrier(b_); } while (0)
#ifdef PROBE_SYNC2
#define GSYNC() do { XSYNC1(); XSYNC1(); } while (0)
#else
#define GSYNC() XSYNC1()
#endif
__global__ void __launch_bounds__(NTHREADS, 2) fwd_megakernel(Params Parg) {
    KP P = kparams();
    extern __shared__ __attribute__((aligned(16))) unsigned char lds[];
    cg::grid_group grid = cg::this_grid();
    const int wave = __builtin_amdgcn_readfirstlane((int)threadIdx.x >> 6);
    const int tid = fresh_tid(wave), lane = tid & 63;
    const int G = gridDim.x, bx = blockIdx.x;
    const int gw = bx * NWAVES + wave, ngw = G * NWAVES;
    const int gt = bx * NTHREADS + tid, ngt = G * NTHREADS;
    unsigned char* ws = P->ws;
    bf16* XA = (bf16*)(ws + WS_XA); bf16* XB2 = (bf16*)(ws + WS_PROJ); bf16* PROJ = (bf16*)(ws + WS_PROJ); bf16* GU = (bf16*)(ws + WS_GU);
    float* SSQ = (float*)(ws + WS_SSQ); float* GB = (float*)(ws + WS_GB); float* WAB = (float*)(ws + WS_WAB);
    float* XRES = P->out;
    float* wscr = (float*)(lds + wave * 16384);
    volatile LAS unsigned* xst = (volatile LAS unsigned*)((LAS unsigned char*)lds + (LDS_BYTES - 64));
    if (tid < 16) xst[tid] = 0u;
    __syncthreads();
    (void)xcd_barrier_post((unsigned*)(ws + WS_BAR), xst);

    for (int i = gt; i < 4 * M; i += ngt) SSQ[M + i] = 0.f;
    for (int i = gt; i < MS * D / 4; i += ngt) ((f32x4*)(XRES + (size_t)MP * D))[i] = ((const f32x4*)P->in[1])[i];
    for (int i = gt; i < 2 * 8 * D; i += ngt) { const int l = i >> 13, j = (i >> 10) & 7, k = i & 1023; WAB[i] = P->in[7][l * D + k] * P->in[8][(size_t)l * D * DIN + (size_t)k * DIN + 2048 + j]; }
    convert_win(P, 0, wscr, gw, ngw, lane);
    convert_layer_rest(P, 0, wscr, gw, ngw, lane);
    convert_layer_rest(P, 1, wscr, gw, ngw, lane);
    for (int m0 = gw; m0 < M; m0 += 2 * ngw) {
        f32x4 v[2][4];
#pragma unroll
        for (int q = 0; q < 2; ++q) { const int m = m0 + q * ngw;
            const float* xr = m < MP ? P->in[0] + (size_t)m * D : P->in[1] + (size_t)((m < M ? m : M - 1) - MP) * D;
#pragma unroll
            for (int j = 0; j < 4; ++j) v[q][j] = ((const f32x4*)xr)[lane + 64 * j]; }
#pragma unroll
        for (int q = 0; q < 2; ++q) { const int m = m0 + q * ngw;
            if (m < M) {
                float ss = 0.f;
#pragma unroll
                for (int j = 0; j < 4; ++j) { const f32x4 w4 = v[q][j]; ss += w4[0] * w4[0] + w4[1] * w4[1] + w4[2] * w4[2] + w4[3] * w4[3];
                    ((v2u*)(XA + (size_t)m * D))[lane + 64 * j] = (v2u){pk2(w4[0], w4[1]), pk2(w4[2], w4[3])}; }
                ss = wave_sum(ss);
                if (lane == 0) SSQ[m] = ss;
            } }
    }
    if (ws == nullptr) grid.sync();
    GSYNC();

#pragma unroll 1
    for (int l = 0; l < 2; ++l) {
#ifndef NO_P1
        {
            const bf16* gA = XA; const bf16* gB = (const bf16*)(ws + WS_WIN); LAUNDER(gA); LAUNDER(gB);
            pg8::Gemm g{gA, gB, M, NPROJ, D, D, D}; pg8::StaticOrder S; S.init(M, NPROJ, G, bx);
            EpiScale E{PROJ, NPROJ, SSQ + (size_t)(2 * l) * M};
            pg8::gemm_phase<EpiScale, pg8::StaticOrder, true, true>((PG8_LAS unsigned char*)lds, g, S, E, wave);
#ifdef PROBE_P1X2
            __syncthreads();
            pg8::gemm_phase<EpiScale, pg8::StaticOrder, true, true>((PG8_LAS unsigned char*)lds, g, S, E, wave);
#endif
        }
#endif
#ifndef NO_AB
        {
            const float* ssq = SSQ + (size_t)(2 * l) * M;
            const int nab = (G > 96 ? G - 48 : G), bab = (G > 96 ? bx - 48 : bx);
            const int tf = fresh_tid(wave), lane = tf & 63, gw = bab * NWAVES + __builtin_amdgcn_readfirstlane(tf >> 6), ngw = nab * NWAVES;
            if (bab >= 0)
            for (int m0 = gw; m0 < M; m0 += 2 * ngw) {
                v4u xq[2][2]; float sqv[2];
#pragma unroll
                for (int q = 0; q < 2; ++q) { const int m = (m0 + q * ngw) < M ? (m0 + q * ngw) : (M - 1);
                    const v4u* xr = (const v4u*)(XA + (size_t)m * D) + lane * 2; xq[q][0] = xr[0]; xq[q][1] = xr[1]; sqv[q] = ssq[m]; }
#pragma unroll
                for (int q = 0; q < 2; ++q) {
                    const int m = m0 + q * ngw;
                    float xf[16]; UNPACK8(xq[q][0], xf); UNPACK8(xq[q][1], xf + 8);
                    float dot[8];
#pragma unroll
                    for (int j = 0; j < 8; ++j) { const float* wp = WAB + (size_t)(l * 8 + j) * D + lane * 16; float s2 = 0.f;
#pragma unroll
                        for (int e = 0; e < 16; ++e) s2 += wp[e] * xf[e];
                        dot[j] = wave_sum(s2); }
                    float v = dot[0];
#pragma unroll
                    for (int j = 1; j < 8; ++j) v = (lane == j) ? dot[j] : v;
                    if (lane < 8 && m < M) {
                        v *= rsqrtf(sqv[q] * (1.f / D) + EPS);
                        const int hh = lane & 3; float r;
                        if (lane < 4) { const float xx = v + P->in[11][l * 4 + hh]; const float sp = fmaxf(xx, 0.f) + __logf(1.f + __expf(-fabsf(xx))); r = -__expf(P->in[10][l * 4 + hh]) * sp; }
                        else r = __builtin_amdgcn_rcpf(1.f + __expf(-v));
                        GB[(size_t)m * 8 + lane] = r;
                    }
                }
            }
        }
#endif
        GSYNC();
#ifndef NO_P2B
        { const int tf = fresh_tid(wave); for (int item = bx; item < 1024; item += G) p2b_item(P, l, item, lds, wave); }
#ifdef PROBE_P2B2
        __syncthreads(); { const int tf = fresh_tid(wave); for (int item = bx; item < 1024; item += G) p2b_item(P, l, item, lds, wave); }
#endif
#endif
        GSYNC();
#ifdef PROBE_SCAN2
        if (bx < 64) { scan_wg(P, l, bx, lds, fresh_tid(wave)); }
#endif
#ifndef NO_SCAN
        if (bx < 64) scan_wg(P, l, bx, lds, fresh_tid(wave));
#endif
        {
            unsigned* qctr = (unsigned*)(ws + WS_BAR) + 3600 + l;
            volatile unsigned* qslot = (volatile unsigned*)(lds + LDS_BYTES - 128);
            bool have_pw = false;
            for (;;) {
                const int tid = fresh_tid(wave);
                __syncthreads();
                if (tid == 0) *qslot = atomicAdd(qctr, 1u);
                __syncthreads();
                const int it = (int)*qslot;
                if (it >= 128 + 272 + 64) break;
                if (it < 128) { sample_delta(P, l, it, lds, wave); have_pw = false; }
                else if (it < 400) {
                    if (!have_pw) {
                        for (int i = tid; i < 16384; i += NTHREADS) { const int e = i & 63, c = (i >> 6) & 63, g = i >> 12; ((bf16*)(lds + PL_PW))[(g * 64 + e) * 72 + c] = (bf16)f2bf(P->in[13][(size_t)l * 16384 + i]); }
                        __syncthreads(); have_pw = true;
                    }
                    pool_tile(P, l, it - 128, lds, wave);
                } else state_copies(P, l, (it - 400) * NTHREADS + tid, 64 * NTHREADS);
            }
        }
        GSYNC();
        { const int tf = fresh_tid(wave); p2d(P, l, bx * NWAVES + __builtin_amdgcn_readfirstlane(tf >> 6), ngw, tf & 63); }
        GSYNC();
#ifdef PROBE_P2D2
        { const int tf = fresh_tid(wave); p2d(P, l, bx * NWAVES + __builtin_amdgcn_readfirstlane(tf >> 6), ngw, tf & 63); }
        GSYNC();
        { const int tf = fresh_tid(wave); p2d(P, l, bx * NWAVES + __builtin_amdgcn_readfirstlane(tf >> 6), ngw, tf & 63); }
        GSYNC();
        { const int tf = fresh_tid(wave); p2d(P, l, bx * NWAVES + __builtin_amdgcn_readfirstlane(tf >> 6), ngw, tf & 63); }
        GSYNC();
#endif
        {
            const bf16* gA = XA; const bf16* gB = (const bf16*)(ws + WS_WOUT) + (size_t)l * D * D; LAUNDER(gA); LAUNDER(gB);
            pg8::Gemm g{gA, gB, MP, D, D, D, D}; pg8::StaticOrder S; S.init(MP, D, G, bx);
            EpiResid E{l == 0 ? P->in[0] : XRES, l == 0 ? P->in[1] : XRES + (size_t)MP * D, XRES, XB2, SSQ + (size_t)(2 * l + 1) * M, 0};
            pg8::gemm_phase<EpiResid, pg8::StaticOrder, true, true>((PG8_LAS unsigned char*)lds, g, S, E, wave);
            const int ks = bx >> 4; const bf16* gA2 = XA + (size_t)MP * D + ks * 256; const bf16* gB2 = gB + ks * 256; LAUNDER(gA2); LAUNDER(gB2);
            pg8::Gemm g2{gA2, gB2, MS, D, 256, D, D}; SplitOrder S2{bx < 64 ? (bx & 15) : -1};
            EpiAtomic E2{(float*)(ws + WS_GU) + (size_t)ks * MS * D};
            pg8::gemm_phase<EpiAtomic, SplitOrder, true, true>((PG8_LAS unsigned char*)lds, g2, S2, E2, wave);
        }
        GSYNC();
        fin_sample(XRES + (size_t)MP * D, XB2 + (size_t)MP * D, SSQ + (size_t)(2 * l + 1) * M + MP, (const float*)(ws + WS_GU), 4, nullptr, 0, bx * NWAVES + wave, ngw, lane_id());
        GSYNC();
        {
            const bf16* gA = XB2; const bf16* gB = (const bf16*)(ws + WS_WGU) + (size_t)l * NGU * D; LAUNDER(gA); LAUNDER(gB);
            pg8::Gemm g{gA, gB, M, NGU, D, D, D}; pg8::StaticOrder S; S.init(M, NGU, G, bx);
            EpiGateUp E{GU, SSQ + (size_t)(2 * l + 1) * M, P->in[19] + (size_t)(l * 3) * FF, P->in[6] + (size_t)l * DBATCH * 2 * FF, (float*)(ws + WS_HAL), (float*)(ws + WS_FIXG), (float*)(ws + WS_FIXU),
                        P->out + O_PFFN + (size_t)l * NBATCH * 2 * FF, P->out + O_SFFN + (size_t)l * DBATCH * 2 * FF, lds};
            pg8::gemm_phase<EpiGateUp, pg8::StaticOrder, true, true>((PG8_LAS unsigned char*)lds, g, S, E, wave);
#ifdef PROBE_P4X2
            __syncthreads();
            pg8::gemm_phase<EpiGateUp, pg8::StaticOrder, true, true>((PG8_LAS unsigned char*)lds, g, S, E, wave);
#endif
        }
        GSYNC();
        p4_fixup(P, l, bx * NTHREADS + fresh_tid(wave), ngt);
        if (l == 0) { const int tf = fresh_tid(wave); convert_win(P, 1, (float*)(lds + wave * 16384), bx * NWAVES + wave, ngw, tf & 63); }
        GSYNC();
        {
            const bf16* gA = GU; const bf16* gB = (const bf16*)(ws + WS_WDN) + (size_t)l * D * FF; LAUNDER(gA); LAUNDER(gB);
            pg8::Gemm g{gA, gB, MP, D, FF, FF, FF}; pg8::StaticOrder S; S.init(MP, D, G, bx);
            EpiResid E{XRES, XRES + (size_t)MP * D, XRES, XA, SSQ + (size_t)(2 * l + 2) * M, 0};
            pg8::gemm_phase<EpiResid, pg8::StaticOrder, true, true>((PG8_LAS unsigned char*)lds, g, S, E, wave);
            const int ks = bx >> 4; const bf16* gA2 = GU + (size_t)MP * FF + ks * 256; const bf16* gB2 = gB + ks * 256; LAUNDER(gA2); LAUNDER(gB2);
            pg8::Gemm g2{gA2, gB2, MS, D, 256, FF, FF}; SplitOrder S2{bx < 176 ? (bx & 15) : -1};
            EpiAtomic E2{ks < 8 ? (float*)(ws + WS_PROJ) + (size_t)ks * MS * D : (float*)(ws + WS_PART2) + (size_t)(ks - 8) * MS * D};
            pg8::gemm_phase<EpiAtomic, SplitOrder, true, true>((PG8_LAS unsigned char*)lds, g2, S2, E2, wave);
        }
        GSYNC();
        fin_sample(XRES + (size_t)MP * D, XA + (size_t)MP * D, SSQ + (size_t)(2 * l + 2) * M + MP, (const float*)(ws + WS_PROJ), 8, (const float*)(ws + WS_PART2), 3, bx * NWAVES + wave, ngw, lane_id());
        GSYNC();
    }
    {
        const float* ssq = SSQ + (size_t)4 * M; const float* fn = P->in[22];
        const int gt = bx * NTHREADS + fresh_tid(wave);
        for (int i0 = gt; i0 < M * 256; i0 += 4 * ngt) {
            f32x4 v[4]; float sq[4];
#pragma unroll
            for (int q = 0; q < 4; ++q) { const int i = i0 + q * ngt; v[q] = (f32x4){0.f, 0.f, 0.f, 0.f}; sq[q] = 1.f;
                if (i < M * 256) { v[q] = ((const f32x4*)XRES)[i]; sq[q] = ssq[i >> 8]; } }
#pragma unroll
            for (int q = 0; q < 4; ++q) { const int i = i0 + q * ngt;
                if (i < M * 256) { const float rs = rsqrtf(sq[q] * (1.f / D) + EPS); const f32x4 gv = ((const f32x4*)fn)[i & 255];
                    f32x4 o = v[q]; o[0] *= rs * gv[0]; o[1] *= rs * gv[1]; o[2] *= rs * gv[2]; o[3] *= rs * gv[3];
                    ((f32x4*)XRES)[i] = o; } }
        }
    }
}

extern "C" void kernel_launch(void* const* d_in, const int* in_sizes, int n_in, void* d_out, int out_size, void* d_ws, size_t ws_size, hipStream_t stream) {
    static int grid = 0;
    if (grid == 0) {
        if (n_in != 23 || (size_t)out_size != O_TOTAL || ws_size < WS_END) { fprintf(stderr, "kernel_launch: unexpected shapes: n_in %d out %d ws %zu\n", n_in, out_size, ws_size); grid = -1; return; }
        int dev = 0, cus = 0, per_cu = 0;
        hipGetDevice(&dev); hipDeviceGetAttribute(&cus, hipDeviceAttributeMultiprocessorCount, dev);
        if (hipFuncSetAttribute((const void*)fwd_megakernel, hipFuncAttributeMaxDynamicSharedMemorySize, LDS_BYTES) != hipSuccess) { fprintf(stderr, "kernel_launch: hipFuncSetAttribute failed\n"); grid = -1; return; }
        hipOccupancyMaxActiveBlocksPerMultiprocessor(&per_cu, (const void*)fwd_megakernel, NTHREADS, LDS_BYTES);
        (void)hipGetLastError();
        if (per_cu < 1) fprintf(stderr, "kernel_launch: occupancy query reports %d blocks per CU\n", per_cu);
        grid = cus;
    }
    if (grid < 0) return;
    if (hipMemsetAsync((char*)d_ws + WS_BAR, 0, 16384, stream) != hipSuccess) { fprintf(stderr, "kernel_launch: memset failed\n"); return; }
    Params p{};
    for (int i = 0; i < 23; ++i) p.in[i] = (const float*)d_in[i];
    p.out = (float*)d_out; p.ws = (unsigned char*)d_ws;
    void* args[] = {&p};
    hipError_t e = hipLaunchCooperativeKernel((const void*)fwd_megakernel, dim3(grid), dim3(NTHREADS), args, LDS_BYTES, stream);
    if (e != hipSuccess) fprintf(stderr, "cooperative launch failed: %s (grid %d)\n", hipGetErrorString(e), grid);
}
```

```cpp
#include <hip/hip_runtime.h>
#include <hip/hip_cooperative_groups.h>
#include <cstdio>
#include <cstdint>
namespace cg = cooperative_groups;
__device__ __forceinline__ int lane_id() { int t; asm volatile("v_mbcnt_lo_u32_b32 %0, -1, 0\n\tv_mbcnt_hi_u32_b32 %0, -1, %0" : "=v"(t)); return t; }
__device__ __forceinline__ int fresh_tid(int wave) { return (wave << 6) | lane_id(); }
namespace pg8 {
#define PG8_LAS __attribute__((address_space(3)))
typedef unsigned short bf16_t;
typedef short bf16x8 __attribute__((ext_vector_type(8)));
typedef float f32x4 __attribute__((ext_vector_type(4)));
typedef unsigned u32x4 __attribute__((ext_vector_type(4)));
constexpr int BM = 256, BK = 64, HALF = 128, HTB = HALF * BK * 2  , STAGE_BYTES = 8 * HTB, NXCD = 8, WGM = 8;

__host__ __device__ __forceinline__ int lds_byte(int r, int c) { const int st = (r >> 4) * 2 + (c >> 5), rr = r & 15, cc = c & 31, ob = rr * 64 + cc * 2; return st * 1024 + (ob ^ (((ob >> 9) & 1) << 5)); }
__host__ __device__ __forceinline__ void stage_rc(int b, int& R, int& C) { const int st = b / 1024, sb = b % 1024, swz = sb ^ (((sb >> 9) & 1) << 5); R = (st >> 1) * 16 + swz / 64; C = (st & 1) * 32 + (swz % 64) / 2; }
__host__ __device__ __forceinline__ int perm32(int rho) { const int n = rho >> 4, i = rho & 15; return 8 * (i >> 2) + 4 * n + (i & 3); }

struct Unit { int pm, pn; };
struct Gemm { const bf16_t* A; const bf16_t* Bt; int M, N, K, lda, ldb; };

struct StaticOrder {
    int nM, nN, nwg, G, c;
    __host__ __device__ void init(int M, int N, int G_, int c_) { nM = M / BM; nN = N / BM; nwg = nM * nN; G = G_; c = c_; }
    __host__ __device__ bool next(int i, Unit& u) const {
        const long L = (long)i * G + c; if (L >= nwg) return false;
        int wgid = (int)L; { const int q = nwg / NXCD, r = nwg % NXCD, xcd = wgid % NXCD, off = wgid / NXCD; wgid = (xcd < r ? xcd * (q + 1) : r * (q + 1) + (xcd - r) * q) + off; }
        const int nig = WGM * nN, gid = wgid / nig, fm = gid * WGM, gsz = (nM - fm) < WGM ? (nM - fm) : WGM;
        u.pm = fm + ((wgid % nig) % gsz); u.pn = (wgid % nig) / gsz; return true;
    }
    __device__ __forceinline__ void a_ready(const Unit&) const {}
    __device__ __forceinline__ void done(const Unit&) const {}
};

template <class Epi, class Sched, bool ALIGN_EPI = false, bool SP2 = false>
__device__ __forceinline__ void gemm_phase(PG8_LAS unsigned char* lds, const Gemm g, const Sched& S, const Epi& E, const int wave_in) {
    const int tid = fresh_tid(wave_in), wid = __builtin_amdgcn_readfirstlane(tid >> 6), lane = tid & 63, wr = wid >> 2, wc = wid & 3, fr = lane & 15, fq = lane >> 4;
    const int K = g.K, nt = K / BK;
    unsigned voffA[2], voffB[2];
#pragma unroll
    for (int i = 0; i < 2; ++i) { int R, C; stage_rc(tid * 16 + i * 8192, R, C); const int Rb = Epi::PERM ? ((R & ~31) + perm32(R & 31)) : R;
        voffA[i] = (unsigned)(R * g.lda + C) * 2u; voffB[i] = (unsigned)(Rb * g.ldb + C) * 2u; }
    const size_t kstep = (size_t)(BK * 2);
    const size_t hstepA = (size_t)HALF * g.lda * 2, hstepB = (size_t)HALF * g.ldb * 2;
    const size_t tstepA = 2 * hstepA, tstepB = 2 * hstepB;
    const unsigned ldsw = (unsigned)wid * 1024u;
    const int aoff = lds_byte(wr * 64 + fr, fq * 8), boff = lds_byte(wc * 32 + fr, fq * 8);
#define PG8_SA(b, h) (((b) * 2 + (h)) * HTB)
#define PG8_SB(b, h) ((4 + (b) * 2 + (h)) * HTB)
#define PG8_STAGE(bufoff, gbase, voff) do { _Pragma("unroll") for (int _i = 0; _i < 2; ++_i) \
        __builtin_amdgcn_global_load_lds((const unsigned*)((const char*)(gbase) + (voff)[_i]), (PG8_LAS unsigned*)(lds + (bufoff) + ldsw + _i * 8192), 16, 0, 0); } while (0)
#define PG8_LDA(dst, b, h) do { _Pragma("unroll") for (int m = 0; m < 4; ++m) _Pragma("unroll") for (int k = 0; k < 2; ++k) dst[m][k] = *(const PG8_LAS bf16x8*)(lds + PG8_SA(b, h) + aoff + m * 2048 + k * 1024); } while (0)
#define PG8_LDB(dst, b, h) do { _Pragma("unroll") for (int n = 0; n < 2; ++n) _Pragma("unroll") for (int k = 0; k < 2; ++k) dst[n][k] = *(const PG8_LAS bf16x8*)(lds + PG8_SB(b, h) + boff + n * 2048 + k * 1024); } while (0)
#define PG8_MMA(ai, bj, At, Bt) do { __builtin_amdgcn_s_setprio(1); _Pragma("unroll") for (int m = 0; m < 4; ++m) _Pragma("unroll") for (int n = 0; n < 2; ++n) _Pragma("unroll") for (int k = 0; k < 2; ++k) \
        acc[ai][bj][m][n] = __builtin_amdgcn_mfma_f32_16x16x32_bf16(Bt[n][k], At[m][k], acc[ai][bj][m][n], 0, 0, 0); __builtin_amdgcn_s_setprio(0); } while (0)
#define PG8_WAIT_V(n) asm volatile("s_waitcnt vmcnt(" #n ")" ::: "memory")
#define PG8_WAIT_L(n) asm volatile("s_waitcnt lgkmcnt(" #n ")" ::: "memory")
#define PG8_BAR __builtin_amdgcn_s_barrier()
#define PG8_SCHED __builtin_amdgcn_sched_barrier(0)
    Unit cur, nxt; int ui = 0;
    if (!S.next(0, cur)) return;
    f32x4 acc[2][2][4][2];
#pragma unroll
    for (int a = 0; a < 2; ++a)
#pragma unroll
        for (int b = 0; b < 2; ++b)
#pragma unroll
            for (int m = 0; m < 4; ++m)
#pragma unroll
                for (int n = 0; n < 2; ++n) acc[a][b][m][n] = (f32x4){0.f, 0.f, 0.f, 0.f};
    bf16x8 At[4][2], B0[2][2], B1[2][2];
    const char* cA = (const char*)g.A + (size_t)cur.pm * tstepA; const char* cB = (const char*)g.Bt + (size_t)cur.pn * tstepB;
    S.a_ready(cur);
    if constexpr (SP2) {
        PG8_STAGE(PG8_SB(0, 0), cB, voffB); PG8_STAGE(PG8_SB(0, 1), cB + hstepB, voffB); PG8_STAGE(PG8_SA(0, 0), cA, voffA); PG8_STAGE(PG8_SA(0, 1), cA + hstepA, voffA);
        if (wr == 1) PG8_BAR;
        PG8_WAIT_V(2); PG8_BAR;
        PG8_STAGE(PG8_SB(1, 0), cB + kstep, voffB); PG8_STAGE(PG8_SA(1, 0), cA + kstep, voffA); PG8_STAGE(PG8_SB(1, 1), cB + hstepB + kstep, voffB);
        PG8_WAIT_V(6); PG8_BAR;
    } else {
        PG8_STAGE(PG8_SB(0, 0), cB, voffB); PG8_STAGE(PG8_SA(0, 0), cA, voffA); PG8_STAGE(PG8_SB(0, 1), cB + hstepB, voffB); PG8_STAGE(PG8_SA(0, 1), cA + hstepA, voffA);
        if (wr == 1) PG8_BAR;
        PG8_WAIT_V(4); PG8_BAR;
        PG8_STAGE(PG8_SB(1, 0), cB + kstep, voffB); PG8_STAGE(PG8_SA(1, 0), cA + kstep, voffA); PG8_STAGE(PG8_SB(1, 1), cB + hstepB + kstep, voffB);
        PG8_WAIT_V(6); PG8_BAR;
    }
    for (;;) {
        const bool has_next = S.next(ui + 1, nxt);
        const char* nA = has_next ? (const char*)g.A + (size_t)nxt.pm * tstepA : cA; const char* nB = has_next ? (const char*)g.Bt + (size_t)nxt.pn * tstepB : cB;
        for (int t = 0; t < nt; t += 2) {
            const bool last = (t == nt - 2);
            const char* a1 = cA + (size_t)(t + 1) * kstep;
            const char* a2 = last ? nA : cA + (size_t)(t + 2) * kstep; const char* b2 = last ? nB : cB + (size_t)(t + 2) * kstep;
            const char* a3 = a2 + kstep; const char* b3 = b2 + kstep;
            if (last && has_next) S.a_ready(nxt);
            if constexpr (SP2) {
            PG8_LDB(B0, 0, 0); PG8_LDB(B1, 0, 1); PG8_SCHED; PG8_LDA(At, 0, 0); PG8_STAGE(PG8_SA(1, 1), a1 + hstepA, voffA);
            PG8_WAIT_V(8); PG8_WAIT_L(0); PG8_BAR; PG8_MMA(0, 0, At, B0); PG8_MMA(0, 1, At, B1); PG8_BAR; PG8_SCHED;
            PG8_LDA(At, 0, 1); PG8_STAGE(PG8_SB(0, 0), b2, voffB); PG8_STAGE(PG8_SB(0, 1), b2 + hstepB, voffB); PG8_STAGE(PG8_SA(0, 0), a2, voffA);
            PG8_WAIT_V(8); PG8_WAIT_L(0); PG8_BAR; PG8_MMA(1, 0, At, B0); PG8_MMA(1, 1, At, B1); PG8_BAR; PG8_SCHED;
            PG8_LDB(B0, 1, 0); PG8_LDB(B1, 1, 1); PG8_SCHED; PG8_LDA(At, 1, 0); PG8_STAGE(PG8_SA(0, 1), a2 + hstepA, voffA);
            PG8_WAIT_V(8); PG8_WAIT_L(0); PG8_BAR; PG8_MMA(0, 0, At, B0); PG8_MMA(0, 1, At, B1); PG8_BAR; PG8_SCHED;
            PG8_LDA(At, 1, 1); PG8_STAGE(PG8_SB(1, 0), b3, voffB); PG8_STAGE(PG8_SB(1, 1), b3 + hstepB, voffB); PG8_STAGE(PG8_SA(1, 0), a3, voffA);
            PG8_WAIT_V(8); PG8_WAIT_L(0); PG8_BAR; PG8_MMA(1, 0, At, B0); PG8_MMA(1, 1, At, B1); PG8_BAR; PG8_SCHED;
            } else {
            PG8_LDB(B0, 0, 0); PG8_SCHED; PG8_LDA(At, 0, 0); PG8_STAGE(PG8_SA(1, 1), a1 + hstepA, voffA);
            PG8_WAIT_L(8); PG8_BAR; PG8_WAIT_L(0); PG8_MMA(0, 0, At, B0); PG8_BAR; PG8_SCHED;
            PG8_LDB(B1, 0, 1); PG8_STAGE(PG8_SB(0, 0), b2, voffB);
            PG8_BAR; PG8_WAIT_L(0); PG8_MMA(0, 1, At, B1); PG8_BAR;
            PG8_LDA(At, 0, 1); PG8_STAGE(PG8_SA(0, 0), a2, voffA);
            PG8_BAR; PG8_WAIT_L(0); PG8_MMA(1, 0, At, B0); PG8_BAR; PG8_SCHED;
            PG8_STAGE(PG8_SB(0, 1), b2 + hstepB, voffB);
            PG8_WAIT_V(6); PG8_BAR; PG8_MMA(1, 1, At, B1); PG8_BAR;
            PG8_LDB(B0, 1, 0); PG8_SCHED; PG8_LDA(At, 1, 0); PG8_STAGE(PG8_SA(0, 1), a2 + hstepA, voffA);
            PG8_WAIT_L(8); PG8_BAR; PG8_WAIT_L(0); PG8_MMA(0, 0, At, B0); PG8_BAR; PG8_SCHED;
            PG8_LDB(B1, 1, 1); PG8_STAGE(PG8_SB(1, 0), b3, voffB);
            PG8_BAR; PG8_WAIT_L(0); PG8_MMA(0, 1, At, B1); PG8_BAR;
            PG8_LDA(At, 1, 1); PG8_STAGE(PG8_SA(1, 0), a3, voffA);
            PG8_BAR; PG8_WAIT_L(0); PG8_MMA(1, 0, At, B0); PG8_BAR; PG8_SCHED;
            PG8_STAGE(PG8_SB(1, 1), b3 + hstepB, voffB);
            PG8_WAIT_V(6); PG8_BAR; PG8_MMA(1, 1, At, B1); PG8_BAR;
            }
        }
        if constexpr (ALIGN_EPI) { if (wr == 0) PG8_BAR; }
        if constexpr (!Epi::AFTER_DRAIN) { E(acc, cur, wr, wc, fr, fq); S.done(cur); }
        if (!has_next) break;
#pragma unroll
        for (int a = 0; a < 2; ++a)
#pragma unroll
            for (int b = 0; b < 2; ++b)
#pragma unroll
                for (int m = 0; m < 4; ++m)
#pragma unroll
                    for (int n = 0; n < 2; ++n) acc[a][b][m][n] = (f32x4){0.f, 0.f, 0.f, 0.f};
        cur = nxt; cA = nA; cB = nB; ++ui;
        if constexpr (ALIGN_EPI) { if (wr == 1) PG8_BAR; }
    }
    PG8_WAIT_V(0);
    if constexpr (!ALIGN_EPI) { if (wr == 0) PG8_BAR; }
    PG8_BAR;
    if constexpr (Epi::AFTER_DRAIN) { E.fused(acc, cur, wr, wc, fr, fq, lds, wid, lane); S.done(cur); }
#undef PG8_SA
#undef PG8_SB
#undef PG8_STAGE
#undef PG8_LDA
#undef PG8_LDB
#undef PG8_MMA
#undef PG8_WAIT_V
#undef PG8_WAIT_L
#undef PG8_BAR
#undef PG8_SCHED
}
}

typedef unsigned short bf16;
typedef unsigned v4u __attribute__((ext_vector_type(4)));
typedef unsigned v2u __attribute__((ext_vector_type(2)));
typedef float f32x4 __attribute__((ext_vector_type(4)));
typedef short bf16x8 __attribute__((ext_vector_type(8)));

constexpr int D = 1024, MP = 16384, MS = 1024, M = MP + MS, SEQL = 2048, NBATCH = 8, DBATCH = 128;
constexpr int NPROJ = 3072, FF = 2816, NGU = 5632, DIN = 3080, MH = M / 2;
constexpr float EPS = 1e-6f;
constexpr int NTHREADS = 512, NWAVES = 8;
constexpr int LDS_BYTES = 155648;
constexpr size_t MiB = 1u << 20;
constexpr size_t WS_WOUT = 0, WS_WGU = 4 * MiB, WS_WDN = 26 * MiB, WS_XA = 37 * MiB, WS_PROJ = 71 * MiB, WS_GU = 105 * MiB, WS_SCR = 173 * MiB, WS_WIN = 239 * MiB;
constexpr size_t WS_GB = 245 * MiB, WS_SSQ = 245 * MiB + 576 * 1024, WS_WAB = 246 * MiB, WS_GL = 246 * MiB + 64 * 1024, WS_HALO = 246 * MiB + 128 * 1024, WS_BAR = 246 * MiB + 192 * 1024, WS_PART2 = 200 * MiB, WS_HAL = 247 * MiB, WS_FIXG = 249 * MiB, WS_FIXU = 251 * MiB, WS_END = 253 * MiB;
constexpr int SCR_ITEM = 73728;
constexpr size_t O_PDELTA = 17825792, O_PDCONV = 18874368, O_PPOOL = 18948096, O_PSCONV = 19009536, O_PFFN = 19017728;
constexpr size_t O_SDELTA = 19107840, O_SDCONV = 35885056, O_SPOOL = 37064704, O_SSCONV = 38047744, O_SFFN = 38178816, O_TOTAL = 39620608;

struct Params { const float* in[23]; float* out; unsigned char* ws; };
typedef const __attribute__((address_space(4))) Params* KP;
__device__ __forceinline__ KP kparams() { KP p = (KP)__builtin_amdgcn_kernarg_segment_ptr(); asm volatile("" : "+s"(p)); return p; }

#define LAUNDER(p) asm volatile("" : "+s"(p))
#define LDS_WAIT() asm volatile("s_waitcnt lgkmcnt(0)" ::: "memory")
__device__ __forceinline__ unsigned f2bf(float f) { unsigned u = __builtin_bit_cast(unsigned, f); return (u + 0x7fffu + ((u >> 16) & 1u)) >> 16; }
__device__ __forceinline__ unsigned pk2(float lo, float hi) { return f2bf(lo) | (f2bf(hi) << 16); }
__device__ __forceinline__ float bflo(unsigned u) { return __builtin_bit_cast(float, u << 16); }
__device__ __forceinline__ float bfhi(unsigned u) { return __builtin_bit_cast(float, u & 0xffff0000u); }
__device__ __forceinline__ float bf1(bf16 h) { return __builtin_bit_cast(float, ((unsigned)h) << 16); }
__device__ __forceinline__ float siluf(float x) { return x * __builtin_amdgcn_rcpf(1.f + __expf(-x)); }
__device__ __forceinline__ float shx(float v, int m) { return __builtin_bit_cast(float, __builtin_amdgcn_ds_bpermute((lane_id() ^ m) << 2, __builtin_bit_cast(int, v))); }
__device__ __forceinline__ float rdl(float v, int l) { return __builtin_bit_cast(float, __builtin_amdgcn_readlane(__builtin_bit_cast(int, v), l)); }
template <int CTRL> __device__ __forceinline__ float dpp_mov(float v) { const int i = __builtin_bit_cast(int, v); return __builtin_bit_cast(float, __builtin_amdgcn_update_dpp(i, i, CTRL, 0xf, 0xf, false)); }
__device__ __forceinline__ float wave_sum(float v) {
    v += dpp_mov<0x128>(v); v += dpp_mov<0x124>(v); v += dpp_mov<0x122>(v); v += dpp_mov<0x121>(v);
    const int i = __builtin_bit_cast(int, v);
    return (__builtin_bit_cast(float, __builtin_amdgcn_readlane(i, 0)) + __builtin_bit_cast(float, __builtin_amdgcn_readlane(i, 16))) +
           (__builtin_bit_cast(float, __builtin_amdgcn_readlane(i, 32)) + __builtin_bit_cast(float, __builtin_amdgcn_readlane(i, 48)));
}
#define UNPACK8(W_, F_) do { (F_)[0] = bflo((W_).x); (F_)[1] = bfhi((W_).x); (F_)[2] = bflo((W_).y); (F_)[3] = bfhi((W_).y); (F_)[4] = bflo((W_).z); (F_)[5] = bfhi((W_).z); (F_)[6] = bflo((W_).w); (F_)[7] = bfhi((W_).w); } while (0)
#define PACK8(F_) ((v4u){pk2((F_)[0], (F_)[1]), pk2((F_)[2], (F_)[3]), pk2((F_)[4], (F_)[5]), pk2((F_)[6], (F_)[7])})

struct EpiScale {
    static constexpr bool PERM = true, AFTER_DRAIN = false;
    bf16* O; int ldc; const float* ssq;
    __device__ __forceinline__ void operator()(const pg8::f32x4 (&acc)[2][2][4][2], const pg8::Unit& u, int wr, int wc, int fr, int fq) const {
        const int row0 = u.pm * 256 + wr * 64 + fr, col0 = u.pn * 256 + wc * 32 + 8 * fq;
        float sq[2][4];
#pragma unroll
        for (int ai = 0; ai < 2; ++ai)
#pragma unroll
            for (int m = 0; m < 4; ++m) sq[ai][m] = ssq[row0 + ai * 128 + m * 16];
#pragma unroll
        for (int ai = 0; ai < 2; ++ai)
#pragma unroll
            for (int m = 0; m < 4; ++m) {
                const int row = row0 + ai * 128 + m * 16;
                const float rs = rsqrtf(sq[ai][m] * (1.f / D) + EPS);
                bf16* rowp = O + (size_t)row * ldc + col0;
#pragma unroll
                for (int bj = 0; bj < 2; ++bj) {
                    pg8::f32x4 v0 = acc[ai][bj][m][0] * rs, v1 = acc[ai][bj][m][1] * rs;
                    v4u w; w.x = pk2(v0[0], v0[1]); w.y = pk2(v0[2], v0[3]); w.z = pk2(v1[0], v1[1]); w.w = pk2(v1[2], v1[3]);
                    *(v4u*)(rowp + bj * 128) = w;
                }
            }
    }
};
struct EpiResid {
    static constexpr bool PERM = true, AFTER_DRAIN = false;
    const float* xa; const float* xb_; float* xres; bf16* xb16; float* ssq; int rowbase;
    __device__ __forceinline__ void operator()(const pg8::f32x4 (&acc)[2][2][4][2], const pg8::Unit& u, int wr, int wc, int fr, int fq) const {
        const int row0 = rowbase + u.pm * 256 + wr * 64 + fr, col0 = u.pn * 256 + wc * 32 + 8 * fq;
#pragma unroll
        for (int ai = 0; ai < 2; ++ai) {
            pg8::f32x4 xo4[4][4];
#pragma unroll
            for (int m = 0; m < 4; ++m) {
                const int row = row0 + ai * 128 + m * 16;
                const float* xo = (row < MP ? xa + (size_t)row * D : xb_ + (size_t)(row - MP) * D) + col0;
                xo4[m][0] = *(const pg8::f32x4*)xo; xo4[m][1] = *(const pg8::f32x4*)(xo + 4); xo4[m][2] = *(const pg8::f32x4*)(xo + 128); xo4[m][3] = *(const pg8::f32x4*)(xo + 132);
            }
#pragma unroll
            for (int m = 0; m < 4; ++m) {
                const int row = row0 + ai * 128 + m * 16;
                float* xr = xres + (size_t)row * D + col0;
                bf16* xh = xb16 + (size_t)row * D + col0;
                float ss = 0.f;
#pragma unroll
                for (int bj = 0; bj < 2; ++bj) {
                    pg8::f32x4 v0 = acc[ai][bj][m][0] + xo4[m][2 * bj], v1 = acc[ai][bj][m][1] + xo4[m][2 * bj + 1];
                    *(pg8::f32x4*)(xr + bj * 128) = v0; *(pg8::f32x4*)(xr + bj * 128 + 4) = v1;
                    v4u w; w.x = pk2(v0[0], v0[1]); w.y = pk2(v0[2], v0[3]); w.z = pk2(v1[0], v1[1]); w.w = pk2(v1[2], v1[3]);
                    *(v4u*)(xh + bj * 128) = w;
                    ss += v0[0] * v0[0] + v0[1] * v0[1] + v0[2] * v0[2] + v0[3] * v0[3] + v1[0] * v1[0] + v1[1] * v1[1] + v1[2] * v1[2] + v1[3] * v1[3];
                }
                ss += shx(ss, 16); ss += shx(ss, 32);
                if (fq == 0) atomicAdd(ssq + row, ss);
            }
        }
    }
};


struct SplitOrder {
    int unit;
    __device__ __forceinline__ bool next(int i, pg8::Unit& u) const { if (i != 0 || unit < 0) return false; u.pm = unit >> 2; u.pn = unit & 3; return true; }
    __device__ __forceinline__ void a_ready(const pg8::Unit&) const {}
    __device__ __forceinline__ void done(const pg8::Unit&) const {}
};
struct EpiAtomic {
    static constexpr bool PERM = true, AFTER_DRAIN = false;
    float* X;
    __device__ __forceinline__ void operator()(const pg8::f32x4 (&acc)[2][2][4][2], const pg8::Unit& u, int wr, int wc, int fr, int fq) const {
        const int row0 = u.pm * 256 + wr * 64 + fr, col0 = u.pn * 256 + wc * 32 + 8 * fq;
#pragma unroll
        for (int ai = 0; ai < 2; ++ai)
#pragma unroll
            for (int m = 0; m < 4; ++m) {
                float* xr = X + (size_t)(row0 + ai * 128 + m * 16) * D + col0;
#pragma unroll
                for (int bj = 0; bj < 2; ++bj) { *(pg8::f32x4*)(xr + bj * 128) = acc[ai][bj][m][0]; *(pg8::f32x4*)(xr + bj * 128 + 4) = acc[ai][bj][m][1]; }
            }
    }
};
__device__ __forceinline__ void fin_sample(float* X, bf16* XB, float* ssq, const float* partA, int nA, const float* partB, int nB, int gw, int ngw, int lane) {
    for (int r = gw; r < MS; r += ngw) {
        f32x4 v[4];
#pragma unroll
        for (int j = 0; j < 4; ++j) v[j] = ((const f32x4*)(X + (size_t)r * D))[lane + 64 * j];
        for (int k = 0; k < nA; ++k) {
#pragma unroll
            for (int j = 0; j < 4; ++j) v[j] += ((const f32x4*)(partA + ((size_t)k * MS + r) * D))[lane + 64 * j];
        }
        for (int k = 0; k < nB; ++k) {
#pragma unroll
            for (int j = 0; j < 4; ++j) v[j] += ((const f32x4*)(partB + ((size_t)k * MS + r) * D))[lane + 64 * j];
        }
        float ss = 0.f;
#pragma unroll
        for (int j = 0; j < 4; ++j) { ss += v[j][0] * v[j][0] + v[j][1] * v[j][1] + v[j][2] * v[j][2] + v[j][3] * v[j][3];
            ((f32x4*)(X + (size_t)r * D))[lane + 64 * j] = v[j];
            ((v2u*)(XB + (size_t)r * D))[lane + 64 * j] = (v2u){pk2(v[j][0], v[j][1]), pk2(v[j][2], v[j][3])}; }
        ss = wave_sum(ss);
        if (lane == 0) ssq[r] = ss;
    }
}

constexpr int EPI_HALO_OFF = 131072;
__device__ __forceinline__ float dpp_f(float oldv, float src, const int ctrl_sel) {
    const int o = __builtin_bit_cast(int, oldv), v = __builtin_bit_cast(int, src); int r;
    if (ctrl_sel == 0) r = __builtin_amdgcn_update_dpp(o, v, 0x111, 0xf, 0xf, false);
    else if (ctrl_sel == 1) r = __builtin_amdgcn_update_dpp(o, v, 0x112, 0xf, 0xf, false);
    else if (ctrl_sel == 2) r = __builtin_amdgcn_update_dpp(o, v, 0x121, 0xf, 0xf, false);
    else r = __builtin_amdgcn_update_dpp(o, v, 0x122, 0xf, 0xf, false);
    return __builtin_bit_cast(float, r);
}
struct EpiGateUp {
    static constexpr bool PERM = true, AFTER_DRAIN = false;
    bf16* ACT; const float* ssq; const float* cw; const float* st; float* HAL; float* FIXG; float* FIXU; float* pffn; float* sffn; unsigned char* lds;
    __device__ __forceinline__ void operator()(const pg8::f32x4 (&acc)[2][2][4][2], const pg8::Unit& u, int wr, int wc, int fr, int fq) const {
        const int pm = u.pm, ch0 = u.pn * 128 + wc * 32 + 8 * fq, row0 = pm * 256 + wr * 64 + fr;
        const bool smp = pm >= 64;
        float* halo = (float*)(lds + EPI_HALO_OFF);
#pragma unroll
        for (int ai = 0; ai < 2; ++ai) {
            const float rs = rsqrtf(ssq[row0 + ai * 128 + 48] * (1.f / D) + EPS);
            if (fr >= 14) {
                float* hp = halo + ((ai * 2 + wr) * 2 + (fr - 14)) * 128 + wc * 32 + 8 * fq;
                *(pg8::f32x4*)hp = acc[ai][0][3][0] * rs; *(pg8::f32x4*)(hp + 4) = acc[ai][0][3][1] * rs;
            }
        }
        asm volatile("s_waitcnt lgkmcnt(0)" ::: "memory");
        __builtin_amdgcn_s_barrier();
        float w0[8], w1[8], w2[8];
#pragma unroll
        for (int e = 0; e < 8; ++e) { w0[e] = cw[ch0 + e]; w1[e] = cw[FF + ch0 + e]; w2[e] = cw[2 * FF + ch0 + e]; }
#pragma unroll
        for (int ai = 0; ai < 2; ++ai) {
            const int s = ai * 2 + wr;
            float prev[8];
#pragma unroll
            for (int e = 0; e < 8; ++e) prev[e] = 0.f;
            if (!smp && s >= 1 && fr >= 14) {
                const float* hp = halo + ((s - 1) * 2 + (fr - 14)) * 128 + wc * 32 + 8 * fq;
                const pg8::f32x4 h0 = *(const pg8::f32x4*)hp, h1 = *(const pg8::f32x4*)(hp + 4);
                prev[0] = h0[0]; prev[1] = h0[1]; prev[2] = h0[2]; prev[3] = h0[3]; prev[4] = h1[0]; prev[5] = h1[1]; prev[6] = h1[2]; prev[7] = h1[3];
            }
            float sq4[4];
#pragma unroll
            for (int m = 0; m < 4; ++m) sq4[m] = ssq[row0 + ai * 128 + m * 16];
#pragma unroll
            for (int m = 0; m < 4; ++m) {
                const int row = row0 + ai * 128 + m * 16;
                const float rs = rsqrtf(sq4[m] * (1.f / D) + EPS);
                float cur[8], upv[8], s0v[8], s1v[8];
#pragma unroll
                for (int e = 0; e < 8; ++e) { cur[e] = acc[ai][0][m][e >> 2][e & 3] * rs; upv[e] = acc[ai][1][m][e >> 2][e & 3] * rs; s0v[e] = 0.f; s1v[e] = 0.f; }
                const int t = fr & 7, sb = (row - MP) >> 3;
                if (smp && t < 2) {
                    const float* sp = st + (size_t)(sb * 2) * FF + ch0;
#pragma unroll
                    for (int e = 0; e < 8; ++e) { s0v[e] = sp[e]; s1v[e] = sp[FF + e]; }
                }
                float a[8];
#pragma unroll
                for (int e = 0; e < 8; ++e) {
                    const float sh1 = dpp_f(cur[e], cur[e], 0), sh2 = dpp_f(cur[e], cur[e], 1), ro1 = dpp_f(prev[e], prev[e], 2), ro2 = dpp_f(prev[e], prev[e], 3);
                    float p1, p2;
                    if (smp) { p1 = t >= 1 ? sh1 : s1v[e]; p2 = t >= 2 ? sh2 : (t == 1 ? s1v[e] : s0v[e]); }
                    else { p1 = fr >= 1 ? sh1 : ro1; p2 = fr >= 2 ? sh2 : ro2; }
                    a[e] = siluf(w0[e] * p2 + w1[e] * p1 + w2[e] * cur[e]) * upv[e];
                }
                *(v4u*)(ACT + (size_t)row * FF + ch0) = PACK8(a);
                if (smp) {
                    if (t >= 6) { float* o = sffn + (size_t)(sb * 2 + t - 6) * FF + ch0;
                        *(pg8::f32x4*)o = (pg8::f32x4){cur[0], cur[1], cur[2], cur[3]}; *(pg8::f32x4*)(o + 4) = (pg8::f32x4){cur[4], cur[5], cur[6], cur[7]}; }
                } else {
                    if (s == 3 && m == 3 && fr >= 14) {
                        float* o = HAL + (size_t)(pm * 2 + fr - 14) * FF + ch0;
                        *(pg8::f32x4*)o = (pg8::f32x4){cur[0], cur[1], cur[2], cur[3]}; *(pg8::f32x4*)(o + 4) = (pg8::f32x4){cur[4], cur[5], cur[6], cur[7]};
                        if ((pm & 7) == 7) { float* o2 = pffn + (size_t)((pm >> 3) * 2 + fr - 14) * FF + ch0;
                            *(pg8::f32x4*)o2 = (pg8::f32x4){cur[0], cur[1], cur[2], cur[3]}; *(pg8::f32x4*)(o2 + 4) = (pg8::f32x4){cur[4], cur[5], cur[6], cur[7]}; }
                    }
                    if (s == 0 && m == 0 && fr < 2 && (pm & 7) != 0) {
                        float* o = FIXG + (size_t)(pm * 2 + fr) * FF + ch0; float* o2 = FIXU + (size_t)(pm * 2 + fr) * FF + ch0;
                        *(pg8::f32x4*)o = (pg8::f32x4){cur[0], cur[1], cur[2], cur[3]}; *(pg8::f32x4*)(o + 4) = (pg8::f32x4){cur[4], cur[5], cur[6], cur[7]};
                        *(pg8::f32x4*)o2 = (pg8::f32x4){upv[0], upv[1], upv[2], upv[3]}; *(pg8::f32x4*)(o2 + 4) = (pg8::f32x4){upv[4], upv[5], upv[6], upv[7]};
                    }
                }
#pragma unroll
                for (int e = 0; e < 8; ++e) prev[e] = cur[e];
            }
        }
    }
};
__device__ __forceinline__ void p4_fixup(KP P, int l, int start, int stride) {
    const float* HAL = (const float*)(P->ws + WS_HAL); const float* FIXG = (const float*)(P->ws + WS_FIXG); const float* FIXU = (const float*)(P->ws + WS_FIXU);
    bf16* ACT = (bf16*)(P->ws + WS_GU);
    const float* cw = P->in[19] + (size_t)(l * 3) * FF;
    for (int idx = start; idx < 56 * 2 * FF; idx += stride) {
        const int k = idx / (2 * FF), rem = idx % (2 * FF), rr = rem / FF, c = rem % FF;
        const int pm = (k / 7) * 8 + 1 + (k % 7);
        const float g0 = FIXG[(size_t)(pm * 2 + rr) * FF + c];
        const float g1 = rr == 0 ? HAL[(size_t)((pm - 1) * 2 + 1) * FF + c] : FIXG[(size_t)(pm * 2) * FF + c];
        const float g2 = rr == 0 ? HAL[(size_t)((pm - 1) * 2) * FF + c] : HAL[(size_t)((pm - 1) * 2 + 1) * FF + c];
        const float a = siluf(cw[c] * g2 + cw[FF + c] * g1 + cw[2 * FF + c] * g0) * FIXU[(size_t)(pm * 2 + rr) * FF + c];
        ACT[(size_t)(pm * 256 + rr) * FF + c] = (bf16)f2bf(a);
    }
}
__device__ __forceinline__ void transpose_item(const float* W, int K, int ldw, int src_col0, const float* g, bf16* WT, int dst_row0, float* scr, int kb, int lane) {
    const int k0 = 64 * kb;
    float wv[32];
#pragma unroll
    for (int i = 0; i < 32; ++i) wv[i] = W[(size_t)(k0 + 2 * i + (lane >> 5)) * ldw + src_col0 + (lane & 31)];
#pragma unroll
    for (int i = 0; i < 32; ++i) { const int kk = 2 * i + (lane >> 5); const float gs = g ? g[k0 + kk] : 1.f; scr[kk * 33 + (lane & 31)] = wv[i] * gs; }
    LDS_WAIT();
    const int c = lane & 7;
#pragma unroll
    for (int j = 0; j < 4; ++j) { const int n = (lane >> 3) + 8 * j; const float* s = scr + (8 * c) * 33 + n;
        v4u o; o.x = pk2(s[0 * 33], s[1 * 33]); o.y = pk2(s[2 * 33], s[3 * 33]); o.z = pk2(s[4 * 33], s[5 * 33]); o.w = pk2(s[6 * 33], s[7 * 33]);
        *(v4u*)(WT + (size_t)(dst_row0 + n) * K + k0 + 8 * c) = o; }
    LDS_WAIT();
}
__device__ __forceinline__ void convert_matrix(const float* W, int K, int N, int ldw, int skip_from, int skip, const float* g, bf16* WT, int dst_row0, float* scr, int gw, int ngw, int lane, int il = 0) {
    const int nnb = N / 32, nit = (K / 64) * nnb;
    for (int it = gw; it < nit; it += ngw) {
        const int kb = it / nnb, nb = it % nnb, n0 = nb * 32;
        const int drow = il ? ((n0 >> 7) * 256 + (n0 & 127) + (il == 2 ? 128 : 0)) : n0;
        transpose_item(W, K, ldw, n0 + (n0 >= skip_from ? skip : 0), g, WT, dst_row0 + drow, scr, kb, lane);
    }
}
__device__ __forceinline__ void convert_layer_rest(KP P, int l, float* scr, int gw, int ngw, int lane) {
    unsigned char* ws = P->ws;
    convert_matrix(P->in[16] + (size_t)l * D * D, D, D, D, 1 << 30, 0, nullptr, (bf16*)(ws + WS_WOUT) + (size_t)l * D * D, 0, scr, gw, ngw, lane);
    convert_matrix(P->in[18] + (size_t)l * D * FF, D, FF, FF, 1 << 30, 0, P->in[17] + l * D, (bf16*)(ws + WS_WGU) + (size_t)l * NGU * D, 0, scr, gw, ngw, lane, 1);
    convert_matrix(P->in[20] + (size_t)l * D * FF, D, FF, FF, 1 << 30, 0, P->in[17] + l * D, (bf16*)(ws + WS_WGU) + (size_t)l * NGU * D, 0, scr, gw, ngw, lane, 2);
    convert_matrix(P->in[21] + (size_t)l * FF * D, FF, D, D, 1 << 30, 0, nullptr, (bf16*)(ws + WS_WDN) + (size_t)l * D * FF, 0, scr, gw, ngw, lane);
}
__device__ __forceinline__ void convert_win(KP P, int l, float* scr, int gw, int ngw, int lane) {
    convert_matrix(P->in[8] + (size_t)l * D * DIN, D, NPROJ, DIN, 2048, 8, P->in[7] + l * D, (bf16*)(P->ws + WS_WIN), 0, scr, gw, ngw, lane);
}

constexpr int B_QF = 0, B_KF = 33792, B_VF = 67584, B_AT = 101376, B_GC = 118784, B_QKS = 120320, B_WST = 128512;
__device__ __forceinline__ void p2b_item(KP P, int l, int item, unsigned char* lds, int wave_in) {
    const int tid = fresh_tid(wave_in);
    const int h = item & 3, n = (item >> 2) & 31, b = item >> 7;
    const int lane = tid & 63, wv = __builtin_amdgcn_readfirstlane(tid >> 6), fr = lane & 15, fq = lane >> 4;
    float* QF = (float*)(lds + B_QF); float* KF = (float*)(lds + B_KF); float* VF = (float*)(lds + B_VF); float* AT = (float*)(lds + B_AT);
    float* Gs = (float*)(lds + B_GC); float* BETA = Gs + 64; float* GC = Gs + 128; float* EG = Gs + 192; float* EKD = Gs + 256;
    bf16* QKS = (bf16*)(lds + B_QKS); bf16* WST = (bf16*)(lds + B_WST);
    const bf16* PROJ = (const bf16*)(P->ws + WS_PROJ);
    const float* GB = (const float*)(P->ws + WS_GB);
    unsigned char* scr = P->ws + WS_SCR + (size_t)item * SCR_ITEM;
    if (tid < 384) {
        const int chunk = tid % 48, tg = tid / 48, part = chunk >> 4, cc = chunk & 15;
        const int col = part * 512 + h * 128 + cc * 8;
        const float* cw = P->in[9] + (size_t)(l * 4) * 1536 + col;
        float w0[8], w1[8], w2[8], w3[8];
#pragma unroll
        for (int e = 0; e < 8; ++e) { w0[e] = cw[e]; w1[e] = cw[1536 + e]; w2[e] = cw[2 * 1536 + e]; w3[e] = cw[3 * 1536 + e]; }
        const int t0 = n * 64 + tg * 8;
        const bf16* base = PROJ + (size_t)(b * SEQL) * NPROJ + col;
        float r0[8], r1[8], r2[8], r3[8];
#pragma unroll
        for (int e = 0; e < 8; ++e) { r0[e] = 0.f; r1[e] = 0.f; r2[e] = 0.f; }
        if (t0 - 3 >= 0) { const v4u w = *(const v4u*)(base + (size_t)(t0 - 3) * NPROJ); UNPACK8(w, r0); }
        if (t0 - 2 >= 0) { const v4u w = *(const v4u*)(base + (size_t)(t0 - 2) * NPROJ); UNPACK8(w, r1); }
        if (t0 - 1 >= 0) { const v4u w = *(const v4u*)(base + (size_t)(t0 - 1) * NPROJ); UNPACK8(w, r2); }
        float* dst = (float*)(lds + part * 33792) + cc * 8;
#pragma unroll
        for (int i = 0; i < 8; ++i) {
            const v4u w = *(const v4u*)(base + (size_t)(t0 + i) * NPROJ); UNPACK8(w, r3);
            float s[8];
#pragma unroll
            for (int e = 0; e < 8; ++e) { const float cv = w0[e] * r0[e] + w1[e] * r1[e] + w2[e] * r2[e] + w3[e] * r3[e]; s[e] = siluf(cv); }
            float* d = dst + (tg * 8 + i) * 132;
            *(f32x4*)d = (f32x4){s[0], s[1], s[2], s[3]}; *(f32x4*)(d + 4) = (f32x4){s[4], s[5], s[6], s[7]};
#pragma unroll
            for (int e = 0; e < 8; ++e) { r0[e] = r1[e]; r1[e] = r2[e]; r2[e] = r3[e]; }
        }
    }
    if (tid < 64) { const int row = b * SEQL + n * 64 + tid; Gs[tid] = GB[(size_t)row * 8 + h]; BETA[tid] = GB[(size_t)row * 8 + 4 + h]; }
    __syncthreads();
    {
        const int tok = tid >> 3, sub = tid & 7;
        float* qr = QF + tok * 132 + sub * 16; float* kr = KF + tok * 132 + sub * 16;
        float qv[16], kv[16]; float sq = 0.f, sk = 0.f;
#pragma unroll
        for (int e = 0; e < 16; ++e) { qv[e] = qr[e]; kv[e] = kr[e]; sq += qv[e] * qv[e]; sk += kv[e] * kv[e]; }
        sq += shx(sq, 1); sq += shx(sq, 2); sq += shx(sq, 4);
        sk += shx(sk, 1); sk += shx(sk, 2); sk += shx(sk, 4);
        const float rq = rsqrtf(sq + EPS) * 0.08838834764831845f, rk = rsqrtf(sk + EPS);
#pragma unroll
        for (int e = 0; e < 16; ++e) { qr[e] = qv[e] * rq; kr[e] = kv[e] * rk; }
    }
    if (tid < 64) {
        float v = Gs[tid];
#pragma unroll
        for (int o = 1; o < 64; o <<= 1) { const int src = tid >= o ? tid - o : tid; const float t = __builtin_bit_cast(float, __builtin_amdgcn_ds_bpermute(src << 2, __builtin_bit_cast(int, v))); if (tid >= o) v += t; }
        const float tot = rdl(v, 63);
        GC[tid] = v; EG[tid] = __expf(v); EKD[tid] = __expf(tot - v);
        if (tid == 0) ((float*)(P->ws + WS_GL))[item] = __expf(tot);
    }
    __syncthreads();
    {
        const int p = wv >> 2, mt = wv & 3;
        const float* X = p ? QF : KF;
        f32x4 acc[4];
#pragma unroll
        for (int nt = 0; nt < 4; ++nt) acc[nt] = (f32x4){0.f, 0.f, 0.f, 0.f};
        const float* xa = X + (mt * 16 + fr) * 132 + fq; const float* kb_ = KF + fr * 132 + fq;
#pragma unroll 8
        for (int k = 0; k < 128; k += 4) {
            const float a = xa[k];
#pragma unroll
            for (int nt = 0; nt < 4; ++nt) acc[nt] = __builtin_amdgcn_mfma_f32_16x16x4f32(a, kb_[nt * 16 * 132 + k], acc[nt], 0, 0, 0);
        }
#pragma unroll
        for (int nt = 0; nt < 4; ++nt) {
            const int j = nt * 16 + fr; const float gj = GC[j];
            float v[4];
#pragma unroll
            for (int r = 0; r < 4; ++r) {
                const int i = mt * 16 + 4 * fq + r;
                if (p == 0) v[r] = (i > j) ? BETA[i] * acc[nt][r] * __expf(GC[i] - gj) : 0.f;
                else        v[r] = (i >= j) ? acc[nt][r] * __expf(GC[i] - gj) : 0.f;
            }
            if (p == 0) *(f32x4*)(AT + j * 68 + mt * 16 + 4 * fq) = (f32x4){v[0], v[1], v[2], v[3]};
            else {
#pragma unroll
                for (int r = 0; r < 4; ++r) QKS[(mt * 16 + 4 * fq + r) * 64 + j] = (bf16)f2bf(v[r]);
            }
        }
    }
    __syncthreads();
    const int tid4 = fresh_tid(wave_in);
    if (tid4 < 256) {
        float x[64];
        int zo = 0; asm volatile("" : "+v"(zo));
        const float* ATz = AT + zo; const float* BETAz = BETA + zo; const float* EGz = EG + zo;
        if (tid4 < 128) {
#pragma unroll
            for (int i = 0; i < 64; ++i) x[i] = BETAz[i] * VF[i * 132 + tid4];
        } else {
#pragma unroll
            for (int i = 0; i < 64; ++i) x[i] = BETAz[i] * EGz[i] * KF[i * 132 + tid4 - 128];
        }
        f32x4 ab[16];
#pragma unroll
        for (int q = 0; q < 16; ++q) ab[q] = *(const f32x4*)(ATz + q * 4);
        typedef float f32x2_t __attribute__((ext_vector_type(2)));
        f32x2_t x2[32];
#pragma unroll
        for (int p = 0; p < 32; ++p) x2[p] = (f32x2_t){x[2 * p], x[2 * p + 1]};
#pragma unroll
        for (int j = 0; j < 63; ++j) {
            const float xj = (j & 1) ? x2[j >> 1].y : x2[j >> 1].x;
            const f32x2_t xj2 = (f32x2_t){xj, xj};
#pragma unroll
            for (int q = (j + 1) / 4; q < 16; ++q) {
#pragma unroll
                for (int hh = 0; hh < 2; ++hh) {
                    const int p = 2 * q + hh;
                    if (2 * p > j) x2[p] -= (f32x2_t){ab[q][2 * hh], ab[q][2 * hh + 1]} * xj2;
                    else if (2 * p + 1 > j) x2[p].y -= ab[q][2 * hh + 1] * xj;
                }
                if (j + 1 < 63 && q >= (j + 2) / 4) ab[q] = *(const f32x4*)(ATz + (j + 1) * 68 + q * 4);
                __builtin_amdgcn_sched_barrier(0);
            }
        }
#pragma unroll
        for (int p = 0; p < 32; ++p) { x[2 * p] = x2[p].x; x[2 * p + 1] = x2[p].y; }
        if (tid4 < 128) {
            unsigned char* up = scr + 49152 + tid4 * 128;
#pragma unroll
            for (int q = 0; q < 8; ++q) *(v4u*)(up + q * 16) = PACK8(x + 8 * q);
        } else {
            const int dk = tid4 - 128;
#pragma unroll
            for (int i = 0; i < 64; ++i) WST[i * 128 + dk] = (bf16)f2bf(-x[i]);
        }
    } else {
        const int t2 = tid4 - 256;
        {
            const int tok = t2 >> 2, seg = t2 & 3; const float eg = EG[tok]; const float* s = QF + tok * 132 + seg * 32;
            unsigned char* o = scr + 16384 + tok * 256 + seg * 64;
#pragma unroll
            for (int q = 0; q < 4; ++q) { float f[8];
#pragma unroll
                for (int e = 0; e < 8; ++e) f[e] = s[q * 8 + e] * eg;
                *(v4u*)(o + q * 16) = PACK8(f); }
        }
        {
            const int dk = t2 >> 1, hf = t2 & 1; unsigned char* o = scr + 32768 + dk * 128 + hf * 64;
#pragma unroll
            for (int q = 0; q < 4; ++q) { float f[8];
#pragma unroll
                for (int e = 0; e < 8; ++e) { const int tok = hf * 32 + q * 8 + e; f[e] = KF[tok * 132 + dk] * EKD[tok]; }
                *(v4u*)(o + q * 16) = PACK8(f); }
        }
#pragma unroll
        for (int q = 0; q < 2; ++q) { const int c = t2 + 256 * q; *(v4u*)(scr + 65536 + c * 16) = *(const v4u*)((const unsigned char*)QKS + c * 16); }
    }
    __syncthreads();
#pragma unroll
    for (int q = 0; q < 2; ++q) { const int c = tid4 + 512 * q; *(v4u*)(scr + c * 16) = *(const v4u*)((const unsigned char*)WST + c * 16); }
    __syncthreads();
}

constexpr int S_ST = 0, S_VNT = 34816, S_OPW = 53248, S_OPQG = 70656, S_OPKD = 88064, S_OPQK = 106496, S_OPU = 115712;
__device__ __forceinline__ void scan_load(v4u (&pre)[9], const unsigned char* src, int tid, int half) {
#pragma unroll
    for (int i = 0; i < 9; ++i) pre[i] = *(const v4u*)(src + (size_t)(tid + 512 * i) * 16);
}
__device__ __forceinline__ void scan_chunk(v4u (&pre)[9], f32x4 (&sacc)[8], unsigned char* lds, unsigned char* scrbase, bf16* orow, int item, int n, float egl, int tid, int w, int fr, int fq, int half) {
    asm volatile("s_waitcnt lgkmcnt(0)" ::: "memory"); __builtin_amdgcn_s_barrier(); asm volatile("" ::: "memory");
#pragma unroll
    for (int i = 0; i < 9; ++i) {
        const int e = (tid + 512 * i) * 16 - (i >> 1) * 16384;
        if (i < 4) { const int row = e >> 8, cb = e & 255; *(v4u*)(lds + (i < 2 ? S_OPW : S_OPQG) + row * 272 + cb) = pre[i]; }
        else { const int row = e >> 7, cb = e & 127; *(v4u*)(lds + (i < 6 ? S_OPKD : (i < 8 ? S_OPU : S_OPQK)) + row * 144 + cb) = pre[i]; }
    }
    asm volatile("s_waitcnt lgkmcnt(0)" ::: "memory"); __builtin_amdgcn_s_barrier(); asm volatile("" ::: "memory");
    scan_load(pre, scrbase + (size_t)(item + (n + 2 < 32 ? 8 : 0)) * SCR_ITEM, tid, half);
    if (w < 4) {
    const int dvt = half * 4 + w;
#define SB() __builtin_amdgcn_sched_barrier(0)
    bf16x8 sf[4];
#pragma unroll
    for (int ks = 0; ks < 4; ++ks) sf[ks] = *(const bf16x8*)(lds + S_ST + (16 * w + fr) * 272 + (ks * 32 + 8 * fq) * 2);
    f32x4 vt[4];
    v2u uu[4];
#pragma unroll
    for (int tt = 0; tt < 4; ++tt) uu[tt] = *(const v2u*)(lds + S_OPU + (16 * dvt + fr) * 144 + (tt * 16 + 4 * fq) * 2);
    {
        bf16x8 af[4][4];
#pragma unroll
        for (int ks = 0; ks < 4; ++ks)
#pragma unroll
            for (int tt = 0; tt < 4; ++tt) af[ks][tt] = *(const bf16x8*)(lds + S_OPW + (tt * 16 + fr) * 272 + (ks * 32 + 8 * fq) * 2);
        SB();
#pragma unroll
        for (int tt = 0; tt < 4; ++tt) vt[tt] = (f32x4){bflo(uu[tt].x), bfhi(uu[tt].x), bflo(uu[tt].y), bfhi(uu[tt].y)};
#pragma unroll
        for (int ks = 0; ks < 4; ++ks)
#pragma unroll
            for (int tt = 0; tt < 4; ++tt) vt[tt] = __builtin_amdgcn_mfma_f32_16x16x32_bf16(af[ks][tt], sf[ks], vt[tt], 0, 0, 0);
        SB();
    }
#pragma unroll
    for (int tt = 0; tt < 4; ++tt) *(v2u*)(lds + S_VNT + (16 * w + fr) * 144 + (tt * 16 + 4 * fq) * 2) = (v2u){pk2(vt[tt][0], vt[tt][1]), pk2(vt[tt][2], vt[tt][3])};
    f32x4 ot[4];
#pragma unroll
    for (int nt = 0; nt < 4; ++nt) ot[nt] = (f32x4){0.f, 0.f, 0.f, 0.f};
    {
        bf16x8 bq[4][4];
#pragma unroll
        for (int ks = 0; ks < 4; ++ks)
#pragma unroll
            for (int nt = 0; nt < 4; ++nt) bq[ks][nt] = *(const bf16x8*)(lds + S_OPQG + (nt * 16 + fr) * 272 + (ks * 32 + 8 * fq) * 2);
        SB();
#pragma unroll
        for (int ks = 0; ks < 4; ++ks)
#pragma unroll
            for (int nt = 0; nt < 4; ++nt) ot[nt] = __builtin_amdgcn_mfma_f32_16x16x32_bf16(sf[ks], bq[ks][nt], ot[nt], 0, 0, 0);
        SB();
    }
    LDS_WAIT();
    bf16x8 vf[2];
#pragma unroll
    for (int js = 0; js < 2; ++js) vf[js] = *(const bf16x8*)(lds + S_VNT + (16 * w + fr) * 144 + (js * 32 + 8 * fq) * 2);
    {
        bf16x8 bk[2][4];
#pragma unroll
        for (int js = 0; js < 2; ++js)
#pragma unroll
            for (int nt = 0; nt < 4; ++nt) bk[js][nt] = *(const bf16x8*)(lds + S_OPQK + (nt * 16 + fr) * 144 + (js * 32 + 8 * fq) * 2);
        SB();
#pragma unroll
        for (int js = 0; js < 2; ++js)
#pragma unroll
            for (int nt = 0; nt < 4; ++nt) ot[nt] = __builtin_amdgcn_mfma_f32_16x16x32_bf16(vf[js], bk[js][nt], ot[nt], 0, 0, 0);
        SB();
    }
#pragma unroll
    for (int nt = 0; nt < 4; ++nt) *(v2u*)(orow + (size_t)(nt * 16 + fr) * D + 16 * dvt + 4 * fq) = (v2u){pk2(ot[nt][0], ot[nt][1]), pk2(ot[nt][2], ot[nt][3])};
    {
        bf16x8 ak[2][8];
#pragma unroll
        for (int js = 0; js < 2; ++js)
#pragma unroll
            for (int mt = 0; mt < 8; ++mt) ak[js][mt] = *(const bf16x8*)(lds + S_OPKD + (mt * 16 + fr) * 144 + (js * 32 + 8 * fq) * 2);
        SB();
#pragma unroll
        for (int mt = 0; mt < 8; ++mt) sacc[mt] = sacc[mt] * egl;
#pragma unroll
        for (int js = 0; js < 2; ++js)
#pragma unroll
            for (int mt = 0; mt < 8; ++mt) sacc[mt] = __builtin_amdgcn_mfma_f32_16x16x32_bf16(ak[js][mt], vf[js], sacc[mt], 0, 0, 0);
        SB();
    }
#pragma unroll
    for (int mt = 0; mt < 8; ++mt) *(v2u*)(lds + S_ST + (16 * w + fr) * 272 + (mt * 16 + 4 * fq) * 2) = (v2u){pk2(sacc[mt][0], sacc[mt][1]), pk2(sacc[mt][2], sacc[mt][3])};
#undef SB
    }
    LDS_WAIT();
}
__device__ __forceinline__ void scan_wg(KP P, int l, int id, unsigned char* lds, int tid) {
    const int bh = id >> 1, half = id & 1, b = bh >> 2, h = bh & 3;
    const int lane = tid & 63, w = __builtin_amdgcn_readfirstlane(tid >> 6), fr = lane & 15, fq = lane >> 4;
    unsigned char* scrbase = P->ws + WS_SCR;
    bf16* OCAT = (bf16*)(P->ws + WS_XA);
    f32x4 sacc[8];
#pragma unroll
    for (int mt = 0; mt < 8; ++mt) sacc[mt] = (f32x4){0.f, 0.f, 0.f, 0.f};
    { unsigned zz0 = 0u; asm volatile("" : "+v"(zz0)); if (w < 4) for (int q = lane; q < 272; q += 64) *(v4u*)(lds + S_ST + (16 * w) * 272 + q * 16) = (v4u){zz0, zz0, zz0, zz0}; }
    const int item0 = (b * 32) * 4 + h;
    const float glv = ((const float*)(P->ws + WS_GL))[item0 + 4 * (lane & 31)];
    v4u preA[9], preB[9];
    scan_load(preA, scrbase + (size_t)item0 * SCR_ITEM, tid, half);
    scan_load(preB, scrbase + (size_t)(item0 + 4) * SCR_ITEM, tid, half);
    bf16* orow = OCAT + (size_t)(b * SEQL) * D + h * 128;
#pragma unroll
    for (int n = 0; n < 32; n += 2) {
        scan_chunk(preA, sacc, lds, scrbase, orow + (size_t)(n * 64) * D, item0 + 4 * n, n, rdl(glv, n), tid, w, fr, fq, half);
        scan_chunk(preB, sacc, lds, scrbase, orow + (size_t)(n * 64 + 64) * D, item0 + 4 * n + 4, n + 1, rdl(glv, n + 1), tid, w, fr, fq, half);
    }
    if (w < 4) {
        const int lane2 = lane_id(), fr2 = lane2 & 15, fq2 = lane2 >> 4;
        float* pd = P->out + O_PDELTA + (size_t)((l * NBATCH + b) * 4 + h) * 16384;
#pragma unroll
        for (int mt = 0; mt < 8; ++mt)
#pragma unroll
            for (int r = 0; r < 4; ++r) pd[(mt * 16 + 4 * fq2 + r) * 128 + 16 * (half * 4 + w) + fr2] = sacc[mt][r];
    }
    __syncthreads();
}
__device__ __forceinline__ void p2d(KP P, int l, int gw, int ngw, int lane) {
    const bf16* PROJ = (const bf16*)(P->ws + WS_PROJ);
    bf16* OCAT = (bf16*)(P->ws + WS_XA);
    const float on0 = P->in[12][l * 128 + lane * 2], on1 = P->in[12][l * 128 + lane * 2 + 1];
    for (int pair0 = gw * 4; pair0 < MP * 4; pair0 += 4 * ngw) {
        float o0[4], o1[4]; unsigned zz[4];
#pragma unroll
        for (int q = 0; q < 4; ++q) {
            const int pair = pair0 + q;
            o0[q] = 0.f; o1[q] = 0.f; zz[q] = 0u;
            if (pair < MP * 4) {
                const int row = pair >> 2, h = pair & 3, b = row >> 11, t = row & 2047, n = t >> 6, tok = t & 63;
                const unsigned ow = *(const unsigned*)(OCAT + (size_t)row * D + h * 128 + lane * 2);
                o0[q] = bflo(ow); o1[q] = bfhi(ow);
                zz[q] = *(const unsigned*)(PROJ + (size_t)row * NPROJ + 1536 + h * 128 + lane * 2);
            }
        }
#pragma unroll
        for (int q = 0; q < 4; ++q) {
            const int pair = pair0 + q;
            const float rs = rsqrtf(wave_sum(o0[q] * o0[q] + o1[q] * o1[q]) * (1.f / 128.f) + EPS);
            if (pair < MP * 4) {
                const int row = pair >> 2, h = pair & 3;
                *(unsigned*)(OCAT + (size_t)row * D + h * 128 + lane * 2) = pk2(o0[q] * rs * on0 * siluf(bflo(zz[q])), o1[q] * rs * on1 * siluf(bfhi(zz[q])));
            }
        }
    }
}

__device__ __forceinline__ void sample_delta(KP P, int l, int it, unsigned char* lds, int wave_in) {
    const int tid = fresh_tid(wave_in);
    const int gq = tid >> 7, c = tid & 127, wv2 = (tid >> 6) & 1, lane = tid & 63;
    const int item = it * 4 + gq, sb = item >> 2, h = item & 3, rowbase = MP + sb * 8;
    float* QS = (float*)(lds + gq * 12288); float* KS = QS + 1024; float* VS = QS + 2048;
    float* RED2 = (float*)(lds + 49152);
    const bf16* PROJ = (const bf16*)(P->ws + WS_PROJ);
    const float* GB = (const float*)(P->ws + WS_GB);
    bf16* OCAT = (bf16*)(P->ws + WS_XA);
#pragma unroll
    for (int part = 0; part < 3; ++part) {
        const int col = part * 512 + h * 128 + c;
        const float* cw = P->in[9] + (size_t)(l * 4) * 1536 + col;
        const float w0 = cw[0], w1 = cw[1536], w2 = cw[2 * 1536], w3 = cw[3 * 1536];
        const float* hs = P->in[3] + (size_t)((l * DBATCH + sb) * 3) * 1536 + col;
        float r0 = hs[0], r1 = hs[1536], r2 = hs[2 * 1536];
        float* dst = QS + part * 1024 + c;
#pragma unroll
        for (int t = 0; t < 8; ++t) {
            const float x = bf1(PROJ[(size_t)(rowbase + t) * NPROJ + col]);
            dst[t * 128] = siluf(w0 * r0 + w1 * r1 + w2 * r2 + w3 * x);
            r0 = r1; r1 = r2; r2 = x;
        }
    }
#pragma unroll
    for (int t = 0; t < 8; ++t) {
        const float q = QS[t * 128 + c], k = KS[t * 128 + c];
        const float sq = wave_sum(q * q), sk = wave_sum(k * k);
        if (lane == 0) { RED2[(gq * 2 + wv2) * 16 + t] = sq; RED2[(gq * 2 + wv2) * 16 + 8 + t] = sk; }
    }
    __syncthreads();
#pragma unroll
    for (int t = 0; t < 8; ++t) {
        const float tq = RED2[(gq * 2) * 16 + t] + RED2[(gq * 2 + 1) * 16 + t], tk = RED2[(gq * 2) * 16 + 8 + t] + RED2[(gq * 2 + 1) * 16 + 8 + t];
        QS[t * 128 + c] *= rsqrtf(tq + EPS) * 0.08838834764831845f; KS[t * 128 + c] *= rsqrtf(tk + EPS);
    }
    __syncthreads();
    float s[128];
    {
        const float* S0 = P->in[2] + (size_t)((l * DBATCH + sb) * 4 + h) * 16384 + c;
#pragma unroll
        for (int d8 = 0; d8 < 16; ++d8) {
#pragma unroll
            for (int e = 0; e < 8; ++e) s[8 * d8 + e] = S0[e * 128];
            S0 += 8 * 128; asm volatile("" : "+v"(S0));
        }
    }
    float* GBS = RED2 + 128 + gq * 16;
    if (c < 8) { GBS[c] = __expf(GB[(size_t)(rowbase + c) * 8 + h]); GBS[8 + c] = GB[(size_t)(rowbase + c) * 8 + 4 + h]; }
    LDS_WAIT(); __syncthreads();
#pragma unroll 1
    for (int t = 0; t < 8; ++t) {
        const float eg = GBS[t], beta = GBS[8 + t];
        const f32x4* kp = (const f32x4*)(KS + t * 128); const f32x4* qp = (const f32x4*)(QS + t * 128);
        float dot = 0.f;
#pragma unroll
        for (int d4 = 0; d4 < 32; ++d4) { const f32x4 kv = kp[d4]; dot += kv[0] * s[4 * d4] + kv[1] * s[4 * d4 + 1] + kv[2] * s[4 * d4 + 2] + kv[3] * s[4 * d4 + 3];
            if ((d4 & 3) == 3) asm volatile("" ::: "memory"); }
        const float cf = beta * (VS[t * 128 + c] - eg * dot);
        float o = 0.f;
#pragma unroll
        for (int d4 = 0; d4 < 32; ++d4) { const f32x4 kv = kp[d4], qv = qp[d4];
#pragma unroll
            for (int e = 0; e < 4; ++e) { s[4 * d4 + e] = eg * s[4 * d4 + e] + cf * kv[e]; o += qv[e] * s[4 * d4 + e]; }
            if ((d4 & 3) == 3) asm volatile("" ::: "memory"); }
        VS[t * 128 + c] = o;
    }
    {
        float* sd = P->out + O_SDELTA + (size_t)((l * DBATCH + sb) * 4 + h) * 16384 + c;
#pragma unroll
        for (int d8 = 0; d8 < 16; ++d8) {
#pragma unroll
            for (int e = 0; e < 8; ++e) sd[e * 128] = s[8 * d8 + e];
            sd += 8 * 128; asm volatile("" : "+v"(sd));
        }
    }
    __syncthreads();
#pragma unroll
    for (int t = 0; t < 8; ++t) { const float o = VS[t * 128 + c]; const float so = wave_sum(o * o); if (lane == 0) RED2[(gq * 2 + wv2) * 16 + t] = so; }
    __syncthreads();
    const float onv = P->in[12][l * 128 + c];
#pragma unroll
    for (int t = 0; t < 8; ++t) {
        const float tot = RED2[(gq * 2) * 16 + t] + RED2[(gq * 2 + 1) * 16 + t];
        const float z = bf1(PROJ[(size_t)(rowbase + t) * NPROJ + 1536 + h * 128 + c]);
        OCAT[(size_t)(rowbase + t) * D + h * 128 + c] = (bf16)f2bf(VS[t * 128 + c] * rsqrtf(tot * (1.f / 128.f) + EPS) * onv * siluf(z));
    }
    __syncthreads();
}

constexpr int PL_DT = 0, PL_PW = 33792;
__device__ __forceinline__ void pool_tile(KP P, int l, int tile, unsigned char* lds, int wave_in) {
    const int tid = fresh_tid(wave_in);
    bf16* DT = (bf16*)(lds + PL_DT);
    const bf16* PROJ = (const bf16*)(P->ws + WS_PROJ);
    bf16* OCAT = (bf16*)(P->ws + WS_XA);
#pragma unroll 1
    for (int i = 0; i < 4; ++i) {
        const int idx = tid + 512 * i, tok = idx & 63, ch8 = idx >> 6, c0 = ch8 * 8, gi = ch8 >> 3, win = 2 << gi;
        int row, t, sb = 0; bool smp;
        if (tile < 256) { t = (tile & 31) * 64 + tok; row = (tile >> 5) * SEQL + t; smp = false; }
        else { sb = (tile - 256) * 8 + (tok >> 3); t = tok & 7; row = MP + sb * 8 + t; smp = true; }
        float ssum[8], cur[8];
#pragma unroll
        for (int e = 0; e < 8; ++e) { ssum[e] = 0.f; cur[e] = 0.f; }
        {
            v4u wv[16];
#pragma unroll
            for (int j = 0; j < 16; ++j) {
                wv[j] = (v4u){0u, 0u, 0u, 0u};
                if (j < win && t - j >= 0) wv[j] = *(const v4u*)(PROJ + (size_t)(row - j) * NPROJ + 2048 + c0);
            }
#pragma unroll
            for (int j = 0; j < 16; ++j) {
                float f[8]; UNPACK8(wv[j], f);
#pragma unroll
                for (int e = 0; e < 8; ++e) { ssum[e] += f[e]; if (j == 0) cur[e] = f[e]; }
            }
            if (smp) {
                for (int j = t + 1; j < win; ++j) { const float* sp = P->in[4] + (size_t)((l * DBATCH + sb) * 15 + 15 + t - j) * 256 + c0;
#pragma unroll
                    for (int e = 0; e < 8; ++e) ssum[e] += sp[e]; }
            }
        }
        const float inv = 1.f / (float)(smp ? win : (t + 1 < win ? t + 1 : win));
        { float dd[8];
#pragma unroll
            for (int e = 0; e < 8; ++e) dd[e] = ssum[e] * inv - cur[e];
            *(v4u*)(DT + tok * 264 + c0) = PACK8(dd); }
        float u0[8], u1[8], u2[8];
#pragma unroll
        for (int j = 0; j < 3; ++j) {
            const int tt = t - j; float f[8];
            if (tt >= 0) { const v4u wc = *(const v4u*)(PROJ + (size_t)(row - j) * NPROJ + 2816 + c0); const v4u wx = *(const v4u*)(PROJ + (size_t)(row - j) * NPROJ + 2304 + c0);
                float fc[8], fx[8]; UNPACK8(wc, fc); UNPACK8(wx, fx);
#pragma unroll
                for (int e = 0; e < 8; ++e) f[e] = fc[e] * fx[e]; }
            else if (smp) { const float* sp = P->in[5] + (size_t)((l * DBATCH + sb) * 2 + 2 + tt) * 256 + c0;
#pragma unroll
                for (int e = 0; e < 8; ++e) f[e] = sp[e]; }
            else {
#pragma unroll
                for (int e = 0; e < 8; ++e) f[e] = 0.f; }
#pragma unroll
            for (int e = 0; e < 8; ++e) { if (j == 0) u0[e] = f[e]; else if (j == 1) u1[e] = f[e]; else u2[e] = f[e]; }
        }
        const float* sw = P->in[15] + (size_t)(l * 3) * 256 + c0;
        const v4u wb = *(const v4u*)(PROJ + (size_t)row * NPROJ + 2560 + c0); float fb[8]; UNPACK8(wb, fb);
        float oc[8];
#pragma unroll
        for (int e = 0; e < 8; ++e) oc[e] = fb[e] * (sw[e] * u2[e] + sw[256 + e] * u1[e] + sw[512 + e] * u0[e]);
        *(v4u*)(OCAT + (size_t)row * D + 768 + c0) = PACK8(oc);
    }
    __syncthreads();
    {
        const int lane = tid & 63, wv = tid >> 6, fr = lane & 15, fq = lane >> 4, g = wv & 3, th = wv >> 2;
        bf16x8 df[2][2], pf[4][2];
#pragma unroll
        for (int tt = 0; tt < 2; ++tt)
#pragma unroll
            for (int ks = 0; ks < 2; ++ks) df[tt][ks] = *(const bf16x8*)(lds + PL_DT + ((th * 32 + tt * 16 + fr) * 264 + g * 64 + ks * 32 + 8 * fq) * 2);
#pragma unroll
        for (int et = 0; et < 4; ++et)
#pragma unroll
            for (int ks = 0; ks < 2; ++ks) pf[et][ks] = *(const bf16x8*)(lds + PL_PW + (((g * 64 + et * 16 + fr) * 72) + ks * 32 + 8 * fq) * 2);
#pragma unroll
        for (int tt = 0; tt < 2; ++tt) {
            const int tok = th * 32 + tt * 16 + fr;
            const int row = tile < 256 ? (tile >> 5) * SEQL + (tile & 31) * 64 + tok : MP + (tile - 256) * 64 + tok;
#pragma unroll
            for (int et = 0; et < 4; ++et) {
                f32x4 acc = (f32x4){0.f, 0.f, 0.f, 0.f};
#pragma unroll
                for (int ks = 0; ks < 2; ++ks) acc = __builtin_amdgcn_mfma_f32_16x16x32_bf16(pf[et][ks], df[tt][ks], acc, 0, 0, 0);
                const int ch = g * 64 + et * 16 + 4 * fq;
                const f32x4 sc = *(const f32x4*)(P->in[14] + l * 256 + ch);
                *(v2u*)(OCAT + (size_t)row * D + 512 + ch) = (v2u){pk2(acc[0] * sc[0], acc[1] * sc[1]), pk2(acc[2] * sc[2], acc[3] * sc[3])};
            }
        }
    }
    __syncthreads();
}

__device__ __forceinline__ void state_copies(KP P, int l, int start, int stride) {
    const bf16* PROJ = (const bf16*)(P->ws + WS_PROJ);
    for (int i = start; i < 136 * 1120; i += stride) {
        const int seq = i / 1120, r = (i % 1120) * 8;
        const bool smp = seq >= 8; const int sb = seq - 8;
        const int L = smp ? 8 : SEQL; const size_t row0 = smp ? (size_t)MP + sb * 8 : (size_t)seq * SEQL;
        float f[8]; float* o;
        if (r < 4608) {
            const int j = r / 1536, c = r % 1536;
            const v4u w = *(const v4u*)(PROJ + (row0 + L - 3 + j) * NPROJ + c); UNPACK8(w, f);
            o = smp ? P->out + O_SDCONV + (size_t)((l * DBATCH + sb) * 3 + j) * 1536 + c : P->out + O_PDCONV + (size_t)((l * NBATCH + seq) * 3 + j) * 1536 + c;
        } else if (r < 4608 + 3840) {
            const int r2 = r - 4608, j = r2 / 256, c = r2 % 256;
            if (smp) {
                if (j < 7) { const float* sp = P->in[4] + (size_t)((l * DBATCH + sb) * 15 + 8 + j) * 256 + c;
#pragma unroll
                    for (int e = 0; e < 8; ++e) f[e] = sp[e]; }
                else { const v4u w = *(const v4u*)(PROJ + (row0 + j - 7) * NPROJ + 2048 + c); UNPACK8(w, f); }
                o = P->out + O_SPOOL + (size_t)((l * DBATCH + sb) * 15 + j) * 256 + c;
            } else {
                const v4u w = *(const v4u*)(PROJ + (row0 + L - 15 + j) * NPROJ + 2048 + c); UNPACK8(w, f);
                o = P->out + O_PPOOL + (size_t)((l * NBATCH + seq) * 15 + j) * 256 + c;
            }
        } else {
            const int r2 = r - 8448, j = r2 / 256, c = r2 % 256;
            const size_t row = row0 + L - 2 + j;
            const v4u wc = *(const v4u*)(PROJ + row * NPROJ + 2816 + c); const v4u wx = *(const v4u*)(PROJ + row * NPROJ + 2304 + c);
            float fc[8], fx[8]; UNPACK8(wc, fc); UNPACK8(wx, fx);
#pragma unroll
            for (int e = 0; e < 8; ++e) f[e] = fc[e] * fx[e];
            o = smp ? P->out + O_SSCONV + (size_t)((l * DBATCH + sb) * 2 + j) * 256 + c : P->out + O_PSCONV + (size_t)((l * NBATCH + seq) * 2 + j) * 256 + c;
        }
        *(f32x4*)o = (f32x4){f[0], f[1], f[2], f[3]}; *(f32x4*)(o + 4) = (f32x4){f[4], f[5], f[6], f[7]};
    }
}

__device__ __forceinline__ void p4b(KP P, int l, int hf, int start, int stride) {
    bf16* GU = (bf16*)(P->ws + WS_GU); bf16* HALO = (bf16*)(P->ws + WS_HALO);
    const float* cw = P->in[19] + (size_t)(l * 3) * FF;
    const int r0 = hf * MH;
    for (int idx = start; idx < MH * 352; idx += stride) {
        const int lr = idx / 352, c0 = (idx % 352) * 8, m = r0 + lr;
        int t, sb = 0; bool smp;
        if (m < MP) { t = m & (SEQL - 1); smp = false; } else { sb = (m - MP) >> 3; t = (m - MP) & 7; smp = true; }
        float g0[8], g1[8], g2[8];
#pragma unroll
        for (int j = 0; j < 3; ++j) {
            const int tt = t - j; float f[8];
            if (tt < 0) {
                if (smp) { const float* sp = P->in[6] + (size_t)((l * DBATCH + sb) * 2 + 2 + tt) * FF + c0;
#pragma unroll
                    for (int e = 0; e < 8; ++e) f[e] = sp[e]; }
                else {
#pragma unroll
                    for (int e = 0; e < 8; ++e) f[e] = 0.f; }
            } else {
                const v4u w = (lr - j < 0) ? *(const v4u*)(HALO + (size_t)(2 + lr - j) * FF + c0) : *(const v4u*)(GU + (size_t)(lr - j) * NGU + c0);
                UNPACK8(w, f);
            }
#pragma unroll
            for (int e = 0; e < 8; ++e) { if (j == 0) g0[e] = f[e]; else if (j == 1) g1[e] = f[e]; else g2[e] = f[e]; }
        }
        const v4u wu = *(const v4u*)(GU + (size_t)lr * NGU + FF + c0); float fu[8]; UNPACK8(wu, fu);
        float a[8];
#pragma unroll
        for (int e = 0; e < 8; ++e) a[e] = siluf(cw[c0 + e] * g2[e] + cw[FF + c0 + e] * g1[e] + cw[2 * FF + c0 + e] * g0[e]) * fu[e];
        *(v4u*)(GU + (size_t)lr * NGU + FF + c0) = PACK8(a);
        if (!smp && t >= SEQL - 2) { float* o = P->out + O_PFFN + (size_t)((l * NBATCH + (m >> 11)) * 2 + t - (SEQL - 2)) * FF + c0;
#pragma unroll
            for (int e = 0; e < 8; ++e) o[e] = g0[e]; }
        if (smp && t >= 6) { float* o = P->out + O_SFFN + (size_t)((l * DBATCH + sb) * 2 + t - 6) * FF + c0;
#pragma unroll
            for (int e = 0; e < 8; ++e) o[e] = g0[e]; }
        if (hf == 0 && lr >= MH - 2) *(v4u*)(HALO + (size_t)(lr - (MH - 2)) * FF + c0) = *(const v4u*)(GU + (size_t)lr * NGU + c0);
    }
}

#define LAS __attribute__((address_space(3)))
#define XB_TMO      128
#define XB_XCNT(j)  (256  + 64 * (j))
#define XB_XSUB(j)  (1280 + 64 * (j))
#define XB_XGEN(j)  (2304 + 64 * (j))
#define XB_TOP      3328
#define XB_TOPGEN   3392
#define XCD_BAR_WORDS 3456
#define XB_SPIN_CAP (1u << 18)

__device__ __forceinline__ unsigned xb_ld(unsigned* p)              { return __hip_atomic_load(p, __ATOMIC_RELAXED, __HIP_MEMORY_SCOPE_AGENT); }
__device__ __forceinline__ unsigned xb_add(unsigned* p, unsigned v) { return __hip_atomic_fetch_add(p, v, __ATOMIC_RELAXED, __HIP_MEMORY_SCOPE_AGENT); }
__device__ __forceinline__ unsigned xb_xcc_id() { return (unsigned)__builtin_amdgcn_s_getreg((3 << 11) | 20) & 0xFu; }
#define XB_SPIN(cond, bar) do { unsigned _sp = 0; while (cond) { __builtin_amdgcn_s_sleep(1); \
    if ((++_sp & 255u) == 0u) { if (xb_ld(&(bar)[XB_TMO])) break; if (_sp > XB_SPIN_CAP) { atomicAdd(&(bar)[XB_TMO], 1u); break; } } } } while (0)

struct XcdBarrier {
    unsigned* bar; unsigned x;
    volatile LAS unsigned* st;
    int wave;
};

__device__ __forceinline__ XcdBarrier xcd_barrier_post(unsigned* bar, volatile LAS unsigned* st) {
    XcdBarrier b; b.bar = bar; b.x = xb_xcc_id(); b.st = st; b.wave = 0;
    if (threadIdx.x == 0) (void)xb_add(&bar[XB_XCNT(b.x)], 1u);
    return b;
}
__device__ __forceinline__ void xcd_barrier_complete(unsigned* bar, unsigned x, unsigned& nloc, unsigned& nx) {
    const unsigned G = gridDim.x * gridDim.y * gridDim.z;
    unsigned sum, cnt, mine, sp = 0u;
    for (;;) {
        sum = 0u; cnt = 0u; mine = 0u;
#pragma unroll
        for (unsigned j = 0; j < 16; ++j) { const unsigned c = xb_ld(&bar[XB_XCNT(j)]); sum += c; cnt += (c > 0u) ? 1u : 0u; mine = (j == x) ? c : mine; }
        if (sum == G) break;
        __builtin_amdgcn_s_sleep(1);
        if ((++sp & 255u) == 0u) { if (xb_ld(&bar[XB_TMO])) break; if (sp > XB_SPIN_CAP) { atomicAdd(&bar[XB_TMO], 1u); break; } }
    }
    nloc = mine > 0u ? mine : 1u; nx = cnt > 0u ? cnt : 1u;
}

__device__ __forceinline__ void xcd_barrier(const XcdBarrier& b) {
    asm volatile("s_waitcnt vmcnt(0)" ::: "memory");
    __syncthreads();
    if (b.wave == 0 && lane_id() == 0) {
        unsigned* bar = b.bar;
        __builtin_amdgcn_s_waitcnt(0);
        unsigned nloc = b.st[0], nx = b.st[1];
        if (nloc == 0u) { xcd_barrier_complete(bar, b.x, nloc, nx); b.st[0] = nloc; b.st[1] = nx; }
        const unsigned old = xb_add(&bar[XB_XSUB(b.x)], 1u);
        const unsigned gen = old / nloc;
        if (old + 1u == (gen + 1u) * nloc) {
            __builtin_amdgcn_fence(__ATOMIC_RELEASE, "agent");
            asm volatile("s_waitcnt vmcnt(0)" ::: "memory");
            const unsigned og = xb_add(&bar[XB_TOP], 1u);
            const unsigned tg = og / nx;
            if (og + 1u == (tg + 1u) * nx) xb_add(&bar[XB_TOPGEN], 1u);
            else XB_SPIN(xb_ld(&bar[XB_TOPGEN]) == tg, bar);
            __builtin_amdgcn_fence(__ATOMIC_ACQUIRE, "agent");
            xb_add(&bar[XB_XGEN(b.x)], 1u);
            asm volatile("s_waitcnt vmcnt(0)" ::: "memory");
        } else {
            XB_SPIN(xb_ld(&bar[XB_XGEN(b.x)]) == gen, bar);
            __builtin_amdgcn_fence(__ATOMIC_ACQUIRE, "agent");
            asm volatile("s_waitcnt vmcnt(0)" ::: "memory");
        }
    }
    __syncthreads();
}

#define XSYNC1() do { XcdBarrier b_; b_.bar = (unsigned*)(kparams()->ws + WS_BAR); b_.x = xb_xcc_id(); b_.st = (volatile LAS unsigned*)((LAS unsigned char*)lds + (LDS_BYTES - 64)); b_.wave = wave; xcd_barrier(b_); } while (0)
#ifdef PROBE_SYNC2
#define GSYNC() do { XSYNC1(); XSYNC1(); } while (0)
#else
#define GSYNC() XSYNC1()
#endif
__global__ void __launch_bounds__(NTHREADS, 2) fwd_megakernel(Params Parg) {
    KP P = kparams();
    extern __shared__ __attribute__((aligned(16))) unsigned char lds[];
    cg::grid_group grid = cg::this_grid();
    const int wave = __builtin_amdgcn_readfirstlane((int)threadIdx.x >> 6);
    const int tid = fresh_tid(wave), lane = tid & 63;
    const int G = gridDim.x, bx = blockIdx.x;
    const int gw = bx * NWAVES + wave, ngw = G * NWAVES;
    const int gt = bx * NTHREADS + tid, ngt = G * NTHREADS;
    unsigned char* ws = P->ws;
    bf16* XA = (bf16*)(ws + WS_XA); bf16* XB2 = (bf16*)(ws + WS_PROJ); bf16* PROJ = (bf16*)(ws + WS_PROJ); bf16* GU = (bf16*)(ws + WS_GU);
    float* SSQ = (float*)(ws + WS_SSQ); float* GB = (float*)(ws + WS_GB); float* WAB = (float*)(ws + WS_WAB);
    float* XRES = P->out;
    float* wscr = (float*)(lds + wave * 16384);
    volatile LAS unsigned* xst = (volatile LAS unsigned*)((LAS unsigned char*)lds + (LDS_BYTES - 64));
    if (tid < 16) xst[tid] = 0u;
    __syncthreads();
    (void)xcd_barrier_post((unsigned*)(ws + WS_BAR), xst);

    for (int i = gt; i < 4 * M; i += ngt) SSQ[M + i] = 0.f;
    for (int i = gt; i < MS * D / 4; i += ngt) ((f32x4*)(XRES + (size_t)MP * D))[i] = ((const f32x4*)P->in[1])[i];
    for (int i = gt; i < 2 * 8 * D; i += ngt) { const int l = i >> 13, j = (i >> 10) & 7, k = i & 1023; WAB[i] = P->in[7][l * D + k] * P->in[8][(size_t)l * D * DIN + (size_t)k * DIN + 2048 + j]; }
    convert_win(P, 0, wscr, gw, ngw, lane);
    convert_layer_rest(P, 0, wscr, gw, ngw, lane);
    convert_layer_rest(P, 1, wscr, gw, ngw, lane);
    for (int m0 = gw; m0 < M; m0 += 2 * ngw) {
        f32x4 v[2][4];
#pragma unroll
        for (int q = 0; q < 2; ++q) { const int m = m0 + q * ngw;
            const float* xr = m < MP ? P->in[0] + (size_t)m * D : P->in[1] + (size_t)((m < M ? m : M - 1) - MP) * D;
#pragma unroll
            for (int j = 0; j < 4; ++j) v[q][j] = ((const f32x4*)xr)[lane + 64 * j]; }
#pragma unroll
        for (int q = 0; q < 2; ++q) { const int m = m0 + q * ngw;
            if (m < M) {
                float ss = 0.f;
#pragma unroll
                for (int j = 0; j < 4; ++j) { const f32x4 w4 = v[q][j]; ss += w4[0] * w4[0] + w4[1] * w4[1] + w4[2] * w4[2] + w4[3] * w4[3];
                    ((v2u*)(XA + (size_t)m * D))[lane + 64 * j] = (v2u){pk2(w4[0], w4[1]), pk2(w4[2], w4[3])}; }
                ss = wave_sum(ss);
                if (lane == 0) SSQ[m] = ss;
            } }
    }
    if (ws == nullptr) grid.sync();
    GSYNC();

#pragma unroll 1
    for (int l = 0; l < 2; ++l) {
#ifndef NO_P1
        {
            const bf16* gA = XA; const bf16* gB = (const bf16*)(ws + WS_WIN); LAUNDER(gA); LAUNDER(gB);
            pg8::Gemm g{gA, gB, M, NPROJ, D, D, D}; pg8::StaticOrder S; S.init(M, NPROJ, G, bx);
            EpiScale E{PROJ, NPROJ, SSQ + (size_t)(2 * l) * M};
            pg8::gemm_phase<EpiScale, pg8::StaticOrder, true, true>((PG8_LAS unsigned char*)lds, g, S, E, wave);
#ifdef PROBE_P1X2
            __syncthreads();
            pg8::gemm_phase<EpiScale, pg8::StaticOrder, true, true>((PG8_LAS unsigned char*)lds, g, S, E, wave);
#endif
        }
#endif
#ifndef NO_AB
        {
            const float* ssq = SSQ + (size_t)(2 * l) * M;
            const int nab = (G > 96 ? G - 48 : G), bab = (G > 96 ? bx - 48 : bx);
            const int tf = fresh_tid(wave), lane = tf & 63, gw = bab * NWAVES + __builtin_amdgcn_readfirstlane(tf >> 6), ngw = nab * NWAVES;
            if (bab >= 0)
            for (int m0 = gw; m0 < M; m0 += 2 * ngw) {
                v4u xq[2][2]; float sqv[2];
#pragma unroll
                for (int q = 0; q < 2; ++q) { const int m = (m0 + q * ngw) < M ? (m0 + q * ngw) : (M - 1);
                    const v4u* xr = (const v4u*)(XA + (size_t)m * D) + lane * 2; xq[q][0] = xr[0]; xq[q][1] = xr[1]; sqv[q] = ssq[m]; }
#pragma unroll
                for (int q = 0; q < 2; ++q) {
                    const int m = m0 + q * ngw;
                    float xf[16]; UNPACK8(xq[q][0], xf); UNPACK8(xq[q][1], xf + 8);
                    float dot[8];
#pragma unroll
                    for (int j = 0; j < 8; ++j) { const float* wp = WAB + (size_t)(l * 8 + j) * D + lane * 16; float s2 = 0.f;
#pragma unroll
                        for (int e = 0; e < 16; ++e) s2 += wp[e] * xf[e];
                        dot[j] = wave_sum(s2); }
                    float v = dot[0];
#pragma unroll
                    for (int j = 1; j < 8; ++j) v = (lane == j) ? dot[j] : v;
                    if (lane < 8 && m < M) {
                        v *= rsqrtf(sqv[q] * (1.f / D) + EPS);
                        const int hh = lane & 3; float r;
                        if (lane < 4) { const float xx = v + P->in[11][l * 4 + hh]; const float sp = fmaxf(xx, 0.f) + __logf(1.f + __expf(-fabsf(xx))); r = -__expf(P->in[10][l * 4 + hh]) * sp; }
                        else r = __builtin_amdgcn_rcpf(1.f + __expf(-v));
                        GB[(size_t)m * 8 + lane] = r;
                    }
                }
            }
        }
#endif
        GSYNC();
#ifndef NO_P2B
        { const int tf = fresh_tid(wave); for (int item = bx; item < 1024; item += G) p2b_item(P, l, item, lds, wave); }
#ifdef PROBE_P2B2
        __syncthreads(); { const int tf = fresh_tid(wave); for (int item = bx; item < 1024; item += G) p2b_item(P, l, item, lds, wave); }
#endif
#endif
        GSYNC();
#ifdef PROBE_SCAN2
        if (bx < 64) { scan_wg(P, l, bx, lds, fresh_tid(wave)); }
#endif
#ifndef NO_SCAN
        if (bx < 64) scan_wg(P, l, bx, lds, fresh_tid(wave));
#endif
        {
            unsigned* qctr = (unsigned*)(ws + WS_BAR) + 3600 + l;
            volatile unsigned* qslot = (volatile unsigned*)(lds + LDS_BYTES - 128);
            bool have_pw = false;
            for (;;) {
                const int tid = fresh_tid(wave);
                __syncthreads();
                if (tid == 0) *qslot = atomicAdd(qctr, 1u);
                __syncthreads();
                const int it = (int)*qslot;
                if (it >= 128 + 272 + 64) break;
                if (it < 128) { sample_delta(P, l, it, lds, wave); have_pw = false; }
                else if (it < 400) {
                    if (!have_pw) {
                        for (int i = tid; i < 16384; i += NTHREADS) { const int e = i & 63, c = (i >> 6) & 63, g = i >> 12; ((bf16*)(lds + PL_PW))[(g * 64 + e) * 72 + c] = (bf16)f2bf(P->in[13][(size_t)l * 16384 + i]); }
                        __syncthreads(); have_pw = true;
                    }
                    pool_tile(P, l, it - 128, lds, wave);
                } else state_copies(P, l, (it - 400) * NTHREADS + tid, 64 * NTHREADS);
            }
        }
        GSYNC();
        { const int tf = fresh_tid(wave); p2d(P, l, bx * NWAVES + __builtin_amdgcn_readfirstlane(tf >> 6), ngw, tf & 63); }
        GSYNC();
#ifdef PROBE_P2D2
        { const int tf = fresh_tid(wave); p2d(P, l, bx * NWAVES + __builtin_amdgcn_readfirstlane(tf >> 6), ngw, tf & 63); }
        GSYNC();
        { const int tf = fresh_tid(wave); p2d(P, l, bx * NWAVES + __builtin_amdgcn_readfirstlane(tf >> 6), ngw, tf & 63); }
        GSYNC();
        { const int tf = fresh_tid(wave); p2d(P, l, bx * NWAVES + __builtin_amdgcn_readfirstlane(tf >> 6), ngw, tf & 63); }
        GSYNC();
#endif
        {
            const bf16* gA = XA; const bf16* gB = (const bf16*)(ws + WS_WOUT) + (size_t)l * D * D; LAUNDER(gA); LAUNDER(gB);
            pg8::Gemm g{gA, gB, MP, D, D, D, D}; pg8::StaticOrder S; S.init(MP, D, G, bx);
            EpiResid E{l == 0 ? P->in[0] : XRES, l == 0 ? P->in[1] : XRES + (size_t)MP * D, XRES, XB2, SSQ + (size_t)(2 * l + 1) * M, 0};
            pg8::gemm_phase<EpiResid, pg8::StaticOrder, true, true>((PG8_LAS unsigned char*)lds, g, S, E, wave);
            const int ks = bx >> 4; const bf16* gA2 = XA + (size_t)MP * D + ks * 256; const bf16* gB2 = gB + ks * 256; LAUNDER(gA2); LAUNDER(gB2);
            pg8::Gemm g2{gA2, gB2, MS, D, 256, D, D}; SplitOrder S2{bx < 64 ? (bx & 15) : -1};
            EpiAtomic E2{(float*)(ws + WS_GU) + (size_t)ks * MS * D};
            pg8::gemm_phase<EpiAtomic, SplitOrder, true, true>((PG8_LAS unsigned char*)lds, g2, S2, E2, wave);
        }
        GSYNC();
        fin_sample(XRES + (size_t)MP * D, XB2 + (size_t)MP * D, SSQ + (size_t)(2 * l + 1) * M + MP, (const float*)(ws + WS_GU), 4, nullptr, 0, bx * NWAVES + wave, ngw, lane_id());
        GSYNC();
        {
            const bf16* gA = XB2; const bf16* gB = (const bf16*)(ws + WS_WGU) + (size_t)l * NGU * D; LAUNDER(gA); LAUNDER(gB);
            pg8::Gemm g{gA, gB, M, NGU, D, D, D}; pg8::StaticOrder S; S.init(M, NGU, G, bx);
            EpiGateUp E{GU, SSQ + (size_t)(2 * l + 1) * M, P->in[19] + (size_t)(l * 3) * FF, P->in[6] + (size_t)l * DBATCH * 2 * FF, (float*)(ws + WS_HAL), (float*)(ws + WS_FIXG), (float*)(ws + WS_FIXU),
                        P->out + O_PFFN + (size_t)l * NBATCH * 2 * FF, P->out + O_SFFN + (size_t)l * DBATCH * 2 * FF, lds};
            pg8::gemm_phase<EpiGateUp, pg8::StaticOrder, true, true>((PG8_LAS unsigned char*)lds, g, S, E, wave);
#ifdef PROBE_P4X2
            __syncthreads();
            pg8::gemm_phase<EpiGateUp, pg8::StaticOrder, true, true>((PG8_LAS unsigned char*)lds, g, S, E, wave);
#endif
        }
        GSYNC();
        p4_fixup(P, l, bx * NTHREADS + fresh_tid(wave), ngt);
        if (l == 0) { const int tf = fresh_tid(wave); convert_win(P, 1, (float*)(lds + wave * 16384), bx * NWAVES + wave, ngw, tf & 63); }
        GSYNC();
        {
            const bf16* gA = GU; const bf16* gB = (const bf16*)(ws + WS_WDN) + (size_t)l * D * FF; LAUNDER(gA); LAUNDER(gB);
            pg8::Gemm g{gA, gB, MP, D, FF, FF, FF}; pg8::StaticOrder S; S.init(MP, D, G, bx);
            EpiResid E{XRES, XRES + (size_t)MP * D, XRES, XA, SSQ + (size_t)(2 * l + 2) * M, 0};
            pg8::gemm_phase<EpiResid, pg8::StaticOrder, true, true>((PG8_LAS unsigned char*)lds, g, S, E, wave);
            const int ks = bx >> 4; const bf16* gA2 = GU + (size_t)MP * FF + ks * 256; const bf16* gB2 = gB + ks * 256; LAUNDER(gA2); LAUNDER(gB2);
            pg8::Gemm g2{gA2, gB2, MS, D, 256, FF, FF}; SplitOrder S2{bx < 176 ? (bx & 15) : -1};
            EpiAtomic E2{ks < 8 ? (float*)(ws + WS_PROJ) + (size_t)ks * MS * D : (float*)(ws + WS_PART2) + (size_t)(ks - 8) * MS * D};
            pg8::gemm_phase<EpiAtomic, SplitOrder, true, true>((PG8_LAS unsigned char*)lds, g2, S2, E2, wave);
        }
        GSYNC();
        fin_sample(XRES + (size_t)MP * D, XA + (size_t)MP * D, SSQ + (size_t)(2 * l + 2) * M + MP, (const float*)(ws + WS_PROJ), 8, (const float*)(ws + WS_PART2), 3, bx * NWAVES + wave, ngw, lane_id());
        GSYNC();
    }
    {
        const float* ssq = SSQ + (size_t)4 * M; const float* fn = P->in[22];
        const int gt = bx * NTHREADS + fresh_tid(wave);
        for (int i0 = gt; i0 < M * 256; i0 += 4 * ngt) {
            f32x4 v[4]; float sq[4];
#pragma unroll
            for (int q = 0; q < 4; ++q) { const int i = i0 + q * ngt; v[q] = (f32x4){0.f, 0.f, 0.f, 0.f}; sq[q] = 1.f;
                if (i < M * 256) { v[q] = ((const f32x4*)XRES)[i]; sq[q] = ssq[i >> 8]; } }
#pragma unroll
            for (int q = 0; q < 4; ++q) { const int i = i0 + q * ngt;
                if (i < M * 256) { const float rs = rsqrtf(sq[q] * (1.f / D) + EPS); const f32x4 gv = ((const f32x4*)fn)[i & 255];
                    f32x4 o = v[q]; o[0] *= rs * gv[0]; o[1] *= rs * gv[1]; o[2] *= rs * gv[2]; o[3] *= rs * gv[3];
                    ((f32x4*)XRES)[i] = o; } }
        }
    }
}

extern "C" void kernel_launch(void* const* d_in, const int* in_sizes, int n_in, void* d_out, int out_size, void* d_ws, size_t ws_size, hipStream_t stream) {
    static int grid = 0;
    if (grid == 0) {
        if (n_in != 23 || (size_t)out_size != O_TOTAL || ws_size < WS_END) { fprintf(stderr, "kernel_launch: unexpected shapes: n_in %d out %d ws %zu\n", n_in, out_size, ws_size); grid = -1; return; }
        int dev = 0, cus = 0, per_cu = 0;
        hipGetDevice(&dev); hipDeviceGetAttribute(&cus, hipDeviceAttributeMultiprocessorCount, dev);
        if (hipFuncSetAttribute((const void*)fwd_megakernel, hipFuncAttributeMaxDynamicSharedMemorySize, LDS_BYTES) != hipSuccess) { fprintf(stderr, "kernel_launch: hipFuncSetAttribute failed\n"); grid = -1; return; }
        hipOccupancyMaxActiveBlocksPerMultiprocessor(&per_cu, (const void*)fwd_megakernel, NTHREADS, LDS_BYTES);
        (void)hipGetLastError();
        if (per_cu < 1) fprintf(stderr, "kernel_launch: occupancy query reports %d blocks per CU\n", per_cu);
        grid = cus;
    }
    if (grid < 0) return;
    if (hipMemsetAsync((char*)d_ws + WS_BAR, 0, 16384, stream) != hipSuccess) { fprintf(stderr, "kernel_launch: memset failed\n"); return; }
    Params p{};
    for (int i = 0; i < 23; ++i) p.in[i] = (const float*)d_in[i];
    p.out = (float*)d_out; p.ws = (unsigned char*)d_ws;
    void* args[] = {&p};
    hipError_t e = hipLaunchCooperativeKernel((const void*)fwd_megakernel, dim3(grid), dim3(NTHREADS), args, LDS_BYTES, stream);
    if (e != hipSuccess) fprintf(stderr, "cooperative launch failed: %s (grid %d)\n", hipGetErrorString(e), grid);
}
```

```cpp
#include <hip/hip_runtime.h>
#include <hip/hip_cooperative_groups.h>
#include <cstdio>
#include <cstdint>
namespace cg = cooperative_groups;
__device__ __forceinline__ int lane_id() { int t; asm volatile("v_mbcnt_lo_u32_b32 %0, -1, 0\n\tv_mbcnt_hi_u32_b32 %0, -1, %0" : "=v"(t)); return t; }
__device__ __forceinline__ int fresh_tid(int wave) { return (wave << 6) | lane_id(); }
namespace pg8 {
#define PG8_LAS __attribute__((address_space(3)))
typedef unsigned short bf16_t;
typedef short bf16x8 __attribute__((ext_vector_type(8)));
typedef float f32x4 __attribute__((ext_vector_type(4)));
typedef unsigned u32x4 __attribute__((ext_vector_type(4)));
constexpr int BM = 256, BK = 64, HALF = 128, HTB = HALF * BK * 2  , STAGE_BYTES = 8 * HTB, NXCD = 8, WGM = 8;

__host__ __device__ __forceinline__ int lds_byte(int r, int c) { const int st = (r >> 4) * 2 + (c >> 5), rr = r & 15, cc = c & 31, ob = rr * 64 + cc * 2; return st * 1024 + (ob ^ (((ob >> 9) & 1) << 5)); }
__host__ __device__ __forceinline__ void stage_rc(int b, int& R, int& C) { const int st = b / 1024, sb = b % 1024, swz = sb ^ (((sb >> 9) & 1) << 5); R = (st >> 1) * 16 + swz / 64; C = (st & 1) * 32 + (swz % 64) / 2; }
__host__ __device__ __forceinline__ int perm32(int rho) { const int n = rho >> 4, i = rho & 15; return 8 * (i >> 2) + 4 * n + (i & 3); }

struct Unit { int pm, pn; };
struct Gemm { const bf16_t* A; const bf16_t* Bt; int M, N, K, lda, ldb; };

struct StaticOrder {
    int nM, nN, nwg, G, c;
    __host__ __device__ void init(int M, int N, int G_, int c_) { nM = M / BM; nN = N / BM; nwg = nM * nN; G = G_; c = c_; }
    __host__ __device__ bool next(int i, Unit& u) const {
        const long L = (long)i * G + c; if (L >= nwg) return false;
        int wgid = (int)L; { const int q = nwg / NXCD, r = nwg % NXCD, xcd = wgid % NXCD, off = wgid / NXCD; wgid = (xcd < r ? xcd * (q + 1) : r * (q + 1) + (xcd - r) * q) + off; }
        const int nig = WGM * nN, gid = wgid / nig, fm = gid * WGM, gsz = (nM - fm) < WGM ? (nM - fm) : WGM;
        u.pm = fm + ((wgid % nig) % gsz); u.pn = (wgid % nig) / gsz; return true;
    }
    __device__ __forceinline__ void a_ready(const Unit&) const {}
    __device__ __forceinline__ void done(const Unit&) const {}
};

template <class Epi, class Sched, bool ALIGN_EPI = false, bool SP2 = false>
__device__ __forceinline__ void gemm_phase(PG8_LAS unsigned char* lds, const Gemm g, const Sched& S, const Epi& E, const int wave_in) {
    const int tid = fresh_tid(wave_in), wid = __builtin_amdgcn_readfirstlane(tid >> 6), lane = tid & 63, wr = wid >> 2, wc = wid & 3, fr = lane & 15, fq = lane >> 4;
    const int K = g.K, nt = K / BK;
    unsigned voffA[2], voffB[2];
#pragma unroll
    for (int i = 0; i < 2; ++i) { int R, C; stage_rc(tid * 16 + i * 8192, R, C); const int Rb = Epi::PERM ? ((R & ~31) + perm32(R & 31)) : R;
        voffA[i] = (unsigned)(R * g.lda + C) * 2u; voffB[i] = (unsigned)(Rb * g.ldb + C) * 2u; }
    const size_t kstep = (size_t)(BK * 2);
    const size_t hstepA = (size_t)HALF * g.lda * 2, hstepB = (size_t)HALF * g.ldb * 2;
    const size_t tstepA = 2 * hstepA, tstepB = 2 * hstepB;
    const unsigned ldsw = (unsigned)wid * 1024u;
    const int aoff = lds_byte(wr * 64 + fr, fq * 8), boff = lds_byte(wc * 32 + fr, fq * 8);
#define PG8_SA(b, h) (((b) * 2 + (h)) * HTB)
#define PG8_SB(b, h) ((4 + (b) * 2 + (h)) * HTB)
#define PG8_STAGE(bufoff, gbase, voff) do { _Pragma("unroll") for (int _i = 0; _i < 2; ++_i) \
        __builtin_amdgcn_global_load_lds((const unsigned*)((const char*)(gbase) + (voff)[_i]), (PG8_LAS unsigned*)(lds + (bufoff) + ldsw + _i * 8192), 16, 0, 0); } while (0)
#define PG8_LDA(dst, b, h) do { _Pragma("unroll") for (int m = 0; m < 4; ++m) _Pragma("unroll") for (int k = 0; k < 2; ++k) dst[m][k] = *(const PG8_LAS bf16x8*)(lds + PG8_SA(b, h) + aoff + m * 2048 + k * 1024); } while (0)
#define PG8_LDB(dst, b, h) do { _Pragma("unroll") for (int n = 0; n < 2; ++n) _Pragma("unroll") for (int k = 0; k < 2; ++k) dst[n][k] = *(const PG8_LAS bf16x8*)(lds + PG8_SB(b, h) + boff + n * 2048 + k * 1024); } while (0)
#define PG8_MMA(ai, bj, At, Bt) do { __builtin_amdgcn_s_setprio(1); _Pragma("unroll") for (int m = 0; m < 4; ++m) _Pragma("unroll") for (int n = 0; n < 2; ++n) _Pragma("unroll") for (int k = 0; k < 2; ++k) \
        acc[ai][bj][m][n] = __builtin_amdgcn_mfma_f32_16x16x32_bf16(Bt[n][k], At[m][k], acc[ai][bj][m][n], 0, 0, 0); __builtin_amdgcn_s_setprio(0); } while (0)
#define PG8_WAIT_V(n) asm volatile("s_waitcnt vmcnt(" #n ")" ::: "memory")
#define PG8_WAIT_L(n) asm volatile("s_waitcnt lgkmcnt(" #n ")" ::: "memory")
#define PG8_BAR __builtin_amdgcn_s_barrier()
#define PG8_SCHED __builtin_amdgcn_sched_barrier(0)
    Unit cur, nxt; int ui = 0;
    if (!S.next(0, cur)) return;
    f32x4 acc[2][2][4][2];
#pragma unroll
    for (int a = 0; a < 2; ++a)
#pragma unroll
        for (int b = 0; b < 2; ++b)
#pragma unroll
            for (int m = 0; m < 4; ++m)
#pragma unroll
                for (int n = 0; n < 2; ++n) acc[a][b][m][n] = (f32x4){0.f, 0.f, 0.f, 0.f};
    bf16x8 At[4][2], B0[2][2], B1[2][2];
    const char* cA = (const char*)g.A + (size_t)cur.pm * tstepA; const char* cB = (const char*)g.Bt + (size_t)cur.pn * tstepB;
    S.a_ready(cur);
    if constexpr (SP2) {
        PG8_STAGE(PG8_SB(0, 0), cB, voffB); PG8_STAGE(PG8_SB(0, 1), cB + hstepB, voffB); PG8_STAGE(PG8_SA(0, 0), cA, voffA); PG8_STAGE(PG8_SA(0, 1), cA + hstepA, voffA);
        if (wr == 1) PG8_BAR;
        PG8_WAIT_V(2); PG8_BAR;
        PG8_STAGE(PG8_SB(1, 0), cB + kstep, voffB); PG8_STAGE(PG8_SA(1, 0), cA + kstep, voffA); PG8_STAGE(PG8_SB(1, 1), cB + hstepB + kstep, voffB);
        PG8_WAIT_V(6); PG8_BAR;
    } else {
        PG8_STAGE(PG8_SB(0, 0), cB, voffB); PG8_STAGE(PG8_SA(0, 0), cA, voffA); PG8_STAGE(PG8_SB(0, 1), cB + hstepB, voffB); PG8_STAGE(PG8_SA(0, 1), cA + hstepA, voffA);
        if (wr == 1) PG8_BAR;
        PG8_WAIT_V(4); PG8_BAR;
        PG8_STAGE(PG8_SB(1, 0), cB + kstep, voffB); PG8_STAGE(PG8_SA(1, 0), cA + kstep, voffA); PG8_STAGE(PG8_SB(1, 1), cB + hstepB + kstep, voffB);
        PG8_WAIT_V(6); PG8_BAR;
    }
    for (;;) {
        const bool has_next = S.next(ui + 1, nxt);
        const char* nA = has_next ? (const char*)g.A + (size_t)nxt.pm * tstepA : cA; const char* nB = has_next ? (const char*)g.Bt + (size_t)nxt.pn * tstepB : cB;
        for (int t = 0; t < nt; t += 2) {
            const bool last = (t == nt - 2);
            const char* a1 = cA + (size_t)(t + 1) * kstep;
            const char* a2 = last ? nA : cA + (size_t)(t + 2) * kstep; const char* b2 = last ? nB : cB + (size_t)(t + 2) * kstep;
            const char* a3 = a2 + kstep; const char* b3 = b2 + kstep;
            if (last && has_next) S.a_ready(nxt);
            if constexpr (SP2) {
            PG8_LDB(B0, 0, 0); PG8_LDB(B1, 0, 1); PG8_SCHED; PG8_LDA(At, 0, 0); PG8_STAGE(PG8_SA(1, 1), a1 + hstepA, voffA);
            PG8_WAIT_V(8); PG8_WAIT_L(0); PG8_BAR; PG8_MMA(0, 0, At, B0); PG8_MMA(0, 1, At, B1); PG8_BAR; PG8_SCHED;
            PG8_LDA(At, 0, 1); PG8_STAGE(PG8_SB(0, 0), b2, voffB); PG8_STAGE(PG8_SB(0, 1), b2 + hstepB, voffB); PG8_STAGE(PG8_SA(0, 0), a2, voffA);
            PG8_WAIT_V(8); PG8_WAIT_L(0); PG8_BAR; PG8_MMA(1, 0, At, B0); PG8_MMA(1, 1, At, B1); PG8_BAR; PG8_SCHED;
            PG8_LDB(B0, 1, 0); PG8_LDB(B1, 1, 1); PG8_SCHED; PG8_LDA(At, 1, 0); PG8_STAGE(PG8_SA(0, 1), a2 + hstepA, voffA);
            PG8_WAIT_V(8); PG8_WAIT_L(0); PG8_BAR; PG8_MMA(0, 0, At, B0); PG8_MMA(0, 1, At, B1); PG8_BAR; PG8_SCHED;
            PG8_LDA(At, 1, 1); PG8_STAGE(PG8_SB(1, 0), b3, voffB); PG8_STAGE(PG8_SB(1, 1), b3 + hstepB, voffB); PG8_STAGE(PG8_SA(1, 0), a3, voffA);
            PG8_WAIT_V(8); PG8_WAIT_L(0); PG8_BAR; PG8_MMA(1, 0, At, B0); PG8_MMA(1, 1, At, B1); PG8_BAR; PG8_SCHED;
            } else {
            PG8_LDB(B0, 0, 0); PG8_SCHED; PG8_LDA(At, 0, 0); PG8_STAGE(PG8_SA(1, 1), a1 + hstepA, voffA);
            PG8_WAIT_L(8); PG8_BAR; PG8_WAIT_L(0); PG8_MMA(0, 0, At, B0); PG8_BAR; PG8_SCHED;
            PG8_LDB(B1, 0, 1); PG8_STAGE(PG8_SB(0, 0), b2, voffB);
            PG8_BAR; PG8_WAIT_L(0); PG8_MMA(0, 1, At, B1); PG8_BAR;
            PG8_LDA(At, 0, 1); PG8_STAGE(PG8_SA(0, 0), a2, voffA);
            PG8_BAR; PG8_WAIT_L(0); PG8_MMA(1, 0, At, B0); PG8_BAR; PG8_SCHED;
            PG8_STAGE(PG8_SB(0, 1), b2 + hstepB, voffB);
            PG8_WAIT_V(6); PG8_BAR; PG8_MMA(1, 1, At, B1); PG8_BAR;
            PG8_LDB(B0, 1, 0); PG8_SCHED; PG8_LDA(At, 1, 0); PG8_STAGE(PG8_SA(0, 1), a2 + hstepA, voffA);
            PG8_WAIT_L(8); PG8_BAR; PG8_WAIT_L(0); PG8_MMA(0, 0, At, B0); PG8_BAR; PG8_SCHED;
            PG8_LDB(B1, 1, 1); PG8_STAGE(PG8_SB(1, 0), b3, voffB);
            PG8_BAR; PG8_WAIT_L(0); PG8_MMA(0, 1, At, B1); PG8_BAR;
            PG8_LDA(At, 1, 1); PG8_STAGE(PG8_SA(1, 0), a3, voffA);
            PG8_BAR; PG8_WAIT_L(0); PG8_MMA(1, 0, At, B0); PG8_BAR; PG8_SCHED;
            PG8_STAGE(PG8_SB(1, 1), b3 + hstepB, voffB);
            PG8_WAIT_V(6); PG8_BAR; PG8_MMA(1, 1, At, B1); PG8_BAR;
            }
        }
        if constexpr (ALIGN_EPI) { if (wr == 0) PG8_BAR; }
        if constexpr (!Epi::AFTER_DRAIN) { E(acc, cur, wr, wc, fr, fq); S.done(cur); }
        if (!has_next) break;
#pragma unroll
        for (int a = 0; a < 2; ++a)
#pragma unroll
            for (int b = 0; b < 2; ++b)
#pragma unroll
                for (int m = 0; m < 4; ++m)
#pragma unroll
                    for (int n = 0; n < 2; ++n) acc[a][b][m][n] = (f32x4){0.f, 0.f, 0.f, 0.f};
        cur = nxt; cA = nA; cB = nB; ++ui;
        if constexpr (ALIGN_EPI) { if (wr == 1) PG8_BAR; }
    }
    PG8_WAIT_V(0);
    if constexpr (!ALIGN_EPI) { if (wr == 0) PG8_BAR; }
    PG8_BAR;
    if constexpr (Epi::AFTER_DRAIN) { E.fused(acc, cur, wr, wc, fr, fq, lds, wid, lane); S.done(cur); }
#undef PG8_SA
#undef PG8_SB
#undef PG8_STAGE
#undef PG8_LDA
#undef PG8_LDB
#undef PG8_MMA
#undef PG8_WAIT_V
#undef PG8_WAIT_L
#undef PG8_BAR
#undef PG8_SCHED
}
}

typedef unsigned short bf16;
typedef unsigned v4u __attribute__((ext_vector_type(4)));
typedef unsigned v2u __attribute__((ext_vector_type(2)));
typedef float f32x4 __attribute__((ext_vector_type(4)));
typedef short bf16x8 __attribute__((ext_vector_type(8)));

constexpr int D = 1024, MP = 16384, MS = 1024, M = MP + MS, SEQL = 2048, NBATCH = 8, DBATCH = 128;
constexpr int NPROJ = 3072, FF = 2816, NGU = 5632, DIN = 3080, MH = M / 2;
constexpr float EPS = 1e-6f;
constexpr int NTHREADS = 512, NWAVES = 8;
constexpr int LDS_BYTES = 155648;
constexpr size_t MiB = 1u << 20;
constexpr size_t WS_WOUT = 0, WS_WGU = 4 * MiB, WS_WDN = 26 * MiB, WS_XA = 37 * MiB, WS_PROJ = 71 * MiB, WS_GU = 105 * MiB, WS_SCR = 173 * MiB, WS_WIN = 239 * MiB;
constexpr size_t WS_GB = 245 * MiB, WS_SSQ = 245 * MiB + 576 * 1024, WS_WAB = 246 * MiB, WS_GL = 246 * MiB + 64 * 1024, WS_HALO = 246 * MiB + 128 * 1024, WS_BAR = 246 * MiB + 192 * 1024, WS_PART2 = 200 * MiB, WS_HAL = 247 * MiB, WS_FIXG = 249 * MiB, WS_FIXU = 251 * MiB, WS_END = 253 * MiB;
constexpr int SCR_ITEM = 73728;
constexpr size_t O_PDELTA = 17825792, O_PDCONV = 18874368, O_PPOOL = 18948096, O_PSCONV = 19009536, O_PFFN = 19017728;
constexpr size_t O_SDELTA = 19107840, O_SDCONV = 35885056, O_SPOOL = 37064704, O_SSCONV = 38047744, O_SFFN = 38178816, O_TOTAL = 39620608;

struct Params { const float* in[23]; float* out; unsigned char* ws; };
typedef const __attribute__((address_space(4))) Params* KP;
__device__ __forceinline__ KP kparams() { KP p = (KP)__builtin_amdgcn_kernarg_segment_ptr(); asm volatile("" : "+s"(p)); return p; }

#define LAUNDER(p) asm volatile("" : "+s"(p))
#define LDS_WAIT() asm volatile("s_waitcnt lgkmcnt(0)" ::: "memory")
__device__ __forceinline__ unsigned f2bf(float f) { unsigned u = __builtin_bit_cast(unsigned, f); return (u + 0x7fffu + ((u >> 16) & 1u)) >> 16; }
__device__ __forceinline__ unsigned pk2(float lo, float hi) { return f2bf(lo) | (f2bf(hi) << 16); }
__device__ __forceinline__ float bflo(unsigned u) { return __builtin_bit_cast(float, u << 16); }
__device__ __forceinline__ float bfhi(unsigned u) { return __builtin_bit_cast(float, u & 0xffff0000u); }
__device__ __forceinline__ float bf1(bf16 h) { return __builtin_bit_cast(float, ((unsigned)h) << 16); }
__device__ __forceinline__ float siluf(float x) { return x * __builtin_amdgcn_rcpf(1.f + __expf(-x)); }
__device__ __forceinline__ float shx(float v, int m) { return __builtin_bit_cast(float, __builtin_amdgcn_ds_bpermute((lane_id() ^ m) << 2, __builtin_bit_cast(int, v))); }
__device__ __forceinline__ float rdl(float v, int l) { return __builtin_bit_cast(float, __builtin_amdgcn_readlane(__builtin_bit_cast(int, v), l)); }
template <int CTRL> __device__ __forceinline__ float dpp_mov(float v) { const int i = __builtin_bit_cast(int, v); return __builtin_bit_cast(float, __builtin_amdgcn_update_dpp(i, i, CTRL, 0xf, 0xf, false)); }
__device__ __forceinline__ float wave_sum(float v) {
    v += dpp_mov<0x128>(v); v += dpp_mov<0x124>(v); v += dpp_mov<0x122>(v); v += dpp_mov<0x121>(v);
    const int i = __builtin_bit_cast(int, v);
    return (__builtin_bit_cast(float, __builtin_amdgcn_readlane(i, 0)) + __builtin_bit_cast(float, __builtin_amdgcn_readlane(i, 16))) +
           (__builtin_bit_cast(float, __builtin_amdgcn_readlane(i, 32)) + __builtin_bit_cast(float, __builtin_amdgcn_readlane(i, 48)));
}
#define UNPACK8(W_, F_) do { (F_)[0] = bflo((W_).x); (F_)[1] = bfhi((W_).x); (F_)[2] = bflo((W_).y); (F_)[3] = bfhi((W_).y); (F_)[4] = bflo((W_).z); (F_)[5] = bfhi((W_).z); (F_)[6] = bflo((W_).w); (F_)[7] = bfhi((W_).w); } while (0)
#define PACK8(F_) ((v4u){pk2((F_)[0], (F_)[1]), pk2((F_)[2], (F_)[3]), pk2((F_)[4], (F_)[5]), pk2((F_)[6], (F_)[7])})

struct EpiScale {
    static constexpr bool PERM = true, AFTER_DRAIN = false;
    bf16* O; int ldc; const float* ssq;
    __device__ __forceinline__ void operator()(const pg8::f32x4 (&acc)[2][2][4][2], const pg8::Unit& u, int wr, int wc, int fr, int fq) const {
        const int row0 = u.pm * 256 + wr * 64 + fr, col0 = u.pn * 256 + wc * 32 + 8 * fq;
        float sq[2][4];
#pragma unroll
        for (int ai = 0; ai < 2; ++ai)
#pragma unroll
            for (int m = 0; m < 4; ++m) sq[ai][m] = ssq[row0 + ai * 128 + m * 16];
#pragma unroll
        for (int ai = 0; ai < 2; ++ai)
#pragma unroll
            for (int m = 0; m < 4; ++m) {
                const int row = row0 + ai * 128 + m * 16;
                const float rs = rsqrtf(sq[ai][m] * (1.f / D) + EPS);
                bf16* rowp = O + (size_t)row * ldc + col0;
#pragma unroll
                for (int bj = 0; bj < 2; ++bj) {
                    pg8::f32x4 v0 = acc[ai][bj][m][0] * rs, v1 = acc[ai][bj][m][1] * rs;
                    v4u w; w.x = pk2(v0[0], v0[1]); w.y = pk2(v0[2], v0[3]); w.z = pk2(v1[0], v1[1]); w.w = pk2(v1[2], v1[3]);
                    *(v4u*)(rowp + bj * 128) = w;
                }
            }
    }
};
struct EpiResid {
    static constexpr bool PERM = true, AFTER_DRAIN = false;
    const float* xa; const float* xb_; float* xres; bf16* xb16; float* ssq; int rowbase;
    __device__ __forceinline__ void operator()(const pg8::f32x4 (&acc)[2][2][4][2], const pg8::Unit& u, int wr, int wc, int fr, int fq) const {
        const int row0 = rowbase + u.pm * 256 + wr * 64 + fr, col0 = u.pn * 256 + wc * 32 + 8 * fq;
#pragma unroll
        for (int ai = 0; ai < 2; ++ai) {
            pg8::f32x4 xo4[4][4];
#pragma unroll
            for (int m = 0; m < 4; ++m) {
                const int row = row0 + ai * 128 + m * 16;
                const float* xo = (row < MP ? xa + (size_t)row * D : xb_ + (size_t)(row - MP) * D) + col0;
                xo4[m][0] = *(const pg8::f32x4*)xo; xo4[m][1] = *(const pg8::f32x4*)(xo + 4); xo4[m][2] = *(const pg8::f32x4*)(xo + 128); xo4[m][3] = *(const pg8::f32x4*)(xo + 132);
            }
#pragma unroll
            for (int m = 0; m < 4; ++m) {
                const int row = row0 + ai * 128 + m * 16;
                float* xr = xres + (size_t)row * D + col0;
                bf16* xh = xb16 + (size_t)row * D + col0;
                float ss = 0.f;
#pragma unroll
                for (int bj = 0; bj < 2; ++bj) {
                    pg8::f32x4 v0 = acc[ai][bj][m][0] + xo4[m][2 * bj], v1 = acc[ai][bj][m][1] + xo4[m][2 * bj + 1];
                    *(pg8::f32x4*)(xr + bj * 128) = v0; *(pg8::f32x4*)(xr + bj * 128 + 4) = v1;
                    v4u w; w.x = pk2(v0[0], v0[1]); w.y = pk2(v0[2], v0[3]); w.z = pk2(v1[0], v1[1]); w.w = pk2(v1[2], v1[3]);
                    *(v4u*)(xh + bj * 128) = w;
                    ss += v0[0] * v0[0] + v0[1] * v0[1] + v0[2] * v0[2] + v0[3] * v0[3] + v1[0] * v1[0] + v1[1] * v1[1] + v1[2] * v1[2] + v1[3] * v1[3];
                }
                ss += shx(ss, 16); ss += shx(ss, 32);
                if (fq == 0) atomicAdd(ssq + row, ss);
            }
        }
    }
};


struct SplitOrder {
    int unit;
    __device__ __forceinline__ bool next(int i, pg8::Unit& u) const { if (i != 0 || unit < 0) return false; u.pm = unit >> 2; u.pn = unit & 3; return true; }
    __device__ __forceinline__ void a_ready(const pg8::Unit&) const {}
    __device__ __forceinline__ void done(const pg8::Unit&) const {}
};
struct EpiAtomic {
    static constexpr bool PERM = true, AFTER_DRAIN = false;
    float* X;
    __device__ __forceinline__ void operator()(const pg8::f32x4 (&acc)[2][2][4][2], const pg8::Unit& u, int wr, int wc, int fr, int fq) const {
        const int row0 = u.pm * 256 + wr * 64 + fr, col0 = u.pn * 256 + wc * 32 + 8 * fq;
#pragma unroll
        for (int ai = 0; ai < 2; ++ai)
#pragma unroll
            for (int m = 0; m < 4; ++m) {
                float* xr = X + (size_t)(row0 + ai * 128 + m * 16) * D + col0;
#pragma unroll
                for (int bj = 0; bj < 2; ++bj) { *(pg8::f32x4*)(xr + bj * 128) = acc[ai][bj][m][0]; *(pg8::f32x4*)(xr + bj * 128 + 4) = acc[ai][bj][m][1]; }
            }
    }
};
__device__ __forceinline__ void fin_sample(float* X, bf16* XB, float* ssq, const float* partA, int nA, const float* partB, int nB, int gw, int ngw, int lane) {
    for (int r = gw; r < MS; r += ngw) {
        f32x4 v[4];
#pragma unroll
        for (int j = 0; j < 4; ++j) v[j] = ((const f32x4*)(X + (size_t)r * D))[lane + 64 * j];
        for (int k = 0; k < nA; ++k) {
#pragma unroll
            for (int j = 0; j < 4; ++j) v[j] += ((const f32x4*)(partA + ((size_t)k * MS + r) * D))[lane + 64 * j];
        }
        for (int k = 0; k < nB; ++k) {
#pragma unroll
            for (int j = 0; j < 4; ++j) v[j] += ((const f32x4*)(partB + ((size_t)k * MS + r) * D))[lane + 64 * j];
        }
        float ss = 0.f;
#pragma unroll
        for (int j = 0; j < 4; ++j) { ss += v[j][0] * v[j][0] + v[j][1] * v[j][1] + v[j][2] * v[j][2] + v[j][3] * v[j][3];
            ((f32x4*)(X + (size_t)r * D))[lane + 64 * j] = v[j];
            ((v2u*)(XB + (size_t)r * D))[lane + 64 * j] = (v2u){pk2(v[j][0], v[j][1]), pk2(v[j][2], v[j][3])}; }
        ss = wave_sum(ss);
        if (lane == 0) ssq[r] = ss;
    }
}

constexpr int EPI_HALO_OFF = 131072;
__device__ __forceinline__ float dpp_f(float oldv, float src, const int ctrl_sel) {
    const int o = __builtin_bit_cast(int, oldv), v = __builtin_bit_cast(int, src); int r;
    if (ctrl_sel == 0) r = __builtin_amdgcn_update_dpp(o, v, 0x111, 0xf, 0xf, false);
    else if (ctrl_sel == 1) r = __builtin_amdgcn_update_dpp(o, v, 0x112, 0xf, 0xf, false);
    else if (ctrl_sel == 2) r = __builtin_amdgcn_update_dpp(o, v, 0x121, 0xf, 0xf, false);
    else r = __builtin_amdgcn_update_dpp(o, v, 0x122, 0xf, 0xf, false);
    return __builtin_bit_cast(float, r);
}
struct EpiGateUp {
    static constexpr bool PERM = true, AFTER_DRAIN = false;
    bf16* ACT; const float* ssq; const float* cw; const float* st; float* HAL; float* FIXG; float* FIXU; float* pffn; float* sffn; unsigned char* lds;
    __device__ __forceinline__ void operator()(const pg8::f32x4 (&acc)[2][2][4][2], const pg8::Unit& u, int wr, int wc, int fr, int fq) const {
        const int pm = u.pm, ch0 = u.pn * 128 + wc * 32 + 8 * fq, row0 = pm * 256 + wr * 64 + fr;
        const bool smp = pm >= 64;
        float* halo = (float*)(lds + EPI_HALO_OFF);
#pragma unroll
        for (int ai = 0; ai < 2; ++ai) {
            const float rs = rsqrtf(ssq[row0 + ai * 128 + 48] * (1.f / D) + EPS);
            if (fr >= 14) {
                float* hp = halo + ((ai * 2 + wr) * 2 + (fr - 14)) * 128 + wc * 32 + 8 * fq;
                *(pg8::f32x4*)hp = acc[ai][0][3][0] * rs; *(pg8::f32x4*)(hp + 4) = acc[ai][0][3][1] * rs;
            }
        }
        asm volatile("s_waitcnt lgkmcnt(0)" ::: "memory");
        __builtin_amdgcn_s_barrier();
        float w0[8], w1[8], w2[8];
#pragma unroll
        for (int e = 0; e < 8; ++e) { w0[e] = cw[ch0 + e]; w1[e] = cw[FF + ch0 + e]; w2[e] = cw[2 * FF + ch0 + e]; }
#pragma unroll
        for (int ai = 0; ai < 2; ++ai) {
            const int s = ai * 2 + wr;
            float prev[8];
#pragma unroll
            for (int e = 0; e < 8; ++e) prev[e] = 0.f;
            if (!smp && s >= 1 && fr >= 14) {
                const float* hp = halo + ((s - 1) * 2 + (fr - 14)) * 128 + wc * 32 + 8 * fq;
                const pg8::f32x4 h0 = *(const pg8::f32x4*)hp, h1 = *(const pg8::f32x4*)(hp + 4);
                prev[0] = h0[0]; prev[1] = h0[1]; prev[2] = h0[2]; prev[3] = h0[3]; prev[4] = h1[0]; prev[5] = h1[1]; prev[6] = h1[2]; prev[7] = h1[3];
            }
            float sq4[4];
#pragma unroll
            for (int m = 0; m < 4; ++m) sq4[m] = ssq[row0 + ai * 128 + m * 16];
#pragma unroll
            for (int m = 0; m < 4; ++m) {
                const int row = row0 + ai * 128 + m * 16;
                const float rs = rsqrtf(sq4[m] * (1.f / D) + EPS);
                float cur[8], upv[8], s0v[8], s1v[8];
#pragma unroll
                for (int e = 0; e < 8; ++e) { cur[e] = acc[ai][0][m][e >> 2][e & 3] * rs; upv[e] = acc[ai][1][m][e >> 2][e & 3] * rs; s0v[e] = 0.f; s1v[e] = 0.f; }
                const int t = fr & 7, sb = (row - MP) >> 3;
                if (smp && t < 2) {
                    const float* sp = st + (size_t)(sb * 2) * FF + ch0;
#pragma unroll
                    for (int e = 0; e < 8; ++e) { s0v[e] = sp[e]; s1v[e] = sp[FF + e]; }
                }
                float a[8];
#pragma unroll
                for (int e = 0; e < 8; ++e) {
                    const float sh1 = dpp_f(cur[e], cur[e], 0), sh2 = dpp_f(cur[e], cur[e], 1), ro1 = dpp_f(prev[e], prev[e], 2), ro2 = dpp_f(prev[e], prev[e], 3);
                    float p1, p2;
                    if (smp) { p1 = t >= 1 ? sh1 : s1v[e]; p2 = t >= 2 ? sh2 : (t == 1 ? s1v[e] : s0v[e]); }
                    else { p1 = fr >= 1 ? sh1 : ro1; p2 = fr >= 2 ? sh2 : ro2; }
                    a[e] = siluf(w0[e] * p2 + w1[e] * p1 + w2[e] * cur[e]) * upv[e];
                }
                *(v4u*)(ACT + (size_t)row * FF + ch0) = PACK8(a);
                if (smp) {
                    if (t >= 6) { float* o = sffn + (size_t)(sb * 2 + t - 6) * FF + ch0;
                        *(pg8::f32x4*)o = (pg8::f32x4){cur[0], cur[1], cur[2], cur[3]}; *(pg8::f32x4*)(o + 4) = (pg8::f32x4){cur[4], cur[5], cur[6], cur[7]}; }
                } else {
                    if (s == 3 && m == 3 && fr >= 14) {
                        float* o = HAL + (size_t)(pm * 2 + fr - 14) * FF + ch0;
                        *(pg8::f32x4*)o = (pg8::f32x4){cur[0], cur[1], cur[2], cur[3]}; *(pg8::f32x4*)(o + 4) = (pg8::f32x4){cur[4], cur[5], cur[6], cur[7]};
                        if ((pm & 7) == 7) { float* o2 = pffn + (size_t)((pm >> 3) * 2 + fr - 14) * FF + ch0;
                            *(pg8::f32x4*)o2 = (pg8::f32x4){cur[0], cur[1], cur[2], cur[3]}; *(pg8::f32x4*)(o2 + 4) = (pg8::f32x4){cur[4], cur[5], cur[6], cur[7]}; }
                    }
                    if (s == 0 && m == 0 && fr < 2 && (pm & 7) != 0) {
                        float* o = FIXG + (size_t)(pm * 2 + fr) * FF + ch0; float* o2 = FIXU + (size_t)(pm * 2 + fr) * FF + ch0;
                        *(pg8::f32x4*)o = (pg8::f32x4){cur[0], cur[1], cur[2], cur[3]}; *(pg8::f32x4*)(o + 4) = (pg8::f32x4){cur[4], cur[5], cur[6], cur[7]};
                        *(pg8::f32x4*)o2 = (pg8::f32x4){upv[0], upv[1], upv[2], upv[3]}; *(pg8::f32x4*)(o2 + 4) = (pg8::f32x4){upv[4], upv[5], upv[6], upv[7]};
                    }
                }
#pragma unroll
                for (int e = 0; e < 8; ++e) prev[e] = cur[e];
            }
        }
    }
};
__device__ __forceinline__ void p4_fixup(KP P, int l, int start, int stride) {
    const float* HAL = (const float*)(P->ws + WS_HAL); const float* FIXG = (const float*)(P->ws + WS_FIXG); const float* FIXU = (const float*)(P->ws + WS_FIXU);
    bf16* ACT = (bf16*)(P->ws + WS_GU);
    const float* cw = P->in[19] + (size_t)(l * 3) * FF;
    for (int idx = start; idx < 56 * 2 * FF; idx += stride) {
        const int k = idx / (2 * FF), rem = idx % (2 * FF), rr = rem / FF, c = rem % FF;
        const int pm = (k / 7) * 8 + 1 + (k % 7);
        const float g0 = FIXG[(size_t)(pm * 2 + rr) * FF + c];
        const float g1 = rr == 0 ? HAL[(size_t)((pm - 1) * 2 + 1) * FF + c] : FIXG[(size_t)(pm * 2) * FF + c];
        const float g2 = rr == 0 ? HAL[(size_t)((pm - 1) * 2) * FF + c] : HAL[(size_t)((pm - 1) * 2 + 1) * FF + c];
        const float a = siluf(cw[c] * g2 + cw[FF + c] * g1 + cw[2 * FF + c] * g0) * FIXU[(size_t)(pm * 2 + rr) * FF + c];
        ACT[(size_t)(pm * 256 + rr) * FF + c] = (bf16)f2bf(a);
    }
}
__device__ __forceinline__ void transpose_item(const float* W, int K, int ldw, int src_col0, const float* g, bf16* WT, int dst_row0, float* scr, int kb, int lane) {
    const int k0 = 64 * kb;
    float wv[32];
#pragma unroll
    for (int i = 0; i < 32; ++i) wv[i] = W[(size_t)(k0 + 2 * i + (lane >> 5)) * ldw + src_col0 + (lane & 31)];
#pragma unroll
    for (int i = 0; i < 32; ++i) { const int kk = 2 * i + (lane >> 5); const float gs = g ? g[k0 + kk] : 1.f; scr[kk * 33 + (lane & 31)] = wv[i] * gs; }
    LDS_WAIT();
    const int c = lane & 7;
#pragma unroll
    for (int j = 0; j < 4; ++j) { const int n = (lane >> 3) + 8 * j; const float* s = scr + (8 * c) * 33 + n;
        v4u o; o.x = pk2(s[0 * 33], s[1 * 33]); o.y = pk2(s[2 * 33], s[3 * 33]); o.z = pk2(s[4 * 33], s[5 * 33]); o.w = pk2(s[6 * 33], s[7 * 33]);
        *(v4u*)(WT + (size_t)(dst_row0 + n) * K + k0 + 8 * c) = o; }
    LDS_WAIT();
}
__device__ __forceinline__ void convert_matrix(const float* W, int K, int N, int ldw, int skip_from, int skip, const float* g, bf16* WT, int dst_row0, float* scr, int gw, int ngw, int lane, int il = 0) {
    const int nnb = N / 32, nit = (K / 64) * nnb;
    for (int it = gw; it < nit; it += ngw) {
        const int kb = it / nnb, nb = it % nnb, n0 = nb * 32;
        const int drow = il ? ((n0 >> 7) * 256 + (n0 & 127) + (il == 2 ? 128 : 0)) : n0;
        transpose_item(W, K, ldw, n0 + (n0 >= skip_from ? skip : 0), g, WT, dst_row0 + drow, scr, kb, lane);
    }
}
__device__ __forceinline__ void convert_layer_rest(KP P, int l, float* scr, int gw, int ngw, int lane) {
    unsigned char* ws = P->ws;
    convert_matrix(P->in[16] + (size_t)l * D * D, D, D, D, 1 << 30, 0, nullptr, (bf16*)(ws + WS_WOUT) + (size_t)l * D * D, 0, scr, gw, ngw, lane);
    convert_matrix(P->in[18] + (size_t)l * D * FF, D, FF, FF, 1 << 30, 0, P->in[17] + l * D, (bf16*)(ws + WS_WGU) + (size_t)l * NGU * D, 0, scr, gw, ngw, lane, 1);
    convert_matrix(P->in[20] + (size_t)l * D * FF, D, FF, FF, 1 << 30, 0, P->in[17] + l * D, (bf16*)(ws + WS_WGU) + (size_t)l * NGU * D, 0, scr, gw, ngw, lane, 2);
    convert_matrix(P->in[21] + (size_t)l * FF * D, FF, D, D, 1 << 30, 0, nullptr, (bf16*)(ws + WS_WDN) + (size_t)l * D * FF, 0, scr, gw, ngw, lane);
}
__device__ __forceinline__ void convert_win(KP P, int l, float* scr, int gw, int ngw, int lane) {
    convert_matrix(P->in[8] + (size_t)l * D * DIN, D, NPROJ, DIN, 2048, 8, P->in[7] + l * D, (bf16*)(P->ws + WS_WIN), 0, scr, gw, ngw, lane);
}

constexpr int B_QF = 0, B_KF = 33792, B_VF = 67584, B_AT = 101376, B_GC = 118784, B_QKS = 120320, B_WST = 128512;
__device__ __forceinline__ void p2b_item(KP P, int l, int item, unsigned char* lds, int wave_in) {
    const int tid = fresh_tid(wave_in);
    const int h = item & 3, n = (item >> 2) & 31, b = item >> 7;
    const int lane = tid & 63, wv = __builtin_amdgcn_readfirstlane(tid >> 6), fr = lane & 15, fq = lane >> 4;
    float* QF = (float*)(lds + B_QF); float* KF = (float*)(lds + B_KF); float* VF = (float*)(lds + B_VF); float* AT = (float*)(lds + B_AT);
    float* Gs = (float*)(lds + B_GC); float* BETA = Gs + 64; float* GC = Gs + 128; float* EG = Gs + 192; float* EKD = Gs + 256;
    bf16* QKS = (bf16*)(lds + B_QKS); bf16* WST = (bf16*)(lds + B_WST);
    const bf16* PROJ = (const bf16*)(P->ws + WS_PROJ);
    const float* GB = (const float*)(P->ws + WS_GB);
    unsigned char* scr = P->ws + WS_SCR + (size_t)item * SCR_ITEM;
    if (tid < 384) {
        const int chunk = tid % 48, tg = tid / 48, part = chunk >> 4, cc = chunk & 15;
        const int col = part * 512 + h * 128 + cc * 8;
        const float* cw = P->in[9] + (size_t)(l * 4) * 1536 + col;
        float w0[8], w1[8], w2[8], w3[8];
#pragma unroll
        for (int e = 0; e < 8; ++e) { w0[e] = cw[e]; w1[e] = cw[1536 + e]; w2[e] = cw[2 * 1536 + e]; w3[e] = cw[3 * 1536 + e]; }
        const int t0 = n * 64 + tg * 8;
        const bf16* base = PROJ + (size_t)(b * SEQL) * NPROJ + col;
        float r0[8], r1[8], r2[8], r3[8];
#pragma unroll
        for (int e = 0; e < 8; ++e) { r0[e] = 0.f; r1[e] = 0.f; r2[e] = 0.f; }
        if (t0 - 3 >= 0) { const v4u w = *(const v4u*)(base + (size_t)(t0 - 3) * NPROJ); UNPACK8(w, r0); }
        if (t0 - 2 >= 0) { const v4u w = *(const v4u*)(base + (size_t)(t0 - 2) * NPROJ); UNPACK8(w, r1); }
        if (t0 - 1 >= 0) { const v4u w = *(const v4u*)(base + (size_t)(t0 - 1) * NPROJ); UNPACK8(w, r2); }
        float* dst = (float*)(lds + part * 33792) + cc * 8;
#pragma unroll
        for (int i = 0; i < 8; ++i) {
            const v4u w = *(const v4u*)(base + (size_t)(t0 + i) * NPROJ); UNPACK8(w, r3);
            float s[8];
#pragma unroll
            for (int e = 0; e < 8; ++e) { const float cv = w0[e] * r0[e] + w1[e] * r1[e] + w2[e] * r2[e] + w3[e] * r3[e]; s[e] = siluf(cv); }
            float* d = dst + (tg * 8 + i) * 132;
            *(f32x4*)d = (f32x4){s[0], s[1], s[2], s[3]}; *(f32x4*)(d + 4) = (f32x4){s[4], s[5], s[6], s[7]};
#pragma unroll
            for (int e = 0; e < 8; ++e) { r0[e] = r1[e]; r1[e] = r2[e]; r2[e] = r3[e]; }
        }
    }
    if (tid < 64) { const int row = b * SEQL + n * 64 + tid; Gs[tid] = GB[(size_t)row * 8 + h]; BETA[tid] = GB[(size_t)row * 8 + 4 + h]; }
    __syncthreads();
    {
        const int tok = tid >> 3, sub = tid & 7;
        float* qr = QF + tok * 132 + sub * 16; float* kr = KF + tok * 132 + sub * 16;
        float qv[16], kv[16]; float sq = 0.f, sk = 0.f;
#pragma unroll
        for (int e = 0; e < 16; ++e) { qv[e] = qr[e]; kv[e] = kr[e]; sq += qv[e] * qv[e]; sk += kv[e] * kv[e]; }
        sq += shx(sq, 1); sq += shx(sq, 2); sq += shx(sq, 4);
        sk += shx(sk, 1); sk += shx(sk, 2); sk += shx(sk, 4);
        const float rq = rsqrtf(sq + EPS) * 0.08838834764831845f, rk = rsqrtf(sk + EPS);
#pragma unroll
        for (int e = 0; e < 16; ++e) { qr[e] = qv[e] * rq; kr[e] = kv[e] * rk; }
    }
    if (tid < 64) {
        float v = Gs[tid];
#pragma unroll
        for (int o = 1; o < 64; o <<= 1) { const int src = tid >= o ? tid - o : tid; const float t = __builtin_bit_cast(float, __builtin_amdgcn_ds_bpermute(src << 2, __builtin_bit_cast(int, v))); if (tid >= o) v += t; }
        const float tot = rdl(v, 63);
        GC[tid] = v; EG[tid] = __expf(v); EKD[tid] = __expf(tot - v);
        if (tid == 0) ((float*)(P->ws + WS_GL))[item] = __expf(tot);
    }
    __syncthreads();
    {
        const int p = wv >> 2, mt = wv & 3;
        const float* X = p ? QF : KF;
        f32x4 acc[4];
#pragma unroll
        for (int nt = 0; nt < 4; ++nt) acc[nt] = (f32x4){0.f, 0.f, 0.f, 0.f};
        const float* xa = X + (mt * 16 + fr) * 132 + fq; const float* kb_ = KF + fr * 132 + fq;
#pragma unroll 8
        for (int k = 0; k < 128; k += 4) {
            const float a = xa[k];
#pragma unroll
            for (int nt = 0; nt < 4; ++nt) acc[nt] = __builtin_amdgcn_mfma_f32_16x16x4f32(a, kb_[nt * 16 * 132 + k], acc[nt], 0, 0, 0);
        }
#pragma unroll
        for (int nt = 0; nt < 4; ++nt) {
            const int j = nt * 16 + fr; const float gj = GC[j];
            float v[4];
#pragma unroll
            for (int r = 0; r < 4; ++r) {
                const int i = mt * 16 + 4 * fq + r;
                if (p == 0) v[r] = (i > j) ? BETA[i] * acc[nt][r] * __expf(GC[i] - gj) : 0.f;
                else        v[r] = (i >= j) ? acc[nt][r] * __expf(GC[i] - gj) : 0.f;
            }
            if (p == 0) *(f32x4*)(AT + j * 68 + mt * 16 + 4 * fq) = (f32x4){v[0], v[1], v[2], v[3]};
            else {
#pragma unroll
                for (int r = 0; r < 4; ++r) QKS[(mt * 16 + 4 * fq + r) * 64 + j] = (bf16)f2bf(v[r]);
            }
        }
    }
    __syncthreads();
    const int tid4 = fresh_tid(wave_in);
    if (tid4 < 256) {
        float x[64];
        int zo = 0; asm volatile("" : "+v"(zo));
        const float* ATz = AT + zo; const float* BETAz = BETA + zo; const float* EGz = EG + zo;
        if (tid4 < 128) {
#pragma unroll
            for (int i = 0; i < 64; ++i) x[i] = BETAz[i] * VF[i * 132 + tid4];
        } else {
#pragma unroll
            for (int i = 0; i < 64; ++i) x[i] = BETAz[i] * EGz[i] * KF[i * 132 + tid4 - 128];
        }
        f32x4 ab[16];
#pragma unroll
        for (int q = 0; q < 16; ++q) ab[q] = *(const f32x4*)(ATz + q * 4);
        typedef float f32x2_t __attribute__((ext_vector_type(2)));
        f32x2_t x2[32];
#pragma unroll
        for (int p = 0; p < 32; ++p) x2[p] = (f32x2_t){x[2 * p], x[2 * p + 1]};
#pragma unroll
        for (int j = 0; j < 63; ++j) {
            const float xj = (j & 1) ? x2[j >> 1].y : x2[j >> 1].x;
            const f32x2_t xj2 = (f32x2_t){xj, xj};
#pragma unroll
            for (int q = (j + 1) / 4; q < 16; ++q) {
#pragma unroll
                for (int hh = 0; hh < 2; ++hh) {
                    const int p = 2 * q + hh;
                    if (2 * p > j) x2[p] -= (f32x2_t){ab[q][2 * hh], ab[q][2 * hh + 1]} * xj2;
                    else if (2 * p + 1 > j) x2[p].y -= ab[q][2 * hh + 1] * xj;
                }
                if (j + 1 < 63 && q >= (j + 2) / 4) ab[q] = *(const f32x4*)(ATz + (j + 1) * 68 + q * 4);
                __builtin_amdgcn_sched_barrier(0);
            }
        }
#pragma unroll
        for (int p = 0; p < 32; ++p) { x[2 * p] = x2[p].x; x[2 * p + 1] = x2[p].y; }
        if (tid4 < 128) {
            unsigned char* up = scr + 49152 + tid4 * 128;
#pragma unroll
            for (int q = 0; q < 8; ++q) *(v4u*)(up + q * 16) = PACK8(x + 8 * q);
        } else {
            const int dk = tid4 - 128;
#pragma unroll
            for (int i = 0; i < 64; ++i) WST[i * 128 + dk] = (bf16)f2bf(-x[i]);
        }
    } else {
        const int t2 = tid4 - 256;
        {
            const int tok = t2 >> 2, seg = t2 & 3; const float eg = EG[tok]; const float* s = QF + tok * 132 + seg * 32;
            unsigned char* o = scr + 16384 + tok * 256 + seg * 64;
#pragma unroll
            for (int q = 0; q < 4; ++q) { float f[8];
#pragma unroll
                for (int e = 0; e < 8; ++e) f[e] = s[q * 8 + e] * eg;
                *(v4u*)(o + q * 16) = PACK8(f); }
        }
        {
            const int dk = t2 >> 1, hf = t2 & 1; unsigned char* o = scr + 32768 + dk * 128 + hf * 64;
#pragma unroll
            for (int q = 0; q < 4; ++q) { float f[8];
#pragma unroll
                for (int e = 0; e < 8; ++e) { const int tok = hf * 32 + q * 8 + e; f[e] = KF[tok * 132 + dk] * EKD[tok]; }
                *(v4u*)(o + q * 16) = PACK8(f); }
        }
#pragma unroll
        for (int q = 0; q < 2; ++q) { const int c = t2 + 256 * q; *(v4u*)(scr + 65536 + c * 16) = *(const v4u*)((const unsigned char*)QKS + c * 16); }
    }
    __syncthreads();
#pragma unroll
    for (int q = 0; q < 2; ++q) { const int c = tid4 + 512 * q; *(v4u*)(scr + c * 16) = *(const v4u*)((const unsigned char*)WST + c * 16); }
    __syncthreads();
}

constexpr int S_ST = 0, S_VNT = 34816, S_OPW = 53248, S_OPQG = 70656, S_OPKD = 88064, S_OPQK = 106496, S_OPU = 115712;
__device__ __forceinline__ void scan_load(v4u (&pre)[9], const unsigned char* src, int tid, int half) {
#pragma unroll
    for (int i = 0; i < 9; ++i) pre[i] = *(const v4u*)(src + (size_t)(tid + 512 * i) * 16);
}
__device__ __forceinline__ void scan_chunk(v4u (&pre)[9], f32x4 (&sacc)[8], unsigned char* lds, unsigned char* scrbase, bf16* orow, int item, int n, float egl, int tid, int w, int fr, int fq, int half) {
    asm volatile("s_waitcnt lgkmcnt(0)" ::: "memory"); __builtin_amdgcn_s_barrier(); asm volatile("" ::: "memory");
#pragma unroll
    for (int i = 0; i < 9; ++i) {
        const int e = (tid + 512 * i) * 16 - (i >> 1) * 16384;
        if (i < 4) { const int row = e >> 8, cb = e & 255; *(v4u*)(lds + (i < 2 ? S_OPW : S_OPQG) + row * 272 + cb) = pre[i]; }
        else { const int row = e >> 7, cb = e & 127; *(v4u*)(lds + (i < 6 ? S_OPKD : (i < 8 ? S_OPU : S_OPQK)) + row * 144 + cb) = pre[i]; }
    }
    asm volatile("s_waitcnt lgkmcnt(0)" ::: "memory"); __builtin_amdgcn_s_barrier(); asm volatile("" ::: "memory");
    scan_load(pre, scrbase + (size_t)(item + (n + 2 < 32 ? 8 : 0)) * SCR_ITEM, tid, half);
    if (w < 4) {
    const int dvt = half * 4 + w;
#define SB() __builtin_amdgcn_sched_barrier(0)
    bf16x8 sf[4];
#pragma unroll
    for (int ks = 0; ks < 4; ++ks) sf[ks] = *(const bf16x8*)(lds + S_ST + (16 * w + fr) * 272 + (ks * 32 + 8 * fq) * 2);
    f32x4 vt[4];
    v2u uu[4];
#pragma unroll
    for (int tt = 0; tt < 4; ++tt) uu[tt] = *(const v2u*)(lds + S_OPU + (16 * dvt + fr) * 144 + (tt * 16 + 4 * fq) * 2);
    {
        bf16x8 af[4][4];
#pragma unroll
        for (int ks = 0; ks < 4; ++ks)
#pragma unroll
            for (int tt = 0; tt < 4; ++tt) af[ks][tt] = *(const bf16x8*)(lds + S_OPW + (tt * 16 + fr) * 272 + (ks * 32 + 8 * fq) * 2);
        SB();
#pragma unroll
        for (int tt = 0; tt < 4; ++tt) vt[tt] = (f32x4){bflo(uu[tt].x), bfhi(uu[tt].x), bflo(uu[tt].y), bfhi(uu[tt].y)};
#pragma unroll
        for (int ks = 0; ks < 4; ++ks)
#pragma unroll
            for (int tt = 0; tt < 4; ++tt) vt[tt] = __builtin_amdgcn_mfma_f32_16x16x32_bf16(af[ks][tt], sf[ks], vt[tt], 0, 0, 0);
        SB();
    }
#pragma unroll
    for (int tt = 0; tt < 4; ++tt) *(v2u*)(lds + S_VNT + (16 * w + fr) * 144 + (tt * 16 + 4 * fq) * 2) = (v2u){pk2(vt[tt][0], vt[tt][1]), pk2(vt[tt][2], vt[tt][3])};
    f32x4 ot[4];
#pragma unroll
    for (int nt = 0; nt < 4; ++nt) ot[nt] = (f32x4){0.f, 0.f, 0.f, 0.f};
    {
        bf16x8 bq[4][4];
#pragma unroll
        for (int ks = 0; ks < 4; ++ks)
#pragma unroll
            for (int nt = 0; nt < 4; ++nt) bq[ks][nt] = *(const bf16x8*)(lds + S_OPQG + (nt * 16 + fr) * 272 + (ks * 32 + 8 * fq) * 2);
        SB();
#pragma unroll
        for (int ks = 0; ks < 4; ++ks)
#pragma unroll
            for (int nt = 0; nt < 4; ++nt) ot[nt] = __builtin_amdgcn_mfma_f32_16x16x32_bf16(sf[ks], bq[ks][nt], ot[nt], 0, 0, 0);
        SB();
    }
    LDS_WAIT();
    bf16x8 vf[2];
#pragma unroll
    for (int js = 0; js < 2; ++js) vf[js] = *(const bf16x8*)(lds + S_VNT + (16 * w + fr) * 144 + (js * 32 + 8 * fq) * 2);
    {
        bf16x8 bk[2][4];
#pragma unroll
        for (int js = 0; js < 2; ++js)
#pragma unroll
            for (int nt = 0; nt < 4; ++nt) bk[js][nt] = *(const bf16x8*)(lds + S_OPQK + (nt * 16 + fr) * 144 + (js * 32 + 8 * fq) * 2);
        SB();
#pragma unroll
        for (int js = 0; js < 2; ++js)
#pragma unroll
            for (int nt = 0; nt < 4; ++nt) ot[nt] = __builtin_amdgcn_mfma_f32_16x16x32_bf16(vf[js], bk[js][nt], ot[nt], 0, 0, 0);
        SB();
    }
#pragma unroll
    for (int nt = 0; nt < 4; ++nt) *(v2u*)(orow + (size_t)(nt * 16 + fr) * D + 16 * dvt + 4 * fq) = (v2u){pk2(ot[nt][0], ot[nt][1]), pk2(ot[nt][2], ot[nt][3])};
    {
        bf16x8 ak[2][8];
#pragma unroll
        for (int js = 0; js < 2; ++js)
#pragma unroll
            for (int mt = 0; mt < 8; ++mt) ak[js][mt] = *(const bf16x8*)(lds + S_OPKD + (mt * 16 + fr) * 144 + (js * 32 + 8 * fq) * 2);
        SB();
#pragma unroll
        for (int mt = 0; mt < 8; ++mt) sacc[mt] = sacc[mt] * egl;
#pragma unroll
        for (int js = 0; js < 2; ++js)
#pragma unroll
            for (int mt = 0; mt < 8; ++mt) sacc[mt] = __builtin_amdgcn_mfma_f32_16x16x32_bf16(ak[js][mt], vf[js], sacc[mt], 0, 0, 0);
        SB();
    }
#pragma unroll
    for (int mt = 0; mt < 8; ++mt) *(v2u*)(lds + S_ST + (16 * w + fr) * 272 + (mt * 16 + 4 * fq) * 2) = (v2u){pk2(sacc[mt][0], sacc[mt][1]), pk2(sacc[mt][2], sacc[mt][3])};
#undef SB
    }
    LDS_WAIT();
}
__device__ __forceinline__ void scan_wg(KP P, int l, int id, unsigned char* lds, int tid) {
    const int bh = id >> 1, half = id & 1, b = bh >> 2, h = bh & 3;
    const int lane = tid & 63, w = __builtin_amdgcn_readfirstlane(tid >> 6), fr = lane & 15, fq = lane >> 4;
    unsigned char* scrbase = P->ws + WS_SCR;
    bf16* OCAT = (bf16*)(P->ws + WS_XA);
    f32x4 sacc[8];
#pragma unroll
    for (int mt = 0; mt < 8; ++mt) sacc[mt] = (f32x4){0.f, 0.f, 0.f, 0.f};
    { unsigned zz0 = 0u; asm volatile("" : "+v"(zz0)); if (w < 4) for (int q = lane; q < 272; q += 64) *(v4u*)(lds + S_ST + (16 * w) * 272 + q * 16) = (v4u){zz0, zz0, zz0, zz0}; }
    const int item0 = (b * 32) * 4 + h;
    const float glv = ((const float*)(P->ws + WS_GL))[item0 + 4 * (lane & 31)];
    v4u preA[9], preB[9];
    scan_load(preA, scrbase + (size_t)item0 * SCR_ITEM, tid, half);
    scan_load(preB, scrbase + (size_t)(item0 + 4) * SCR_ITEM, tid, half);
    bf16* orow = OCAT + (size_t)(b * SEQL) * D + h * 128;
#pragma unroll
    for (int n = 0; n < 32; n += 2) {
        scan_chunk(preA, sacc, lds, scrbase, orow + (size_t)(n * 64) * D, item0 + 4 * n, n, rdl(glv, n), tid, w, fr, fq, half);
        scan_chunk(preB, sacc, lds, scrbase, orow + (size_t)(n * 64 + 64) * D, item0 + 4 * n + 4, n + 1, rdl(glv, n + 1), tid, w, fr, fq, half);
    }
    if (w < 4) {
        const int lane2 = lane_id(), fr2 = lane2 & 15, fq2 = lane2 >> 4;
        float* pd = P->out + O_PDELTA + (size_t)((l * NBATCH + b) * 4 + h) * 16384;
#pragma unroll
        for (int mt = 0; mt < 8; ++mt)
#pragma unroll
            for (int r = 0; r < 4; ++r) pd[(mt * 16 + 4 * fq2 + r) * 128 + 16 * (half * 4 + w) + fr2] = sacc[mt][r];
    }
    __syncthreads();
}
__device__ __forceinline__ void p2d(KP P, int l, int gw, int ngw, int lane) {
    const bf16* PROJ = (const bf16*)(P->ws + WS_PROJ);
    bf16* OCAT = (bf16*)(P->ws + WS_XA);
    const float on0 = P->in[12][l * 128 + lane * 2], on1 = P->in[12][l * 128 + lane * 2 + 1];
    for (int pair0 = gw * 4; pair0 < MP * 4; pair0 += 4 * ngw) {
        float o0[4], o1[4]; unsigned zz[4];
#pragma unroll
        for (int q = 0; q < 4; ++q) {
            const int pair = pair0 + q;
            o0[q] = 0.f; o1[q] = 0.f; zz[q] = 0u;
            if (pair < MP * 4) {
                const int row = pair >> 2, h = pair & 3, b = row >> 11, t = row & 2047, n = t >> 6, tok = t & 63;
                const unsigned ow = *(const unsigned*)(OCAT + (size_t)row * D + h * 128 + lane * 2);
                o0[q] = bflo(ow); o1[q] = bfhi(ow);
                zz[q] = *(const unsigned*)(PROJ + (size_t)row * NPROJ + 1536 + h * 128 + lane * 2);
            }
        }
#pragma unroll
        for (int q = 0; q < 4; ++q) {
            const int pair = pair0 + q;
            const float rs = rsqrtf(wave_sum(o0[q] * o0[q] + o1[q] * o1[q]) * (1.f / 128.f) + EPS);
            if (pair < MP * 4) {
                const int row = pair >> 2, h = pair & 3;
                *(unsigned*)(OCAT + (size_t)row * D + h * 128 + lane * 2) = pk2(o0[q] * rs * on0 * siluf(bflo(zz[q])), o1[q] * rs * on1 * siluf(bfhi(zz[q])));
            }
        }
    }
}

__device__ __forceinline__ void sample_delta(KP P, int l, int it, unsigned char* lds, int wave_in) {
    const int tid = fresh_tid(wave_in);
    const int gq = tid >> 7, c = tid & 127, wv2 = (tid >> 6) & 1, lane = tid & 63;
    const int item = it * 4 + gq, sb = item >> 2, h = item & 3, rowbase = MP + sb * 8;
    float* QS = (float*)(lds + gq * 12288); float* KS = QS + 1024; float* VS = QS + 2048;
    float* RED2 = (float*)(lds + 49152);
    const bf16* PROJ = (const bf16*)(P->ws + WS_PROJ);
    const float* GB = (const float*)(P->ws + WS_GB);
    bf16* OCAT = (bf16*)(P->ws + WS_XA);
#pragma unroll
    for (int part = 0; part < 3; ++part) {
        const int col = part * 512 + h * 128 + c;
        const float* cw = P->in[9] + (size_t)(l * 4) * 1536 + col;
        const float w0 = cw[0], w1 = cw[1536], w2 = cw[2 * 1536], w3 = cw[3 * 1536];
        const float* hs = P->in[3] + (size_t)((l * DBATCH + sb) * 3) * 1536 + col;
        float r0 = hs[0], r1 = hs[1536], r2 = hs[2 * 1536];
        float* dst = QS + part * 1024 + c;
#pragma unroll
        for (int t = 0; t < 8; ++t) {
            const float x = bf1(PROJ[(size_t)(rowbase + t) * NPROJ + col]);
            dst[t * 128] = siluf(w0 * r0 + w1 * r1 + w2 * r2 + w3 * x);
            r0 = r1; r1 = r2; r2 = x;
        }
    }
#pragma unroll
    for (int t = 0; t < 8; ++t) {
        const float q = QS[t * 128 + c], k = KS[t * 128 + c];
        const float sq = wave_sum(q * q), sk = wave_sum(k * k);
        if (lane == 0) { RED2[(gq * 2 + wv2) * 16 + t] = sq; RED2[(gq * 2 + wv2) * 16 + 8 + t] = sk; }
    }
    __syncthreads();
#pragma unroll
    for (int t = 0; t < 8; ++t) {
        const float tq = RED2[(gq * 2) * 16 + t] + RED2[(gq * 2 + 1) * 16 + t], tk = RED2[(gq * 2) * 16 + 8 + t] + RED2[(gq * 2 + 1) * 16 + 8 + t];
        QS[t * 128 + c] *= rsqrtf(tq + EPS) * 0.08838834764831845f; KS[t * 128 + c] *= rsqrtf(tk + EPS);
    }
    __syncthreads();
    float s[128];
    {
        const float* S0 = P->in[2] + (size_t)((l * DBATCH + sb) * 4 + h) * 16384 + c;
#pragma unroll
        for (int d8 = 0; d8 < 16; ++d8) {
#pragma unroll
            for (int e = 0; e < 8; ++e) s[8 * d8 + e] = S0[e * 128];
            S0 += 8 * 128; asm volatile("" : "+v"(S0));
        }
    }
    float* GBS = RED2 + 128 + gq * 16;
    if (c < 8) { GBS[c] = __expf(GB[(size_t)(rowbase + c) * 8 + h]); GBS[8 + c] = GB[(size_t)(rowbase + c) * 8 + 4 + h]; }
    LDS_WAIT(); __syncthreads();
#pragma unroll 1
    for (int t = 0; t < 8; ++t) {
        const float eg = GBS[t], beta = GBS[8 + t];
        const f32x4* kp = (const f32x4*)(KS + t * 128); const f32x4* qp = (const f32x4*)(QS + t * 128);
        float dot = 0.f;
#pragma unroll
        for (int d4 = 0; d4 < 32; ++d4) { const f32x4 kv = kp[d4]; dot += kv[0] * s[4 * d4] + kv[1] * s[4 * d4 + 1] + kv[2] * s[4 * d4 + 2] + kv[3] * s[4 * d4 + 3];
            if ((d4 & 3) == 3) asm volatile("" ::: "memory"); }
        const float cf = beta * (VS[t * 128 + c] - eg * dot);
        float o = 0.f;
#pragma unroll
        for (int d4 = 0; d4 < 32; ++d4) { const f32x4 kv = kp[d4], qv = qp[d4];
#pragma unroll
            for (int e = 0; e < 4; ++e) { s[4 * d4 + e] = eg * s[4 * d4 + e] + cf * kv[e]; o += qv[e] * s[4 * d4 + e]; }
            if ((d4 & 3) == 3) asm volatile("" ::: "memory"); }
        VS[t * 128 + c] = o;
    }
    {
        float* sd = P->out + O_SDELTA + (size_t)((l * DBATCH + sb) * 4 + h) * 16384 + c;
#pragma unroll
        for (int d8 = 0; d8 < 16; ++d8) {
#pragma unroll
            for (int e = 0; e < 8; ++e) sd[e * 128] = s[8 * d8 + e];
            sd += 8 * 128; asm volatile("" : "+v"(sd));
        }
    }
    __syncthreads();
#pragma unroll
    for (int t = 0; t < 8; ++t) { const float o = VS[t * 128 + c]; const float so = wave_sum(o * o); if (lane == 0) RED2[(gq * 2 + wv2) * 16 + t] = so; }
    __syncthreads();
    const float onv = P->in[12][l * 128 + c];
#pragma unroll
    for (int t = 0; t < 8; ++t) {
        const float tot = RED2[(gq * 2) * 16 + t] + RED2[(gq * 2 + 1) * 16 + t];
        const float z = bf1(PROJ[(size_t)(rowbase + t) * NPROJ + 1536 + h * 128 + c]);
        OCAT[(size_t)(rowbase + t) * D + h * 128 + c] = (bf16)f2bf(VS[t * 128 + c] * rsqrtf(tot * (1.f / 128.f) + EPS) * onv * siluf(z));
    }
    __syncthreads();
}

constexpr int PL_DT = 0, PL_PW = 33792;
__device__ __forceinline__ void pool_tile(KP P, int l, int tile, unsigned char* lds, int wave_in) {
    const int tid = fresh_tid(wave_in);
    bf16* DT = (bf16*)(lds + PL_DT);
    const bf16* PROJ = (const bf16*)(P->ws + WS_PROJ);
    bf16* OCAT = (bf16*)(P->ws + WS_XA);
#pragma unroll 1
    for (int i = 0; i < 4; ++i) {
        const int idx = tid + 512 * i, tok = idx & 63, ch8 = idx >> 6, c0 = ch8 * 8, gi = ch8 >> 3, win = 2 << gi;
        int row, t, sb = 0; bool smp;
        if (tile < 256) { t = (tile & 31) * 64 + tok; row = (tile >> 5) * SEQL + t; smp = false; }
        else { sb = (tile - 256) * 8 + (tok >> 3); t = tok & 7; row = MP + sb * 8 + t; smp = true; }
        float ssum[8], cur[8];
#pragma unroll
        for (int e = 0; e < 8; ++e) { ssum[e] = 0.f; cur[e] = 0.f; }
        {
            v4u wv[16];
#pragma unroll
            for (int j = 0; j < 16; ++j) {
                wv[j] = (v4u){0u, 0u, 0u, 0u};
                if (j < win && t - j >= 0) wv[j] = *(const v4u*)(PROJ + (size_t)(row - j) * NPROJ + 2048 + c0);
            }
#pragma unroll
            for (int j = 0; j < 16; ++j) {
                float f[8]; UNPACK8(wv[j], f);
#pragma unroll
                for (int e = 0; e < 8; ++e) { ssum[e] += f[e]; if (j == 0) cur[e] = f[e]; }
            }
            if (smp) {
                for (int j = t + 1; j < win; ++j) { const float* sp = P->in[4] + (size_t)((l * DBATCH + sb) * 15 + 15 + t - j) * 256 + c0;
#pragma unroll
                    for (int e = 0; e < 8; ++e) ssum[e] += sp[e]; }
            }
        }
        const float inv = 1.f / (float)(smp ? win : (t + 1 < win ? t + 1 : win));
        { float dd[8];
#pragma unroll
            for (int e = 0; e < 8; ++e) dd[e] = ssum[e] * inv - cur[e];
            *(v4u*)(DT + tok * 264 + c0) = PACK8(dd); }
        float u0[8], u1[8], u2[8];
#pragma unroll
        for (int j = 0; j < 3; ++j) {
            const int tt = t - j; float f[8];
            if (tt >= 0) { const v4u wc = *(const v4u*)(PROJ + (size_t)(row - j) * NPROJ + 2816 + c0); const v4u wx = *(const v4u*)(PROJ + (size_t)(row - j) * NPROJ + 2304 + c0);
                float fc[8], fx[8]; UNPACK8(wc, fc); UNPACK8(wx, fx);
#pragma unroll
                for (int e = 0; e < 8; ++e) f[e] = fc[e] * fx[e]; }
            else if (smp) { const float* sp = P->in[5] + (size_t)((l * DBATCH + sb) * 2 + 2 + tt) * 256 + c0;
#pragma unroll
                for (int e = 0; e < 8; ++e) f[e] = sp[e]; }
            else {
#pragma unroll
                for (int e = 0; e < 8; ++e) f[e] = 0.f; }
#pragma unroll
            for (int e = 0; e < 8; ++e) { if (j == 0) u0[e] = f[e]; else if (j == 1) u1[e] = f[e]; else u2[e] = f[e]; }
        }
        const float* sw = P->in[15] + (size_t)(l * 3) * 256 + c0;
        const v4u wb = *(const v4u*)(PROJ + (size_t)row * NPROJ + 2560 + c0); float fb[8]; UNPACK8(wb, fb);
        float oc[8];
#pragma unroll
        for (int e = 0; e < 8; ++e) oc[e] = fb[e] * (sw[e] * u2[e] + sw[256 + e] * u1[e] + sw[512 + e] * u0[e]);
        *(v4u*)(OCAT + (size_t)row * D + 768 + c0) = PACK8(oc);
    }
    __syncthreads();
    {
        const int lane = tid & 63, wv = tid >> 6, fr = lane & 15, fq = lane >> 4, g = wv & 3, th = wv >> 2;
        bf16x8 df[2][2], pf[4][2];
#pragma unroll
        for (int tt = 0; tt < 2; ++tt)
#pragma unroll
            for (int ks = 0; ks < 2; ++ks) df[tt][ks] = *(const bf16x8*)(lds + PL_DT + ((th * 32 + tt * 16 + fr) * 264 + g * 64 + ks * 32 + 8 * fq) * 2);
#pragma unroll
        for (int et = 0; et < 4; ++et)
#pragma unroll
            for (int ks = 0; ks < 2; ++ks) pf[et][ks] = *(const bf16x8*)(lds + PL_PW + (((g * 64 + et * 16 + fr) * 72) + ks * 32 + 8 * fq) * 2);
#pragma unroll
        for (int tt = 0; tt < 2; ++tt) {
            const int tok = th * 32 + tt * 16 + fr;
            const int row = tile < 256 ? (tile >> 5) * SEQL + (tile & 31) * 64 + tok : MP + (tile - 256) * 64 + tok;
#pragma unroll
            for (int et = 0; et < 4; ++et) {
                f32x4 acc = (f32x4){0.f, 0.f, 0.f, 0.f};
#pragma unroll
                for (int ks = 0; ks < 2; ++ks) acc = __builtin_amdgcn_mfma_f32_16x16x32_bf16(pf[et][ks], df[tt][ks], acc, 0, 0, 0);
                const int ch = g * 64 + et * 16 + 4 * fq;
                const f32x4 sc = *(const f32x4*)(P->in[14] + l * 256 + ch);
                *(v2u*)(OCAT + (size_t)row * D + 512 + ch) = (v2u){pk2(acc[0] * sc[0], acc[1] * sc[1]), pk2(acc[2] * sc[2], acc[3] * sc[3])};
            }
        }
    }
    __syncthreads();
}

__device__ __forceinline__ void state_copies(KP P, int l, int start, int stride) {
    const bf16* PROJ = (const bf16*)(P->ws + WS_PROJ);
    for (int i = start; i < 136 * 1120; i += stride) {
        const int seq = i / 1120, r = (i % 1120) * 8;
        const bool smp = seq >= 8; const int sb = seq - 8;
        const int L = smp ? 8 : SEQL; const size_t row0 = smp ? (size_t)MP + sb * 8 : (size_t)seq * SEQL;
        float f[8]; float* o;
        if (r < 4608) {
            const int j = r / 1536, c = r % 1536;
            const v4u w = *(const v4u*)(PROJ + (row0 + L - 3 + j) * NPROJ + c); UNPACK8(w, f);
            o = smp ? P->out + O_SDCONV + (size_t)((l * DBATCH + sb) * 3 + j) * 1536 + c : P->out + O_PDCONV + (size_t)((l * NBATCH + seq) * 3 + j) * 1536 + c;
        } else if (r < 4608 + 3840) {
            const int r2 = r - 4608, j = r2 / 256, c = r2 % 256;
            if (smp) {
                if (j < 7) { const float* sp = P->in[4] + (size_t)((l * DBATCH + sb) * 15 + 8 + j) * 256 + c;
#pragma unroll
                    for (int e = 0; e < 8; ++e) f[e] = sp[e]; }
                else { const v4u w = *(const v4u*)(PROJ + (row0 + j - 7) * NPROJ + 2048 + c); UNPACK8(w, f); }
                o = P->out + O_SPOOL + (size_t)((l * DBATCH + sb) * 15 + j) * 256 + c;
            } else {
                const v4u w = *(const v4u*)(PROJ + (row0 + L - 15 + j) * NPROJ + 2048 + c); UNPACK8(w, f);
                o = P->out + O_PPOOL + (size_t)((l * NBATCH + seq) * 15 + j) * 256 + c;
            }
        } else {
            const int r2 = r - 8448, j = r2 / 256, c = r2 % 256;
            const size_t row = row0 + L - 2 + j;
            const v4u wc = *(const v4u*)(PROJ + row * NPROJ + 2816 + c); const v4u wx = *(const v4u*)(PROJ + row * NPROJ + 2304 + c);
            float fc[8], fx[8]; UNPACK8(wc, fc); UNPACK8(wx, fx);
#pragma unroll
            for (int e = 0; e < 8; ++e) f[e] = fc[e] * fx[e];
            o = smp ? P->out + O_SSCONV + (size_t)((l * DBATCH + sb) * 2 + j) * 256 + c : P->out + O_PSCONV + (size_t)((l * NBATCH + seq) * 2 + j) * 256 + c;
        }
        *(f32x4*)o = (f32x4){f[0], f[1], f[2], f[3]}; *(f32x4*)(o + 4) = (f32x4){f[4], f[5], f[6], f[7]};
    }
}

__device__ __forceinline__ void p4b(KP P, int l, int hf, int start, int stride) {
    bf16* GU = (bf16*)(P->ws + WS_GU); bf16* HALO = (bf16*)(P->ws + WS_HALO);
    const float* cw = P->in[19] + (size_t)(l * 3) * FF;
    const int r0 = hf * MH;
    for (int idx = start; idx < MH * 352; idx += stride) {
        const int lr = idx / 352, c0 = (idx % 352) * 8, m = r0 + lr;
        int t, sb = 0; bool smp;
        if (m < MP) { t = m & (SEQL - 1); smp = false; } else { sb = (m - MP) >> 3; t = (m - MP) & 7; smp = true; }
        float g0[8], g1[8], g2[8];
#pragma unroll
        for (int j = 0; j < 3; ++j) {
            const int tt = t - j; float f[8];
            if (tt < 0) {
                if (smp) { const float* sp = P->in[6] + (size_t)((l * DBATCH + sb) * 2 + 2 + tt) * FF + c0;
#pragma unroll
                    for (int e = 0; e < 8; ++e) f[e] = sp[e]; }
                else {
#pragma unroll
                    for (int e = 0; e < 8; ++e) f[e] = 0.f; }
            } else {
                const v4u w = (lr - j < 0) ? *(const v4u*)(HALO + (size_t)(2 + lr - j) * FF + c0) : *(const v4u*)(GU + (size_t)(lr - j) * NGU + c0);
                UNPACK8(w, f);
            }
#pragma unroll
            for (int e = 0; e < 8; ++e) { if (j == 0) g0[e] = f[e]; else if (j == 1) g1[e] = f[e]; else g2[e] = f[e]; }
        }
        const v4u wu = *(const v4u*)(GU + (size_t)lr * NGU + FF + c0); float fu[8]; UNPACK8(wu, fu);
        float a[8];
#pragma unroll
        for (int e = 0; e < 8; ++e) a[e] = siluf(cw[c0 + e] * g2[e] + cw[FF + c0 + e] * g1[e] + cw[2 * FF + c0 + e] * g0[e]) * fu[e];
        *(v4u*)(GU + (size_t)lr * NGU + FF + c0) = PACK8(a);
        if (!smp && t >= SEQL - 2) { float* o = P->out + O_PFFN + (size_t)((l * NBATCH + (m >> 11)) * 2 + t - (SEQL - 2)) * FF + c0;
#pragma unroll
            for (int e = 0; e < 8; ++e) o[e] = g0[e]; }
        if (smp && t >= 6) { float* o = P->out + O_SFFN + (size_t)((l * DBATCH + sb) * 2 + t - 6) * FF + c0;
#pragma unroll
            for (int e = 0; e < 8; ++e) o[e] = g0[e]; }
        if (hf == 0 && lr >= MH - 2) *(v4u*)(HALO + (size_t)(lr - (MH - 2)) * FF + c0) = *(const v4u*)(GU + (size_t)lr * NGU + c0);
    }
}

#define LAS __attribute__((address_space(3)))
#define XB_TMO      128
#define XB_XCNT(j)  (256  + 64 * (j))
#define XB_XSUB(j)  (1280 + 64 * (j))
#define XB_XGEN(j)  (2304 + 64 * (j))
#define XB_TOP      3328
#define XB_TOPGEN   3392
#define XCD_BAR_WORDS 3456
#define XB_SPIN_CAP (1u << 18)

__device__ __forceinline__ unsigned xb_ld(unsigned* p)              { return __hip_atomic_load(p, __ATOMIC_RELAXED, __HIP_MEMORY_SCOPE_AGENT); }
__device__ __forceinline__ unsigned xb_add(unsigned* p, unsigned v) { return __hip_atomic_fetch_add(p, v, __ATOMIC_RELAXED, __HIP_MEMORY_SCOPE_AGENT); }
__device__ __forceinline__ unsigned xb_xcc_id() { return (unsigned)__builtin_amdgcn_s_getreg((3 << 11) | 20) & 0xFu; }
#define XB_SPIN(cond, bar) do { unsigned _sp = 0; while (cond) { __builtin_amdgcn_s_sleep(1); \
    if ((++_sp & 255u) == 0u) { if (xb_ld(&(bar)[XB_TMO])) break; if (_sp > XB_SPIN_CAP) { atomicAdd(&(bar)[XB_TMO], 1u); break; } } } } while (0)

struct XcdBarrier {
    unsigned* bar; unsigned x;
    volatile LAS unsigned* st;
    int wave;
};

__device__ __forceinline__ XcdBarrier xcd_barrier_post(unsigned* bar, volatile LAS unsigned* st) {
    XcdBarrier b; b.bar = bar; b.x = xb_xcc_id(); b.st = st; b.wave = 0;
    if (threadIdx.x == 0) (void)xb_add(&bar[XB_XCNT(b.x)], 1u);
    return b;
}
__device__ __forceinline__ void xcd_barrier_complete(unsigned* bar, unsigned x, unsigned& nloc, unsigned& nx) {
    const unsigned G = gridDim.x * gridDim.y * gridDim.z;
    unsigned sum, cnt, mine, sp = 0u;
    for (;;) {
        sum = 0u; cnt = 0u; mine = 0u;
#pragma unroll
        for (unsigned j = 0; j < 16; ++j) { const unsigned c = xb_ld(&bar[XB_XCNT(j)]); sum += c; cnt += (c > 0u) ? 1u : 0u; mine = (j == x) ? c : mine; }
        if (sum == G) break;
        __builtin_amdgcn_s_sleep(1);
        if ((++sp & 255u) == 0u) { if (xb_ld(&bar[XB_TMO])) break; if (sp > XB_SPIN_CAP) { atomicAdd(&bar[XB_TMO], 1u); break; } }
    }
    nloc = mine > 0u ? mine : 1u; nx = cnt > 0u ? cnt : 1u;
}

__device__ __forceinline__ void xcd_barrier(const XcdBarrier& b) {
    asm volatile("s_waitcnt vmcnt(0)" ::: "memory");
    __syncthreads();
    if (b.wave == 0 && lane_id() == 0) {
        unsigned* bar = b.bar;
        __builtin_amdgcn_s_waitcnt(0);
        unsigned nloc = b.st[0], nx = b.st[1];
        if (nloc == 0u) { xcd_barrier_complete(bar, b.x, nloc, nx); b.st[0] = nloc; b.st[1] = nx; }
        const unsigned old = xb_add(&bar[XB_XSUB(b.x)], 1u);
        const unsigned gen = old / nloc;
        if (old + 1u == (gen + 1u) * nloc) {
            __builtin_amdgcn_fence(__ATOMIC_RELEASE, "agent");
            asm volatile("s_waitcnt vmcnt(0)" ::: "memory");
            const unsigned og = xb_add(&bar[XB_TOP], 1u);
            const unsigned tg = og / nx;
            if (og + 1u == (tg + 1u) * nx) xb_add(&bar[XB_TOPGEN], 1u);
            else XB_SPIN(xb_ld(&bar[XB_TOPGEN]) == tg, bar);
            __builtin_amdgcn_fence(__ATOMIC_ACQUIRE, "agent");
            xb_add(&bar[XB_XGEN(b.x)], 1u);
            asm volatile("s_waitcnt vmcnt(0)" ::: "memory");
        } else {
            XB_SPIN(xb_ld(&bar[XB_XGEN(b.x)]) == gen, bar);
            __builtin_amdgcn_fence(__ATOMIC_ACQUIRE, "agent");
            asm volatile("s_waitcnt vmcnt(0)" ::: "memory");
        }
    }
    __syncthreads();
}

#define XSYNC1() do { XcdBarrier b_; b_.bar = (unsigned*)(kparams()->ws + WS_BAR); b_.x = xb_xcc_id(); b_.st = (volatile LAS unsigned*)((LAS unsigned char*)lds + (LDS_BYTES - 64)); b_.wave = wave; xcd_barrier(b_); } while (0)
#ifdef PROBE_SYNC2
#define GSYNC() do { XSYNC1(); XSYNC1(); } while (0)
#else
#define GSYNC() XSYNC1()
#endif
__global__ void __launch_bounds__(NTHREADS, 2) fwd_megakernel(Params Parg) {
    KP P = kparams();
    extern __shared__ __attribute__((aligned(16))) unsigned char lds[];
    cg::grid_group grid = cg::this_grid();
    const int wave = __builtin_amdgcn_readfirstlane((int)threadIdx.x >> 6);
    const int tid = fresh_tid(wave), lane = tid & 63;
    const int G = gridDim.x, bx = blockIdx.x;
    const int gw = bx * NWAVES + wave, ngw = G * NWAVES;
    const int gt = bx * NTHREADS + tid, ngt = G * NTHREADS;
    unsigned char* ws = P->ws;
    bf16* XA = (bf16*)(ws + WS_XA); bf16* XB2 = (bf16*)(ws + WS_PROJ); bf16* PROJ = (bf16*)(ws + WS_PROJ); bf16* GU = (bf16*)(ws + WS_GU);
    float* SSQ = (float*)(ws + WS_SSQ); float* GB = (float*)(ws + WS_GB); float* WAB = (float*)(ws + WS_WAB);
    float* XRES = P->out;
    float* wscr = (float*)(lds + wave * 16384);
    volatile LAS unsigned* xst = (volatile LAS unsigned*)((LAS unsigned char*)lds + (LDS_BYTES - 64));
    if (tid < 16) xst[tid] = 0u;
    __syncthreads();
    (void)xcd_barrier_post((unsigned*)(ws + WS_BAR), xst);

    for (int i = gt; i < 4 * M; i += ngt) SSQ[M + i] = 0.f;
    for (int i = gt; i < MS * D / 4; i += ngt) ((f32x4*)(XRES + (size_t)MP * D))[i] = ((const f32x4*)P->in[1])[i];
    for (int i = gt; i < 2 * 8 * D; i += ngt) { const int l = i >> 13, j = (i >> 10) & 7, k = i & 1023; WAB[i] = P->in[7][l * D + k] * P->in[8][(size_t)l * D * DIN + (size_t)k * DIN + 2048 + j]; }
    convert_win(P, 0, wscr, gw, ngw, lane);
    convert_layer_rest(P, 0, wscr, gw, ngw, lane);
    convert_layer_rest(P, 1, wscr, gw, ngw, lane);
    for (int m0 = gw; m0 < M; m0 += 2 * ngw) {
        f32x4 v[2][4];
#pragma unroll
        for (int q = 0; q < 2; ++q) { const int m = m0 + q * ngw;
            const float* xr = m < MP ? P->in[0] + (size_t)m * D : P->in[1] + (size_t)((m < M ? m : M - 1) - MP) * D;
#pragma unroll
            for (int j = 0; j < 4; ++j) v[q][j] = ((const f32x4*)xr)[lane + 64 * j]; }
#pragma unroll
        for (int q = 0; q < 2; ++q) { const int m = m0 + q * ngw;
            if (m < M) {
                float ss = 0.f;
#pragma unroll
                for (int j = 0; j < 4; ++j) { const f32x4 w4 = v[q][j]; ss += w4[0] * w4[0] + w4[1] * w4[1] + w4[2] * w4[2] + w4[3] * w4[3];
                    ((v2u*)(XA + (size_t)m * D))[lane + 64 * j] = (v2u){pk2(w4[0], w4[1]), pk2(w4[2], w4[3])}; }
                ss = wave_sum(ss);
                if (lane == 0) SSQ[m] = ss;
            } }
    }
    if (ws == nullptr) grid.sync();
    GSYNC();

#pragma unroll 1
    for (int l = 0; l < 2; ++l) {
#ifndef NO_P1
        {
            const bf16* gA = XA; const bf16* gB = (const bf16*)(ws + WS_WIN); LAUNDER(gA); LAUNDER(gB);
            pg8::Gemm g{gA, gB, M, NPROJ, D, D, D}; pg8::StaticOrder S; S.init(M, NPROJ, G, bx);
            EpiScale E{PROJ, NPROJ, SSQ + (size_t)(2 * l) * M};
            pg8::gemm_phase<EpiScale, pg8::StaticOrder, true, true>((PG8_LAS unsigned char*)lds, g, S, E, wave);
#ifdef PROBE_P1X2
            __syncthreads();
            pg8::gemm_phase<EpiScale, pg8::StaticOrder, true, true>((PG8_LAS unsigned char*)lds, g, S, E, wave);
#endif
        }
#endif
#ifndef NO_AB
        {
            const float* ssq = SSQ + (size_t)(2 * l) * M;
            const int nab = (G > 96 ? G - 48 : G), bab = (G > 96 ? bx - 48 : bx);
            const int tf = fresh_tid(wave), lane = tf & 63, gw = bab * NWAVES + __builtin_amdgcn_readfirstlane(tf >> 6), ngw = nab * NWAVES;
            if (bab >= 0)
            for (int m0 = gw; m0 < M; m0 += 2 * ngw) {
                v4u xq[2][2]; float sqv[2];
#pragma unroll
                for (int q = 0; q < 2; ++q) { const int m = (m0 + q * ngw) < M ? (m0 + q * ngw) : (M - 1);
                    const v4u* xr = (const v4u*)(XA + (size_t)m * D) + lane * 2; xq[q][0] = xr[0]; xq[q][1] = xr[1]; sqv[q] = ssq[m]; }
#pragma unroll
                for (int q = 0; q < 2; ++q) {
                    const int m = m0 + q * ngw;
                    float xf[16]; UNPACK8(xq[q][0], xf); UNPACK8(xq[q][1], xf + 8);
                    float dot[8];
#pragma unroll
                    for (int j = 0; j < 8; ++j) { const float* wp = WAB + (size_t)(l * 8 + j) * D + lane * 16; float s2 = 0.f;
#pragma unroll
                        for (int e = 0; e < 16; ++e) s2 += wp[e] * xf[e];
                        dot[j] = wave_sum(s2); }
                    float v = dot[0];
#pragma unroll
                    for (int j = 1; j < 8; ++j) v = (lane == j) ? dot[j] : v;
                    if (lane < 8 && m < M) {
                        v *= rsqrtf(sqv[q] * (1.f / D) + EPS);
                        const int hh = lane & 3; float r;
                        if (lane < 4) { const float xx = v + P->in[11][l * 4 + hh]; const float sp = fmaxf(xx, 0.f) + __logf(1.f + __expf(-fabsf(xx))); r = -__expf(P->in[10][l * 4 + hh]) * sp; }
                        else r = __builtin_amdgcn_rcpf(1.f + __expf(-v));
                        GB[(size_t)m * 8 + lane] = r;
                    }
                }
            }
        }
#endif
        GSYNC();
#ifndef NO_P2B
        { const int tf = fresh_tid(wave); for (int item = bx; item < 1024; item += G) p2b_item(P, l, item, lds, wave); }
#ifdef PROBE_P2B2
        __syncthreads(); { const int tf = fresh_tid(wave); for (int item = bx; item < 1024; item += G) p2b_item(P, l, item, lds, wave); }
#endif
#endif
        GSYNC();
#ifdef PROBE_SCAN2
        if (bx < 64) { scan_wg(P, l, bx, lds, fresh_tid(wave)); }
#endif
#ifndef NO_SCAN
        if (bx < 64) scan_wg(P, l, bx, lds, fresh_tid(wave));
#endif
        {
            unsigned* qctr = (unsigned*)(ws + WS_BAR) + 3600 + l;
            volatile unsigned* qslot = (volatile unsigned*)(lds + LDS_BYTES - 128);
            bool have_pw = false;
            for (;;) {
                const int tid = fresh_tid(wave);
                __syncthreads();
                if (tid == 0) *qslot = atomicAdd(qctr, 1u);
                __syncthreads();
                const int it = (int)*qslot;
                if (it >= 128 + 272 + 64) break;
                if (it < 128) { sample_delta(P, l, it, lds, wave); have_pw = false; }
                else if (it < 400) {
                    if (!have_pw) {
                        for (int i = tid; i < 16384; i += NTHREADS) { const int e = i & 63, c = (i >> 6) & 63, g = i >> 12; ((bf16*)(lds + PL_PW))[(g * 64 + e) * 72 + c] = (bf16)f2bf(P->in[13][(size_t)l * 16384 + i]); }
                        __syncthreads(); have_pw = true;
                    }
                    pool_tile(P, l, it - 128, lds, wave);
                } else state_copies(P, l, (it - 400) * NTHREADS + tid, 64 * NTHREADS);
            }
        }
        GSYNC();
        {
            const bf16* gB = (const bf16*)(ws + WS_WOUT) + (size_t)l * D * D;
            const int ks = bx >> 4; const bf16* gA2 = XA + (size_t)MP * D + ks * 256; const bf16* gB2 = gB + ks * 256; LAUNDER(gA2); LAUNDER(gB2);
            pg8::Gemm g2{gA2, gB2, MS, D, 256, D, D}; SplitOrder S2{bx < 64 ? (bx & 15) : -1};
            EpiAtomic E2{(float*)(ws + WS_SCR) + (size_t)ks * MS * D};
            pg8::gemm_phase<EpiAtomic, SplitOrder, true, true>((PG8_LAS unsigned char*)lds, g2, S2, E2, wave);
        }
        { const int tf = fresh_tid(wave); p2d(P, l, bx * NWAVES + __builtin_amdgcn_readfirstlane(tf >> 6), ngw, tf & 63); }
        GSYNC();
#ifdef PROBE_P2D2
        { const int tf = fresh_tid(wave); p2d(P, l, bx * NWAVES + __builtin_amdgcn_readfirstlane(tf >> 6), ngw, tf & 63); }
        GSYNC();
        { const int tf = fresh_tid(wave); p2d(P, l, bx * NWAVES + __builtin_amdgcn_readfirstlane(tf >> 6), ngw, tf & 63); }
        GSYNC();
        { const int tf = fresh_tid(wave); p2d(P, l, bx * NWAVES + __builtin_amdgcn_readfirstlane(tf >> 6), ngw, tf & 63); }
        GSYNC();
#endif
        fin_sample(XRES + (size_t)MP * D, XB2 + (size_t)MP * D, SSQ + (size_t)(2 * l + 1) * M + MP, (const float*)(ws + WS_SCR), 4, nullptr, 0, bx * NWAVES + wave, ngw, lane_id());
        {
            const bf16* gA = XA; const bf16* gB = (const bf16*)(ws + WS_WOUT) + (size_t)l * D * D; LAUNDER(gA); LAUNDER(gB);
            pg8::Gemm g{gA, gB, MP, D, D, D, D}; pg8::StaticOrder S; S.init(MP, D, G, bx);
            EpiResid E{l == 0 ? P->in[0] : XRES, l == 0 ? P->in[1] : XRES + (size_t)MP * D, XRES, XB2, SSQ + (size_t)(2 * l + 1) * M, 0};
            pg8::gemm_phase<EpiResid, pg8::StaticOrder, true, true>((PG8_LAS unsigned char*)lds, g, S, E, wave);
        }
        GSYNC();
        {
            const bf16* gA = XB2; const bf16* gB = (const bf16*)(ws + WS_WGU) + (size_t)l * NGU * D; LAUNDER(gA); LAUNDER(gB);
            pg8::Gemm g{gA, gB, M, NGU, D, D, D}; pg8::StaticOrder S; S.init(M, NGU, G, bx);
            EpiGateUp E{GU, SSQ + (size_t)(2 * l + 1) * M, P->in[19] + (size_t)(l * 3) * FF, P->in[6] + (size_t)l * DBATCH * 2 * FF, (float*)(ws + WS_HAL), (float*)(ws + WS_FIXG), (float*)(ws + WS_FIXU),
                        P->out + O_PFFN + (size_t)l * NBATCH * 2 * FF, P->out + O_SFFN + (size_t)l * DBATCH * 2 * FF, lds};
            pg8::gemm_phase<EpiGateUp, pg8::StaticOrder, true, true>((PG8_LAS unsigned char*)lds, g, S, E, wave);
#ifdef PROBE_P4X2
            __syncthreads();
            pg8::gemm_phase<EpiGateUp, pg8::StaticOrder, true, true>((PG8_LAS unsigned char*)lds, g, S, E, wave);
#endif
        }
        GSYNC();
        p4_fixup(P, l, bx * NTHREADS + fresh_tid(wave), ngt);
        if (l == 0) { const int tf = fresh_tid(wave); convert_win(P, 1, (float*)(lds + wave * 16384), bx * NWAVES + wave, ngw, tf & 63); }
        GSYNC();
        {
            const bf16* gA = GU; const bf16* gB = (const bf16*)(ws + WS_WDN) + (size_t)l * D * FF; LAUNDER(gA); LAUNDER(gB);
            pg8::Gemm g{gA, gB, MP, D, FF, FF, FF}; pg8::StaticOrder S; S.init(MP, D, G, bx);
            EpiResid E{XRES, XRES + (size_t)MP * D, XRES, XA, SSQ + (size_t)(2 * l + 2) * M, 0};
            pg8::gemm_phase<EpiResid, pg8::StaticOrder, true, true>((PG8_LAS unsigned char*)lds, g, S, E, wave);
            const int ks = bx >> 4; const bf16* gA2 = GU + (size_t)MP * FF + ks * 256; const bf16* gB2 = gB + ks * 256; LAUNDER(gA2); LAUNDER(gB2);
            pg8::Gemm g2{gA2, gB2, MS, D, 256, FF, FF}; SplitOrder S2{bx < 176 ? (bx & 15) : -1};
            EpiAtomic E2{ks < 8 ? (float*)(ws + WS_PROJ) + (size_t)ks * MS * D : (float*)(ws + WS_PART2) + (size_t)(ks - 8) * MS * D};
            pg8::gemm_phase<EpiAtomic, SplitOrder, true, true>((PG8_LAS unsigned char*)lds, g2, S2, E2, wave);
        }
        GSYNC();
        fin_sample(XRES + (size_t)MP * D, XA + (size_t)MP * D, SSQ + (size_t)(2 * l + 2) * M + MP, (const float*)(ws + WS_PROJ), 8, (const float*)(ws + WS_PART2), 3, bx * NWAVES + wave, ngw, lane_id());
        GSYNC();
    }
    {
        const float* ssq = SSQ + (size_t)4 * M; const float* fn = P->in[22];
        const int gt = bx * NTHREADS + fresh_tid(wave);
        for (int i0 = gt; i0 < M * 256; i0 += 4 * ngt) {
            f32x4 v[4]; float sq[4];
#pragma unroll
            for (int q = 0; q < 4; ++q) { const int i = i0 + q * ngt; v[q] = (f32x4){0.f, 0.f, 0.f, 0.f}; sq[q] = 1.f;
                if (i < M * 256) { v[q] = ((const f32x4*)XRES)[i]; sq[q] = ssq[i >> 8]; } }
#pragma unroll
            for (int q = 0; q < 4; ++q) { const int i = i0 + q * ngt;
                if (i < M * 256) { const float rs = rsqrtf(sq[q] * (1.f / D) + EPS); const f32x4 gv = ((const f32x4*)fn)[i & 255];
                    f32x4 o = v[q]; o[0] *= rs * gv[0]; o[1] *= rs * gv[1]; o[2] *= rs * gv[2]; o[3] *= rs * gv[3];
                    ((f32x4*)XRES)[i] = o; } }
        }
    }
}

extern "C" void kernel_launch(void* const* d_in, const int* in_sizes, int n_in, void* d_out, int out_size, void* d_ws, size_t ws_size, hipStream_t stream) {
    static int grid = 0;
    if (grid == 0) {
        if (n_in != 23 || (size_t)out_size != O_TOTAL || ws_size < WS_END) { fprintf(stderr, "kernel_launch: unexpected shapes: n_in %d out %d ws %zu\n", n_in, out_size, ws_size); grid = -1; return; }
        int dev = 0, cus = 0, per_cu = 0;
        hipGetDevice(&dev); hipDeviceGetAttribute(&cus, hipDeviceAttributeMultiprocessorCount, dev);
        if (hipFuncSetAttribute((const void*)fwd_megakernel, hipFuncAttributeMaxDynamicSharedMemorySize, LDS_BYTES) != hipSuccess) { fprintf(stderr, "kernel_launch: hipFuncSetAttribute failed\n"); grid = -1; return; }
        hipOccupancyMaxActiveBlocksPerMultiprocessor(&per_cu, (const void*)fwd_megakernel, NTHREADS, LDS_BYTES);
        (void)hipGetLastError();
        if (per_cu < 1) fprintf(stderr, "kernel_launch: occupancy query reports %d blocks per CU\n", per_cu);
        grid = cus;
    }
    if (grid < 0) return;
    if (hipMemsetAsync((char*)d_ws + WS_BAR, 0, 16384, stream) != hipSuccess) { fprintf(stderr, "kernel_launch: memset failed\n"); return; }
    Params p{};
    for (int i = 0; i < 23; ++i) p.in[i] = (const float*)d_in[i];
    p.out = (float*)d_out; p.ws = (unsigned char*)d_ws;
    void* args[] = {&p};
    hipError_t e = hipLaunchCooperativeKernel((const void*)fwd_megakernel, dim3(grid), dim3(NTHREADS), args, LDS_BYTES, stream);
    if (e != hipSuccess) fprintf(stderr, "cooperative launch failed: %s (grid %d)\n", hipGetErrorString(e), grid);
}
```

```cpp
#include <hip/hip_runtime.h>
#include <hip/hip_cooperative_groups.h>
#include <cstdio>
#include <cstdint>
namespace cg = cooperative_groups;
__device__ __forceinline__ int lane_id() { int t; asm volatile("v_mbcnt_lo_u32_b32 %0, -1, 0\n\tv_mbcnt_hi_u32_b32 %0, -1, %0" : "=v"(t)); return t; }
__device__ __forceinline__ int fresh_tid(int wave) { return (wave << 6) | lane_id(); }
namespace pg8 {
#define PG8_LAS __attribute__((address_space(3)))
typedef unsigned short bf16_t;
typedef short bf16x8 __attribute__((ext_vector_type(8)));
typedef float f32x4 __attribute__((ext_vector_type(4)));
typedef unsigned u32x4 __attribute__((ext_vector_type(4)));
constexpr int BM = 256, BK = 64, HALF = 128, HTB = HALF * BK * 2  , STAGE_BYTES = 8 * HTB, NXCD = 8, WGM = 8;

__host__ __device__ __forceinline__ int lds_byte(int r, int c) { const int st = (r >> 4) * 2 + (c >> 5), rr = r & 15, cc = c & 31, ob = rr * 64 + cc * 2; return st * 1024 + (ob ^ (((ob >> 9) & 1) << 5)); }
__host__ __device__ __forceinline__ void stage_rc(int b, int& R, int& C) { const int st = b / 1024, sb = b % 1024, swz = sb ^ (((sb >> 9) & 1) << 5); R = (st >> 1) * 16 + swz / 64; C = (st & 1) * 32 + (swz % 64) / 2; }
__host__ __device__ __forceinline__ int perm32(int rho) { const int n = rho >> 4, i = rho & 15; return 8 * (i >> 2) + 4 * n + (i & 3); }

struct Unit { int pm, pn; };
struct Gemm { const bf16_t* A; const bf16_t* Bt; int M, N, K, lda, ldb; };

struct StaticOrder {
    int nM, nN, nwg, G, c;
    __host__ __device__ void init(int M, int N, int G_, int c_) { nM = M / BM; nN = N / BM; nwg = nM * nN; G = G_; c = c_; }
    __host__ __device__ bool next(int i, Unit& u) const {
        const long L = (long)i * G + c; if (L >= nwg) return false;
        int wgid = (int)L; { const int q = nwg / NXCD, r = nwg % NXCD, xcd = wgid % NXCD, off = wgid / NXCD; wgid = (xcd < r ? xcd * (q + 1) : r * (q + 1) + (xcd - r) * q) + off; }
        const int nig = WGM * nN, gid = wgid / nig, fm = gid * WGM, gsz = (nM - fm) < WGM ? (nM - fm) : WGM;
        u.pm = fm + ((wgid % nig) % gsz); u.pn = (wgid % nig) / gsz; return true;
    }
    __device__ __forceinline__ void a_ready(const Unit&) const {}
    __device__ __forceinline__ void done(const Unit&) const {}
};

template <class Epi, class Sched, bool ALIGN_EPI = false, bool SP2 = false>
__device__ __forceinline__ void gemm_phase(PG8_LAS unsigned char* lds, const Gemm g, const Sched& S, const Epi& E, const int wave_in) {
    const int tid = fresh_tid(wave_in), wid = __builtin_amdgcn_readfirstlane(tid >> 6), lane = tid & 63, wr = wid >> 2, wc = wid & 3, fr = lane & 15, fq = lane >> 4;
    const int K = g.K, nt = K / BK;
    unsigned voffA[2], voffB[2];
#pragma unroll
    for (int i = 0; i < 2; ++i) { int R, C; stage_rc(tid * 16 + i * 8192, R, C); const int Rb = Epi::PERM ? ((R & ~31) + perm32(R & 31)) : R;
        voffA[i] = (unsigned)(R * g.lda + C) * 2u; voffB[i] = (unsigned)(Rb * g.ldb + C) * 2u; }
    const size_t kstep = (size_t)(BK * 2);
    const size_t hstepA = (size_t)HALF * g.lda * 2, hstepB = (size_t)HALF * g.ldb * 2;
    const size_t tstepA = 2 * hstepA, tstepB = 2 * hstepB;
    const unsigned ldsw = (unsigned)wid * 1024u;
    const int aoff = lds_byte(wr * 64 + fr, fq * 8), boff = lds_byte(wc * 32 + fr, fq * 8);
#define PG8_SA(b, h) (((b) * 2 + (h)) * HTB)
#define PG8_SB(b, h) ((4 + (b) * 2 + (h)) * HTB)
#define PG8_STAGE(bufoff, gbase, voff) do { _Pragma("unroll") for (int _i = 0; _i < 2; ++_i) \
        __builtin_amdgcn_global_load_lds((const unsigned*)((const char*)(gbase) + (voff)[_i]), (PG8_LAS unsigned*)(lds + (bufoff) + ldsw + _i * 8192), 16, 0, 0); } while (0)
#define PG8_LDA(dst, b, h) do { _Pragma("unroll") for (int m = 0; m < 4; ++m) _Pragma("unroll") for (int k = 0; k < 2; ++k) dst[m][k] = *(const PG8_LAS bf16x8*)(lds + PG8_SA(b, h) + aoff + m * 2048 + k * 1024); } while (0)
#define PG8_LDB(dst, b, h) do { _Pragma("unroll") for (int n = 0; n < 2; ++n) _Pragma("unroll") for (int k = 0; k < 2; ++k) dst[n][k] = *(const PG8_LAS bf16x8*)(lds + PG8_SB(b, h) + boff + n * 2048 + k * 1024); } while (0)
#define PG8_MMA(ai, bj, At, Bt) do { __builtin_amdgcn_s_setprio(1); _Pragma("unroll") for (int m = 0; m < 4; ++m) _Pragma("unroll") for (int n = 0; n < 2; ++n) _Pragma("unroll") for (int k = 0; k < 2; ++k) \
        acc[ai][bj][m][n] = __builtin_amdgcn_mfma_f32_16x16x32_bf16(Bt[n][k], At[m][k], acc[ai][bj][m][n], 0, 0, 0); __builtin_amdgcn_s_setprio(0); } while (0)
#define PG8_WAIT_V(n) asm volatile("s_waitcnt vmcnt(" #n ")" ::: "memory")
#define PG8_WAIT_L(n) asm volatile("s_waitcnt lgkmcnt(" #n ")" ::: "memory")
#define PG8_BAR __builtin_amdgcn_s_barrier()
#define PG8_SCHED __builtin_amdgcn_sched_barrier(0)
    Unit cur, nxt; int ui = 0;
    if (!S.next(0, cur)) return;
    f32x4 acc[2][2][4][2];
#pragma unroll
    for (int a = 0; a < 2; ++a)
#pragma unroll
        for (int b = 0; b < 2; ++b)
#pragma unroll
            for (int m = 0; m < 4; ++m)
#pragma unroll
                for (int n = 0; n < 2; ++n) acc[a][b][m][n] = (f32x4){0.f, 0.f, 0.f, 0.f};
    bf16x8 At[4][2], B0[2][2], B1[2][2];
    const char* cA = (const char*)g.A + (size_t)cur.pm * tstepA; const char* cB = (const char*)g.Bt + (size_t)cur.pn * tstepB;
    S.a_ready(cur);
    if constexpr (SP2) {
        PG8_STAGE(PG8_SB(0, 0), cB, voffB); PG8_STAGE(PG8_SB(0, 1), cB + hstepB, voffB); PG8_STAGE(PG8_SA(0, 0), cA, voffA); PG8_STAGE(PG8_SA(0, 1), cA + hstepA, voffA);
        if (wr == 1) PG8_BAR;
        PG8_WAIT_V(2); PG8_BAR;
        PG8_STAGE(PG8_SB(1, 0), cB + kstep, voffB); PG8_STAGE(PG8_SA(1, 0), cA + kstep, voffA); PG8_STAGE(PG8_SB(1, 1), cB + hstepB + kstep, voffB);
        PG8_WAIT_V(6); PG8_BAR;
    } else {
        PG8_STAGE(PG8_SB(0, 0), cB, voffB); PG8_STAGE(PG8_SA(0, 0), cA, voffA); PG8_STAGE(PG8_SB(0, 1), cB + hstepB, voffB); PG8_STAGE(PG8_SA(0, 1), cA + hstepA, voffA);
        if (wr == 1) PG8_BAR;
        PG8_WAIT_V(4); PG8_BAR;
        PG8_STAGE(PG8_SB(1, 0), cB + kstep, voffB); PG8_STAGE(PG8_SA(1, 0), cA + kstep, voffA); PG8_STAGE(PG8_SB(1, 1), cB + hstepB + kstep, voffB);
        PG8_WAIT_V(6); PG8_BAR;
    }
    for (;;) {
        const bool has_next = S.next(ui + 1, nxt);
        const char* nA = has_next ? (const char*)g.A + (size_t)nxt.pm * tstepA : cA; const char* nB = has_next ? (const char*)g.Bt + (size_t)nxt.pn * tstepB : cB;
        for (int t = 0; t < nt; t += 2) {
            const bool last = (t == nt - 2);
            const char* a1 = cA + (size_t)(t + 1) * kstep;
            const char* a2 = last ? nA : cA + (size_t)(t + 2) * kstep; const char* b2 = last ? nB : cB + (size_t)(t + 2) * kstep;
            const char* a3 = a2 + kstep; const char* b3 = b2 + kstep;
            if (last && has_next) S.a_ready(nxt);
            if constexpr (SP2) {
            PG8_LDB(B0, 0, 0); PG8_LDB(B1, 0, 1); PG8_SCHED; PG8_LDA(At, 0, 0); PG8_STAGE(PG8_SA(1, 1), a1 + hstepA, voffA);
            PG8_WAIT_V(8); PG8_WAIT_L(0); PG8_BAR; PG8_MMA(0, 0, At, B0); PG8_MMA(0, 1, At, B1); PG8_BAR; PG8_SCHED;
            PG8_LDA(At, 0, 1); PG8_STAGE(PG8_SB(0, 0), b2, voffB); PG8_STAGE(PG8_SB(0, 1), b2 + hstepB, voffB); PG8_STAGE(PG8_SA(0, 0), a2, voffA);
            PG8_WAIT_V(8); PG8_WAIT_L(0); PG8_BAR; PG8_MMA(1, 0, At, B0); PG8_MMA(1, 1, At, B1); PG8_BAR; PG8_SCHED;
            PG8_LDB(B0, 1, 0); PG8_LDB(B1, 1, 1); PG8_SCHED; PG8_LDA(At, 1, 0); PG8_STAGE(PG8_SA(0, 1), a2 + hstepA, voffA);
            PG8_WAIT_V(8); PG8_WAIT_L(0); PG8_BAR; PG8_MMA(0, 0, At, B0); PG8_MMA(0, 1, At, B1); PG8_BAR; PG8_SCHED;
            PG8_LDA(At, 1, 1); PG8_STAGE(PG8_SB(1, 0), b3, voffB); PG8_STAGE(PG8_SB(1, 1), b3 + hstepB, voffB); PG8_STAGE(PG8_SA(1, 0), a3, voffA);
            PG8_WAIT_V(8); PG8_WAIT_L(0); PG8_BAR; PG8_MMA(1, 0, At, B0); PG8_MMA(1, 1, At, B1); PG8_BAR; PG8_SCHED;
            } else {
            PG8_LDB(B0, 0, 0); PG8_SCHED; PG8_LDA(At, 0, 0); PG8_STAGE(PG8_SA(1, 1), a1 + hstepA, voffA);
            PG8_WAIT_L(8); PG8_BAR; PG8_WAIT_L(0); PG8_MMA(0, 0, At, B0); PG8_BAR; PG8_SCHED;
            PG8_LDB(B1, 0, 1); PG8_STAGE(PG8_SB(0, 0), b2, voffB);
            PG8_BAR; PG8_WAIT_L(0); PG8_MMA(0, 1, At, B1); PG8_BAR;
            PG8_LDA(At, 0, 1); PG8_STAGE(PG8_SA(0, 0), a2, voffA);
            PG8_BAR; PG8_WAIT_L(0); PG8_MMA(1, 0, At, B0); PG8_BAR; PG8_SCHED;
            PG8_STAGE(PG8_SB(0, 1), b2 + hstepB, voffB);
            PG8_WAIT_V(6); PG8_BAR; PG8_MMA(1, 1, At, B1); PG8_BAR;
            PG8_LDB(B0, 1, 0); PG8_SCHED; PG8_LDA(At, 1, 0); PG8_STAGE(PG8_SA(0, 1), a2 + hstepA, voffA);
            PG8_WAIT_L(8); PG8_BAR; PG8_WAIT_L(0); PG8_MMA(0, 0, At, B0); PG8_BAR; PG8_SCHED;
            PG8_LDB(B1, 1, 1); PG8_STAGE(PG8_SB(1, 0), b3, voffB);
            PG8_BAR; PG8_WAIT_L(0); PG8_MMA(0, 1, At, B1); PG8_BAR;
            PG8_LDA(At, 1, 1); PG8_STAGE(PG8_SA(1, 0), a3, voffA);
            PG8_BAR; PG8_WAIT_L(0); PG8_MMA(1, 0, At, B0); PG8_BAR; PG8_SCHED;
            PG8_STAGE(PG8_SB(1, 1), b3 + hstepB, voffB);
            PG8_WAIT_V(6); PG8_BAR; PG8_MMA(1, 1, At, B1); PG8_BAR;
            }
        }
        if constexpr (ALIGN_EPI) { if (wr == 0) PG8_BAR; }
        if constexpr (!Epi::AFTER_DRAIN) { E(acc, cur, wr, wc, fr, fq); S.done(cur); }
        if (!has_next) break;
#pragma unroll
        for (int a = 0; a < 2; ++a)
#pragma unroll
            for (int b = 0; b < 2; ++b)
#pragma unroll
                for (int m = 0; m < 4; ++m)
#pragma unroll
                    for (int n = 0; n < 2; ++n) acc[a][b][m][n] = (f32x4){0.f, 0.f, 0.f, 0.f};
        cur = nxt; cA = nA; cB = nB; ++ui;
        if constexpr (ALIGN_EPI) { if (wr == 1) PG8_BAR; }
    }
    PG8_WAIT_V(0);
    if constexpr (!ALIGN_EPI) { if (wr == 0) PG8_BAR; }
    PG8_BAR;
    if constexpr (Epi::AFTER_DRAIN) { E.fused(acc, cur, wr, wc, fr, fq, lds, wid, lane); S.done(cur); }
#undef PG8_SA
#undef PG8_SB
#undef PG8_STAGE
#undef PG8_LDA
#undef PG8_LDB
#undef PG8_MMA
#undef PG8_WAIT_V
#undef PG8_WAIT_L
#undef PG8_BAR
#undef PG8_SCHED
}
}

typedef unsigned short bf16;
typedef unsigned v4u __attribute__((ext_vector_type(4)));
typedef unsigned v2u __attribute__((ext_vector_type(2)));
typedef float f32x4 __attribute__((ext_vector_type(4)));
typedef short bf16x8 __attribute__((ext_vector_type(8)));

constexpr int D = 1024, MP = 16384, MS = 1024, M = MP + MS, SEQL = 2048, NBATCH = 8, DBATCH = 128;
constexpr int NPROJ = 3072, FF = 2816, NGU = 5632, DIN = 3080, MH = M / 2;
constexpr float EPS = 1e-6f;
constexpr int NTHREADS = 512, NWAVES = 8;
constexpr int LDS_BYTES = 155648;
constexpr size_t MiB = 1u << 20;
constexpr size_t WS_WOUT = 0, WS_WGU = 4 * MiB, WS_WDN = 26 * MiB, WS_XA = 37 * MiB, WS_PROJ = 71 * MiB, WS_GU = 105 * MiB, WS_SCR = 173 * MiB, WS_WIN = 239 * MiB;
constexpr size_t WS_GB = 245 * MiB, WS_SSQ = 245 * MiB + 576 * 1024, WS_WAB = 246 * MiB, WS_GL = 246 * MiB + 64 * 1024, WS_HALO = 246 * MiB + 128 * 1024, WS_BAR = 246 * MiB + 192 * 1024, WS_PART2 = 200 * MiB, WS_HAL = 247 * MiB, WS_FIXG = 249 * MiB, WS_FIXU = 251 * MiB, WS_END = 253 * MiB;
constexpr int SCR_ITEM = 73728;
constexpr size_t O_PDELTA = 17825792, O_PDCONV = 18874368, O_PPOOL = 18948096, O_PSCONV = 19009536, O_PFFN = 19017728;
constexpr size_t O_SDELTA = 19107840, O_SDCONV = 35885056, O_SPOOL = 37064704, O_SSCONV = 38047744, O_SFFN = 38178816, O_TOTAL = 39620608;

struct Params { const float* in[23]; float* out; unsigned char* ws; };
typedef const __attribute__((address_space(4))) Params* KP;
__device__ __forceinline__ KP kparams() { KP p = (KP)__builtin_amdgcn_kernarg_segment_ptr(); asm volatile("" : "+s"(p)); return p; }

#define LAUNDER(p) asm volatile("" : "+s"(p))
#define LDS_WAIT() asm volatile("s_waitcnt lgkmcnt(0)" ::: "memory")
__device__ __forceinline__ unsigned f2bf(float f) { unsigned u = __builtin_bit_cast(unsigned, f); return (u + 0x7fffu + ((u >> 16) & 1u)) >> 16; }
__device__ __forceinline__ unsigned pk2(float lo, float hi) { return f2bf(lo) | (f2bf(hi) << 16); }
__device__ __forceinline__ float bflo(unsigned u) { return __builtin_bit_cast(float, u << 16); }
__device__ __forceinline__ float bfhi(unsigned u) { return __builtin_bit_cast(float, u & 0xffff0000u); }
__device__ __forceinline__ float bf1(bf16 h) { return __builtin_bit_cast(float, ((unsigned)h) << 16); }
__device__ __forceinline__ float siluf(float x) { return x * __builtin_amdgcn_rcpf(1.f + __expf(-x)); }
__device__ __forceinline__ float shx(float v, int m) { return __builtin_bit_cast(float, __builtin_amdgcn_ds_bpermute((lane_id() ^ m) << 2, __builtin_bit_cast(int, v))); }
__device__ __forceinline__ float rdl(float v, int l) { return __builtin_bit_cast(float, __builtin_amdgcn_readlane(__builtin_bit_cast(int, v), l)); }
template <int CTRL> __device__ __forceinline__ float dpp_mov(float v) { const int i = __builtin_bit_cast(int, v); return __builtin_bit_cast(float, __builtin_amdgcn_update_dpp(i, i, CTRL, 0xf, 0xf, false)); }
__device__ __forceinline__ float wave_sum(float v) {
    v += dpp_mov<0x128>(v); v += dpp_mov<0x124>(v); v += dpp_mov<0x122>(v); v += dpp_mov<0x121>(v);
    const int i = __builtin_bit_cast(int, v);
    return (__builtin_bit_cast(float, __builtin_amdgcn_readlane(i, 0)) + __builtin_bit_cast(float, __builtin_amdgcn_readlane(i, 16))) +
           (__builtin_bit_cast(float, __builtin_amdgcn_readlane(i, 32)) + __builtin_bit_cast(float, __builtin_amdgcn_readlane(i, 48)));
}
#define UNPACK8(W_, F_) do { (F_)[0] = bflo((W_).x); (F_)[1] = bfhi((W_).x); (F_)[2] = bflo((W_).y); (F_)[3] = bfhi((W_).y); (F_)[4] = bflo((W_).z); (F_)[5] = bfhi((W_).z); (F_)[6] = bflo((W_).w); (F_)[7] = bfhi((W_).w); } while (0)
#define PACK8(F_) ((v4u){pk2((F_)[0], (F_)[1]), pk2((F_)[2], (F_)[3]), pk2((F_)[4], (F_)[5]), pk2((F_)[6], (F_)[7])})

struct EpiScale {
    static constexpr bool PERM = true, AFTER_DRAIN = false;
    bf16* O; int ldc; const float* ssq;
    __device__ __forceinline__ void operator()(const pg8::f32x4 (&acc)[2][2][4][2], const pg8::Unit& u, int wr, int wc, int fr, int fq) const {
        const int row0 = u.pm * 256 + wr * 64 + fr, col0 = u.pn * 256 + wc * 32 + 8 * fq;
        float sq[2][4];
#pragma unroll
        for (int ai = 0; ai < 2; ++ai)
#pragma unroll
            for (int m = 0; m < 4; ++m) sq[ai][m] = ssq[row0 + ai * 128 + m * 16];
#pragma unroll
        for (int ai = 0; ai < 2; ++ai)
#pragma unroll
            for (int m = 0; m < 4; ++m) {
                const int row = row0 + ai * 128 + m * 16;
                const float rs = rsqrtf(sq[ai][m] * (1.f / D) + EPS);
                bf16* rowp = O + (size_t)row * ldc + col0;
#pragma unroll
                for (int bj = 0; bj < 2; ++bj) {
                    pg8::f32x4 v0 = acc[ai][bj][m][0] * rs, v1 = acc[ai][bj][m][1] * rs;
                    v4u w; w.x = pk2(v0[0], v0[1]); w.y = pk2(v0[2], v0[3]); w.z = pk2(v1[0], v1[1]); w.w = pk2(v1[2], v1[3]);
                    *(v4u*)(rowp + bj * 128) = w;
                }
            }
    }
};
struct EpiResid {
    static constexpr bool PERM = true, AFTER_DRAIN = false;
    const float* xa; const float* xb_; float* xres; bf16* xb16; float* ssq; int rowbase;
    __device__ __forceinline__ void operator()(const pg8::f32x4 (&acc)[2][2][4][2], const pg8::Unit& u, int wr, int wc, int fr, int fq) const {
        const int row0 = rowbase + u.pm * 256 + wr * 64 + fr, col0 = u.pn * 256 + wc * 32 + 8 * fq;
#pragma unroll
        for (int ai = 0; ai < 2; ++ai) {
            pg8::f32x4 xo4[4][4];
#pragma unroll
            for (int m = 0; m < 4; ++m) {
                const int row = row0 + ai * 128 + m * 16;
                const float* xo = (row < MP ? xa + (size_t)row * D : xb_ + (size_t)(row - MP) * D) + col0;
                xo4[m][0] = *(const pg8::f32x4*)xo; xo4[m][1] = *(const pg8::f32x4*)(xo + 4); xo4[m][2] = *(const pg8::f32x4*)(xo + 128); xo4[m][3] = *(const pg8::f32x4*)(xo + 132);
            }
#pragma unroll
            for (int m = 0; m < 4; ++m) {
                const int row = row0 + ai * 128 + m * 16;
                float* xr = xres + (size_t)row * D + col0;
                bf16* xh = xb16 + (size_t)row * D + col0;
                float ss = 0.f;
#pragma unroll
                for (int bj = 0; bj < 2; ++bj) {
                    pg8::f32x4 v0 = acc[ai][bj][m][0] + xo4[m][2 * bj], v1 = acc[ai][bj][m][1] + xo4[m][2 * bj + 1];
                    *(pg8::f32x4*)(xr + bj * 128) = v0; *(pg8::f32x4*)(xr + bj * 128 + 4) = v1;
                    v4u w; w.x = pk2(v0[0], v0[1]); w.y = pk2(v0[2], v0[3]); w.z = pk2(v1[0], v1[1]); w.w = pk2(v1[2], v1[3]);
                    *(v4u*)(xh + bj * 128) = w;
                    ss += v0[0] * v0[0] + v0[1] * v0[1] + v0[2] * v0[2] + v0[3] * v0[3] + v1[0] * v1[0] + v1[1] * v1[1] + v1[2] * v1[2] + v1[3] * v1[3];
                }
                ss += shx(ss, 16); ss += shx(ss, 32);
                if (fq == 0) atomicAdd(ssq + row, ss);
            }
        }
    }
};


struct SplitOrder {
    int unit;
    __device__ __forceinline__ bool next(int i, pg8::Unit& u) const { if (i != 0 || unit < 0) return false; u.pm = unit >> 2; u.pn = unit & 3; return true; }
    __device__ __forceinline__ void a_ready(const pg8::Unit&) const {}
    __device__ __forceinline__ void done(const pg8::Unit&) const {}
};
struct EpiAtomic {
    static constexpr bool PERM = true, AFTER_DRAIN = false;
    float* X;
    __device__ __forceinline__ void operator()(const pg8::f32x4 (&acc)[2][2][4][2], const pg8::Unit& u, int wr, int wc, int fr, int fq) const {
        const int row0 = u.pm * 256 + wr * 64 + fr, col0 = u.pn * 256 + wc * 32 + 8 * fq;
#pragma unroll
        for (int ai = 0; ai < 2; ++ai)
#pragma unroll
            for (int m = 0; m < 4; ++m) {
                float* xr = X + (size_t)(row0 + ai * 128 + m * 16) * D + col0;
#pragma unroll
                for (int bj = 0; bj < 2; ++bj) { *(pg8::f32x4*)(xr + bj * 128) = acc[ai][bj][m][0]; *(pg8::f32x4*)(xr + bj * 128 + 4) = acc[ai][bj][m][1]; }
            }
    }
};
__device__ __forceinline__ void fin_sample(float* X, bf16* XB, float* ssq, const float* partA, int nA, const float* partB, int nB, int gw, int ngw, int lane) {
    for (int r = gw; r < MS; r += ngw) {
        f32x4 v[4];
#pragma unroll
        for (int j = 0; j < 4; ++j) v[j] = ((const f32x4*)(X + (size_t)r * D))[lane + 64 * j];
        for (int k = 0; k < nA; ++k) {
#pragma unroll
            for (int j = 0; j < 4; ++j) v[j] += ((const f32x4*)(partA + ((size_t)k * MS + r) * D))[lane + 64 * j];
        }
        for (int k = 0; k < nB; ++k) {
#pragma unroll
            for (int j = 0; j < 4; ++j) v[j] += ((const f32x4*)(partB + ((size_t)k * MS + r) * D))[lane + 64 * j];
        }
        float ss = 0.f;
#pragma unroll
        for (int j = 0; j < 4; ++j) { ss += v[j][0] * v[j][0] + v[j][1] * v[j][1] + v[j][2] * v[j][2] + v[j][3] * v[j][3];
            ((f32x4*)(X + (size_t)r * D))[lane + 64 * j] = v[j];
            ((v2u*)(XB + (size_t)r * D))[lane + 64 * j] = (v2u){pk2(v[j][0], v[j][1]), pk2(v[j][2], v[j][3])}; }
        ss = wave_sum(ss);
        if (lane == 0) ssq[r] = ss;
    }
}

constexpr int EPI_HALO_OFF = 131072;
__device__ __forceinline__ float dpp_f(float oldv, float src, const int ctrl_sel) {
    const int o = __builtin_bit_cast(int, oldv), v = __builtin_bit_cast(int, src); int r;
    if (ctrl_sel == 0) r = __builtin_amdgcn_update_dpp(o, v, 0x111, 0xf, 0xf, false);
    else if (ctrl_sel == 1) r = __builtin_amdgcn_update_dpp(o, v, 0x112, 0xf, 0xf, false);
    else if (ctrl_sel == 2) r = __builtin_amdgcn_update_dpp(o, v, 0x121, 0xf, 0xf, false);
    else r = __builtin_amdgcn_update_dpp(o, v, 0x122, 0xf, 0xf, false);
    return __builtin_bit_cast(float, r);
}
struct EpiGateUp {
    static constexpr bool PERM = true, AFTER_DRAIN = false;
    bf16* ACT; const float* ssq; const float* cw; const float* st; float* HAL; float* FIXG; float* FIXU; float* pffn; float* sffn; unsigned char* lds;
    __device__ __forceinline__ void operator()(const pg8::f32x4 (&acc)[2][2][4][2], const pg8::Unit& u, int wr, int wc, int fr, int fq) const {
        const int pm = u.pm, ch0 = u.pn * 128 + wc * 32 + 8 * fq, row0 = pm * 256 + wr * 64 + fr;
        const bool smp = pm >= 64;
        float* halo = (float*)(lds + EPI_HALO_OFF);
#pragma unroll
        for (int ai = 0; ai < 2; ++ai) {
            const float rs = rsqrtf(ssq[row0 + ai * 128 + 48] * (1.f / D) + EPS);
            if (fr >= 14) {
                float* hp = halo + ((ai * 2 + wr) * 2 + (fr - 14)) * 128 + wc * 32 + 8 * fq;
                *(pg8::f32x4*)hp = acc[ai][0][3][0] * rs; *(pg8::f32x4*)(hp + 4) = acc[ai][0][3][1] * rs;
            }
        }
        asm volatile("s_waitcnt lgkmcnt(0)" ::: "memory");
        __builtin_amdgcn_s_barrier();
        float w0[8], w1[8], w2[8];
#pragma unroll
        for (int e = 0; e < 8; ++e) { w0[e] = cw[ch0 + e]; w1[e] = cw[FF + ch0 + e]; w2[e] = cw[2 * FF + ch0 + e]; }
#pragma unroll
        for (int ai = 0; ai < 2; ++ai) {
            const int s = ai * 2 + wr;
            float prev[8];
#pragma unroll
            for (int e = 0; e < 8; ++e) prev[e] = 0.f;
            if (!smp && s >= 1 && fr >= 14) {
                const float* hp = halo + ((s - 1) * 2 + (fr - 14)) * 128 + wc * 32 + 8 * fq;
                const pg8::f32x4 h0 = *(const pg8::f32x4*)hp, h1 = *(const pg8::f32x4*)(hp + 4);
                prev[0] = h0[0]; prev[1] = h0[1]; prev[2] = h0[2]; prev[3] = h0[3]; prev[4] = h1[0]; prev[5] = h1[1]; prev[6] = h1[2]; prev[7] = h1[3];
            }
            float sq4[4];
#pragma unroll
            for (int m = 0; m < 4; ++m) sq4[m] = ssq[row0 + ai * 128 + m * 16];
#pragma unroll
            for (int m = 0; m < 4; ++m) {
                const int row = row0 + ai * 128 + m * 16;
                const float rs = rsqrtf(sq4[m] * (1.f / D) + EPS);
                float cur[8], upv[8], s0v[8], s1v[8];
#pragma unroll
                for (int e = 0; e < 8; ++e) { cur[e] = acc[ai][0][m][e >> 2][e & 3] * rs; upv[e] = acc[ai][1][m][e >> 2][e & 3] * rs; s0v[e] = 0.f; s1v[e] = 0.f; }
                const int t = fr & 7, sb = (row - MP) >> 3;
                if (smp && t < 2) {
                    const float* sp = st + (size_t)(sb * 2) * FF + ch0;
#pragma unroll
                    for (int e = 0; e < 8; ++e) { s0v[e] = sp[e]; s1v[e] = sp[FF + e]; }
                }
                float a[8];
#pragma unroll
                for (int e = 0; e < 8; ++e) {
                    const float sh1 = dpp_f(cur[e], cur[e], 0), sh2 = dpp_f(cur[e], cur[e], 1), ro1 = dpp_f(prev[e], prev[e], 2), ro2 = dpp_f(prev[e], prev[e], 3);
                    float p1, p2;
                    if (smp) { p1 = t >= 1 ? sh1 : s1v[e]; p2 = t >= 2 ? sh2 : (t == 1 ? s1v[e] : s0v[e]); }
                    else { p1 = fr >= 1 ? sh1 : ro1; p2 = fr >= 2 ? sh2 : ro2; }
                    a[e] = siluf(w0[e] * p2 + w1[e] * p1 + w2[e] * cur[e]) * upv[e];
                }
                *(v4u*)(ACT + (size_t)row * FF + ch0) = PACK8(a);
                if (smp) {
                    if (t >= 6) { float* o = sffn + (size_t)(sb * 2 + t - 6) * FF + ch0;
                        *(pg8::f32x4*)o = (pg8::f32x4){cur[0], cur[1], cur[2], cur[3]}; *(pg8::f32x4*)(o + 4) = (pg8::f32x4){cur[4], cur[5], cur[6], cur[7]}; }
                } else {
                    if (s == 3 && m == 3 && fr >= 14) {
                        float* o = HAL + (size_t)(pm * 2 + fr - 14) * FF + ch0;
                        *(pg8::f32x4*)o = (pg8::f32x4){cur[0], cur[1], cur[2], cur[3]}; *(pg8::f32x4*)(o + 4) = (pg8::f32x4){cur[4], cur[5], cur[6], cur[7]};
                        if ((pm & 7) == 7) { float* o2 = pffn + (size_t)((pm >> 3) * 2 + fr - 14) * FF + ch0;
                            *(pg8::f32x4*)o2 = (pg8::f32x4){cur[0], cur[1], cur[2], cur[3]}; *(pg8::f32x4*)(o2 + 4) = (pg8::f32x4){cur[4], cur[5], cur[6], cur[7]}; }
                    }
                    if (s == 0 && m == 0 && fr < 2 && (pm & 7) != 0) {
                        float* o = FIXG + (size_t)(pm * 2 + fr) * FF + ch0; float* o2 = FIXU + (size_t)(pm * 2 + fr) * FF + ch0;
                        *(pg8::f32x4*)o = (pg8::f32x4){cur[0], cur[1], cur[2], cur[3]}; *(pg8::f32x4*)(o + 4) = (pg8::f32x4){cur[4], cur[5], cur[6], cur[7]};
                        *(pg8::f32x4*)o2 = (pg8::f32x4){upv[0], upv[1], upv[2], upv[3]}; *(pg8::f32x4*)(o2 + 4) = (pg8::f32x4){upv[4], upv[5], upv[6], upv[7]};
                    }
                }
#pragma unroll
                for (int e = 0; e < 8; ++e) prev[e] = cur[e];
            }
        }
    }
};
__device__ __forceinline__ void p4_fixup(KP P, int l, int start, int stride) {
    const float* HAL = (const float*)(P->ws + WS_HAL); const float* FIXG = (const float*)(P->ws + WS_FIXG); const float* FIXU = (const float*)(P->ws + WS_FIXU);
    bf16* ACT = (bf16*)(P->ws + WS_GU);
    const float* cw = P->in[19] + (size_t)(l * 3) * FF;
    for (int idx = start; idx < 56 * 2 * FF; idx += stride) {
        const int k = idx / (2 * FF), rem = idx % (2 * FF), rr = rem / FF, c = rem % FF;
        const int pm = (k / 7) * 8 + 1 + (k % 7);
        const float g0 = FIXG[(size_t)(pm * 2 + rr) * FF + c];
        const float g1 = rr == 0 ? HAL[(size_t)((pm - 1) * 2 + 1) * FF + c] : FIXG[(size_t)(pm * 2) * FF + c];
        const float g2 = rr == 0 ? HAL[(size_t)((pm - 1) * 2) * FF + c] : HAL[(size_t)((pm - 1) * 2 + 1) * FF + c];
        const float a = siluf(cw[c] * g2 + cw[FF + c] * g1 + cw[2 * FF + c] * g0) * FIXU[(size_t)(pm * 2 + rr) * FF + c];
        ACT[(size_t)(pm * 256 + rr) * FF + c] = (bf16)f2bf(a);
    }
}
__device__ __forceinline__ void transpose_item(const float* W, int K, int ldw, int src_col0, const float* g, bf16* WT, int dst_row0, float* scr, int kb, int lane) {
    const int k0 = 64 * kb;
    float wv[32];
#pragma unroll
    for (int i = 0; i < 32; ++i) wv[i] = W[(size_t)(k0 + 2 * i + (lane >> 5)) * ldw + src_col0 + (lane & 31)];
#pragma unroll
    for (int i = 0; i < 32; ++i) { const int kk = 2 * i + (lane >> 5); const float gs = g ? g[k0 + kk] : 1.f; scr[kk * 33 + (lane & 31)] = wv[i] * gs; }
    LDS_WAIT();
    const int c = lane & 7;
#pragma unroll
    for (int j = 0; j < 4; ++j) { const int n = (lane >> 3) + 8 * j; const float* s = scr + (8 * c) * 33 + n;
        v4u o; o.x = pk2(s[0 * 33], s[1 * 33]); o.y = pk2(s[2 * 33], s[3 * 33]); o.z = pk2(s[4 * 33], s[5 * 33]); o.w = pk2(s[6 * 33], s[7 * 33]);
        *(v4u*)(WT + (size_t)(dst_row0 + n) * K + k0 + 8 * c) = o; }
    LDS_WAIT();
}
__device__ __forceinline__ void convert_matrix(const float* W, int K, int N, int ldw, int skip_from, int skip, const float* g, bf16* WT, int dst_row0, float* scr, int gw, int ngw, int lane, int il = 0) {
    const int nnb = N / 32, nit = (K / 64) * nnb;
    for (int it = gw; it < nit; it += ngw) {
        const int kb = it / nnb, nb = it % nnb, n0 = nb * 32;
        const int drow = il ? ((n0 >> 7) * 256 + (n0 & 127) + (il == 2 ? 128 : 0)) : n0;
        transpose_item(W, K, ldw, n0 + (n0 >= skip_from ? skip : 0), g, WT, dst_row0 + drow, scr, kb, lane);
    }
}
__device__ __forceinline__ void convert_layer_rest(KP P, int l, float* scr, int gw, int ngw, int lane) {
    unsigned char* ws = P->ws;
    convert_matrix(P->in[16] + (size_t)l * D * D, D, D, D, 1 << 30, 0, nullptr, (bf16*)(ws + WS_WOUT) + (size_t)l * D * D, 0, scr, gw, ngw, lane);
    convert_matrix(P->in[18] + (size_t)l * D * FF, D, FF, FF, 1 << 30, 0, P->in[17] + l * D, (bf16*)(ws + WS_WGU) + (size_t)l * NGU * D, 0, scr, gw, ngw, lane, 1);
    convert_matrix(P->in[20] + (size_t)l * D * FF, D, FF, FF, 1 << 30, 0, P->in[17] + l * D, (bf16*)(ws + WS_WGU) + (size_t)l * NGU * D, 0, scr, gw, ngw, lane, 2);
    convert_matrix(P->in[21] + (size_t)l * FF * D, FF, D, D, 1 << 30, 0, nullptr, (bf16*)(ws + WS_WDN) + (size_t)l * D * FF, 0, scr, gw, ngw, lane);
}
__device__ __forceinline__ void convert_win(KP P, int l, float* scr, int gw, int ngw, int lane) {
    convert_matrix(P->in[8] + (size_t)l * D * DIN, D, NPROJ, DIN, 2048, 8, P->in[7] + l * D, (bf16*)(P->ws + WS_WIN), 0, scr, gw, ngw, lane);
}

constexpr int B_QF = 0, B_KF = 33792, B_VF = 67584, B_AT = 101376, B_GC = 118784, B_QKS = 120320, B_WST = 128512;
__device__ __forceinline__ void p2b_item(KP P, int l, int item, unsigned char* lds, int wave_in) {
    const int tid = fresh_tid(wave_in);
    const int h = item & 3, n = (item >> 2) & 31, b = item >> 7;
    const int lane = tid & 63, wv = __builtin_amdgcn_readfirstlane(tid >> 6), fr = lane & 15, fq = lane >> 4;
    float* QF = (float*)(lds + B_QF); float* KF = (float*)(lds + B_KF); float* VF = (float*)(lds + B_VF); float* AT = (float*)(lds + B_AT);
    float* Gs = (float*)(lds + B_GC); float* BETA = Gs + 64; float* GC = Gs + 128; float* EG = Gs + 192; float* EKD = Gs + 256;
    bf16* QKS = (bf16*)(lds + B_QKS); bf16* WST = (bf16*)(lds + B_WST);
    const bf16* PROJ = (const bf16*)(P->ws + WS_PROJ);
    const float* GB = (const float*)(P->ws + WS_GB);
    unsigned char* scr = P->ws + WS_SCR + (size_t)item * SCR_ITEM;
    if (tid < 384) {
        const int chunk = tid % 48, tg = tid / 48, part = chunk >> 4, cc = chunk & 15;
        const int col = part * 512 + h * 128 + cc * 8;
        const float* cw = P->in[9] + (size_t)(l * 4) * 1536 + col;
        float w0[8], w1[8], w2[8], w3[8];
#pragma unroll
        for (int e = 0; e < 8; ++e) { w0[e] = cw[e]; w1[e] = cw[1536 + e]; w2[e] = cw[2 * 1536 + e]; w3[e] = cw[3 * 1536 + e]; }
        const int t0 = n * 64 + tg * 8;
        const bf16* base = PROJ + (size_t)(b * SEQL) * NPROJ + col;
        float r0[8], r1[8], r2[8], r3[8];
#pragma unroll
        for (int e = 0; e < 8; ++e) { r0[e] = 0.f; r1[e] = 0.f; r2[e] = 0.f; }
        if (t0 - 3 >= 0) { const v4u w = *(const v4u*)(base + (size_t)(t0 - 3) * NPROJ); UNPACK8(w, r0); }
        if (t0 - 2 >= 0) { const v4u w = *(const v4u*)(base + (size_t)(t0 - 2) * NPROJ); UNPACK8(w, r1); }
        if (t0 - 1 >= 0) { const v4u w = *(const v4u*)(base + (size_t)(t0 - 1) * NPROJ); UNPACK8(w, r2); }
        float* dst = (float*)(lds + part * 33792) + cc * 8;
#pragma unroll
        for (int i = 0; i < 8; ++i) {
            const v4u w = *(const v4u*)(base + (size_t)(t0 + i) * NPROJ); UNPACK8(w, r3);
            float s[8];
#pragma unroll
            for (int e = 0; e < 8; ++e) { const float cv = w0[e] * r0[e] + w1[e] * r1[e] + w2[e] * r2[e] + w3[e] * r3[e]; s[e] = siluf(cv); }
            float* d = dst + (tg * 8 + i) * 132;
            *(f32x4*)d = (f32x4){s[0], s[1], s[2], s[3]}; *(f32x4*)(d + 4) = (f32x4){s[4], s[5], s[6], s[7]};
#pragma unroll
            for (int e = 0; e < 8; ++e) { r0[e] = r1[e]; r1[e] = r2[e]; r2[e] = r3[e]; }
        }
    }
    if (tid < 64) { const int row = b * SEQL + n * 64 + tid; Gs[tid] = GB[(size_t)row * 8 + h]; BETA[tid] = GB[(size_t)row * 8 + 4 + h]; }
    __syncthreads();
    {
        const int tok = tid >> 3, sub = tid & 7;
        float* qr = QF + tok * 132 + sub * 16; float* kr = KF + tok * 132 + sub * 16;
        float qv[16], kv[16]; float sq = 0.f, sk = 0.f;
#pragma unroll
        for (int e = 0; e < 16; ++e) { qv[e] = qr[e]; kv[e] = kr[e]; sq += qv[e] * qv[e]; sk += kv[e] * kv[e]; }
        sq += shx(sq, 1); sq += shx(sq, 2); sq += shx(sq, 4);
        sk += shx(sk, 1); sk += shx(sk, 2); sk += shx(sk, 4);
        const float rq = rsqrtf(sq + EPS) * 0.08838834764831845f, rk = rsqrtf(sk + EPS);
#pragma unroll
        for (int e = 0; e < 16; ++e) { qr[e] = qv[e] * rq; kr[e] = kv[e] * rk; }
    }
    if (tid < 64) {
        float v = Gs[tid];
#pragma unroll
        for (int o = 1; o < 64; o <<= 1) { const int src = tid >= o ? tid - o : tid; const float t = __builtin_bit_cast(float, __builtin_amdgcn_ds_bpermute(src << 2, __builtin_bit_cast(int, v))); if (tid >= o) v += t; }
        const float tot = rdl(v, 63);
        GC[tid] = v; EG[tid] = __expf(v); EKD[tid] = __expf(tot - v);
        if (tid == 0) ((float*)(P->ws + WS_GL))[item] = __expf(tot);
    }
    __syncthreads();
    {
        const int p = wv >> 2, mt = wv & 3;
        const float* X = p ? QF : KF;
        f32x4 acc[4];
#pragma unroll
        for (int nt = 0; nt < 4; ++nt) acc[nt] = (f32x4){0.f, 0.f, 0.f, 0.f};
        const float* xa = X + (mt * 16 + fr) * 132 + fq; const float* kb_ = KF + fr * 132 + fq;
#pragma unroll 8
        for (int k = 0; k < 128; k += 4) {
            const float a = xa[k];
#pragma unroll
            for (int nt = 0; nt < 4; ++nt) acc[nt] = __builtin_amdgcn_mfma_f32_16x16x4f32(a, kb_[nt * 16 * 132 + k], acc[nt], 0, 0, 0);
        }
#pragma unroll
        for (int nt = 0; nt < 4; ++nt) {
            const int j = nt * 16 + fr; const float gj = GC[j];
            float v[4];
#pragma unroll
            for (int r = 0; r < 4; ++r) {
                const int i = mt * 16 + 4 * fq + r;
                if (p == 0) v[r] = (i > j) ? BETA[i] * acc[nt][r] * __expf(GC[i] - gj) : 0.f;
                else        v[r] = (i >= j) ? acc[nt][r] * __expf(GC[i] - gj) : 0.f;
            }
            if (p == 0) *(f32x4*)(AT + j * 68 + mt * 16 + 4 * fq) = (f32x4){v[0], v[1], v[2], v[3]};
            else {
#pragma unroll
                for (int r = 0; r < 4; ++r) QKS[(mt * 16 + 4 * fq + r) * 64 + j] = (bf16)f2bf(v[r]);
            }
        }
    }
    __syncthreads();
    const int tid4 = fresh_tid(wave_in);
    if (tid4 < 256) {
        float x[64];
        int zo = 0; asm volatile("" : "+v"(zo));
        const float* ATz = AT + zo; const float* BETAz = BETA + zo; const float* EGz = EG + zo;
        if (tid4 < 128) {
#pragma unroll
            for (int i = 0; i < 64; ++i) x[i] = BETAz[i] * VF[i * 132 + tid4];
        } else {
#pragma unroll
            for (int i = 0; i < 64; ++i) x[i] = BETAz[i] * EGz[i] * KF[i * 132 + tid4 - 128];
        }
        f32x4 ab[16];
#pragma unroll
        for (int q = 0; q < 16; ++q) ab[q] = *(const f32x4*)(ATz + q * 4);
        typedef float f32x2_t __attribute__((ext_vector_type(2)));
        f32x2_t x2[32];
#pragma unroll
        for (int p = 0; p < 32; ++p) x2[p] = (f32x2_t){x[2 * p], x[2 * p + 1]};
#pragma unroll
        for (int j = 0; j < 63; ++j) {
            const float xj = (j & 1) ? x2[j >> 1].y : x2[j >> 1].x;
            const f32x2_t xj2 = (f32x2_t){xj, xj};
#pragma unroll
            for (int q = (j + 1) / 4; q < 16; ++q) {
#pragma unroll
                for (int hh = 0; hh < 2; ++hh) {
                    const int p = 2 * q + hh;
                    if (2 * p > j) x2[p] -= (f32x2_t){ab[q][2 * hh], ab[q][2 * hh + 1]} * xj2;
                    else if (2 * p + 1 > j) x2[p].y -= ab[q][2 * hh + 1] * xj;
                }
                if (j + 1 < 63 && q >= (j + 2) / 4) ab[q] = *(const f32x4*)(ATz + (j + 1) * 68 + q * 4);
                __builtin_amdgcn_sched_barrier(0);
            }
        }
#pragma unroll
        for (int p = 0; p < 32; ++p) { x[2 * p] = x2[p].x; x[2 * p + 1] = x2[p].y; }
        if (tid4 < 128) {
            unsigned char* up = scr + 49152 + tid4 * 128;
#pragma unroll
            for (int q = 0; q < 8; ++q) *(v4u*)(up + q * 16) = PACK8(x + 8 * q);
        } else {
            const int dk = tid4 - 128;
#pragma unroll
            for (int i = 0; i < 64; ++i) WST[i * 128 + dk] = (bf16)f2bf(-x[i]);
        }
    } else {
        const int t2 = tid4 - 256;
        {
            const int tok = t2 >> 2, seg = t2 & 3; const float eg = EG[tok]; const float* s = QF + tok * 132 + seg * 32;
            unsigned char* o = scr + 16384 + tok * 256 + seg * 64;
#pragma unroll
            for (int q = 0; q < 4; ++q) { float f[8];
#pragma unroll
                for (int e = 0; e < 8; ++e) f[e] = s[q * 8 + e] * eg;
                *(v4u*)(o + q * 16) = PACK8(f); }
        }
        {
            const int dk = t2 >> 1, hf = t2 & 1; unsigned char* o = scr + 32768 + dk * 128 + hf * 64;
#pragma unroll
            for (int q = 0; q < 4; ++q) { float f[8];
#pragma unroll
                for (int e = 0; e < 8; ++e) { const int tok = hf * 32 + q * 8 + e; f[e] = KF[tok * 132 + dk] * EKD[tok]; }
                *(v4u*)(o + q * 16) = PACK8(f); }
        }
#pragma unroll
        for (int q = 0; q < 2; ++q) { const int c = t2 + 256 * q; *(v4u*)(scr + 65536 + c * 16) = *(const v4u*)((const unsigned char*)QKS + c * 16); }
    }
    __syncthreads();
#pragma unroll
    for (int q = 0; q < 2; ++q) { const int c = tid4 + 512 * q; *(v4u*)(scr + c * 16) = *(const v4u*)((const unsigned char*)WST + c * 16); }
    __syncthreads();
}

constexpr int S_ST = 0, S_VNT = 34816, S_OPW = 53248, S_OPQG = 70656, S_OPKD = 88064, S_OPQK = 106496, S_OPU = 115712;
__device__ __forceinline__ void scan_load(v4u (&pre)[9], const unsigned char* src, int tid, int half) {
#pragma unroll
    for (int i = 0; i < 9; ++i) pre[i] = *(const v4u*)(src + (size_t)(tid + 512 * i) * 16);
}
__device__ __forceinline__ void scan_chunk(v4u (&pre)[9], f32x4 (&sacc)[8], unsigned char* lds, unsigned char* scrbase, bf16* orow, int item, int n, float egl, int tid, int w, int fr, int fq, int half) {
    asm volatile("s_waitcnt lgkmcnt(0)" ::: "memory"); __builtin_amdgcn_s_barrier(); asm volatile("" ::: "memory");
#pragma unroll
    for (int i = 0; i < 9; ++i) {
        const int e = (tid + 512 * i) * 16 - (i >> 1) * 16384;
        if (i < 4) { const int row = e >> 8, cb = e & 255; *(v4u*)(lds + (i < 2 ? S_OPW : S_OPQG) + row * 272 + cb) = pre[i]; }
        else { const int row = e >> 7, cb = e & 127; *(v4u*)(lds + (i < 6 ? S_OPKD : (i < 8 ? S_OPU : S_OPQK)) + row * 144 + cb) = pre[i]; }
    }
    asm volatile("s_waitcnt lgkmcnt(0)" ::: "memory"); __builtin_amdgcn_s_barrier(); asm volatile("" ::: "memory");
    scan_load(pre, scrbase + (size_t)(item + (n + 2 < 32 ? 8 : 0)) * SCR_ITEM, tid, half);
    if (w < 4) {
    const int dvt = half * 4 + w;
#define SB() __builtin_amdgcn_sched_barrier(0)
    bf16x8 sf[4];
#pragma unroll
    for (int ks = 0; ks < 4; ++ks) sf[ks] = *(const bf16x8*)(lds + S_ST + (16 * w + fr) * 272 + (ks * 32 + 8 * fq) * 2);
    f32x4 vt[4];
    v2u uu[4];
#pragma unroll
    for (int tt = 0; tt < 4; ++tt) uu[tt] = *(const v2u*)(lds + S_OPU + (16 * dvt + fr) * 144 + (tt * 16 + 4 * fq) * 2);
    {
        bf16x8 af[4][4];
#pragma unroll
        for (int ks = 0; ks < 4; ++ks)
#pragma unroll
            for (int tt = 0; tt < 4; ++tt) af[ks][tt] = *(const bf16x8*)(lds + S_OPW + (tt * 16 + fr) * 272 + (ks * 32 + 8 * fq) * 2);
        SB();
#pragma unroll
        for (int tt = 0; tt < 4; ++tt) vt[tt] = (f32x4){bflo(uu[tt].x), bfhi(uu[tt].x), bflo(uu[tt].y), bfhi(uu[tt].y)};
#pragma unroll
        for (int ks = 0; ks < 4; ++ks)
#pragma unroll
            for (int tt = 0; tt < 4; ++tt) vt[tt] = __builtin_amdgcn_mfma_f32_16x16x32_bf16(af[ks][tt], sf[ks], vt[tt], 0, 0, 0);
        SB();
    }
#pragma unroll
    for (int tt = 0; tt < 4; ++tt) *(v2u*)(lds + S_VNT + (16 * w + fr) * 144 + (tt * 16 + 4 * fq) * 2) = (v2u){pk2(vt[tt][0], vt[tt][1]), pk2(vt[tt][2], vt[tt][3])};
    f32x4 ot[4];
#pragma unroll
    for (int nt = 0; nt < 4; ++nt) ot[nt] = (f32x4){0.f, 0.f, 0.f, 0.f};
    {
        bf16x8 bq[4][4];
#pragma unroll
        for (int ks = 0; ks < 4; ++ks)
#pragma unroll
            for (int nt = 0; nt < 4; ++nt) bq[ks][nt] = *(const bf16x8*)(lds + S_OPQG + (nt * 16 + fr) * 272 + (ks * 32 + 8 * fq) * 2);
        SB();
#pragma unroll
        for (int ks = 0; ks < 4; ++ks)
#pragma unroll
            for (int nt = 0; nt < 4; ++nt) ot[nt] = __builtin_amdgcn_mfma_f32_16x16x32_bf16(sf[ks], bq[ks][nt], ot[nt], 0, 0, 0);
        SB();
    }
    LDS_WAIT();
    bf16x8 vf[2];
#pragma unroll
    for (int js = 0; js < 2; ++js) vf[js] = *(const bf16x8*)(lds + S_VNT + (16 * w + fr) * 144 + (js * 32 + 8 * fq) * 2);
    {
        bf16x8 bk[2][4];
#pragma unroll
        for (int js = 0; js < 2; ++js)
#pragma unroll
            for (int nt = 0; nt < 4; ++nt) bk[js][nt] = *(const bf16x8*)(lds + S_OPQK + (nt * 16 + fr) * 144 + (js * 32 + 8 * fq) * 2);
        SB();
#pragma unroll
        for (int js = 0; js < 2; ++js)
#pragma unroll
            for (int nt = 0; nt < 4; ++nt) ot[nt] = __builtin_amdgcn_mfma_f32_16x16x32_bf16(vf[js], bk[js][nt], ot[nt], 0, 0, 0);
        SB();
    }
#pragma unroll
    for (int nt = 0; nt < 4; ++nt) *(v2u*)(orow + (size_t)(nt * 16 + fr) * D + 16 * dvt + 4 * fq) = (v2u){pk2(ot[nt][0], ot[nt][1]), pk2(ot[nt][2], ot[nt][3])};
    {
        bf16x8 ak[2][8];
#pragma unroll
        for (int js = 0; js < 2; ++js)
#pragma unroll
            for (int mt = 0; mt < 8; ++mt) ak[js][mt] = *(const bf16x8*)(lds + S_OPKD + (mt * 16 + fr) * 144 + (js * 32 + 8 * fq) * 2);
        SB();
#pragma unroll
        for (int mt = 0; mt < 8; ++mt) sacc[mt] = sacc[mt] * egl;
#pragma unroll
        for (int js = 0; js < 2; ++js)
#pragma unroll
            for (int mt = 0; mt < 8; ++mt) sacc[mt] = __builtin_amdgcn_mfma_f32_16x16x32_bf16(ak[js][mt], vf[js], sacc[mt], 0, 0, 0);
        SB();
    }
#pragma unroll
    for (int mt = 0; mt < 8; ++mt) *(v2u*)(lds + S_ST + (16 * w + fr) * 272 + (mt * 16 + 4 * fq) * 2) = (v2u){pk2(sacc[mt][0], sacc[mt][1]), pk2(sacc[mt][2], sacc[mt][3])};
#undef SB
    }
    LDS_WAIT();
}
__device__ __forceinline__ void scan_wg(KP P, int l, int id, unsigned char* lds, int tid) {
    const int bh = id >> 1, half = id & 1, b = bh >> 2, h = bh & 3;
    const int lane = tid & 63, w = __builtin_amdgcn_readfirstlane(tid >> 6), fr = lane & 15, fq = lane >> 4;
    unsigned char* scrbase = P->ws + WS_SCR;
    bf16* OCAT = (bf16*)(P->ws + WS_XA);
    f32x4 sacc[8];
#pragma unroll
    for (int mt = 0; mt < 8; ++mt) sacc[mt] = (f32x4){0.f, 0.f, 0.f, 0.f};
    { unsigned zz0 = 0u; asm volatile("" : "+v"(zz0)); if (w < 4) for (int q = lane; q < 272; q += 64) *(v4u*)(lds + S_ST + (16 * w) * 272 + q * 16) = (v4u){zz0, zz0, zz0, zz0}; }
    const int item0 = (b * 32) * 4 + h;
    const float glv = ((const float*)(P->ws + WS_GL))[item0 + 4 * (lane & 31)];
    v4u preA[9], preB[9];
    scan_load(preA, scrbase + (size_t)item0 * SCR_ITEM, tid, half);
    scan_load(preB, scrbase + (size_t)(item0 + 4) * SCR_ITEM, tid, half);
    bf16* orow = OCAT + (size_t)(b * SEQL) * D + h * 128;
#pragma unroll
    for (int n = 0; n < 32; n += 2) {
        scan_chunk(preA, sacc, lds, scrbase, orow + (size_t)(n * 64) * D, item0 + 4 * n, n, rdl(glv, n), tid, w, fr, fq, half);
        scan_chunk(preB, sacc, lds, scrbase, orow + (size_t)(n * 64 + 64) * D, item0 + 4 * n + 4, n + 1, rdl(glv, n + 1), tid, w, fr, fq, half);
    }
    if (w < 4) {
        const int lane2 = lane_id(), fr2 = lane2 & 15, fq2 = lane2 >> 4;
        float* pd = P->out + O_PDELTA + (size_t)((l * NBATCH + b) * 4 + h) * 16384;
#pragma unroll
        for (int mt = 0; mt < 8; ++mt)
#pragma unroll
            for (int r = 0; r < 4; ++r) pd[(mt * 16 + 4 * fq2 + r) * 128 + 16 * (half * 4 + w) + fr2] = sacc[mt][r];
    }
    __syncthreads();
}
__device__ __forceinline__ void p2d(KP P, int l, int gw, int ngw, int lane) {
    const bf16* PROJ = (const bf16*)(P->ws + WS_PROJ);
    bf16* OCAT = (bf16*)(P->ws + WS_XA);
    const float on0 = P->in[12][l * 128 + lane * 2], on1 = P->in[12][l * 128 + lane * 2 + 1];
    for (int pair0 = gw * 4; pair0 < MP * 4; pair0 += 4 * ngw) {
        float o0[4], o1[4]; unsigned zz[4];
#pragma unroll
        for (int q = 0; q < 4; ++q) {
            const int pair = pair0 + q;
            o0[q] = 0.f; o1[q] = 0.f; zz[q] = 0u;
            if (pair < MP * 4) {
                const int row = pair >> 2, h = pair & 3, b = row >> 11, t = row & 2047, n = t >> 6, tok = t & 63;
                const unsigned ow = *(const unsigned*)(OCAT + (size_t)row * D + h * 128 + lane * 2);
                o0[q] = bflo(ow); o1[q] = bfhi(ow);
                zz[q] = *(const unsigned*)(PROJ + (size_t)row * NPROJ + 1536 + h * 128 + lane * 2);
            }
        }
#pragma unroll
        for (int q = 0; q < 4; ++q) {
            const int pair = pair0 + q;
            const float rs = rsqrtf(wave_sum(o0[q] * o0[q] + o1[q] * o1[q]) * (1.f / 128.f) + EPS);
            if (pair < MP * 4) {
                const int row = pair >> 2, h = pair & 3;
                *(unsigned*)(OCAT + (size_t)row * D + h * 128 + lane * 2) = pk2(o0[q] * rs * on0 * siluf(bflo(zz[q])), o1[q] * rs * on1 * siluf(bfhi(zz[q])));
            }
        }
    }
}

__device__ __forceinline__ void sample_delta(KP P, int l, int it, unsigned char* lds, int wave_in) {
    const int tid = fresh_tid(wave_in);
    const int gq = tid >> 7, c = tid & 127, wv2 = (tid >> 6) & 1, lane = tid & 63;
    const int item = it * 4 + gq, sb = item >> 2, h = item & 3, rowbase = MP + sb * 8;
    float* QS = (float*)(lds + gq * 12288); float* KS = QS + 1024; float* VS = QS + 2048;
    float* RED2 = (float*)(lds + 49152);
    const bf16* PROJ = (const bf16*)(P->ws + WS_PROJ);
    const float* GB = (const float*)(P->ws + WS_GB);
    bf16* OCAT = (bf16*)(P->ws + WS_XA);
#pragma unroll
    for (int part = 0; part < 3; ++part) {
        const int col = part * 512 + h * 128 + c;
        const float* cw = P->in[9] + (size_t)(l * 4) * 1536 + col;
        const float w0 = cw[0], w1 = cw[1536], w2 = cw[2 * 1536], w3 = cw[3 * 1536];
        const float* hs = P->in[3] + (size_t)((l * DBATCH + sb) * 3) * 1536 + col;
        float r0 = hs[0], r1 = hs[1536], r2 = hs[2 * 1536];
        float* dst = QS + part * 1024 + c;
#pragma unroll
        for (int t = 0; t < 8; ++t) {
            const float x = bf1(PROJ[(size_t)(rowbase + t) * NPROJ + col]);
            dst[t * 128] = siluf(w0 * r0 + w1 * r1 + w2 * r2 + w3 * x);
            r0 = r1; r1 = r2; r2 = x;
        }
    }
#pragma unroll
    for (int t = 0; t < 8; ++t) {
        const float q = QS[t * 128 + c], k = KS[t * 128 + c];
        const float sq = wave_sum(q * q), sk = wave_sum(k * k);
        if (lane == 0) { RED2[(gq * 2 + wv2) * 16 + t] = sq; RED2[(gq * 2 + wv2) * 16 + 8 + t] = sk; }
    }
    __syncthreads();
#pragma unroll
    for (int t = 0; t < 8; ++t) {
        const float tq = RED2[(gq * 2) * 16 + t] + RED2[(gq * 2 + 1) * 16 + t], tk = RED2[(gq * 2) * 16 + 8 + t] + RED2[(gq * 2 + 1) * 16 + 8 + t];
        QS[t * 128 + c] *= rsqrtf(tq + EPS) * 0.08838834764831845f; KS[t * 128 + c] *= rsqrtf(tk + EPS);
    }
    __syncthreads();
    float s[128];
    {
        const float* S0 = P->in[2] + (size_t)((l * DBATCH + sb) * 4 + h) * 16384 + c;
#pragma unroll
        for (int d8 = 0; d8 < 16; ++d8) {
#pragma unroll
            for (int e = 0; e < 8; ++e) s[8 * d8 + e] = S0[e * 128];
            S0 += 8 * 128; asm volatile("" : "+v"(S0));
        }
    }
    float* GBS = RED2 + 128 + gq * 16;
    if (c < 8) { GBS[c] = __expf(GB[(size_t)(rowbase + c) * 8 + h]); GBS[8 + c] = GB[(size_t)(rowbase + c) * 8 + 4 + h]; }
    LDS_WAIT(); __syncthreads();
#pragma unroll 1
    for (int t = 0; t < 8; ++t) {
        const float eg = GBS[t], beta = GBS[8 + t];
        const f32x4* kp = (const f32x4*)(KS + t * 128); const f32x4* qp = (const f32x4*)(QS + t * 128);
        float dot = 0.f;
#pragma unroll
        for (int d4 = 0; d4 < 32; ++d4) { const f32x4 kv = kp[d4]; dot += kv[0] * s[4 * d4] + kv[1] * s[4 * d4 + 1] + kv[2] * s[4 * d4 + 2] + kv[3] * s[4 * d4 + 3];
            if ((d4 & 3) == 3) asm volatile("" ::: "memory"); }
        const float cf = beta * (VS[t * 128 + c] - eg * dot);
        float o = 0.f;
#pragma unroll
        for (int d4 = 0; d4 < 32; ++d4) { const f32x4 kv = kp[d4], qv = qp[d4];
#pragma unroll
            for (int e = 0; e < 4; ++e) { s[4 * d4 + e] = eg * s[4 * d4 + e] + cf * kv[e]; o += qv[e] * s[4 * d4 + e]; }
            if ((d4 & 3) == 3) asm volatile("" ::: "memory"); }
        VS[t * 128 + c] = o;
    }
    {
        float* sd = P->out + O_SDELTA + (size_t)((l * DBATCH + sb) * 4 + h) * 16384 + c;
#pragma unroll
        for (int d8 = 0; d8 < 16; ++d8) {
#pragma unroll
            for (int e = 0; e < 8; ++e) sd[e * 128] = s[8 * d8 + e];
            sd += 8 * 128; asm volatile("" : "+v"(sd));
        }
    }
    __syncthreads();
#pragma unroll
    for (int t = 0; t < 8; ++t) { const float o = VS[t * 128 + c]; const float so = wave_sum(o * o); if (lane == 0) RED2[(gq * 2 + wv2) * 16 + t] = so; }
    __syncthreads();
    const float onv = P->in[12][l * 128 + c];
#pragma unroll
    for (int t = 0; t < 8; ++t) {
        const float tot = RED2[(gq * 2) * 16 + t] + RED2[(gq * 2 + 1) * 16 + t];
        const float z = bf1(PROJ[(size_t)(rowbase + t) * NPROJ + 1536 + h * 128 + c]);
        OCAT[(size_t)(rowbase + t) * D + h * 128 + c] = (bf16)f2bf(VS[t * 128 + c] * rsqrtf(tot * (1.f / 128.f) + EPS) * onv * siluf(z));
    }
    __syncthreads();
}

constexpr int PL_DT = 0, PL_PW = 33792;
__device__ __forceinline__ void pool_tile(KP P, int l, int tile, unsigned char* lds, int wave_in) {
    const int tid = fresh_tid(wave_in);
    bf16* DT = (bf16*)(lds + PL_DT);
    const bf16* PROJ = (const bf16*)(P->ws + WS_PROJ);
    bf16* OCAT = (bf16*)(P->ws + WS_XA);
#pragma unroll 1
    for (int i = 0; i < 4; ++i) {
        const int idx = tid + 512 * i, tok = idx & 63, ch8 = idx >> 6, c0 = ch8 * 8, gi = ch8 >> 3, win = 2 << gi;
        int row, t, sb = 0; bool smp;
        if (tile < 256) { t = (tile & 31) * 64 + tok; row = (tile >> 5) * SEQL + t; smp = false; }
        else { sb = (tile - 256) * 8 + (tok >> 3); t = tok & 7; row = MP + sb * 8 + t; smp = true; }
        float ssum[8], cur[8];
#pragma unroll
        for (int e = 0; e < 8; ++e) { ssum[e] = 0.f; cur[e] = 0.f; }
        {
            v4u wv[16];
#pragma unroll
            for (int j = 0; j < 16; ++j) {
                wv[j] = (v4u){0u, 0u, 0u, 0u};
                if (j < win && t - j >= 0) wv[j] = *(const v4u*)(PROJ + (size_t)(row - j) * NPROJ + 2048 + c0);
            }
#pragma unroll
            for (int j = 0; j < 16; ++j) {
                float f[8]; UNPACK8(wv[j], f);
#pragma unroll
                for (int e = 0; e < 8; ++e) { ssum[e] += f[e]; if (j == 0) cur[e] = f[e]; }
            }
            if (smp) {
                for (int j = t + 1; j < win; ++j) { const float* sp = P->in[4] + (size_t)((l * DBATCH + sb) * 15 + 15 + t - j) * 256 + c0;
#pragma unroll
                    for (int e = 0; e < 8; ++e) ssum[e] += sp[e]; }
            }
        }
        const float inv = 1.f / (float)(smp ? win : (t + 1 < win ? t + 1 : win));
        { float dd[8];
#pragma unroll
            for (int e = 0; e < 8; ++e) dd[e] = ssum[e] * inv - cur[e];
            *(v4u*)(DT + tok * 264 + c0) = PACK8(dd); }
        float u0[8], u1[8], u2[8];
#pragma unroll
        for (int j = 0; j < 3; ++j) {
            const int tt = t - j; float f[8];
            if (tt >= 0) { const v4u wc = *(const v4u*)(PROJ + (size_t)(row - j) * NPROJ + 2816 + c0); const v4u wx = *(const v4u*)(PROJ + (size_t)(row - j) * NPROJ + 2304 + c0);
                float fc[8], fx[8]; UNPACK8(wc, fc); UNPACK8(wx, fx);
#pragma unroll
                for (int e = 0; e < 8; ++e) f[e] = fc[e] * fx[e]; }
            else if (smp) { const float* sp = P->in[5] + (size_t)((l * DBATCH + sb) * 2 + 2 + tt) * 256 + c0;
#pragma unroll
                for (int e = 0; e < 8; ++e) f[e] = sp[e]; }
            else {
#pragma unroll
                for (int e = 0; e < 8; ++e) f[e] = 0.f; }
#pragma unroll
            for (int e = 0; e < 8; ++e) { if (j == 0) u0[e] = f[e]; else if (j == 1) u1[e] = f[e]; else u2[e] = f[e]; }
        }
        const float* sw = P->in[15] + (size_t)(l * 3) * 256 + c0;
        const v4u wb = *(const v4u*)(PROJ + (size_t)row * NPROJ + 2560 + c0); float fb[8]; UNPACK8(wb, fb);
        float oc[8];
#pragma unroll
        for (int e = 0; e < 8; ++e) oc[e] = fb[e] * (sw[e] * u2[e] + sw[256 + e] * u1[e] + sw[512 + e] * u0[e]);
        *(v4u*)(OCAT + (size_t)row * D + 768 + c0) = PACK8(oc);
    }
    __syncthreads();
    {
        const int lane = tid & 63, wv = tid >> 6, fr = lane & 15, fq = lane >> 4, g = wv & 3, th = wv >> 2;
        bf16x8 df[2][2], pf[4][2];
#pragma unroll
        for (int tt = 0; tt < 2; ++tt)
#pragma unroll
            for (int ks = 0; ks < 2; ++ks) df[tt][ks] = *(const bf16x8*)(lds + PL_DT + ((th * 32 + tt * 16 + fr) * 264 + g * 64 + ks * 32 + 8 * fq) * 2);
#pragma unroll
        for (int et = 0; et < 4; ++et)
#pragma unroll
            for (int ks = 0; ks < 2; ++ks) pf[et][ks] = *(const bf16x8*)(lds + PL_PW + (((g * 64 + et * 16 + fr) * 72) + ks * 32 + 8 * fq) * 2);
#pragma unroll
        for (int tt = 0; tt < 2; ++tt) {
            const int tok = th * 32 + tt * 16 + fr;
            const int row = tile < 256 ? (tile >> 5) * SEQL + (tile & 31) * 64 + tok : MP + (tile - 256) * 64 + tok;
#pragma unroll
            for (int et = 0; et < 4; ++et) {
                f32x4 acc = (f32x4){0.f, 0.f, 0.f, 0.f};
#pragma unroll
                for (int ks = 0; ks < 2; ++ks) acc = __builtin_amdgcn_mfma_f32_16x16x32_bf16(pf[et][ks], df[tt][ks], acc, 0, 0, 0);
                const int ch = g * 64 + et * 16 + 4 * fq;
                const f32x4 sc = *(const f32x4*)(P->in[14] + l * 256 + ch);
                *(v2u*)(OCAT + (size_t)row * D + 512 + ch) = (v2u){pk2(acc[0] * sc[0], acc[1] * sc[1]), pk2(acc[2] * sc[2], acc[3] * sc[3])};
            }
        }
    }
    __syncthreads();
}

__device__ __forceinline__ void state_copies(KP P, int l, int start, int stride) {
    const bf16* PROJ = (const bf16*)(P->ws + WS_PROJ);
    for (int i = start; i < 136 * 1120; i += stride) {
        const int seq = i / 1120, r = (i % 1120) * 8;
        const bool smp = seq >= 8; const int sb = seq - 8;
        const int L = smp ? 8 : SEQL; const size_t row0 = smp ? (size_t)MP + sb * 8 : (size_t)seq * SEQL;
        float f[8]; float* o;
        if (r < 4608) {
            const int j = r / 1536, c = r % 1536;
            const v4u w = *(const v4u*)(PROJ + (row0 + L - 3 + j) * NPROJ + c); UNPACK8(w, f);
            o = smp ? P->out + O_SDCONV + (size_t)((l * DBATCH + sb) * 3 + j) * 1536 + c : P->out + O_PDCONV + (size_t)((l * NBATCH + seq) * 3 + j) * 1536 + c;
        } else if (r < 4608 + 3840) {
            const int r2 = r - 4608, j = r2 / 256, c = r2 % 256;
            if (smp) {
                if (j < 7) { const float* sp = P->in[4] + (size_t)((l * DBATCH + sb) * 15 + 8 + j) * 256 + c;
#pragma unroll
                    for (int e = 0; e < 8; ++e) f[e] = sp[e]; }
                else { const v4u w = *(const v4u*)(PROJ + (row0 + j - 7) * NPROJ + 2048 + c); UNPACK8(w, f); }
                o = P->out + O_SPOOL + (size_t)((l * DBATCH + sb) * 15 + j) * 256 + c;
            } else {
                const v4u w = *(const v4u*)(PROJ + (row0 + L - 15 + j) * NPROJ + 2048 + c); UNPACK8(w, f);
                o = P->out + O_PPOOL + (size_t)((l * NBATCH + seq) * 15 + j) * 256 + c;
            }
        } else {
            const int r2 = r - 8448, j = r2 / 256, c = r2 % 256;
            const size_t row = row0 + L - 2 + j;
            const v4u wc = *(const v4u*)(PROJ + row * NPROJ + 2816 + c); const v4u wx = *(const v4u*)(PROJ + row * NPROJ + 2304 + c);
            float fc[8], fx[8]; UNPACK8(wc, fc); UNPACK8(wx, fx);
#pragma unroll
            for (int e = 0; e < 8; ++e) f[e] = fc[e] * fx[e];
            o = smp ? P->out + O_SSCONV + (size_t)((l * DBATCH + sb) * 2 + j) * 256 + c : P->out + O_PSCONV + (size_t)((l * NBATCH + seq) * 2 + j) * 256 + c;
        }
        *(f32x4*)o = (f32x4){f[0], f[1], f[2], f[3]}; *(f32x4*)(o + 4) = (f32x4){f[4], f[5], f[6], f[7]};
    }
}

__device__ __forceinline__ void p4b(KP P, int l, int hf, int start, int stride) {
    bf16* GU = (bf16*)(P->ws + WS_GU); bf16* HALO = (bf16*)(P->ws + WS_HALO);
    const float* cw = P->in[19] + (size_t)(l * 3) * FF;
    const int r0 = hf * MH;
    for (int idx = start; idx < MH * 352; idx += stride) {
        const int lr = idx / 352, c0 = (idx % 352) * 8, m = r0 + lr;
        int t, sb = 0; bool smp;
        if (m < MP) { t = m & (SEQL - 1); smp = false; } else { sb = (m - MP) >> 3; t = (m - MP) & 7; smp = true; }
        float g0[8], g1[8], g2[8];
#pragma unroll
        for (int j = 0; j < 3; ++j) {
            const int tt = t - j; float f[8];
            if (tt < 0) {
                if (smp) { const float* sp = P->in[6] + (size_t)((l * DBATCH + sb) * 2 + 2 + tt) * FF + c0;
#pragma unroll
                    for (int e = 0; e < 8; ++e) f[e] = sp[e]; }
                else {
#pragma unroll
                    for (int e = 0; e < 8; ++e) f[e] = 0.f; }
            } else {
                const v4u w = (lr - j < 0) ? *(const v4u*)(HALO + (size_t)(2 + lr - j) * FF + c0) : *(const v4u*)(GU + (size_t)(lr - j) * NGU + c0);
                UNPACK8(w, f);
            }
#pragma unroll
            for (int e = 0; e < 8; ++e) { if (j == 0) g0[e] = f[e]; else if (j == 1) g1[e] = f[e]; else g2[e] = f[e]; }
        }
        const v4u wu = *(const v4u*)(GU + (size_t)lr * NGU + FF + c0); float fu[8]; UNPACK8(wu, fu);
        float a[8];
#pragma unroll
        for (int e = 0; e < 8; ++e) a[e] = siluf(cw[c0 + e] * g2[e] + cw[FF + c0 + e] * g1[e] + cw[2 * FF + c0 + e] * g0[e]) * fu[e];
        *(v4u*)(GU + (size_t)lr * NGU + FF + c0) = PACK8(a);
        if (!smp && t >= SEQL - 2) { float* o = P->out + O_PFFN + (size_t)((l * NBATCH + (m >> 11)) * 2 + t - (SEQL - 2)) * FF + c0;
#pragma unroll
            for (int e = 0; e < 8; ++e) o[e] = g0[e]; }
        if (smp && t >= 6) { float* o = P->out + O_SFFN + (size_t)((l * DBATCH + sb) * 2 + t - 6) * FF + c0;
#pragma unroll
            for (int e = 0; e < 8; ++e) o[e] = g0[e]; }
        if (hf == 0 && lr >= MH - 2) *(v4u*)(HALO + (size_t)(lr - (MH - 2)) * FF + c0) = *(const v4u*)(GU + (size_t)lr * NGU + c0);
    }
}

#define LAS __attribute__((address_space(3)))
#define XB_TMO      128
#define XB_XCNT(j)  (256  + 64 * (j))
#define XB_XSUB(j)  (1280 + 64 * (j))
#define XB_XGEN(j)  (2304 + 64 * (j))
#define XB_TOP      3328
#define XB_TOPGEN   3392
#define XCD_BAR_WORDS 3456
#define XB_SPIN_CAP (1u << 18)

__device__ __forceinline__ unsigned xb_ld(unsigned* p)              { return __hip_atomic_load(p, __ATOMIC_RELAXED, __HIP_MEMORY_SCOPE_AGENT); }
__device__ __forceinline__ unsigned xb_add(unsigned* p, unsigned v) { return __hip_atomic_fetch_add(p, v, __ATOMIC_RELAXED, __HIP_MEMORY_SCOPE_AGENT); }
__device__ __forceinline__ unsigned xb_xcc_id() { return (unsigned)__builtin_amdgcn_s_getreg((3 << 11) | 20) & 0xFu; }
#define XB_SPIN(cond, bar) do { unsigned _sp = 0; while (cond) { __builtin_amdgcn_s_sleep(1); \
    if ((++_sp & 255u) == 0u) { if (xb_ld(&(bar)[XB_TMO])) break; if (_sp > XB_SPIN_CAP) { atomicAdd(&(bar)[XB_TMO], 1u); break; } } } } while (0)

struct XcdBarrier {
    unsigned* bar; unsigned x;
    volatile LAS unsigned* st;
    int wave;
};

__device__ __forceinline__ XcdBarrier xcd_barrier_post(unsigned* bar, volatile LAS unsigned* st) {
    XcdBarrier b; b.bar = bar; b.x = xb_xcc_id(); b.st = st; b.wave = 0;
    if (threadIdx.x == 0) (void)xb_add(&bar[XB_XCNT(b.x)], 1u);
    return b;
}
__device__ __forceinline__ void xcd_barrier_complete(unsigned* bar, unsigned x, unsigned& nloc, unsigned& nx) {
    const unsigned G = gridDim.x * gridDim.y * gridDim.z;
    unsigned sum, cnt, mine, sp = 0u;
    for (;;) {
        sum = 0u; cnt = 0u; mine = 0u;
#pragma unroll
        for (unsigned j = 0; j < 16; ++j) { const unsigned c = xb_ld(&bar[XB_XCNT(j)]); sum += c; cnt += (c > 0u) ? 1u : 0u; mine = (j == x) ? c : mine; }
        if (sum == G) break;
        __builtin_amdgcn_s_sleep(1);
        if ((++sp & 255u) == 0u) { if (xb_ld(&bar[XB_TMO])) break; if (sp > XB_SPIN_CAP) { atomicAdd(&bar[XB_TMO], 1u); break; } }
    }
    nloc = mine > 0u ? mine : 1u; nx = cnt > 0u ? cnt : 1u;
}

__device__ __forceinline__ void xcd_barrier(const XcdBarrier& b) {
    asm volatile("s_waitcnt vmcnt(0)" ::: "memory");
    __syncthreads();
    if (b.wave == 0 && lane_id() == 0) {
        unsigned* bar = b.bar;
        __builtin_amdgcn_s_waitcnt(0);
        unsigned nloc = b.st[0], nx = b.st[1];
        if (nloc == 0u) { xcd_barrier_complete(bar, b.x, nloc, nx); b.st[0] = nloc; b.st[1] = nx; }
        const unsigned old = xb_add(&bar[XB_XSUB(b.x)], 1u);
        const unsigned gen = old / nloc;
        if (old + 1u == (gen + 1u) * nloc) {
            __builtin_amdgcn_fence(__ATOMIC_RELEASE, "agent");
            asm volatile("s_waitcnt vmcnt(0)" ::: "memory");
            const unsigned og = xb_add(&bar[XB_TOP], 1u);
            const unsigned tg = og / nx;
            if (og + 1u == (tg + 1u) * nx) xb_add(&bar[XB_TOPGEN], 1u);
            else XB_SPIN(xb_ld(&bar[XB_TOPGEN]) == tg, bar);
            __builtin_amdgcn_fence(__ATOMIC_ACQUIRE, "agent");
            xb_add(&bar[XB_XGEN(b.x)], 1u);
            asm volatile("s_waitcnt vmcnt(0)" ::: "memory");
        } else {
            XB_SPIN(xb_ld(&bar[XB_XGEN(b.x)]) == gen, bar);
            __builtin_amdgcn_fence(__ATOMIC_ACQUIRE, "agent");
            asm volatile("s_waitcnt vmcnt(0)" ::: "memory");
        }
    }
    __syncthreads();
}

#define XSYNC1() do { XcdBarrier b_; b_.bar = (unsigned*)(kparams()->ws + WS_BAR); b_.x = xb_xcc_id(); b_.st = (volatile LAS unsigned*)((LAS unsigned char*)lds + (LDS_BYTES - 64)); b_.wave = wave; xcd_barrier(b_); } while (0)
#ifdef PROBE_SYNC2
#define GSYNC() do { XSYNC1(); XSYNC1(); } while (0)
#else
#define GSYNC() XSYNC1()
#endif
__global__ void __launch_bounds__(NTHREADS, 2) fwd_megakernel(Params Parg) {
    KP P = kparams();
    extern __shared__ __attribute__((aligned(16))) unsigned char lds[];
    cg::grid_group grid = cg::this_grid();
    const int wave = __builtin_amdgcn_readfirstlane((int)threadIdx.x >> 6);
    const int tid = fresh_tid(wave), lane = tid & 63;
    const int G = gridDim.x, bx = blockIdx.x;
    const int gw = bx * NWAVES + wave, ngw = G * NWAVES;
    const int gt = bx * NTHREADS + tid, ngt = G * NTHREADS;
    unsigned char* ws = P->ws;
    bf16* XA = (bf16*)(ws + WS_XA); bf16* XB2 = (bf16*)(ws + WS_PROJ); bf16* PROJ = (bf16*)(ws + WS_PROJ); bf16* GU = (bf16*)(ws + WS_GU);
    float* SSQ = (float*)(ws + WS_SSQ); float* GB = (float*)(ws + WS_GB); float* WAB = (float*)(ws + WS_WAB);
    float* XRES = P->out;
    float* wscr = (float*)(lds + wave * 16384);
    volatile LAS unsigned* xst = (volatile LAS unsigned*)((LAS unsigned char*)lds + (LDS_BYTES - 64));
    if (tid < 16) xst[tid] = 0u;
    __syncthreads();
    (void)xcd_barrier_post((unsigned*)(ws + WS_BAR), xst);

    for (int i = gt; i < 4 * M; i += ngt) SSQ[M + i] = 0.f;
    for (int i = gt; i < MS * D / 4; i += ngt) ((f32x4*)(XRES + (size_t)MP * D))[i] = ((const f32x4*)P->in[1])[i];
    for (int i = gt; i < 2 * 8 * D; i += ngt) { const int l = i >> 13, j = (i >> 10) & 7, k = i & 1023; WAB[i] = P->in[7][l * D + k] * P->in[8][(size_t)l * D * DIN + (size_t)k * DIN + 2048 + j]; }
    convert_win(P, 0, wscr, gw, ngw, lane);
    convert_layer_rest(P, 0, wscr, gw, ngw, lane);
    convert_layer_rest(P, 1, wscr, gw, ngw, lane);
    for (int m0 = gw; m0 < M; m0 += 2 * ngw) {
        f32x4 v[2][4];
#pragma unroll
        for (int q = 0; q < 2; ++q) { const int m = m0 + q * ngw;
            const float* xr = m < MP ? P->in[0] + (size_t)m * D : P->in[1] + (size_t)((m < M ? m : M - 1) - MP) * D;
#pragma unroll
            for (int j = 0; j < 4; ++j) v[q][j] = ((const f32x4*)xr)[lane + 64 * j]; }
#pragma unroll
        for (int q = 0; q < 2; ++q) { const int m = m0 + q * ngw;
            if (m < M) {
                float ss = 0.f;
#pragma unroll
                for (int j = 0; j < 4; ++j) { const f32x4 w4 = v[q][j]; ss += w4[0] * w4[0] + w4[1] * w4[1] + w4[2] * w4[2] + w4[3] * w4[3];
                    ((v2u*)(XA + (size_t)m * D))[lane + 64 * j] = (v2u){pk2(w4[0], w4[1]), pk2(w4[2], w4[3])}; }
                ss = wave_sum(ss);
                if (lane == 0) SSQ[m] = ss;
            } }
    }
    if (ws == nullptr) grid.sync();
    GSYNC();

#pragma unroll 1
    for (int l = 0; l < 2; ++l) {
#ifndef NO_P1
        {
            const bf16* gA = XA; const bf16* gB = (const bf16*)(ws + WS_WIN); LAUNDER(gA); LAUNDER(gB);
            pg8::Gemm g{gA, gB, M, NPROJ, D, D, D}; pg8::StaticOrder S; S.init(M, NPROJ, G, bx);
            EpiScale E{PROJ, NPROJ, SSQ + (size_t)(2 * l) * M};
            pg8::gemm_phase<EpiScale, pg8::StaticOrder, true, true>((PG8_LAS unsigned char*)lds, g, S, E, wave);
#ifdef PROBE_P1X2
            __syncthreads();
            pg8::gemm_phase<EpiScale, pg8::StaticOrder, true, true>((PG8_LAS unsigned char*)lds, g, S, E, wave);
#endif
        }
#endif
#ifndef NO_AB
        {
            const float* ssq = SSQ + (size_t)(2 * l) * M;
            const int nab = (G > 96 ? G - 48 : G), bab = (G > 96 ? bx - 48 : bx);
            const int tf = fresh_tid(wave), lane = tf & 63, gw = bab * NWAVES + __builtin_amdgcn_readfirstlane(tf >> 6), ngw = nab * NWAVES;
            if (bab >= 0)
            for (int m0 = gw; m0 < M; m0 += 2 * ngw) {
                v4u xq[2][2]; float sqv[2];
#pragma unroll
                for (int q = 0; q < 2; ++q) { const int m = (m0 + q * ngw) < M ? (m0 + q * ngw) : (M - 1);
                    const v4u* xr = (const v4u*)(XA + (size_t)m * D) + lane * 2; xq[q][0] = xr[0]; xq[q][1] = xr[1]; sqv[q] = ssq[m]; }
#pragma unroll
                for (int q = 0; q < 2; ++q) {
                    const int m = m0 + q * ngw;
                    float xf[16]; UNPACK8(xq[q][0], xf); UNPACK8(xq[q][1], xf + 8);
                    float dot[8];
#pragma unroll
                    for (int j = 0; j < 8; ++j) { const float* wp = WAB + (size_t)(l * 8 + j) * D + lane * 16; float s2 = 0.f;
#pragma unroll
                        for (int e = 0; e < 16; ++e) s2 += wp[e] * xf[e];
                        dot[j] = wave_sum(s2); }
                    float v = dot[0];
#pragma unroll
                    for (int j = 1; j < 8; ++j) v = (lane == j) ? dot[j] : v;
                    if (lane < 8 && m < M) {
                        v *= rsqrtf(sqv[q] * (1.f / D) + EPS);
                        const int hh = lane & 3; float r;
                        if (lane < 4) { const float xx = v + P->in[11][l * 4 + hh]; const float sp = fmaxf(xx, 0.f) + __logf(1.f + __expf(-fabsf(xx))); r = -__expf(P->in[10][l * 4 + hh]) * sp; }
                        else r = __builtin_amdgcn_rcpf(1.f + __expf(-v));
                        GB[(size_t)m * 8 + lane] = r;
                    }
                }
            }
        }
#endif
        GSYNC();
#ifndef NO_P2B
        { const int tf = fresh_tid(wave); for (int item = bx; item < 1024; item += G) p2b_item(P, l, item, lds, wave); }
#ifdef PROBE_P2B2
        __syncthreads(); { const int tf = fresh_tid(wave); for (int item = bx; item < 1024; item += G) p2b_item(P, l, item, lds, wave); }
#endif
#endif
        GSYNC();
#ifdef PROBE_SCAN2
        if (bx < 64) { scan_wg(P, l, bx, lds, fresh_tid(wave)); }
#endif
#ifndef NO_SCAN
        if (bx < 64) scan_wg(P, l, bx, lds, fresh_tid(wave));
#endif
        {
            unsigned* qctr = (unsigned*)(ws + WS_BAR) + 3600 + l;
            volatile unsigned* qslot = (volatile unsigned*)(lds + LDS_BYTES - 128);
            bool have_pw = false;
            for (;;) {
                const int tid = fresh_tid(wave);
                __syncthreads();
                if (tid == 0) *qslot = atomicAdd(qctr, 1u);
                __syncthreads();
                const int it = (int)*qslot;
                if (it >= 128 + 272 + 64) break;
                if (it < 128) { sample_delta(P, l, it, lds, wave); have_pw = false; }
                else if (it < 400) {
                    if (!have_pw) {
                        for (int i = tid; i < 16384; i += NTHREADS) { const int e = i & 63, c = (i >> 6) & 63, g = i >> 12; ((bf16*)(lds + PL_PW))[(g * 64 + e) * 72 + c] = (bf16)f2bf(P->in[13][(size_t)l * 16384 + i]); }
                        __syncthreads(); have_pw = true;
                    }
                    pool_tile(P, l, it - 128, lds, wave);
                } else state_copies(P, l, (it - 400) * NTHREADS + tid, 64 * NTHREADS);
            }
        }
        GSYNC();
        {
            const bf16* gB = (const bf16*)(ws + WS_WOUT) + (size_t)l * D * D;
            const int ks = bx >> 4; const bf16* gA2 = XA + (size_t)MP * D + ks * 256; const bf16* gB2 = gB + ks * 256; LAUNDER(gA2); LAUNDER(gB2);
            pg8::Gemm g2{gA2, gB2, MS, D, 256, D, D}; SplitOrder S2{bx < 64 ? (bx & 15) : -1};
            EpiAtomic E2{(float*)(ws + WS_SCR) + (size_t)ks * MS * D};
            pg8::gemm_phase<EpiAtomic, SplitOrder, true, true>((PG8_LAS unsigned char*)lds, g2, S2, E2, wave);
        }
        { const int tf = fresh_tid(wave); p2d(P, l, bx * NWAVES + __builtin_amdgcn_readfirstlane(tf >> 6), ngw, tf & 63); }
        GSYNC();
#ifdef PROBE_P2D2
        { const int tf = fresh_tid(wave); p2d(P, l, bx * NWAVES + __builtin_amdgcn_readfirstlane(tf >> 6), ngw, tf & 63); }
        GSYNC();
        { const int tf = fresh_tid(wave); p2d(P, l, bx * NWAVES + __builtin_amdgcn_readfirstlane(tf >> 6), ngw, tf & 63); }
        GSYNC();
        { const int tf = fresh_tid(wave); p2d(P, l, bx * NWAVES + __builtin_amdgcn_readfirstlane(tf >> 6), ngw, tf & 63); }
        GSYNC();
#endif
        fin_sample(XRES + (size_t)MP * D, XB2 + (size_t)MP * D, SSQ + (size_t)(2 * l + 1) * M + MP, (const float*)(ws + WS_SCR), 4, nullptr, 0, bx * NWAVES + wave, ngw, lane_id());
        {
            const bf16* gA = XA; const bf16* gB = (const bf16*)(ws + WS_WOUT) + (size_t)l * D * D; LAUNDER(gA); LAUNDER(gB);
            pg8::Gemm g{gA, gB, MP, D, D, D, D}; pg8::StaticOrder S; S.init(MP, D, G, bx);
            EpiResid E{l == 0 ? P->in[0] : XRES, l == 0 ? P->in[1] : XRES + (size_t)MP * D, XRES, XB2, SSQ + (size_t)(2 * l + 1) * M, 0};
            pg8::gemm_phase<EpiResid, pg8::StaticOrder, true, true>((PG8_LAS unsigned char*)lds, g, S, E, wave);
        }
        GSYNC();
        {
            const bf16* gA = XB2; const bf16* gB = (const bf16*)(ws + WS_WGU) + (size_t)l * NGU * D; LAUNDER(gA); LAUNDER(gB);
            pg8::Gemm g{gA, gB, M, NGU, D, D, D}; pg8::StaticOrder S; S.init(M, NGU, G, bx);
            EpiGateUp E{GU, SSQ + (size_t)(2 * l + 1) * M, P->in[19] + (size_t)(l * 3) * FF, P->in[6] + (size_t)l * DBATCH * 2 * FF, (float*)(ws + WS_HAL), (float*)(ws + WS_FIXG), (float*)(ws + WS_FIXU),
                        P->out + O_PFFN + (size_t)l * NBATCH * 2 * FF, P->out + O_SFFN + (size_t)l * DBATCH * 2 * FF, lds};
            pg8::gemm_phase<EpiGateUp, pg8::StaticOrder, true, true>((PG8_LAS unsigned char*)lds, g, S, E, wave);
#ifdef PROBE_P4X2
            __syncthreads();
            pg8::gemm_phase<EpiGateUp, pg8::StaticOrder, true, true>((PG8_LAS unsigned char*)lds, g, S, E, wave);
#endif
        }
        GSYNC();
        {
            const bf16* gB = (const bf16*)(ws + WS_WDN) + (size_t)l * D * FF;
            const int ks = bx >> 4; const bf16* gA2 = GU + (size_t)MP * FF + ks * 256; const bf16* gB2 = gB + ks * 256; LAUNDER(gA2); LAUNDER(gB2);
            pg8::Gemm g2{gA2, gB2, MS, D, 256, FF, FF}; SplitOrder S2{bx < 176 ? (bx & 15) : -1};
            EpiAtomic E2{ks < 8 ? (float*)(ws + WS_PROJ) + (size_t)ks * MS * D : (float*)(ws + WS_PART2) + (size_t)(ks - 8) * MS * D};
            pg8::gemm_phase<EpiAtomic, SplitOrder, true, true>((PG8_LAS unsigned char*)lds, g2, S2, E2, wave);
        }
        p4_fixup(P, l, bx * NTHREADS + fresh_tid(wave), ngt);
        if (l == 0) { const int tf = fresh_tid(wave); convert_win(P, 1, (float*)(lds + wave * 16384), bx * NWAVES + wave, ngw, tf & 63); }
        GSYNC();
        fin_sample(XRES + (size_t)MP * D, XA + (size_t)MP * D, SSQ + (size_t)(2 * l + 2) * M + MP, (const float*)(ws + WS_PROJ), 8, (const float*)(ws + WS_PART2), 3, bx * NWAVES + wave, ngw, lane_id());
        {
            const bf16* gA = GU; const bf16* gB = (const bf16*)(ws + WS_WDN) + (size_t)l * D * FF; LAUNDER(gA); LAUNDER(gB);
            pg8::Gemm g{gA, gB, MP, D, FF, FF, FF}; pg8::StaticOrder S; S.init(MP, D, G, bx);
            EpiResid E{XRES, XRES + (size_t)MP * D, XRES, XA, SSQ + (size_t)(2 * l + 2) * M, 0};
            pg8::gemm_phase<EpiResid, pg8::StaticOrder, true, true>((PG8_LAS unsigned char*)lds, g, S, E, wave);
        }
        GSYNC();
    }
    {
        const float* ssq = SSQ + (size_t)4 * M; const float* fn = P->in[22];
        const int gt = bx * NTHREADS + fresh_tid(wave);
        for (int i0 = gt; i0 < M * 256; i0 += 4 * ngt) {
            f32x4 v[4]; float sq[4];
#pragma unroll
            for (int q = 0; q < 4; ++q) { const int i = i0 + q * ngt; v[q] = (f32x4){0.f, 0.f, 0.f, 0.f}; sq[q] = 1.f;
                if (i < M * 256) { v[q] = ((const f32x4*)XRES)[i]; sq[q] = ssq[i >> 8]; } }
#pragma unroll
            for (int q = 0; q < 4; ++q) { const int i = i0 + q * ngt;
                if (i < M * 256) { const float rs = rsqrtf(sq[q] * (1.f / D) + EPS); const f32x4 gv = ((const f32x4*)fn)[i & 255];
                    f32x4 o = v[q]; o[0] *= rs * gv[0]; o[1] *= rs * gv[1]; o[2] *= rs * gv[2]; o[3] *= rs * gv[3];
                    ((f32x4*)XRES)[i] = o; } }
        }
    }
}

extern "C" void kernel_launch(void* const* d_in, const int* in_sizes, int n_in, void* d_out, int out_size, void* d_ws, size_t ws_size, hipStream_t stream) {
    static int grid = 0;
    if (grid == 0) {
        if (n_in != 23 || (size_t)out_size != O_TOTAL || ws_size < WS_END) { fprintf(stderr, "kernel_launch: unexpected shapes: n_in %d out %d ws %zu\n", n_in, out_size, ws_size); grid = -1; return; }
        int dev = 0, cus = 0, per_cu = 0;
        hipGetDevice(&dev); hipDeviceGetAttribute(&cus, hipDeviceAttributeMultiprocessorCount, dev);
        if (hipFuncSetAttribute((const void*)fwd_megakernel, hipFuncAttributeMaxDynamicSharedMemorySize, LDS_BYTES) != hipSuccess) { fprintf(stderr, "kernel_launch: hipFuncSetAttribute failed\n"); grid = -1; return; }
        hipOccupancyMaxActiveBlocksPerMultiprocessor(&per_cu, (const void*)fwd_megakernel, NTHREADS, LDS_BYTES);
        (void)hipGetLastError();
        if (per_cu < 1) fprintf(stderr, "kernel_launch: occupancy query reports %d blocks per CU\n", per_cu);
        grid = cus;
    }
    if (grid < 0) return;
    if (hipMemsetAsync((char*)d_ws + WS_BAR, 0, 16384, stream) != hipSuccess) { fprintf(stderr, "kernel_launch: memset failed\n"); return; }
    Params p{};
    for (int i = 0; i < 23; ++i) p.in[i] = (const float*)d_in[i];
    p.out = (float*)d_out; p.ws = (unsigned char*)d_ws;
    void* args[] = {&p};
    hipError_t e = hipLaunchCooperativeKernel((const void*)fwd_megakernel, dim3(grid), dim3(NTHREADS), args, LDS_BYTES, stream);
    if (e != hipSuccess) fprintf(stderr, "cooperative launch failed: %s (grid %d)\n", hipGetErrorString(e), grid);
}
```
